# Optimizing an MI355X kernel written in HIP

```python
import math
import jax, jax.numpy as jnp
from jax import lax
import numpy as np

D_MODEL = 2048
BATCH = 4
SEQ = 2048
DEPTH = 1
DEC_BATCH = 128
DEC_SEQ = 1
PAST_LEN = 16384
PAGE_SIZE = 128

GLA_HEADS = 4
GLA_DK = D_MODEL // 2 // GLA_HEADS
GLA_DV = D_MODEL // GLA_HEADS
GLA_KW = GLA_HEADS * GLA_DK
GLA_VW = GLA_HEADS * GLA_DV
GATE_RANK = 16
GATE_TEMP = 16.0
GLA_CHUNK = 64
POOL_WINDOWS = (2, 4, 8, 16)
POOL_GROUPS = 4
POOL_GW = D_MODEL // 8
POOL_W = POOL_GROUPS * POOL_GW
POOL_BUF = 15
D_FF = 128 * ((8 * D_MODEL // 3 + 127) // 128)
CONV_W = 3
PLE_DIM = 256
EPS = 1e-6
IN_SIZES = (GLA_KW, GLA_KW, GLA_VW, GLA_VW, GATE_RANK, POOL_W, D_MODEL, D_MODEL)
IN_WIDTH = GLA_KW * 2 + GLA_VW * 2 + GATE_RANK + POOL_W + D_MODEL * 2

kernel_name = 'gla_pool_convffn_hybrid_step'


def rmsnorm(x, g):
    xf = x.astype(jnp.float32)
    y = xf * lax.rsqrt(jnp.mean(xf * xf, axis=-1, keepdims=True) + EPS)
    return (y * g.astype(jnp.float32)).astype(x.dtype)


def split_cols(z):
    idx = [int(i) for i in np.cumsum(IN_SIZES)[:-1]]
    return jnp.split(z, idx, axis=-1)


def gla_scan(q, k, v, glog, s0):
    B, T, H, DK = q.shape
    DV = v.shape[-1]
    C = math.gcd(T, GLA_CHUNK)
    NC = T // C

    def to_chunks(a):
        return a.reshape(B, NC, C, H, a.shape[-1]).transpose(1, 0, 3, 2, 4)

    qc, kc, vc, gc = to_chunks(q), to_chunks(k), to_chunks(v), to_chunks(glog)
    causal = jnp.tril(jnp.ones((C, C), dtype=bool))

    def step(S, inp):
        qi, ki, vi, gi = inp
        b = jnp.cumsum(gi, axis=2)
        b_last = b[:, :, -1:, :]
        qb = qi * jnp.exp(b)
        kb = ki * jnp.exp(-b)
        att = jnp.where(causal, jnp.einsum('bhtd,bhsd->bhts', qb, kb), 0.0)
        o = jnp.einsum('bhtd,bhdv->bhtv', qb, S) + jnp.einsum('bhts,bhsv->bhtv', att, vi)
        kd = ki * jnp.exp(b_last - b)
        S = jnp.exp(b_last[:, :, 0, :])[..., None] * S + jnp.einsum('bhsd,bhsv->bhdv', kd, vi)
        return S, o

    S, oc = lax.scan(step, s0, (qc, kc, vc, gc))
    o = oc.transpose(1, 0, 3, 2, 4).reshape(B, T, H, DV)
    return o, S


def pool_mix(u, buf, start_pos):
    B, T, _ = u.shape
    uf = u.astype(jnp.float32)
    ext = jnp.concatenate([buf.astype(jnp.float32), uf], axis=1)
    cs = jnp.concatenate([jnp.zeros((B, 1, POOL_W), jnp.float32), jnp.cumsum(ext, axis=1)], axis=1)
    pos = start_pos + jnp.arange(T)
    means = []
    for g, w in enumerate(POOL_WINDOWS):
        lo, hi = g * POOL_GW, (g + 1) * POOL_GW
        s = cs[:, POOL_BUF + 1:POOL_BUF + 1 + T, lo:hi] - cs[:, POOL_BUF + 1 - w:POOL_BUF + 1 - w + T, lo:hi]
        cnt = jnp.minimum(pos + 1, w).astype(jnp.float32)[None, :, None]
        means.append(s / cnt)
    mix = jnp.concatenate(means, axis=-1) - uf
    return mix.astype(u.dtype), ext[:, -POOL_BUF:].astype(buf.dtype)


def causal_dwconv(u, buf, w, b):
    T = u.shape[1]
    ext = jnp.concatenate([buf.astype(u.dtype), u], axis=1)
    y = b
    for j in range(CONV_W):
        y = y + w[j] * ext[:, j:j + T]
    return y, ext[:, -(CONV_W - 1):].astype(buf.dtype)


def trunk_layer(h, pl, s_gla, s_pool, s_conv, start_pos, lw):
    B, T, _ = h.shape
    dt = h.dtype
    f32 = jnp.float32
    a = rmsnorm(h, lw['norm_mix'])
    z = a @ lw['w_in']
    q, k, v, r, glr, u, ga, gb = split_cols(z)
    zg = glr.astype(f32) @ lw['w_gate_up'].astype(f32) + lw['b_gate'].astype(f32)
    glog = (jax.nn.log_sigmoid(zg) / GATE_TEMP).reshape(B, T, GLA_HEADS, GLA_DK)
    qh = q.astype(f32).reshape(B, T, GLA_HEADS, GLA_DK) * (GLA_DK ** -0.5)
    kh = k.astype(f32).reshape(B, T, GLA_HEADS, GLA_DK)
    vh = v.astype(f32).reshape(B, T, GLA_HEADS, GLA_DV)
    o, s_gla_new = gla_scan(qh, kh, vh, glog, s_gla.astype(f32))
    o = o * lax.rsqrt(jnp.mean(o * o, axis=-1, keepdims=True) + EPS)
    o = o * lw['gla_norm'].astype(f32).reshape(GLA_HEADS, GLA_DV)
    o = o.reshape(B, T, GLA_VW).astype(dt) * jax.nn.silu(r)
    y_a = o @ lw['w_branch_a']
    pm, s_pool_new = pool_mix(u, s_pool, start_pos)
    pm = jnp.einsum('btgc,gcd->btgd', pm.reshape(B, T, POOL_GROUPS, POOL_GW), lw['w_pool'])
    pm = pm.reshape(B, T, POOL_W) * lw['pool_scale']
    y_b = pm @ lw['w_branch_b']
    m = jax.nn.sigmoid(ga) * y_a + jax.nn.sigmoid(gb) * y_b
    h = h + m @ lw['w_out']
    c = rmsnorm(h, lw['norm_ffn'])
    gate, up = jnp.split(c @ lw['w_up'], 2, axis=-1)
    gconv, s_conv_new = causal_dwconv(gate, s_conv, lw['conv_w'], lw['conv_b'])
    h = h + (jax.nn.silu(gconv) * up) @ lw['w_down']
    pg = jax.nn.sigmoid(rmsnorm(h, lw['norm_ple']) @ lw['w_ple_gate'])
    h = h + pg * (pl @ lw['w_ple'])
    return h, s_gla_new.astype(s_gla.dtype), s_pool_new, s_conv_new


def setup_inputs(seed: int = 0) -> dict:
    key = jax.random.key(seed)
    ks = jax.random.split(key, 32)

    def nrm(k, shape, scale):
        return jax.random.normal(k, shape, jnp.float32) * scale

    L = DEPTH
    return {
        'x_prompt': nrm(ks[0], (BATCH, SEQ, D_MODEL), 1.0),
        'x_sample': nrm(ks[1], (DEC_BATCH, DEC_SEQ, D_MODEL), 1.0),
        'state_gla': nrm(ks[2], (L, DEC_BATCH, GLA_HEADS, GLA_DK, GLA_DV), 1.0),
        'state_pool': nrm(ks[3], (L, DEC_BATCH, POOL_BUF, POOL_W), 1.0),
        'state_conv': nrm(ks[4], (L, DEC_BATCH, CONV_W - 1, D_FF), 1.0),
        'p_prompt': nrm(ks[5], (L, BATCH, SEQ, PLE_DIM), 1.0),
        'p_sample': nrm(ks[6], (L, DEC_BATCH, DEC_SEQ, PLE_DIM), 1.0),
        'norm_mix': 1.0 + nrm(ks[7], (L, D_MODEL), 0.02),
        'w_in': nrm(ks[8], (L, D_MODEL, IN_WIDTH), D_MODEL ** -0.5),
        'w_gate_up': nrm(ks[9], (L, GATE_RANK, GLA_KW), GATE_RANK ** -0.5),
        'b_gate': nrm(ks[10], (L, GLA_KW), 0.01),
        'gla_norm': 1.0 + nrm(ks[11], (L, GLA_VW), 0.02),
        'w_branch_a': nrm(ks[12], (L, GLA_VW, D_MODEL), GLA_VW ** -0.5),
        'w_pool': nrm(ks[13], (L, POOL_GROUPS, POOL_GW, POOL_GW), POOL_GW ** -0.5),
        'pool_scale': 1.0 + nrm(ks[14], (L, POOL_W), 0.02),
        'w_branch_b': nrm(ks[15], (L, POOL_W, D_MODEL), POOL_W ** -0.5),
        'w_out': nrm(ks[16], (L, D_MODEL, D_MODEL), D_MODEL ** -0.5),
        'norm_ffn': 1.0 + nrm(ks[17], (L, D_MODEL), 0.02),
        'w_up': nrm(ks[18], (L, D_MODEL, 2 * D_FF), D_MODEL ** -0.5),
        'conv_w': nrm(ks[19], (L, CONV_W, D_FF), CONV_W ** -0.5),
        'conv_b': nrm(ks[20], (L, D_FF), 0.01),
        'w_down': nrm(ks[21], (L, D_FF, D_MODEL), D_FF ** -0.5),
        'norm_ple': 1.0 + nrm(ks[22], (L, D_MODEL), 0.02),
        'w_ple_gate': nrm(ks[23], (L, D_MODEL, D_MODEL), D_MODEL ** -0.5),
        'w_ple': nrm(ks[24], (L, PLE_DIM, D_MODEL), PLE_DIM ** -0.5),
        'norm_final': 1.0 + nrm(ks[25], (D_MODEL,), 0.02),
    }


def reference(x_prompt, x_sample, state_gla, state_pool, state_conv, p_prompt, p_sample,
              norm_mix, w_in, w_gate_up, b_gate, gla_norm, w_branch_a, w_pool, pool_scale,
              w_branch_b, w_out, norm_ffn, w_up, conv_w, conv_b, w_down, norm_ple, w_ple_gate,
              w_ple, norm_final):
    hp, hs = x_prompt, x_sample
    bp = x_prompt.shape[0]
    gla_p, pool_p, conv_p, gla_s, pool_s, conv_s = [], [], [], [], [], []
    for i in range(DEPTH):
        lw = {
            'norm_mix': norm_mix[i], 'w_in': w_in[i], 'w_gate_up': w_gate_up[i], 'b_gate': b_gate[i],
            'gla_norm': gla_norm[i], 'w_branch_a': w_branch_a[i], 'w_pool': w_pool[i],
            'pool_scale': pool_scale[i], 'w_branch_b': w_branch_b[i], 'w_out': w_out[i],
            'norm_ffn': norm_ffn[i], 'w_up': w_up[i], 'conv_w': conv_w[i], 'conv_b': conv_b[i],
            'w_down': w_down[i], 'norm_ple': norm_ple[i], 'w_ple_gate': w_ple_gate[i], 'w_ple': w_ple[i],
        }
        z_gla = jnp.zeros((bp, GLA_HEADS, GLA_DK, GLA_DV), state_gla.dtype)
        z_pool = jnp.zeros((bp, POOL_BUF, POOL_W), state_pool.dtype)
        z_conv = jnp.zeros((bp, CONV_W - 1, D_FF), state_conv.dtype)
        hp, g1, p1, c1 = trunk_layer(hp, p_prompt[i], z_gla, z_pool, z_conv, 0, lw)
        hs, g2, p2, c2 = trunk_layer(hs, p_sample[i], state_gla[i], state_pool[i], state_conv[i], PAST_LEN, lw)
        gla_p.append(g1); pool_p.append(p1); conv_p.append(c1)
        gla_s.append(g2); pool_s.append(p2); conv_s.append(c2)
    y_prompt = rmsnorm(hp, norm_final)
    y_sample = rmsnorm(hs, norm_final)
    new_gla_prompt = jnp.stack(gla_p, axis=0)
    new_pool_prompt = jnp.stack(pool_p, axis=0)
    new_conv_prompt = jnp.stack(conv_p, axis=0)
    new_gla_sample = jnp.stack(gla_s, axis=0)
    new_pool_sample = jnp.stack(pool_s, axis=0)
    new_conv_sample = jnp.stack(conv_s, axis=0)
    return (y_prompt, y_sample, new_gla_prompt, new_pool_prompt, new_conv_prompt, new_gla_sample, new_pool_sample, new_conv_sample)
```

```cpp
#include <hip/hip_runtime.h>
#include <hip/hip_cooperative_groups.h>
#include <cstdio>
#include <cstdint>
namespace cg = cooperative_groups;

#ifndef MK_N_LAUNCHES
#define MK_N_LAUNCHES 1
#endif

#define LAS __attribute__((address_space(3)))
#define DI __device__ __forceinline__
typedef unsigned short bf16_t;
typedef short bf16x8 __attribute__((ext_vector_type(8)));
typedef short s16x4 __attribute__((ext_vector_type(4)));
typedef float f32x4 __attribute__((ext_vector_type(4)));
typedef float f32x2 __attribute__((ext_vector_type(2)));
typedef float f32x16 __attribute__((ext_vector_type(16)));
typedef unsigned u32x4 __attribute__((ext_vector_type(4)));
typedef unsigned u32x2 __attribute__((ext_vector_type(2)));

constexpr int D = 2048, MP = 8192, MS = 128, M = MP + MS, MPAD = 8448, NTM = 33;
constexpr int SEQ = 2048, NB = 4, NH = 4, DK = 256, DV = 512, KW = 1024, VW = 2048;
constexpr int DFF = 5504, NUP = 2 * DFF, PLE = 256, POOLW = 1024, INW = 11280, NIN = 11264;
constexpr float EPS = 1e-6f;
constexpr int NSL = 16;

constexpr size_t O_YP = 0, O_YS = O_YP + (size_t)MP * D, O_GLAP = O_YS + (size_t)MS * D, O_POOLP = O_GLAP + (size_t)NB * NH * DK * DV,
                 O_CONVP = O_POOLP + (size_t)NB * 15 * POOLW, O_GLAS = O_CONVP + (size_t)NB * 2 * DFF, O_POOLS = O_GLAS + (size_t)MS * NH * DK * DV,
                 O_CONVS = O_POOLS + (size_t)MS * 15 * POOLW, O_END = O_CONVS + (size_t)MS * 2 * DFF;

constexpr size_t al(size_t x) { return (x + 255) & ~(size_t)255; }
constexpr size_t WS_CTL = 0, CTL_BYTES = 65536;
constexpr size_t WS_WUP = WS_CTL + CTL_BYTES;
constexpr size_t WS_WD = WS_WUP + al((size_t)NUP * D * 2);
constexpr size_t WS_WA = WS_WD + al((size_t)D * DFF * 2);
constexpr size_t WS_WO = WS_WA + al((size_t)D * D * 2);
constexpr size_t WS_WPG = WS_WO + al((size_t)D * D * 2);
constexpr size_t WS_WPB = WS_WPG + al((size_t)D * D * 2);
constexpr size_t WS_WPLE = WS_WPB + al((size_t)D * POOLW * 2);
constexpr size_t WS_SMALL = WS_WPLE + al((size_t)D * PLE * 2);
constexpr size_t WS_RSTD1 = WS_SMALL;
constexpr size_t WS_LAM = WS_RSTD1 + al((size_t)MPAD * 4);
constexpr size_t WS_OSS = WS_LAM + al((size_t)256 * KW * 4);
constexpr size_t WS_OSP = WS_OSS + al((size_t)MP * NH * NSL * 4);
constexpr size_t WS_SS1 = WS_OSP + al((size_t)MS * NH * 8 * DV * 4);
constexpr size_t WS_SS2 = WS_SS1 + al((size_t)MPAD * 32 * 4);
constexpr size_t WS_SS3 = WS_SS2 + al((size_t)MPAD * 32 * 4);
constexpr size_t WS_PLB = WS_SS3 + al((size_t)MPAD * 32 * 4);
constexpr size_t WS_R1 = WS_PLB + al((size_t)MPAD * PLE * 2);
constexpr size_t WS_XB = WS_R1;
constexpr size_t WS_WIN = WS_XB + al((size_t)MPAD * D * 2);
constexpr size_t WS_BCUM = WS_WIN + al((size_t)NIN * D * 2);
constexpr size_t WS_R1_END = WS_BCUM + al((size_t)MPAD * KW * 4);
constexpr size_t WS_ACT = WS_R1;
static_assert(WS_ACT + al((size_t)MPAD * DFF * 2) <= WS_R1_END, "R1 overlay");
constexpr size_t WS_R2 = WS_R1_END;
constexpr size_t WS_QB = WS_R2;
constexpr size_t WS_KB = WS_QB + al((size_t)MPAD * KW * 2);
constexpr size_t WS_KD = WS_KB + al((size_t)MPAD * KW * 2);
constexpr size_t WS_V = WS_KD + al((size_t)MPAD * KW * 2);
constexpr size_t WS_SR = WS_V + al((size_t)MPAD * VW * 2);
constexpr size_t WS_GA = WS_SR + al((size_t)MPAD * VW * 2);
constexpr size_t WS_GB = WS_GA + al((size_t)MPAD * D * 2);
constexpr size_t WS_U = WS_GB + al((size_t)MPAD * D * 2);
constexpr size_t WS_OG = WS_U + al((size_t)MPAD * POOLW * 4);
constexpr size_t WS_PM = WS_OG + al((size_t)MPAD * VW * 2);
constexpr size_t WS_YBG = WS_PM + al((size_t)MPAD * POOLW * 2);
constexpr size_t WS_R2_END = WS_YBG + al((size_t)MPAD * D * 4);
constexpr size_t WS_GU = WS_R2;
constexpr size_t WS_H2 = WS_GU + al((size_t)MPAD * NUP * 2);
constexpr size_t WS_PE = WS_H2 + al((size_t)MPAD * D * 4);
static_assert(WS_PE + al((size_t)MPAD * D * 4) <= WS_R2_END, "R2 overlay");
constexpr size_t WS_MB = WS_R2_END;
constexpr size_t WS_H1 = WS_MB + al((size_t)MPAD * D * 2);
constexpr size_t WS_H1B = WS_H1 + al((size_t)MPAD * D * 4);
constexpr size_t WS_END = WS_H1B + al((size_t)MPAD * D * 2);
constexpr size_t WS_H3 = WS_H1;
constexpr size_t WS_H2B = WS_MB;

DI unsigned pk2(float lo, float hi) {
    typedef __bf16 bf2 __attribute__((ext_vector_type(2)));
    f32x2 v = {lo, hi};
    bf2 b = __builtin_convertvector(v, bf2);
    return __builtin_bit_cast(unsigned, b);
}
DI float bflo(unsigned w) { return __uint_as_float(w << 16); }
DI float bfhi(unsigned w) { return __uint_as_float(w & 0xffff0000u); }
DI float bf1(bf16_t b) { return __uint_as_float(((unsigned)b) << 16); }
DI float fexp(float x) { return __expf(x); }
DI float sigmoidf_(float x) { return __builtin_amdgcn_rcpf(1.0f + __expf(-x)); }
DI float siluf_(float x) { return x * sigmoidf_(x); }
DI float logsigmoidf_(float z) { return fminf(z, 0.f) - __logf(1.0f + __expf(-fabsf(z))); }
DI float wave_sum(float v) {
#pragma unroll
    for (int o = 1; o < 64; o <<= 1) v += __shfl_xor(v, o);
    return v;
}
DI int lane_id() { int l; asm volatile("v_mbcnt_lo_u32_b32 %0, -1, 0\n\tv_mbcnt_hi_u32_b32 %0, -1, %0" : "=v"(l)); return l; }
#define LDS_WAIT() asm volatile("s_waitcnt lgkmcnt(0)" ::: "memory")
#define VM_WAIT() asm volatile("s_waitcnt vmcnt(0)" ::: "memory")

struct Params {
    const float *x_prompt, *x_sample, *state_gla, *state_pool, *state_conv, *p_prompt, *p_sample;
    const float *norm_mix, *w_in, *w_gate_up, *b_gate, *gla_norm, *w_branch_a, *w_pool, *pool_scale, *w_branch_b, *w_out, *norm_ffn, *w_up, *conv_w, *conv_b,
        *w_down, *norm_ple, *w_ple_gate, *w_ple, *norm_final;
    float* out; unsigned char* ws;
    int ph_lo, ph_hi;
};

constexpr int NWAVES = 8, NTHREADS = 512;
constexpr int LDS_BYTES = 147456;
constexpr int LDS_MISC = 131072;

namespace g8 {
constexpr int BM = 256, BK = 64, HALF = 128, HTB = HALF * BK * 2, STAGE_BYTES = 8 * HTB, NXCD = 8, WGM = 8;
DI int lds_byte(int r, int c) { const int st = (r >> 4) * 2 + (c >> 5), rr = r & 15, cc = c & 31, ob = rr * 64 + cc * 2; return st * 1024 + (ob ^ (((ob >> 9) & 1) << 5)); }
DI void stage_rc(int b, int& R, int& C) { const int st = b / 1024, sb = b % 1024, swz = sb ^ (((sb >> 9) & 1) << 5); R = (st >> 1) * 16 + swz / 64; C = (st & 1) * 32 + (swz % 64) / 2; }
DI int perm32(int rho) { const int n = rho >> 4, i = rho & 15; return 8 * (i >> 2) + 4 * n + (i & 3); }

struct Unit { const char* A; const char* B; int pm, pn; };

DI bool grid_order(int nM, int nN, int G, int c, int i, int& pm, int& pn) {
    const int nwg = nM * nN; const long L = (long)i * G + c; if (L >= nwg) return false;
    int wgid = (int)L; { const int q = nwg / NXCD, r = nwg % NXCD, xcd = wgid % NXCD, off = wgid / NXCD; wgid = (xcd < r ? xcd * (q + 1) : r * (q + 1) + (xcd - r) * q) + off; }
    const int nig = WGM * nN, gid = wgid / nig, fm = gid * WGM, gsz = (nM - fm) < WGM ? (nM - fm) : WGM;
    pm = fm + ((wgid % nig) % gsz); pn = (wgid % nig) / gsz; return true;
}

template <class P, bool ALIGN_EPI, bool SP2>
DI void run(LAS unsigned char* lds, const P& ph, int wid) {
    const int lane = lane_id(), tid = wid * 64 + lane, wr = wid >> 2, wc = wid & 3, fr = lane & 15, fq = lane >> 4;
    constexpr int nt = P::KT;
    unsigned voffA[2], voffB[2];
#pragma unroll
    for (int i = 0; i < 2; ++i) { int R, C; stage_rc(tid * 16 + i * 8192, R, C); const int Rb = (R & ~31) + perm32(R & 31);
        voffA[i] = (unsigned)(R * P::LDA + C) * 2u; voffB[i] = (unsigned)(Rb * P::LDB + C) * 2u; }
    constexpr size_t kstep = (size_t)(BK * 2);
    constexpr size_t hstepA = (size_t)HALF * P::LDA * 2, hstepB = (size_t)HALF * P::LDB * 2;
    const unsigned ldsw = (unsigned)wid * 1024u;
    const int aoff = lds_byte(wr * 64 + fr, fq * 8), boff = lds_byte(wc * 32 + fr, fq * 8);
#define G8_SA(b, h) (((b) * 2 + (h)) * HTB)
#define G8_SB(b, h) ((4 + (b) * 2 + (h)) * HTB)
#define G8_STAGE(bufoff, gbase, voff) do { _Pragma("unroll") for (int _i = 0; _i < 2; ++_i) \
        __builtin_amdgcn_global_load_lds((const unsigned*)((const char*)(gbase) + (voff)[_i]), (LAS unsigned*)(lds + (bufoff) + ldsw + _i * 8192), 16, 0, 0); } while (0)
#define G8_LDA(dst, b, h) do { _Pragma("unroll") for (int m = 0; m < 4; ++m) _Pragma("unroll") for (int k = 0; k < 2; ++k) dst[m][k] = *(const LAS bf16x8*)(lds + G8_SA(b, h) + aoff + m * 2048 + k * 1024); } while (0)
#define G8_LDB(dst, b, h) do { _Pragma("unroll") for (int n = 0; n < 2; ++n) _Pragma("unroll") for (int k = 0; k < 2; ++k) dst[n][k] = *(const LAS bf16x8*)(lds + G8_SB(b, h) + boff + n * 2048 + k * 1024); } while (0)
#define G8_MMA(ai, bj, At, Bt) do { __builtin_amdgcn_s_setprio(1); _Pragma("unroll") for (int m = 0; m < 4; ++m) _Pragma("unroll") for (int n = 0; n < 2; ++n) _Pragma("unroll") for (int k = 0; k < 2; ++k) \
        acc[ai][bj][m][n] = __builtin_amdgcn_mfma_f32_16x16x32_bf16(Bt[n][k], At[m][k], acc[ai][bj][m][n], 0, 0, 0); __builtin_amdgcn_s_setprio(0); } while (0)
#define G8_WAIT_V(n) asm volatile("s_waitcnt vmcnt(" #n ")" ::: "memory")
#define G8_WAIT_L(n) asm volatile("s_waitcnt lgkmcnt(" #n ")" ::: "memory")
#define G8_BAR __builtin_amdgcn_s_barrier()
#define G8_SCHED __builtin_amdgcn_sched_barrier(0)
    Unit cur, nxt; int ui = 0;
    if (!ph.next(0, cur)) return;
    f32x4 acc[2][2][4][2];
#pragma unroll
    for (int a = 0; a < 2; ++a)
#pragma unroll
        for (int b = 0; b < 2; ++b)
#pragma unroll
            for (int m = 0; m < 4; ++m)
#pragma unroll
                for (int n = 0; n < 2; ++n) acc[a][b][m][n] = (f32x4){0.f, 0.f, 0.f, 0.f};
    bf16x8 At[4][2], B0[2][2], B1[2][2];
    const char* cA = cur.A; const char* cB = cur.B;
    if constexpr (SP2) {
        G8_STAGE(G8_SB(0, 0), cB, voffB); G8_STAGE(G8_SB(0, 1), cB + hstepB, voffB); G8_STAGE(G8_SA(0, 0), cA, voffA); G8_STAGE(G8_SA(0, 1), cA + hstepA, voffA);
        if (wr == 1) G8_BAR;
        G8_WAIT_V(2); G8_BAR;
        G8_STAGE(G8_SB(1, 0), cB + kstep, voffB); G8_STAGE(G8_SA(1, 0), cA + kstep, voffA); G8_STAGE(G8_SB(1, 1), cB + hstepB + kstep, voffB);
        G8_WAIT_V(6); G8_BAR;
    } else {
        G8_STAGE(G8_SB(0, 0), cB, voffB); G8_STAGE(G8_SA(0, 0), cA, voffA); G8_STAGE(G8_SB(0, 1), cB + hstepB, voffB); G8_STAGE(G8_SA(0, 1), cA + hstepA, voffA);
        if (wr == 1) G8_BAR;
        G8_WAIT_V(4); G8_BAR;
        G8_STAGE(G8_SB(1, 0), cB + kstep, voffB); G8_STAGE(G8_SA(1, 0), cA + kstep, voffA); G8_STAGE(G8_SB(1, 1), cB + hstepB + kstep, voffB);
        G8_WAIT_V(6); G8_BAR;
    }
    for (;;) {
        const bool has_next = ph.next(ui + 1, nxt);
        const char* nA = has_next ? nxt.A : cA; const char* nB = has_next ? nxt.B : cB;
        for (int t = 0; t < nt; t += 2) {
            const bool last = (t == nt - 2);
            const char* a1 = cA + (size_t)(t + 1) * kstep;
            const char* a2 = last ? nA : cA + (size_t)(t + 2) * kstep; const char* b2 = last ? nB : cB + (size_t)(t + 2) * kstep;
            const char* a3 = a2 + kstep; const char* b3 = b2 + kstep;
            if constexpr (SP2) {
            G8_LDB(B0, 0, 0); G8_LDB(B1, 0, 1); G8_SCHED; G8_LDA(At, 0, 0); G8_STAGE(G8_SA(1, 1), a1 + hstepA, voffA);
            G8_WAIT_V(8); G8_WAIT_L(0); G8_BAR; G8_MMA(0, 0, At, B0); G8_MMA(0, 1, At, B1); G8_BAR; G8_SCHED;
            G8_LDA(At, 0, 1); G8_STAGE(G8_SB(0, 0), b2, voffB); G8_STAGE(G8_SB(0, 1), b2 + hstepB, voffB); G8_STAGE(G8_SA(0, 0), a2, voffA);
            G8_WAIT_V(8); G8_WAIT_L(0); G8_BAR; G8_MMA(1, 0, At, B0); G8_MMA(1, 1, At, B1); G8_BAR; G8_SCHED;
            G8_LDB(B0, 1, 0); G8_LDB(B1, 1, 1); G8_SCHED; G8_LDA(At, 1, 0); G8_STAGE(G8_SA(0, 1), a2 + hstepA, voffA);
            G8_WAIT_V(8); G8_WAIT_L(0); G8_BAR; G8_MMA(0, 0, At, B0); G8_MMA(0, 1, At, B1); G8_BAR; G8_SCHED;
            G8_LDA(At, 1, 1); G8_STAGE(G8_SB(1, 0), b3, voffB); G8_STAGE(G8_SB(1, 1), b3 + hstepB, voffB); G8_STAGE(G8_SA(1, 0), a3, voffA);
            G8_WAIT_V(8); G8_WAIT_L(0); G8_BAR; G8_MMA(1, 0, At, B0); G8_MMA(1, 1, At, B1); G8_BAR; G8_SCHED;
            } else {
            G8_LDB(B0, 0, 0); G8_SCHED; G8_LDA(At, 0, 0); G8_STAGE(G8_SA(1, 1), a1 + hstepA, voffA);
            G8_WAIT_L(8); G8_BAR; G8_WAIT_L(0); G8_MMA(0, 0, At, B0); G8_BAR; G8_SCHED;
            G8_LDB(B1, 0, 1); G8_STAGE(G8_SB(0, 0), b2, voffB);
            G8_BAR; G8_WAIT_L(0); G8_MMA(0, 1, At, B1); G8_BAR;
            G8_LDA(At, 0, 1); G8_STAGE(G8_SA(0, 0), a2, voffA);
            G8_BAR; G8_WAIT_L(0); G8_MMA(1, 0, At, B0); G8_BAR; G8_SCHED;
            G8_STAGE(G8_SB(0, 1), b2 + hstepB, voffB);
            G8_WAIT_V(6); G8_BAR; G8_MMA(1, 1, At, B1); G8_BAR;
            G8_LDB(B0, 1, 0); G8_SCHED; G8_LDA(At, 1, 0); G8_STAGE(G8_SA(0, 1), a2 + hstepA, voffA);
            G8_WAIT_L(8); G8_BAR; G8_WAIT_L(0); G8_MMA(0, 0, At, B0); G8_BAR; G8_SCHED;
            G8_LDB(B1, 1, 1); G8_STAGE(G8_SB(1, 0), b3, voffB);
            G8_BAR; G8_WAIT_L(0); G8_MMA(0, 1, At, B1); G8_BAR;
            G8_LDA(At, 1, 1); G8_STAGE(G8_SA(1, 0), a3, voffA);
            G8_BAR; G8_WAIT_L(0); G8_MMA(1, 0, At, B0); G8_BAR; G8_SCHED;
            G8_STAGE(G8_SB(1, 1), b3 + hstepB, voffB);
            G8_WAIT_V(6); G8_BAR; G8_MMA(1, 1, At, B1); G8_BAR;
            }
        }
        if constexpr (ALIGN_EPI) { if (wr == 0) G8_BAR; }
        ph.epi(acc, cur, wr, wc, fr, fq);
        if (!has_next) break;
#pragma unroll
        for (int a = 0; a < 2; ++a)
#pragma unroll
            for (int b = 0; b < 2; ++b)
#pragma unroll
                for (int m = 0; m < 4; ++m)
#pragma unroll
                    for (int n = 0; n < 2; ++n) acc[a][b][m][n] = (f32x4){0.f, 0.f, 0.f, 0.f};
        cur = nxt; cA = nA; cB = nB; ++ui;
        if constexpr (ALIGN_EPI) { if (wr == 1) G8_BAR; }
    }
    G8_WAIT_V(0);
    if constexpr (!ALIGN_EPI) { if (wr == 0) G8_BAR; }
    G8_BAR;
#undef G8_SA
#undef G8_SB
#undef G8_STAGE
#undef G8_LDA
#undef G8_LDB
#undef G8_MMA
#undef G8_WAIT_V
#undef G8_WAIT_L
#undef G8_BAR
#undef G8_SCHED
}
}

struct TJob { const float* src; bf16_t* dst; const float* gain; int K, Nsrc, Ndst, map, nitems; };

DI int map_col(int map, int n0) {
    if (map == 1) return n0 + (n0 >= 6144 ? 16 : 0);
    if (map == 2) { const int t = n0 >> 8, r = n0 & 255; return (r < 128) ? 128 * t + r : DFF + 128 * t + (r - 128); }
    return n0;
}
DI void p0_transpose_item(const TJob& J, LAS float* scr, int item, int lane) {
    const int nblk = J.Ndst / 32, kb = item / nblk, nb = item % nblk, k0 = 64 * kb, n0 = 32 * nb, ns0 = map_col(J.map, n0);
#pragma unroll 8
    for (int i = 0; i < 32; ++i) { const int kk = 2 * i + (lane >> 5); float w = J.src[(size_t)(k0 + kk) * J.Nsrc + ns0 + (lane & 31)]; if (J.gain) w *= J.gain[k0 + kk]; scr[kk * 33 + (lane & 31)] = w; }
    LDS_WAIT(); asm volatile("" ::: "memory");
    const int c = lane & 7;
#pragma unroll
    for (int j = 0; j < 4; ++j) { const int n = (lane >> 3) + 8 * j; const LAS float* s = scr + (8 * c) * 33 + n;
        u32x4 o; o.x = pk2(s[0 * 33], s[1 * 33]); o.y = pk2(s[2 * 33], s[3 * 33]); o.z = pk2(s[4 * 33], s[5 * 33]); o.w = pk2(s[6 * 33], s[7 * 33]);
        *(u32x4*)(J.dst + (size_t)(n0 + n) * J.K + k0 + 8 * c) = o; }
    LDS_WAIT(); asm volatile("" ::: "memory");
}
DI void p0_wpb_item(const Params& p, bf16_t* WpbT, int item, int lane) {
    const int nb = item & 31, cb = (item >> 5) & 31, g = item >> 10; const int n = nb * 64 + lane, c0 = cb * 8;
    float acc[8];
#pragma unroll
    for (int j = 0; j < 8; ++j) acc[j] = 0.f;
    const float* wp = p.w_pool + ((size_t)g * 256 + c0) * 256; const float* ps = p.pool_scale + g * 256; const float* wb = p.w_branch_b + (size_t)g * 256 * D + n;
#pragma unroll 4
    for (int d = 0; d < 256; ++d) { const float b = wb[(size_t)d * D] * ps[d];
#pragma unroll
        for (int j = 0; j < 8; ++j) acc[j] += wp[j * 256 + d] * b; }
    u32x4 o; o.x = pk2(acc[0], acc[1]); o.y = pk2(acc[2], acc[3]); o.z = pk2(acc[4], acc[5]); o.w = pk2(acc[6], acc[7]);
    *(u32x4*)(WpbT + (size_t)n * POOLW + g * 256 + c0) = o;
}
DI void p0_plb_item(const Params& p, bf16_t* PLB, int item, int lane) {
    const size_t e = (size_t)item * 512 + lane * 8; const size_t row = e / PLE;
    const float* src = (row < MP) ? p.p_prompt + e : p.p_sample + (e - (size_t)MP * PLE);
    const f32x4 a = *(const f32x4*)src, b = *(const f32x4*)(src + 4);
    u32x4 o; o.x = pk2(a.x, a.y); o.y = pk2(a.z, a.w); o.z = pk2(b.x, b.y); o.w = pk2(b.z, b.w);
    *(u32x4*)(PLB + e) = o;
}

DI void p0_xprep_unit(const Params& p, LAS unsigned char* lds, int u, int wave) {
    const int lane = lane_id(), tid = wave * 64 + lane;
    unsigned char* ws = p.ws;
    bf16_t* XB = (bf16_t*)(ws + WS_XB); float* RSTD1 = (float*)(ws + WS_RSTD1); float* BCUM = (float*)(ws + WS_BCUM); float* LAM = (float*)(ws + WS_LAM);
    LAS unsigned char* WG = lds; LAS float* GL = (LAS float*)(lds + 65536); LAS float* RS = (LAS float*)(lds + 73728);
    for (int pr = tid; pr < 4096; pr += NTHREADS) { const int k8 = pr >> 4, n = pr & 15; float w[8];
#pragma unroll
        for (int j = 0; j < 8; ++j) { const int k = 8 * k8 + j; w[j] = p.w_in[(size_t)k * INW + 6144 + n] * p.norm_mix[k]; }
        u32x4 o; o.x = pk2(w[0], w[1]); o.y = pk2(w[2], w[3]); o.z = pk2(w[4], w[5]); o.w = pk2(w[6], w[7]);
        *(LAS u32x4*)(WG + (size_t)pr * 16) = o; }
    __syncthreads();
    {
        const int fr = lane & 15, fq = lane >> 4; const int row = 128 * u + 16 * wave + fr;
        const float* xr = (row < MP) ? p.x_prompt + (size_t)row * D : p.x_sample + (size_t)(row - MP) * D;
        f32x4 acc = {0.f, 0.f, 0.f, 0.f}; float ss = 0.f;
#pragma unroll 8
        for (int s = 0; s < 64; ++s) {
            const f32x4 a = *(const f32x4*)(xr + 32 * s + 8 * fq), b = *(const f32x4*)(xr + 32 * s + 8 * fq + 4);
            ss += (a.x * a.x + a.y * a.y) + (a.z * a.z + a.w * a.w) + (b.x * b.x + b.y * b.y) + (b.z * b.z + b.w * b.w);
            u32x4 o; o.x = pk2(a.x, a.y); o.y = pk2(a.z, a.w); o.z = pk2(b.x, b.y); o.w = pk2(b.z, b.w);
            *(u32x4*)(XB + (size_t)row * D + 32 * s + 8 * fq) = o;
            const bf16x8 af = __builtin_bit_cast(bf16x8, o);
            const bf16x8 bfr = *(const LAS bf16x8*)(WG + (size_t)((4 * s + fq) * 16 + fr) * 16);
            acc = __builtin_amdgcn_mfma_f32_16x16x32_bf16(af, bfr, acc, 0, 0, 0);
        }
        ss += __shfl_xor(ss, 16); ss += __shfl_xor(ss, 32);
        const float rstd = 1.0f / sqrtf(ss * (1.0f / D) + EPS);
        if (fq == 0) { RS[16 * wave + fr] = rstd; RSTD1[row] = rstd; }
        LDS_WAIT(); asm volatile("" ::: "memory");
#pragma unroll
        for (int j = 0; j < 4; ++j) { const int tl = 16 * wave + 4 * fq + j; GL[tl * 16 + fr] = acc[j] * RS[tl]; }
    }
    __syncthreads();
    const bool sample = (u == 64);
#pragma unroll 1
    for (int cc = 0; cc < 2; ++cc) {
        const int c = tid + 512 * cc; float wg[16];
#pragma unroll
        for (int j = 0; j < 16; ++j) wg[j] = p.w_gate_up[j * KW + c];
        const float bg = p.b_gate[c]; float cum = 0.f;
#pragma unroll 2
        for (int t = 0; t < 128; ++t) {
            const f32x4 g0 = *(const LAS f32x4*)(GL + t * 16), g1 = *(const LAS f32x4*)(GL + t * 16 + 4), g2 = *(const LAS f32x4*)(GL + t * 16 + 8), g3 = *(const LAS f32x4*)(GL + t * 16 + 12);
            float z = bg;
            z += g0.x * wg[0] + g0.y * wg[1] + g0.z * wg[2] + g0.w * wg[3];
            z += g1.x * wg[4] + g1.y * wg[5] + g1.z * wg[6] + g1.w * wg[7];
            z += g2.x * wg[8] + g2.y * wg[9] + g2.z * wg[10] + g2.w * wg[11];
            z += g3.x * wg[12] + g3.y * wg[13] + g3.z * wg[14] + g3.w * wg[15];
            const float gl = logsigmoidf_(z) * (1.0f / 16.0f);
            const int row = 128 * u + t;
            if (sample) { BCUM[(size_t)row * KW + c] = 0.f; LAM[(size_t)(128 + t) * KW + c] = __expf(gl); }
            else { cum = ((t & 63) == 0) ? gl : cum + gl; BCUM[(size_t)row * KW + c] = cum; if ((t & 63) == 63) LAM[(size_t)(row >> 6) * KW + c] = __expf(cum); }
        }
    }
    __syncthreads();
}

constexpr int NXPREP = 65;
DI void phase_p0(const Params& p, LAS unsigned char* lds, int wave) {
    const int lane = lane_id();
    unsigned char* ws = p.ws;
    if ((int)blockIdx.x < NXPREP) { p0_xprep_unit(p, lds, blockIdx.x, wave); return; }
    TJob J[7];
    J[0] = TJob{p.w_in, (bf16_t*)(ws + WS_WIN), p.norm_mix, D, INW, NIN, 1, (D / 64) * (NIN / 32)};
    J[1] = TJob{p.w_up, (bf16_t*)(ws + WS_WUP), p.norm_ffn, D, NUP, NUP, 2, (D / 64) * (NUP / 32)};
    J[2] = TJob{p.w_down, (bf16_t*)(ws + WS_WD), nullptr, DFF, D, D, 0, (DFF / 64) * (D / 32)};
    J[3] = TJob{p.w_branch_a, (bf16_t*)(ws + WS_WA), p.gla_norm, D, D, D, 0, (D / 64) * (D / 32)};
    J[4] = TJob{p.w_out, (bf16_t*)(ws + WS_WO), nullptr, D, D, D, 0, (D / 64) * (D / 32)};
    J[5] = TJob{p.w_ple_gate, (bf16_t*)(ws + WS_WPG), p.norm_ple, D, D, D, 0, (D / 64) * (D / 32)};
    J[6] = TJob{p.w_ple, (bf16_t*)(ws + WS_WPLE), nullptr, PLE, D, D, 0, (PLE / 64) * (D / 32)};
    LAS float* scr = (LAS float*)(lds + wave * 8448);
    const int gw = ((int)blockIdx.x - NXPREP) * NWAVES + wave, NGW = ((int)gridDim.x - NXPREP) * NWAVES;
    int base = 0;
#pragma unroll
    for (int j = 0; j < 7; ++j) {
        const int n = J[j].nitems;
        int it = gw - (base % NGW); if (it < 0) it += NGW;
        for (; it < n; it += NGW) p0_transpose_item(J[j], scr, it, lane);
        base += n;
    }
    for (int it = gw; it < 4096; it += NGW) p0_wpb_item(p, (bf16_t*)(ws + WS_WPB), it, lane);
    for (int it = gw; it < (M * PLE) / 512; it += NGW) p0_plb_item(p, (bf16_t*)(ws + WS_PLB), it, lane);
}

#define MFMA32(a, b, c) __builtin_amdgcn_mfma_f32_32x32x16_bf16((a), (b), (c), 0, 0, 0)
typedef LAS s16x4* lds_s16x4_p;
DI s16x4 tr_read(LAS unsigned char* a) { return __builtin_amdgcn_ds_read_tr16_b64_v4i16((lds_s16x4_p)a); }
DI bf16x8 cat8(s16x4 lo, s16x4 hi) { return __builtin_shufflevector(lo, hi, 0, 1, 2, 3, 4, 5, 6, 7); }
DI bf16x8 ld_perm(const bf16_t* p) {
    const u32x2 a = *(const u32x2*)p, b = *(const u32x2*)(p + 8);
    u32x4 r; r.x = a.x; r.y = a.y; r.z = b.x; r.w = b.y; return __builtin_bit_cast(bf16x8, r);
}
template <int S> DI bf16x8 pack_step(const f32x16& x) {
    u32x4 r; r.x = pk2(x[8 * S + 0], x[8 * S + 1]); r.y = pk2(x[8 * S + 2], x[8 * S + 3]); r.z = pk2(x[8 * S + 4], x[8 * S + 5]); r.w = pk2(x[8 * S + 6], x[8 * S + 7]);
    return __builtin_bit_cast(bf16x8, r);
}
DI f32x16 zero16() { f32x16 z;
#pragma unroll
    for (int i = 0; i < 16; ++i) z[i] = 0.f; return z; }

constexpr int KDI_ROW = 576, KDI_BYTES = 64 * KDI_ROW;
DI void scan_task(const Params& p, LAS unsigned char* lds, int task) {
    unsigned char* ws = p.ws;
    const bf16_t* QB = (const bf16_t*)(ws + WS_QB); const bf16_t* KB = (const bf16_t*)(ws + WS_KB); const bf16_t* KD = (const bf16_t*)(ws + WS_KD);
    const bf16_t* V = (const bf16_t*)(ws + WS_V); const bf16_t* SR = (const bf16_t*)(ws + WS_SR); bf16_t* OG = (bf16_t*)(ws + WS_OG);
    const float* LAM = (const float*)(ws + WS_LAM); float* OSS = (float*)(ws + WS_OSS);
    const int sl = task & 15, hd = (task >> 4) & 3, b = task >> 6;
    LAS unsigned char* KDI = lds; LAS unsigned char* VI = lds + KDI_BYTES;
    f32x16 S[8];
#pragma unroll
    for (int db = 0; db < 8; ++db) S[db] = zero16();

#pragma unroll 1
    for (int ch = 0; ch < 32; ++ch) {
        int lane; asm volatile("v_mbcnt_lo_u32_b32 %0, -1, 0\n\tv_mbcnt_hi_u32_b32 %0, -1, %0" : "=v"(lane));
        const int c = lane & 31, h = lane >> 5;
        const int i16 = lane & 15, q = i16 >> 2, pp = i16 & 3, jb = (lane >> 4) & 1;
        const int row0 = b * SEQ + 64 * ch;
        {   const bf16_t* src = KD + (size_t)row0 * KW + hd * 256 + (lane >> 5) * KW + 8 * (lane & 31); LAS unsigned char* dst = KDI + (lane >> 5) * KDI_ROW + (lane & 31) * 16;
#pragma unroll 4
            for (int i = 0; i < 32; ++i) { const u32x4 w = *(const u32x4*)(src + (size_t)i * 2 * KW); *(LAS u32x4*)(dst + i * 2 * KDI_ROW) = w; }
            const bf16_t* vs = V + (size_t)row0 * VW + hd * 512 + 32 * sl + (lane >> 2) * VW + 8 * (lane & 3); LAS unsigned char* vd = VI + lane * 16;
#pragma unroll
            for (int i = 0; i < 4; ++i) { const u32x4 w = *(const u32x4*)(vs + (size_t)i * 16 * VW); *(LAS u32x4*)(vd + i * 1024) = w; }
        }
        LDS_WAIT(); asm volatile("" ::: "memory");

#pragma unroll
        for (int tb = 0; tb < 2; ++tb) {
            f32x16 o = zero16();
            const bf16_t* qrow = QB + (size_t)(row0 + 32 * tb) * KW + hd * 256 + c * KW + 4 * h;
            {
                f32x16 att0 = zero16(), att1 = zero16();
                const bf16_t* krow0 = KB + (size_t)row0 * KW + hd * 256 + c * KW + 4 * h;
#pragma unroll
                for (int st = 0; st < 16; ++st) {
                    const bf16x8 qf = ld_perm(qrow + 16 * st);
                    const bf16x8 k0 = ld_perm(krow0 + 16 * st);
                    att0 = MFMA32(k0, qf, att0);
                    if (tb == 1) { const bf16x8 k1 = ld_perm(krow0 + 32 * KW + 16 * st); att1 = MFMA32(k1, qf, att1); }
                    if (st & 1) __builtin_amdgcn_sched_barrier(0);
                }
                if (tb == 0) {
#pragma unroll
                    for (int r = 0; r < 16; ++r) { const int sloc = (r & 3) + 8 * (r >> 2) + 4 * h; att0[r] = (sloc <= c) ? att0[r] : 0.f; }
                } else {
#pragma unroll
                    for (int r = 0; r < 16; ++r) { const int sloc = (r & 3) + 8 * (r >> 2) + 4 * h; att1[r] = (sloc <= c) ? att1[r] : 0.f; }
                }
                LAS unsigned char* vb = VI + ((4 * h + q) * 4 + 2 * jb + (pp >> 1)) * 16 + (pp & 1) * 8;
                { const bf16x8 vf = cat8(tr_read(vb), tr_read(vb + 8 * 64)); o = MFMA32(vf, pack_step<0>(att0), o); }
                { const bf16x8 vf = cat8(tr_read(vb + 16 * 64), tr_read(vb + 24 * 64)); o = MFMA32(vf, pack_step<1>(att0), o); }
                if (tb == 1) {
                    { const bf16x8 vf = cat8(tr_read(vb + 32 * 64), tr_read(vb + 40 * 64)); o = MFMA32(vf, pack_step<0>(att1), o); }
                    { const bf16x8 vf = cat8(tr_read(vb + 48 * 64), tr_read(vb + 56 * 64)); o = MFMA32(vf, pack_step<1>(att1), o); }
                }
            }
            __builtin_amdgcn_sched_barrier(0);
#pragma unroll
            for (int db = 0; db < 8; ++db) {
                { const bf16x8 qf = ld_perm(qrow + 32 * db); o = MFMA32(pack_step<0>(S[db]), qf, o); }
                { const bf16x8 qf = ld_perm(qrow + 32 * db + 16); o = MFMA32(pack_step<1>(S[db]), qf, o); }
                __builtin_amdgcn_sched_barrier(0);
            }
            const int t = row0 + 32 * tb + c;
            float ss = 0.f;
#pragma unroll
            for (int r = 0; r < 16; ++r) ss += o[r] * o[r];
            { const auto sw = __builtin_amdgcn_permlane32_swap(__float_as_uint(ss), __float_as_uint(ss), false, false); ss = __uint_as_float(sw[0]) + __uint_as_float(sw[1]); }
            if (h == 0) OSS[(size_t)t * 64 + hd * 16 + sl] = ss;
            const size_t off = (size_t)(row0 + 32 * tb) * VW + hd * 512 + 32 * sl + c * VW + 4 * h;
#pragma unroll
            for (int g = 0; g < 4; ++g) {
                const u32x2 sr = *(const u32x2*)(SR + off + 8 * g);
                u32x2 w; w.x = pk2(o[4 * g + 0] * bflo(sr.x), o[4 * g + 1] * bfhi(sr.x)); w.y = pk2(o[4 * g + 2] * bflo(sr.y), o[4 * g + 3] * bfhi(sr.y));
                *(u32x2*)(OG + off + 8 * g) = w; }
            __builtin_amdgcn_sched_barrier(0);
        }

        {
            const float* lam = LAM + (size_t)(b * 32 + ch) * KW + hd * 256 + 4 * h;
            LAS unsigned char* vb = VI + ((8 * h + q) * 4 + 2 * jb + (pp >> 1)) * 16 + (pp & 1) * 8;
            LAS unsigned char* kb = KDI + (8 * h + q) * KDI_ROW + (16 * jb + 4 * pp) * 2;
#pragma unroll
            for (int db = 0; db < 8; ++db) {
#pragma unroll
                for (int g = 0; g < 4; ++g) { const f32x4 l4 = *(const f32x4*)(lam + 32 * db + 8 * g);
                    S[db][4 * g + 0] *= l4.x; S[db][4 * g + 1] *= l4.y; S[db][4 * g + 2] *= l4.z; S[db][4 * g + 3] *= l4.w; }
#pragma unroll
                for (int ks = 0; ks < 4; ++ks) {
                    const bf16x8 kf = cat8(tr_read(kb + (16 * ks) * KDI_ROW + 64 * db), tr_read(kb + (16 * ks + 4) * KDI_ROW + 64 * db));
                    const bf16x8 vf = cat8(tr_read(vb + (16 * ks) * 64), tr_read(vb + (16 * ks + 4) * 64));
                    S[db] = MFMA32(kf, vf, S[db]);
                }
                __builtin_amdgcn_sched_barrier(0);
            }
        }
        asm volatile("" ::: "memory");
    }
    {   int lane; asm volatile("v_mbcnt_lo_u32_b32 %0, -1, 0\n\tv_mbcnt_hi_u32_b32 %0, -1, %0" : "=v"(lane));
        const unsigned voff = (unsigned)(((lane >> 5) * 4 * DV + (lane & 31)) * 4);
        const char* gbase = (const char*)(p.out + O_GLAP + ((size_t)(b * NH + hd) * DK) * DV + 32 * sl);
#pragma unroll
        for (int db = 0; db < 8; ++db) {
#pragma unroll
            for (int r = 0; r < 16; ++r) { const int dl = 32 * db + (r & 3) + 8 * (r >> 2); *(float*)(const_cast<char*>(gbase) + (size_t)dl * DV * 4 + voff) = S[db][r]; }
        }
    }
}

DI void sgla_task(const Params& p, int task, int lane) {
    unsigned char* ws = p.ws;
    const bf16_t* QB = (const bf16_t*)(ws + WS_QB); const bf16_t* KB = (const bf16_t*)(ws + WS_KB); const bf16_t* V = (const bf16_t*)(ws + WS_V);
    const float* LAM = (const float*)(ws + WS_LAM); float* OSP = (float*)(ws + WS_OSP);
    const int dblk = task & 7, hd = (task >> 3) & 3, b = task >> 5; const int row = MP + b;
    const size_t sbase = ((size_t)(b * NH + hd) * DK + 32 * dblk) * DV;
    const float* S0 = p.state_gla + sbase; float* So = p.out + O_GLAS + sbase;
    const int dl = lane & 31;
    const float lam_l = LAM[(size_t)(128 + b) * KW + hd * 256 + 32 * dblk + dl];
    const float k_l = bf1(KB[(size_t)row * KW + hd * 256 + 32 * dblk + dl]);
    const float q_l = bf1(QB[(size_t)row * KW + hd * 256 + 32 * dblk + dl]);
    f32x4 va, vb;
    { const u32x2 w = *(const u32x2*)(V + (size_t)row * VW + hd * 512 + 4 * lane); va = (f32x4){bflo(w.x), bfhi(w.x), bflo(w.y), bfhi(w.y)}; }
    { const u32x2 w = *(const u32x2*)(V + (size_t)row * VW + hd * 512 + 256 + 4 * lane); vb = (f32x4){bflo(w.x), bfhi(w.x), bflo(w.y), bfhi(w.y)}; }
    f32x4 oa = {0.f, 0.f, 0.f, 0.f}, ob = {0.f, 0.f, 0.f, 0.f};
#pragma unroll 8
    for (int d = 0; d < 32; ++d) {
        const float lam = __uint_as_float(__builtin_amdgcn_readlane(__float_as_uint(lam_l), d)), kk = __uint_as_float(__builtin_amdgcn_readlane(__float_as_uint(k_l), d)), qq = __uint_as_float(__builtin_amdgcn_readlane(__float_as_uint(q_l), d));
        const f32x4 s0a = __builtin_nontemporal_load((const f32x4*)(S0 + (size_t)d * DV + 4 * lane)), s0b = __builtin_nontemporal_load((const f32x4*)(S0 + (size_t)d * DV + 256 + 4 * lane));
        const f32x4 sa = s0a * lam + va * kk, sb = s0b * lam + vb * kk;
        __builtin_nontemporal_store(sa, (f32x4*)(So + (size_t)d * DV + 4 * lane)); __builtin_nontemporal_store(sb, (f32x4*)(So + (size_t)d * DV + 256 + 4 * lane));
        oa += sa * qq; ob += sb * qq;
    }
    float* op = OSP + ((size_t)(b * NH + hd) * 8 + dblk) * DV;
    *(f32x4*)(op + 4 * lane) = oa; *(f32x4*)(op + 256 + 4 * lane) = ob;
}

DI void pmix_task(const Params& p, int t, int lane) {
    unsigned char* ws = p.ws;
    const float* U = (const float*)(ws + WS_U); bf16_t* PM = (bf16_t*)(ws + WS_PM);
    if (t < MP) {
        const int b = t >> 11, pos = t & 2047;
#pragma unroll
        for (int i = 0; i < 4; ++i) {
            const int w = 2 << i, c = 256 * i + 4 * lane; const int cnt = (pos + 1 < w) ? pos + 1 : w;
            const f32x4 u0 = *(const f32x4*)(U + (size_t)t * POOLW + c); f32x4 s = u0;
            for (int j = 1; j < cnt; ++j) s += *(const f32x4*)(U + (size_t)(t - j) * POOLW + c);
            const float inv = 1.0f / (float)cnt; const f32x4 mx = s * inv - u0;
            u32x2 o; o.x = pk2(mx.x, mx.y); o.y = pk2(mx.z, mx.w); *(u32x2*)(PM + (size_t)t * POOLW + c) = o;
            if (pos >= SEQ - 15) *(f32x4*)(p.out + O_POOLP + ((size_t)b * 15 + (pos - (SEQ - 15))) * POOLW + c) = u0;
        }
    } else {
        const int b = t - MP; const float* sp = p.state_pool + (size_t)b * 15 * POOLW; float* po = p.out + O_POOLS + (size_t)b * 15 * POOLW;
#pragma unroll
        for (int i = 0; i < 4; ++i) {
            const int w = 2 << i, c = 256 * i + 4 * lane;
            const f32x4 u0 = *(const f32x4*)(U + (size_t)t * POOLW + c); f32x4 s = u0;
            for (int j = 1; j < w; ++j) s += *(const f32x4*)(sp + (size_t)(15 - j) * POOLW + c);
            const float inv = 1.0f / (float)w; const f32x4 mx = s * inv - u0;
            u32x2 o; o.x = pk2(mx.x, mx.y); o.y = pk2(mx.z, mx.w); *(u32x2*)(PM + (size_t)t * POOLW + c) = o;
            for (int r = 0; r < 14; ++r) *(f32x4*)(po + (size_t)r * POOLW + c) = *(const f32x4*)(sp + (size_t)(r + 1) * POOLW + c);
            *(f32x4*)(po + (size_t)14 * POOLW + c) = u0;
        }
    }
}

DI void phase_p2(const Params& p, LAS unsigned char* lds, int wave) {
    const int G = gridDim.x;
    if (wave == 0) { for (int task = blockIdx.x; task < NB * NH * NSL; task += G) scan_task(p, lds, task); }
    else {
        const int lane = lane_id(); const int gw = (int)blockIdx.x * 7 + (wave - 1), NGW = G * 7;
        for (int t = gw; t < M; t += NGW) pmix_task(p, t, lane);
        for (int task = gw; task < MS * NH * 8; task += NGW) sgla_task(p, task, lane);
    }
}

DI void ogn_task(const Params& p, int t, int lane) {
    unsigned char* ws = p.ws;
    bf16_t* OG = (bf16_t*)(ws + WS_OG); const float* OSS = (const float*)(ws + WS_OSS); const float* OSP = (const float*)(ws + WS_OSP); const bf16_t* SR = (const bf16_t*)(ws + WS_SR);
    if (t < MP) {
#pragma unroll
        for (int hd = 0; hd < 4; ++hd) {
            const float* sp = OSS + (size_t)t * 64 + hd * 16; const f32x4 a = *(const f32x4*)sp, b = *(const f32x4*)(sp + 4), c = *(const f32x4*)(sp + 8), d = *(const f32x4*)(sp + 12);
            const float ss = ((a.x + a.y) + (a.z + a.w)) + ((b.x + b.y) + (b.z + b.w)) + ((c.x + c.y) + (c.z + c.w)) + ((d.x + d.y) + (d.z + d.w));
            const float rstd = 1.0f / sqrtf(ss * (1.0f / DV) + EPS);
            bf16_t* op = OG + (size_t)t * VW + hd * 512 + 8 * lane; const u32x4 w = *(const u32x4*)op;
            u32x4 o; o.x = pk2(bflo(w.x) * rstd, bfhi(w.x) * rstd); o.y = pk2(bflo(w.y) * rstd, bfhi(w.y) * rstd); o.z = pk2(bflo(w.z) * rstd, bfhi(w.z) * rstd); o.w = pk2(bflo(w.w) * rstd, bfhi(w.w) * rstd);
            *(u32x4*)op = o;
        }
    } else {
        const int b = t - MP;
#pragma unroll
        for (int hd = 0; hd < 4; ++hd) {
            f32x4 oa = {0.f, 0.f, 0.f, 0.f}, ob = {0.f, 0.f, 0.f, 0.f};
#pragma unroll
            for (int k = 0; k < 8; ++k) { const float* op = OSP + ((size_t)(b * NH + hd) * 8 + k) * DV + 8 * lane; oa += *(const f32x4*)op; ob += *(const f32x4*)(op + 4); }
            float ss = (oa.x * oa.x + oa.y * oa.y) + (oa.z * oa.z + oa.w * oa.w) + (ob.x * ob.x + ob.y * ob.y) + (ob.z * ob.z + ob.w * ob.w);
            ss = wave_sum(ss);
            const float rstd = 1.0f / sqrtf(ss * (1.0f / DV) + EPS);
            const u32x4 w = *(const u32x4*)(SR + (size_t)t * VW + hd * 512 + 8 * lane);
            u32x4 o; o.x = pk2(oa.x * rstd * bflo(w.x), oa.y * rstd * bfhi(w.x)); o.y = pk2(oa.z * rstd * bflo(w.y), oa.w * rstd * bfhi(w.y));
            o.z = pk2(ob.x * rstd * bflo(w.z), ob.y * rstd * bfhi(w.z)); o.w = pk2(ob.z * rstd * bflo(w.w), ob.w * rstd * bfhi(w.w));
            *(u32x4*)(OG + (size_t)t * VW + hd * 512 + 8 * lane) = o;
        }
    }
}
DI void phase_p3(const Params& p, int wave) {
    const int lane = lane_id();
    const int gw = (int)blockIdx.x * NWAVES + wave, NGW = gridDim.x * NWAVES;
    for (int t = gw; t < M; t += NGW) ogn_task(p, t, lane);
}

DI float row_rstd(const float* SS, int row, int lane) {
    float v = (lane < 32) ? SS[(size_t)row * 32 + lane] : 0.f;
    v = wave_sum(v);
    return 1.0f / sqrtf(v * (1.0f / D) + EPS);
}

struct F8 { f32x4 a, b; };
DI F8 unpack8(u32x4 w, float s) { F8 r; r.a = (f32x4){bflo(w.x) * s, bfhi(w.x) * s, bflo(w.y) * s, bfhi(w.y) * s}; r.b = (f32x4){bflo(w.z) * s, bfhi(w.z) * s, bflo(w.w) * s, bfhi(w.w) * s}; return r; }
DI F8 ld8(const float* q) { F8 r; r.a = *(const f32x4*)q; r.b = *(const f32x4*)(q + 4); return r; }
DI void st8(float* q, const F8& v) { *(f32x4*)q = v.a; *(f32x4*)(q + 4) = v.b; }
DI f32x4 silu4(f32x4 x) { return (f32x4){siluf_(x.x), siluf_(x.y), siluf_(x.z), siluf_(x.w)}; }
DI void conv_task(const Params& p, int t, int lane) {
    unsigned char* ws = p.ws;
    const bf16_t* GU = (const bf16_t*)(ws + WS_GU); const float* SS1 = (const float*)(ws + WS_SS1); bf16_t* ACT = (bf16_t*)(ws + WS_ACT);
    const bool prompt = t < MP; const int b = prompt ? (t >> 11) : (t - MP), pos = prompt ? (t & 2047) : 2;
    const float r0 = row_rstd(SS1, t, lane);
    const float r1 = (prompt && pos >= 1) ? row_rstd(SS1, t - 1, lane) : 0.f;
    const float r2 = (prompt && pos >= 2) ? row_rstd(SS1, t - 2, lane) : 0.f;
    const bf16_t* g0p = GU + (size_t)t * NUP; const bf16_t* g1p = GU + (size_t)((prompt && pos >= 1) ? t - 1 : t) * NUP; const bf16_t* g2p = GU + (size_t)((prompt && pos >= 2) ? t - 2 : t) * NUP;
    const float* sc = p.state_conv + (size_t)b * 2 * DFF;
    for (int v = lane; v < DFF / 8; v += 64) {
        const int ch0 = 8 * v, pn = ch0 >> 7, r = ch0 & 127, gcol = 256 * pn + r, ucol = gcol + 128;
        const F8 g0 = unpack8(*(const u32x4*)(g0p + gcol), r0), up = unpack8(*(const u32x4*)(g0p + ucol), r0);
        F8 g1, g2;
        if (prompt) { g1 = unpack8(*(const u32x4*)(g1p + gcol), r1); g2 = unpack8(*(const u32x4*)(g2p + gcol), r2); }
        else { g1 = ld8(sc + DFF + ch0); g2 = ld8(sc + ch0); }
        const F8 w0 = ld8(p.conv_w + ch0), w1 = ld8(p.conv_w + DFF + ch0), w2 = ld8(p.conv_w + 2 * DFF + ch0), cb = ld8(p.conv_b + ch0);
        const f32x4 ga = cb.a + w0.a * g2.a + w1.a * g1.a + w2.a * g0.a, gb = cb.b + w0.b * g2.b + w1.b * g1.b + w2.b * g0.b;
        const f32x4 aa = silu4(ga) * up.a, ab = silu4(gb) * up.b;
        u32x4 o; o.x = pk2(aa.x, aa.y); o.y = pk2(aa.z, aa.w); o.z = pk2(ab.x, ab.y); o.w = pk2(ab.z, ab.w);
        *(u32x4*)(ACT + (size_t)t * DFF + ch0) = o;
        if (prompt) { if (pos >= SEQ - 2) st8(p.out + O_CONVP + ((size_t)b * 2 + (pos - (SEQ - 2))) * DFF + ch0, g0); }
        else { float* co = p.out + O_CONVS + (size_t)b * 2 * DFF + ch0; st8(co, g1); st8(co + DFF, g0); }
    }
}
DI void phase_conv(const Params& p, int wave) {
    const int lane = lane_id();
    const int gw = (int)blockIdx.x * NWAVES + wave, NGW = gridDim.x * NWAVES;
    for (int t = gw; t < M; t += NGW) conv_task(p, t, lane);
}

DI void phase_final(const Params& p, int wave) {
    const int lane = lane_id();
    const int gw = (int)blockIdx.x * NWAVES + wave, NGW = gridDim.x * NWAVES;
    const float* H3 = (const float*)(p.ws + WS_H3); const float* SS3 = (const float*)(p.ws + WS_SS3);
    for (int t = gw; t < M; t += NGW) {
        const float rs = row_rstd(SS3, t, lane);
        float* yo = (t < MP) ? p.out + O_YP + (size_t)t * D : p.out + O_YS + (size_t)(t - MP) * D;
#pragma unroll
        for (int i = 0; i < 8; ++i) { const int c = 256 * i + 4 * lane; const f32x4 hv = *(const f32x4*)(H3 + (size_t)t * D + c), g = *(const f32x4*)(p.norm_final + c);
            *(f32x4*)(yo + c) = hv * rs * g; }
    }
}

#define EPI_ARGS const f32x4 (&acc)[2][2][4][2], const g8::Unit& u, int wr, int wc, int fr, int fq
#define EPI_ROWS(ROWVAR) _Pragma("unroll") for (int ai = 0; ai < 2; ++ai) _Pragma("unroll") for (int m = 0; m < 4; ++m) { const int ROWVAR = u.pm * 256 + ai * 128 + wr * 64 + m * 16 + fr; if (ROWVAR < M) {
#define EPI_COLS(COLVAR) _Pragma("unroll") for (int bj = 0; bj < 2; ++bj) { const int COLVAR = bj * 128 + wc * 32 + 8 * fq; const f32x4 v0 = acc[ai][bj][m][0], v1 = acc[ai][bj][m][1];
#define EPI_END } } }
DI u32x4 pk8(f32x4 a, f32x4 b) { u32x4 o; o.x = pk2(a.x, a.y); o.y = pk2(a.z, a.w); o.z = pk2(b.x, b.y); o.w = pk2(b.z, b.w); return o; }
DI f32x4 exp4(f32x4 x) { return (f32x4){__expf(x.x), __expf(x.y), __expf(x.z), __expf(x.w)}; }
DI f32x4 sig4(f32x4 x) { return (f32x4){sigmoidf_(x.x), sigmoidf_(x.y), sigmoidf_(x.z), sigmoidf_(x.w)}; }
DI f32x4 bf4lo(u32x4 w) { return (f32x4){bflo(w.x), bfhi(w.x), bflo(w.y), bfhi(w.y)}; }
DI f32x4 bf4hi(u32x4 w) { return (f32x4){bflo(w.z), bfhi(w.z), bflo(w.w), bfhi(w.w)}; }
DI float sum4(f32x4 a) { return (a.x + a.y) + (a.z + a.w); }

struct PhaseIn {
    static constexpr int LDA = D, LDB = D, KT = D / 64;
    const Params& p; int G, c;
    DI bool next(int i, g8::Unit& u) const { int pm, pn; if (!g8::grid_order(NTM, 44, G, c, i, pm, pn)) return false;
        u.pm = pm; u.pn = pn; u.A = (const char*)(p.ws + WS_XB) + (size_t)pm * 256 * D * 2; u.B = (const char*)(p.ws + WS_WIN) + (size_t)pn * 256 * D * 2; return true; }
    DI void epi(EPI_ARGS) const {
        unsigned char* ws = p.ws; const float* RSTD1 = (const float*)(ws + WS_RSTD1); const float* BCUM = (const float*)(ws + WS_BCUM);
        const int pn = u.pn;
        if (pn < 4) {
            bf16_t* QB = (bf16_t*)(ws + WS_QB);
            EPI_ROWS(row) const float rs = RSTD1[row] * 0.0625f; EPI_COLS(col) const size_t o = (size_t)row * KW + pn * 256 + col;
                const f32x4 e0 = exp4(*(const f32x4*)(BCUM + o)), e1 = exp4(*(const f32x4*)(BCUM + o + 4));
                *(u32x4*)(QB + o) = pk8(v0 * rs * e0, v1 * rs * e1); EPI_END
        } else if (pn < 8) {
            bf16_t* KB = (bf16_t*)(ws + WS_KB); bf16_t* KD = (bf16_t*)(ws + WS_KD);
            EPI_ROWS(row) const float rs = RSTD1[row]; const int lrow = (row < MP) ? (row | 63) : row; EPI_COLS(col) const size_t o = (size_t)row * KW + (pn - 4) * 256 + col, ol = (size_t)lrow * KW + (pn - 4) * 256 + col;
                const f32x4 b0 = *(const f32x4*)(BCUM + o), b1 = *(const f32x4*)(BCUM + o + 4), l0 = *(const f32x4*)(BCUM + ol), l1 = *(const f32x4*)(BCUM + ol + 4);
                const f32x4 k0 = v0 * rs, k1 = v1 * rs;
                *(u32x4*)(KB + o) = pk8(k0 * exp4(-b0), k1 * exp4(-b1)); *(u32x4*)(KD + o) = pk8(k0 * exp4(l0 - b0), k1 * exp4(l1 - b1)); EPI_END
        } else if (pn < 16) {
            bf16_t* V = (bf16_t*)(ws + WS_V);
            EPI_ROWS(row) const float rs = RSTD1[row]; EPI_COLS(col) *(u32x4*)(V + (size_t)row * VW + (pn - 8) * 256 + col) = pk8(v0 * rs, v1 * rs); EPI_END
        } else if (pn < 24) {
            bf16_t* SR = (bf16_t*)(ws + WS_SR);
            EPI_ROWS(row) const float rs = RSTD1[row]; EPI_COLS(col) const f32x4 a = v0 * rs, b = v1 * rs; *(u32x4*)(SR + (size_t)row * VW + (pn - 16) * 256 + col) = pk8(a * sig4(a), b * sig4(b)); EPI_END
        } else if (pn < 28) {
            float* U = (float*)(ws + WS_U);
            EPI_ROWS(row) const float rs = RSTD1[row]; EPI_COLS(col) float* o = U + (size_t)row * POOLW + (pn - 24) * 256 + col; *(f32x4*)o = v0 * rs; *(f32x4*)(o + 4) = v1 * rs; EPI_END
        } else {
            bf16_t* Gt = (bf16_t*)(ws + (pn < 36 ? WS_GA : WS_GB)); const int c0 = (pn < 36 ? pn - 28 : pn - 36) * 256;
            EPI_ROWS(row) const float rs = RSTD1[row]; EPI_COLS(col) *(u32x4*)(Gt + (size_t)row * D + c0 + col) = pk8(sig4(v0 * rs), sig4(v1 * rs)); EPI_END
        }
    }
};

template <int LDA_, int LDB_, int K_> struct PhaseN2048 {
    static constexpr int LDA = LDA_, LDB = LDB_, KT = K_ / 64;
    const Params& p; int G, c; size_t a_off, b_off;
    DI bool next_(int i, g8::Unit& u) const { int pm, pn; if (!g8::grid_order(NTM, 8, G, c, i, pm, pn)) return false;
        u.pm = pm; u.pn = pn; u.A = (const char*)(p.ws + a_off) + (size_t)pm * 256 * LDA * 2; u.B = (const char*)(p.ws + b_off) + (size_t)pn * 256 * LDB * 2; return true; }
};
struct PhaseYb : PhaseN2048<POOLW, POOLW, POOLW> {
    DI bool next(int i, g8::Unit& u) const { return next_(i, u); }
    DI void epi(EPI_ARGS) const { const bf16_t* GB = (const bf16_t*)(p.ws + WS_GB); float* Y = (float*)(p.ws + WS_YBG);
        EPI_ROWS(row) EPI_COLS(col) const size_t o = (size_t)row * D + u.pn * 256 + col; const u32x4 g = *(const u32x4*)(GB + o);
            *(f32x4*)(Y + o) = v0 * bf4lo(g); *(f32x4*)(Y + o + 4) = v1 * bf4hi(g); EPI_END }
};
struct PhaseYa : PhaseN2048<VW, VW, VW> {
    DI bool next(int i, g8::Unit& u) const { return next_(i, u); }
    DI void epi(EPI_ARGS) const { const bf16_t* GA = (const bf16_t*)(p.ws + WS_GA); const float* Y = (const float*)(p.ws + WS_YBG); bf16_t* MB = (bf16_t*)(p.ws + WS_MB);
        EPI_ROWS(row) EPI_COLS(col) const size_t o = (size_t)row * D + u.pn * 256 + col; const u32x4 g = *(const u32x4*)(GA + o);
            *(u32x4*)(MB + o) = pk8(v0 * bf4lo(g) + *(const f32x4*)(Y + o), v1 * bf4hi(g) + *(const f32x4*)(Y + o + 4)); EPI_END }
};
DI void epi_residual(EPI_ARGS, const float* base_p, const float* base_s, float* H, bf16_t* HB, float* SS) {
    EPI_ROWS(row) float ss = 0.f; const float* br = (base_s && row >= MP) ? base_s + (size_t)(row - MP) * D : base_p + (size_t)row * D;
        EPI_COLS(col) const int cg_ = u.pn * 256 + col; const size_t o = (size_t)row * D + cg_;
            const f32x4 h0 = v0 + *(const f32x4*)(br + cg_), h1 = v1 + *(const f32x4*)(br + cg_ + 4);
            *(f32x4*)(H + o) = h0; *(f32x4*)(H + o + 4) = h1; *(u32x4*)(HB + o) = pk8(h0, h1);
            ss += sum4(h0 * h0) + sum4(h1 * h1); }
        ss += __shfl_xor(ss, 16); ss += __shfl_xor(ss, 32);
        if (fq == 0) SS[(size_t)row * 32 + u.pn * 4 + wc] = ss; } }
}
struct PhaseOut : PhaseN2048<D, D, D> {
    DI bool next(int i, g8::Unit& u) const { return next_(i, u); }
    DI void epi(EPI_ARGS) const { epi_residual(acc, u, wr, wc, fr, fq, p.x_prompt, p.x_sample, (float*)(p.ws + WS_H1), (bf16_t*)(p.ws + WS_H1B), (float*)(p.ws + WS_SS1)); }
};
struct PhaseDown : PhaseN2048<DFF, DFF, DFF> {
    DI bool next(int i, g8::Unit& u) const { return next_(i, u); }
    DI void epi(EPI_ARGS) const { epi_residual(acc, u, wr, wc, fr, fq, (const float*)(p.ws + WS_H1), nullptr, (float*)(p.ws + WS_H2), (bf16_t*)(p.ws + WS_H2B), (float*)(p.ws + WS_SS2)); }
};
struct PhasePe : PhaseN2048<PLE, PLE, PLE> {
    DI bool next(int i, g8::Unit& u) const { return next_(i, u); }
    DI void epi(EPI_ARGS) const { float* PE = (float*)(p.ws + WS_PE);
        EPI_ROWS(row) EPI_COLS(col) const size_t o = (size_t)row * D + u.pn * 256 + col; *(f32x4*)(PE + o) = v0; *(f32x4*)(PE + o + 4) = v1; EPI_END }
};
struct PhasePg : PhaseN2048<D, D, D> {
    DI bool next(int i, g8::Unit& u) const { return next_(i, u); }
    DI void epi(EPI_ARGS) const { const float* H2 = (const float*)(p.ws + WS_H2); const float* PE = (const float*)(p.ws + WS_PE); const float* SS2 = (const float*)(p.ws + WS_SS2);
        float* H3 = (float*)(p.ws + WS_H3); float* SS3 = (float*)(p.ws + WS_SS3);
        EPI_ROWS(row) float s2 = 0.f;
#pragma unroll
            for (int k = 0; k < 8; ++k) s2 += sum4(*(const f32x4*)(SS2 + (size_t)row * 32 + 4 * k));
            const float rs = 1.0f / sqrtf(s2 * (1.0f / D) + EPS); float ss = 0.f;
            EPI_COLS(col) const size_t o = (size_t)row * D + u.pn * 256 + col;
                const f32x4 h0 = *(const f32x4*)(H2 + o) + sig4(v0 * rs) * *(const f32x4*)(PE + o), h1 = *(const f32x4*)(H2 + o + 4) + sig4(v1 * rs) * *(const f32x4*)(PE + o + 4);
                *(f32x4*)(H3 + o) = h0; *(f32x4*)(H3 + o + 4) = h1; ss += sum4(h0 * h0) + sum4(h1 * h1); }
            ss += __shfl_xor(ss, 16); ss += __shfl_xor(ss, 32);
            if (fq == 0) SS3[(size_t)row * 32 + u.pn * 4 + wc] = ss; } }
    }
};
struct PhaseUp {
    static constexpr int LDA = D, LDB = D, KT = D / 64;
    const Params& p; int G, c;
    DI bool next(int i, g8::Unit& u) const { int pm, pn; if (!g8::grid_order(NTM, 43, G, c, i, pm, pn)) return false;
        u.pm = pm; u.pn = pn; u.A = (const char*)(p.ws + WS_H1B) + (size_t)pm * 256 * D * 2; u.B = (const char*)(p.ws + WS_WUP) + (size_t)pn * 256 * D * 2; return true; }
    DI void epi(EPI_ARGS) const { bf16_t* GU = (bf16_t*)(p.ws + WS_GU);
        EPI_ROWS(row) EPI_COLS(col) *(u32x4*)(GU + (size_t)row * NUP + u.pn * 256 + col) = pk8(v0, v1); EPI_END }
};


#define XB_TMO      128
#define XB_XCNT(j)  (256  + 64 * (j))
#define XB_XSUB(j)  (1280 + 64 * (j))
#define XB_XGEN(j)  (2304 + 64 * (j))
#define XB_TOP      3328
#define XB_TOPGEN   3392
#define XCD_BAR_WORDS 3456
#define XB_SPIN_CAP (1u << 22)
DI unsigned xb_ld(unsigned* p)              { return __hip_atomic_load(p, __ATOMIC_RELAXED, __HIP_MEMORY_SCOPE_AGENT); }
DI unsigned xb_add(unsigned* p, unsigned v) { return __hip_atomic_fetch_add(p, v, __ATOMIC_RELAXED, __HIP_MEMORY_SCOPE_AGENT); }
DI unsigned xb_xcc_id() { return (unsigned)__builtin_amdgcn_s_getreg((3 << 11) | 20) & 0xFu; }
#define XB_SPIN(cond, bar) do { unsigned _sp = 0; while (cond) { __builtin_amdgcn_s_sleep(1); \
    if ((++_sp & 255u) == 0u) { if (xb_ld(&(bar)[XB_TMO])) break; if (_sp > XB_SPIN_CAP) { atomicAdd(&(bar)[XB_TMO], 1u); break; } } } } while (0)
struct XcdBarrier { unsigned* bar; unsigned x; volatile LAS unsigned* st; };
DI XcdBarrier xcd_barrier_post(unsigned* bar, volatile LAS unsigned* st, bool t0) {
    XcdBarrier b; b.bar = bar; b.x = xb_xcc_id(); b.st = st;
    if (t0) (void)xb_add(&bar[XB_XCNT(b.x)], 1u);
    return b;
}
DI void xcd_barrier_complete(unsigned* bar, unsigned x, unsigned& nloc, unsigned& nx) {
    const unsigned G = gridDim.x * gridDim.y * gridDim.z;
    unsigned sum, cnt, mine, sp = 0u;
    for (;;) {
        sum = 0u; cnt = 0u; mine = 0u;
#pragma unroll
        for (unsigned j = 0; j < 16; ++j) { const unsigned c = xb_ld(&bar[XB_XCNT(j)]); sum += c; cnt += (c > 0u) ? 1u : 0u; mine = (j == x) ? c : mine; }
        if (sum == G) break;
        __builtin_amdgcn_s_sleep(1);
        if ((++sp & 255u) == 0u) { if (xb_ld(&bar[XB_TMO])) break; if (sp > XB_SPIN_CAP) { atomicAdd(&bar[XB_TMO], 1u); break; } }
    }
    nloc = mine > 0u ? mine : 1u; nx = cnt > 0u ? cnt : 1u;
}
DI void xcd_barrier(const XcdBarrier& b, bool t0) {
    asm volatile("s_waitcnt vmcnt(0)" ::: "memory");
    __syncthreads();
    if (t0) {
        unsigned* bar = b.bar;
        __builtin_amdgcn_s_waitcnt(0);
        unsigned nloc = b.st[0], nx = b.st[1];
        if (nloc == 0u) { xcd_barrier_complete(bar, b.x, nloc, nx); b.st[0] = nloc; b.st[1] = nx; }
        const unsigned old = xb_add(&bar[XB_XSUB(b.x)], 1u);
        const unsigned gen = old / nloc;
        if (old + 1u == (gen + 1u) * nloc) {
            __builtin_amdgcn_fence(__ATOMIC_RELEASE, "agent");
            asm volatile("s_waitcnt vmcnt(0)" ::: "memory");
            const unsigned og = xb_add(&bar[XB_TOP], 1u);
            const unsigned tg = og / nx;
            if (og + 1u == (tg + 1u) * nx) xb_add(&bar[XB_TOPGEN], 1u);
            else XB_SPIN(xb_ld(&bar[XB_TOPGEN]) == tg, bar);
            __builtin_amdgcn_fence(__ATOMIC_ACQUIRE, "agent");
            xb_add(&bar[XB_XGEN(b.x)], 1u);
            asm volatile("s_waitcnt vmcnt(0)" ::: "memory");
        } else {
            XB_SPIN(xb_ld(&bar[XB_XGEN(b.x)]) == gen, bar);
            __builtin_amdgcn_fence(__ATOMIC_ACQUIRE, "agent");
            asm volatile("s_waitcnt vmcnt(0)" ::: "memory");
        }
    }
    __syncthreads();
}

constexpr int N_PHASES = 13;
#ifndef G8_SP2
#define G8_SP2 true
#endif
#ifndef G8_ALIGN
#define G8_ALIGN true
#endif

__global__ void __launch_bounds__(NTHREADS, 2) fwd_kernel(Params p) {
    extern __shared__ __attribute__((aligned(16))) unsigned char lds_raw[];
    LAS unsigned char* lds = (LAS unsigned char*)lds_raw;
    const int G = gridDim.x, c = blockIdx.x;
    const int wave = __builtin_amdgcn_readfirstlane(threadIdx.x >> 6);
    const int lo = p.ph_lo, hi = p.ph_hi;
#ifndef PHASE_MASK
#define PHASE_MASK 0x1fff
#endif
#define IN(k) (((PHASE_MASK >> (k)) & 1) && lo <= (k) && (k) < hi)
    volatile LAS unsigned* bst = (volatile LAS unsigned*)(lds + LDS_MISC);
    const bool t0 = (wave == 0) && (lane_id() == 0);
    XcdBarrier bar; bar.bar = (unsigned*)(p.ws + WS_CTL); bar.x = 0; bar.st = bst;
    if (hi - lo > 1) { if (t0) { bst[0] = 0u; bst[1] = 0u; } __syncthreads(); bar = xcd_barrier_post((unsigned*)(p.ws + WS_CTL), bst, t0); }
#define SEAM(k) do { if (IN(k) && IN((k) + 1)) { xcd_barrier(bar, (wave == 0) && (lane_id() == 0)); } } while (0)
    if (IN(0)) { phase_p0(p, lds, wave); } SEAM(0);
    if (IN(1)) { PhaseIn ph{p, G, c}; g8::run<PhaseIn, G8_ALIGN, G8_SP2>(lds, ph, wave); } SEAM(1);
    if (IN(2)) { phase_p2(p, lds, wave); } SEAM(2);
    if (IN(3)) { phase_p3(p, wave); } SEAM(3);
    if (IN(4)) { PhaseYb ph{{p, G, c, WS_PM, WS_WPB}}; g8::run<PhaseYb, G8_ALIGN, G8_SP2>(lds, ph, wave); } SEAM(4);
    if (IN(5)) { PhaseYa ph{{p, G, c, WS_OG, WS_WA}}; g8::run<PhaseYa, G8_ALIGN, G8_SP2>(lds, ph, wave); } SEAM(5);
    if (IN(6)) { PhaseOut ph{{p, G, c, WS_MB, WS_WO}}; g8::run<PhaseOut, G8_ALIGN, G8_SP2>(lds, ph, wave); } SEAM(6);
    if (IN(7)) { PhaseUp ph{p, G, c}; g8::run<PhaseUp, G8_ALIGN, G8_SP2>(lds, ph, wave); } SEAM(7);
    if (IN(8)) { phase_conv(p, wave); } SEAM(8);
    if (IN(9)) { PhaseDown ph{{p, G, c, WS_ACT, WS_WD}}; g8::run<PhaseDown, G8_ALIGN, G8_SP2>(lds, ph, wave); } SEAM(9);
    if (IN(10)) { PhasePe ph{{p, G, c, WS_PLB, WS_WPLE}}; g8::run<PhasePe, G8_ALIGN, G8_SP2>(lds, ph, wave); } SEAM(10);
    if (IN(11)) { PhasePg ph{{p, G, c, WS_H2B, WS_WPG}}; g8::run<PhasePg, G8_ALIGN, G8_SP2>(lds, ph, wave); } SEAM(11);
    if (IN(12)) { phase_final(p, wave); }
#undef IN
#undef SEAM
}

extern "C" void kernel_launch(void* const* d_in, const int* in_sizes, int n_in, void* d_out, int out_size, void* d_ws, size_t ws_size, hipStream_t stream) {
    static int grid = 0;
    if (grid == 0) {
        if (n_in != 26 || (size_t)out_size != O_END || ws_size < WS_END) {
            fprintf(stderr, "kernel_launch: unexpected problem: n_in %d out %d ws %zu (need %zu)\n", n_in, out_size, ws_size, (size_t)WS_END); grid = -1; return; }
        int dev = 0, cus = 0, per_cu = 0;
        if (hipGetDevice(&dev) != hipSuccess || hipDeviceGetAttribute(&cus, hipDeviceAttributeMultiprocessorCount, dev) != hipSuccess) { grid = -1; return; }
        if (hipFuncSetAttribute((const void*)fwd_kernel, hipFuncAttributeMaxDynamicSharedMemorySize, LDS_BYTES) != hipSuccess) { fprintf(stderr, "kernel_launch: hipFuncSetAttribute failed\n"); grid = -1; return; }
        if (hipOccupancyMaxActiveBlocksPerMultiprocessor(&per_cu, (const void*)fwd_kernel, NTHREADS, LDS_BYTES) != hipSuccess || per_cu < 1) {
            fprintf(stderr, "kernel_launch: occupancy query reports %d blocks per CU\n", per_cu); (void)hipGetLastError(); grid = -1; return; }
        grid = cus;
    }
    if (grid < 0) return;
    Params p{};
    const float** pp = (const float**)&p;
    for (int i = 0; i < 26; ++i) pp[i] = (const float*)d_in[i];
    p.out = (float*)d_out; p.ws = (unsigned char*)d_ws;
#if MK_N_LAUNCHES == 1
    p.ph_lo = 0; p.ph_hi = N_PHASES;
    void* args[] = {&p};
    if (hipMemsetAsync((char*)d_ws + WS_CTL, 0, XCD_BAR_WORDS * 4, stream) != hipSuccess) { fprintf(stderr, "kernel_launch: memset failed\n"); return; }
    hipError_t e = hipLaunchCooperativeKernel((const void*)fwd_kernel, dim3(grid), dim3(NTHREADS), args, LDS_BYTES, stream);
    if (e != hipSuccess) fprintf(stderr, "kernel_launch: cooperative launch failed: %s (grid %d)\n", hipGetErrorString(e), grid);
#else
    for (int k = 0; k < N_PHASES; ++k) { p.ph_lo = k; p.ph_hi = k + 1; hipLaunchKernelGGL(fwd_kernel, dim3(grid), dim3(NTHREADS), LDS_BYTES, stream, p); }
#endif
}
```

```cpp
#include <hip/hip_runtime.h>
#include <hip/hip_cooperative_groups.h>
#include <cstdio>
#include <cstdint>
namespace cg = cooperative_groups;

#ifndef MK_N_LAUNCHES
#define MK_N_LAUNCHES 1
#endif

#define LAS __attribute__((address_space(3)))
#define DI __device__ __forceinline__
typedef unsigned short bf16_t;
typedef short bf16x8 __attribute__((ext_vector_type(8)));
typedef short s16x4 __attribute__((ext_vector_type(4)));
typedef float f32x4 __attribute__((ext_vector_type(4)));
typedef float f32x2 __attribute__((ext_vector_type(2)));
typedef float f32x16 __attribute__((ext_vector_type(16)));
typedef unsigned u32x4 __attribute__((ext_vector_type(4)));
typedef unsigned u32x2 __attribute__((ext_vector_type(2)));

constexpr int D = 2048, MP = 8192, MS = 128, M = MP + MS, MPAD = 8448, NTM = 33;
constexpr int SEQ = 2048, NB = 4, NH = 4, DK = 256, DV = 512, KW = 1024, VW = 2048;
constexpr int DFF = 5504, NUP = 2 * DFF, PLE = 256, POOLW = 1024, INW = 11280, NIN = 11264;
constexpr float EPS = 1e-6f;
constexpr int NSL = 16;

constexpr size_t O_YP = 0, O_YS = O_YP + (size_t)MP * D, O_GLAP = O_YS + (size_t)MS * D, O_POOLP = O_GLAP + (size_t)NB * NH * DK * DV,
                 O_CONVP = O_POOLP + (size_t)NB * 15 * POOLW, O_GLAS = O_CONVP + (size_t)NB * 2 * DFF, O_POOLS = O_GLAS + (size_t)MS * NH * DK * DV,
                 O_CONVS = O_POOLS + (size_t)MS * 15 * POOLW, O_END = O_CONVS + (size_t)MS * 2 * DFF;

constexpr size_t al(size_t x) { return (x + 255) & ~(size_t)255; }
constexpr size_t WS_CTL = 0, CTL_BYTES = 65536;
constexpr size_t WS_WUP = WS_CTL + CTL_BYTES;
constexpr size_t WS_WD = WS_WUP + al((size_t)NUP * D * 2);
constexpr size_t WS_WA = WS_WD + al((size_t)D * DFF * 2);
constexpr size_t WS_WO = WS_WA + al((size_t)D * D * 2);
constexpr size_t WS_WPG = WS_WO + al((size_t)D * D * 2);
constexpr size_t WS_WPB = WS_WPG + al((size_t)D * D * 2);
constexpr size_t WS_WPLE = WS_WPB + al((size_t)D * POOLW * 2);
constexpr size_t WS_SMALL = WS_WPLE + al((size_t)D * PLE * 2);
constexpr size_t WS_RSTD1 = WS_SMALL;
constexpr size_t WS_LAM = WS_RSTD1 + al((size_t)MPAD * 4);
constexpr size_t WS_OSS = WS_LAM + al((size_t)256 * KW * 4);
constexpr size_t WS_OSP = WS_OSS + al((size_t)MP * NH * NSL * 4);
constexpr size_t WS_SS1 = WS_OSP + al((size_t)MS * NH * 8 * DV * 4);
constexpr size_t WS_SS2 = WS_SS1 + al((size_t)MPAD * 32 * 4);
constexpr size_t WS_SS3 = WS_SS2 + al((size_t)MPAD * 32 * 4);
constexpr size_t WS_PLB = WS_SS3 + al((size_t)MPAD * 32 * 4);
constexpr size_t WS_R1 = WS_PLB + al((size_t)MPAD * PLE * 2);
constexpr size_t WS_XB = WS_R1;
constexpr size_t WS_WIN = WS_XB + al((size_t)MPAD * D * 2);
constexpr size_t WS_BCUM = WS_WIN + al((size_t)NIN * D * 2);
constexpr size_t WS_R1_END = WS_BCUM + al((size_t)MPAD * KW * 4);
constexpr size_t WS_ACT = WS_R1;
static_assert(WS_ACT + al((size_t)MPAD * DFF * 2) <= WS_R1_END, "R1 overlay");
constexpr size_t WS_R2 = WS_R1_END;
constexpr size_t WS_QB = WS_R2;
constexpr size_t WS_KB = WS_QB + al((size_t)MPAD * KW * 2);
constexpr size_t WS_KD = WS_KB + al((size_t)MPAD * KW * 2);
constexpr size_t WS_V = WS_KD + al((size_t)MPAD * KW * 2);
constexpr size_t WS_SR = WS_V + al((size_t)MPAD * VW * 2);
constexpr size_t WS_GA = WS_SR + al((size_t)MPAD * VW * 2);
constexpr size_t WS_GB = WS_GA + al((size_t)MPAD * D * 2);
constexpr size_t WS_U = WS_GB + al((size_t)MPAD * D * 2);
constexpr size_t WS_OG = WS_U + al((size_t)MPAD * POOLW * 4);
constexpr size_t WS_PM = WS_OG + al((size_t)MPAD * VW * 2);
constexpr size_t WS_YBG = WS_PM + al((size_t)MPAD * POOLW * 2);
constexpr size_t WS_R2_END = WS_YBG + al((size_t)MPAD * D * 4);
constexpr size_t WS_GU = WS_R2;
constexpr size_t WS_H2 = WS_GU + al((size_t)MPAD * NUP * 2);
constexpr size_t WS_PE = WS_H2 + al((size_t)MPAD * D * 4);
static_assert(WS_PE + al((size_t)MPAD * D * 4) <= WS_R2_END, "R2 overlay");
constexpr size_t WS_MB = WS_R2_END;
constexpr size_t WS_H1 = WS_MB + al((size_t)MPAD * D * 2);
constexpr size_t WS_H1B = WS_H1 + al((size_t)MPAD * D * 4);
constexpr size_t WS_END = WS_H1B + al((size_t)MPAD * D * 2);
constexpr size_t WS_H3 = WS_H1;
constexpr size_t WS_H2B = WS_MB;

DI unsigned pk2(float lo, float hi) {
    typedef __bf16 bf2 __attribute__((ext_vector_type(2)));
    f32x2 v = {lo, hi};
    bf2 b = __builtin_convertvector(v, bf2);
    return __builtin_bit_cast(unsigned, b);
}
DI float bflo(unsigned w) { return __uint_as_float(w << 16); }
DI float bfhi(unsigned w) { return __uint_as_float(w & 0xffff0000u); }
DI float bf1(bf16_t b) { return __uint_as_float(((unsigned)b) << 16); }
DI float fexp(float x) { return __expf(x); }
DI float sigmoidf_(float x) { return __builtin_amdgcn_rcpf(1.0f + __expf(-x)); }
DI float siluf_(float x) { return x * sigmoidf_(x); }
DI float logsigmoidf_(float z) { return fminf(z, 0.f) - __logf(1.0f + __expf(-fabsf(z))); }
DI float wave_sum(float v) {
#pragma unroll
    for (int o = 1; o < 64; o <<= 1) v += __shfl_xor(v, o);
    return v;
}
DI int lane_id() { int l; asm volatile("v_mbcnt_lo_u32_b32 %0, -1, 0\n\tv_mbcnt_hi_u32_b32 %0, -1, %0" : "=v"(l)); return l; }
#define LDS_WAIT() asm volatile("s_waitcnt lgkmcnt(0)" ::: "memory")
#define VM_WAIT() asm volatile("s_waitcnt vmcnt(0)" ::: "memory")

struct Params {
    const float *x_prompt, *x_sample, *state_gla, *state_pool, *state_conv, *p_prompt, *p_sample;
    const float *norm_mix, *w_in, *w_gate_up, *b_gate, *gla_norm, *w_branch_a, *w_pool, *pool_scale, *w_branch_b, *w_out, *norm_ffn, *w_up, *conv_w, *conv_b,
        *w_down, *norm_ple, *w_ple_gate, *w_ple, *norm_final;
    float* out; unsigned char* ws;
    int ph_lo, ph_hi;
};

constexpr int NWAVES = 8, NTHREADS = 512;
constexpr int LDS_BYTES = 147456;
constexpr int LDS_MISC = LDS_BYTES - 256;

namespace g8 {
constexpr int BM = 256, BK = 64, HALF = 128, HTB = HALF * BK * 2, STAGE_BYTES = 8 * HTB, NXCD = 8, WGM = 8;
DI int lds_byte(int r, int c) { const int st = (r >> 4) * 2 + (c >> 5), rr = r & 15, cc = c & 31, ob = rr * 64 + cc * 2; return st * 1024 + (ob ^ (((ob >> 9) & 1) << 5)); }
DI void stage_rc(int b, int& R, int& C) { const int st = b / 1024, sb = b % 1024, swz = sb ^ (((sb >> 9) & 1) << 5); R = (st >> 1) * 16 + swz / 64; C = (st & 1) * 32 + (swz % 64) / 2; }
DI int perm32(int rho) { const int n = rho >> 4, i = rho & 15; return 8 * (i >> 2) + 4 * n + (i & 3); }

struct Unit { const char* A; const char* B; int pm, pn; };

DI bool grid_order(int nM, int nN, int G, int c, int i, int& pm, int& pn) {
    const int nwg = nM * nN; const long L = (long)i * G + c; if (L >= nwg) return false;
    int wgid = (int)L; { const int q = nwg / NXCD, r = nwg % NXCD, xcd = wgid % NXCD, off = wgid / NXCD; wgid = (xcd < r ? xcd * (q + 1) : r * (q + 1) + (xcd - r) * q) + off; }
    const int nig = WGM * nN, gid = wgid / nig, fm = gid * WGM, gsz = (nM - fm) < WGM ? (nM - fm) : WGM;
    pm = fm + ((wgid % nig) % gsz); pn = (wgid % nig) / gsz; return true;
}

template <class P, bool ALIGN_EPI, bool SP2>
DI void run(LAS unsigned char* lds, const P& ph, int wid) {
    const int lane = lane_id(), tid = wid * 64 + lane, wr = wid >> 2, wc = wid & 3, fr = lane & 15, fq = lane >> 4;
    constexpr int nt = P::KT;
    unsigned voffA[2], voffB[2];
#pragma unroll
    for (int i = 0; i < 2; ++i) { int R, C; stage_rc(tid * 16 + i * 8192, R, C); const int Rb = (R & ~31) + perm32(R & 31);
        voffA[i] = (unsigned)(R * P::LDA + C) * 2u; voffB[i] = (unsigned)(Rb * P::LDB + C) * 2u; }
    constexpr size_t kstep = (size_t)(BK * 2);
    constexpr size_t hstepA = (size_t)HALF * P::LDA * 2, hstepB = (size_t)HALF * P::LDB * 2;
    const unsigned ldsw = (unsigned)wid * 1024u;
    const int aoff = lds_byte(wr * 64 + fr, fq * 8), boff = lds_byte(wc * 32 + fr, fq * 8);
#define G8_SA(b, h) (((b) * 2 + (h)) * HTB)
#define G8_SB(b, h) ((4 + (b) * 2 + (h)) * HTB)
#define G8_STAGE(bufoff, gbase, voff) do { _Pragma("unroll") for (int _i = 0; _i < 2; ++_i) \
        __builtin_amdgcn_global_load_lds((const unsigned*)((const char*)(gbase) + (voff)[_i]), (LAS unsigned*)(lds + (bufoff) + ldsw + _i * 8192), 16, 0, 0); } while (0)
#define G8_LDA(dst, b, h) do { _Pragma("unroll") for (int m = 0; m < 4; ++m) _Pragma("unroll") for (int k = 0; k < 2; ++k) dst[m][k] = *(const LAS bf16x8*)(lds + G8_SA(b, h) + aoff + m * 2048 + k * 1024); } while (0)
#define G8_LDB(dst, b, h) do { _Pragma("unroll") for (int n = 0; n < 2; ++n) _Pragma("unroll") for (int k = 0; k < 2; ++k) dst[n][k] = *(const LAS bf16x8*)(lds + G8_SB(b, h) + boff + n * 2048 + k * 1024); } while (0)
#define G8_MMA(ai, bj, At, Bt) do { __builtin_amdgcn_s_setprio(1); _Pragma("unroll") for (int m = 0; m < 4; ++m) _Pragma("unroll") for (int n = 0; n < 2; ++n) _Pragma("unroll") for (int k = 0; k < 2; ++k) \
        acc[ai][bj][m][n] = __builtin_amdgcn_mfma_f32_16x16x32_bf16(Bt[n][k], At[m][k], acc[ai][bj][m][n], 0, 0, 0); __builtin_amdgcn_s_setprio(0); } while (0)
#define G8_WAIT_V(n) asm volatile("s_waitcnt vmcnt(" #n ")" ::: "memory")
#define G8_WAIT_L(n) asm volatile("s_waitcnt lgkmcnt(" #n ")" ::: "memory")
#define G8_BAR __builtin_amdgcn_s_barrier()
#define G8_SCHED __builtin_amdgcn_sched_barrier(0)
    Unit cur, nxt; int ui = 0;
    if (!ph.next(0, cur)) return;
    f32x4 acc[2][2][4][2];
#pragma unroll
    for (int a = 0; a < 2; ++a)
#pragma unroll
        for (int b = 0; b < 2; ++b)
#pragma unroll
            for (int m = 0; m < 4; ++m)
#pragma unroll
                for (int n = 0; n < 2; ++n) acc[a][b][m][n] = (f32x4){0.f, 0.f, 0.f, 0.f};
    bf16x8 At[4][2], B0[2][2], B1[2][2];
    const char* cA = cur.A; const char* cB = cur.B;
    if constexpr (SP2) {
        G8_STAGE(G8_SB(0, 0), cB, voffB); G8_STAGE(G8_SB(0, 1), cB + hstepB, voffB); G8_STAGE(G8_SA(0, 0), cA, voffA); G8_STAGE(G8_SA(0, 1), cA + hstepA, voffA);
        if (wr == 1) G8_BAR;
        G8_WAIT_V(2); G8_BAR;
        G8_STAGE(G8_SB(1, 0), cB + kstep, voffB); G8_STAGE(G8_SA(1, 0), cA + kstep, voffA); G8_STAGE(G8_SB(1, 1), cB + hstepB + kstep, voffB);
        G8_WAIT_V(6); G8_BAR;
    } else {
        G8_STAGE(G8_SB(0, 0), cB, voffB); G8_STAGE(G8_SA(0, 0), cA, voffA); G8_STAGE(G8_SB(0, 1), cB + hstepB, voffB); G8_STAGE(G8_SA(0, 1), cA + hstepA, voffA);
        if (wr == 1) G8_BAR;
        G8_WAIT_V(4); G8_BAR;
        G8_STAGE(G8_SB(1, 0), cB + kstep, voffB); G8_STAGE(G8_SA(1, 0), cA + kstep, voffA); G8_STAGE(G8_SB(1, 1), cB + hstepB + kstep, voffB);
        G8_WAIT_V(6); G8_BAR;
    }
    for (;;) {
        const bool has_next = ph.next(ui + 1, nxt);
        const char* nA = has_next ? nxt.A : cA; const char* nB = has_next ? nxt.B : cB;
        for (int t = 0; t < nt; t += 2) {
            const bool last = (t == nt - 2);
            const char* a1 = cA + (size_t)(t + 1) * kstep;
            const char* a2 = last ? nA : cA + (size_t)(t + 2) * kstep; const char* b2 = last ? nB : cB + (size_t)(t + 2) * kstep;
            const char* a3 = a2 + kstep; const char* b3 = b2 + kstep;
            if constexpr (SP2) {
            G8_LDB(B0, 0, 0); G8_LDB(B1, 0, 1); G8_SCHED; G8_LDA(At, 0, 0); G8_STAGE(G8_SA(1, 1), a1 + hstepA, voffA);
            G8_WAIT_V(8); G8_WAIT_L(0); G8_BAR; G8_MMA(0, 0, At, B0); G8_MMA(0, 1, At, B1); G8_BAR; G8_SCHED;
            G8_LDA(At, 0, 1); G8_STAGE(G8_SB(0, 0), b2, voffB); G8_STAGE(G8_SB(0, 1), b2 + hstepB, voffB); G8_STAGE(G8_SA(0, 0), a2, voffA);
            G8_WAIT_V(8); G8_WAIT_L(0); G8_BAR; G8_MMA(1, 0, At, B0); G8_MMA(1, 1, At, B1); G8_BAR; G8_SCHED;
            G8_LDB(B0, 1, 0); G8_LDB(B1, 1, 1); G8_SCHED; G8_LDA(At, 1, 0); G8_STAGE(G8_SA(0, 1), a2 + hstepA, voffA);
            G8_WAIT_V(8); G8_WAIT_L(0); G8_BAR; G8_MMA(0, 0, At, B0); G8_MMA(0, 1, At, B1); G8_BAR; G8_SCHED;
            G8_LDA(At, 1, 1); G8_STAGE(G8_SB(1, 0), b3, voffB); G8_STAGE(G8_SB(1, 1), b3 + hstepB, voffB); G8_STAGE(G8_SA(1, 0), a3, voffA);
            G8_WAIT_V(8); G8_WAIT_L(0); G8_BAR; G8_MMA(1, 0, At, B0); G8_MMA(1, 1, At, B1); G8_BAR; G8_SCHED;
            } else {
            G8_LDB(B0, 0, 0); G8_SCHED; G8_LDA(At, 0, 0); G8_STAGE(G8_SA(1, 1), a1 + hstepA, voffA);
            G8_WAIT_L(8); G8_BAR; G8_WAIT_L(0); G8_MMA(0, 0, At, B0); G8_BAR; G8_SCHED;
            G8_LDB(B1, 0, 1); G8_STAGE(G8_SB(0, 0), b2, voffB);
            G8_BAR; G8_WAIT_L(0); G8_MMA(0, 1, At, B1); G8_BAR;
            G8_LDA(At, 0, 1); G8_STAGE(G8_SA(0, 0), a2, voffA);
            G8_BAR; G8_WAIT_L(0); G8_MMA(1, 0, At, B0); G8_BAR; G8_SCHED;
            G8_STAGE(G8_SB(0, 1), b2 + hstepB, voffB);
            G8_WAIT_V(6); G8_BAR; G8_MMA(1, 1, At, B1); G8_BAR;
            G8_LDB(B0, 1, 0); G8_SCHED; G8_LDA(At, 1, 0); G8_STAGE(G8_SA(0, 1), a2 + hstepA, voffA);
            G8_WAIT_L(8); G8_BAR; G8_WAIT_L(0); G8_MMA(0, 0, At, B0); G8_BAR; G8_SCHED;
            G8_LDB(B1, 1, 1); G8_STAGE(G8_SB(1, 0), b3, voffB);
            G8_BAR; G8_WAIT_L(0); G8_MMA(0, 1, At, B1); G8_BAR;
            G8_LDA(At, 1, 1); G8_STAGE(G8_SA(1, 0), a3, voffA);
            G8_BAR; G8_WAIT_L(0); G8_MMA(1, 0, At, B0); G8_BAR; G8_SCHED;
            G8_STAGE(G8_SB(1, 1), b3 + hstepB, voffB);
            G8_WAIT_V(6); G8_BAR; G8_MMA(1, 1, At, B1); G8_BAR;
            }
        }
        if constexpr (ALIGN_EPI) { if (wr == 0) G8_BAR; }
        ph.epi(acc, cur, wr, wc, fr, fq);
        if (!has_next) break;
#pragma unroll
        for (int a = 0; a < 2; ++a)
#pragma unroll
            for (int b = 0; b < 2; ++b)
#pragma unroll
                for (int m = 0; m < 4; ++m)
#pragma unroll
                    for (int n = 0; n < 2; ++n) acc[a][b][m][n] = (f32x4){0.f, 0.f, 0.f, 0.f};
        cur = nxt; cA = nA; cB = nB; ++ui;
        if constexpr (ALIGN_EPI) { if (wr == 1) G8_BAR; }
    }
    G8_WAIT_V(0);
    if constexpr (!ALIGN_EPI) { if (wr == 0) G8_BAR; }
    G8_BAR;
#undef G8_SA
#undef G8_SB
#undef G8_STAGE
#undef G8_LDA
#undef G8_LDB
#undef G8_MMA
#undef G8_WAIT_V
#undef G8_WAIT_L
#undef G8_BAR
#undef G8_SCHED
}
}

struct TJob { const float* src; bf16_t* dst; const float* gain; int K, Nsrc, Ndst, map, nitems; };

DI int map_col(int map, int n0) {
    if (map == 1) return n0 + (n0 >= 6144 ? 16 : 0);
    if (map == 2) { const int t = n0 >> 8, r = n0 & 255; return (r < 128) ? 128 * t + r : DFF + 128 * t + (r - 128); }
    return n0;
}
constexpr int TR_SCR = 64 * 65 * 4;
static_assert(8 * TR_SCR <= LDS_MISC, "transpose scratch must stay below the barrier words");
DI void p0_transpose_item(const TJob& J, LAS float* scr, int item, int lane) {
    const int nblk = J.Ndst / 64, kb = item / nblk, nb = item % nblk, k0 = 64 * kb, n0 = 64 * nb, ns0 = map_col(J.map, n0);
    const float* src = J.src + (size_t)(k0 + (lane >> 4)) * J.Nsrc + ns0 + 4 * (lane & 15);
    f32x4 v[16];
#pragma unroll
    for (int i = 0; i < 16; ++i) v[i] = *(const f32x4*)(src + (size_t)(4 * i) * J.Nsrc);
    if (J.gain) {
#pragma unroll
        for (int i = 0; i < 16; ++i) v[i] *= J.gain[k0 + 4 * i + (lane >> 4)];
    }
#pragma unroll
    for (int i = 0; i < 16; ++i) { LAS float* d = scr + (4 * i + (lane >> 4)) * 65 + 4 * (lane & 15); d[0] = v[i].x; d[1] = v[i].y; d[2] = v[i].z; d[3] = v[i].w; }
    LDS_WAIT(); asm volatile("" ::: "memory");
    const int c = lane & 7;
#pragma unroll
    for (int j = 0; j < 8; ++j) { const int n = (lane >> 3) + 8 * j; const LAS float* s = scr + (8 * c) * 65 + n;
        u32x4 o; o.x = pk2(s[0 * 65], s[1 * 65]); o.y = pk2(s[2 * 65], s[3 * 65]); o.z = pk2(s[4 * 65], s[5 * 65]); o.w = pk2(s[6 * 65], s[7 * 65]);
        *(u32x4*)(J.dst + (size_t)(n0 + n) * J.K + k0 + 8 * c) = o; }
    LDS_WAIT(); asm volatile("" ::: "memory");
}
DI void p0_wpb_item(const Params& p, bf16_t* WpbT, int item, int lane) {
    const int nb = item & 31, cb = (item >> 5) & 31, g = item >> 10; const int n = nb * 64 + lane, c0 = cb * 8;
    float acc[8];
#pragma unroll
    for (int j = 0; j < 8; ++j) acc[j] = 0.f;
    const float* wp = p.w_pool + ((size_t)g * 256 + c0) * 256; const float* ps = p.pool_scale + g * 256; const float* wb = p.w_branch_b + (size_t)g * 256 * D + n;
#pragma unroll 32
    for (int d = 0; d < 256; ++d) { const float b = wb[(size_t)d * D] * ps[d];
#pragma unroll
        for (int j = 0; j < 8; ++j) acc[j] += wp[j * 256 + d] * b; }
    u32x4 o; o.x = pk2(acc[0], acc[1]); o.y = pk2(acc[2], acc[3]); o.z = pk2(acc[4], acc[5]); o.w = pk2(acc[6], acc[7]);
    *(u32x4*)(WpbT + (size_t)n * POOLW + g * 256 + c0) = o;
}
DI void p0_plb_item(const Params& p, bf16_t* PLB, int item, int lane) {
    const size_t e = (size_t)item * 512 + lane * 8; const size_t row = e / PLE;
    const float* src = (row < MP) ? p.p_prompt + e : p.p_sample + (e - (size_t)MP * PLE);
    const f32x4 a = *(const f32x4*)src, b = *(const f32x4*)(src + 4);
    u32x4 o; o.x = pk2(a.x, a.y); o.y = pk2(a.z, a.w); o.z = pk2(b.x, b.y); o.w = pk2(b.z, b.w);
    *(u32x4*)(PLB + e) = o;
}

DI void p0_xprep_unit(const Params& p, LAS unsigned char* lds, int u, int wave) {
    const int lane = lane_id(), tid = wave * 64 + lane;
    unsigned char* ws = p.ws;
    bf16_t* XB = (bf16_t*)(ws + WS_XB); float* RSTD1 = (float*)(ws + WS_RSTD1); float* BCUM = (float*)(ws + WS_BCUM); float* LAM = (float*)(ws + WS_LAM);
    LAS unsigned char* WG = lds; LAS float* GL = (LAS float*)(lds + 65536); LAS float* RS = (LAS float*)(lds + 73728);
    for (int pr = tid; pr < 4096; pr += NTHREADS) { const int k8 = pr >> 4, n = pr & 15; float w[8];
#pragma unroll
        for (int j = 0; j < 8; ++j) { const int k = 8 * k8 + j; w[j] = p.w_in[(size_t)k * INW + 6144 + n] * p.norm_mix[k]; }
        u32x4 o; o.x = pk2(w[0], w[1]); o.y = pk2(w[2], w[3]); o.z = pk2(w[4], w[5]); o.w = pk2(w[6], w[7]);
        *(LAS u32x4*)(WG + (size_t)pr * 16) = o; }
    __syncthreads();
    {
        const int fr = lane & 15, fq = lane >> 4; const int row = 128 * u + 16 * wave + fr;
        const float* xr = (row < MP) ? p.x_prompt + (size_t)row * D : p.x_sample + (size_t)(row - MP) * D;
        f32x4 acc = {0.f, 0.f, 0.f, 0.f}; float ss = 0.f;
#pragma unroll 8
        for (int s = 0; s < 64; ++s) {
            const f32x4 a = *(const f32x4*)(xr + 32 * s + 8 * fq), b = *(const f32x4*)(xr + 32 * s + 8 * fq + 4);
            ss += (a.x * a.x + a.y * a.y) + (a.z * a.z + a.w * a.w) + (b.x * b.x + b.y * b.y) + (b.z * b.z + b.w * b.w);
            u32x4 o; o.x = pk2(a.x, a.y); o.y = pk2(a.z, a.w); o.z = pk2(b.x, b.y); o.w = pk2(b.z, b.w);
            *(u32x4*)(XB + (size_t)row * D + 32 * s + 8 * fq) = o;
            const bf16x8 af = __builtin_bit_cast(bf16x8, o);
            const bf16x8 bfr = *(const LAS bf16x8*)(WG + (size_t)((4 * s + fq) * 16 + fr) * 16);
            acc = __builtin_amdgcn_mfma_f32_16x16x32_bf16(af, bfr, acc, 0, 0, 0);
        }
        ss += __shfl_xor(ss, 16); ss += __shfl_xor(ss, 32);
        const float rstd = 1.0f / sqrtf(ss * (1.0f / D) + EPS);
        if (fq == 0) { RS[16 * wave + fr] = rstd; RSTD1[row] = rstd; }
        LDS_WAIT(); asm volatile("" ::: "memory");
#pragma unroll
        for (int j = 0; j < 4; ++j) { const int tl = 16 * wave + 4 * fq + j; GL[tl * 16 + fr] = acc[j] * RS[tl]; }
    }
    __syncthreads();
    const bool sample = (u == 64);
#pragma unroll 1
    for (int cc = 0; cc < 2; ++cc) {
        const int c = tid + 512 * cc; float wg[16];
#pragma unroll
        for (int j = 0; j < 16; ++j) wg[j] = p.w_gate_up[j * KW + c];
        const float bg = p.b_gate[c]; float cum = 0.f;
#pragma unroll 2
        for (int t = 0; t < 128; ++t) {
            const f32x4 g0 = *(const LAS f32x4*)(GL + t * 16), g1 = *(const LAS f32x4*)(GL + t * 16 + 4), g2 = *(const LAS f32x4*)(GL + t * 16 + 8), g3 = *(const LAS f32x4*)(GL + t * 16 + 12);
            float z = bg;
            z += g0.x * wg[0] + g0.y * wg[1] + g0.z * wg[2] + g0.w * wg[3];
            z += g1.x * wg[4] + g1.y * wg[5] + g1.z * wg[6] + g1.w * wg[7];
            z += g2.x * wg[8] + g2.y * wg[9] + g2.z * wg[10] + g2.w * wg[11];
            z += g3.x * wg[12] + g3.y * wg[13] + g3.z * wg[14] + g3.w * wg[15];
            const float gl = logsigmoidf_(z) * (1.0f / 16.0f);
            const int row = 128 * u + t;
            if (sample) { BCUM[(size_t)row * KW + c] = 0.f; LAM[(size_t)(128 + t) * KW + c] = __expf(gl); }
            else { cum = ((t & 63) == 0) ? gl : cum + gl; BCUM[(size_t)row * KW + c] = cum; if ((t & 63) == 63) LAM[(size_t)(row >> 6) * KW + c] = __expf(cum); }
        }
    }
    __syncthreads();
}

constexpr int NXPREP = 65;
DI void phase_p0(const Params& p, LAS unsigned char* lds, int wave) {
    const int lane = lane_id();
    unsigned char* ws = p.ws;
    if ((int)blockIdx.x < NXPREP) { p0_xprep_unit(p, lds, blockIdx.x, wave); return; }
    TJob J[7];
    J[0] = TJob{p.w_in, (bf16_t*)(ws + WS_WIN), p.norm_mix, D, INW, NIN, 1, (D / 64) * (NIN / 64)};
    J[1] = TJob{p.w_up, (bf16_t*)(ws + WS_WUP), p.norm_ffn, D, NUP, NUP, 2, (D / 64) * (NUP / 64)};
    J[2] = TJob{p.w_down, (bf16_t*)(ws + WS_WD), nullptr, DFF, D, D, 0, (DFF / 64) * (D / 64)};
    J[3] = TJob{p.w_branch_a, (bf16_t*)(ws + WS_WA), p.gla_norm, D, D, D, 0, (D / 64) * (D / 64)};
    J[4] = TJob{p.w_out, (bf16_t*)(ws + WS_WO), nullptr, D, D, D, 0, (D / 64) * (D / 64)};
    J[5] = TJob{p.w_ple_gate, (bf16_t*)(ws + WS_WPG), p.norm_ple, D, D, D, 0, (D / 64) * (D / 64)};
    J[6] = TJob{p.w_ple, (bf16_t*)(ws + WS_WPLE), nullptr, PLE, D, D, 0, (PLE / 64) * (D / 64)};
    LAS float* scr = (LAS float*)(lds + wave * TR_SCR);
    const int gw = ((int)blockIdx.x - NXPREP) * NWAVES + wave, NGW = ((int)gridDim.x - NXPREP) * NWAVES;
    int base = 0;
#pragma unroll
    for (int j = 0; j < 7; ++j) {
        const int n = J[j].nitems;
        int it = gw - (base % NGW); if (it < 0) it += NGW;
        for (; it < n; it += NGW) p0_transpose_item(J[j], scr, it, lane);
        base += n;
    }
    for (int it = gw; it < 4096; it += NGW) p0_wpb_item(p, (bf16_t*)(ws + WS_WPB), it, lane);
    for (int it = gw; it < (M * PLE) / 512; it += NGW) p0_plb_item(p, (bf16_t*)(ws + WS_PLB), it, lane);
}

#define MFMA32(a, b, c) __builtin_amdgcn_mfma_f32_32x32x16_bf16((a), (b), (c), 0, 0, 0)
typedef LAS s16x4* lds_s16x4_p;
DI s16x4 tr_read(LAS unsigned char* a) { return __builtin_amdgcn_ds_read_tr16_b64_v4i16((lds_s16x4_p)a); }
DI bf16x8 cat8(s16x4 lo, s16x4 hi) { return __builtin_shufflevector(lo, hi, 0, 1, 2, 3, 4, 5, 6, 7); }
DI bf16x8 ld_perm(const bf16_t* p) {
    const u32x2 a = *(const u32x2*)p, b = *(const u32x2*)(p + 8);
    u32x4 r; r.x = a.x; r.y = a.y; r.z = b.x; r.w = b.y; return __builtin_bit_cast(bf16x8, r);
}
template <int S> DI bf16x8 pack_step(const f32x16& x) {
    u32x4 r; r.x = pk2(x[8 * S + 0], x[8 * S + 1]); r.y = pk2(x[8 * S + 2], x[8 * S + 3]); r.z = pk2(x[8 * S + 4], x[8 * S + 5]); r.w = pk2(x[8 * S + 6], x[8 * S + 7]);
    return __builtin_bit_cast(bf16x8, r);
}
DI f32x16 zero16() { f32x16 z;
#pragma unroll
    for (int i = 0; i < 16; ++i) z[i] = 0.f; return z; }

constexpr int SC_QI = 0, SC_KI = 32768, SC_KDI = 65536, SC_LMI = 98304, SC_VI = 99328, SC_BYTES = 107520;
DI void dma16(const void* g, LAS unsigned char* l) { __builtin_amdgcn_global_load_lds((const unsigned*)g, (LAS unsigned*)l, 16, 0, 0); }
DI bf16x8 lds_perm(LAS unsigned char* a) {
    const u32x2 x = *(const LAS u32x2*)a, y = *(const LAS u32x2*)(a + 1024);
    u32x4 r; r.x = x.x; r.y = x.y; r.z = y.x; r.w = y.y; return __builtin_bit_cast(bf16x8, r);
}
DI void scan_task(const Params& p, LAS unsigned char* lds, int task) {
    unsigned char* ws = p.ws;
    const bf16_t* QB = (const bf16_t*)(ws + WS_QB); const bf16_t* KB = (const bf16_t*)(ws + WS_KB); const bf16_t* KD = (const bf16_t*)(ws + WS_KD);
    const bf16_t* V = (const bf16_t*)(ws + WS_V); bf16_t* OG = (bf16_t*)(ws + WS_OG);
    const float* LAM = (const float*)(ws + WS_LAM); float* OSS = (float*)(ws + WS_OSS);
    const int sl = task & 15, hd = (task >> 4) & 3, b = task >> 6;
    f32x16 S[8];
#pragma unroll
    for (int db = 0; db < 8; ++db) S[db] = zero16();

#define SC_ISSUE_QKV(ch_) do { const int _l = lane_id(); const size_t _r0 = (size_t)(b * SEQ + 64 * (ch_)); \
        const bf16_t* _q = QB + (_r0 + _l) * KW + hd * 256; const bf16_t* _k = KB + (_r0 + _l) * KW + hd * 256; \
        _Pragma("unroll") for (int _i = 0; _i < 32; ++_i) { dma16(_q + 8 * _i, lds + SC_QI + _i * 1024); dma16(_k + 8 * _i, lds + SC_KI + _i * 1024); } \
        const bf16_t* _v = V + (_r0 + (_l >> 2)) * VW + hd * 512 + 32 * sl + 8 * (_l & 3); \
        _Pragma("unroll") for (int _i = 0; _i < 4; ++_i) dma16(_v + (size_t)_i * 16 * VW, lds + SC_VI + ((ch_) & 1) * 4096 + _i * 1024); } while (0)
#define SC_ISSUE_KD(ch_) do { const int _l = lane_id(); const size_t _r0 = (size_t)(b * SEQ + 64 * (ch_)); const int _hi = _l >> 5, _pos = _l & 31; \
        const bf16_t* _kd = KD + (_r0 + _hi) * KW + hd * 256; \
        _Pragma("unroll") for (int _i = 0; _i < 32; ++_i) { const int _cc = _pos ^ (4 * (((2 * _i) & 3) | _hi)); dma16(_kd + (size_t)_i * 2 * KW + 8 * _cc, lds + SC_KDI + _i * 1024); } \
        dma16(LAM + (size_t)(b * 32 + (ch_)) * KW + hd * 256 + 4 * _l, lds + SC_LMI); } while (0)

    SC_ISSUE_QKV(0);
#pragma unroll 1
    for (int ch = 0; ch < 32; ++ch) {
        const int row0 = b * SEQ + 64 * ch;
        VM_WAIT();
        __builtin_amdgcn_sched_barrier(0);
        SC_ISSUE_KD(ch);
        const int lane = lane_id();
        const int c = lane & 31, h = lane >> 5;
        const int i16 = lane & 15, q = i16 >> 2, pp = i16 & 3, jb = (lane >> 4) & 1;
        LAS unsigned char* VI = lds + SC_VI + (ch & 1) * 4096;

#pragma unroll
        for (int tb = 0; tb < 2; ++tb) {
            f32x16 o = zero16();
            LAS unsigned char* qa = lds + SC_QI + (32 * tb + c) * 16 + 8 * h;
            {
                f32x16 att0 = zero16(), att1 = zero16();
                LAS unsigned char* ka = lds + SC_KI + c * 16 + 8 * h;
#pragma unroll
                for (int st = 0; st < 16; ++st) {
                    const bf16x8 qf = lds_perm(qa + 2048 * st);
                    const bf16x8 k0 = lds_perm(ka + 2048 * st);
                    att0 = MFMA32(k0, qf, att0);
                    if (tb == 1) { const bf16x8 k1 = lds_perm(ka + 512 + 2048 * st); att1 = MFMA32(k1, qf, att1); }
                    if ((st & 3) == 3) __builtin_amdgcn_sched_barrier(0);
                }
                if (tb == 0) {
#pragma unroll
                    for (int r = 0; r < 16; ++r) { const int sloc = (r & 3) + 8 * (r >> 2) + 4 * h; att0[r] = (sloc <= c) ? att0[r] : 0.f; }
                } else {
#pragma unroll
                    for (int r = 0; r < 16; ++r) { const int sloc = (r & 3) + 8 * (r >> 2) + 4 * h; att1[r] = (sloc <= c) ? att1[r] : 0.f; }
                }
                LAS unsigned char* vb = VI + ((4 * h + q) * 4 + 2 * jb + (pp >> 1)) * 16 + (pp & 1) * 8;
                { const bf16x8 vf = cat8(tr_read(vb), tr_read(vb + 8 * 64)); o = MFMA32(vf, pack_step<0>(att0), o); }
                { const bf16x8 vf = cat8(tr_read(vb + 16 * 64), tr_read(vb + 24 * 64)); o = MFMA32(vf, pack_step<1>(att0), o); }
                if (tb == 1) {
                    { const bf16x8 vf = cat8(tr_read(vb + 32 * 64), tr_read(vb + 40 * 64)); o = MFMA32(vf, pack_step<0>(att1), o); }
                    { const bf16x8 vf = cat8(tr_read(vb + 48 * 64), tr_read(vb + 56 * 64)); o = MFMA32(vf, pack_step<1>(att1), o); }
                }
            }
#pragma unroll
            for (int db = 0; db < 8; ++db) {
                { const bf16x8 qf = lds_perm(qa + 4096 * db); o = MFMA32(pack_step<0>(S[db]), qf, o); }
                { const bf16x8 qf = lds_perm(qa + 4096 * db + 2048); o = MFMA32(pack_step<1>(S[db]), qf, o); }
                if (db & 1) __builtin_amdgcn_sched_barrier(0);
            }
            const int t = row0 + 32 * tb + c;
            float ss = 0.f;
#pragma unroll
            for (int r = 0; r < 16; ++r) ss += o[r] * o[r];
            { const auto sw = __builtin_amdgcn_permlane32_swap(__float_as_uint(ss), __float_as_uint(ss), false, false); ss = __uint_as_float(sw[0]) + __uint_as_float(sw[1]); }
            if (h == 0) OSS[(size_t)t * 64 + hd * 16 + sl] = ss;
            bf16_t* og = OG + (size_t)(row0 + 32 * tb) * VW + hd * 512 + 32 * sl + c * VW + 4 * h;
#pragma unroll
            for (int g = 0; g < 4; ++g) { u32x2 w; w.x = pk2(o[4 * g + 0], o[4 * g + 1]); w.y = pk2(o[4 * g + 2], o[4 * g + 3]); *(u32x2*)(og + 8 * g) = w; }
        }

        VM_WAIT();
        __builtin_amdgcn_sched_barrier(0);
        if (ch + 1 < 32) SC_ISSUE_QKV(ch + 1);
        {
            LAS unsigned char* vb = VI + ((8 * h + q) * 4 + 2 * jb + (pp >> 1)) * 16 + (pp & 1) * 8;
            LAS unsigned char* kbase = lds + SC_KDI + (8 * h + q) * 512 + (2 * jb + (pp >> 1)) * 16 + (pp & 1) * 8;
            LAS unsigned char* lm = lds + SC_LMI + 16 * h;
#pragma unroll
            for (int db = 0; db < 8; ++db) {
#pragma unroll
                for (int g = 0; g < 4; ++g) { const f32x4 l4 = *(const LAS f32x4*)(lm + (32 * db + 8 * g) * 4);
                    S[db][4 * g + 0] *= l4.x; S[db][4 * g + 1] *= l4.y; S[db][4 * g + 2] *= l4.z; S[db][4 * g + 3] *= l4.w; }
                LAS unsigned char* kb = kbase + (((db & 3) ^ q) * 4) * 16 + (db >> 2) * 256;
#pragma unroll
                for (int ks = 0; ks < 4; ++ks) {
                    const bf16x8 kf = cat8(tr_read(kb + (16 * ks) * 512), tr_read(kb + (16 * ks + 4) * 512));
                    const bf16x8 vf = cat8(tr_read(vb + (16 * ks) * 64), tr_read(vb + (16 * ks + 4) * 64));
                    S[db] = MFMA32(kf, vf, S[db]);
                }
                __builtin_amdgcn_sched_barrier(0);
            }
        }
        asm volatile("" ::: "memory");
    }
#undef SC_ISSUE_QKV
#undef SC_ISSUE_KD
    {   const int lane = lane_id();
        const unsigned voff = (unsigned)(((lane >> 5) * 4 * DV + (lane & 31)) * 4);
        const char* gbase = (const char*)(p.out + O_GLAP + ((size_t)(b * NH + hd) * DK) * DV + 32 * sl);
#pragma unroll
        for (int db = 0; db < 8; ++db) {
#pragma unroll
            for (int r = 0; r < 16; ++r) { const int dl = 32 * db + (r & 3) + 8 * (r >> 2); *(float*)(const_cast<char*>(gbase) + (size_t)dl * DV * 4 + voff) = S[db][r]; }
        }
    }
}

DI void sgla_task(const Params& p, int task, int lane) {
    unsigned char* ws = p.ws;
    const bf16_t* QB = (const bf16_t*)(ws + WS_QB); const bf16_t* KB = (const bf16_t*)(ws + WS_KB); const bf16_t* V = (const bf16_t*)(ws + WS_V);
    const float* LAM = (const float*)(ws + WS_LAM); float* OSP = (float*)(ws + WS_OSP);
    const int dblk = task & 7, hd = (task >> 3) & 3, b = task >> 5; const int row = MP + b;
    const size_t sbase = ((size_t)(b * NH + hd) * DK + 32 * dblk) * DV;
    const float* S0 = p.state_gla + sbase; float* So = p.out + O_GLAS + sbase;
    const int dl = lane & 31;
    const float lam_l = LAM[(size_t)(128 + b) * KW + hd * 256 + 32 * dblk + dl];
    const float k_l = bf1(KB[(size_t)row * KW + hd * 256 + 32 * dblk + dl]);
    const float q_l = bf1(QB[(size_t)row * KW + hd * 256 + 32 * dblk + dl]);
    f32x4 va, vb;
    { const u32x2 w = *(const u32x2*)(V + (size_t)row * VW + hd * 512 + 4 * lane); va = (f32x4){bflo(w.x), bfhi(w.x), bflo(w.y), bfhi(w.y)}; }
    { const u32x2 w = *(const u32x2*)(V + (size_t)row * VW + hd * 512 + 256 + 4 * lane); vb = (f32x4){bflo(w.x), bfhi(w.x), bflo(w.y), bfhi(w.y)}; }
    f32x4 oa = {0.f, 0.f, 0.f, 0.f}, ob = {0.f, 0.f, 0.f, 0.f};
#pragma unroll 8
    for (int d = 0; d < 32; ++d) {
        const float lam = __uint_as_float(__builtin_amdgcn_readlane(__float_as_uint(lam_l), d)), kk = __uint_as_float(__builtin_amdgcn_readlane(__float_as_uint(k_l), d)), qq = __uint_as_float(__builtin_amdgcn_readlane(__float_as_uint(q_l), d));
        const f32x4 s0a = __builtin_nontemporal_load((const f32x4*)(S0 + (size_t)d * DV + 4 * lane)), s0b = __builtin_nontemporal_load((const f32x4*)(S0 + (size_t)d * DV + 256 + 4 * lane));
        const f32x4 sa = s0a * lam + va * kk, sb = s0b * lam + vb * kk;
        __builtin_nontemporal_store(sa, (f32x4*)(So + (size_t)d * DV + 4 * lane)); __builtin_nontemporal_store(sb, (f32x4*)(So + (size_t)d * DV + 256 + 4 * lane));
        oa += sa * qq; ob += sb * qq;
    }
    float* op = OSP + ((size_t)(b * NH + hd) * 8 + dblk) * DV;
    *(f32x4*)(op + 4 * lane) = oa; *(f32x4*)(op + 256 + 4 * lane) = ob;
}

DI void pmix_task(const Params& p, int t, int lane) {
    unsigned char* ws = p.ws;
    const float* U = (const float*)(ws + WS_U); bf16_t* PM = (bf16_t*)(ws + WS_PM);
    if (t < MP) {
        const int b = t >> 11, pos = t & 2047;
#pragma unroll
        for (int i = 0; i < 4; ++i) {
            const int w = 2 << i, c = 256 * i + 4 * lane; const int cnt = (pos + 1 < w) ? pos + 1 : w;
            const f32x4 u0 = *(const f32x4*)(U + (size_t)t * POOLW + c); f32x4 s = u0;
            for (int j = 1; j < cnt; ++j) s += *(const f32x4*)(U + (size_t)(t - j) * POOLW + c);
            const float inv = 1.0f / (float)cnt; const f32x4 mx = s * inv - u0;
            u32x2 o; o.x = pk2(mx.x, mx.y); o.y = pk2(mx.z, mx.w); *(u32x2*)(PM + (size_t)t * POOLW + c) = o;
            if (pos >= SEQ - 15) *(f32x4*)(p.out + O_POOLP + ((size_t)b * 15 + (pos - (SEQ - 15))) * POOLW + c) = u0;
        }
    } else {
        const int b = t - MP; const float* sp = p.state_pool + (size_t)b * 15 * POOLW; float* po = p.out + O_POOLS + (size_t)b * 15 * POOLW;
#pragma unroll
        for (int i = 0; i < 4; ++i) {
            const int w = 2 << i, c = 256 * i + 4 * lane;
            const f32x4 u0 = *(const f32x4*)(U + (size_t)t * POOLW + c); f32x4 s = u0;
            for (int j = 1; j < w; ++j) s += *(const f32x4*)(sp + (size_t)(15 - j) * POOLW + c);
            const float inv = 1.0f / (float)w; const f32x4 mx = s * inv - u0;
            u32x2 o; o.x = pk2(mx.x, mx.y); o.y = pk2(mx.z, mx.w); *(u32x2*)(PM + (size_t)t * POOLW + c) = o;
            for (int r = 0; r < 14; ++r) *(f32x4*)(po + (size_t)r * POOLW + c) = *(const f32x4*)(sp + (size_t)(r + 1) * POOLW + c);
            *(f32x4*)(po + (size_t)14 * POOLW + c) = u0;
        }
    }
}

DI void phase_p2(const Params& p, LAS unsigned char* lds, int wave) {
    const int G = gridDim.x;
    if (wave == 0) { for (int task = blockIdx.x; task < NB * NH * NSL; task += G) scan_task(p, lds, task); }
    else {
        const int lane = lane_id(); const int gw = (int)blockIdx.x * 7 + (wave - 1), NGW = G * 7;
        for (int t = gw; t < M; t += NGW) pmix_task(p, t, lane);
        for (int task = gw; task < MS * NH * 8; task += NGW) sgla_task(p, task, lane);
    }
}

DI void ogn_task(const Params& p, int t, int lane) {
    unsigned char* ws = p.ws;
    bf16_t* OG = (bf16_t*)(ws + WS_OG); const float* OSS = (const float*)(ws + WS_OSS); const float* OSP = (const float*)(ws + WS_OSP); const bf16_t* SR = (const bf16_t*)(ws + WS_SR);
    if (t < MP) {
#pragma unroll
        for (int hd = 0; hd < 4; ++hd) {
            const float* sp = OSS + (size_t)t * 64 + hd * 16; const f32x4 a = *(const f32x4*)sp, b = *(const f32x4*)(sp + 4), c = *(const f32x4*)(sp + 8), d = *(const f32x4*)(sp + 12);
            const float ss = ((a.x + a.y) + (a.z + a.w)) + ((b.x + b.y) + (b.z + b.w)) + ((c.x + c.y) + (c.z + c.w)) + ((d.x + d.y) + (d.z + d.w));
            const float rstd = 1.0f / sqrtf(ss * (1.0f / DV) + EPS);
            bf16_t* op = OG + (size_t)t * VW + hd * 512 + 8 * lane; const u32x4 w = *(const u32x4*)op; const u32x4 g = *(const u32x4*)(SR + (size_t)t * VW + hd * 512 + 8 * lane);
            u32x4 o; o.x = pk2(bflo(w.x) * rstd * bflo(g.x), bfhi(w.x) * rstd * bfhi(g.x)); o.y = pk2(bflo(w.y) * rstd * bflo(g.y), bfhi(w.y) * rstd * bfhi(g.y));
            o.z = pk2(bflo(w.z) * rstd * bflo(g.z), bfhi(w.z) * rstd * bfhi(g.z)); o.w = pk2(bflo(w.w) * rstd * bflo(g.w), bfhi(w.w) * rstd * bfhi(g.w));
            *(u32x4*)op = o;
        }
    } else {
        const int b = t - MP;
#pragma unroll
        for (int hd = 0; hd < 4; ++hd) {
            f32x4 oa = {0.f, 0.f, 0.f, 0.f}, ob = {0.f, 0.f, 0.f, 0.f};
#pragma unroll
            for (int k = 0; k < 8; ++k) { const float* op = OSP + ((size_t)(b * NH + hd) * 8 + k) * DV + 8 * lane; oa += *(const f32x4*)op; ob += *(const f32x4*)(op + 4); }
            float ss = (oa.x * oa.x + oa.y * oa.y) + (oa.z * oa.z + oa.w * oa.w) + (ob.x * ob.x + ob.y * ob.y) + (ob.z * ob.z + ob.w * ob.w);
            ss = wave_sum(ss);
            const float rstd = 1.0f / sqrtf(ss * (1.0f / DV) + EPS);
            const u32x4 w = *(const u32x4*)(SR + (size_t)t * VW + hd * 512 + 8 * lane);
            u32x4 o; o.x = pk2(oa.x * rstd * bflo(w.x), oa.y * rstd * bfhi(w.x)); o.y = pk2(oa.z * rstd * bflo(w.y), oa.w * rstd * bfhi(w.y));
            o.z = pk2(ob.x * rstd * bflo(w.z), ob.y * rstd * bfhi(w.z)); o.w = pk2(ob.z * rstd * bflo(w.w), ob.w * rstd * bfhi(w.w));
            *(u32x4*)(OG + (size_t)t * VW + hd * 512 + 8 * lane) = o;
        }
    }
}
DI void phase_p3(const Params& p, int wave) {
    const int lane = lane_id();
    const int gw = (int)blockIdx.x * NWAVES + wave, NGW = gridDim.x * NWAVES;
    for (int t = gw; t < M; t += NGW) ogn_task(p, t, lane);
}

DI float row_rstd(const float* SS, int row, int lane) {
    float v = (lane < 32) ? SS[(size_t)row * 32 + lane] : 0.f;
    v = wave_sum(v);
    return 1.0f / sqrtf(v * (1.0f / D) + EPS);
}

struct F8 { f32x4 a, b; };
DI F8 unpack8(u32x4 w, float s) { F8 r; r.a = (f32x4){bflo(w.x) * s, bfhi(w.x) * s, bflo(w.y) * s, bfhi(w.y) * s}; r.b = (f32x4){bflo(w.z) * s, bfhi(w.z) * s, bflo(w.w) * s, bfhi(w.w) * s}; return r; }
DI F8 ld8(const float* q) { F8 r; r.a = *(const f32x4*)q; r.b = *(const f32x4*)(q + 4); return r; }
DI void st8(float* q, const F8& v) { *(f32x4*)q = v.a; *(f32x4*)(q + 4) = v.b; }
DI f32x4 silu4(f32x4 x) { return (f32x4){siluf_(x.x), siluf_(x.y), siluf_(x.z), siluf_(x.w)}; }
DI void conv_task(const Params& p, int t, int lane) {
    unsigned char* ws = p.ws;
    const bf16_t* GU = (const bf16_t*)(ws + WS_GU); const float* SS1 = (const float*)(ws + WS_SS1); bf16_t* ACT = (bf16_t*)(ws + WS_ACT);
    const bool prompt = t < MP; const int b = prompt ? (t >> 11) : (t - MP), pos = prompt ? (t & 2047) : 2;
    const float r0 = row_rstd(SS1, t, lane);
    const float r1 = (prompt && pos >= 1) ? row_rstd(SS1, t - 1, lane) : 0.f;
    const float r2 = (prompt && pos >= 2) ? row_rstd(SS1, t - 2, lane) : 0.f;
    const bf16_t* g0p = GU + (size_t)t * NUP; const bf16_t* g1p = GU + (size_t)((prompt && pos >= 1) ? t - 1 : t) * NUP; const bf16_t* g2p = GU + (size_t)((prompt && pos >= 2) ? t - 2 : t) * NUP;
    const float* sc = p.state_conv + (size_t)b * 2 * DFF;
    for (int v = lane; v < DFF / 8; v += 64) {
        const int ch0 = 8 * v, pn = ch0 >> 7, r = ch0 & 127, gcol = 256 * pn + r, ucol = gcol + 128;
        const F8 g0 = unpack8(*(const u32x4*)(g0p + gcol), r0), up = unpack8(*(const u32x4*)(g0p + ucol), r0);
        F8 g1, g2;
        if (prompt) { g1 = unpack8(*(const u32x4*)(g1p + gcol), r1); g2 = unpack8(*(const u32x4*)(g2p + gcol), r2); }
        else { g1 = ld8(sc + DFF + ch0); g2 = ld8(sc + ch0); }
        const F8 w0 = ld8(p.conv_w + ch0), w1 = ld8(p.conv_w + DFF + ch0), w2 = ld8(p.conv_w + 2 * DFF + ch0), cb = ld8(p.conv_b + ch0);
        const f32x4 ga = cb.a + w0.a * g2.a + w1.a * g1.a + w2.a * g0.a, gb = cb.b + w0.b * g2.b + w1.b * g1.b + w2.b * g0.b;
        const f32x4 aa = silu4(ga) * up.a, ab = silu4(gb) * up.b;
        u32x4 o; o.x = pk2(aa.x, aa.y); o.y = pk2(aa.z, aa.w); o.z = pk2(ab.x, ab.y); o.w = pk2(ab.z, ab.w);
        *(u32x4*)(ACT + (size_t)t * DFF + ch0) = o;
        if (prompt) { if (pos >= SEQ - 2) st8(p.out + O_CONVP + ((size_t)b * 2 + (pos - (SEQ - 2))) * DFF + ch0, g0); }
        else { float* co = p.out + O_CONVS + (size_t)b * 2 * DFF + ch0; st8(co, g1); st8(co + DFF, g0); }
    }
}
DI void phase_conv(const Params& p, int wave) {
    const int lane = lane_id();
    const int gw = (int)blockIdx.x * NWAVES + wave, NGW = gridDim.x * NWAVES;
    for (int t = gw; t < M; t += NGW) conv_task(p, t, lane);
}

DI void phase_final(const Params& p, int wave) {
    const int lane = lane_id();
    const int gw = (int)blockIdx.x * NWAVES + wave, NGW = gridDim.x * NWAVES;
    const float* H3 = (const float*)(p.ws + WS_H3); const float* SS3 = (const float*)(p.ws + WS_SS3);
    for (int t = gw; t < M; t += NGW) {
        const float rs = row_rstd(SS3, t, lane);
        float* yo = (t < MP) ? p.out + O_YP + (size_t)t * D : p.out + O_YS + (size_t)(t - MP) * D;
#pragma unroll
        for (int i = 0; i < 8; ++i) { const int c = 256 * i + 4 * lane; const f32x4 hv = *(const f32x4*)(H3 + (size_t)t * D + c), g = *(const f32x4*)(p.norm_final + c);
            *(f32x4*)(yo + c) = hv * rs * g; }
    }
}

#define EPI_ARGS const f32x4 (&acc)[2][2][4][2], const g8::Unit& u, int wr, int wc, int fr, int fq
#define EPI_ROWS(ROWVAR) _Pragma("unroll") for (int ai = 0; ai < 2; ++ai) _Pragma("unroll") for (int m = 0; m < 4; ++m) { const int ROWVAR = u.pm * 256 + ai * 128 + wr * 64 + m * 16 + fr; if (ROWVAR < M) {
#define EPI_COLS(COLVAR) _Pragma("unroll") for (int bj = 0; bj < 2; ++bj) { const int COLVAR = bj * 128 + wc * 32 + 8 * fq; const f32x4 v0 = acc[ai][bj][m][0], v1 = acc[ai][bj][m][1];
#define EPI_END } } }
DI u32x4 pk8(f32x4 a, f32x4 b) { u32x4 o; o.x = pk2(a.x, a.y); o.y = pk2(a.z, a.w); o.z = pk2(b.x, b.y); o.w = pk2(b.z, b.w); return o; }
DI f32x4 exp4(f32x4 x) { return (f32x4){__expf(x.x), __expf(x.y), __expf(x.z), __expf(x.w)}; }
DI f32x4 sig4(f32x4 x) { return (f32x4){sigmoidf_(x.x), sigmoidf_(x.y), sigmoidf_(x.z), sigmoidf_(x.w)}; }
DI f32x4 bf4lo(u32x4 w) { return (f32x4){bflo(w.x), bfhi(w.x), bflo(w.y), bfhi(w.y)}; }
DI f32x4 bf4hi(u32x4 w) { return (f32x4){bflo(w.z), bfhi(w.z), bflo(w.w), bfhi(w.w)}; }
DI float sum4(f32x4 a) { return (a.x + a.y) + (a.z + a.w); }

struct PhaseIn {
    static constexpr int LDA = D, LDB = D, KT = D / 64;
    const Params& p; int G, c;
    DI bool next(int i, g8::Unit& u) const { int pm, pn; if (!g8::grid_order(NTM, 44, G, c, i, pm, pn)) return false;
        u.pm = pm; u.pn = pn; u.A = (const char*)(p.ws + WS_XB) + (size_t)pm * 256 * D * 2; u.B = (const char*)(p.ws + WS_WIN) + (size_t)pn * 256 * D * 2; return true; }
    DI void epi(EPI_ARGS) const {
        unsigned char* ws = p.ws; const float* RSTD1 = (const float*)(ws + WS_RSTD1); const float* BCUM = (const float*)(ws + WS_BCUM);
        const int pn = u.pn;
        if (pn < 4) {
            bf16_t* QB = (bf16_t*)(ws + WS_QB);
            EPI_ROWS(row) const float rs = RSTD1[row] * 0.0625f; EPI_COLS(col) const size_t o = (size_t)row * KW + pn * 256 + col;
                const f32x4 e0 = exp4(*(const f32x4*)(BCUM + o)), e1 = exp4(*(const f32x4*)(BCUM + o + 4));
                *(u32x4*)(QB + o) = pk8(v0 * rs * e0, v1 * rs * e1); EPI_END
        } else if (pn < 8) {
            bf16_t* KB = (bf16_t*)(ws + WS_KB); bf16_t* KD = (bf16_t*)(ws + WS_KD);
            EPI_ROWS(row) const float rs = RSTD1[row]; const int lrow = (row < MP) ? (row | 63) : row; EPI_COLS(col) const size_t o = (size_t)row * KW + (pn - 4) * 256 + col, ol = (size_t)lrow * KW + (pn - 4) * 256 + col;
                const f32x4 b0 = *(const f32x4*)(BCUM + o), b1 = *(const f32x4*)(BCUM + o + 4), l0 = *(const f32x4*)(BCUM + ol), l1 = *(const f32x4*)(BCUM + ol + 4);
                const f32x4 k0 = v0 * rs, k1 = v1 * rs;
                *(u32x4*)(KB + o) = pk8(k0 * exp4(-b0), k1 * exp4(-b1)); *(u32x4*)(KD + o) = pk8(k0 * exp4(l0 - b0), k1 * exp4(l1 - b1)); EPI_END
        } else if (pn < 16) {
            bf16_t* V = (bf16_t*)(ws + WS_V);
            EPI_ROWS(row) const float rs = RSTD1[row]; EPI_COLS(col) *(u32x4*)(V + (size_t)row * VW + (pn - 8) * 256 + col) = pk8(v0 * rs, v1 * rs); EPI_END
        } else if (pn < 24) {
            bf16_t* SR = (bf16_t*)(ws + WS_SR);
            EPI_ROWS(row) const float rs = RSTD1[row]; EPI_COLS(col) const f32x4 a = v0 * rs, b = v1 * rs; *(u32x4*)(SR + (size_t)row * VW + (pn - 16) * 256 + col) = pk8(a * sig4(a), b * sig4(b)); EPI_END
        } else if (pn < 28) {
            float* U = (float*)(ws + WS_U);
            EPI_ROWS(row) const float rs = RSTD1[row]; EPI_COLS(col) float* o = U + (size_t)row * POOLW + (pn - 24) * 256 + col; *(f32x4*)o = v0 * rs; *(f32x4*)(o + 4) = v1 * rs; EPI_END
        } else {
            bf16_t* Gt = (bf16_t*)(ws + (pn < 36 ? WS_GA : WS_GB)); const int c0 = (pn < 36 ? pn - 28 : pn - 36) * 256;
            EPI_ROWS(row) const float rs = RSTD1[row]; EPI_COLS(col) *(u32x4*)(Gt + (size_t)row * D + c0 + col) = pk8(sig4(v0 * rs), sig4(v1 * rs)); EPI_END
        }
    }
};

template <int LDA_, int LDB_, int K_> struct PhaseN2048 {
    static constexpr int LDA = LDA_, LDB = LDB_, KT = K_ / 64;
    const Params& p; int G, c; size_t a_off, b_off;
    DI bool next_(int i, g8::Unit& u) const { int pm, pn; if (!g8::grid_order(NTM, 8, G, c, i, pm, pn)) return false;
        u.pm = pm; u.pn = pn; u.A = (const char*)(p.ws + a_off) + (size_t)pm * 256 * LDA * 2; u.B = (const char*)(p.ws + b_off) + (size_t)pn * 256 * LDB * 2; return true; }
};
struct PhaseYb : PhaseN2048<POOLW, POOLW, POOLW> {
    DI bool next(int i, g8::Unit& u) const { return next_(i, u); }
    DI void epi(EPI_ARGS) const { const bf16_t* GB = (const bf16_t*)(p.ws + WS_GB); float* Y = (float*)(p.ws + WS_YBG);
        EPI_ROWS(row) EPI_COLS(col) const size_t o = (size_t)row * D + u.pn * 256 + col; const u32x4 g = *(const u32x4*)(GB + o);
            *(f32x4*)(Y + o) = v0 * bf4lo(g); *(f32x4*)(Y + o + 4) = v1 * bf4hi(g); EPI_END }
};
struct PhaseYa : PhaseN2048<VW, VW, VW> {
    DI bool next(int i, g8::Unit& u) const { return next_(i, u); }
    DI void epi(EPI_ARGS) const { const bf16_t* GA = (const bf16_t*)(p.ws + WS_GA); const float* Y = (const float*)(p.ws + WS_YBG); bf16_t* MB = (bf16_t*)(p.ws + WS_MB);
        EPI_ROWS(row) EPI_COLS(col) const size_t o = (size_t)row * D + u.pn * 256 + col; const u32x4 g = *(const u32x4*)(GA + o);
            *(u32x4*)(MB + o) = pk8(v0 * bf4lo(g) + *(const f32x4*)(Y + o), v1 * bf4hi(g) + *(const f32x4*)(Y + o + 4)); EPI_END }
};
DI void epi_residual(EPI_ARGS, const float* base_p, const float* base_s, float* H, bf16_t* HB, float* SS) {
    EPI_ROWS(row) float ss = 0.f; const float* br = (base_s && row >= MP) ? base_s + (size_t)(row - MP) * D : base_p + (size_t)row * D;
        EPI_COLS(col) const int cg_ = u.pn * 256 + col; const size_t o = (size_t)row * D + cg_;
            const f32x4 h0 = v0 + *(const f32x4*)(br + cg_), h1 = v1 + *(const f32x4*)(br + cg_ + 4);
            *(f32x4*)(H + o) = h0; *(f32x4*)(H + o + 4) = h1; *(u32x4*)(HB + o) = pk8(h0, h1);
            ss += sum4(h0 * h0) + sum4(h1 * h1); }
        ss += __shfl_xor(ss, 16); ss += __shfl_xor(ss, 32);
        if (fq == 0) SS[(size_t)row * 32 + u.pn * 4 + wc] = ss; } }
}
struct PhaseOut : PhaseN2048<D, D, D> {
    DI bool next(int i, g8::Unit& u) const { return next_(i, u); }
    DI void epi(EPI_ARGS) const { epi_residual(acc, u, wr, wc, fr, fq, p.x_prompt, p.x_sample, (float*)(p.ws + WS_H1), (bf16_t*)(p.ws + WS_H1B), (float*)(p.ws + WS_SS1)); }
};
struct PhaseDown : PhaseN2048<DFF, DFF, DFF> {
    DI bool next(int i, g8::Unit& u) const { return next_(i, u); }
    DI void epi(EPI_ARGS) const { epi_residual(acc, u, wr, wc, fr, fq, (const float*)(p.ws + WS_H1), nullptr, (float*)(p.ws + WS_H2), (bf16_t*)(p.ws + WS_H2B), (float*)(p.ws + WS_SS2)); }
};
struct PhasePe : PhaseN2048<PLE, PLE, PLE> {
    DI bool next(int i, g8::Unit& u) const { return next_(i, u); }
    DI void epi(EPI_ARGS) const { float* PE = (float*)(p.ws + WS_PE);
        EPI_ROWS(row) EPI_COLS(col) const size_t o = (size_t)row * D + u.pn * 256 + col; *(f32x4*)(PE + o) = v0; *(f32x4*)(PE + o + 4) = v1; EPI_END }
};
struct PhasePg : PhaseN2048<D, D, D> {
    DI bool next(int i, g8::Unit& u) const { return next_(i, u); }
    DI void epi(EPI_ARGS) const { const float* H2 = (const float*)(p.ws + WS_H2); const float* PE = (const float*)(p.ws + WS_PE); const float* SS2 = (const float*)(p.ws + WS_SS2);
        float* H3 = (float*)(p.ws + WS_H3); float* SS3 = (float*)(p.ws + WS_SS3);
        EPI_ROWS(row) float s2 = 0.f;
#pragma unroll
            for (int k = 0; k < 8; ++k) s2 += sum4(*(const f32x4*)(SS2 + (size_t)row * 32 + 4 * k));
            const float rs = 1.0f / sqrtf(s2 * (1.0f / D) + EPS); float ss = 0.f;
            EPI_COLS(col) const size_t o = (size_t)row * D + u.pn * 256 + col;
                const f32x4 h0 = *(const f32x4*)(H2 + o) + sig4(v0 * rs) * *(const f32x4*)(PE + o), h1 = *(const f32x4*)(H2 + o + 4) + sig4(v1 * rs) * *(const f32x4*)(PE + o + 4);
                *(f32x4*)(H3 + o) = h0; *(f32x4*)(H3 + o + 4) = h1; ss += sum4(h0 * h0) + sum4(h1 * h1); }
            ss += __shfl_xor(ss, 16); ss += __shfl_xor(ss, 32);
            if (fq == 0) SS3[(size_t)row * 32 + u.pn * 4 + wc] = ss; } }
    }
};
struct PhaseUp {
    static constexpr int LDA = D, LDB = D, KT = D / 64;
    const Params& p; int G, c;
    DI bool next(int i, g8::Unit& u) const { int pm, pn; if (!g8::grid_order(NTM, 43, G, c, i, pm, pn)) return false;
        u.pm = pm; u.pn = pn; u.A = (const char*)(p.ws + WS_H1B) + (size_t)pm * 256 * D * 2; u.B = (const char*)(p.ws + WS_WUP) + (size_t)pn * 256 * D * 2; return true; }
    DI void epi(EPI_ARGS) const { bf16_t* GU = (bf16_t*)(p.ws + WS_GU);
        EPI_ROWS(row) EPI_COLS(col) *(u32x4*)(GU + (size_t)row * NUP + u.pn * 256 + col) = pk8(v0, v1); EPI_END }
};


#define XB_TMO      128
#define XB_XCNT(j)  (256  + 64 * (j))
#define XB_XSUB(j)  (1280 + 64 * (j))
#define XB_XGEN(j)  (2304 + 64 * (j))
#define XB_TOP      3328
#define XB_TOPGEN   3392
#define XCD_BAR_WORDS 3456
#define XB_SPIN_CAP (1u << 22)
DI unsigned xb_ld(unsigned* p)              { return __hip_atomic_load(p, __ATOMIC_RELAXED, __HIP_MEMORY_SCOPE_AGENT); }
DI unsigned xb_add(unsigned* p, unsigned v) { return __hip_atomic_fetch_add(p, v, __ATOMIC_RELAXED, __HIP_MEMORY_SCOPE_AGENT); }
DI unsigned xb_xcc_id() { return (unsigned)__builtin_amdgcn_s_getreg((3 << 11) | 20) & 0xFu; }
#define XB_SPIN(cond, bar) do { unsigned _sp = 0; while (cond) { __builtin_amdgcn_s_sleep(1); \
    if ((++_sp & 255u) == 0u) { if (xb_ld(&(bar)[XB_TMO])) break; if (_sp > XB_SPIN_CAP) { atomicAdd(&(bar)[XB_TMO], 1u); break; } } } } while (0)
struct XcdBarrier { unsigned* bar; unsigned x; volatile LAS unsigned* st; };
DI XcdBarrier xcd_barrier_post(unsigned* bar, volatile LAS unsigned* st, bool t0) {
    XcdBarrier b; b.bar = bar; b.x = xb_xcc_id(); b.st = st;
    if (t0) (void)xb_add(&bar[XB_XCNT(b.x)], 1u);
    return b;
}
DI void xcd_barrier_complete(unsigned* bar, unsigned x, unsigned& nloc, unsigned& nx) {
    const unsigned G = gridDim.x * gridDim.y * gridDim.z;
    unsigned sum, cnt, mine, sp = 0u;
    for (;;) {
        sum = 0u; cnt = 0u; mine = 0u;
#pragma unroll
        for (unsigned j = 0; j < 16; ++j) { const unsigned c = xb_ld(&bar[XB_XCNT(j)]); sum += c; cnt += (c > 0u) ? 1u : 0u; mine = (j == x) ? c : mine; }
        if (sum == G) break;
        __builtin_amdgcn_s_sleep(1);
        if ((++sp & 255u) == 0u) { if (xb_ld(&bar[XB_TMO])) break; if (sp > XB_SPIN_CAP) { atomicAdd(&bar[XB_TMO], 1u); break; } }
    }
    nloc = mine > 0u ? mine : 1u; nx = cnt > 0u ? cnt : 1u;
}
DI void xcd_barrier(const XcdBarrier& b, bool t0) {
    asm volatile("s_waitcnt vmcnt(0)" ::: "memory");
    __syncthreads();
    if (t0) {
        unsigned* bar = b.bar;
        __builtin_amdgcn_s_waitcnt(0);
        unsigned nloc = b.st[0], nx = b.st[1];
        if (nloc == 0u) { xcd_barrier_complete(bar, b.x, nloc, nx); b.st[0] = nloc; b.st[1] = nx; }
        const unsigned old = xb_add(&bar[XB_XSUB(b.x)], 1u);
        const unsigned gen = old / nloc;
        if (old + 1u == (gen + 1u) * nloc) {
            __builtin_amdgcn_fence(__ATOMIC_RELEASE, "agent");
            asm volatile("s_waitcnt vmcnt(0)" ::: "memory");
            const unsigned og = xb_add(&bar[XB_TOP], 1u);
            const unsigned tg = og / nx;
            if (og + 1u == (tg + 1u) * nx) xb_add(&bar[XB_TOPGEN], 1u);
            else XB_SPIN(xb_ld(&bar[XB_TOPGEN]) == tg, bar);
            __builtin_amdgcn_fence(__ATOMIC_ACQUIRE, "agent");
            xb_add(&bar[XB_XGEN(b.x)], 1u);
            asm volatile("s_waitcnt vmcnt(0)" ::: "memory");
        } else {
            XB_SPIN(xb_ld(&bar[XB_XGEN(b.x)]) == gen, bar);
            __builtin_amdgcn_fence(__ATOMIC_ACQUIRE, "agent");
            asm volatile("s_waitcnt vmcnt(0)" ::: "memory");
        }
    }
    __syncthreads();
}

constexpr int N_PHASES = 13;
#ifndef G8_SP2
#define G8_SP2 true
#endif
#ifndef G8_ALIGN
#define G8_ALIGN true
#endif

__global__ void __launch_bounds__(NTHREADS, 2) fwd_kernel(Params p) {
    extern __shared__ __attribute__((aligned(16))) unsigned char lds_raw[];
    LAS unsigned char* lds = (LAS unsigned char*)lds_raw;
    const int G = gridDim.x, c = blockIdx.x;
    const int wave = __builtin_amdgcn_readfirstlane(threadIdx.x >> 6);
    const int lo = p.ph_lo, hi = p.ph_hi;
#ifndef REPEAT_MASK
#define REPEAT_MASK 0
#endif
#ifndef PHASE_MASK
#define PHASE_MASK 0x1fff
#endif
#define IN(k) (((PHASE_MASK >> (k)) & 1) && lo <= (k) && (k) < hi)
    volatile LAS unsigned* bst = (volatile LAS unsigned*)(lds + LDS_MISC);
    const bool t0 = (wave == 0) && (lane_id() == 0);
    XcdBarrier bar; bar.bar = (unsigned*)(p.ws + WS_CTL); bar.x = 0; bar.st = bst;
    if (hi - lo > 1) { if (t0) { bst[0] = 0u; bst[1] = 0u; } __syncthreads(); bar = xcd_barrier_post((unsigned*)(p.ws + WS_CTL), bst, t0); }
#define SEAM(k) do { if (IN(k) && IN((k) + 1)) { xcd_barrier(bar, (wave == 0) && (lane_id() == 0)); } } while (0)
    if (IN(0)) { phase_p0(p, lds, wave); if ((REPEAT_MASK >> 0) & 1) { xcd_barrier(bar, (wave == 0) && (lane_id() == 0)); phase_p0(p, lds, wave); } } SEAM(0);
    if (IN(1)) { PhaseIn ph{p, G, c}; g8::run<PhaseIn, G8_ALIGN, G8_SP2>(lds, ph, wave); if ((REPEAT_MASK >> 1) & 1) { xcd_barrier(bar, (wave == 0) && (lane_id() == 0)); PhaseIn ph{p, G, c}; g8::run<PhaseIn, G8_ALIGN, G8_SP2>(lds, ph, wave); } } SEAM(1);
    if (IN(2)) { phase_p2(p, lds, wave); if ((REPEAT_MASK >> 2) & 1) { xcd_barrier(bar, (wave == 0) && (lane_id() == 0)); phase_p2(p, lds, wave); } } SEAM(2);
    if (IN(3)) { phase_p3(p, wave); if ((REPEAT_MASK >> 3) & 1) { xcd_barrier(bar, (wave == 0) && (lane_id() == 0)); phase_p3(p, wave); } } SEAM(3);
    if (IN(4)) { PhaseYb ph{{p, G, c, WS_PM, WS_WPB}}; g8::run<PhaseYb, G8_ALIGN, G8_SP2>(lds, ph, wave); if ((REPEAT_MASK >> 4) & 1) { xcd_barrier(bar, (wave == 0) && (lane_id() == 0)); PhaseYb ph{{p, G, c, WS_PM, WS_WPB}}; g8::run<PhaseYb, G8_ALIGN, G8_SP2>(lds, ph, wave); } } SEAM(4);
    if (IN(5)) { PhaseYa ph{{p, G, c, WS_OG, WS_WA}}; g8::run<PhaseYa, G8_ALIGN, G8_SP2>(lds, ph, wave); if ((REPEAT_MASK >> 5) & 1) { xcd_barrier(bar, (wave == 0) && (lane_id() == 0)); PhaseYa ph{{p, G, c, WS_OG, WS_WA}}; g8::run<PhaseYa, G8_ALIGN, G8_SP2>(lds, ph, wave); } } SEAM(5);
    if (IN(6)) { PhaseOut ph{{p, G, c, WS_MB, WS_WO}}; g8::run<PhaseOut, G8_ALIGN, G8_SP2>(lds, ph, wave); if ((REPEAT_MASK >> 6) & 1) { xcd_barrier(bar, (wave == 0) && (lane_id() == 0)); PhaseOut ph{{p, G, c, WS_MB, WS_WO}}; g8::run<PhaseOut, G8_ALIGN, G8_SP2>(lds, ph, wave); } } SEAM(6);
    if (IN(7)) { PhaseUp ph{p, G, c}; g8::run<PhaseUp, G8_ALIGN, G8_SP2>(lds, ph, wave); if ((REPEAT_MASK >> 7) & 1) { xcd_barrier(bar, (wave == 0) && (lane_id() == 0)); PhaseUp ph{p, G, c}; g8::run<PhaseUp, G8_ALIGN, G8_SP2>(lds, ph, wave); } } SEAM(7);
    if (IN(8)) { phase_conv(p, wave); if ((REPEAT_MASK >> 8) & 1) { xcd_barrier(bar, (wave == 0) && (lane_id() == 0)); phase_conv(p, wave); } } SEAM(8);
    if (IN(9)) { PhaseDown ph{{p, G, c, WS_ACT, WS_WD}}; g8::run<PhaseDown, G8_ALIGN, G8_SP2>(lds, ph, wave); if ((REPEAT_MASK >> 9) & 1) { xcd_barrier(bar, (wave == 0) && (lane_id() == 0)); PhaseDown ph{{p, G, c, WS_ACT, WS_WD}}; g8::run<PhaseDown, G8_ALIGN, G8_SP2>(lds, ph, wave); } } SEAM(9);
    if (IN(10)) { PhasePe ph{{p, G, c, WS_PLB, WS_WPLE}}; g8::run<PhasePe, G8_ALIGN, G8_SP2>(lds, ph, wave); if ((REPEAT_MASK >> 10) & 1) { xcd_barrier(bar, (wave == 0) && (lane_id() == 0)); PhasePe ph{{p, G, c, WS_PLB, WS_WPLE}}; g8::run<PhasePe, G8_ALIGN, G8_SP2>(lds, ph, wave); } } SEAM(10);
    if (IN(11)) { PhasePg ph{{p, G, c, WS_H2B, WS_WPG}}; g8::run<PhasePg, G8_ALIGN, G8_SP2>(lds, ph, wave); if ((REPEAT_MASK >> 11) & 1) { xcd_barrier(bar, (wave == 0) && (lane_id() == 0)); PhasePg ph{{p, G, c, WS_H2B, WS_WPG}}; g8::run<PhasePg, G8_ALIGN, G8_SP2>(lds, ph, wave); } } SEAM(11);
    if (IN(12)) { phase_final(p, wave); if ((REPEAT_MASK >> 12) & 1) { xcd_barrier(bar, (wave == 0) && (lane_id() == 0)); phase_final(p, wave); } }
#undef IN
#undef SEAM
}

extern "C" void kernel_launch(void* const* d_in, const int* in_sizes, int n_in, void* d_out, int out_size, void* d_ws, size_t ws_size, hipStream_t stream) {
    static int grid = 0;
    if (grid == 0) {
        if (n_in != 26 || (size_t)out_size != O_END || ws_size < WS_END) {
            fprintf(stderr, "kernel_launch: unexpected problem: n_in %d out %d ws %zu (need %zu)\n", n_in, out_size, ws_size, (size_t)WS_END); grid = -1; return; }
        int dev = 0, cus = 0, per_cu = 0;
        if (hipGetDevice(&dev) != hipSuccess || hipDeviceGetAttribute(&cus, hipDeviceAttributeMultiprocessorCount, dev) != hipSuccess) { grid = -1; return; }
        if (hipFuncSetAttribute((const void*)fwd_kernel, hipFuncAttributeMaxDynamicSharedMemorySize, LDS_BYTES) != hipSuccess) { fprintf(stderr, "kernel_launch: hipFuncSetAttribute failed\n"); grid = -1; return; }
        if (hipOccupancyMaxActiveBlocksPerMultiprocessor(&per_cu, (const void*)fwd_kernel, NTHREADS, LDS_BYTES) != hipSuccess || per_cu < 1) {
            fprintf(stderr, "kernel_launch: occupancy query reports %d blocks per CU\n", per_cu); (void)hipGetLastError(); grid = -1; return; }
        grid = cus;
    }
    if (grid < 0) return;
    Params p{};
    const float** pp = (const float**)&p;
    for (int i = 0; i < 26; ++i) pp[i] = (const float*)d_in[i];
    p.out = (float*)d_out; p.ws = (unsigned char*)d_ws;
#if MK_N_LAUNCHES == 1
    p.ph_lo = 0; p.ph_hi = N_PHASES;
    void* args[] = {&p};
    if (hipMemsetAsync((char*)d_ws + WS_CTL, 0, XCD_BAR_WORDS * 4, stream) != hipSuccess) { fprintf(stderr, "kernel_launch: memset failed\n"); return; }
    hipError_t e = hipLaunchCooperativeKernel((const void*)fwd_kernel, dim3(grid), dim3(NTHREADS), args, LDS_BYTES, stream);
    if (e != hipSuccess) fprintf(stderr, "kernel_launch: cooperative launch failed: %s (grid %d)\n", hipGetErrorString(e), grid);
#else
    for (int k = 0; k < N_PHASES; ++k) { p.ph_lo = k; p.ph_hi = k + 1; hipLaunchKernelGGL(fwd_kernel, dim3(grid), dim3(NTHREADS), LDS_BYTES, stream, p); }
#endif
}
```

```cpp
#include <hip/hip_runtime.h>
#include <hip/hip_cooperative_groups.h>
#include <cstdio>
#include <cstdint>
namespace cg = cooperative_groups;

#ifndef MK_N_LAUNCHES
#define MK_N_LAUNCHES 1
#endif

#define LAS __attribute__((address_space(3)))
#define DI __device__ __forceinline__
typedef unsigned short bf16_t;
typedef short bf16x8 __attribute__((ext_vector_type(8)));
typedef short s16x4 __attribute__((ext_vector_type(4)));
typedef float f32x4 __attribute__((ext_vector_type(4)));
typedef float f32x2 __attribute__((ext_vector_type(2)));
typedef float f32x16 __attribute__((ext_vector_type(16)));
typedef unsigned u32x4 __attribute__((ext_vector_type(4)));
typedef unsigned u32x2 __attribute__((ext_vector_type(2)));

constexpr int D = 2048, MP = 8192, MS = 128, M = MP + MS, MPAD = 8448, NTM = 33;
constexpr int SEQ = 2048, NB = 4, NH = 4, DK = 256, DV = 512, KW = 1024, VW = 2048;
constexpr int DFF = 5504, NUP = 2 * DFF, PLE = 256, POOLW = 1024, INW = 11280, NIN = 11264;
constexpr float EPS = 1e-6f;
constexpr int NSL = 16;

constexpr size_t O_YP = 0, O_YS = O_YP + (size_t)MP * D, O_GLAP = O_YS + (size_t)MS * D, O_POOLP = O_GLAP + (size_t)NB * NH * DK * DV,
                 O_CONVP = O_POOLP + (size_t)NB * 15 * POOLW, O_GLAS = O_CONVP + (size_t)NB * 2 * DFF, O_POOLS = O_GLAS + (size_t)MS * NH * DK * DV,
                 O_CONVS = O_POOLS + (size_t)MS * 15 * POOLW, O_END = O_CONVS + (size_t)MS * 2 * DFF;

constexpr size_t al(size_t x) { return (x + 255) & ~(size_t)255; }
constexpr size_t WS_CTL = 0, CTL_BYTES = 65536;
constexpr size_t WS_WUP = WS_CTL + CTL_BYTES;
constexpr size_t WS_WD = WS_WUP + al((size_t)NUP * D * 2);
constexpr size_t WS_WA = WS_WD + al((size_t)D * DFF * 2);
constexpr size_t WS_WO = WS_WA + al((size_t)D * D * 2);
constexpr size_t WS_WPG = WS_WO + al((size_t)D * D * 2);
constexpr size_t WS_WPB = WS_WPG + al((size_t)D * D * 2);
constexpr size_t WS_WPLE = WS_WPB + al((size_t)D * POOLW * 2);
constexpr size_t WS_WBT = WS_WPLE + al((size_t)D * PLE * 2);
constexpr size_t WS_WPS = WS_WBT + al((size_t)D * POOLW * 2);
constexpr size_t WS_SMALL = WS_WPS + al((size_t)POOLW * 256 * 2);
constexpr size_t WS_RSTD1 = WS_SMALL;
constexpr size_t WS_LAM = WS_RSTD1 + al((size_t)MPAD * 4);
constexpr size_t WS_OSS = WS_LAM + al((size_t)256 * KW * 4);
constexpr size_t WS_OSP = WS_OSS + al((size_t)MP * NH * NSL * 4);
constexpr size_t WS_SS1 = WS_OSP + al((size_t)MS * NH * 8 * DV * 4);
constexpr size_t WS_SS2 = WS_SS1 + al((size_t)MPAD * 32 * 4);
constexpr size_t WS_SS3 = WS_SS2 + al((size_t)MPAD * 32 * 4);
constexpr size_t WS_SS1S = WS_SS3 + al((size_t)MPAD * 32 * 4);
constexpr size_t WS_SS2S = WS_SS1S + al((size_t)MS * 128 * 4);
constexpr size_t WS_SS3S = WS_SS2S + al((size_t)MS * 128 * 4);
constexpr size_t WS_PLB = WS_SS3S + al((size_t)MS * 128 * 4);
constexpr size_t WS_R1 = WS_PLB + al((size_t)MPAD * PLE * 2);
constexpr size_t WS_XB = WS_R1;
constexpr size_t WS_WIN = WS_XB + al((size_t)MPAD * D * 2);
constexpr size_t WS_BCUM = WS_WIN + al((size_t)NIN * D * 2);
constexpr size_t WS_R1_END = WS_BCUM + al((size_t)MPAD * KW * 4);
constexpr size_t WS_ACT = WS_R1;
static_assert(WS_ACT + al((size_t)MPAD * DFF * 2) <= WS_R1_END, "R1 overlay");
constexpr size_t WS_R2 = WS_R1_END;
constexpr size_t WS_QB = WS_R2;
constexpr size_t WS_KB = WS_QB + al((size_t)MPAD * KW * 2);
constexpr size_t WS_KD = WS_KB + al((size_t)MPAD * KW * 2);
constexpr size_t WS_V = WS_KD + al((size_t)MPAD * KW * 2);
constexpr size_t WS_SR = WS_V + al((size_t)MPAD * VW * 2);
constexpr size_t WS_GA = WS_SR + al((size_t)MPAD * VW * 2);
constexpr size_t WS_GB = WS_GA + al((size_t)MPAD * D * 2);
constexpr size_t WS_U = WS_GB + al((size_t)MPAD * D * 2);
constexpr size_t WS_OG = WS_U + al((size_t)MPAD * POOLW * 4);
constexpr size_t WS_PM = WS_OG + al((size_t)MPAD * VW * 2);
constexpr size_t WS_YBG = WS_PM + al((size_t)MPAD * POOLW * 2);
constexpr size_t WS_R2_END = WS_YBG + al((size_t)MPAD * D * 4);
constexpr size_t WS_GU = WS_R2;
constexpr size_t WS_H2 = WS_GU + al((size_t)MPAD * NUP * 2);
constexpr size_t WS_PE = WS_H2 + al((size_t)MPAD * D * 4);
static_assert(WS_PE + al((size_t)MPAD * D * 4) <= WS_R2_END, "R2 overlay");
constexpr size_t WS_MB = WS_R2_END;
constexpr size_t WS_H1 = WS_MB + al((size_t)MPAD * D * 2);
constexpr size_t WS_H1B = WS_H1 + al((size_t)MPAD * D * 4);
constexpr size_t WS_END = WS_H1B + al((size_t)MPAD * D * 2);
constexpr size_t WS_H3 = WS_H1;
constexpr size_t WS_H2B = WS_MB;

DI unsigned pk2(float lo, float hi) {
    typedef __bf16 bf2 __attribute__((ext_vector_type(2)));
    f32x2 v = {lo, hi};
    bf2 b = __builtin_convertvector(v, bf2);
    return __builtin_bit_cast(unsigned, b);
}
DI float bflo(unsigned w) { return __uint_as_float(w << 16); }
DI float bfhi(unsigned w) { return __uint_as_float(w & 0xffff0000u); }
DI float bf1(bf16_t b) { return __uint_as_float(((unsigned)b) << 16); }
DI float fexp(float x) { return __expf(x); }
DI float sigmoidf_(float x) { return __builtin_amdgcn_rcpf(1.0f + __expf(-x)); }
DI float siluf_(float x) { return x * sigmoidf_(x); }
DI float logsigmoidf_(float z) { return fminf(z, 0.f) - __logf(1.0f + __expf(-fabsf(z))); }
DI float wave_sum(float v) {
#pragma unroll
    for (int o = 1; o < 64; o <<= 1) v += __shfl_xor(v, o);
    return v;
}
DI int lane_id() { int l; asm volatile("v_mbcnt_lo_u32_b32 %0, -1, 0\n\tv_mbcnt_hi_u32_b32 %0, -1, %0" : "=v"(l)); return l; }
#define LDS_WAIT() asm volatile("s_waitcnt lgkmcnt(0)" ::: "memory")
#define VM_WAIT() asm volatile("s_waitcnt vmcnt(0)" ::: "memory")

struct Params {
    const float *x_prompt, *x_sample, *state_gla, *state_pool, *state_conv, *p_prompt, *p_sample;
    const float *norm_mix, *w_in, *w_gate_up, *b_gate, *gla_norm, *w_branch_a, *w_pool, *pool_scale, *w_branch_b, *w_out, *norm_ffn, *w_up, *conv_w, *conv_b,
        *w_down, *norm_ple, *w_ple_gate, *w_ple, *norm_final;
    float* out; unsigned char* ws;
    int ph_lo, ph_hi;
};

constexpr int NWAVES = 8, NTHREADS = 512;
constexpr int LDS_BYTES = 147456;
constexpr int LDS_MISC = LDS_BYTES - 256;

namespace g8 {
constexpr int BM = 256, BK = 64, HALF = 128, HTB = HALF * BK * 2, STAGE_BYTES = 8 * HTB, NXCD = 8, WGM = 8;
DI int lds_byte(int r, int c) { const int st = (r >> 4) * 2 + (c >> 5), rr = r & 15, cc = c & 31, ob = rr * 64 + cc * 2; return st * 1024 + (ob ^ (((ob >> 9) & 1) << 5)); }
DI void stage_rc(int b, int& R, int& C) { const int st = b / 1024, sb = b % 1024, swz = sb ^ (((sb >> 9) & 1) << 5); R = (st >> 1) * 16 + swz / 64; C = (st & 1) * 32 + (swz % 64) / 2; }
DI int perm32(int rho) { const int n = rho >> 4, i = rho & 15; return 8 * (i >> 2) + 4 * n + (i & 3); }

struct Unit { const char* A; const char* B; int pm, pn; };

DI bool grid_order(int nM, int nN, int G, int c, int i, int& pm, int& pn) {
    const int nwg = nM * nN; const long L = (long)i * G + c; if (L >= nwg) return false;
    int wgid = (int)L; { const int q = nwg / NXCD, r = nwg % NXCD, xcd = wgid % NXCD, off = wgid / NXCD; wgid = (xcd < r ? xcd * (q + 1) : r * (q + 1) + (xcd - r) * q) + off; }
    const int nig = WGM * nN, gid = wgid / nig, fm = gid * WGM, gsz = (nM - fm) < WGM ? (nM - fm) : WGM;
    pm = fm + ((wgid % nig) % gsz); pn = (wgid % nig) / gsz; return true;
}

template <class P, bool ALIGN_EPI, bool SP2>
DI void run(LAS unsigned char* lds, const P& ph, int wid) {
    const int lane = lane_id(), tid = wid * 64 + lane, wr = wid >> 2, wc = wid & 3, fr = lane & 15, fq = lane >> 4;
    constexpr int nt = P::KT;
    unsigned voffA[2], voffB[2];
#pragma unroll
    for (int i = 0; i < 2; ++i) { int R, C; stage_rc(tid * 16 + i * 8192, R, C); const int Rb = (R & ~31) + perm32(R & 31);
        voffA[i] = (unsigned)(R * P::LDA + C) * 2u; voffB[i] = (unsigned)(Rb * P::LDB + C) * 2u; }
    constexpr size_t kstep = (size_t)(BK * 2);
    constexpr size_t hstepA = (size_t)HALF * P::LDA * 2, hstepB = (size_t)HALF * P::LDB * 2;
    const unsigned ldsw = (unsigned)wid * 1024u;
    const int aoff = lds_byte(wr * 64 + fr, fq * 8), boff = lds_byte(wc * 32 + fr, fq * 8);
#define G8_SA(b, h) (((b) * 2 + (h)) * HTB)
#define G8_SB(b, h) ((4 + (b) * 2 + (h)) * HTB)
#define G8_STAGE(bufoff, gbase, voff) do { _Pragma("unroll") for (int _i = 0; _i < 2; ++_i) \
        __builtin_amdgcn_global_load_lds((const unsigned*)((const char*)(gbase) + (voff)[_i]), (LAS unsigned*)(lds + (bufoff) + ldsw + _i * 8192), 16, 0, 0); } while (0)
#define G8_LDA(dst, b, h) do { _Pragma("unroll") for (int m = 0; m < 4; ++m) _Pragma("unroll") for (int k = 0; k < 2; ++k) dst[m][k] = *(const LAS bf16x8*)(lds + G8_SA(b, h) + aoff + m * 2048 + k * 1024); } while (0)
#define G8_LDB(dst, b, h) do { _Pragma("unroll") for (int n = 0; n < 2; ++n) _Pragma("unroll") for (int k = 0; k < 2; ++k) dst[n][k] = *(const LAS bf16x8*)(lds + G8_SB(b, h) + boff + n * 2048 + k * 1024); } while (0)
#define G8_MMA(ai, bj, At, Bt) do { __builtin_amdgcn_s_setprio(1); _Pragma("unroll") for (int m = 0; m < 4; ++m) _Pragma("unroll") for (int n = 0; n < 2; ++n) _Pragma("unroll") for (int k = 0; k < 2; ++k) \
        acc[ai][bj][m][n] = __builtin_amdgcn_mfma_f32_16x16x32_bf16(Bt[n][k], At[m][k], acc[ai][bj][m][n], 0, 0, 0); __builtin_amdgcn_s_setprio(0); } while (0)
#define G8_WAIT_V(n) asm volatile("s_waitcnt vmcnt(" #n ")" ::: "memory")
#define G8_WAIT_L(n) asm volatile("s_waitcnt lgkmcnt(" #n ")" ::: "memory")
#define G8_BAR __builtin_amdgcn_s_barrier()
#define G8_SCHED __builtin_amdgcn_sched_barrier(0)
    Unit cur, nxt; int ui = 0;
    if (!ph.next(0, cur)) return;
    f32x4 acc[2][2][4][2];
#pragma unroll
    for (int a = 0; a < 2; ++a)
#pragma unroll
        for (int b = 0; b < 2; ++b)
#pragma unroll
            for (int m = 0; m < 4; ++m)
#pragma unroll
                for (int n = 0; n < 2; ++n) acc[a][b][m][n] = (f32x4){0.f, 0.f, 0.f, 0.f};
    bf16x8 At[4][2], B0[2][2], B1[2][2];
    const char* cA = cur.A; const char* cB = cur.B;
    if constexpr (SP2) {
        G8_STAGE(G8_SB(0, 0), cB, voffB); G8_STAGE(G8_SB(0, 1), cB + hstepB, voffB); G8_STAGE(G8_SA(0, 0), cA, voffA); G8_STAGE(G8_SA(0, 1), cA + hstepA, voffA);
        if (wr == 1) G8_BAR;
        G8_WAIT_V(2); G8_BAR;
        G8_STAGE(G8_SB(1, 0), cB + kstep, voffB); G8_STAGE(G8_SA(1, 0), cA + kstep, voffA); G8_STAGE(G8_SB(1, 1), cB + hstepB + kstep, voffB);
        G8_WAIT_V(6); G8_BAR;
    } else {
        G8_STAGE(G8_SB(0, 0), cB, voffB); G8_STAGE(G8_SA(0, 0), cA, voffA); G8_STAGE(G8_SB(0, 1), cB + hstepB, voffB); G8_STAGE(G8_SA(0, 1), cA + hstepA, voffA);
        if (wr == 1) G8_BAR;
        G8_WAIT_V(4); G8_BAR;
        G8_STAGE(G8_SB(1, 0), cB + kstep, voffB); G8_STAGE(G8_SA(1, 0), cA + kstep, voffA); G8_STAGE(G8_SB(1, 1), cB + hstepB + kstep, voffB);
        G8_WAIT_V(6); G8_BAR;
    }
    for (;;) {
        const bool has_next = ph.next(ui + 1, nxt);
        const char* nA = has_next ? nxt.A : cA; const char* nB = has_next ? nxt.B : cB;
#pragma unroll 1
        for (int t = 0; t < nt; t += 2) {
            const bool last = (t == nt - 2);
            const char* a1 = cA + (size_t)(t + 1) * kstep;
            const char* a2 = last ? nA : cA + (size_t)(t + 2) * kstep; const char* b2 = last ? nB : cB + (size_t)(t + 2) * kstep;
            const char* a3 = a2 + kstep; const char* b3 = b2 + kstep;
            if constexpr (SP2) {
            G8_LDB(B0, 0, 0); G8_LDB(B1, 0, 1); G8_SCHED; G8_LDA(At, 0, 0); G8_STAGE(G8_SA(1, 1), a1 + hstepA, voffA);
            G8_WAIT_V(8); G8_WAIT_L(0); G8_BAR; G8_MMA(0, 0, At, B0); G8_MMA(0, 1, At, B1); G8_BAR; G8_SCHED;
            G8_LDA(At, 0, 1); G8_STAGE(G8_SB(0, 0), b2, voffB); G8_STAGE(G8_SB(0, 1), b2 + hstepB, voffB); G8_STAGE(G8_SA(0, 0), a2, voffA);
            G8_WAIT_V(8); G8_WAIT_L(0); G8_BAR; G8_MMA(1, 0, At, B0); G8_MMA(1, 1, At, B1); G8_BAR; G8_SCHED;
            G8_LDB(B0, 1, 0); G8_LDB(B1, 1, 1); G8_SCHED; G8_LDA(At, 1, 0); G8_STAGE(G8_SA(0, 1), a2 + hstepA, voffA);
            G8_WAIT_V(8); G8_WAIT_L(0); G8_BAR; G8_MMA(0, 0, At, B0); G8_MMA(0, 1, At, B1); G8_BAR; G8_SCHED;
            G8_LDA(At, 1, 1); G8_STAGE(G8_SB(1, 0), b3, voffB); G8_STAGE(G8_SB(1, 1), b3 + hstepB, voffB); G8_STAGE(G8_SA(1, 0), a3, voffA);
            G8_WAIT_V(8); G8_WAIT_L(0); G8_BAR; G8_MMA(1, 0, At, B0); G8_MMA(1, 1, At, B1); G8_BAR; G8_SCHED;
            } else {
            G8_LDB(B0, 0, 0); G8_SCHED; G8_LDA(At, 0, 0); G8_STAGE(G8_SA(1, 1), a1 + hstepA, voffA);
            G8_WAIT_L(8); G8_BAR; G8_WAIT_L(0); G8_MMA(0, 0, At, B0); G8_BAR; G8_SCHED;
            G8_LDB(B1, 0, 1); G8_STAGE(G8_SB(0, 0), b2, voffB);
            G8_BAR; G8_WAIT_L(0); G8_MMA(0, 1, At, B1); G8_BAR;
            G8_LDA(At, 0, 1); G8_STAGE(G8_SA(0, 0), a2, voffA);
            G8_BAR; G8_WAIT_L(0); G8_MMA(1, 0, At, B0); G8_BAR; G8_SCHED;
            G8_STAGE(G8_SB(0, 1), b2 + hstepB, voffB);
            G8_WAIT_V(6); G8_BAR; G8_MMA(1, 1, At, B1); G8_BAR;
            G8_LDB(B0, 1, 0); G8_SCHED; G8_LDA(At, 1, 0); G8_STAGE(G8_SA(0, 1), a2 + hstepA, voffA);
            G8_WAIT_L(8); G8_BAR; G8_WAIT_L(0); G8_MMA(0, 0, At, B0); G8_BAR; G8_SCHED;
            G8_LDB(B1, 1, 1); G8_STAGE(G8_SB(1, 0), b3, voffB);
            G8_BAR; G8_WAIT_L(0); G8_MMA(0, 1, At, B1); G8_BAR;
            G8_LDA(At, 1, 1); G8_STAGE(G8_SA(1, 0), a3, voffA);
            G8_BAR; G8_WAIT_L(0); G8_MMA(1, 0, At, B0); G8_BAR; G8_SCHED;
            G8_STAGE(G8_SB(1, 1), b3 + hstepB, voffB);
            G8_WAIT_V(6); G8_BAR; G8_MMA(1, 1, At, B1); G8_BAR;
            }
        }
        if constexpr (ALIGN_EPI) { if (wr == 0) G8_BAR; }
        ph.epi(acc, cur, wr, wc, fr, fq);
        if (!has_next) break;
#pragma unroll
        for (int a = 0; a < 2; ++a)
#pragma unroll
            for (int b = 0; b < 2; ++b)
#pragma unroll
                for (int m = 0; m < 4; ++m)
#pragma unroll
                    for (int n = 0; n < 2; ++n) acc[a][b][m][n] = (f32x4){0.f, 0.f, 0.f, 0.f};
        cur = nxt; cA = nA; cB = nB; ++ui;
        if constexpr (ALIGN_EPI) { if (wr == 1) G8_BAR; }
    }
    G8_WAIT_V(0);
    if constexpr (!ALIGN_EPI) { if (wr == 0) G8_BAR; }
    G8_BAR;
#undef G8_SA
#undef G8_SB
#undef G8_STAGE
#undef G8_LDA
#undef G8_LDB
#undef G8_MMA
#undef G8_WAIT_V
#undef G8_WAIT_L
#undef G8_BAR
#undef G8_SCHED
}
}

struct TJob { const float* src; bf16_t* dst; const float* gain; int K, Nsrc, Ndst, map, nitems; };

DI int map_col(int map, int n0) {
    if (map == 1) return n0 + (n0 >= 6144 ? 16 : 0);
    if (map == 2) { const int t = n0 >> 8, r = n0 & 255; return (r < 128) ? 128 * t + r : DFF + 128 * t + (r - 128); }
    return n0;
}
constexpr int TR_SCR = 64 * 65 * 4;
static_assert(8 * TR_SCR <= LDS_MISC, "transpose scratch must stay below the barrier words");
DI void p0_transpose_item(const TJob& J, LAS float* scr, int item, int lane) {
    const int nblk = J.Ndst / 64, kb = item / nblk, nb = item % nblk, k0 = 64 * kb, n0 = 64 * nb, ns0 = map_col(J.map, n0);
    const float* src = J.src + (size_t)(k0 + (lane >> 4)) * J.Nsrc + ns0 + 4 * (lane & 15);
    f32x4 v[16];
#pragma unroll
    for (int i = 0; i < 16; ++i) v[i] = *(const f32x4*)(src + (size_t)(4 * i) * J.Nsrc);
    if (J.gain) {
#pragma unroll
        for (int i = 0; i < 16; ++i) v[i] *= J.gain[k0 + 4 * i + (lane >> 4)];
    }
#pragma unroll
    for (int i = 0; i < 16; ++i) { LAS float* d = scr + (4 * i + (lane >> 4)) * 65 + 4 * (lane & 15); d[0] = v[i].x; d[1] = v[i].y; d[2] = v[i].z; d[3] = v[i].w; }
    LDS_WAIT(); asm volatile("" ::: "memory");
    const int c = lane & 7;
#pragma unroll
    for (int j = 0; j < 8; ++j) { const int n = (lane >> 3) + 8 * j; const LAS float* s = scr + (8 * c) * 65 + n;
        u32x4 o; o.x = pk2(s[0 * 65], s[1 * 65]); o.y = pk2(s[2 * 65], s[3 * 65]); o.z = pk2(s[4 * 65], s[5 * 65]); o.w = pk2(s[6 * 65], s[7 * 65]);
        *(u32x4*)(J.dst + (size_t)(n0 + n) * J.K + k0 + 8 * c) = o; }
    LDS_WAIT(); asm volatile("" ::: "memory");
}
DI void p0_wps_item(const Params& p, bf16_t* WPS, int item, int lane) {
    const size_t e = (size_t)item * 512 + lane * 8; const float* src = p.w_pool + e;
    const f32x4 a = *(const f32x4*)src, b = *(const f32x4*)(src + 4);
    u32x4 o; o.x = pk2(a.x, a.y); o.y = pk2(a.z, a.w); o.z = pk2(b.x, b.y); o.w = pk2(b.z, b.w);
    *(u32x4*)(WPS + e) = o;
}
DI void p0_plb_item(const Params& p, bf16_t* PLB, int item, int lane) {
    const size_t e = (size_t)item * 512 + lane * 8; const size_t row = e / PLE;
    const float* src = (row < MP) ? p.p_prompt + e : p.p_sample + (e - (size_t)MP * PLE);
    const f32x4 a = *(const f32x4*)src, b = *(const f32x4*)(src + 4);
    u32x4 o; o.x = pk2(a.x, a.y); o.y = pk2(a.z, a.w); o.z = pk2(b.x, b.y); o.w = pk2(b.z, b.w);
    *(u32x4*)(PLB + e) = o;
}

DI void p0_xprep_unit(const Params& p, LAS unsigned char* lds, int u, int wave) {
    const int lane = lane_id(), tid = wave * 64 + lane;
    unsigned char* ws = p.ws;
    bf16_t* XB = (bf16_t*)(ws + WS_XB); float* RSTD1 = (float*)(ws + WS_RSTD1); float* BCUM = (float*)(ws + WS_BCUM); float* LAM = (float*)(ws + WS_LAM);
    LAS unsigned char* WG = lds; LAS float* GL = (LAS float*)(lds + 65536); LAS float* RS = (LAS float*)(lds + 73728);
    for (int pr = tid; pr < 4096; pr += NTHREADS) { const int k8 = pr >> 4, n = pr & 15; float w[8];
#pragma unroll
        for (int j = 0; j < 8; ++j) { const int k = 8 * k8 + j; w[j] = p.w_in[(size_t)k * INW + 6144 + n] * p.norm_mix[k]; }
        u32x4 o; o.x = pk2(w[0], w[1]); o.y = pk2(w[2], w[3]); o.z = pk2(w[4], w[5]); o.w = pk2(w[6], w[7]);
        *(LAS u32x4*)(WG + (size_t)pr * 16) = o; }
    __syncthreads();
    {
        const int fr = lane & 15, fq = lane >> 4; const int row = 128 * u + 16 * wave + fr;
        const float* xr = (row < MP) ? p.x_prompt + (size_t)row * D : p.x_sample + (size_t)(row - MP) * D;
        f32x4 acc = {0.f, 0.f, 0.f, 0.f}; float ss = 0.f;
#pragma unroll 8
        for (int s = 0; s < 64; ++s) {
            const f32x4 a = *(const f32x4*)(xr + 32 * s + 8 * fq), b = *(const f32x4*)(xr + 32 * s + 8 * fq + 4);
            ss += (a.x * a.x + a.y * a.y) + (a.z * a.z + a.w * a.w) + (b.x * b.x + b.y * b.y) + (b.z * b.z + b.w * b.w);
            u32x4 o; o.x = pk2(a.x, a.y); o.y = pk2(a.z, a.w); o.z = pk2(b.x, b.y); o.w = pk2(b.z, b.w);
            *(u32x4*)(XB + (size_t)row * D + 32 * s + 8 * fq) = o;
            const bf16x8 af = __builtin_bit_cast(bf16x8, o);
            const bf16x8 bfr = *(const LAS bf16x8*)(WG + (size_t)((4 * s + fq) * 16 + fr) * 16);
            acc = __builtin_amdgcn_mfma_f32_16x16x32_bf16(af, bfr, acc, 0, 0, 0);
        }
        ss += __shfl_xor(ss, 16); ss += __shfl_xor(ss, 32);
        const float rstd = 1.0f / sqrtf(ss * (1.0f / D) + EPS);
        if (fq == 0) { RS[16 * wave + fr] = rstd; RSTD1[row] = rstd; }
        LDS_WAIT(); asm volatile("" ::: "memory");
#pragma unroll
        for (int j = 0; j < 4; ++j) { const int tl = 16 * wave + 4 * fq + j; GL[tl * 16 + fr] = acc[j] * RS[tl]; }
    }
    __syncthreads();
    const bool sample = (u == 64);
#pragma unroll 1
    for (int cc = 0; cc < 2; ++cc) {
        const int c = tid + 512 * cc; float wg[16];
#pragma unroll
        for (int j = 0; j < 16; ++j) wg[j] = p.w_gate_up[j * KW + c];
        const float bg = p.b_gate[c]; float cum = 0.f;
#pragma unroll 2
        for (int t = 0; t < 128; ++t) {
            const f32x4 g0 = *(const LAS f32x4*)(GL + t * 16), g1 = *(const LAS f32x4*)(GL + t * 16 + 4), g2 = *(const LAS f32x4*)(GL + t * 16 + 8), g3 = *(const LAS f32x4*)(GL + t * 16 + 12);
            float z = bg;
            z += g0.x * wg[0] + g0.y * wg[1] + g0.z * wg[2] + g0.w * wg[3];
            z += g1.x * wg[4] + g1.y * wg[5] + g1.z * wg[6] + g1.w * wg[7];
            z += g2.x * wg[8] + g2.y * wg[9] + g2.z * wg[10] + g2.w * wg[11];
            z += g3.x * wg[12] + g3.y * wg[13] + g3.z * wg[14] + g3.w * wg[15];
            const float gl = logsigmoidf_(z) * (1.0f / 16.0f);
            const int row = 128 * u + t;
            if (sample) { BCUM[(size_t)row * KW + c] = 0.f; LAM[(size_t)(128 + t) * KW + c] = __expf(gl); }
            else { cum = ((t & 63) == 0) ? gl : cum + gl; BCUM[(size_t)row * KW + c] = cum; if ((t & 63) == 63) LAM[(size_t)(row >> 6) * KW + c] = __expf(cum); }
        }
    }
    __syncthreads();
}

constexpr int NXPREP = 65;
DI void phase_p0(const Params& p, LAS unsigned char* lds, int wave) {
    const int lane = lane_id();
    unsigned char* ws = p.ws;
#ifndef P0_REP
#define P0_REP 0
#endif
    if ((int)blockIdx.x < NXPREP) { p0_xprep_unit(p, lds, blockIdx.x, wave); if (P0_REP & 1) p0_xprep_unit(p, lds, blockIdx.x, wave); return; }
    TJob J[8];
    J[0] = TJob{p.w_in, (bf16_t*)(ws + WS_WIN), p.norm_mix, D, INW, NIN, 1, (D / 64) * (NIN / 64)};
    J[1] = TJob{p.w_up, (bf16_t*)(ws + WS_WUP), p.norm_ffn, D, NUP, NUP, 2, (D / 64) * (NUP / 64)};
    J[2] = TJob{p.w_down, (bf16_t*)(ws + WS_WD), nullptr, DFF, D, D, 0, (DFF / 64) * (D / 64)};
    J[3] = TJob{p.w_branch_a, (bf16_t*)(ws + WS_WA), p.gla_norm, D, D, D, 0, (D / 64) * (D / 64)};
    J[4] = TJob{p.w_out, (bf16_t*)(ws + WS_WO), nullptr, D, D, D, 0, (D / 64) * (D / 64)};
    J[5] = TJob{p.w_ple_gate, (bf16_t*)(ws + WS_WPG), p.norm_ple, D, D, D, 0, (D / 64) * (D / 64)};
    J[6] = TJob{p.w_ple, (bf16_t*)(ws + WS_WPLE), nullptr, PLE, D, D, 0, (PLE / 64) * (D / 64)};
    J[7] = TJob{p.w_branch_b, (bf16_t*)(ws + WS_WBT), p.pool_scale, POOLW, D, D, 0, (POOLW / 64) * (D / 64)};
    LAS float* scr = (LAS float*)(lds + wave * TR_SCR);
    const int gw = ((int)blockIdx.x - NXPREP) * NWAVES + wave, NGW = ((int)gridDim.x - NXPREP) * NWAVES;
    for (int rep = 0; rep < ((P0_REP & 2) ? 2 : 1); ++rep) {
    int base = 0;
#pragma unroll
    for (int j = 0; j < 8; ++j) {
        const int n = J[j].nitems;
        int it = gw - (base % NGW); if (it < 0) it += NGW;
        for (; it < n; it += NGW) p0_transpose_item(J[j], scr, it, lane);
        base += n;
    }
    }
    for (int it = gw; it < (POOLW * 256) / 512; it += NGW) p0_wps_item(p, (bf16_t*)(ws + WS_WPS), it, lane);
    for (int it = gw; it < (M * PLE) / 512; it += NGW) p0_plb_item(p, (bf16_t*)(ws + WS_PLB), it, lane);
}

#define MFMA32(a, b, c) __builtin_amdgcn_mfma_f32_32x32x16_bf16((a), (b), (c), 0, 0, 0)
typedef LAS s16x4* lds_s16x4_p;
DI s16x4 tr_read(LAS unsigned char* a) { return __builtin_amdgcn_ds_read_tr16_b64_v4i16((lds_s16x4_p)a); }
DI bf16x8 cat8(s16x4 lo, s16x4 hi) { return __builtin_shufflevector(lo, hi, 0, 1, 2, 3, 4, 5, 6, 7); }
DI bf16x8 ld_perm(const bf16_t* p) {
    const u32x2 a = *(const u32x2*)p, b = *(const u32x2*)(p + 8);
    u32x4 r; r.x = a.x; r.y = a.y; r.z = b.x; r.w = b.y; return __builtin_bit_cast(bf16x8, r);
}
template <int S> DI bf16x8 pack_step(const f32x16& x) {
    u32x4 r; r.x = pk2(x[8 * S + 0], x[8 * S + 1]); r.y = pk2(x[8 * S + 2], x[8 * S + 3]); r.z = pk2(x[8 * S + 4], x[8 * S + 5]); r.w = pk2(x[8 * S + 6], x[8 * S + 7]);
    return __builtin_bit_cast(bf16x8, r);
}
DI f32x16 zero16() { f32x16 z;
#pragma unroll
    for (int i = 0; i < 16; ++i) z[i] = 0.f; return z; }

constexpr int SC_QI = 0, SC_KI = 32768, SC_KDI = 65536, SC_LMI = 131072, SC_VI = 133120, SC_BYTES = 141312;
static_assert(SC_BYTES <= LDS_MISC, "scan LDS map");
DI void dma16(const void* g, LAS unsigned char* l) { __builtin_amdgcn_global_load_lds((const unsigned*)g, (LAS unsigned*)l, 16, 0, 0); }
DI bf16x8 lds_perm(LAS unsigned char* a) {
    const u32x2 x = *(const LAS u32x2*)a, y = *(const LAS u32x2*)(a + 1024);
    u32x4 r; r.x = x.x; r.y = x.y; r.z = y.x; r.w = y.y; return __builtin_bit_cast(bf16x8, r);
}
DI void mask_diag(f32x16& a, int c, int h) {
#pragma unroll
    for (int r = 0; r < 16; ++r) { const int sloc = (r & 3) + 8 * (r >> 2) + 4 * h; a[r] = (sloc <= c) ? a[r] : 0.f; }
}
DI void scan_task(const Params& p, LAS unsigned char* lds, int task) {
    unsigned char* ws = p.ws;
    const bf16_t* QB = (const bf16_t*)(ws + WS_QB); const bf16_t* KB = (const bf16_t*)(ws + WS_KB); const bf16_t* KD = (const bf16_t*)(ws + WS_KD);
    const bf16_t* V = (const bf16_t*)(ws + WS_V); bf16_t* OG = (bf16_t*)(ws + WS_OG);
    const float* LAM = (const float*)(ws + WS_LAM); float* OSS = (float*)(ws + WS_OSS);
    const int sl = task & 15, hd = (task >> 4) & 3, b = task >> 6;
    f32x16 S[8];
#pragma unroll
    for (int db = 0; db < 8; ++db) S[db] = zero16();

#define SC_ISSUE_Q(ch_) do { const int _l = lane_id(); LAS unsigned char* _lb = lds; asm volatile("" : "+s"(_lb)); \
        const bf16_t* _q = QB + ((size_t)(b * SEQ + 64 * (ch_)) + _l) * KW + hd * 256; \
        _Pragma("unroll") for (int _i = 0; _i < 32; ++_i) dma16(_q + 8 * _i, _lb + SC_QI + _i * 1024); } while (0)
#define SC_ISSUE_KVKD(ch_) do { const int _l = lane_id(); const size_t _r0 = (size_t)(b * SEQ + 64 * (ch_)); const int _hi = _l >> 5, _pos = _l & 31; LAS unsigned char* _lb = lds; asm volatile("" : "+s"(_lb)); \
        const bf16_t* _k = KB + (_r0 + _l) * KW + hd * 256; \
        _Pragma("unroll") for (int _i = 0; _i < 32; ++_i) dma16(_k + 8 * _i, _lb + SC_KI + _i * 1024); \
        const bf16_t* _v = V + (_r0 + (_l >> 2)) * VW + hd * 512 + 32 * sl + 8 * (_l & 3); \
        _Pragma("unroll") for (int _i = 0; _i < 4; ++_i) dma16(_v + (size_t)_i * 16 * VW, _lb + SC_VI + ((ch_) & 1) * 4096 + _i * 1024); \
        const bf16_t* _kd = KD + (_r0 + _hi) * KW + hd * 256; \
        _Pragma("unroll") for (int _i = 0; _i < 32; ++_i) { const int _cc = _pos ^ (4 * (((2 * _i) & 3) | _hi)); dma16(_kd + (size_t)_i * 2 * KW + 8 * _cc, _lb + SC_KDI + ((ch_) & 1) * 32768 + _i * 1024); } \
        dma16(LAM + (size_t)(b * 32 + (ch_)) * KW + hd * 256 + 4 * _l, _lb + SC_LMI + ((ch_) & 1) * 1024); } while (0)

    SC_ISSUE_KVKD(0); SC_ISSUE_Q(0);
#pragma unroll 1
    for (int ch = 0; ch < 32; ++ch) {
        const int row0 = b * SEQ + 64 * ch;
        VM_WAIT();
        __builtin_amdgcn_sched_barrier(0);
        const int lane = lane_id();
        const int c = lane & 31, h = lane >> 5;
        const int i16 = lane & 15, q = i16 >> 2, pp = i16 & 3, jb = (lane >> 4) & 1;
        LAS unsigned char* VI = lds + SC_VI + (ch & 1) * 4096;
        LAS unsigned char* ka = lds + SC_KI + c * 16 + 8 * h;

#pragma unroll
        for (int tbi = 0; tbi < 2; ++tbi) {
            const int tb = 1 - tbi;
            LAS unsigned char* qa = lds + SC_QI + (32 * tb + c) * 16 + 8 * h;
            bf16x8 a0_0, a0_1, a1_0, a1_1;
            {   f32x16 att0 = zero16(), att1 = zero16();
#pragma unroll
                for (int st = 0; st < 16; ++st) {
                    const bf16x8 qf = lds_perm(qa + 2048 * st);
                    att0 = MFMA32(lds_perm(ka + 2048 * st), qf, att0);
                    if (tb == 1) att1 = MFMA32(lds_perm(ka + 512 + 2048 * st), qf, att1);
                    if ((st & 3) == 3) __builtin_amdgcn_sched_barrier(0);
                }
                if (tb == 1) mask_diag(att1, c, h); else mask_diag(att0, c, h);
                a0_0 = pack_step<0>(att0); a0_1 = pack_step<1>(att0);
                if (tb == 1) { a1_0 = pack_step<0>(att1); a1_1 = pack_step<1>(att1); }
            }
            if (tb == 0) {
                __builtin_amdgcn_sched_barrier(0);
                if (ch + 1 < 32) SC_ISSUE_KVKD(ch + 1);
                __builtin_amdgcn_sched_barrier(0);
            }
            f32x16 o = zero16();
            LAS unsigned char* vb = VI + ((4 * h + q) * 4 + 2 * jb + (pp >> 1)) * 16 + (pp & 1) * 8;
            { const bf16x8 vf = cat8(tr_read(vb), tr_read(vb + 8 * 64)); o = MFMA32(vf, a0_0, o); }
            { const bf16x8 vf = cat8(tr_read(vb + 16 * 64), tr_read(vb + 24 * 64)); o = MFMA32(vf, a0_1, o); }
            if (tb == 1) {
                { const bf16x8 vf = cat8(tr_read(vb + 32 * 64), tr_read(vb + 40 * 64)); o = MFMA32(vf, a1_0, o); }
                { const bf16x8 vf = cat8(tr_read(vb + 48 * 64), tr_read(vb + 56 * 64)); o = MFMA32(vf, a1_1, o); }
            }
#pragma unroll
            for (int db = 0; db < 8; ++db) {
                { const bf16x8 qf = lds_perm(qa + 4096 * db); o = MFMA32(pack_step<0>(S[db]), qf, o); }
                { const bf16x8 qf = lds_perm(qa + 4096 * db + 2048); o = MFMA32(pack_step<1>(S[db]), qf, o); }
                if (db & 1) __builtin_amdgcn_sched_barrier(0);
            }
            const int t = row0 + 32 * tb + c;
            float ss = 0.f;
#pragma unroll
            for (int r = 0; r < 16; ++r) ss += o[r] * o[r];
            { const auto sw = __builtin_amdgcn_permlane32_swap(__float_as_uint(ss), __float_as_uint(ss), false, false); ss = __uint_as_float(sw[0]) + __uint_as_float(sw[1]); }
            if (h == 0) OSS[(size_t)t * 64 + hd * 16 + sl] = ss;
            bf16_t* og = OG + (size_t)(row0 + 32 * tb) * VW + hd * 512 + 32 * sl + c * VW + 4 * h;
#pragma unroll
            for (int g = 0; g < 4; ++g) { u32x2 w; w.x = pk2(o[4 * g + 0], o[4 * g + 1]); w.y = pk2(o[4 * g + 2], o[4 * g + 3]); *(u32x2*)(og + 8 * g) = w; }
            __builtin_amdgcn_sched_barrier(0);
        }
        __builtin_amdgcn_sched_barrier(0);
        if (ch + 1 < 32) SC_ISSUE_Q(ch + 1);
        __builtin_amdgcn_sched_barrier(0);

        {
            LAS unsigned char* vb = VI + ((8 * h + q) * 4 + 2 * jb + (pp >> 1)) * 16 + (pp & 1) * 8;
            LAS unsigned char* kbase = lds + SC_KDI + (ch & 1) * 32768 + (8 * h + q) * 512 + (2 * jb + (pp >> 1)) * 16 + (pp & 1) * 8;
            LAS unsigned char* lm = lds + SC_LMI + (ch & 1) * 1024 + 16 * h;
#pragma unroll
            for (int db = 0; db < 8; ++db) {
#pragma unroll
                for (int g = 0; g < 4; ++g) { const f32x4 l4 = *(const LAS f32x4*)(lm + (32 * db + 8 * g) * 4);
                    S[db][4 * g + 0] *= l4.x; S[db][4 * g + 1] *= l4.y; S[db][4 * g + 2] *= l4.z; S[db][4 * g + 3] *= l4.w; }
                LAS unsigned char* kb = kbase + (((db & 3) ^ q) * 4) * 16 + (db >> 2) * 256;
#pragma unroll
                for (int ks = 0; ks < 4; ++ks) {
                    const bf16x8 kf = cat8(tr_read(kb + (16 * ks) * 512), tr_read(kb + (16 * ks + 4) * 512));
                    const bf16x8 vf = cat8(tr_read(vb + (16 * ks) * 64), tr_read(vb + (16 * ks + 4) * 64));
                    S[db] = MFMA32(kf, vf, S[db]);
                }
                __builtin_amdgcn_sched_barrier(0);
            }
        }
        asm volatile("" ::: "memory");
    }
#undef SC_ISSUE_Q
#undef SC_ISSUE_KVKD
    {   const int lane = lane_id();
        const unsigned voff = (unsigned)(((lane >> 5) * 4 * DV + (lane & 31)) * 4);
        const char* gbase = (const char*)(p.out + O_GLAP + ((size_t)(b * NH + hd) * DK) * DV + 32 * sl);
#pragma unroll
        for (int db = 0; db < 8; ++db) {
#pragma unroll
            for (int r = 0; r < 16; ++r) { const int dl = 32 * db + (r & 3) + 8 * (r >> 2); *(float*)(const_cast<char*>(gbase) + (size_t)dl * DV * 4 + voff) = S[db][r]; }
        }
    }
}

DI void sgla_task(const Params& p, int task, int lane) {
    unsigned char* ws = p.ws;
    const bf16_t* QB = (const bf16_t*)(ws + WS_QB); const bf16_t* KB = (const bf16_t*)(ws + WS_KB); const bf16_t* V = (const bf16_t*)(ws + WS_V);
    const float* LAM = (const float*)(ws + WS_LAM); float* OSP = (float*)(ws + WS_OSP);
    const int dblk = task & 7, hd = (task >> 3) & 3, b = task >> 5; const int row = MP + b;
    const size_t sbase = ((size_t)(b * NH + hd) * DK + 32 * dblk) * DV;
    const float* S0 = p.state_gla + sbase; float* So = p.out + O_GLAS + sbase;
    const int dl = lane & 31;
    const float lam_l = LAM[(size_t)(128 + b) * KW + hd * 256 + 32 * dblk + dl];
    const float k_l = bf1(KB[(size_t)row * KW + hd * 256 + 32 * dblk + dl]);
    const float q_l = bf1(QB[(size_t)row * KW + hd * 256 + 32 * dblk + dl]);
    f32x4 va, vb;
    { const u32x2 w = *(const u32x2*)(V + (size_t)row * VW + hd * 512 + 4 * lane); va = (f32x4){bflo(w.x), bfhi(w.x), bflo(w.y), bfhi(w.y)}; }
    { const u32x2 w = *(const u32x2*)(V + (size_t)row * VW + hd * 512 + 256 + 4 * lane); vb = (f32x4){bflo(w.x), bfhi(w.x), bflo(w.y), bfhi(w.y)}; }
    f32x4 oa = {0.f, 0.f, 0.f, 0.f}, ob = {0.f, 0.f, 0.f, 0.f};
#pragma unroll 1
    for (int d0 = 0; d0 < 32; d0 += 8) {
        f32x4 ra[8], rb[8];
#pragma unroll
        for (int i = 0; i < 8; ++i) { ra[i] = __builtin_nontemporal_load((const f32x4*)(S0 + (size_t)(d0 + i) * DV + 4 * lane)); rb[i] = __builtin_nontemporal_load((const f32x4*)(S0 + (size_t)(d0 + i) * DV + 256 + 4 * lane)); }
#pragma unroll
        for (int i = 0; i < 8; ++i) { const int d = d0 + i;
            const float lam = __uint_as_float(__builtin_amdgcn_readlane(__float_as_uint(lam_l), d)), kk = __uint_as_float(__builtin_amdgcn_readlane(__float_as_uint(k_l), d)), qq = __uint_as_float(__builtin_amdgcn_readlane(__float_as_uint(q_l), d));
            const f32x4 sa = ra[i] * lam + va * kk, sb = rb[i] * lam + vb * kk;
            __builtin_nontemporal_store(sa, (f32x4*)(So + (size_t)d * DV + 4 * lane)); __builtin_nontemporal_store(sb, (f32x4*)(So + (size_t)d * DV + 256 + 4 * lane));
            oa += sa * qq; ob += sb * qq; }
    }
    float* op = OSP + ((size_t)(b * NH + hd) * 8 + dblk) * DV;
    *(f32x4*)(op + 4 * lane) = oa; *(f32x4*)(op + 256 + 4 * lane) = ob;
}

DI void pmix_task(const Params& p, int t, int lane) {
    unsigned char* ws = p.ws;
    const float* U = (const float*)(ws + WS_U); bf16_t* PM = (bf16_t*)(ws + WS_PM);
    if (t < MP) {
        const int b = t >> 11, pos = t & 2047;
#pragma unroll
        for (int i = 0; i < 4; ++i) {
            const int w = 2 << i, c = 256 * i + 4 * lane; const int cnt = (pos + 1 < w) ? pos + 1 : w;
            const f32x4 u0 = *(const f32x4*)(U + (size_t)t * POOLW + c); f32x4 s = u0;
#pragma unroll
            for (int j = 1; j < w; ++j) {
                const bool in = j < cnt; const f32x4 v = *(const f32x4*)(U + (size_t)(in ? t - j : t) * POOLW + c); const float m = in ? 1.f : 0.f; s += v * m; }
            const float inv = 1.0f / (float)cnt; const f32x4 mx = s * inv - u0;
            u32x2 o; o.x = pk2(mx.x, mx.y); o.y = pk2(mx.z, mx.w); *(u32x2*)(PM + (size_t)t * POOLW + c) = o;
            if (pos >= SEQ - 15) *(f32x4*)(p.out + O_POOLP + ((size_t)b * 15 + (pos - (SEQ - 15))) * POOLW + c) = u0;
        }
    } else {
        const int b = t - MP; const float* sp = p.state_pool + (size_t)b * 15 * POOLW; float* po = p.out + O_POOLS + (size_t)b * 15 * POOLW;
#pragma unroll
        for (int i = 0; i < 4; ++i) {
            const int w = 2 << i, c = 256 * i + 4 * lane;
            const f32x4 u0 = *(const f32x4*)(U + (size_t)t * POOLW + c); f32x4 s = u0;
#pragma unroll
            for (int j = 1; j < w; ++j) s += *(const f32x4*)(sp + (size_t)(15 - j) * POOLW + c);
            const float inv = 1.0f / (float)w; const f32x4 mx = s * inv - u0;
            u32x2 o; o.x = pk2(mx.x, mx.y); o.y = pk2(mx.z, mx.w); *(u32x2*)(PM + (size_t)t * POOLW + c) = o;
#pragma unroll
            for (int r = 0; r < 14; ++r) *(f32x4*)(po + (size_t)r * POOLW + c) = *(const f32x4*)(sp + (size_t)(r + 1) * POOLW + c);
            *(f32x4*)(po + (size_t)14 * POOLW + c) = u0;
        }
    }
}

#ifndef P2_REP
#define P2_REP 0
#endif
DI void phase_p2(const Params& p, LAS unsigned char* lds, int wave) {
    const int G = gridDim.x;
    if (wave == 0) { const int vc = (G % 8 == 0) ? ((int)blockIdx.x % 8) * (G / 8) + (int)blockIdx.x / 8 : (int)blockIdx.x;
        for (int rep = 0; rep < ((P2_REP & 1) ? 2 : 1); ++rep) for (int task = vc; task < NB * NH * NSL; task += G) scan_task(p, lds, task); }
    else {
        const int lane = lane_id(); const int gw = (int)blockIdx.x * 7 + (wave - 1), NGW = G * 7;
        for (int rep = 0; rep < ((P2_REP & 2) ? 2 : 1); ++rep) {
        for (int t = gw; t < M; t += NGW) pmix_task(p, t, lane);
        for (int task = gw; task < MS * NH * 8; task += NGW) sgla_task(p, task, lane); }
    }
}

DI void ogn_task(const Params& p, int t, int lane) {
    unsigned char* ws = p.ws;
    bf16_t* OG = (bf16_t*)(ws + WS_OG); const float* OSS = (const float*)(ws + WS_OSS); const float* OSP = (const float*)(ws + WS_OSP); const bf16_t* SR = (const bf16_t*)(ws + WS_SR);
    if (t < MP) {
#pragma unroll
        for (int hd = 0; hd < 4; ++hd) {
            const float* sp = OSS + (size_t)t * 64 + hd * 16; const f32x4 a = *(const f32x4*)sp, b = *(const f32x4*)(sp + 4), c = *(const f32x4*)(sp + 8), d = *(const f32x4*)(sp + 12);
            const float ss = ((a.x + a.y) + (a.z + a.w)) + ((b.x + b.y) + (b.z + b.w)) + ((c.x + c.y) + (c.z + c.w)) + ((d.x + d.y) + (d.z + d.w));
            const float rstd = 1.0f / sqrtf(ss * (1.0f / DV) + EPS);
            bf16_t* op = OG + (size_t)t * VW + hd * 512 + 8 * lane; const u32x4 w = *(const u32x4*)op; const u32x4 g = *(const u32x4*)(SR + (size_t)t * VW + hd * 512 + 8 * lane);
            u32x4 o; o.x = pk2(bflo(w.x) * rstd * bflo(g.x), bfhi(w.x) * rstd * bfhi(g.x)); o.y = pk2(bflo(w.y) * rstd * bflo(g.y), bfhi(w.y) * rstd * bfhi(g.y));
            o.z = pk2(bflo(w.z) * rstd * bflo(g.z), bfhi(w.z) * rstd * bfhi(g.z)); o.w = pk2(bflo(w.w) * rstd * bflo(g.w), bfhi(w.w) * rstd * bfhi(g.w));
            *(u32x4*)op = o;
        }
    } else {
        const int b = t - MP;
#pragma unroll
        for (int hd = 0; hd < 4; ++hd) {
            f32x4 oa = {0.f, 0.f, 0.f, 0.f}, ob = {0.f, 0.f, 0.f, 0.f};
#pragma unroll
            for (int k = 0; k < 8; ++k) { const float* op = OSP + ((size_t)(b * NH + hd) * 8 + k) * DV + 8 * lane; oa += *(const f32x4*)op; ob += *(const f32x4*)(op + 4); }
            float ss = (oa.x * oa.x + oa.y * oa.y) + (oa.z * oa.z + oa.w * oa.w) + (ob.x * ob.x + ob.y * ob.y) + (ob.z * ob.z + ob.w * ob.w);
            ss = wave_sum(ss);
            const float rstd = 1.0f / sqrtf(ss * (1.0f / DV) + EPS);
            const u32x4 w = *(const u32x4*)(SR + (size_t)t * VW + hd * 512 + 8 * lane);
            u32x4 o; o.x = pk2(oa.x * rstd * bflo(w.x), oa.y * rstd * bfhi(w.x)); o.y = pk2(oa.z * rstd * bflo(w.y), oa.w * rstd * bfhi(w.y));
            o.z = pk2(ob.x * rstd * bflo(w.z), ob.y * rstd * bfhi(w.z)); o.w = pk2(ob.z * rstd * bflo(w.w), ob.w * rstd * bfhi(w.w));
            *(u32x4*)(OG + (size_t)t * VW + hd * 512 + 8 * lane) = o;
        }
    }
}
DI void phase_p3(const Params& p, int wave) {
    const int lane = lane_id();
    const int gw = (int)blockIdx.x * NWAVES + wave, NGW = gridDim.x * NWAVES;
    for (int t = gw; t < M; t += NGW) ogn_task(p, t, lane);
}

DI float row_rstd(const float* SS, const float* SSs, int row, int lane) {
    float v = (row < MP) ? ((lane < 32) ? SS[(size_t)row * 32 + lane] : 0.f) : (SSs[(size_t)(row - MP) * 128 + lane] + SSs[(size_t)(row - MP) * 128 + 64 + lane]);
    v = wave_sum(v);
    return 1.0f / sqrtf(v * (1.0f / D) + EPS);
}

struct F8 { f32x4 a, b; };
DI F8 unpack8(u32x4 w, float s) { F8 r; r.a = (f32x4){bflo(w.x) * s, bfhi(w.x) * s, bflo(w.y) * s, bfhi(w.y) * s}; r.b = (f32x4){bflo(w.z) * s, bfhi(w.z) * s, bflo(w.w) * s, bfhi(w.w) * s}; return r; }
DI F8 ld8(const float* q) { F8 r; r.a = *(const f32x4*)q; r.b = *(const f32x4*)(q + 4); return r; }
DI void st8(float* q, const F8& v) { *(f32x4*)q = v.a; *(f32x4*)(q + 4) = v.b; }
DI f32x4 silu4(f32x4 x) { return (f32x4){siluf_(x.x), siluf_(x.y), siluf_(x.z), siluf_(x.w)}; }
DI void conv_task(const Params& p, int t, int lane) {
    unsigned char* ws = p.ws;
    const bf16_t* GU = (const bf16_t*)(ws + WS_GU); const float* SS1 = (const float*)(ws + WS_SS1); const float* SS1S = (const float*)(ws + WS_SS1S); bf16_t* ACT = (bf16_t*)(ws + WS_ACT);
    const bool prompt = t < MP; const int b = prompt ? (t >> 11) : (t - MP), pos = prompt ? (t & 2047) : 2;
    const float r0 = row_rstd(SS1, SS1S, t, lane);
    const float r1 = (prompt && pos >= 1) ? row_rstd(SS1, SS1S, t - 1, lane) : 0.f;
    const float r2 = (prompt && pos >= 2) ? row_rstd(SS1, SS1S, t - 2, lane) : 0.f;
    const bf16_t* g0p = GU + (size_t)t * NUP; const bf16_t* g1p = GU + (size_t)((prompt && pos >= 1) ? t - 1 : t) * NUP; const bf16_t* g2p = GU + (size_t)((prompt && pos >= 2) ? t - 2 : t) * NUP;
    const float* sc = p.state_conv + (size_t)b * 2 * DFF;
    for (int v = lane; v < DFF / 8; v += 64) {
        const int ch0 = 8 * v, pn = ch0 >> 7, r = ch0 & 127, gcol = 256 * pn + r, ucol = gcol + 128;
        const F8 g0 = unpack8(*(const u32x4*)(g0p + gcol), r0), up = unpack8(*(const u32x4*)(g0p + ucol), r0);
        F8 g1, g2;
        if (prompt) { g1 = unpack8(*(const u32x4*)(g1p + gcol), r1); g2 = unpack8(*(const u32x4*)(g2p + gcol), r2); }
        else { g1 = ld8(sc + DFF + ch0); g2 = ld8(sc + ch0); }
        const F8 w0 = ld8(p.conv_w + ch0), w1 = ld8(p.conv_w + DFF + ch0), w2 = ld8(p.conv_w + 2 * DFF + ch0), cb = ld8(p.conv_b + ch0);
        const f32x4 ga = cb.a + w0.a * g2.a + w1.a * g1.a + w2.a * g0.a, gb = cb.b + w0.b * g2.b + w1.b * g1.b + w2.b * g0.b;
        const f32x4 aa = silu4(ga) * up.a, ab = silu4(gb) * up.b;
        u32x4 o; o.x = pk2(aa.x, aa.y); o.y = pk2(aa.z, aa.w); o.z = pk2(ab.x, ab.y); o.w = pk2(ab.z, ab.w);
        *(u32x4*)(ACT + (size_t)t * DFF + ch0) = o;
        if (prompt) { if (pos >= SEQ - 2) st8(p.out + O_CONVP + ((size_t)b * 2 + (pos - (SEQ - 2))) * DFF + ch0, g0); }
        else { float* co = p.out + O_CONVS + (size_t)b * 2 * DFF + ch0; st8(co, g1); st8(co + DFF, g0); }
    }
}
DI void phase_conv(const Params& p, int wave) {
    const int lane = lane_id();
    const int gw = (int)blockIdx.x * NWAVES + wave, NGW = gridDim.x * NWAVES;
    for (int t = gw; t < M; t += NGW) conv_task(p, t, lane);
}

DI void phase_final(const Params& p, int wave) {
    const int lane = lane_id();
    const int gw = (int)blockIdx.x * NWAVES + wave, NGW = gridDim.x * NWAVES;
    const float* H3 = (const float*)(p.ws + WS_H3); const float* SS3 = (const float*)(p.ws + WS_SS3); const float* SS3S = (const float*)(p.ws + WS_SS3S);
    for (int t = gw; t < M; t += NGW) {
        const float rs = row_rstd(SS3, SS3S, t, lane);
        float* yo = (t < MP) ? p.out + O_YP + (size_t)t * D : p.out + O_YS + (size_t)(t - MP) * D;
#pragma unroll
        for (int i = 0; i < 8; ++i) { const int c = 256 * i + 4 * lane; const f32x4 hv = *(const f32x4*)(H3 + (size_t)t * D + c), g = *(const f32x4*)(p.norm_final + c);
            *(f32x4*)(yo + c) = hv * rs * g; }
    }
}

#define EPI_ARGS const f32x4 (&acc)[2][2][4][2], const g8::Unit& u, int wr, int wc, int fr, int fq
#define EPI_ROWS(ROWVAR) _Pragma("unroll") for (int ai = 0; ai < 2; ++ai) _Pragma("unroll") for (int m = 0; m < 4; ++m) { const int ROWVAR = u.pm * 256 + ai * 128 + wr * 64 + m * 16 + fr; if (ROWVAR < M) {
#define EPI_COLS(COLVAR) _Pragma("unroll") for (int bj = 0; bj < 2; ++bj) { const int COLVAR = bj * 128 + wc * 32 + 8 * fq; const f32x4 v0 = acc[ai][bj][m][0], v1 = acc[ai][bj][m][1];
#define EPI_END } } }
DI u32x4 pk8(f32x4 a, f32x4 b) { u32x4 o; o.x = pk2(a.x, a.y); o.y = pk2(a.z, a.w); o.z = pk2(b.x, b.y); o.w = pk2(b.z, b.w); return o; }
DI f32x4 exp4(f32x4 x) { return (f32x4){__expf(x.x), __expf(x.y), __expf(x.z), __expf(x.w)}; }
DI f32x4 sig4(f32x4 x) { return (f32x4){sigmoidf_(x.x), sigmoidf_(x.y), sigmoidf_(x.z), sigmoidf_(x.w)}; }
DI f32x4 bf4lo(u32x4 w) { return (f32x4){bflo(w.x), bfhi(w.x), bflo(w.y), bfhi(w.y)}; }
DI f32x4 bf4hi(u32x4 w) { return (f32x4){bflo(w.z), bfhi(w.z), bflo(w.w), bfhi(w.w)}; }
DI float sum4(f32x4 a) { return (a.x + a.y) + (a.z + a.w); }

struct PhaseIn {
    static constexpr int LDA = D, LDB = D, KT = D / 64;
    const Params& p; int G, c;
    DI bool next(int i, g8::Unit& u) const { int pm, pn; if (!g8::grid_order(NTM, 44, G, c, i, pm, pn)) return false;
        u.pm = pm; u.pn = pn; u.A = (const char*)(p.ws + WS_XB) + (size_t)pm * 256 * D * 2; u.B = (const char*)(p.ws + WS_WIN) + (size_t)pn * 256 * D * 2; return true; }
    DI void epi(EPI_ARGS) const {
        unsigned char* ws = p.ws; const float* RSTD1 = (const float*)(ws + WS_RSTD1); const float* BCUM = (const float*)(ws + WS_BCUM);
        const int pn = u.pn;
        if (pn < 4) {
            bf16_t* QB = (bf16_t*)(ws + WS_QB);
            EPI_ROWS(row) const float rs = RSTD1[row] * 0.0625f; EPI_COLS(col) const size_t o = (size_t)row * KW + pn * 256 + col;
                const f32x4 e0 = exp4(*(const f32x4*)(BCUM + o)), e1 = exp4(*(const f32x4*)(BCUM + o + 4));
                *(u32x4*)(QB + o) = pk8(v0 * rs * e0, v1 * rs * e1); EPI_END
        } else if (pn < 8) {
            bf16_t* KB = (bf16_t*)(ws + WS_KB); bf16_t* KD = (bf16_t*)(ws + WS_KD);
            EPI_ROWS(row) const float rs = RSTD1[row]; const int lrow = (row < MP) ? (row | 63) : row; EPI_COLS(col) const size_t o = (size_t)row * KW + (pn - 4) * 256 + col, ol = (size_t)lrow * KW + (pn - 4) * 256 + col;
                const f32x4 b0 = *(const f32x4*)(BCUM + o), b1 = *(const f32x4*)(BCUM + o + 4), l0 = *(const f32x4*)(BCUM + ol), l1 = *(const f32x4*)(BCUM + ol + 4);
                const f32x4 k0 = v0 * rs, k1 = v1 * rs;
                *(u32x4*)(KB + o) = pk8(k0 * exp4(-b0), k1 * exp4(-b1)); *(u32x4*)(KD + o) = pk8(k0 * exp4(l0 - b0), k1 * exp4(l1 - b1)); EPI_END
        } else if (pn < 16) {
            bf16_t* V = (bf16_t*)(ws + WS_V);
            EPI_ROWS(row) const float rs = RSTD1[row]; EPI_COLS(col) *(u32x4*)(V + (size_t)row * VW + (pn - 8) * 256 + col) = pk8(v0 * rs, v1 * rs); EPI_END
        } else if (pn < 24) {
            bf16_t* SR = (bf16_t*)(ws + WS_SR);
            EPI_ROWS(row) const float rs = RSTD1[row]; EPI_COLS(col) const f32x4 a = v0 * rs, b = v1 * rs; *(u32x4*)(SR + (size_t)row * VW + (pn - 16) * 256 + col) = pk8(a * sig4(a), b * sig4(b)); EPI_END
        } else if (pn < 28) {
            float* U = (float*)(ws + WS_U);
            EPI_ROWS(row) const float rs = RSTD1[row]; EPI_COLS(col) float* o = U + (size_t)row * POOLW + (pn - 24) * 256 + col; *(f32x4*)o = v0 * rs; *(f32x4*)(o + 4) = v1 * rs; EPI_END
        } else {
            bf16_t* Gt = (bf16_t*)(ws + (pn < 36 ? WS_GA : WS_GB)); const int c0 = (pn < 36 ? pn - 28 : pn - 36) * 256;
            EPI_ROWS(row) const float rs = RSTD1[row]; EPI_COLS(col) *(u32x4*)(Gt + (size_t)row * D + c0 + col) = pk8(sig4(v0 * rs), sig4(v1 * rs)); EPI_END
        }
    }
};

template <int LDA_, int LDB_, int K_> struct PhaseN2048 {
    static constexpr int LDA = LDA_, LDB = LDB_, KT = K_ / 64;
    const Params& p; int G, c; size_t a_off, b_off;
    DI bool next_(int i, g8::Unit& u) const { int pm, pn; if (!g8::grid_order(NTM - 1, 8, G, c, i, pm, pn)) return false;
        u.pm = pm; u.pn = pn; u.A = (const char*)(p.ws + a_off) + (size_t)pm * 256 * LDA * 2; u.B = (const char*)(p.ws + b_off) + (size_t)pn * 256 * LDB * 2; return true; }
};
struct PhaseYb : PhaseN2048<POOLW, POOLW, POOLW> {
    DI bool next(int i, g8::Unit& u) const { return next_(i, u); }
    DI void epi(EPI_ARGS) const { const bf16_t* GB = (const bf16_t*)(p.ws + WS_GB); float* Y = (float*)(p.ws + WS_YBG);
        EPI_ROWS(row) EPI_COLS(col) const size_t o = (size_t)row * D + u.pn * 256 + col; const u32x4 g = *(const u32x4*)(GB + o);
            *(f32x4*)(Y + o) = v0 * bf4lo(g); *(f32x4*)(Y + o + 4) = v1 * bf4hi(g); EPI_END }
};
struct PhaseYa : PhaseN2048<VW, VW, VW> {
    DI bool next(int i, g8::Unit& u) const { return next_(i, u); }
    DI void epi(EPI_ARGS) const { const bf16_t* GA = (const bf16_t*)(p.ws + WS_GA); const float* Y = (const float*)(p.ws + WS_YBG); bf16_t* MB = (bf16_t*)(p.ws + WS_MB);
        EPI_ROWS(row) EPI_COLS(col) const size_t o = (size_t)row * D + u.pn * 256 + col; const u32x4 g = *(const u32x4*)(GA + o);
            *(u32x4*)(MB + o) = pk8(v0 * bf4lo(g) + *(const f32x4*)(Y + o), v1 * bf4hi(g) + *(const f32x4*)(Y + o + 4)); EPI_END }
};
DI void epi_residual(EPI_ARGS, const float* base_p, const float* base_s, float* H, bf16_t* HB, float* SS) {
    EPI_ROWS(row) float ss = 0.f; const float* br = (base_s && row >= MP) ? base_s + (size_t)(row - MP) * D : base_p + (size_t)row * D;
        EPI_COLS(col) const int cg_ = u.pn * 256 + col; const size_t o = (size_t)row * D + cg_;
            const f32x4 h0 = v0 + *(const f32x4*)(br + cg_), h1 = v1 + *(const f32x4*)(br + cg_ + 4);
            *(f32x4*)(H + o) = h0; *(f32x4*)(H + o + 4) = h1; *(u32x4*)(HB + o) = pk8(h0, h1);
            ss += sum4(h0 * h0) + sum4(h1 * h1); }
        ss += __shfl_xor(ss, 16); ss += __shfl_xor(ss, 32);
        if (fq == 0) SS[(size_t)row * 32 + u.pn * 4 + wc] = ss; } }
}
struct PhaseOut : PhaseN2048<D, D, D> {
    DI bool next(int i, g8::Unit& u) const { return next_(i, u); }
    DI void epi(EPI_ARGS) const { epi_residual(acc, u, wr, wc, fr, fq, p.x_prompt, p.x_sample, (float*)(p.ws + WS_H1), (bf16_t*)(p.ws + WS_H1B), (float*)(p.ws + WS_SS1)); }
};
struct PhaseDown : PhaseN2048<DFF, DFF, DFF> {
    DI bool next(int i, g8::Unit& u) const { return next_(i, u); }
    DI void epi(EPI_ARGS) const { epi_residual(acc, u, wr, wc, fr, fq, (const float*)(p.ws + WS_H1), nullptr, (float*)(p.ws + WS_H2), (bf16_t*)(p.ws + WS_H2B), (float*)(p.ws + WS_SS2)); }
};
struct PhasePe : PhaseN2048<PLE, PLE, PLE> {
    DI bool next(int i, g8::Unit& u) const { return next_(i, u); }
    DI void epi(EPI_ARGS) const { float* PE = (float*)(p.ws + WS_PE);
        EPI_ROWS(row) EPI_COLS(col) const size_t o = (size_t)row * D + u.pn * 256 + col; *(f32x4*)(PE + o) = v0; *(f32x4*)(PE + o + 4) = v1; EPI_END }
};
struct PhasePg : PhaseN2048<D, D, D> {
    DI bool next(int i, g8::Unit& u) const { return next_(i, u); }
    DI void epi(EPI_ARGS) const { const float* H2 = (const float*)(p.ws + WS_H2); const float* PE = (const float*)(p.ws + WS_PE); const float* SS2 = (const float*)(p.ws + WS_SS2);
        float* H3 = (float*)(p.ws + WS_H3); float* SS3 = (float*)(p.ws + WS_SS3);
        EPI_ROWS(row) float s2 = 0.f;
#pragma unroll
            for (int k = 0; k < 8; ++k) s2 += sum4(*(const f32x4*)(SS2 + (size_t)row * 32 + 4 * k));
            const float rs = 1.0f / sqrtf(s2 * (1.0f / D) + EPS); float ss = 0.f;
            EPI_COLS(col) const size_t o = (size_t)row * D + u.pn * 256 + col;
                const f32x4 h0 = *(const f32x4*)(H2 + o) + sig4(v0 * rs) * *(const f32x4*)(PE + o), h1 = *(const f32x4*)(H2 + o + 4) + sig4(v1 * rs) * *(const f32x4*)(PE + o + 4);
                *(f32x4*)(H3 + o) = h0; *(f32x4*)(H3 + o + 4) = h1; ss += sum4(h0 * h0) + sum4(h1 * h1); }
            ss += __shfl_xor(ss, 16); ss += __shfl_xor(ss, 32);
            if (fq == 0) SS3[(size_t)row * 32 + u.pn * 4 + wc] = ss; } }
    }
};
struct PhaseUp {
    static constexpr int LDA = D, LDB = D, KT = D / 64;
    const Params& p; int G, c;
    DI bool next(int i, g8::Unit& u) const { int pm, pn; if (!g8::grid_order(NTM, 43, G, c, i, pm, pn)) return false;
        u.pm = pm; u.pn = pn; u.A = (const char*)(p.ws + WS_H1B) + (size_t)pm * 256 * D * 2; u.B = (const char*)(p.ws + WS_WUP) + (size_t)pn * 256 * D * 2; return true; }
    DI void epi(EPI_ARGS) const { bf16_t* GU = (bf16_t*)(p.ws + WS_GU);
        EPI_ROWS(row) EPI_COLS(col) *(u32x4*)(GU + (size_t)row * NUP + u.pn * 256 + col) = pk8(v0, v1); EPI_END }
};

struct PhaseWpb {
    static constexpr int LDA = POOLW, LDB = 256, KT = 4;
    const Params& p; int G, c;
    DI bool next(int i, g8::Unit& u) const { const int off = 200 % G; const long L = (long)i * G + ((c + G - off) % G); if (L >= 32) return false;
        const int pm = (int)L >> 2, g = (int)L & 3; u.pm = pm; u.pn = g;
        u.A = (const char*)(p.ws + WS_WBT) + ((size_t)pm * 256 * POOLW + g * 256) * 2; u.B = (const char*)(p.ws + WS_WPS) + (size_t)g * 256 * 256 * 2; return true; }
    DI void epi(EPI_ARGS) const { bf16_t* W = (bf16_t*)(p.ws + WS_WPB);
        EPI_ROWS(row) EPI_COLS(col) *(u32x4*)(W + (size_t)row * POOLW + u.pn * 256 + col) = pk8(v0, v1); EPI_END }
};

template <int K, int LDA, int LDB>
DI f32x4 skinny16(const bf16_t* A, const bf16_t* W, int lane) {
    const int fr = lane & 15, fq = lane >> 4;
    const bf16_t* ap = A + (size_t)fr * LDA + 8 * fq; const bf16_t* bp = W + (size_t)fr * LDB + 8 * fq;
    f32x4 acc = {0.f, 0.f, 0.f, 0.f};
#pragma unroll 4
    for (int s = 0; s < K / 32; ++s) { const bf16x8 a = *(const bf16x8*)(ap + 32 * s), b = *(const bf16x8*)(bp + 32 * s); acc = __builtin_amdgcn_mfma_f32_16x16x32_bf16(a, b, acc, 0, 0, 0); }
    return acc;
}
DI float sum16(float v) { v += __shfl_xor(v, 1); v += __shfl_xor(v, 2); v += __shfl_xor(v, 4); v += __shfl_xor(v, 8); return v; }
template <int KIND, int K, int LDA, int LDB>
DI void sample_gemm(const Params& p, size_t a_off, size_t w_off, int wave) {
    unsigned char* ws = p.ws; const int lane = lane_id(), fr = lane & 15, fq = lane >> 4;
    for (int cg_ = blockIdx.x; cg_ < 128; cg_ += gridDim.x) {
        const int r0 = MP + 16 * wave, col = 16 * cg_ + fr;
        const f32x4 acc = skinny16<K, LDA, LDB>((const bf16_t*)(ws + a_off) + (size_t)r0 * LDA, (const bf16_t*)(ws + w_off) + (size_t)(16 * cg_) * LDB, lane);
        float rs[4] = {0.f, 0.f, 0.f, 0.f};
        if (KIND == 5) {
            const float* SS2S = (const float*)(ws + WS_SS2S);
#pragma unroll
            for (int r = 0; r < 16; ++r) { const float* q = SS2S + (size_t)(16 * wave + r) * 128; const float s = wave_sum(q[lane] + q[64 + lane]); const float rr = 1.0f / sqrtf(s * (1.0f / D) + EPS);
#pragma unroll
                for (int j = 0; j < 4; ++j) rs[j] = (r == 4 * fq + j) ? rr : rs[j]; }
        }
#pragma unroll
        for (int j = 0; j < 4; ++j) {
            const int row = r0 + 4 * fq + j; const size_t o = (size_t)row * D + col; const float v = acc[j]; float hsq = 0.f;
            if (KIND == 0) { ((float*)(ws + WS_YBG))[o] = v * bf1(((const bf16_t*)(ws + WS_GB))[o]); }
            if (KIND == 1) { ((bf16_t*)(ws + WS_MB))[o] = (bf16_t)(pk2(v * bf1(((const bf16_t*)(ws + WS_GA))[o]) + ((const float*)(ws + WS_YBG))[o], 0.f) & 0xffffu); }
            if (KIND == 2) { const float hv = p.x_sample[(size_t)(row - MP) * D + col] + v; ((float*)(ws + WS_H1))[o] = hv; ((bf16_t*)(ws + WS_H1B))[o] = (bf16_t)(pk2(hv, 0.f) & 0xffffu); hsq = hv * hv; }
            if (KIND == 3) { const float hv = ((const float*)(ws + WS_H1))[o] + v; ((float*)(ws + WS_H2))[o] = hv; ((bf16_t*)(ws + WS_H2B))[o] = (bf16_t)(pk2(hv, 0.f) & 0xffffu); hsq = hv * hv; }
            if (KIND == 4) { ((float*)(ws + WS_PE))[o] = v; }
            if (KIND == 5) { const float hv = ((const float*)(ws + WS_H2))[o] + sigmoidf_(v * rs[j]) * ((const float*)(ws + WS_PE))[o]; ((float*)(ws + WS_H3))[o] = hv; hsq = hv * hv; }
            if (KIND == 2 || KIND == 3 || KIND == 5) { const float t = sum16(hsq);
                float* SSx = (float*)(ws + (KIND == 2 ? WS_SS1S : (KIND == 3 ? WS_SS2S : WS_SS3S))); if (fr == 0) SSx[(size_t)(row - MP) * 128 + cg_] = t; }
        }
    }
}


#define XB_TMO      128
#define XB_XCNT(j)  (256  + 64 * (j))
#define XB_XSUB(j)  (1280 + 64 * (j))
#define XB_XGEN(j)  (2304 + 64 * (j))
#define XB_TOP      3328
#define XB_TOPGEN   3392
#define XCD_BAR_WORDS 3456
#define XB_SPIN_CAP (1u << 22)
DI unsigned xb_ld(unsigned* p)              { return __hip_atomic_load(p, __ATOMIC_RELAXED, __HIP_MEMORY_SCOPE_AGENT); }
DI unsigned xb_add(unsigned* p, unsigned v) { return __hip_atomic_fetch_add(p, v, __ATOMIC_RELAXED, __HIP_MEMORY_SCOPE_AGENT); }
DI unsigned xb_xcc_id() { return (unsigned)__builtin_amdgcn_s_getreg((3 << 11) | 20) & 0xFu; }
#define XB_SPIN(cond, bar) do { unsigned _sp = 0; while (cond) { __builtin_amdgcn_s_sleep(1); \
    if ((++_sp & 255u) == 0u) { if (xb_ld(&(bar)[XB_TMO])) break; if (_sp > XB_SPIN_CAP) { atomicAdd(&(bar)[XB_TMO], 1u); break; } } } } while (0)
struct XcdBarrier { unsigned* bar; unsigned x; volatile LAS unsigned* st; };
DI XcdBarrier xcd_barrier_post(unsigned* bar, volatile LAS unsigned* st, bool t0) {
    XcdBarrier b; b.bar = bar; b.x = xb_xcc_id(); b.st = st;
    if (t0) (void)xb_add(&bar[XB_XCNT(b.x)], 1u);
    return b;
}
DI void xcd_barrier_complete(unsigned* bar, unsigned x, unsigned& nloc, unsigned& nx) {
    const unsigned G = gridDim.x * gridDim.y * gridDim.z;
    unsigned sum, cnt, mine, sp = 0u;
    for (;;) {
        sum = 0u; cnt = 0u; mine = 0u;
#pragma unroll
        for (unsigned j = 0; j < 16; ++j) { const unsigned c = xb_ld(&bar[XB_XCNT(j)]); sum += c; cnt += (c > 0u) ? 1u : 0u; mine = (j == x) ? c : mine; }
        if (sum == G) break;
        __builtin_amdgcn_s_sleep(1);
        if ((++sp & 255u) == 0u) { if (xb_ld(&bar[XB_TMO])) break; if (sp > XB_SPIN_CAP) { atomicAdd(&bar[XB_TMO], 1u); break; } }
    }
    nloc = mine > 0u ? mine : 1u; nx = cnt > 0u ? cnt : 1u;
}
DI void xcd_barrier(const XcdBarrier& b, bool t0) {
    asm volatile("s_waitcnt vmcnt(0)" ::: "memory");
    __syncthreads();
    if (t0) {
        unsigned* bar = b.bar;
        __builtin_amdgcn_s_waitcnt(0);
        unsigned nloc = b.st[0], nx = b.st[1];
        if (nloc == 0u) { xcd_barrier_complete(bar, b.x, nloc, nx); b.st[0] = nloc; b.st[1] = nx; }
        const unsigned old = xb_add(&bar[XB_XSUB(b.x)], 1u);
        const unsigned gen = old / nloc;
        if (old + 1u == (gen + 1u) * nloc) {
            __builtin_amdgcn_fence(__ATOMIC_RELEASE, "agent");
            asm volatile("s_waitcnt vmcnt(0)" ::: "memory");
            const unsigned og = xb_add(&bar[XB_TOP], 1u);
            const unsigned tg = og / nx;
            if (og + 1u == (tg + 1u) * nx) xb_add(&bar[XB_TOPGEN], 1u);
            else XB_SPIN(xb_ld(&bar[XB_TOPGEN]) == tg, bar);
            __builtin_amdgcn_fence(__ATOMIC_ACQUIRE, "agent");
            xb_add(&bar[XB_XGEN(b.x)], 1u);
            asm volatile("s_waitcnt vmcnt(0)" ::: "memory");
        } else {
            XB_SPIN(xb_ld(&bar[XB_XGEN(b.x)]) == gen, bar);
            __builtin_amdgcn_fence(__ATOMIC_ACQUIRE, "agent");
            asm volatile("s_waitcnt vmcnt(0)" ::: "memory");
        }
    }
    __syncthreads();
}

constexpr int N_PHASES = 13;
#ifndef G8_SP2
#define G8_SP2 true
#endif
#ifndef G8_ALIGN
#define G8_ALIGN true
#endif

__global__ void __launch_bounds__(NTHREADS, 2) fwd_kernel(Params p) {
    extern __shared__ __attribute__((aligned(16))) unsigned char lds_raw[];
    LAS unsigned char* lds = (LAS unsigned char*)lds_raw;
    const int G = gridDim.x, c = blockIdx.x;
    const int wave = __builtin_amdgcn_readfirstlane(threadIdx.x >> 6);
    const int lo = p.ph_lo, hi = p.ph_hi;
#ifndef REPEAT_MASK
#define REPEAT_MASK 0
#endif
#ifndef PHASE_MASK
#define PHASE_MASK 0x1fff
#endif
#define IN(k) (((PHASE_MASK >> (k)) & 1) && lo <= (k) && (k) < hi)
    volatile LAS unsigned* bst = (volatile LAS unsigned*)(lds + LDS_MISC);
    const bool t0 = (wave == 0) && (lane_id() == 0);
    XcdBarrier bar; bar.bar = (unsigned*)(p.ws + WS_CTL); bar.x = 0; bar.st = bst;
    if (hi - lo > 1) { if (t0) { bst[0] = 0u; bst[1] = 0u; } __syncthreads(); bar = xcd_barrier_post((unsigned*)(p.ws + WS_CTL), bst, t0); }
#define SEAM(k) do { if (IN(k) && IN((k) + 1)) { xcd_barrier(bar, (wave == 0) && (lane_id() == 0)); } } while (0)
    if (IN(0)) { phase_p0(p, lds, wave); if ((REPEAT_MASK >> 0) & 1) { xcd_barrier(bar, (wave == 0) && (lane_id() == 0)); phase_p0(p, lds, wave); } } SEAM(0);
    if (IN(1)) { PhaseIn ph{p, G, c}; g8::run<PhaseIn, G8_ALIGN, G8_SP2>(lds, ph, wave); { PhaseWpb pw{p, G, c}; g8::run<PhaseWpb, G8_ALIGN, G8_SP2>(lds, pw, wave); } if ((REPEAT_MASK >> 1) & 1) { xcd_barrier(bar, (wave == 0) && (lane_id() == 0)); PhaseIn ph{p, G, c}; g8::run<PhaseIn, G8_ALIGN, G8_SP2>(lds, ph, wave); } } SEAM(1);
    if (IN(2)) { phase_p2(p, lds, wave); if ((REPEAT_MASK >> 2) & 1) { xcd_barrier(bar, (wave == 0) && (lane_id() == 0)); phase_p2(p, lds, wave); } } SEAM(2);
    if (IN(3)) { phase_p3(p, wave); if ((REPEAT_MASK >> 3) & 1) { xcd_barrier(bar, (wave == 0) && (lane_id() == 0)); phase_p3(p, wave); } } SEAM(3);
    if (IN(4)) { sample_gemm<0, POOLW, POOLW, POOLW>(p, WS_PM, WS_WPB, wave); PhaseYb ph{{p, G, c, WS_PM, WS_WPB}}; g8::run<PhaseYb, G8_ALIGN, G8_SP2>(lds, ph, wave); if ((REPEAT_MASK >> 4) & 1) { xcd_barrier(bar, (wave == 0) && (lane_id() == 0)); sample_gemm<0, POOLW, POOLW, POOLW>(p, WS_PM, WS_WPB, wave); PhaseYb ph{{p, G, c, WS_PM, WS_WPB}}; g8::run<PhaseYb, G8_ALIGN, G8_SP2>(lds, ph, wave); } } SEAM(4);
    if (IN(5)) { sample_gemm<1, VW, VW, VW>(p, WS_OG, WS_WA, wave); PhaseYa ph{{p, G, c, WS_OG, WS_WA}}; g8::run<PhaseYa, G8_ALIGN, G8_SP2>(lds, ph, wave); if ((REPEAT_MASK >> 5) & 1) { xcd_barrier(bar, (wave == 0) && (lane_id() == 0)); sample_gemm<1, VW, VW, VW>(p, WS_OG, WS_WA, wave); PhaseYa ph{{p, G, c, WS_OG, WS_WA}}; g8::run<PhaseYa, G8_ALIGN, G8_SP2>(lds, ph, wave); } } SEAM(5);
    if (IN(6)) { sample_gemm<2, D, D, D>(p, WS_MB, WS_WO, wave); PhaseOut ph{{p, G, c, WS_MB, WS_WO}}; g8::run<PhaseOut, G8_ALIGN, G8_SP2>(lds, ph, wave); if ((REPEAT_MASK >> 6) & 1) { xcd_barrier(bar, (wave == 0) && (lane_id() == 0)); sample_gemm<2, D, D, D>(p, WS_MB, WS_WO, wave); PhaseOut ph{{p, G, c, WS_MB, WS_WO}}; g8::run<PhaseOut, G8_ALIGN, G8_SP2>(lds, ph, wave); } } SEAM(6);
    if (IN(7)) { PhaseUp ph{p, G, c}; g8::run<PhaseUp, G8_ALIGN, G8_SP2>(lds, ph, wave); if ((REPEAT_MASK >> 7) & 1) { xcd_barrier(bar, (wave == 0) && (lane_id() == 0)); PhaseUp ph{p, G, c}; g8::run<PhaseUp, G8_ALIGN, G8_SP2>(lds, ph, wave); } } SEAM(7);
    if (IN(8)) { phase_conv(p, wave); if ((REPEAT_MASK >> 8) & 1) { xcd_barrier(bar, (wave == 0) && (lane_id() == 0)); phase_conv(p, wave); } } SEAM(8);
    if (IN(9)) { sample_gemm<3, DFF, DFF, DFF>(p, WS_ACT, WS_WD, wave); PhaseDown ph{{p, G, c, WS_ACT, WS_WD}}; g8::run<PhaseDown, G8_ALIGN, G8_SP2>(lds, ph, wave); if ((REPEAT_MASK >> 9) & 1) { xcd_barrier(bar, (wave == 0) && (lane_id() == 0)); sample_gemm<3, DFF, DFF, DFF>(p, WS_ACT, WS_WD, wave); PhaseDown ph{{p, G, c, WS_ACT, WS_WD}}; g8::run<PhaseDown, G8_ALIGN, G8_SP2>(lds, ph, wave); } } SEAM(9);
    if (IN(10)) { sample_gemm<4, PLE, PLE, PLE>(p, WS_PLB, WS_WPLE, wave); PhasePe ph{{p, G, c, WS_PLB, WS_WPLE}}; g8::run<PhasePe, G8_ALIGN, G8_SP2>(lds, ph, wave); if ((REPEAT_MASK >> 10) & 1) { xcd_barrier(bar, (wave == 0) && (lane_id() == 0)); sample_gemm<4, PLE, PLE, PLE>(p, WS_PLB, WS_WPLE, wave); PhasePe ph{{p, G, c, WS_PLB, WS_WPLE}}; g8::run<PhasePe, G8_ALIGN, G8_SP2>(lds, ph, wave); } } SEAM(10);
    if (IN(11)) { sample_gemm<5, D, D, D>(p, WS_H2B, WS_WPG, wave); PhasePg ph{{p, G, c, WS_H2B, WS_WPG}}; g8::run<PhasePg, G8_ALIGN, G8_SP2>(lds, ph, wave); if ((REPEAT_MASK >> 11) & 1) { xcd_barrier(bar, (wave == 0) && (lane_id() == 0)); sample_gemm<5, D, D, D>(p, WS_H2B, WS_WPG, wave); PhasePg ph{{p, G, c, WS_H2B, WS_WPG}}; g8::run<PhasePg, G8_ALIGN, G8_SP2>(lds, ph, wave); } } SEAM(11);
    if (IN(12)) { phase_final(p, wave); if ((REPEAT_MASK >> 12) & 1) { xcd_barrier(bar, (wave == 0) && (lane_id() == 0)); phase_final(p, wave); } }
#undef IN
#undef SEAM
}

extern "C" void kernel_launch(void* const* d_in, const int* in_sizes, int n_in, void* d_out, int out_size, void* d_ws, size_t ws_size, hipStream_t stream) {
    static int grid = 0;
    if (grid == 0) {
        if (n_in != 26 || (size_t)out_size != O_END || ws_size < WS_END) {
            fprintf(stderr, "kernel_launch: unexpected problem: n_in %d out %d ws %zu (need %zu)\n", n_in, out_size, ws_size, (size_t)WS_END); grid = -1; return; }
        int dev = 0, cus = 0, per_cu = 0;
        if (hipGetDevice(&dev) != hipSuccess || hipDeviceGetAttribute(&cus, hipDeviceAttributeMultiprocessorCount, dev) != hipSuccess) { grid = -1; return; }
        if (hipFuncSetAttribute((const void*)fwd_kernel, hipFuncAttributeMaxDynamicSharedMemorySize, LDS_BYTES) != hipSuccess) { fprintf(stderr, "kernel_launch: hipFuncSetAttribute failed\n"); grid = -1; return; }
        if (hipOccupancyMaxActiveBlocksPerMultiprocessor(&per_cu, (const void*)fwd_kernel, NTHREADS, LDS_BYTES) != hipSuccess || per_cu < 1) {
            fprintf(stderr, "kernel_launch: occupancy query reports %d blocks per CU\n", per_cu); (void)hipGetLastError(); grid = -1; return; }
        grid = cus;
    }
    if (grid < 0) return;
    Params p{};
    const float** pp = (const float**)&p;
    for (int i = 0; i < 26; ++i) pp[i] = (const float*)d_in[i];
    p.out = (float*)d_out; p.ws = (unsigned char*)d_ws;
#if MK_N_LAUNCHES == 1
    p.ph_lo = 0; p.ph_hi = N_PHASES;
    void* args[] = {&p};
    if (hipMemsetAsync((char*)d_ws + WS_CTL, 0, XCD_BAR_WORDS * 4, stream) != hipSuccess) { fprintf(stderr, "kernel_launch: memset failed\n"); return; }
    hipError_t e = hipLaunchCooperativeKernel((const void*)fwd_kernel, dim3(grid), dim3(NTHREADS), args, LDS_BYTES, stream);
    if (e != hipSuccess) fprintf(stderr, "kernel_launch: cooperative launch failed: %s (grid %d)\n", hipGetErrorString(e), grid);
#else
    for (int k = 0; k < N_PHASES; ++k) { p.ph_lo = k; p.ph_hi = k + 1; hipLaunchKernelGGL(fwd_kernel, dim3(grid), dim3(NTHREADS), LDS_BYTES, stream, p); }
#endif
}
```

```cpp
#include <hip/hip_runtime.h>
#include <hip/hip_cooperative_groups.h>
#include <cstdio>
#include <cstdint>
namespace cg = cooperative_groups;

#ifndef MK_N_LAUNCHES
#define MK_N_LAUNCHES 1
#endif

#define LAS __attribute__((address_space(3)))
#define DI __device__ __forceinline__
typedef unsigned short bf16_t;
typedef short bf16x8 __attribute__((ext_vector_type(8)));
typedef short s16x4 __attribute__((ext_vector_type(4)));
typedef float f32x4 __attribute__((ext_vector_type(4)));
typedef float f32x2 __attribute__((ext_vector_type(2)));
typedef float f32x16 __attribute__((ext_vector_type(16)));
typedef unsigned u32x4 __attribute__((ext_vector_type(4)));
typedef unsigned u32x2 __attribute__((ext_vector_type(2)));

constexpr int D = 2048, MP = 8192, MS = 128, M = MP + MS, MPAD = 8448, NTM = 33;
constexpr int SEQ = 2048, NB = 4, NH = 4, DK = 256, DV = 512, KW = 1024, VW = 2048;
constexpr int DFF = 5504, NUP = 2 * DFF, PLE = 256, POOLW = 1024, INW = 11280, NIN = 11264;
constexpr float EPS = 1e-6f;
constexpr int NSL = 16;

constexpr size_t O_YP = 0, O_YS = O_YP + (size_t)MP * D, O_GLAP = O_YS + (size_t)MS * D, O_POOLP = O_GLAP + (size_t)NB * NH * DK * DV,
                 O_CONVP = O_POOLP + (size_t)NB * 15 * POOLW, O_GLAS = O_CONVP + (size_t)NB * 2 * DFF, O_POOLS = O_GLAS + (size_t)MS * NH * DK * DV,
                 O_CONVS = O_POOLS + (size_t)MS * 15 * POOLW, O_END = O_CONVS + (size_t)MS * 2 * DFF;

constexpr size_t al(size_t x) { return (x + 255) & ~(size_t)255; }
constexpr size_t WS_CTL = 0, CTL_BYTES = 65536;
constexpr size_t WS_WUP = WS_CTL + CTL_BYTES;
constexpr size_t WS_WD = WS_WUP + al((size_t)NUP * D * 2);
constexpr size_t WS_WA = WS_WD + al((size_t)D * DFF * 2);
constexpr size_t WS_WO = WS_WA + al((size_t)D * D * 2);
constexpr size_t WS_WPG = WS_WO + al((size_t)D * D * 2);
constexpr size_t WS_WPB = WS_WPG + al((size_t)D * D * 2);
constexpr size_t WS_WPLE = WS_WPB + al((size_t)D * POOLW * 2);
constexpr size_t WS_WBT = WS_WPLE + al((size_t)D * PLE * 2);
constexpr size_t WS_WPS = WS_WBT + al((size_t)D * POOLW * 2);
constexpr size_t WS_SMALL = WS_WPS + al((size_t)POOLW * 256 * 2);
constexpr size_t WS_RSTD1 = WS_SMALL;
constexpr size_t WS_LAM = WS_RSTD1 + al((size_t)MPAD * 4);
constexpr size_t WS_OSS = WS_LAM + al((size_t)256 * KW * 4);
constexpr size_t WS_OSP = WS_OSS + al((size_t)MP * NH * NSL * 4);
constexpr size_t WS_SS1 = WS_OSP + al((size_t)MS * NH * 8 * DV * 4);
constexpr size_t WS_SS2 = WS_SS1 + al((size_t)MPAD * 32 * 4);
constexpr size_t WS_SS3 = WS_SS2 + al((size_t)MPAD * 32 * 4);
constexpr size_t WS_SS1S = WS_SS3 + al((size_t)MPAD * 32 * 4);
constexpr size_t WS_SS2S = WS_SS1S + al((size_t)MS * 128 * 4);
constexpr size_t WS_SS3S = WS_SS2S + al((size_t)MS * 128 * 4);
constexpr size_t WS_PLB = WS_SS3S + al((size_t)MS * 128 * 4);
constexpr size_t WS_R1 = WS_PLB + al((size_t)MPAD * PLE * 2);
constexpr size_t WS_XB = WS_R1;
constexpr size_t WS_WIN = WS_XB + al((size_t)MPAD * D * 2);
constexpr size_t WS_BCUM = WS_WIN + al((size_t)NIN * D * 2);
constexpr size_t WS_R1_END = WS_BCUM + al((size_t)MPAD * KW * 4);
constexpr size_t WS_ACT = WS_R1;
static_assert(WS_ACT + al((size_t)MPAD * DFF * 2) <= WS_R1_END, "R1 overlay");
constexpr size_t WS_R2 = WS_R1_END;
constexpr size_t WS_QB = WS_R2;
constexpr size_t WS_KB = WS_QB + al((size_t)MPAD * KW * 2);
constexpr size_t WS_KD = WS_KB + al((size_t)MPAD * KW * 2);
constexpr size_t WS_V = WS_KD + al((size_t)MPAD * KW * 2);
constexpr size_t WS_SR = WS_V + al((size_t)MPAD * VW * 2);
constexpr size_t WS_GA = WS_SR + al((size_t)MPAD * VW * 2);
constexpr size_t WS_GB = WS_GA + al((size_t)MPAD * D * 2);
constexpr size_t WS_U = WS_GB + al((size_t)MPAD * D * 2);
constexpr size_t WS_OG = WS_U + al((size_t)MPAD * POOLW * 4);
constexpr size_t WS_PM = WS_OG + al((size_t)MPAD * VW * 2);
constexpr size_t WS_YBG = WS_PM + al((size_t)MPAD * POOLW * 2);
constexpr size_t WS_R2_END = WS_YBG + al((size_t)MPAD * D * 4);
constexpr size_t WS_GU = WS_R2;
constexpr size_t WS_H2 = WS_GU + al((size_t)MPAD * NUP * 2);
constexpr size_t WS_PE = WS_H2 + al((size_t)MPAD * D * 4);
static_assert(WS_PE + al((size_t)MPAD * D * 4) <= WS_R2_END, "R2 overlay");
constexpr size_t WS_MB = WS_R2_END;
constexpr size_t WS_H1 = WS_MB + al((size_t)MPAD * D * 2);
constexpr size_t WS_H1B = WS_H1 + al((size_t)MPAD * D * 4);
constexpr size_t WS_END = WS_H1B + al((size_t)MPAD * D * 2);
constexpr size_t WS_H3 = WS_H1;
constexpr size_t WS_H2B = WS_MB;

DI unsigned pk2(float lo, float hi) {
    typedef __bf16 bf2 __attribute__((ext_vector_type(2)));
    f32x2 v = {lo, hi};
    bf2 b = __builtin_convertvector(v, bf2);
    return __builtin_bit_cast(unsigned, b);
}
DI float bflo(unsigned w) { return __uint_as_float(w << 16); }
DI float bfhi(unsigned w) { return __uint_as_float(w & 0xffff0000u); }
DI float bf1(bf16_t b) { return __uint_as_float(((unsigned)b) << 16); }
DI float fexp(float x) { return __expf(x); }
DI float sigmoidf_(float x) { return __builtin_amdgcn_rcpf(1.0f + __expf(-x)); }
DI float siluf_(float x) { return x * sigmoidf_(x); }
DI float logsigmoidf_(float z) { return fminf(z, 0.f) - __logf(1.0f + __expf(-fabsf(z))); }
DI float wave_sum(float v) {
#pragma unroll
    for (int o = 1; o < 64; o <<= 1) v += __shfl_xor(v, o);
    return v;
}
DI int lane_id() { int l; asm volatile("v_mbcnt_lo_u32_b32 %0, -1, 0\n\tv_mbcnt_hi_u32_b32 %0, -1, %0" : "=v"(l)); return l; }
#define LDS_WAIT() asm volatile("s_waitcnt lgkmcnt(0)" ::: "memory")
#define VM_WAIT() asm volatile("s_waitcnt vmcnt(0)" ::: "memory")

struct Params {
    const float *x_prompt, *x_sample, *state_gla, *state_pool, *state_conv, *p_prompt, *p_sample;
    const float *norm_mix, *w_in, *w_gate_up, *b_gate, *gla_norm, *w_branch_a, *w_pool, *pool_scale, *w_branch_b, *w_out, *norm_ffn, *w_up, *conv_w, *conv_b,
        *w_down, *norm_ple, *w_ple_gate, *w_ple, *norm_final;
    float* out; unsigned char* ws;
    int ph_lo, ph_hi;
};

constexpr int NWAVES = 8, NTHREADS = 512;
constexpr int LDS_BYTES = 147456;
constexpr int LDS_MISC = LDS_BYTES - 256;

namespace g8 {
constexpr int BM = 256, BK = 64, HALF = 128, HTB = HALF * BK * 2, STAGE_BYTES = 8 * HTB, NXCD = 8, WGM = 8;
DI int lds_byte(int r, int c) { const int st = (r >> 4) * 2 + (c >> 5), rr = r & 15, cc = c & 31, ob = rr * 64 + cc * 2; return st * 1024 + (ob ^ (((ob >> 9) & 1) << 5)); }
DI void stage_rc(int b, int& R, int& C) { const int st = b / 1024, sb = b % 1024, swz = sb ^ (((sb >> 9) & 1) << 5); R = (st >> 1) * 16 + swz / 64; C = (st & 1) * 32 + (swz % 64) / 2; }
DI int perm32(int rho) { const int n = rho >> 4, i = rho & 15; return 8 * (i >> 2) + 4 * n + (i & 3); }

struct Unit { const char* A; const char* B; int pm, pn; };

DI bool grid_order(int nM, int nN, int G, int c, int i, int& pm, int& pn) {
    const int nwg = nM * nN; const long L = (long)i * G + c; if (L >= nwg) return false;
    int wgid = (int)L; { const int q = nwg / NXCD, r = nwg % NXCD, xcd = wgid % NXCD, off = wgid / NXCD; wgid = (xcd < r ? xcd * (q + 1) : r * (q + 1) + (xcd - r) * q) + off; }
    const int nig = WGM * nN, gid = wgid / nig, fm = gid * WGM, gsz = (nM - fm) < WGM ? (nM - fm) : WGM;
    pm = fm + ((wgid % nig) % gsz); pn = (wgid % nig) / gsz; return true;
}

template <class P, bool ALIGN_EPI, bool SP2>
DI void run(LAS unsigned char* lds, const P& ph, int wid) {
    const int lane = lane_id(), tid = wid * 64 + lane, wr = wid >> 2, wc = wid & 3, fr = lane & 15, fq = lane >> 4;
    constexpr int nt = P::KT;
    unsigned voffA[2], voffB[2];
#pragma unroll
    for (int i = 0; i < 2; ++i) { int R, C; stage_rc(tid * 16 + i * 8192, R, C); const int Rb = (R & ~31) + perm32(R & 31);
        voffA[i] = (unsigned)(R * P::LDA + C) * 2u; voffB[i] = (unsigned)(Rb * P::LDB + C) * 2u; }
    constexpr size_t kstep = (size_t)(BK * 2);
    constexpr size_t hstepA = (size_t)HALF * P::LDA * 2, hstepB = (size_t)HALF * P::LDB * 2;
    const unsigned ldsw = (unsigned)wid * 1024u;
    const int aoff = lds_byte(wr * 64 + fr, fq * 8), boff = lds_byte(wc * 32 + fr, fq * 8);
#define G8_SA(b, h) (((b) * 2 + (h)) * HTB)
#define G8_SB(b, h) ((4 + (b) * 2 + (h)) * HTB)
#define G8_STAGE(bufoff, gbase, voff) do { _Pragma("unroll") for (int _i = 0; _i < 2; ++_i) \
        __builtin_amdgcn_global_load_lds((const unsigned*)((const char*)(gbase) + (voff)[_i]), (LAS unsigned*)(lds + (bufoff) + ldsw + _i * 8192), 16, 0, 0); } while (0)
#define G8_LDA(dst, b, h) do { _Pragma("unroll") for (int m = 0; m < 4; ++m) _Pragma("unroll") for (int k = 0; k < 2; ++k) dst[m][k] = *(const LAS bf16x8*)(lds + G8_SA(b, h) + aoff + m * 2048 + k * 1024); } while (0)
#define G8_LDB(dst, b, h) do { _Pragma("unroll") for (int n = 0; n < 2; ++n) _Pragma("unroll") for (int k = 0; k < 2; ++k) dst[n][k] = *(const LAS bf16x8*)(lds + G8_SB(b, h) + boff + n * 2048 + k * 1024); } while (0)
#define G8_MMA(ai, bj, At, Bt) do { __builtin_amdgcn_s_setprio(1); _Pragma("unroll") for (int m = 0; m < 4; ++m) _Pragma("unroll") for (int n = 0; n < 2; ++n) _Pragma("unroll") for (int k = 0; k < 2; ++k) \
        acc[ai][bj][m][n] = __builtin_amdgcn_mfma_f32_16x16x32_bf16(Bt[n][k], At[m][k], acc[ai][bj][m][n], 0, 0, 0); __builtin_amdgcn_s_setprio(0); } while (0)
#define G8_WAIT_V(n) asm volatile("s_waitcnt vmcnt(" #n ")" ::: "memory")
#define G8_WAIT_L(n) asm volatile("s_waitcnt lgkmcnt(" #n ")" ::: "memory")
#define G8_BAR __builtin_amdgcn_s_barrier()
#define G8_SCHED __builtin_amdgcn_sched_barrier(0)
    Unit cur, nxt; int ui = 0;
    if (!ph.next(0, cur)) return;
    f32x4 acc[2][2][4][2];
#pragma unroll
    for (int a = 0; a < 2; ++a)
#pragma unroll
        for (int b = 0; b < 2; ++b)
#pragma unroll
            for (int m = 0; m < 4; ++m)
#pragma unroll
                for (int n = 0; n < 2; ++n) acc[a][b][m][n] = (f32x4){0.f, 0.f, 0.f, 0.f};
    bf16x8 At[4][2], B0[2][2], B1[2][2];
    const char* cA = cur.A; const char* cB = cur.B;
    if constexpr (SP2) {
        G8_STAGE(G8_SB(0, 0), cB, voffB); G8_STAGE(G8_SB(0, 1), cB + hstepB, voffB); G8_STAGE(G8_SA(0, 0), cA, voffA); G8_STAGE(G8_SA(0, 1), cA + hstepA, voffA);
        if (wr == 1) G8_BAR;
        G8_WAIT_V(2); G8_BAR;
        G8_STAGE(G8_SB(1, 0), cB + kstep, voffB); G8_STAGE(G8_SA(1, 0), cA + kstep, voffA); G8_STAGE(G8_SB(1, 1), cB + hstepB + kstep, voffB);
        G8_WAIT_V(6); G8_BAR;
    } else {
        G8_STAGE(G8_SB(0, 0), cB, voffB); G8_STAGE(G8_SA(0, 0), cA, voffA); G8_STAGE(G8_SB(0, 1), cB + hstepB, voffB); G8_STAGE(G8_SA(0, 1), cA + hstepA, voffA);
        if (wr == 1) G8_BAR;
        G8_WAIT_V(4); G8_BAR;
        G8_STAGE(G8_SB(1, 0), cB + kstep, voffB); G8_STAGE(G8_SA(1, 0), cA + kstep, voffA); G8_STAGE(G8_SB(1, 1), cB + hstepB + kstep, voffB);
        G8_WAIT_V(6); G8_BAR;
    }
    for (;;) {
        const bool has_next = ph.next(ui + 1, nxt);
        const char* nA = has_next ? nxt.A : cA; const char* nB = has_next ? nxt.B : cB;
#pragma unroll 1
        for (int t = 0; t < nt; t += 2) {
            const bool last = (t == nt - 2);
            const char* a1 = cA + (size_t)(t + 1) * kstep;
            const char* a2 = last ? nA : cA + (size_t)(t + 2) * kstep; const char* b2 = last ? nB : cB + (size_t)(t + 2) * kstep;
            const char* a3 = a2 + kstep; const char* b3 = b2 + kstep;
            if constexpr (SP2) {
            G8_LDB(B0, 0, 0); G8_LDB(B1, 0, 1); G8_SCHED; G8_LDA(At, 0, 0); G8_STAGE(G8_SA(1, 1), a1 + hstepA, voffA);
            G8_WAIT_V(8); G8_WAIT_L(0); G8_BAR; G8_MMA(0, 0, At, B0); G8_MMA(0, 1, At, B1); G8_BAR; G8_SCHED;
            G8_LDA(At, 0, 1); G8_STAGE(G8_SB(0, 0), b2, voffB); G8_STAGE(G8_SB(0, 1), b2 + hstepB, voffB); G8_STAGE(G8_SA(0, 0), a2, voffA);
            G8_WAIT_V(8); G8_WAIT_L(0); G8_BAR; G8_MMA(1, 0, At, B0); G8_MMA(1, 1, At, B1); G8_BAR; G8_SCHED;
            G8_LDB(B0, 1, 0); G8_LDB(B1, 1, 1); G8_SCHED; G8_LDA(At, 1, 0); G8_STAGE(G8_SA(0, 1), a2 + hstepA, voffA);
            G8_WAIT_V(8); G8_WAIT_L(0); G8_BAR; G8_MMA(0, 0, At, B0); G8_MMA(0, 1, At, B1); G8_BAR; G8_SCHED;
            G8_LDA(At, 1, 1); G8_STAGE(G8_SB(1, 0), b3, voffB); G8_STAGE(G8_SB(1, 1), b3 + hstepB, voffB); G8_STAGE(G8_SA(1, 0), a3, voffA);
            G8_WAIT_V(8); G8_WAIT_L(0); G8_BAR; G8_MMA(1, 0, At, B0); G8_MMA(1, 1, At, B1); G8_BAR; G8_SCHED;
            } else {
            G8_LDB(B0, 0, 0); G8_SCHED; G8_LDA(At, 0, 0); G8_STAGE(G8_SA(1, 1), a1 + hstepA, voffA);
            G8_WAIT_L(8); G8_BAR; G8_WAIT_L(0); G8_MMA(0, 0, At, B0); G8_BAR; G8_SCHED;
            G8_LDB(B1, 0, 1); G8_STAGE(G8_SB(0, 0), b2, voffB);
            G8_BAR; G8_WAIT_L(0); G8_MMA(0, 1, At, B1); G8_BAR;
            G8_LDA(At, 0, 1); G8_STAGE(G8_SA(0, 0), a2, voffA);
            G8_BAR; G8_WAIT_L(0); G8_MMA(1, 0, At, B0); G8_BAR; G8_SCHED;
            G8_STAGE(G8_SB(0, 1), b2 + hstepB, voffB);
            G8_WAIT_V(6); G8_BAR; G8_MMA(1, 1, At, B1); G8_BAR;
            G8_LDB(B0, 1, 0); G8_SCHED; G8_LDA(At, 1, 0); G8_STAGE(G8_SA(0, 1), a2 + hstepA, voffA);
            G8_WAIT_L(8); G8_BAR; G8_WAIT_L(0); G8_MMA(0, 0, At, B0); G8_BAR; G8_SCHED;
            G8_LDB(B1, 1, 1); G8_STAGE(G8_SB(1, 0), b3, voffB);
            G8_BAR; G8_WAIT_L(0); G8_MMA(0, 1, At, B1); G8_BAR;
            G8_LDA(At, 1, 1); G8_STAGE(G8_SA(1, 0), a3, voffA);
            G8_BAR; G8_WAIT_L(0); G8_MMA(1, 0, At, B0); G8_BAR; G8_SCHED;
            G8_STAGE(G8_SB(1, 1), b3 + hstepB, voffB);
            G8_WAIT_V(6); G8_BAR; G8_MMA(1, 1, At, B1); G8_BAR;
            }
        }
        if constexpr (ALIGN_EPI) { if (wr == 0) G8_BAR; }
        ph.epi(acc, cur, wr, wc, fr, fq);
        if (!has_next) break;
#pragma unroll
        for (int a = 0; a < 2; ++a)
#pragma unroll
            for (int b = 0; b < 2; ++b)
#pragma unroll
                for (int m = 0; m < 4; ++m)
#pragma unroll
                    for (int n = 0; n < 2; ++n) acc[a][b][m][n] = (f32x4){0.f, 0.f, 0.f, 0.f};
        cur = nxt; cA = nA; cB = nB; ++ui;
        if constexpr (ALIGN_EPI) { if (wr == 1) G8_BAR; }
    }
    G8_WAIT_V(0);
    if constexpr (!ALIGN_EPI) { if (wr == 0) G8_BAR; }
    G8_BAR;
#undef G8_SA
#undef G8_SB
#undef G8_STAGE
#undef G8_LDA
#undef G8_LDB
#undef G8_MMA
#undef G8_WAIT_V
#undef G8_WAIT_L
#undef G8_BAR
#undef G8_SCHED
}
}

struct TJob { const float* src; bf16_t* dst; const float* gain; int K, Nsrc, Ndst, map, nitems; };

DI int map_col(int map, int n0) {
    if (map == 1) return n0 + (n0 >= 6144 ? 16 : 0);
    if (map == 2) { const int t = n0 >> 8, r = n0 & 255; return (r < 128) ? 128 * t + r : DFF + 128 * t + (r - 128); }
    return n0;
}
constexpr int TR_SCR = 64 * 65 * 4;
static_assert(8 * TR_SCR <= LDS_MISC, "transpose scratch must stay below the barrier words");
DI void p0_transpose_item(const TJob& J, LAS float* scr, int item, int lane) {
    const int nblk = J.Ndst / 64, kb = item / nblk, nb = item % nblk, k0 = 64 * kb, n0 = 64 * nb, ns0 = map_col(J.map, n0);
    const float* src = J.src + (size_t)(k0 + (lane >> 4)) * J.Nsrc + ns0 + 4 * (lane & 15);
    f32x4 v[16];
#pragma unroll
    for (int i = 0; i < 16; ++i) v[i] = *(const f32x4*)(src + (size_t)(4 * i) * J.Nsrc);
    if (J.gain) {
#pragma unroll
        for (int i = 0; i < 16; ++i) v[i] *= J.gain[k0 + 4 * i + (lane >> 4)];
    }
#pragma unroll
    for (int i = 0; i < 16; ++i) { LAS float* d = scr + (4 * i + (lane >> 4)) * 65 + 4 * (lane & 15); d[0] = v[i].x; d[1] = v[i].y; d[2] = v[i].z; d[3] = v[i].w; }
    LDS_WAIT(); asm volatile("" ::: "memory");
    const int c = lane & 7;
#pragma unroll
    for (int j = 0; j < 8; ++j) { const int n = (lane >> 3) + 8 * j; const LAS float* s = scr + (8 * c) * 65 + n;
        u32x4 o; o.x = pk2(s[0 * 65], s[1 * 65]); o.y = pk2(s[2 * 65], s[3 * 65]); o.z = pk2(s[4 * 65], s[5 * 65]); o.w = pk2(s[6 * 65], s[7 * 65]);
        *(u32x4*)(J.dst + (size_t)(n0 + n) * J.K + k0 + 8 * c) = o; }
    LDS_WAIT(); asm volatile("" ::: "memory");
}
DI void p0_wps_item(const Params& p, bf16_t* WPS, int item, int lane) {
    const size_t e = (size_t)item * 512 + lane * 8; const float* src = p.w_pool + e;
    const f32x4 a = *(const f32x4*)src, b = *(const f32x4*)(src + 4);
    u32x4 o; o.x = pk2(a.x, a.y); o.y = pk2(a.z, a.w); o.z = pk2(b.x, b.y); o.w = pk2(b.z, b.w);
    *(u32x4*)(WPS + e) = o;
}
DI void p0_plb_item(const Params& p, bf16_t* PLB, int item, int lane) {
    const size_t e = (size_t)item * 512 + lane * 8; const size_t row = e / PLE;
    const float* src = (row < MP) ? p.p_prompt + e : p.p_sample + (e - (size_t)MP * PLE);
    const f32x4 a = *(const f32x4*)src, b = *(const f32x4*)(src + 4);
    u32x4 o; o.x = pk2(a.x, a.y); o.y = pk2(a.z, a.w); o.z = pk2(b.x, b.y); o.w = pk2(b.z, b.w);
    *(u32x4*)(PLB + e) = o;
}

DI void p0_xprep_unit(const Params& p, LAS unsigned char* lds, int u, int wave) {
    const int lane = lane_id(), tid = wave * 64 + lane;
    unsigned char* ws = p.ws;
    bf16_t* XB = (bf16_t*)(ws + WS_XB); float* RSTD1 = (float*)(ws + WS_RSTD1); float* BCUM = (float*)(ws + WS_BCUM); float* LAM = (float*)(ws + WS_LAM);
    LAS unsigned char* WG = lds; LAS float* GL = (LAS float*)(lds + 65536); LAS float* RS = (LAS float*)(lds + 73728);
    for (int pr = tid; pr < 4096; pr += NTHREADS) { const int k8 = pr >> 4, n = pr & 15; float w[8];
#pragma unroll
        for (int j = 0; j < 8; ++j) { const int k = 8 * k8 + j; w[j] = p.w_in[(size_t)k * INW + 6144 + n] * p.norm_mix[k]; }
        u32x4 o; o.x = pk2(w[0], w[1]); o.y = pk2(w[2], w[3]); o.z = pk2(w[4], w[5]); o.w = pk2(w[6], w[7]);
        *(LAS u32x4*)(WG + (size_t)pr * 16) = o; }
    __syncthreads();
    {
        const int fr = lane & 15, fq = lane >> 4; const int row = 128 * u + 16 * wave + fr;
        const float* xr = (row < MP) ? p.x_prompt + (size_t)row * D : p.x_sample + (size_t)(row - MP) * D;
        f32x4 acc = {0.f, 0.f, 0.f, 0.f}; float ss = 0.f;
#pragma unroll 8
        for (int s = 0; s < 64; ++s) {
            const f32x4 a = *(const f32x4*)(xr + 32 * s + 8 * fq), b = *(const f32x4*)(xr + 32 * s + 8 * fq + 4);
            ss += (a.x * a.x + a.y * a.y) + (a.z * a.z + a.w * a.w) + (b.x * b.x + b.y * b.y) + (b.z * b.z + b.w * b.w);
            u32x4 o; o.x = pk2(a.x, a.y); o.y = pk2(a.z, a.w); o.z = pk2(b.x, b.y); o.w = pk2(b.z, b.w);
            *(u32x4*)(XB + (size_t)row * D + 32 * s + 8 * fq) = o;
            const bf16x8 af = __builtin_bit_cast(bf16x8, o);
            const bf16x8 bfr = *(const LAS bf16x8*)(WG + (size_t)((4 * s + fq) * 16 + fr) * 16);
            acc = __builtin_amdgcn_mfma_f32_16x16x32_bf16(af, bfr, acc, 0, 0, 0);
        }
        ss += __shfl_xor(ss, 16); ss += __shfl_xor(ss, 32);
        const float rstd = 1.0f / sqrtf(ss * (1.0f / D) + EPS);
        if (fq == 0) { RS[16 * wave + fr] = rstd; RSTD1[row] = rstd; }
        LDS_WAIT(); asm volatile("" ::: "memory");
#pragma unroll
        for (int j = 0; j < 4; ++j) { const int tl = 16 * wave + 4 * fq + j; GL[tl * 16 + fr] = acc[j] * RS[tl]; }
    }
    __syncthreads();
    const bool sample = (u == 64);
#pragma unroll 1
    for (int cc = 0; cc < 2; ++cc) {
        const int c = tid + 512 * cc; float wg[16];
#pragma unroll
        for (int j = 0; j < 16; ++j) wg[j] = p.w_gate_up[j * KW + c];
        const float bg = p.b_gate[c]; float cum = 0.f;
#pragma unroll 2
        for (int t = 0; t < 128; ++t) {
            const f32x4 g0 = *(const LAS f32x4*)(GL + t * 16), g1 = *(const LAS f32x4*)(GL + t * 16 + 4), g2 = *(const LAS f32x4*)(GL + t * 16 + 8), g3 = *(const LAS f32x4*)(GL + t * 16 + 12);
            float z = bg;
            z += g0.x * wg[0] + g0.y * wg[1] + g0.z * wg[2] + g0.w * wg[3];
            z += g1.x * wg[4] + g1.y * wg[5] + g1.z * wg[6] + g1.w * wg[7];
            z += g2.x * wg[8] + g2.y * wg[9] + g2.z * wg[10] + g2.w * wg[11];
            z += g3.x * wg[12] + g3.y * wg[13] + g3.z * wg[14] + g3.w * wg[15];
            const float gl = logsigmoidf_(z) * (1.0f / 16.0f);
            const int row = 128 * u + t;
            if (sample) { BCUM[(size_t)row * KW + c] = 0.f; LAM[(size_t)(128 + t) * KW + c] = __expf(gl); }
            else { cum = ((t & 63) == 0) ? gl : cum + gl; BCUM[(size_t)row * KW + c] = cum; if ((t & 63) == 63) LAM[(size_t)(row >> 6) * KW + c] = __expf(cum); }
        }
    }
    __syncthreads();
}

constexpr int NXPREP = 65;
DI void phase_p0(const Params& p, LAS unsigned char* lds, int wave) {
    const int lane = lane_id();
    unsigned char* ws = p.ws;
#ifndef P0_REP
#define P0_REP 0
#endif
    if ((int)blockIdx.x < NXPREP) { p0_xprep_unit(p, lds, blockIdx.x, wave); if (P0_REP & 1) p0_xprep_unit(p, lds, blockIdx.x, wave); return; }
    TJob J[8];
    J[0] = TJob{p.w_in, (bf16_t*)(ws + WS_WIN), p.norm_mix, D, INW, NIN, 1, (D / 64) * (NIN / 64)};
    J[1] = TJob{p.w_up, (bf16_t*)(ws + WS_WUP), p.norm_ffn, D, NUP, NUP, 2, (D / 64) * (NUP / 64)};
    J[2] = TJob{p.w_down, (bf16_t*)(ws + WS_WD), nullptr, DFF, D, D, 0, (DFF / 64) * (D / 64)};
    J[3] = TJob{p.w_branch_a, (bf16_t*)(ws + WS_WA), p.gla_norm, D, D, D, 0, (D / 64) * (D / 64)};
    J[4] = TJob{p.w_out, (bf16_t*)(ws + WS_WO), nullptr, D, D, D, 0, (D / 64) * (D / 64)};
    J[5] = TJob{p.w_ple_gate, (bf16_t*)(ws + WS_WPG), p.norm_ple, D, D, D, 0, (D / 64) * (D / 64)};
    J[6] = TJob{p.w_ple, (bf16_t*)(ws + WS_WPLE), nullptr, PLE, D, D, 0, (PLE / 64) * (D / 64)};
    J[7] = TJob{p.w_branch_b, (bf16_t*)(ws + WS_WBT), p.pool_scale, POOLW, D, D, 0, (POOLW / 64) * (D / 64)};
    LAS float* scr = (LAS float*)(lds + wave * TR_SCR);
    const int gw = ((int)blockIdx.x - NXPREP) * NWAVES + wave, NGW = ((int)gridDim.x - NXPREP) * NWAVES;
    for (int rep = 0; rep < ((P0_REP & 2) ? 2 : 1); ++rep) {
    int base = 0;
#pragma unroll
    for (int j = 0; j < 8; ++j) {
        const int n = J[j].nitems;
        int it = gw - (base % NGW); if (it < 0) it += NGW;
        for (; it < n; it += NGW) p0_transpose_item(J[j], scr, it, lane);
        base += n;
    }
    }
    for (int it = gw; it < (POOLW * 256) / 512; it += NGW) p0_wps_item(p, (bf16_t*)(ws + WS_WPS), it, lane);
    for (int it = gw; it < (M * PLE) / 512; it += NGW) p0_plb_item(p, (bf16_t*)(ws + WS_PLB), it, lane);
}

#define MFMA32(a, b, c) __builtin_amdgcn_mfma_f32_32x32x16_bf16((a), (b), (c), 0, 0, 0)
typedef LAS s16x4* lds_s16x4_p;
DI s16x4 tr_read(LAS unsigned char* a) { return __builtin_amdgcn_ds_read_tr16_b64_v4i16((lds_s16x4_p)a); }
DI bf16x8 cat8(s16x4 lo, s16x4 hi) { return __builtin_shufflevector(lo, hi, 0, 1, 2, 3, 4, 5, 6, 7); }
DI bf16x8 ld_perm(const bf16_t* p) {
    const u32x2 a = *(const u32x2*)p, b = *(const u32x2*)(p + 8);
    u32x4 r; r.x = a.x; r.y = a.y; r.z = b.x; r.w = b.y; return __builtin_bit_cast(bf16x8, r);
}
template <int S> DI bf16x8 pack_step(const f32x16& x) {
    u32x4 r; r.x = pk2(x[8 * S + 0], x[8 * S + 1]); r.y = pk2(x[8 * S + 2], x[8 * S + 3]); r.z = pk2(x[8 * S + 4], x[8 * S + 5]); r.w = pk2(x[8 * S + 6], x[8 * S + 7]);
    return __builtin_bit_cast(bf16x8, r);
}
DI f32x16 zero16() { f32x16 z;
#pragma unroll
    for (int i = 0; i < 16; ++i) z[i] = 0.f; return z; }

constexpr int SC_QI = 0, SC_KI = 32768, SC_KDI = 65536, SC_LMI = 131072, SC_VI = 133120, SC_BYTES = 141312;
static_assert(SC_BYTES <= LDS_MISC, "scan LDS map");
DI void dma16(const void* g, LAS unsigned char* l) { __builtin_amdgcn_global_load_lds((const unsigned*)g, (LAS unsigned*)l, 16, 0, 0); }
DI bf16x8 lds_perm(LAS unsigned char* a) {
    const u32x2 x = *(const LAS u32x2*)a, y = *(const LAS u32x2*)(a + 1024);
    u32x4 r; r.x = x.x; r.y = x.y; r.z = y.x; r.w = y.y; return __builtin_bit_cast(bf16x8, r);
}
DI void mask_diag(f32x16& a, int c, int h) {
#pragma unroll
    for (int r = 0; r < 16; ++r) { const int sloc = (r & 3) + 8 * (r >> 2) + 4 * h; a[r] = (sloc <= c) ? a[r] : 0.f; }
}
DI void scan_task(const Params& p, LAS unsigned char* lds, int task) {
    unsigned char* ws = p.ws;
    const bf16_t* QB = (const bf16_t*)(ws + WS_QB); const bf16_t* KB = (const bf16_t*)(ws + WS_KB); const bf16_t* KD = (const bf16_t*)(ws + WS_KD);
    const bf16_t* V = (const bf16_t*)(ws + WS_V); bf16_t* OG = (bf16_t*)(ws + WS_OG);
    const float* LAM = (const float*)(ws + WS_LAM); float* OSS = (float*)(ws + WS_OSS);
    const int sl = task & 15, hd = (task >> 4) & 3, b = task >> 6;
    f32x16 S[8];
#pragma unroll
    for (int db = 0; db < 8; ++db) S[db] = zero16();

#define SC_ISSUE_Q(ch_) do { const int _l = lane_id(); LAS unsigned char* _lb = lds; asm volatile("" : "+s"(_lb)); \
        const bf16_t* _q = QB + ((size_t)(b * SEQ + 64 * (ch_)) + _l) * KW + hd * 256; \
        _Pragma("unroll") for (int _i = 0; _i < 32; ++_i) dma16(_q + 8 * _i, _lb + SC_QI + _i * 1024); } while (0)
#define SC_ISSUE_KVKD(ch_) do { const int _l = lane_id(); const size_t _r0 = (size_t)(b * SEQ + 64 * (ch_)); const int _hi = _l >> 5, _pos = _l & 31; LAS unsigned char* _lb = lds; asm volatile("" : "+s"(_lb)); \
        const bf16_t* _k = KB + (_r0 + _l) * KW + hd * 256; \
        _Pragma("unroll") for (int _i = 0; _i < 32; ++_i) dma16(_k + 8 * _i, _lb + SC_KI + _i * 1024); \
        const bf16_t* _v = V + (_r0 + (_l >> 2)) * VW + hd * 512 + 32 * sl + 8 * (_l & 3); \
        _Pragma("unroll") for (int _i = 0; _i < 4; ++_i) dma16(_v + (size_t)_i * 16 * VW, _lb + SC_VI + ((ch_) & 1) * 4096 + _i * 1024); \
        const bf16_t* _kd = KD + (_r0 + _hi) * KW + hd * 256; \
        _Pragma("unroll") for (int _i = 0; _i < 32; ++_i) { const int _cc = _pos ^ (4 * (((2 * _i) & 3) | _hi)); dma16(_kd + (size_t)_i * 2 * KW + 8 * _cc, _lb + SC_KDI + ((ch_) & 1) * 32768 + _i * 1024); } \
        dma16(LAM + (size_t)(b * 32 + (ch_)) * KW + hd * 256 + 4 * _l, _lb + SC_LMI + ((ch_) & 1) * 1024); } while (0)

    SC_ISSUE_KVKD(0); SC_ISSUE_Q(0);
#pragma unroll 1
    for (int ch = 0; ch < 32; ++ch) {
        const int row0 = b * SEQ + 64 * ch;
        VM_WAIT();
        __builtin_amdgcn_sched_barrier(0);
        const int lane = lane_id();
        const int c = lane & 31, h = lane >> 5;
        const int i16 = lane & 15, q = i16 >> 2, pp = i16 & 3, jb = (lane >> 4) & 1;
        LAS unsigned char* VI = lds + SC_VI + (ch & 1) * 4096;
        LAS unsigned char* ka = lds + SC_KI + c * 16 + 8 * h;

#pragma unroll
        for (int tbi = 0; tbi < 2; ++tbi) {
            const int tb = 1 - tbi;
            LAS unsigned char* qa = lds + SC_QI + (32 * tb + c) * 16 + 8 * h;
            bf16x8 a0_0, a0_1, a1_0, a1_1;
            {   f32x16 att0 = zero16(), att1 = zero16();
#pragma unroll
                for (int st = 0; st < 16; ++st) {
                    const bf16x8 qf = lds_perm(qa + 2048 * st);
                    att0 = MFMA32(lds_perm(ka + 2048 * st), qf, att0);
                    if (tb == 1) att1 = MFMA32(lds_perm(ka + 512 + 2048 * st), qf, att1);
                    if ((st & 3) == 3) __builtin_amdgcn_sched_barrier(0);
                }
                if (tb == 1) mask_diag(att1, c, h); else mask_diag(att0, c, h);
                a0_0 = pack_step<0>(att0); a0_1 = pack_step<1>(att0);
                if (tb == 1) { a1_0 = pack_step<0>(att1); a1_1 = pack_step<1>(att1); }
            }
            if (tb == 0) {
                __builtin_amdgcn_sched_barrier(0);
                if (ch + 1 < 32) SC_ISSUE_KVKD(ch + 1);
                __builtin_amdgcn_sched_barrier(0);
            }
            f32x16 o = zero16();
            LAS unsigned char* vb = VI + ((4 * h + q) * 4 + 2 * jb + (pp >> 1)) * 16 + (pp & 1) * 8;
            { const bf16x8 vf = cat8(tr_read(vb), tr_read(vb + 8 * 64)); o = MFMA32(vf, a0_0, o); }
            { const bf16x8 vf = cat8(tr_read(vb + 16 * 64), tr_read(vb + 24 * 64)); o = MFMA32(vf, a0_1, o); }
            if (tb == 1) {
                { const bf16x8 vf = cat8(tr_read(vb + 32 * 64), tr_read(vb + 40 * 64)); o = MFMA32(vf, a1_0, o); }
                { const bf16x8 vf = cat8(tr_read(vb + 48 * 64), tr_read(vb + 56 * 64)); o = MFMA32(vf, a1_1, o); }
            }
#pragma unroll
            for (int db = 0; db < 8; ++db) {
                { const bf16x8 qf = lds_perm(qa + 4096 * db); o = MFMA32(pack_step<0>(S[db]), qf, o); }
                { const bf16x8 qf = lds_perm(qa + 4096 * db + 2048); o = MFMA32(pack_step<1>(S[db]), qf, o); }
                if (db & 1) __builtin_amdgcn_sched_barrier(0);
            }
            const int t = row0 + 32 * tb + c;
            float ss = 0.f;
#pragma unroll
            for (int r = 0; r < 16; ++r) ss += o[r] * o[r];
            { const auto sw = __builtin_amdgcn_permlane32_swap(__float_as_uint(ss), __float_as_uint(ss), false, false); ss = __uint_as_float(sw[0]) + __uint_as_float(sw[1]); }
            if (h == 0) OSS[(size_t)t * 64 + hd * 16 + sl] = ss;
            bf16_t* og = OG + (size_t)(row0 + 32 * tb) * VW + hd * 512 + 32 * sl + c * VW + 4 * h;
#pragma unroll
            for (int g = 0; g < 4; ++g) { u32x2 w; w.x = pk2(o[4 * g + 0], o[4 * g + 1]); w.y = pk2(o[4 * g + 2], o[4 * g + 3]); *(u32x2*)(og + 8 * g) = w; }
            __builtin_amdgcn_sched_barrier(0);
        }
        __builtin_amdgcn_sched_barrier(0);
        if (ch + 1 < 32) SC_ISSUE_Q(ch + 1);
        __builtin_amdgcn_sched_barrier(0);

        {
            LAS unsigned char* vb = VI + ((8 * h + q) * 4 + 2 * jb + (pp >> 1)) * 16 + (pp & 1) * 8;
            LAS unsigned char* kbase = lds + SC_KDI + (ch & 1) * 32768 + (8 * h + q) * 512 + (2 * jb + (pp >> 1)) * 16 + (pp & 1) * 8;
            LAS unsigned char* lm = lds + SC_LMI + (ch & 1) * 1024 + 16 * h;
#pragma unroll
            for (int db = 0; db < 8; ++db) {
#pragma unroll
                for (int g = 0; g < 4; ++g) { const f32x4 l4 = *(const LAS f32x4*)(lm + (32 * db + 8 * g) * 4);
                    S[db][4 * g + 0] *= l4.x; S[db][4 * g + 1] *= l4.y; S[db][4 * g + 2] *= l4.z; S[db][4 * g + 3] *= l4.w; }
                LAS unsigned char* kb = kbase + (((db & 3) ^ q) * 4) * 16 + (db >> 2) * 256;
#pragma unroll
                for (int ks = 0; ks < 4; ++ks) {
                    const bf16x8 kf = cat8(tr_read(kb + (16 * ks) * 512), tr_read(kb + (16 * ks + 4) * 512));
                    const bf16x8 vf = cat8(tr_read(vb + (16 * ks) * 64), tr_read(vb + (16 * ks + 4) * 64));
                    S[db] = MFMA32(kf, vf, S[db]);
                }
                __builtin_amdgcn_sched_barrier(0);
            }
        }
        asm volatile("" ::: "memory");
    }
#undef SC_ISSUE_Q
#undef SC_ISSUE_KVKD
    {   const int lane = lane_id();
        const unsigned voff = (unsigned)(((lane >> 5) * 4 * DV + (lane & 31)) * 4);
        const char* gbase = (const char*)(p.out + O_GLAP + ((size_t)(b * NH + hd) * DK) * DV + 32 * sl);
#pragma unroll
        for (int db = 0; db < 8; ++db) {
#pragma unroll
            for (int r = 0; r < 16; ++r) { const int dl = 32 * db + (r & 3) + 8 * (r >> 2); *(float*)(const_cast<char*>(gbase) + (size_t)dl * DV * 4 + voff) = S[db][r]; }
        }
    }
}

DI void sgla_task(const Params& p, int task, int lane) {
    unsigned char* ws = p.ws;
    const bf16_t* QB = (const bf16_t*)(ws + WS_QB); const bf16_t* KB = (const bf16_t*)(ws + WS_KB); const bf16_t* V = (const bf16_t*)(ws + WS_V);
    const float* LAM = (const float*)(ws + WS_LAM); float* OSP = (float*)(ws + WS_OSP);
    const int dblk = task & 7, hd = (task >> 3) & 3, b = task >> 5; const int row = MP + b;
    const size_t sbase = ((size_t)(b * NH + hd) * DK + 32 * dblk) * DV;
    const float* S0 = p.state_gla + sbase; float* So = p.out + O_GLAS + sbase;
    const int dl = lane & 31;
    const float lam_l = LAM[(size_t)(128 + b) * KW + hd * 256 + 32 * dblk + dl];
    const float k_l = bf1(KB[(size_t)row * KW + hd * 256 + 32 * dblk + dl]);
    const float q_l = bf1(QB[(size_t)row * KW + hd * 256 + 32 * dblk + dl]);
    f32x4 va, vb;
    { const u32x2 w = *(const u32x2*)(V + (size_t)row * VW + hd * 512 + 4 * lane); va = (f32x4){bflo(w.x), bfhi(w.x), bflo(w.y), bfhi(w.y)}; }
    { const u32x2 w = *(const u32x2*)(V + (size_t)row * VW + hd * 512 + 256 + 4 * lane); vb = (f32x4){bflo(w.x), bfhi(w.x), bflo(w.y), bfhi(w.y)}; }
    f32x4 oa = {0.f, 0.f, 0.f, 0.f}, ob = {0.f, 0.f, 0.f, 0.f};
#pragma unroll 1
    for (int d0 = 0; d0 < 32; d0 += 8) {
        f32x4 ra[8], rb[8];
#pragma unroll
        for (int i = 0; i < 8; ++i) { ra[i] = __builtin_nontemporal_load((const f32x4*)(S0 + (size_t)(d0 + i) * DV + 4 * lane)); rb[i] = __builtin_nontemporal_load((const f32x4*)(S0 + (size_t)(d0 + i) * DV + 256 + 4 * lane)); }
#pragma unroll
        for (int i = 0; i < 8; ++i) { const int d = d0 + i;
            const float lam = __uint_as_float(__builtin_amdgcn_readlane(__float_as_uint(lam_l), d)), kk = __uint_as_float(__builtin_amdgcn_readlane(__float_as_uint(k_l), d)), qq = __uint_as_float(__builtin_amdgcn_readlane(__float_as_uint(q_l), d));
            const f32x4 sa = ra[i] * lam + va * kk, sb = rb[i] * lam + vb * kk;
            __builtin_nontemporal_store(sa, (f32x4*)(So + (size_t)d * DV + 4 * lane)); __builtin_nontemporal_store(sb, (f32x4*)(So + (size_t)d * DV + 256 + 4 * lane));
            oa += sa * qq; ob += sb * qq; }
    }
    float* op = OSP + ((size_t)(b * NH + hd) * 8 + dblk) * DV;
    *(f32x4*)(op + 4 * lane) = oa; *(f32x4*)(op + 256 + 4 * lane) = ob;
}

DI void pmix_task(const Params& p, int t, int lane) {
    unsigned char* ws = p.ws;
    const float* U = (const float*)(ws + WS_U); bf16_t* PM = (bf16_t*)(ws + WS_PM);
    if (t < MP) {
        const int b = t >> 11, pos = t & 2047;
#pragma unroll
        for (int i = 0; i < 4; ++i) {
            const int w = 2 << i, c = 256 * i + 4 * lane; const int cnt = (pos + 1 < w) ? pos + 1 : w;
            const f32x4 u0 = *(const f32x4*)(U + (size_t)t * POOLW + c); f32x4 s = u0;
#pragma unroll
            for (int j = 1; j < w; ++j) {
                const bool in = j < cnt; const f32x4 v = *(const f32x4*)(U + (size_t)(in ? t - j : t) * POOLW + c); const float m = in ? 1.f : 0.f; s += v * m; }
            const float inv = 1.0f / (float)cnt; const f32x4 mx = s * inv - u0;
            u32x2 o; o.x = pk2(mx.x, mx.y); o.y = pk2(mx.z, mx.w); *(u32x2*)(PM + (size_t)t * POOLW + c) = o;
            if (pos >= SEQ - 15) *(f32x4*)(p.out + O_POOLP + ((size_t)b * 15 + (pos - (SEQ - 15))) * POOLW + c) = u0;
        }
    } else {
        const int b = t - MP; const float* sp = p.state_pool + (size_t)b * 15 * POOLW; float* po = p.out + O_POOLS + (size_t)b * 15 * POOLW;
#pragma unroll
        for (int i = 0; i < 4; ++i) {
            const int w = 2 << i, c = 256 * i + 4 * lane;
            const f32x4 u0 = *(const f32x4*)(U + (size_t)t * POOLW + c); f32x4 s = u0;
#pragma unroll
            for (int j = 1; j < w; ++j) s += *(const f32x4*)(sp + (size_t)(15 - j) * POOLW + c);
            const float inv = 1.0f / (float)w; const f32x4 mx = s * inv - u0;
            u32x2 o; o.x = pk2(mx.x, mx.y); o.y = pk2(mx.z, mx.w); *(u32x2*)(PM + (size_t)t * POOLW + c) = o;
#pragma unroll
            for (int r = 0; r < 14; ++r) *(f32x4*)(po + (size_t)r * POOLW + c) = *(const f32x4*)(sp + (size_t)(r + 1) * POOLW + c);
            *(f32x4*)(po + (size_t)14 * POOLW + c) = u0;
        }
    }
}

#ifndef P2_REP
#define P2_REP 0
#endif
DI void phase_p2(const Params& p, LAS unsigned char* lds, int wave) {
    const int G = gridDim.x;
    if (wave == 0) { const int vc = (G % 8 == 0) ? ((int)blockIdx.x % 8) * (G / 8) + (int)blockIdx.x / 8 : (int)blockIdx.x;
        for (int rep = 0; rep < ((P2_REP & 1) ? 2 : 1); ++rep) for (int task = vc; task < NB * NH * NSL; task += G) scan_task(p, lds, task); }
    else {
        const int lane = lane_id(); const int gw = (int)blockIdx.x * 7 + (wave - 1), NGW = G * 7;
        for (int rep = 0; rep < ((P2_REP & 2) ? 2 : 1); ++rep) {
        for (int t = gw; t < M; t += NGW) pmix_task(p, t, lane);
        for (int task = gw; task < MS * NH * 8; task += NGW) sgla_task(p, task, lane); }
    }
}

DI void ogn_task(const Params& p, int t, int lane) {
    unsigned char* ws = p.ws;
    bf16_t* OG = (bf16_t*)(ws + WS_OG); const float* OSS = (const float*)(ws + WS_OSS); const float* OSP = (const float*)(ws + WS_OSP); const bf16_t* SR = (const bf16_t*)(ws + WS_SR);
    if (t < MP) {
#pragma unroll
        for (int hd = 0; hd < 4; ++hd) {
            const float* sp = OSS + (size_t)t * 64 + hd * 16; const f32x4 a = *(const f32x4*)sp, b = *(const f32x4*)(sp + 4), c = *(const f32x4*)(sp + 8), d = *(const f32x4*)(sp + 12);
            const float ss = ((a.x + a.y) + (a.z + a.w)) + ((b.x + b.y) + (b.z + b.w)) + ((c.x + c.y) + (c.z + c.w)) + ((d.x + d.y) + (d.z + d.w));
            const float rstd = 1.0f / sqrtf(ss * (1.0f / DV) + EPS);
            bf16_t* op = OG + (size_t)t * VW + hd * 512 + 8 * lane; const u32x4 w = *(const u32x4*)op; const u32x4 g = *(const u32x4*)(SR + (size_t)t * VW + hd * 512 + 8 * lane);
            u32x4 o; o.x = pk2(bflo(w.x) * rstd * bflo(g.x), bfhi(w.x) * rstd * bfhi(g.x)); o.y = pk2(bflo(w.y) * rstd * bflo(g.y), bfhi(w.y) * rstd * bfhi(g.y));
            o.z = pk2(bflo(w.z) * rstd * bflo(g.z), bfhi(w.z) * rstd * bfhi(g.z)); o.w = pk2(bflo(w.w) * rstd * bflo(g.w), bfhi(w.w) * rstd * bfhi(g.w));
            *(u32x4*)op = o;
        }
    } else {
        const int b = t - MP;
#pragma unroll
        for (int hd = 0; hd < 4; ++hd) {
            f32x4 oa = {0.f, 0.f, 0.f, 0.f}, ob = {0.f, 0.f, 0.f, 0.f};
#pragma unroll
            for (int k = 0; k < 8; ++k) { const float* op = OSP + ((size_t)(b * NH + hd) * 8 + k) * DV + 8 * lane; oa += *(const f32x4*)op; ob += *(const f32x4*)(op + 4); }
            float ss = (oa.x * oa.x + oa.y * oa.y) + (oa.z * oa.z + oa.w * oa.w) + (ob.x * ob.x + ob.y * ob.y) + (ob.z * ob.z + ob.w * ob.w);
            ss = wave_sum(ss);
            const float rstd = 1.0f / sqrtf(ss * (1.0f / DV) + EPS);
            const u32x4 w = *(const u32x4*)(SR + (size_t)t * VW + hd * 512 + 8 * lane);
            u32x4 o; o.x = pk2(oa.x * rstd * bflo(w.x), oa.y * rstd * bfhi(w.x)); o.y = pk2(oa.z * rstd * bflo(w.y), oa.w * rstd * bfhi(w.y));
            o.z = pk2(ob.x * rstd * bflo(w.z), ob.y * rstd * bfhi(w.z)); o.w = pk2(ob.z * rstd * bflo(w.w), ob.w * rstd * bfhi(w.w));
            *(u32x4*)(OG + (size_t)t * VW + hd * 512 + 8 * lane) = o;
        }
    }
}
DI void phase_p3(const Params& p, int wave) {
    const int lane = lane_id();
    const int gw = (int)blockIdx.x * NWAVES + wave, NGW = gridDim.x * NWAVES;
    for (int t = gw; t < M; t += NGW) ogn_task(p, t, lane);
}

DI float row_rstd(const float* SS, const float* SSs, int row, int lane) {
    float v = (row < MP) ? ((lane < 32) ? SS[(size_t)row * 32 + lane] : 0.f) : (SSs[(size_t)(row - MP) * 128 + lane] + SSs[(size_t)(row - MP) * 128 + 64 + lane]);
    v = wave_sum(v);
    return 1.0f / sqrtf(v * (1.0f / D) + EPS);
}

struct F8 { f32x4 a, b; };
DI F8 unpack8(u32x4 w, float s) { F8 r; r.a = (f32x4){bflo(w.x) * s, bfhi(w.x) * s, bflo(w.y) * s, bfhi(w.y) * s}; r.b = (f32x4){bflo(w.z) * s, bfhi(w.z) * s, bflo(w.w) * s, bfhi(w.w) * s}; return r; }
DI F8 ld8(const float* q) { F8 r; r.a = *(const f32x4*)q; r.b = *(const f32x4*)(q + 4); return r; }
DI void st8(float* q, const F8& v) { *(f32x4*)q = v.a; *(f32x4*)(q + 4) = v.b; }
DI f32x4 silu4(f32x4 x) { return (f32x4){siluf_(x.x), siluf_(x.y), siluf_(x.z), siluf_(x.w)}; }
DI void conv_task(const Params& p, int t, int lane) {
    unsigned char* ws = p.ws;
    const bf16_t* GU = (const bf16_t*)(ws + WS_GU); const float* SS1 = (const float*)(ws + WS_SS1); const float* SS1S = (const float*)(ws + WS_SS1S); bf16_t* ACT = (bf16_t*)(ws + WS_ACT);
    const bool prompt = t < MP; const int b = prompt ? (t >> 11) : (t - MP), pos = prompt ? (t & 2047) : 2;
    const float r0 = row_rstd(SS1, SS1S, t, lane);
    const float r1 = (prompt && pos >= 1) ? row_rstd(SS1, SS1S, t - 1, lane) : 0.f;
    const float r2 = (prompt && pos >= 2) ? row_rstd(SS1, SS1S, t - 2, lane) : 0.f;
    const bf16_t* g0p = GU + (size_t)t * NUP; const bf16_t* g1p = GU + (size_t)((prompt && pos >= 1) ? t - 1 : t) * NUP; const bf16_t* g2p = GU + (size_t)((prompt && pos >= 2) ? t - 2 : t) * NUP;
    const float* sc = p.state_conv + (size_t)b * 2 * DFF;
    for (int v = lane; v < DFF / 8; v += 64) {
        const int ch0 = 8 * v, pn = ch0 >> 7, r = ch0 & 127, gcol = 256 * pn + r, ucol = gcol + 128;
        const F8 g0 = unpack8(*(const u32x4*)(g0p + gcol), r0), up = unpack8(*(const u32x4*)(g0p + ucol), r0);
        F8 g1, g2;
        if (prompt) { g1 = unpack8(*(const u32x4*)(g1p + gcol), r1); g2 = unpack8(*(const u32x4*)(g2p + gcol), r2); }
        else { g1 = ld8(sc + DFF + ch0); g2 = ld8(sc + ch0); }
        const F8 w0 = ld8(p.conv_w + ch0), w1 = ld8(p.conv_w + DFF + ch0), w2 = ld8(p.conv_w + 2 * DFF + ch0), cb = ld8(p.conv_b + ch0);
        const f32x4 ga = cb.a + w0.a * g2.a + w1.a * g1.a + w2.a * g0.a, gb = cb.b + w0.b * g2.b + w1.b * g1.b + w2.b * g0.b;
        const f32x4 aa = silu4(ga) * up.a, ab = silu4(gb) * up.b;
        u32x4 o; o.x = pk2(aa.x, aa.y); o.y = pk2(aa.z, aa.w); o.z = pk2(ab.x, ab.y); o.w = pk2(ab.z, ab.w);
        *(u32x4*)(ACT + (size_t)t * DFF + ch0) = o;
        if (prompt) { if (pos >= SEQ - 2) st8(p.out + O_CONVP + ((size_t)b * 2 + (pos - (SEQ - 2))) * DFF + ch0, g0); }
        else { float* co = p.out + O_CONVS + (size_t)b * 2 * DFF + ch0; st8(co, g1); st8(co + DFF, g0); }
    }
}
DI void phase_conv(const Params& p, int wave) {
    const int lane = lane_id();
    const int gw = (int)blockIdx.x * NWAVES + wave, NGW = gridDim.x * NWAVES;
    for (int t = gw; t < M; t += NGW) conv_task(p, t, lane);
}

DI void phase_final(const Params& p, int wave) {
    const int lane = lane_id();
    const int gw = (int)blockIdx.x * NWAVES + wave, NGW = gridDim.x * NWAVES;
    const float* H3 = (const float*)(p.ws + WS_H3); const float* SS3 = (const float*)(p.ws + WS_SS3); const float* SS3S = (const float*)(p.ws + WS_SS3S);
    for (int t = gw; t < M; t += NGW) {
        const float rs = row_rstd(SS3, SS3S, t, lane);
        float* yo = (t < MP) ? p.out + O_YP + (size_t)t * D : p.out + O_YS + (size_t)(t - MP) * D;
#pragma unroll
        for (int i = 0; i < 8; ++i) { const int c = 256 * i + 4 * lane; const f32x4 hv = *(const f32x4*)(H3 + (size_t)t * D + c), g = *(const f32x4*)(p.norm_final + c);
            *(f32x4*)(yo + c) = hv * rs * g; }
    }
}

#define EPI_ARGS const f32x4 (&acc)[2][2][4][2], const g8::Unit& u, int wr, int wc, int fr, int fq
#define EPI_ROWS(ROWVAR) _Pragma("unroll") for (int ai = 0; ai < 2; ++ai) _Pragma("unroll") for (int m = 0; m < 4; ++m) { const int ROWVAR = u.pm * 256 + ai * 128 + wr * 64 + m * 16 + fr; if (ROWVAR < M) {
#define EPI_COLS(COLVAR) _Pragma("unroll") for (int bj = 0; bj < 2; ++bj) { const int COLVAR = bj * 128 + wc * 32 + 8 * fq; const f32x4 v0 = acc[ai][bj][m][0], v1 = acc[ai][bj][m][1];
#define EPI_END } } }
DI u32x4 pk8(f32x4 a, f32x4 b) { u32x4 o; o.x = pk2(a.x, a.y); o.y = pk2(a.z, a.w); o.z = pk2(b.x, b.y); o.w = pk2(b.z, b.w); return o; }
DI f32x4 exp4(f32x4 x) { return (f32x4){__expf(x.x), __expf(x.y), __expf(x.z), __expf(x.w)}; }
DI f32x4 sig4(f32x4 x) { return (f32x4){sigmoidf_(x.x), sigmoidf_(x.y), sigmoidf_(x.z), sigmoidf_(x.w)}; }
DI f32x4 bf4lo(u32x4 w) { return (f32x4){bflo(w.x), bfhi(w.x), bflo(w.y), bfhi(w.y)}; }
DI f32x4 bf4hi(u32x4 w) { return (f32x4){bflo(w.z), bfhi(w.z), bflo(w.w), bfhi(w.w)}; }
DI float sum4(f32x4 a) { return (a.x + a.y) + (a.z + a.w); }

struct PhaseIn {
    static constexpr int LDA = D, LDB = D, KT = D / 64;
    const Params& p; int G, c;
    DI bool next(int i, g8::Unit& u) const { int pm, pn; if (!g8::grid_order(NTM, 44, G, c, i, pm, pn)) return false;
        u.pm = pm; u.pn = pn; u.A = (const char*)(p.ws + WS_XB) + (size_t)pm * 256 * D * 2; u.B = (const char*)(p.ws + WS_WIN) + (size_t)pn * 256 * D * 2; return true; }
    DI void epi(EPI_ARGS) const {
        unsigned char* ws = p.ws; const float* RSTD1 = (const float*)(ws + WS_RSTD1); const float* BCUM = (const float*)(ws + WS_BCUM);
        const int pn = u.pn;
        if (pn < 4) {
            bf16_t* QB = (bf16_t*)(ws + WS_QB);
            EPI_ROWS(row) const float rs = RSTD1[row] * 0.0625f; EPI_COLS(col) const size_t o = (size_t)row * KW + pn * 256 + col;
                const f32x4 e0 = exp4(*(const f32x4*)(BCUM + o)), e1 = exp4(*(const f32x4*)(BCUM + o + 4));
                *(u32x4*)(QB + o) = pk8(v0 * rs * e0, v1 * rs * e1); EPI_END
        } else if (pn < 8) {
            bf16_t* KB = (bf16_t*)(ws + WS_KB); bf16_t* KD = (bf16_t*)(ws + WS_KD);
            EPI_ROWS(row) const float rs = RSTD1[row]; const int lrow = (row < MP) ? (row | 63) : row; EPI_COLS(col) const size_t o = (size_t)row * KW + (pn - 4) * 256 + col, ol = (size_t)lrow * KW + (pn - 4) * 256 + col;
                const f32x4 b0 = *(const f32x4*)(BCUM + o), b1 = *(const f32x4*)(BCUM + o + 4), l0 = *(const f32x4*)(BCUM + ol), l1 = *(const f32x4*)(BCUM + ol + 4);
                const f32x4 k0 = v0 * rs, k1 = v1 * rs;
                *(u32x4*)(KB + o) = pk8(k0 * exp4(-b0), k1 * exp4(-b1)); *(u32x4*)(KD + o) = pk8(k0 * exp4(l0 - b0), k1 * exp4(l1 - b1)); EPI_END
        } else if (pn < 16) {
            bf16_t* V = (bf16_t*)(ws + WS_V);
            EPI_ROWS(row) const float rs = RSTD1[row]; EPI_COLS(col) *(u32x4*)(V + (size_t)row * VW + (pn - 8) * 256 + col) = pk8(v0 * rs, v1 * rs); EPI_END
        } else if (pn < 24) {
            bf16_t* SR = (bf16_t*)(ws + WS_SR);
            EPI_ROWS(row) const float rs = RSTD1[row]; EPI_COLS(col) const f32x4 a = v0 * rs, b = v1 * rs; *(u32x4*)(SR + (size_t)row * VW + (pn - 16) * 256 + col) = pk8(a * sig4(a), b * sig4(b)); EPI_END
        } else if (pn < 28) {
            float* U = (float*)(ws + WS_U);
            EPI_ROWS(row) const float rs = RSTD1[row]; EPI_COLS(col) float* o = U + (size_t)row * POOLW + (pn - 24) * 256 + col; *(f32x4*)o = v0 * rs; *(f32x4*)(o + 4) = v1 * rs; EPI_END
        } else {
            bf16_t* Gt = (bf16_t*)(ws + (pn < 36 ? WS_GA : WS_GB)); const int c0 = (pn < 36 ? pn - 28 : pn - 36) * 256;
            EPI_ROWS(row) const float rs = RSTD1[row]; EPI_COLS(col) *(u32x4*)(Gt + (size_t)row * D + c0 + col) = pk8(sig4(v0 * rs), sig4(v1 * rs)); EPI_END
        }
    }
};

template <int LDA_, int LDB_, int K_> struct PhaseN2048 {
    static constexpr int LDA = LDA_, LDB = LDB_, KT = K_ / 64;
    const Params& p; int G, c; size_t a_off, b_off;
    DI bool next_(int i, g8::Unit& u) const { int pm, pn; if (!g8::grid_order(NTM - 1, 8, G, c, i, pm, pn)) return false;
        u.pm = pm; u.pn = pn; u.A = (const char*)(p.ws + a_off) + (size_t)pm * 256 * LDA * 2; u.B = (const char*)(p.ws + b_off) + (size_t)pn * 256 * LDB * 2; return true; }
};
struct PhaseYb : PhaseN2048<POOLW, POOLW, POOLW> {
    DI bool next(int i, g8::Unit& u) const { return next_(i, u); }
    DI void epi(EPI_ARGS) const { const bf16_t* GB = (const bf16_t*)(p.ws + WS_GB); float* Y = (float*)(p.ws + WS_YBG);
#pragma unroll
        for (int ai = 0; ai < 2; ++ai) { u32x4 g[4][2];
#pragma unroll
            for (int m = 0; m < 4; ++m)
#pragma unroll
                for (int bj = 0; bj < 2; ++bj) g[m][bj] = *(const u32x4*)(GB + (size_t)(u.pm * 256 + ai * 128 + wr * 64 + m * 16 + fr) * D + u.pn * 256 + bj * 128 + wc * 32 + 8 * fq);
#pragma unroll
            for (int m = 0; m < 4; ++m)
#pragma unroll
                for (int bj = 0; bj < 2; ++bj) { const size_t o = (size_t)(u.pm * 256 + ai * 128 + wr * 64 + m * 16 + fr) * D + u.pn * 256 + bj * 128 + wc * 32 + 8 * fq;
                    *(f32x4*)(Y + o) = acc[ai][bj][m][0] * bf4lo(g[m][bj]); *(f32x4*)(Y + o + 4) = acc[ai][bj][m][1] * bf4hi(g[m][bj]); } } }
};
struct PhaseYa : PhaseN2048<VW, VW, VW> {
    DI bool next(int i, g8::Unit& u) const { return next_(i, u); }
    DI void epi(EPI_ARGS) const { const bf16_t* GA = (const bf16_t*)(p.ws + WS_GA); const float* Y = (const float*)(p.ws + WS_YBG); bf16_t* MB = (bf16_t*)(p.ws + WS_MB);
#pragma unroll
        for (int ai = 0; ai < 2; ++ai)
#pragma unroll
            for (int mh = 0; mh < 2; ++mh) { u32x4 g[2][2]; f32x4 y0[2][2], y1[2][2];
#pragma unroll
                for (int mm = 0; mm < 2; ++mm)
#pragma unroll
                    for (int bj = 0; bj < 2; ++bj) { const size_t o = (size_t)(u.pm * 256 + ai * 128 + wr * 64 + (2 * mh + mm) * 16 + fr) * D + u.pn * 256 + bj * 128 + wc * 32 + 8 * fq;
                        g[mm][bj] = *(const u32x4*)(GA + o); y0[mm][bj] = *(const f32x4*)(Y + o); y1[mm][bj] = *(const f32x4*)(Y + o + 4); }
#pragma unroll
                for (int mm = 0; mm < 2; ++mm)
#pragma unroll
                    for (int bj = 0; bj < 2; ++bj) { const int m = 2 * mh + mm; const size_t o = (size_t)(u.pm * 256 + ai * 128 + wr * 64 + m * 16 + fr) * D + u.pn * 256 + bj * 128 + wc * 32 + 8 * fq;
                        *(u32x4*)(MB + o) = pk8(acc[ai][bj][m][0] * bf4lo(g[mm][bj]) + y0[mm][bj], acc[ai][bj][m][1] * bf4hi(g[mm][bj]) + y1[mm][bj]); } } }
};
DI void epi_residual(EPI_ARGS, const float* base_p, float* H, bf16_t* HB, float* SS) {
#pragma unroll
    for (int ai = 0; ai < 2; ++ai)
#pragma unroll
        for (int mh = 0; mh < 2; ++mh) {
            f32x4 b0[2][2], b1[2][2];
#pragma unroll
            for (int mm = 0; mm < 2; ++mm) { const int row = u.pm * 256 + ai * 128 + wr * 64 + (2 * mh + mm) * 16 + fr;
#pragma unroll
                for (int bj = 0; bj < 2; ++bj) { const size_t o = (size_t)row * D + u.pn * 256 + bj * 128 + wc * 32 + 8 * fq; b0[mm][bj] = *(const f32x4*)(base_p + o); b1[mm][bj] = *(const f32x4*)(base_p + o + 4); } }
#pragma unroll
            for (int mm = 0; mm < 2; ++mm) { const int m = 2 * mh + mm; const int row = u.pm * 256 + ai * 128 + wr * 64 + m * 16 + fr; float ss = 0.f;
#pragma unroll
                for (int bj = 0; bj < 2; ++bj) { const size_t o = (size_t)row * D + u.pn * 256 + bj * 128 + wc * 32 + 8 * fq;
                    const f32x4 h0 = acc[ai][bj][m][0] + b0[mm][bj], h1 = acc[ai][bj][m][1] + b1[mm][bj];
                    *(f32x4*)(H + o) = h0; *(f32x4*)(H + o + 4) = h1; *(u32x4*)(HB + o) = pk8(h0, h1);
                    ss += sum4(h0 * h0) + sum4(h1 * h1); }
                ss += __shfl_xor(ss, 16); ss += __shfl_xor(ss, 32);
                if (fq == 0) SS[(size_t)row * 32 + u.pn * 4 + wc] = ss; }
        }
}
struct PhaseOut : PhaseN2048<D, D, D> {
    DI bool next(int i, g8::Unit& u) const { return next_(i, u); }
    DI void epi(EPI_ARGS) const { epi_residual(acc, u, wr, wc, fr, fq, p.x_prompt, (float*)(p.ws + WS_H1), (bf16_t*)(p.ws + WS_H1B), (float*)(p.ws + WS_SS1)); }
};
struct PhaseDown : PhaseN2048<DFF, DFF, DFF> {
    DI bool next(int i, g8::Unit& u) const { return next_(i, u); }
    DI void epi(EPI_ARGS) const { epi_residual(acc, u, wr, wc, fr, fq, (const float*)(p.ws + WS_H1), (float*)(p.ws + WS_H2), (bf16_t*)(p.ws + WS_H2B), (float*)(p.ws + WS_SS2)); }
};
struct PhasePe : PhaseN2048<PLE, PLE, PLE> {
    DI bool next(int i, g8::Unit& u) const { return next_(i, u); }
    DI void epi(EPI_ARGS) const { float* PE = (float*)(p.ws + WS_PE);
        EPI_ROWS(row) EPI_COLS(col) const size_t o = (size_t)row * D + u.pn * 256 + col; *(f32x4*)(PE + o) = v0; *(f32x4*)(PE + o + 4) = v1; EPI_END }
};
struct PhasePg : PhaseN2048<D, D, D> {
    DI bool next(int i, g8::Unit& u) const { return next_(i, u); }
    DI void epi(EPI_ARGS) const { const float* H2 = (const float*)(p.ws + WS_H2); const float* PE = (const float*)(p.ws + WS_PE); const float* SS2 = (const float*)(p.ws + WS_SS2);
        float* H3 = (float*)(p.ws + WS_H3); float* SS3 = (float*)(p.ws + WS_SS3);
#pragma unroll
        for (int ai = 0; ai < 2; ++ai)
#pragma unroll
            for (int m = 0; m < 4; ++m) { f32x4 hA[2], hB[2], pA[2], pB[2];
                const int row = u.pm * 256 + ai * 128 + wr * 64 + m * 16 + fr; float s2 = 0.f;
#pragma unroll
                for (int k = 0; k < 8; ++k) s2 += sum4(*(const f32x4*)(SS2 + (size_t)row * 32 + 4 * k));
                const float rs = 1.0f / sqrtf(s2 * (1.0f / D) + EPS);
#pragma unroll
                for (int bj = 0; bj < 2; ++bj) { const size_t o = (size_t)row * D + u.pn * 256 + bj * 128 + wc * 32 + 8 * fq;
                    hA[bj] = *(const f32x4*)(H2 + o); hB[bj] = *(const f32x4*)(H2 + o + 4); pA[bj] = *(const f32x4*)(PE + o); pB[bj] = *(const f32x4*)(PE + o + 4); }
                float ss = 0.f;
#pragma unroll
                for (int bj = 0; bj < 2; ++bj) { const size_t o = (size_t)row * D + u.pn * 256 + bj * 128 + wc * 32 + 8 * fq;
                    const f32x4 h0 = hA[bj] + sig4(acc[ai][bj][m][0] * rs) * pA[bj], h1 = hB[bj] + sig4(acc[ai][bj][m][1] * rs) * pB[bj];
                    *(f32x4*)(H3 + o) = h0; *(f32x4*)(H3 + o + 4) = h1; ss += sum4(h0 * h0) + sum4(h1 * h1); }
                ss += __shfl_xor(ss, 16); ss += __shfl_xor(ss, 32);
                if (fq == 0) SS3[(size_t)row * 32 + u.pn * 4 + wc] = ss; } }
};
struct PhaseUp {
    static constexpr int LDA = D, LDB = D, KT = D / 64;
    const Params& p; int G, c;
    DI bool next(int i, g8::Unit& u) const { int pm, pn; if (!g8::grid_order(NTM, 43, G, c, i, pm, pn)) return false;
        u.pm = pm; u.pn = pn; u.A = (const char*)(p.ws + WS_H1B) + (size_t)pm * 256 * D * 2; u.B = (const char*)(p.ws + WS_WUP) + (size_t)pn * 256 * D * 2; return true; }
    DI void epi(EPI_ARGS) const { bf16_t* GU = (bf16_t*)(p.ws + WS_GU);
        EPI_ROWS(row) EPI_COLS(col) *(u32x4*)(GU + (size_t)row * NUP + u.pn * 256 + col) = pk8(v0, v1); EPI_END }
};

struct PhaseWpb {
    static constexpr int LDA = POOLW, LDB = 256, KT = 4;
    const Params& p; int G, c;
    DI bool next(int i, g8::Unit& u) const { const int off = 200 % G; const long L = (long)i * G + ((c + G - off) % G); if (L >= 32) return false;
        const int pm = (int)L >> 2, g = (int)L & 3; u.pm = pm; u.pn = g;
        u.A = (const char*)(p.ws + WS_WBT) + ((size_t)pm * 256 * POOLW + g * 256) * 2; u.B = (const char*)(p.ws + WS_WPS) + (size_t)g * 256 * 256 * 2; return true; }
    DI void epi(EPI_ARGS) const { bf16_t* W = (bf16_t*)(p.ws + WS_WPB);
        EPI_ROWS(row) EPI_COLS(col) *(u32x4*)(W + (size_t)row * POOLW + u.pn * 256 + col) = pk8(v0, v1); EPI_END }
};

template <int KS, int LDA, int LDB>
DI f32x4 skinny16(const bf16_t* A, const bf16_t* W, int lane) {
    const int fr = lane & 15, fq = lane >> 4;
    const bf16_t* ap = A + (size_t)fr * LDA + 8 * fq; const bf16_t* bp = W + (size_t)fr * LDB + 8 * fq;
    f32x4 acc = {0.f, 0.f, 0.f, 0.f};
#pragma unroll 4
    for (int s = 0; s < KS; ++s) { const bf16x8 a = *(const bf16x8*)(ap + 32 * s), b = *(const bf16x8*)(bp + 32 * s); acc = __builtin_amdgcn_mfma_f32_16x16x32_bf16(a, b, acc, 0, 0, 0); }
    return acc;
}
DI float sum16(float v) { v += __shfl_xor(v, 1); v += __shfl_xor(v, 2); v += __shfl_xor(v, 4); v += __shfl_xor(v, 8); return v; }
template <int KIND, int K, int LDA, int LDB>
DI void sample_gemm(const Params& p, LAS unsigned char* lds, size_t a_off, size_t w_off, int wave) {
    unsigned char* ws = p.ws; const int lane = lane_id(), fr = lane & 15, fq = lane >> 4;
    constexpr int KS = K / 64;
    for (int it = blockIdx.x; it < 256; it += gridDim.x) {
        const int cg_ = it >> 1, r0 = MP + 64 * (it & 1) + 16 * (wave & 3), col = 16 * cg_ + fr, kh = wave >> 2;
        f32x4 acc = skinny16<KS, LDA, LDB>((const bf16_t*)(ws + a_off) + (size_t)r0 * LDA + kh * (K / 2), (const bf16_t*)(ws + w_off) + (size_t)(16 * cg_) * LDB + kh * (K / 2), lane);
        LAS f32x4* xch = (LAS f32x4*)lds;
        if (kh == 1) xch[(wave & 3) * 64 + lane] = acc;
        __syncthreads();
        if (kh == 0) {
        acc += xch[wave * 64 + lane];
        float rs[4] = {0.f, 0.f, 0.f, 0.f};
        if (KIND == 5) {
            const float* SS2S = (const float*)(ws + WS_SS2S);
#pragma unroll
            for (int r = 0; r < 16; ++r) { const float* q = SS2S + (size_t)(r0 - MP + r) * 128; const float s_ = wave_sum(q[lane] + q[64 + lane]); const float rr = 1.0f / sqrtf(s_ * (1.0f / D) + EPS);
#pragma unroll
                for (int j = 0; j < 4; ++j) rs[j] = (r == 4 * fq + j) ? rr : rs[j]; }
        }
#pragma unroll
        for (int j = 0; j < 4; ++j) {
            const int row = r0 + 4 * fq + j; const size_t o = (size_t)row * D + col; const float v = acc[j]; float hsq = 0.f;
            if (KIND == 0) { ((float*)(ws + WS_YBG))[o] = v * bf1(((const bf16_t*)(ws + WS_GB))[o]); }
            if (KIND == 1) { ((bf16_t*)(ws + WS_MB))[o] = (bf16_t)(pk2(v * bf1(((const bf16_t*)(ws + WS_GA))[o]) + ((const float*)(ws + WS_YBG))[o], 0.f) & 0xffffu); }
            if (KIND == 2) { const float hv = p.x_sample[(size_t)(row - MP) * D + col] + v; ((float*)(ws + WS_H1))[o] = hv; ((bf16_t*)(ws + WS_H1B))[o] = (bf16_t)(pk2(hv, 0.f) & 0xffffu); hsq = hv * hv; }
            if (KIND == 3) { const float hv = ((const float*)(ws + WS_H1))[o] + v; ((float*)(ws + WS_H2))[o] = hv; ((bf16_t*)(ws + WS_H2B))[o] = (bf16_t)(pk2(hv, 0.f) & 0xffffu); hsq = hv * hv; }
            if (KIND == 4) { ((float*)(ws + WS_PE))[o] = v; }
            if (KIND == 5) { const float hv = ((const float*)(ws + WS_H2))[o] + sigmoidf_(v * rs[j]) * ((const float*)(ws + WS_PE))[o]; ((float*)(ws + WS_H3))[o] = hv; hsq = hv * hv; }
            if (KIND == 2 || KIND == 3 || KIND == 5) { const float t = sum16(hsq);
                float* SSx = (float*)(ws + (KIND == 2 ? WS_SS1S : (KIND == 3 ? WS_SS2S : WS_SS3S))); if (fr == 0) SSx[(size_t)(row - MP) * 128 + cg_] = t; }
        }
        }
        __syncthreads();
    }
}


#define XB_TMO      128
#define XB_XCNT(j)  (256  + 64 * (j))
#define XB_XSUB(j)  (1280 + 64 * (j))
#define XB_XGEN(j)  (2304 + 64 * (j))
#define XB_TOP      3328
#define XB_TOPGEN   3392
#define XCD_BAR_WORDS 3456
#define XB_SPIN_CAP (1u << 22)
DI unsigned xb_ld(unsigned* p)              { return __hip_atomic_load(p, __ATOMIC_RELAXED, __HIP_MEMORY_SCOPE_AGENT); }
DI unsigned xb_add(unsigned* p, unsigned v) { return __hip_atomic_fetch_add(p, v, __ATOMIC_RELAXED, __HIP_MEMORY_SCOPE_AGENT); }
DI unsigned xb_xcc_id() { return (unsigned)__builtin_amdgcn_s_getreg((3 << 11) | 20) & 0xFu; }
#define XB_SPIN(cond, bar) do { unsigned _sp = 0; while (cond) { __builtin_amdgcn_s_sleep(1); \
    if ((++_sp & 255u) == 0u) { if (xb_ld(&(bar)[XB_TMO])) break; if (_sp > XB_SPIN_CAP) { atomicAdd(&(bar)[XB_TMO], 1u); break; } } } } while (0)
struct XcdBarrier { unsigned* bar; unsigned x; volatile LAS unsigned* st; };
DI XcdBarrier xcd_barrier_post(unsigned* bar, volatile LAS unsigned* st, bool t0) {
    XcdBarrier b; b.bar = bar; b.x = xb_xcc_id(); b.st = st;
    if (t0) (void)xb_add(&bar[XB_XCNT(b.x)], 1u);
    return b;
}
DI void xcd_barrier_complete(unsigned* bar, unsigned x, unsigned& nloc, unsigned& nx) {
    const unsigned G = gridDim.x * gridDim.y * gridDim.z;
    unsigned sum, cnt, mine, sp = 0u;
    for (;;) {
        sum = 0u; cnt = 0u; mine = 0u;
#pragma unroll
        for (unsigned j = 0; j < 16; ++j) { const unsigned c = xb_ld(&bar[XB_XCNT(j)]); sum += c; cnt += (c > 0u) ? 1u : 0u; mine = (j == x) ? c : mine; }
        if (sum == G) break;
        __builtin_amdgcn_s_sleep(1);
        if ((++sp & 255u) == 0u) { if (xb_ld(&bar[XB_TMO])) break; if (sp > XB_SPIN_CAP) { atomicAdd(&bar[XB_TMO], 1u); break; } }
    }
    nloc = mine > 0u ? mine : 1u; nx = cnt > 0u ? cnt : 1u;
}
DI void xcd_barrier(const XcdBarrier& b, bool t0) {
    asm volatile("s_waitcnt vmcnt(0)" ::: "memory");
    __syncthreads();
    if (t0) {
        unsigned* bar = b.bar;
        __builtin_amdgcn_s_waitcnt(0);
        unsigned nloc = b.st[0], nx = b.st[1];
        if (nloc == 0u) { xcd_barrier_complete(bar, b.x, nloc, nx); b.st[0] = nloc; b.st[1] = nx; }
        const unsigned old = xb_add(&bar[XB_XSUB(b.x)], 1u);
        const unsigned gen = old / nloc;
        if (old + 1u == (gen + 1u) * nloc) {
            __builtin_amdgcn_fence(__ATOMIC_RELEASE, "agent");
            asm volatile("s_waitcnt vmcnt(0)" ::: "memory");
            const unsigned og = xb_add(&bar[XB_TOP], 1u);
            const unsigned tg = og / nx;
            if (og + 1u == (tg + 1u) * nx) xb_add(&bar[XB_TOPGEN], 1u);
            else XB_SPIN(xb_ld(&bar[XB_TOPGEN]) == tg, bar);
            __builtin_amdgcn_fence(__ATOMIC_ACQUIRE, "agent");
            xb_add(&bar[XB_XGEN(b.x)], 1u);
            asm volatile("s_waitcnt vmcnt(0)" ::: "memory");
        } else {
            XB_SPIN(xb_ld(&bar[XB_XGEN(b.x)]) == gen, bar);
            __builtin_amdgcn_fence(__ATOMIC_ACQUIRE, "agent");
            asm volatile("s_waitcnt vmcnt(0)" ::: "memory");
        }
    }
    __syncthreads();
}

constexpr int N_PHASES = 13;
#ifndef G8_SP2
#define G8_SP2 true
#endif
#ifndef G8_ALIGN
#define G8_ALIGN true
#endif

__global__ void __launch_bounds__(NTHREADS, 2) fwd_kernel(Params p) {
    extern __shared__ __attribute__((aligned(16))) unsigned char lds_raw[];
    LAS unsigned char* lds = (LAS unsigned char*)lds_raw;
    const int G = gridDim.x, c = blockIdx.x;
    const int wave = __builtin_amdgcn_readfirstlane(threadIdx.x >> 6);
    const int lo = p.ph_lo, hi = p.ph_hi;
#ifndef REPEAT_MASK
#define REPEAT_MASK 0
#endif
#ifndef PHASE_MASK
#define PHASE_MASK 0x1fff
#endif
#define IN(k) (((PHASE_MASK >> (k)) & 1) && lo <= (k) && (k) < hi)
    volatile LAS unsigned* bst = (volatile LAS unsigned*)(lds + LDS_MISC);
    const bool t0 = (wave == 0) && (lane_id() == 0);
    XcdBarrier bar; bar.bar = (unsigned*)(p.ws + WS_CTL); bar.x = 0; bar.st = bst;
    if (hi - lo > 1) { if (t0) { bst[0] = 0u; bst[1] = 0u; } __syncthreads(); bar = xcd_barrier_post((unsigned*)(p.ws + WS_CTL), bst, t0); }
#define SEAM(k) do { if (IN(k) && IN((k) + 1)) { xcd_barrier(bar, (wave == 0) && (lane_id() == 0)); } } while (0)
    if (IN(0)) { phase_p0(p, lds, wave); if ((REPEAT_MASK >> 0) & 1) { xcd_barrier(bar, (wave == 0) && (lane_id() == 0)); phase_p0(p, lds, wave); } } SEAM(0);
    if (IN(1)) { PhaseIn ph{p, G, c}; g8::run<PhaseIn, G8_ALIGN, G8_SP2>(lds, ph, wave); { PhaseWpb pw{p, G, c}; g8::run<PhaseWpb, G8_ALIGN, G8_SP2>(lds, pw, wave); } if ((REPEAT_MASK >> 1) & 1) { xcd_barrier(bar, (wave == 0) && (lane_id() == 0)); PhaseIn ph{p, G, c}; g8::run<PhaseIn, G8_ALIGN, G8_SP2>(lds, ph, wave); } } SEAM(1);
    if (IN(2)) { phase_p2(p, lds, wave); if ((REPEAT_MASK >> 2) & 1) { xcd_barrier(bar, (wave == 0) && (lane_id() == 0)); phase_p2(p, lds, wave); } } SEAM(2);
    if (IN(3)) { phase_p3(p, wave); if ((REPEAT_MASK >> 3) & 1) { xcd_barrier(bar, (wave == 0) && (lane_id() == 0)); phase_p3(p, wave); } } SEAM(3);
    if (IN(4)) { sample_gemm<0, POOLW, POOLW, POOLW>(p, lds, WS_PM, WS_WPB, wave); PhaseYb ph{{p, G, c, WS_PM, WS_WPB}}; g8::run<PhaseYb, G8_ALIGN, G8_SP2>(lds, ph, wave); if ((REPEAT_MASK >> 4) & 1) { xcd_barrier(bar, (wave == 0) && (lane_id() == 0)); sample_gemm<0, POOLW, POOLW, POOLW>(p, lds, WS_PM, WS_WPB, wave); PhaseYb ph{{p, G, c, WS_PM, WS_WPB}}; g8::run<PhaseYb, G8_ALIGN, G8_SP2>(lds, ph, wave); } } SEAM(4);
    if (IN(5)) { sample_gemm<1, VW, VW, VW>(p, lds, WS_OG, WS_WA, wave); PhaseYa ph{{p, G, c, WS_OG, WS_WA}}; g8::run<PhaseYa, G8_ALIGN, G8_SP2>(lds, ph, wave); if ((REPEAT_MASK >> 5) & 1) { xcd_barrier(bar, (wave == 0) && (lane_id() == 0)); sample_gemm<1, VW, VW, VW>(p, lds, WS_OG, WS_WA, wave); PhaseYa ph{{p, G, c, WS_OG, WS_WA}}; g8::run<PhaseYa, G8_ALIGN, G8_SP2>(lds, ph, wave); } } SEAM(5);
    if (IN(6)) { sample_gemm<2, D, D, D>(p, lds, WS_MB, WS_WO, wave); PhaseOut ph{{p, G, c, WS_MB, WS_WO}}; g8::run<PhaseOut, G8_ALIGN, G8_SP2>(lds, ph, wave); if ((REPEAT_MASK >> 6) & 1) { xcd_barrier(bar, (wave == 0) && (lane_id() == 0)); sample_gemm<2, D, D, D>(p, lds, WS_MB, WS_WO, wave); PhaseOut ph{{p, G, c, WS_MB, WS_WO}}; g8::run<PhaseOut, G8_ALIGN, G8_SP2>(lds, ph, wave); } } SEAM(6);
    if (IN(7)) { PhaseUp ph{p, G, c}; g8::run<PhaseUp, G8_ALIGN, G8_SP2>(lds, ph, wave); if ((REPEAT_MASK >> 7) & 1) { xcd_barrier(bar, (wave == 0) && (lane_id() == 0)); PhaseUp ph{p, G, c}; g8::run<PhaseUp, G8_ALIGN, G8_SP2>(lds, ph, wave); } } SEAM(7);
    if (IN(8)) { phase_conv(p, wave); if ((REPEAT_MASK >> 8) & 1) { xcd_barrier(bar, (wave == 0) && (lane_id() == 0)); phase_conv(p, wave); } } SEAM(8);
    if (IN(9)) { sample_gemm<3, DFF, DFF, DFF>(p, lds, WS_ACT, WS_WD, wave); PhaseDown ph{{p, G, c, WS_ACT, WS_WD}}; g8::run<PhaseDown, G8_ALIGN, G8_SP2>(lds, ph, wave); if ((REPEAT_MASK >> 9) & 1) { xcd_barrier(bar, (wave == 0) && (lane_id() == 0)); sample_gemm<3, DFF, DFF, DFF>(p, lds, WS_ACT, WS_WD, wave); PhaseDown ph{{p, G, c, WS_ACT, WS_WD}}; g8::run<PhaseDown, G8_ALIGN, G8_SP2>(lds, ph, wave); } } SEAM(9);
    if (IN(10)) { sample_gemm<4, PLE, PLE, PLE>(p, lds, WS_PLB, WS_WPLE, wave); PhasePe ph{{p, G, c, WS_PLB, WS_WPLE}}; g8::run<PhasePe, G8_ALIGN, G8_SP2>(lds, ph, wave); if ((REPEAT_MASK >> 10) & 1) { xcd_barrier(bar, (wave == 0) && (lane_id() == 0)); sample_gemm<4, PLE, PLE, PLE>(p, lds, WS_PLB, WS_WPLE, wave); PhasePe ph{{p, G, c, WS_PLB, WS_WPLE}}; g8::run<PhasePe, G8_ALIGN, G8_SP2>(lds, ph, wave); } } SEAM(10);
    if (IN(11)) { sample_gemm<5, D, D, D>(p, lds, WS_H2B, WS_WPG, wave); PhasePg ph{{p, G, c, WS_H2B, WS_WPG}}; g8::run<PhasePg, G8_ALIGN, G8_SP2>(lds, ph, wave); if ((REPEAT_MASK >> 11) & 1) { xcd_barrier(bar, (wave == 0) && (lane_id() == 0)); sample_gemm<5, D, D, D>(p, lds, WS_H2B, WS_WPG, wave); PhasePg ph{{p, G, c, WS_H2B, WS_WPG}}; g8::run<PhasePg, G8_ALIGN, G8_SP2>(lds, ph, wave); } } SEAM(11);
    if (IN(12)) { phase_final(p, wave); if ((REPEAT_MASK >> 12) & 1) { xcd_barrier(bar, (wave == 0) && (lane_id() == 0)); phase_final(p, wave); } }
#undef IN
#undef SEAM
}

extern "C" void kernel_launch(void* const* d_in, const int* in_sizes, int n_in, void* d_out, int out_size, void* d_ws, size_t ws_size, hipStream_t stream) {
    static int grid = 0;
    if (grid == 0) {
        if (n_in != 26 || (size_t)out_size != O_END || ws_size < WS_END) {
            fprintf(stderr, "kernel_launch: unexpected problem: n_in %d out %d ws %zu (need %zu)\n", n_in, out_size, ws_size, (size_t)WS_END); grid = -1; return; }
        int dev = 0, cus = 0, per_cu = 0;
        if (hipGetDevice(&dev) != hipSuccess || hipDeviceGetAttribute(&cus, hipDeviceAttributeMultiprocessorCount, dev) != hipSuccess) { grid = -1; return; }
        if (hipFuncSetAttribute((const void*)fwd_kernel, hipFuncAttributeMaxDynamicSharedMemorySize, LDS_BYTES) != hipSuccess) { fprintf(stderr, "kernel_launch: hipFuncSetAttribute failed\n"); grid = -1; return; }
        if (hipOccupancyMaxActiveBlocksPerMultiprocessor(&per_cu, (const void*)fwd_kernel, NTHREADS, LDS_BYTES) != hipSuccess || per_cu < 1) {
            fprintf(stderr, "kernel_launch: occupancy query reports %d blocks per CU\n", per_cu); (void)hipGetLastError(); grid = -1; return; }
        grid = cus;
    }
    if (grid < 0) return;
    Params p{};
    const float** pp = (const float**)&p;
    for (int i = 0; i < 26; ++i) pp[i] = (const float*)d_in[i];
    p.out = (float*)d_out; p.ws = (unsigned char*)d_ws;
#if MK_N_LAUNCHES == 1
    p.ph_lo = 0; p.ph_hi = N_PHASES;
    void* args[] = {&p};
    if (hipMemsetAsync((char*)d_ws + WS_CTL, 0, XCD_BAR_WORDS * 4, stream) != hipSuccess) { fprintf(stderr, "kernel_launch: memset failed\n"); return; }
    hipError_t e = hipLaunchCooperativeKernel((const void*)fwd_kernel, dim3(grid), dim3(NTHREADS), args, LDS_BYTES, stream);
    if (e != hipSuccess) fprintf(stderr, "kernel_launch: cooperative launch failed: %s (grid %d)\n", hipGetErrorString(e), grid);
#else
    for (int k = 0; k < N_PHASES; ++k) { p.ph_lo = k; p.ph_hi = k + 1; hipLaunchKernelGGL(fwd_kernel, dim3(grid), dim3(NTHREADS), LDS_BYTES, stream, p); }
#endif
}
```

```cpp
#include <hip/hip_runtime.h>
#include <hip/hip_cooperative_groups.h>
#include <cstdio>
#include <cstdint>
namespace cg = cooperative_groups;

#ifndef MK_N_LAUNCHES
#define MK_N_LAUNCHES 1
#endif

#define LAS __attribute__((address_space(3)))
#define DI __device__ __forceinline__
typedef unsigned short bf16_t;
typedef short bf16x8 __attribute__((ext_vector_type(8)));
typedef short s16x4 __attribute__((ext_vector_type(4)));
typedef float f32x4 __attribute__((ext_vector_type(4)));
typedef float f32x2 __attribute__((ext_vector_type(2)));
typedef float f32x16 __attribute__((ext_vector_type(16)));
typedef unsigned u32x4 __attribute__((ext_vector_type(4)));
typedef unsigned u32x2 __attribute__((ext_vector_type(2)));

constexpr int D = 2048, MP = 8192, MS = 128, M = MP + MS, MPAD = 8448, NTM = 33;
constexpr int SEQ = 2048, NB = 4, NH = 4, DK = 256, DV = 512, KW = 1024, VW = 2048;
constexpr int DFF = 5504, NUP = 2 * DFF, PLE = 256, POOLW = 1024, INW = 11280, NIN = 11264;
constexpr float EPS = 1e-6f;
constexpr int NSL = 16;
constexpr int CH = 32, NCHK = MP / CH;

constexpr size_t O_YP = 0, O_YS = O_YP + (size_t)MP * D, O_GLAP = O_YS + (size_t)MS * D, O_POOLP = O_GLAP + (size_t)NB * NH * DK * DV,
                 O_CONVP = O_POOLP + (size_t)NB * 15 * POOLW, O_GLAS = O_CONVP + (size_t)NB * 2 * DFF, O_POOLS = O_GLAS + (size_t)MS * NH * DK * DV,
                 O_CONVS = O_POOLS + (size_t)MS * 15 * POOLW, O_END = O_CONVS + (size_t)MS * 2 * DFF;

constexpr size_t al(size_t x) { return (x + 255) & ~(size_t)255; }
constexpr size_t WS_CTL = 0, CTL_BYTES = 65536;
constexpr size_t WS_WUP = WS_CTL + CTL_BYTES;
constexpr size_t WS_WD = WS_WUP + al((size_t)NUP * D * 2);
constexpr size_t WS_WA = WS_WD + al((size_t)D * DFF * 2);
constexpr size_t WS_WO = WS_WA + al((size_t)D * D * 2);
constexpr size_t WS_WPG = WS_WO + al((size_t)D * D * 2);
constexpr size_t WS_WPB = WS_WPG + al((size_t)D * D * 2);
constexpr size_t WS_WPLE = WS_WPB + al((size_t)D * POOLW * 2);
constexpr size_t WS_WBT = WS_WPLE + al((size_t)D * PLE * 2);
constexpr size_t WS_WPS = WS_WBT + al((size_t)D * POOLW * 2);
constexpr size_t WS_SMALL = WS_WPS + al((size_t)POOLW * 256 * 2);
constexpr size_t WS_RSTD1 = WS_SMALL;
constexpr size_t WS_LAM = WS_RSTD1 + al((size_t)MPAD * 4);
constexpr size_t WS_OSS = WS_LAM + al((size_t)(NCHK + MS) * KW * 4);
constexpr size_t WS_OSP = WS_OSS + al((size_t)MP * NH * NSL * 4);
constexpr size_t WS_SS1 = WS_OSP + al((size_t)MS * NH * 8 * DV * 4);
constexpr size_t WS_SS2 = WS_SS1 + al((size_t)MPAD * 32 * 4);
constexpr size_t WS_SS3 = WS_SS2 + al((size_t)MPAD * 32 * 4);
constexpr size_t WS_SS1S = WS_SS3 + al((size_t)MPAD * 32 * 4);
constexpr size_t WS_SS2S = WS_SS1S + al((size_t)MS * 128 * 4);
constexpr size_t WS_SS3S = WS_SS2S + al((size_t)MS * 128 * 4);
constexpr size_t WS_PLB = WS_SS3S + al((size_t)MS * 128 * 4);
constexpr size_t WS_R1 = WS_PLB + al((size_t)MPAD * PLE * 2);
constexpr size_t WS_XB = WS_R1;
constexpr size_t WS_WIN = WS_XB + al((size_t)MPAD * D * 2);
constexpr size_t WS_BCUM = WS_WIN + al((size_t)NIN * D * 2);
constexpr size_t WS_R1_END = WS_BCUM + al((size_t)MPAD * KW * 4);
constexpr size_t WS_ACT = WS_R1;
static_assert(WS_ACT + al((size_t)MPAD * DFF * 2) <= WS_R1_END, "R1 overlay");
constexpr size_t WS_R2 = WS_R1_END;
constexpr size_t WS_QB = WS_R2;
constexpr size_t WS_KB = WS_QB + al((size_t)MPAD * KW * 2);
constexpr size_t WS_KD = WS_KB + al((size_t)MPAD * KW * 2);
constexpr size_t WS_V = WS_KD + al((size_t)MPAD * KW * 2);
constexpr size_t WS_SR = WS_V + al((size_t)MPAD * VW * 2);
constexpr size_t WS_GA = WS_SR + al((size_t)MPAD * VW * 2);
constexpr size_t WS_GB = WS_GA + al((size_t)MPAD * D * 2);
constexpr size_t WS_U = WS_GB + al((size_t)MPAD * D * 2);
constexpr size_t WS_OG = WS_U + al((size_t)MPAD * POOLW * 4);
constexpr size_t WS_PM = WS_OG + al((size_t)MPAD * VW * 2);
constexpr size_t WS_YBG = WS_PM + al((size_t)MPAD * POOLW * 2);
constexpr size_t WS_R2_END = WS_YBG + al((size_t)MPAD * D * 4);
constexpr size_t WS_GU = WS_R2;
constexpr size_t WS_H2 = WS_GU + al((size_t)MPAD * NUP * 2);
constexpr size_t WS_PE = WS_H2 + al((size_t)MPAD * D * 4);
static_assert(WS_PE + al((size_t)MPAD * D * 4) <= WS_R2_END, "R2 overlay");
constexpr size_t WS_MB = WS_R2_END;
constexpr size_t WS_H1 = WS_MB + al((size_t)MPAD * D * 2);
constexpr size_t WS_H1B = WS_H1 + al((size_t)MPAD * D * 4);
constexpr size_t WS_END = WS_H1B + al((size_t)MPAD * D * 2);
constexpr size_t WS_H3 = WS_H1;
constexpr size_t WS_H2B = WS_MB;

DI unsigned pk2(float lo, float hi) {
    typedef __bf16 bf2 __attribute__((ext_vector_type(2)));
    f32x2 v = {lo, hi};
    bf2 b = __builtin_convertvector(v, bf2);
    return __builtin_bit_cast(unsigned, b);
}
DI float bflo(unsigned w) { return __uint_as_float(w << 16); }
DI float bfhi(unsigned w) { return __uint_as_float(w & 0xffff0000u); }
DI float bf1(bf16_t b) { return __uint_as_float(((unsigned)b) << 16); }
DI float fexp(float x) { return __expf(x); }
DI float sigmoidf_(float x) { return __builtin_amdgcn_rcpf(1.0f + __expf(-x)); }
DI float siluf_(float x) { return x * sigmoidf_(x); }
DI float logsigmoidf_(float z) { return fminf(z, 0.f) - __logf(1.0f + __expf(-fabsf(z))); }
DI float wave_sum(float v) {
#pragma unroll
    for (int o = 1; o < 64; o <<= 1) v += __shfl_xor(v, o);
    return v;
}
DI int lane_id() { int l; asm volatile("v_mbcnt_lo_u32_b32 %0, -1, 0\n\tv_mbcnt_hi_u32_b32 %0, -1, %0" : "=v"(l)); return l; }
#define LDS_WAIT() asm volatile("s_waitcnt lgkmcnt(0)" ::: "memory")
#define VM_WAIT() asm volatile("s_waitcnt vmcnt(0)" ::: "memory")

struct Params {
    const float *x_prompt, *x_sample, *state_gla, *state_pool, *state_conv, *p_prompt, *p_sample;
    const float *norm_mix, *w_in, *w_gate_up, *b_gate, *gla_norm, *w_branch_a, *w_pool, *pool_scale, *w_branch_b, *w_out, *norm_ffn, *w_up, *conv_w, *conv_b,
        *w_down, *norm_ple, *w_ple_gate, *w_ple, *norm_final;
    float* out; unsigned char* ws;
    int ph_lo, ph_hi;
};

constexpr int NWAVES = 8, NTHREADS = 512;
constexpr int LDS_BYTES = 147456;
constexpr int LDS_MISC = LDS_BYTES - 256;

namespace g8 {
constexpr int BM = 256, BK = 64, HALF = 128, HTB = HALF * BK * 2, STAGE_BYTES = 8 * HTB, NXCD = 8, WGM = 8;
DI int lds_byte(int r, int c) { const int st = (r >> 4) * 2 + (c >> 5), rr = r & 15, cc = c & 31, ob = rr * 64 + cc * 2; return st * 1024 + (ob ^ (((ob >> 9) & 1) << 5)); }
DI void stage_rc(int b, int& R, int& C) { const int st = b / 1024, sb = b % 1024, swz = sb ^ (((sb >> 9) & 1) << 5); R = (st >> 1) * 16 + swz / 64; C = (st & 1) * 32 + (swz % 64) / 2; }
DI int perm32(int rho) { const int n = rho >> 4, i = rho & 15; return 8 * (i >> 2) + 4 * n + (i & 3); }

struct Unit { const char* A; const char* B; int pm, pn; };

DI bool grid_order(int nM, int nN, int G, int c, int i, int& pm, int& pn) {
    const int nwg = nM * nN; const long L = (long)i * G + c; if (L >= nwg) return false;
    int wgid = (int)L; { const int q = nwg / NXCD, r = nwg % NXCD, xcd = wgid % NXCD, off = wgid / NXCD; wgid = (xcd < r ? xcd * (q + 1) : r * (q + 1) + (xcd - r) * q) + off; }
    const int nig = WGM * nN, gid = wgid / nig, fm = gid * WGM, gsz = (nM - fm) < WGM ? (nM - fm) : WGM;
    pm = fm + ((wgid % nig) % gsz); pn = (wgid % nig) / gsz; return true;
}

template <class P, bool ALIGN_EPI, bool SP2>
DI void run(LAS unsigned char* lds, const P& ph, int wid) {
    const int lane = lane_id(), tid = wid * 64 + lane, wr = wid >> 2, wc = wid & 3, fr = lane & 15, fq = lane >> 4;
    constexpr int nt = P::KT;
    unsigned voffA[2], voffB[2];
#pragma unroll
    for (int i = 0; i < 2; ++i) { int R, C; stage_rc(tid * 16 + i * 8192, R, C); const int Rb = (R & ~31) + perm32(R & 31);
        voffA[i] = (unsigned)(R * P::LDA + C) * 2u; voffB[i] = (unsigned)(Rb * P::LDB + C) * 2u; }
    constexpr size_t kstep = (size_t)(BK * 2);
    constexpr size_t hstepA = (size_t)HALF * P::LDA * 2, hstepB = (size_t)HALF * P::LDB * 2;
    const unsigned ldsw = (unsigned)wid * 1024u;
    const int aoff = lds_byte(wr * 64 + fr, fq * 8), boff = lds_byte(wc * 32 + fr, fq * 8);
#define G8_SA(b, h) (((b) * 2 + (h)) * HTB)
#define G8_SB(b, h) ((4 + (b) * 2 + (h)) * HTB)
#define G8_STAGE(bufoff, gbase, voff) do { _Pragma("unroll") for (int _i = 0; _i < 2; ++_i) \
        __builtin_amdgcn_global_load_lds((const unsigned*)((const char*)(gbase) + (voff)[_i]), (LAS unsigned*)(lds + (bufoff) + ldsw + _i * 8192), 16, 0, 0); } while (0)
#define G8_LDA(dst, b, h) do { _Pragma("unroll") for (int m = 0; m < 4; ++m) _Pragma("unroll") for (int k = 0; k < 2; ++k) dst[m][k] = *(const LAS bf16x8*)(lds + G8_SA(b, h) + aoff + m * 2048 + k * 1024); } while (0)
#define G8_LDB(dst, b, h) do { _Pragma("unroll") for (int n = 0; n < 2; ++n) _Pragma("unroll") for (int k = 0; k < 2; ++k) dst[n][k] = *(const LAS bf16x8*)(lds + G8_SB(b, h) + boff + n * 2048 + k * 1024); } while (0)
#define G8_MMA(ai, bj, At, Bt) do { __builtin_amdgcn_s_setprio(1); _Pragma("unroll") for (int m = 0; m < 4; ++m) _Pragma("unroll") for (int n = 0; n < 2; ++n) _Pragma("unroll") for (int k = 0; k < 2; ++k) \
        acc[ai][bj][m][n] = __builtin_amdgcn_mfma_f32_16x16x32_bf16(Bt[n][k], At[m][k], acc[ai][bj][m][n], 0, 0, 0); __builtin_amdgcn_s_setprio(0); } while (0)
#define G8_WAIT_V(n) asm volatile("s_waitcnt vmcnt(" #n ")" ::: "memory")
#define G8_WAIT_L(n) asm volatile("s_waitcnt lgkmcnt(" #n ")" ::: "memory")
#define G8_BAR __builtin_amdgcn_s_barrier()
#define G8_SCHED __builtin_amdgcn_sched_barrier(0)
    Unit cur, nxt; int ui = 0;
    if (!ph.next(0, cur)) return;
    f32x4 acc[2][2][4][2];
#pragma unroll
    for (int a = 0; a < 2; ++a)
#pragma unroll
        for (int b = 0; b < 2; ++b)
#pragma unroll
            for (int m = 0; m < 4; ++m)
#pragma unroll
                for (int n = 0; n < 2; ++n) acc[a][b][m][n] = (f32x4){0.f, 0.f, 0.f, 0.f};
    bf16x8 At[4][2], B0[2][2], B1[2][2];
    const char* cA = cur.A; const char* cB = cur.B;
    if constexpr (SP2) {
        G8_STAGE(G8_SB(0, 0), cB, voffB); G8_STAGE(G8_SB(0, 1), cB + hstepB, voffB); G8_STAGE(G8_SA(0, 0), cA, voffA); G8_STAGE(G8_SA(0, 1), cA + hstepA, voffA);
        if (wr == 1) G8_BAR;
        G8_WAIT_V(2); G8_BAR;
        G8_STAGE(G8_SB(1, 0), cB + kstep, voffB); G8_STAGE(G8_SA(1, 0), cA + kstep, voffA); G8_STAGE(G8_SB(1, 1), cB + hstepB + kstep, voffB);
        G8_WAIT_V(6); G8_BAR;
    } else {
        G8_STAGE(G8_SB(0, 0), cB, voffB); G8_STAGE(G8_SA(0, 0), cA, voffA); G8_STAGE(G8_SB(0, 1), cB + hstepB, voffB); G8_STAGE(G8_SA(0, 1), cA + hstepA, voffA);
        if (wr == 1) G8_BAR;
        G8_WAIT_V(4); G8_BAR;
        G8_STAGE(G8_SB(1, 0), cB + kstep, voffB); G8_STAGE(G8_SA(1, 0), cA + kstep, voffA); G8_STAGE(G8_SB(1, 1), cB + hstepB + kstep, voffB);
        G8_WAIT_V(6); G8_BAR;
    }
    for (;;) {
        const bool has_next = ph.next(ui + 1, nxt);
        const char* nA = has_next ? nxt.A : cA; const char* nB = has_next ? nxt.B : cB;
#pragma unroll 1
        for (int t = 0; t < nt; t += 2) {
            const bool last = (t == nt - 2);
            const char* a1 = cA + (size_t)(t + 1) * kstep;
            const char* a2 = last ? nA : cA + (size_t)(t + 2) * kstep; const char* b2 = last ? nB : cB + (size_t)(t + 2) * kstep;
            const char* a3 = a2 + kstep; const char* b3 = b2 + kstep;
            if constexpr (SP2) {
            G8_LDB(B0, 0, 0); G8_LDB(B1, 0, 1); G8_SCHED; G8_LDA(At, 0, 0); G8_STAGE(G8_SA(1, 1), a1 + hstepA, voffA);
            G8_WAIT_V(8); G8_WAIT_L(0); G8_BAR; G8_MMA(0, 0, At, B0); G8_MMA(0, 1, At, B1); G8_BAR; G8_SCHED;
            G8_LDA(At, 0, 1); G8_STAGE(G8_SB(0, 0), b2, voffB); G8_STAGE(G8_SB(0, 1), b2 + hstepB, voffB); G8_STAGE(G8_SA(0, 0), a2, voffA);
            G8_WAIT_V(8); G8_WAIT_L(0); G8_BAR; G8_MMA(1, 0, At, B0); G8_MMA(1, 1, At, B1); G8_BAR; G8_SCHED;
            G8_LDB(B0, 1, 0); G8_LDB(B1, 1, 1); G8_SCHED; G8_LDA(At, 1, 0); G8_STAGE(G8_SA(0, 1), a2 + hstepA, voffA);
            G8_WAIT_V(8); G8_WAIT_L(0); G8_BAR; G8_MMA(0, 0, At, B0); G8_MMA(0, 1, At, B1); G8_BAR; G8_SCHED;
            G8_LDA(At, 1, 1); G8_STAGE(G8_SB(1, 0), b3, voffB); G8_STAGE(G8_SB(1, 1), b3 + hstepB, voffB); G8_STAGE(G8_SA(1, 0), a3, voffA);
            G8_WAIT_V(8); G8_WAIT_L(0); G8_BAR; G8_MMA(1, 0, At, B0); G8_MMA(1, 1, At, B1); G8_BAR; G8_SCHED;
            } else {
            G8_LDB(B0, 0, 0); G8_SCHED; G8_LDA(At, 0, 0); G8_STAGE(G8_SA(1, 1), a1 + hstepA, voffA);
            G8_WAIT_L(8); G8_BAR; G8_WAIT_L(0); G8_MMA(0, 0, At, B0); G8_BAR; G8_SCHED;
            G8_LDB(B1, 0, 1); G8_STAGE(G8_SB(0, 0), b2, voffB);
            G8_BAR; G8_WAIT_L(0); G8_MMA(0, 1, At, B1); G8_BAR;
            G8_LDA(At, 0, 1); G8_STAGE(G8_SA(0, 0), a2, voffA);
            G8_BAR; G8_WAIT_L(0); G8_MMA(1, 0, At, B0); G8_BAR; G8_SCHED;
            G8_STAGE(G8_SB(0, 1), b2 + hstepB, voffB);
            G8_WAIT_V(6); G8_BAR; G8_MMA(1, 1, At, B1); G8_BAR;
            G8_LDB(B0, 1, 0); G8_SCHED; G8_LDA(At, 1, 0); G8_STAGE(G8_SA(0, 1), a2 + hstepA, voffA);
            G8_WAIT_L(8); G8_BAR; G8_WAIT_L(0); G8_MMA(0, 0, At, B0); G8_BAR; G8_SCHED;
            G8_LDB(B1, 1, 1); G8_STAGE(G8_SB(1, 0), b3, voffB);
            G8_BAR; G8_WAIT_L(0); G8_MMA(0, 1, At, B1); G8_BAR;
            G8_LDA(At, 1, 1); G8_STAGE(G8_SA(1, 0), a3, voffA);
            G8_BAR; G8_WAIT_L(0); G8_MMA(1, 0, At, B0); G8_BAR; G8_SCHED;
            G8_STAGE(G8_SB(1, 1), b3 + hstepB, voffB);
            G8_WAIT_V(6); G8_BAR; G8_MMA(1, 1, At, B1); G8_BAR;
            }
        }
        if constexpr (ALIGN_EPI) { if (wr == 0) G8_BAR; }
        ph.epi(acc, cur, wr, wc, fr, fq);
        if (!has_next) break;
#pragma unroll
        for (int a = 0; a < 2; ++a)
#pragma unroll
            for (int b = 0; b < 2; ++b)
#pragma unroll
                for (int m = 0; m < 4; ++m)
#pragma unroll
                    for (int n = 0; n < 2; ++n) acc[a][b][m][n] = (f32x4){0.f, 0.f, 0.f, 0.f};
        cur = nxt; cA = nA; cB = nB; ++ui;
        if constexpr (ALIGN_EPI) { if (wr == 1) G8_BAR; }
    }
    G8_WAIT_V(0);
    if constexpr (!ALIGN_EPI) { if (wr == 0) G8_BAR; }
    G8_BAR;
#undef G8_SA
#undef G8_SB
#undef G8_STAGE
#undef G8_LDA
#undef G8_LDB
#undef G8_MMA
#undef G8_WAIT_V
#undef G8_WAIT_L
#undef G8_BAR
#undef G8_SCHED
}
}

struct TJob { const float* src; bf16_t* dst; const float* gain; int K, Nsrc, Ndst, map, nitems; };

DI int map_col(int map, int n0) {
    if (map == 1) return n0 + (n0 >= 6144 ? 16 : 0);
    if (map == 2) { const int t = n0 >> 8, r = n0 & 255; return (r < 128) ? 128 * t + r : DFF + 128 * t + (r - 128); }
    return n0;
}
constexpr int TR_SCR = 64 * 65 * 4;
static_assert(8 * TR_SCR <= LDS_MISC, "transpose scratch must stay below the barrier words");
DI void p0_transpose_item(const TJob& J, LAS float* scr, int item, int lane) {
    const int nblk = J.Ndst / 64, kb = item / nblk, nb = item % nblk, k0 = 64 * kb, n0 = 64 * nb, ns0 = map_col(J.map, n0);
    const float* src = J.src + (size_t)(k0 + (lane >> 4)) * J.Nsrc + ns0 + 4 * (lane & 15);
    f32x4 v[16];
#pragma unroll
    for (int i = 0; i < 16; ++i) v[i] = *(const f32x4*)(src + (size_t)(4 * i) * J.Nsrc);
    if (J.gain) {
#pragma unroll
        for (int i = 0; i < 16; ++i) v[i] *= J.gain[k0 + 4 * i + (lane >> 4)];
    }
#pragma unroll
    for (int i = 0; i < 16; ++i) { LAS float* d = scr + (4 * i + (lane >> 4)) * 65 + 4 * (lane & 15); d[0] = v[i].x; d[1] = v[i].y; d[2] = v[i].z; d[3] = v[i].w; }
    LDS_WAIT(); asm volatile("" ::: "memory");
    const int c = lane & 7;
#pragma unroll
    for (int j = 0; j < 8; ++j) { const int n = (lane >> 3) + 8 * j; const LAS float* s = scr + (8 * c) * 65 + n;
        u32x4 o; o.x = pk2(s[0 * 65], s[1 * 65]); o.y = pk2(s[2 * 65], s[3 * 65]); o.z = pk2(s[4 * 65], s[5 * 65]); o.w = pk2(s[6 * 65], s[7 * 65]);
        *(u32x4*)(J.dst + (size_t)(n0 + n) * J.K + k0 + 8 * c) = o; }
    LDS_WAIT(); asm volatile("" ::: "memory");
}
DI void p0_wps_item(const Params& p, bf16_t* WPS, int item, int lane) {
    const size_t e = (size_t)item * 512 + lane * 8; const float* src = p.w_pool + e;
    const f32x4 a = *(const f32x4*)src, b = *(const f32x4*)(src + 4);
    u32x4 o; o.x = pk2(a.x, a.y); o.y = pk2(a.z, a.w); o.z = pk2(b.x, b.y); o.w = pk2(b.z, b.w);
    *(u32x4*)(WPS + e) = o;
}
DI void p0_plb_item(const Params& p, bf16_t* PLB, int item, int lane) {
    const size_t e = (size_t)item * 512 + lane * 8; const size_t row = e / PLE;
    const float* src = (row < MP) ? p.p_prompt + e : p.p_sample + (e - (size_t)MP * PLE);
    const f32x4 a = *(const f32x4*)src, b = *(const f32x4*)(src + 4);
    u32x4 o; o.x = pk2(a.x, a.y); o.y = pk2(a.z, a.w); o.z = pk2(b.x, b.y); o.w = pk2(b.z, b.w);
    *(u32x4*)(PLB + e) = o;
}

DI void p0_xprep_unit(const Params& p, LAS unsigned char* lds, int u, int wave) {
    const int lane = lane_id(), tid = wave * 64 + lane;
    unsigned char* ws = p.ws;
    bf16_t* XB = (bf16_t*)(ws + WS_XB); float* RSTD1 = (float*)(ws + WS_RSTD1); float* BCUM = (float*)(ws + WS_BCUM); float* LAM = (float*)(ws + WS_LAM);
    LAS unsigned char* WG = lds; LAS float* GL = (LAS float*)(lds + 65536); LAS float* RS = (LAS float*)(lds + 69632);
    {   f32x4 w[16]; float gk[16];
#pragma unroll
        for (int i = 0; i < 16; ++i) { const int idx = tid + 512 * i, k = idx >> 2, n4 = idx & 3; w[i] = *(const f32x4*)(p.w_in + (size_t)k * INW + 6144 + 4 * n4); gk[i] = p.norm_mix[k]; }
#pragma unroll
        for (int i = 0; i < 16; ++i) { const int idx = tid + 512 * i, k = idx >> 2, n4 = idx & 3; LAS bf16_t* d = (LAS bf16_t*)(WG + (size_t)((k >> 3) * 16 + 4 * n4) * 16) + (k & 7);
            const unsigned a = pk2(w[i].x * gk[i], w[i].y * gk[i]), b = pk2(w[i].z * gk[i], w[i].w * gk[i]);
            d[0] = (bf16_t)(a & 0xffffu); d[8] = (bf16_t)(a >> 16); d[16] = (bf16_t)(b & 0xffffu); d[24] = (bf16_t)(b >> 16); }
    }
    __syncthreads();
    if (wave < 4) {
        const int fr = lane & 15, fq = lane >> 4; const int row = 64 * u + 16 * wave + fr;
        const float* xr = (row < MP) ? p.x_prompt + (size_t)row * D : p.x_sample + (size_t)(row - MP) * D;
        f32x4 acc = {0.f, 0.f, 0.f, 0.f}; float ss = 0.f;
#pragma unroll 1
        for (int s0 = 0; s0 < 64; s0 += 8) {
            f32x4 xa[8], xb[8];
#pragma unroll
            for (int i = 0; i < 8; ++i) { xa[i] = *(const f32x4*)(xr + 32 * (s0 + i) + 8 * fq); xb[i] = *(const f32x4*)(xr + 32 * (s0 + i) + 8 * fq + 4); }
#pragma unroll
            for (int i = 0; i < 8; ++i) { const int s = s0 + i; const f32x4 a = xa[i], b = xb[i];
                ss += (a.x * a.x + a.y * a.y) + (a.z * a.z + a.w * a.w) + (b.x * b.x + b.y * b.y) + (b.z * b.z + b.w * b.w);
                u32x4 o; o.x = pk2(a.x, a.y); o.y = pk2(a.z, a.w); o.z = pk2(b.x, b.y); o.w = pk2(b.z, b.w);
                *(u32x4*)(XB + (size_t)row * D + 32 * s + 8 * fq) = o;
                const bf16x8 af = __builtin_bit_cast(bf16x8, o);
                const bf16x8 bfr = *(const LAS bf16x8*)(WG + (size_t)((4 * s + fq) * 16 + fr) * 16);
                acc = __builtin_amdgcn_mfma_f32_16x16x32_bf16(af, bfr, acc, 0, 0, 0); }
        }
        ss += __shfl_xor(ss, 16); ss += __shfl_xor(ss, 32);
        const float rstd = 1.0f / sqrtf(ss * (1.0f / D) + EPS);
        if (fq == 0) { RS[16 * wave + fr] = rstd; RSTD1[row] = rstd; }
        LDS_WAIT(); asm volatile("" ::: "memory");
#pragma unroll
        for (int j = 0; j < 4; ++j) { const int tl = 16 * wave + 4 * fq + j; GL[tl * 16 + fr] = acc[j] * RS[tl]; }
    }
    __syncthreads();
    const bool sample = (u >= MP / 64);
#pragma unroll 1
    for (int cc = 0; cc < 2; ++cc) {
        const int c = tid + 512 * cc; float wg[16];
#pragma unroll
        for (int j = 0; j < 16; ++j) wg[j] = p.w_gate_up[j * KW + c];
        const float bg = p.b_gate[c]; float cum = 0.f;
#pragma unroll 2
        for (int t = 0; t < 64; ++t) {
            const f32x4 g0 = *(const LAS f32x4*)(GL + t * 16), g1 = *(const LAS f32x4*)(GL + t * 16 + 4), g2 = *(const LAS f32x4*)(GL + t * 16 + 8), g3 = *(const LAS f32x4*)(GL + t * 16 + 12);
            float z = bg;
            z += g0.x * wg[0] + g0.y * wg[1] + g0.z * wg[2] + g0.w * wg[3];
            z += g1.x * wg[4] + g1.y * wg[5] + g1.z * wg[6] + g1.w * wg[7];
            z += g2.x * wg[8] + g2.y * wg[9] + g2.z * wg[10] + g2.w * wg[11];
            z += g3.x * wg[12] + g3.y * wg[13] + g3.z * wg[14] + g3.w * wg[15];
            const float gl = logsigmoidf_(z) * (1.0f / 16.0f);
            const int row = 64 * u + t;
            if (sample) { BCUM[(size_t)row * KW + c] = 0.f; LAM[(size_t)(NCHK + row - MP) * KW + c] = __expf(gl); }
            else { cum = ((t & (CH - 1)) == 0) ? gl : cum + gl; BCUM[(size_t)row * KW + c] = cum; if ((t & (CH - 1)) == CH - 1) LAM[(size_t)(row / CH) * KW + c] = __expf(cum); }
        }
    }
    __syncthreads();
}

constexpr int NXPREP = M / 64;
DI void phase_p0(const Params& p, LAS unsigned char* lds, int wave) {
    const int lane = lane_id();
    unsigned char* ws = p.ws;
#ifndef P0_REP
#define P0_REP 0
#endif
    if ((int)blockIdx.x < NXPREP) { p0_xprep_unit(p, lds, blockIdx.x, wave); if (P0_REP & 1) p0_xprep_unit(p, lds, blockIdx.x, wave); return; }
    TJob J[8];
    J[0] = TJob{p.w_in, (bf16_t*)(ws + WS_WIN), p.norm_mix, D, INW, NIN, 1, (D / 64) * (NIN / 64)};
    J[1] = TJob{p.w_up, (bf16_t*)(ws + WS_WUP), p.norm_ffn, D, NUP, NUP, 2, (D / 64) * (NUP / 64)};
    J[2] = TJob{p.w_down, (bf16_t*)(ws + WS_WD), nullptr, DFF, D, D, 0, (DFF / 64) * (D / 64)};
    J[3] = TJob{p.w_branch_a, (bf16_t*)(ws + WS_WA), p.gla_norm, D, D, D, 0, (D / 64) * (D / 64)};
    J[4] = TJob{p.w_out, (bf16_t*)(ws + WS_WO), nullptr, D, D, D, 0, (D / 64) * (D / 64)};
    J[5] = TJob{p.w_ple_gate, (bf16_t*)(ws + WS_WPG), p.norm_ple, D, D, D, 0, (D / 64) * (D / 64)};
    J[6] = TJob{p.w_ple, (bf16_t*)(ws + WS_WPLE), nullptr, PLE, D, D, 0, (PLE / 64) * (D / 64)};
    J[7] = TJob{p.w_branch_b, (bf16_t*)(ws + WS_WBT), p.pool_scale, POOLW, D, D, 0, (POOLW / 64) * (D / 64)};
    LAS float* scr = (LAS float*)(lds + wave * TR_SCR);
    const int gw = ((int)blockIdx.x - NXPREP) * NWAVES + wave, NGW = ((int)gridDim.x - NXPREP) * NWAVES;
    for (int rep = 0; rep < ((P0_REP & 2) ? 2 : 1); ++rep) {
    int base = 0;
#pragma unroll
    for (int j = 0; j < 8; ++j) {
        const int n = J[j].nitems;
        int it = gw - (base % NGW); if (it < 0) it += NGW;
        for (; it < n; it += NGW) p0_transpose_item(J[j], scr, it, lane);
        base += n;
    }
    }
    for (int it = gw; it < (POOLW * 256) / 512; it += NGW) p0_wps_item(p, (bf16_t*)(ws + WS_WPS), it, lane);
    for (int it = gw; it < (M * PLE) / 512; it += NGW) p0_plb_item(p, (bf16_t*)(ws + WS_PLB), it, lane);
}

#define MFMA32(a, b, c) __builtin_amdgcn_mfma_f32_32x32x16_bf16((a), (b), (c), 0, 0, 0)
typedef LAS s16x4* lds_s16x4_p;
DI s16x4 tr_read(LAS unsigned char* a) { return __builtin_amdgcn_ds_read_tr16_b64_v4i16((lds_s16x4_p)a); }
DI bf16x8 cat8(s16x4 lo, s16x4 hi) { return __builtin_shufflevector(lo, hi, 0, 1, 2, 3, 4, 5, 6, 7); }
DI bf16x8 ld_perm(const bf16_t* p) {
    const u32x2 a = *(const u32x2*)p, b = *(const u32x2*)(p + 8);
    u32x4 r; r.x = a.x; r.y = a.y; r.z = b.x; r.w = b.y; return __builtin_bit_cast(bf16x8, r);
}
template <int S> DI bf16x8 pack_step(const f32x16& x) {
    u32x4 r; r.x = pk2(x[8 * S + 0], x[8 * S + 1]); r.y = pk2(x[8 * S + 2], x[8 * S + 3]); r.z = pk2(x[8 * S + 4], x[8 * S + 5]); r.w = pk2(x[8 * S + 6], x[8 * S + 7]);
    return __builtin_bit_cast(bf16x8, r);
}
DI f32x16 zero16() { f32x16 z;
#pragma unroll
    for (int i = 0; i < 16; ++i) z[i] = 0.f; return z; }

constexpr int SC_BUF = 66560, SC_QI = 0, SC_KI = 16384, SC_KDI = 32768, SC_VI = 49152, SC_LMI = 65536, SC_ATT = 2 * SC_BUF, SC_BYTES = SC_ATT + 2048;
static_assert(SC_BYTES <= LDS_MISC, "scan LDS map");
DI void dma16(const void* g, LAS unsigned char* l) { __builtin_amdgcn_global_load_lds((const unsigned*)g, (LAS unsigned*)l, 16, 0, 0); }
DI bf16x8 lds_perm(LAS unsigned char* a) {
    const u32x2 x = *(const LAS u32x2*)a, y = *(const LAS u32x2*)(a + 512);
    u32x4 r; r.x = x.x; r.y = x.y; r.z = y.x; r.w = y.y; return __builtin_bit_cast(bf16x8, r);
}
DI void scan_block(const Params& p, LAS unsigned char* lds, int task, int wave) {
    unsigned char* ws = p.ws;
    const bf16_t* QB = (const bf16_t*)(ws + WS_QB); const bf16_t* KB = (const bf16_t*)(ws + WS_KB); const bf16_t* KD = (const bf16_t*)(ws + WS_KD);
    const bf16_t* V = (const bf16_t*)(ws + WS_V); bf16_t* OG = (bf16_t*)(ws + WS_OG);
    const float* LAM = (const float*)(ws + WS_LAM); float* OSS = (float*)(ws + WS_OSS);
    const int half = task & 1, hd = (task >> 1) & 3, b = task >> 3, sl = 8 * half + wave;
    f32x16 S[8];
#pragma unroll
    for (int db = 0; db < 8; ++db) S[db] = zero16();

#define SC_ISSUE(ch_) do { const int _l = lane_id(); const size_t _r0 = (size_t)(b * SEQ + CH * (ch_)); LAS unsigned char* _lb = lds + ((ch_) & 1) * SC_BUF; asm volatile("" : "+s"(_lb)); \
        _Pragma("unroll") for (int _k = 0; _k < 2; ++_k) { const int _i = 2 * wave + _k; \
            const int _row = _l & 31, _cc = 2 * _i + (_l >> 5); \
            dma16(QB + (_r0 + _row) * KW + hd * 256 + 8 * _cc, _lb + SC_QI + _i * 1024); dma16(KB + (_r0 + _row) * KW + hd * 256 + 8 * _cc, _lb + SC_KI + _i * 1024); \
            const int _s = 2 * _i + (_l >> 5), _c2 = (_l & 31) ^ (4 * (_s & 3)); \
            dma16(KD + (_r0 + _s) * KW + hd * 256 + 8 * _c2, _lb + SC_KDI + _i * 1024); dma16(V + (_r0 + _s) * VW + hd * 512 + 256 * half + 8 * _c2, _lb + SC_VI + _i * 1024); } \
        if (wave == 0) dma16(LAM + (size_t)(b * (SEQ / CH) + (ch_)) * KW + hd * 256 + 4 * _l, _lb + SC_LMI); } while (0)

    SC_ISSUE(0);
#pragma unroll 1
    for (int ch = 0; ch < SEQ / CH; ++ch) {
        const int row0 = b * SEQ + CH * ch;
        VM_WAIT();
        __syncthreads();
        if (ch + 1 < SEQ / CH) SC_ISSUE(ch + 1);
        const int lane = lane_id();
        const int c = lane & 31, h = lane >> 5;
        const int i16 = lane & 15, q = i16 >> 2, pp = i16 & 3, jb = (lane >> 4) & 1;
        LAS unsigned char* buf = lds + (ch & 1) * SC_BUF;
        LAS unsigned char* ATT = lds + SC_ATT;

        if (wave < 4) {
            const int si = wave >> 1, ti = wave & 1, fr = lane & 15, fq = lane >> 4;
            f32x4 a = {0.f, 0.f, 0.f, 0.f};
            LAS unsigned char* kp = buf + SC_KI + fq * 512 + (16 * si + fr) * 16; LAS unsigned char* qp = buf + SC_QI + fq * 512 + (16 * ti + fr) * 16;
#pragma unroll
            for (int ks = 0; ks < 8; ++ks) a = __builtin_amdgcn_mfma_f32_16x16x32_bf16(*(const LAS bf16x8*)(kp + 2048 * ks), *(const LAS bf16x8*)(qp + 2048 * ks), a, 0, 0, 0);
            const int s0 = 16 * si + 4 * fq, t = 16 * ti + fr;
            u32x2 w; w.x = pk2(s0 + 0 <= t ? a[0] : 0.f, s0 + 1 <= t ? a[1] : 0.f); w.y = pk2(s0 + 2 <= t ? a[2] : 0.f, s0 + 3 <= t ? a[3] : 0.f);
            *(LAS u32x2*)(ATT + t * 64 + s0 * 2) = w;
        }
        __syncthreads();

        f32x16 o = zero16();
        {
            LAS unsigned char* vb = buf + SC_VI + (8 * h + q) * 512 + (4 * (wave ^ q) + 2 * jb + (pp >> 1)) * 16 + (pp & 1) * 8;
            LAS unsigned char* ab = ATT + c * 64 + 16 * h;
#pragma unroll
            for (int ks = 0; ks < 2; ++ks) {
                const bf16x8 vf = cat8(tr_read(vb + (16 * ks) * 512), tr_read(vb + (16 * ks + 4) * 512));
                const bf16x8 af = *(const LAS bf16x8*)(ab + 32 * ks);
                o = MFMA32(vf, af, o);
            }
            LAS unsigned char* qa = buf + SC_QI + c * 16 + 8 * h;
#pragma unroll
            for (int db = 0; db < 8; ++db) {
                { const bf16x8 qf = lds_perm(qa + 2048 * db); o = MFMA32(pack_step<0>(S[db]), qf, o); }
                { const bf16x8 qf = lds_perm(qa + 2048 * db + 1024); o = MFMA32(pack_step<1>(S[db]), qf, o); }
                if ((db & 3) == 3) __builtin_amdgcn_sched_barrier(0);
            }
            const int t = row0 + c;
            float ss = 0.f;
#pragma unroll
            for (int r = 0; r < 16; ++r) ss += o[r] * o[r];
            { const auto sw = __builtin_amdgcn_permlane32_swap(__float_as_uint(ss), __float_as_uint(ss), false, false); ss = __uint_as_float(sw[0]) + __uint_as_float(sw[1]); }
            if (h == 0) OSS[(size_t)t * 64 + hd * 16 + sl] = ss;
            bf16_t* og = OG + (size_t)row0 * VW + hd * 512 + 32 * sl + c * VW + 4 * h;
#pragma unroll
            for (int g = 0; g < 4; ++g) { u32x2 w; w.x = pk2(o[4 * g + 0], o[4 * g + 1]); w.y = pk2(o[4 * g + 2], o[4 * g + 3]); *(u32x2*)(og + 8 * g) = w; }
        }
        __builtin_amdgcn_sched_barrier(0);

        {
            LAS unsigned char* vb = buf + SC_VI + (8 * h + q) * 512 + (4 * (wave ^ q) + 2 * jb + (pp >> 1)) * 16 + (pp & 1) * 8;
            LAS unsigned char* kbase = buf + SC_KDI + (8 * h + q) * 512 + (2 * jb + (pp >> 1)) * 16 + (pp & 1) * 8;
            LAS unsigned char* lm = buf + SC_LMI + 16 * h;
            const bf16x8 vf0 = cat8(tr_read(vb), tr_read(vb + 4 * 512)), vf1 = cat8(tr_read(vb + 16 * 512), tr_read(vb + 20 * 512));
#pragma unroll
            for (int db = 0; db < 8; ++db) {
#pragma unroll
                for (int g = 0; g < 4; ++g) { const f32x4 l4 = *(const LAS f32x4*)(lm + (32 * db + 8 * g) * 4);
                    S[db][4 * g + 0] *= l4.x; S[db][4 * g + 1] *= l4.y; S[db][4 * g + 2] *= l4.z; S[db][4 * g + 3] *= l4.w; }
                LAS unsigned char* kb = kbase + (((db & 3) ^ q) * 4) * 16 + (db >> 2) * 256;
                S[db] = MFMA32(cat8(tr_read(kb), tr_read(kb + 4 * 512)), vf0, S[db]);
                S[db] = MFMA32(cat8(tr_read(kb + 16 * 512), tr_read(kb + 20 * 512)), vf1, S[db]);
                if (db & 1) __builtin_amdgcn_sched_barrier(0);
            }
        }
        asm volatile("" ::: "memory");
    }
#undef SC_ISSUE
    {   const int lane = lane_id();
        const unsigned voff = (unsigned)(((lane >> 5) * 4 * DV + (lane & 31)) * 4);
        const char* gbase = (const char*)(p.out + O_GLAP + ((size_t)(b * NH + hd) * DK) * DV + 32 * sl);
#pragma unroll
        for (int db = 0; db < 8; ++db) {
#pragma unroll
            for (int r = 0; r < 16; ++r) { const int dl = 32 * db + (r & 3) + 8 * (r >> 2); *(float*)(const_cast<char*>(gbase) + (size_t)dl * DV * 4 + voff) = S[db][r]; }
        }
    }
    __syncthreads();
}

DI void sgla_task(const Params& p, int task, int lane) {
    unsigned char* ws = p.ws;
    const bf16_t* QB = (const bf16_t*)(ws + WS_QB); const bf16_t* KB = (const bf16_t*)(ws + WS_KB); const bf16_t* V = (const bf16_t*)(ws + WS_V);
    const float* LAM = (const float*)(ws + WS_LAM); float* OSP = (float*)(ws + WS_OSP);
    const int dblk = task & 7, hd = (task >> 3) & 3, b = task >> 5; const int row = MP + b;
    const size_t sbase = ((size_t)(b * NH + hd) * DK + 32 * dblk) * DV;
    const float* S0 = p.state_gla + sbase; float* So = p.out + O_GLAS + sbase;
    const int dl = lane & 31;
    const float lam_l = LAM[(size_t)(NCHK + b) * KW + hd * 256 + 32 * dblk + dl];
    const float k_l = bf1(KB[(size_t)row * KW + hd * 256 + 32 * dblk + dl]);
    const float q_l = bf1(QB[(size_t)row * KW + hd * 256 + 32 * dblk + dl]);
    f32x4 va, vb;
    { const u32x2 w = *(const u32x2*)(V + (size_t)row * VW + hd * 512 + 4 * lane); va = (f32x4){bflo(w.x), bfhi(w.x), bflo(w.y), bfhi(w.y)}; }
    { const u32x2 w = *(const u32x2*)(V + (size_t)row * VW + hd * 512 + 256 + 4 * lane); vb = (f32x4){bflo(w.x), bfhi(w.x), bflo(w.y), bfhi(w.y)}; }
    f32x4 oa = {0.f, 0.f, 0.f, 0.f}, ob = {0.f, 0.f, 0.f, 0.f};
#pragma unroll 1
    for (int d0 = 0; d0 < 32; d0 += 8) {
        f32x4 ra[8], rb[8];
#pragma unroll
        for (int i = 0; i < 8; ++i) { ra[i] = __builtin_nontemporal_load((const f32x4*)(S0 + (size_t)(d0 + i) * DV + 4 * lane)); rb[i] = __builtin_nontemporal_load((const f32x4*)(S0 + (size_t)(d0 + i) * DV + 256 + 4 * lane)); }
#pragma unroll
        for (int i = 0; i < 8; ++i) { const int d = d0 + i;
            const float lam = __uint_as_float(__builtin_amdgcn_readlane(__float_as_uint(lam_l), d)), kk = __uint_as_float(__builtin_amdgcn_readlane(__float_as_uint(k_l), d)), qq = __uint_as_float(__builtin_amdgcn_readlane(__float_as_uint(q_l), d));
            const f32x4 sa = ra[i] * lam + va * kk, sb = rb[i] * lam + vb * kk;
            __builtin_nontemporal_store(sa, (f32x4*)(So + (size_t)d * DV + 4 * lane)); __builtin_nontemporal_store(sb, (f32x4*)(So + (size_t)d * DV + 256 + 4 * lane));
            oa += sa * qq; ob += sb * qq; }
    }
    float* op = OSP + ((size_t)(b * NH + hd) * 8 + dblk) * DV;
    *(f32x4*)(op + 4 * lane) = oa; *(f32x4*)(op + 256 + 4 * lane) = ob;
}

DI void pmix_task(const Params& p, int t, int lane) {
    unsigned char* ws = p.ws;
    const float* U = (const float*)(ws + WS_U); bf16_t* PM = (bf16_t*)(ws + WS_PM);
    if (t < MP) {
        const int b = t >> 11, pos = t & 2047;
#pragma unroll
        for (int i = 0; i < 4; ++i) {
            const int w = 2 << i, c = 256 * i + 4 * lane; const int cnt = (pos + 1 < w) ? pos + 1 : w;
            const f32x4 u0 = *(const f32x4*)(U + (size_t)t * POOLW + c); f32x4 s = u0;
#pragma unroll
            for (int j = 1; j < w; ++j) {
                const bool in = j < cnt; const f32x4 v = *(const f32x4*)(U + (size_t)(in ? t - j : t) * POOLW + c); const float m = in ? 1.f : 0.f; s += v * m; }
            const float inv = 1.0f / (float)cnt; const f32x4 mx = s * inv - u0;
            u32x2 o; o.x = pk2(mx.x, mx.y); o.y = pk2(mx.z, mx.w); *(u32x2*)(PM + (size_t)t * POOLW + c) = o;
            if (pos >= SEQ - 15) *(f32x4*)(p.out + O_POOLP + ((size_t)b * 15 + (pos - (SEQ - 15))) * POOLW + c) = u0;
        }
    } else {
        const int b = t - MP; const float* sp = p.state_pool + (size_t)b * 15 * POOLW; float* po = p.out + O_POOLS + (size_t)b * 15 * POOLW;
#pragma unroll
        for (int i = 0; i < 4; ++i) {
            const int w = 2 << i, c = 256 * i + 4 * lane;
            const f32x4 u0 = *(const f32x4*)(U + (size_t)t * POOLW + c); f32x4 s = u0;
#pragma unroll
            for (int j = 1; j < w; ++j) s += *(const f32x4*)(sp + (size_t)(15 - j) * POOLW + c);
            const float inv = 1.0f / (float)w; const f32x4 mx = s * inv - u0;
            u32x2 o; o.x = pk2(mx.x, mx.y); o.y = pk2(mx.z, mx.w); *(u32x2*)(PM + (size_t)t * POOLW + c) = o;
            *(f32x4*)(po + (size_t)14 * POOLW + c) = u0;
        }
    }
}

DI void pool_copy_task(const Params& p, int item, int lane) {
    const int b = item / 14, r = item - 14 * b; const float* src = p.state_pool + ((size_t)b * 15 + r + 1) * POOLW + 4 * lane; float* dst = p.out + O_POOLS + ((size_t)b * 15 + r) * POOLW + 4 * lane;
    const f32x4 v0 = *(const f32x4*)src, v1 = *(const f32x4*)(src + 256), v2 = *(const f32x4*)(src + 512), v3 = *(const f32x4*)(src + 768);
    *(f32x4*)dst = v0; *(f32x4*)(dst + 256) = v1; *(f32x4*)(dst + 512) = v2; *(f32x4*)(dst + 768) = v3;
}
#ifndef P2_REP
#define P2_REP 0
#endif
DI void scan_role(const Params& p, LAS unsigned char* lds, int wave, int idx, int n) {
    for (int rep = 0; rep < ((P2_REP & 1) ? 2 : 1); ++rep) for (int task = (n == 32) ? (idx % 8) * 4 + idx / 8 : idx; task < 2 * NB * NH; task += n) scan_block(p, lds, task, wave);
}
DI void stream_role(const Params& p, int wave, int idx, int n) {
    const int lane = lane_id(); const int gw = idx * NWAVES + wave, NGW = n * NWAVES;
    for (int rep = 0; rep < ((P2_REP & 2) ? 2 : 1); ++rep) {
        for (int it = gw; it < MS * 14; it += NGW) pool_copy_task(p, it, lane);
        for (int task = gw; task < MS * NH * 8; task += NGW) sgla_task(p, task, lane); }
}

DI void ogn_task(const Params& p, int t, int lane) {
    unsigned char* ws = p.ws;
    bf16_t* OG = (bf16_t*)(ws + WS_OG); const float* OSS = (const float*)(ws + WS_OSS); const float* OSP = (const float*)(ws + WS_OSP); const bf16_t* SR = (const bf16_t*)(ws + WS_SR);
    if (t < MP) {
#pragma unroll
        for (int hd = 0; hd < 4; ++hd) {
            const float* sp = OSS + (size_t)t * 64 + hd * 16; const f32x4 a = *(const f32x4*)sp, b = *(const f32x4*)(sp + 4), c = *(const f32x4*)(sp + 8), d = *(const f32x4*)(sp + 12);
            const float ss = ((a.x + a.y) + (a.z + a.w)) + ((b.x + b.y) + (b.z + b.w)) + ((c.x + c.y) + (c.z + c.w)) + ((d.x + d.y) + (d.z + d.w));
            const float rstd = 1.0f / sqrtf(ss * (1.0f / DV) + EPS);
            bf16_t* op = OG + (size_t)t * VW + hd * 512 + 8 * lane; const u32x4 w = *(const u32x4*)op; const u32x4 g = *(const u32x4*)(SR + (size_t)t * VW + hd * 512 + 8 * lane);
            u32x4 o; o.x = pk2(bflo(w.x) * rstd * bflo(g.x), bfhi(w.x) * rstd * bfhi(g.x)); o.y = pk2(bflo(w.y) * rstd * bflo(g.y), bfhi(w.y) * rstd * bfhi(g.y));
            o.z = pk2(bflo(w.z) * rstd * bflo(g.z), bfhi(w.z) * rstd * bfhi(g.z)); o.w = pk2(bflo(w.w) * rstd * bflo(g.w), bfhi(w.w) * rstd * bfhi(g.w));
            *(u32x4*)op = o;
        }
    } else {
        const int b = t - MP;
#pragma unroll
        for (int hd = 0; hd < 4; ++hd) {
            f32x4 oa = {0.f, 0.f, 0.f, 0.f}, ob = {0.f, 0.f, 0.f, 0.f};
#pragma unroll
            for (int k = 0; k < 8; ++k) { const float* op = OSP + ((size_t)(b * NH + hd) * 8 + k) * DV + 8 * lane; oa += *(const f32x4*)op; ob += *(const f32x4*)(op + 4); }
            float ss = (oa.x * oa.x + oa.y * oa.y) + (oa.z * oa.z + oa.w * oa.w) + (ob.x * ob.x + ob.y * ob.y) + (ob.z * ob.z + ob.w * ob.w);
            ss = wave_sum(ss);
            const float rstd = 1.0f / sqrtf(ss * (1.0f / DV) + EPS);
            const u32x4 w = *(const u32x4*)(SR + (size_t)t * VW + hd * 512 + 8 * lane);
            u32x4 o; o.x = pk2(oa.x * rstd * bflo(w.x), oa.y * rstd * bfhi(w.x)); o.y = pk2(oa.z * rstd * bflo(w.y), oa.w * rstd * bfhi(w.y));
            o.z = pk2(ob.x * rstd * bflo(w.z), ob.y * rstd * bfhi(w.z)); o.w = pk2(ob.z * rstd * bflo(w.w), ob.w * rstd * bfhi(w.w));
            *(u32x4*)(OG + (size_t)t * VW + hd * 512 + 8 * lane) = o;
        }
    }
}
DI void phase_p3(const Params& p, int wave) {
    const int lane = lane_id();
    const int gw = (int)blockIdx.x * NWAVES + wave, NGW = gridDim.x * NWAVES;
    for (int t = gw; t < M; t += NGW) pmix_task(p, t, lane);
    for (int t = gw; t < M; t += NGW) ogn_task(p, t, lane);
}

DI float row_rstd(const float* SS, const float* SSs, int row, int lane) {
    float v = (row < MP) ? ((lane < 32) ? SS[(size_t)row * 32 + lane] : 0.f) : (SSs[(size_t)(row - MP) * 128 + lane] + SSs[(size_t)(row - MP) * 128 + 64 + lane]);
    v = wave_sum(v);
    return 1.0f / sqrtf(v * (1.0f / D) + EPS);
}

struct F8 { f32x4 a, b; };
DI F8 unpack8(u32x4 w, float s) { F8 r; r.a = (f32x4){bflo(w.x) * s, bfhi(w.x) * s, bflo(w.y) * s, bfhi(w.y) * s}; r.b = (f32x4){bflo(w.z) * s, bfhi(w.z) * s, bflo(w.w) * s, bfhi(w.w) * s}; return r; }
DI F8 ld8(const float* q) { F8 r; r.a = *(const f32x4*)q; r.b = *(const f32x4*)(q + 4); return r; }
DI void st8(float* q, const F8& v) { *(f32x4*)q = v.a; *(f32x4*)(q + 4) = v.b; }
DI f32x4 silu4(f32x4 x) { return (f32x4){siluf_(x.x), siluf_(x.y), siluf_(x.z), siluf_(x.w)}; }
DI void conv_task(const Params& p, int t, int lane) {
    unsigned char* ws = p.ws;
    const bf16_t* GU = (const bf16_t*)(ws + WS_GU); const float* SS1 = (const float*)(ws + WS_SS1); const float* SS1S = (const float*)(ws + WS_SS1S); bf16_t* ACT = (bf16_t*)(ws + WS_ACT);
    const bool prompt = t < MP; const int b = prompt ? (t >> 11) : (t - MP), pos = prompt ? (t & 2047) : 2;
    const float r0 = row_rstd(SS1, SS1S, t, lane);
    const float r1 = (prompt && pos >= 1) ? row_rstd(SS1, SS1S, t - 1, lane) : 0.f;
    const float r2 = (prompt && pos >= 2) ? row_rstd(SS1, SS1S, t - 2, lane) : 0.f;
    const bf16_t* g0p = GU + (size_t)t * NUP; const bf16_t* g1p = GU + (size_t)((prompt && pos >= 1) ? t - 1 : t) * NUP; const bf16_t* g2p = GU + (size_t)((prompt && pos >= 2) ? t - 2 : t) * NUP;
    const float* sc = p.state_conv + (size_t)b * 2 * DFF;
    for (int v = lane; v < DFF / 8; v += 64) {
        const int ch0 = 8 * v, pn = ch0 >> 7, r = ch0 & 127, gcol = 256 * pn + r, ucol = gcol + 128;
        const F8 g0 = unpack8(*(const u32x4*)(g0p + gcol), r0), up = unpack8(*(const u32x4*)(g0p + ucol), r0);
        F8 g1, g2;
        if (prompt) { g1 = unpack8(*(const u32x4*)(g1p + gcol), r1); g2 = unpack8(*(const u32x4*)(g2p + gcol), r2); }
        else { g1 = ld8(sc + DFF + ch0); g2 = ld8(sc + ch0); }
        const F8 w0 = ld8(p.conv_w + ch0), w1 = ld8(p.conv_w + DFF + ch0), w2 = ld8(p.conv_w + 2 * DFF + ch0), cb = ld8(p.conv_b + ch0);
        const f32x4 ga = cb.a + w0.a * g2.a + w1.a * g1.a + w2.a * g0.a, gb = cb.b + w0.b * g2.b + w1.b * g1.b + w2.b * g0.b;
        const f32x4 aa = silu4(ga) * up.a, ab = silu4(gb) * up.b;
        u32x4 o; o.x = pk2(aa.x, aa.y); o.y = pk2(aa.z, aa.w); o.z = pk2(ab.x, ab.y); o.w = pk2(ab.z, ab.w);
        *(u32x4*)(ACT + (size_t)t * DFF + ch0) = o;
        if (prompt) { if (pos >= SEQ - 2) st8(p.out + O_CONVP + ((size_t)b * 2 + (pos - (SEQ - 2))) * DFF + ch0, g0); }
        else { float* co = p.out + O_CONVS + (size_t)b * 2 * DFF + ch0; st8(co, g1); st8(co + DFF, g0); }
    }
}
DI void conv_block_task(const Params& p, int rb, int vg, int lane) {
    unsigned char* ws = p.ws;
    const bf16_t* GU = (const bf16_t*)(ws + WS_GU); const float* SS1 = (const float*)(ws + WS_SS1); bf16_t* ACT = (bf16_t*)(ws + WS_ACT);
    const int t0 = 16 * rb, b = t0 >> 11, pos0 = t0 & 2047;
    float rr[18];
#pragma unroll
    for (int i = 0; i < 18; ++i) { const int t = t0 - 2 + i; float v = (lane < 32 && (i >= 2 || pos0 > 0)) ? SS1[(size_t)t * 32 + lane] : 0.f; v = wave_sum(v); rr[i] = (i >= 2 || pos0 > 0) ? 1.0f / sqrtf(v * (1.0f / D) + EPS) : 0.f; }
    const int v = vg * 64 + lane; if (v >= DFF / 8) return;
    const int ch0 = 8 * v, pn = ch0 >> 7, r = ch0 & 127, gcol = 256 * pn + r, ucol = gcol + 128;
    const F8 w0 = ld8(p.conv_w + ch0), w1 = ld8(p.conv_w + DFF + ch0), w2 = ld8(p.conv_w + 2 * DFF + ch0), cb = ld8(p.conv_b + ch0);
    const bf16_t* gp = GU + (size_t)t0 * NUP + gcol; const bf16_t* up_ = GU + (size_t)t0 * NUP + ucol;
    F8 g2 = unpack8(*(const u32x4*)(gp - (pos0 > 0 ? 2 : 0) * (size_t)NUP), rr[0]), g1 = unpack8(*(const u32x4*)(gp - (pos0 > 0 ? 1 : 0) * (size_t)NUP), rr[1]);
#pragma unroll 1
    for (int h = 0; h < 2; ++h) {
        u32x4 gw[8], uw[8];
#pragma unroll
        for (int i = 0; i < 8; ++i) { gw[i] = *(const u32x4*)(gp + (size_t)(8 * h + i) * NUP); uw[i] = *(const u32x4*)(up_ + (size_t)(8 * h + i) * NUP); }
#pragma unroll
        for (int i = 0; i < 8; ++i) { const int ii = 8 * h + i; const float r0 = (h == 0) ? rr[2 + i] : rr[10 + i];
            const F8 g0 = unpack8(gw[i], r0), up = unpack8(uw[i], r0);
            const f32x4 ga = cb.a + w0.a * g2.a + w1.a * g1.a + w2.a * g0.a, gb = cb.b + w0.b * g2.b + w1.b * g1.b + w2.b * g0.b;
            const f32x4 aa = silu4(ga) * up.a, ab = silu4(gb) * up.b;
            u32x4 o; o.x = pk2(aa.x, aa.y); o.y = pk2(aa.z, aa.w); o.z = pk2(ab.x, ab.y); o.w = pk2(ab.z, ab.w);
            *(u32x4*)(ACT + (size_t)(t0 + ii) * DFF + ch0) = o;
            if (pos0 + ii >= SEQ - 2) st8(p.out + O_CONVP + ((size_t)b * 2 + (pos0 + ii - (SEQ - 2))) * DFF + ch0, g0);
            g2 = g1; g1 = g0; }
    }
}
DI void phase_conv(const Params& p, int wave) {
    const int lane = lane_id();
    const int gw = (int)blockIdx.x * NWAVES + wave, NGW = gridDim.x * NWAVES;
    constexpr int NVG = (DFF / 8 + 63) / 64;
    for (int t = MP + gw; t < M; t += NGW) conv_task(p, t, lane);
    for (int it = gw; it < (MP / 16) * NVG; it += NGW) conv_block_task(p, it / NVG, it % NVG, lane);
}

DI void phase_final(const Params& p, int wave) {
    const int lane = lane_id();
    const int gw = (int)blockIdx.x * NWAVES + wave, NGW = gridDim.x * NWAVES;
    const float* H3 = (const float*)(p.ws + WS_H3); const float* SS3 = (const float*)(p.ws + WS_SS3); const float* SS3S = (const float*)(p.ws + WS_SS3S);
    for (int t = gw; t < M; t += NGW) {
        const float rs = row_rstd(SS3, SS3S, t, lane);
        float* yo = (t < MP) ? p.out + O_YP + (size_t)t * D : p.out + O_YS + (size_t)(t - MP) * D;
#pragma unroll
        for (int i = 0; i < 8; ++i) { const int c = 256 * i + 4 * lane; const f32x4 hv = *(const f32x4*)(H3 + (size_t)t * D + c), g = *(const f32x4*)(p.norm_final + c);
            *(f32x4*)(yo + c) = hv * rs * g; }
    }
}

#define EPI_ARGS const f32x4 (&acc)[2][2][4][2], const g8::Unit& u, int wr, int wc, int fr, int fq
#define EPI_ROWS(ROWVAR) _Pragma("unroll") for (int ai = 0; ai < 2; ++ai) _Pragma("unroll") for (int m = 0; m < 4; ++m) { const int ROWVAR = u.pm * 256 + ai * 128 + wr * 64 + m * 16 + fr; if (ROWVAR < M) {
#define EPI_COLS(COLVAR) _Pragma("unroll") for (int bj = 0; bj < 2; ++bj) { const int COLVAR = bj * 128 + wc * 32 + 8 * fq; const f32x4 v0 = acc[ai][bj][m][0], v1 = acc[ai][bj][m][1];
#define EPI_END } } }
DI u32x4 pk8(f32x4 a, f32x4 b) { u32x4 o; o.x = pk2(a.x, a.y); o.y = pk2(a.z, a.w); o.z = pk2(b.x, b.y); o.w = pk2(b.z, b.w); return o; }
DI f32x4 exp4(f32x4 x) { return (f32x4){__expf(x.x), __expf(x.y), __expf(x.z), __expf(x.w)}; }
DI f32x4 sig4(f32x4 x) { return (f32x4){sigmoidf_(x.x), sigmoidf_(x.y), sigmoidf_(x.z), sigmoidf_(x.w)}; }
DI f32x4 bf4lo(u32x4 w) { return (f32x4){bflo(w.x), bfhi(w.x), bflo(w.y), bfhi(w.y)}; }
DI f32x4 bf4hi(u32x4 w) { return (f32x4){bflo(w.z), bfhi(w.z), bflo(w.w), bfhi(w.w)}; }
DI float sum4(f32x4 a) { return (a.x + a.y) + (a.z + a.w); }

struct PhaseIn {
    static constexpr int LDA = D, LDB = D, KT = D / 64;
    const Params& p; int G, c, part;
    int c0;
    DI bool next(int i, g8::Unit& u) const { int pm, pn;
        if (part == 0) { if (!g8::grid_order(NTM - 1, 16, G, c, i, pm, pn)) return false; }
        else { if (c < c0 || !g8::grid_order(NTM, 28, G - c0, c - c0, i, pm, pn)) return false; pn += 16; }
        u.pm = pm; u.pn = pn; u.A = (const char*)(p.ws + WS_XB) + (size_t)pm * 256 * D * 2; u.B = (const char*)(p.ws + WS_WIN) + (size_t)pn * 256 * D * 2; return true; }
    DI void epi(EPI_ARGS) const {
        unsigned char* ws = p.ws; const float* RSTD1 = (const float*)(ws + WS_RSTD1); const float* BCUM = (const float*)(ws + WS_BCUM);
        const int pn = u.pn;
        if (pn < 4) {
            bf16_t* QB = (bf16_t*)(ws + WS_QB);
            EPI_ROWS(row) const float rs = RSTD1[row] * 0.0625f; EPI_COLS(col) const size_t o = (size_t)row * KW + pn * 256 + col;
                const f32x4 e0 = exp4(*(const f32x4*)(BCUM + o)), e1 = exp4(*(const f32x4*)(BCUM + o + 4));
                *(u32x4*)(QB + o) = pk8(v0 * rs * e0, v1 * rs * e1); EPI_END
        } else if (pn < 8) {
            bf16_t* KB = (bf16_t*)(ws + WS_KB); bf16_t* KD = (bf16_t*)(ws + WS_KD);
            EPI_ROWS(row) const float rs = RSTD1[row]; const int lrow = (row < MP) ? (row | (CH - 1)) : row; EPI_COLS(col) const size_t o = (size_t)row * KW + (pn - 4) * 256 + col, ol = (size_t)lrow * KW + (pn - 4) * 256 + col;
                const f32x4 b0 = *(const f32x4*)(BCUM + o), b1 = *(const f32x4*)(BCUM + o + 4), l0 = *(const f32x4*)(BCUM + ol), l1 = *(const f32x4*)(BCUM + ol + 4);
                const f32x4 k0 = v0 * rs, k1 = v1 * rs;
                *(u32x4*)(KB + o) = pk8(k0 * exp4(-b0), k1 * exp4(-b1)); *(u32x4*)(KD + o) = pk8(k0 * exp4(l0 - b0), k1 * exp4(l1 - b1)); EPI_END
        } else if (pn < 16) {
            bf16_t* V = (bf16_t*)(ws + WS_V);
            EPI_ROWS(row) const float rs = RSTD1[row]; EPI_COLS(col) *(u32x4*)(V + (size_t)row * VW + (pn - 8) * 256 + col) = pk8(v0 * rs, v1 * rs); EPI_END
        } else if (pn < 24) {
            bf16_t* SR = (bf16_t*)(ws + WS_SR);
            EPI_ROWS(row) const float rs = RSTD1[row]; EPI_COLS(col) const f32x4 a = v0 * rs, b = v1 * rs; *(u32x4*)(SR + (size_t)row * VW + (pn - 16) * 256 + col) = pk8(a * sig4(a), b * sig4(b)); EPI_END
        } else if (pn < 28) {
            float* U = (float*)(ws + WS_U);
            EPI_ROWS(row) const float rs = RSTD1[row]; EPI_COLS(col) float* o = U + (size_t)row * POOLW + (pn - 24) * 256 + col; *(f32x4*)o = v0 * rs; *(f32x4*)(o + 4) = v1 * rs; EPI_END
        } else {
            bf16_t* Gt = (bf16_t*)(ws + (pn < 36 ? WS_GA : WS_GB)); const int c0 = (pn < 36 ? pn - 28 : pn - 36) * 256;
            EPI_ROWS(row) const float rs = RSTD1[row]; EPI_COLS(col) *(u32x4*)(Gt + (size_t)row * D + c0 + col) = pk8(sig4(v0 * rs), sig4(v1 * rs)); EPI_END
        }
    }
};

template <int LDA_, int LDB_, int K_> struct PhaseN2048 {
    static constexpr int LDA = LDA_, LDB = LDB_, KT = K_ / 64;
    const Params& p; int G, c; size_t a_off, b_off;
    DI bool next_(int i, g8::Unit& u) const { int pm, pn; if (!g8::grid_order(NTM - 1, 8, G, c, i, pm, pn)) return false;
        u.pm = pm; u.pn = pn; u.A = (const char*)(p.ws + a_off) + (size_t)pm * 256 * LDA * 2; u.B = (const char*)(p.ws + b_off) + (size_t)pn * 256 * LDB * 2; return true; }
};
struct PhaseYb : PhaseN2048<POOLW, POOLW, POOLW> {
    DI bool next(int i, g8::Unit& u) const { return next_(i, u); }
    DI void epi(EPI_ARGS) const { const bf16_t* GB = (const bf16_t*)(p.ws + WS_GB); float* Y = (float*)(p.ws + WS_YBG);
#pragma unroll
        for (int ai = 0; ai < 2; ++ai) { u32x4 g[4][2];
#pragma unroll
            for (int m = 0; m < 4; ++m)
#pragma unroll
                for (int bj = 0; bj < 2; ++bj) g[m][bj] = *(const u32x4*)(GB + (size_t)(u.pm * 256 + ai * 128 + wr * 64 + m * 16 + fr) * D + u.pn * 256 + bj * 128 + wc * 32 + 8 * fq);
#pragma unroll
            for (int m = 0; m < 4; ++m)
#pragma unroll
                for (int bj = 0; bj < 2; ++bj) { const size_t o = (size_t)(u.pm * 256 + ai * 128 + wr * 64 + m * 16 + fr) * D + u.pn * 256 + bj * 128 + wc * 32 + 8 * fq;
                    *(f32x4*)(Y + o) = acc[ai][bj][m][0] * bf4lo(g[m][bj]); *(f32x4*)(Y + o + 4) = acc[ai][bj][m][1] * bf4hi(g[m][bj]); } } }
};
struct PhaseYa : PhaseN2048<VW, VW, VW> {
    DI bool next(int i, g8::Unit& u) const { return next_(i, u); }
    DI void epi(EPI_ARGS) const { const bf16_t* GA = (const bf16_t*)(p.ws + WS_GA); const float* Y = (const float*)(p.ws + WS_YBG); bf16_t* MB = (bf16_t*)(p.ws + WS_MB);
#pragma unroll
        for (int ai = 0; ai < 2; ++ai)
#pragma unroll
            for (int mh = 0; mh < 2; ++mh) { u32x4 g[2][2]; f32x4 y0[2][2], y1[2][2];
#pragma unroll
                for (int mm = 0; mm < 2; ++mm)
#pragma unroll
                    for (int bj = 0; bj < 2; ++bj) { const size_t o = (size_t)(u.pm * 256 + ai * 128 + wr * 64 + (2 * mh + mm) * 16 + fr) * D + u.pn * 256 + bj * 128 + wc * 32 + 8 * fq;
                        g[mm][bj] = *(const u32x4*)(GA + o); y0[mm][bj] = *(const f32x4*)(Y + o); y1[mm][bj] = *(const f32x4*)(Y + o + 4); }
#pragma unroll
                for (int mm = 0; mm < 2; ++mm)
#pragma unroll
                    for (int bj = 0; bj < 2; ++bj) { const int m = 2 * mh + mm; const size_t o = (size_t)(u.pm * 256 + ai * 128 + wr * 64 + m * 16 + fr) * D + u.pn * 256 + bj * 128 + wc * 32 + 8 * fq;
                        *(u32x4*)(MB + o) = pk8(acc[ai][bj][m][0] * bf4lo(g[mm][bj]) + y0[mm][bj], acc[ai][bj][m][1] * bf4hi(g[mm][bj]) + y1[mm][bj]); } } }
};
DI void epi_residual(EPI_ARGS, const float* base_p, float* H, bf16_t* HB, float* SS) {
#pragma unroll
    for (int ai = 0; ai < 2; ++ai)
#pragma unroll
        for (int mh = 0; mh < 2; ++mh) {
            f32x4 b0[2][2], b1[2][2];
#pragma unroll
            for (int mm = 0; mm < 2; ++mm) { const int row = u.pm * 256 + ai * 128 + wr * 64 + (2 * mh + mm) * 16 + fr;
#pragma unroll
                for (int bj = 0; bj < 2; ++bj) { const size_t o = (size_t)row * D + u.pn * 256 + bj * 128 + wc * 32 + 8 * fq; b0[mm][bj] = *(const f32x4*)(base_p + o); b1[mm][bj] = *(const f32x4*)(base_p + o + 4); } }
#pragma unroll
            for (int mm = 0; mm < 2; ++mm) { const int m = 2 * mh + mm; const int row = u.pm * 256 + ai * 128 + wr * 64 + m * 16 + fr; float ss = 0.f;
#pragma unroll
                for (int bj = 0; bj < 2; ++bj) { const size_t o = (size_t)row * D + u.pn * 256 + bj * 128 + wc * 32 + 8 * fq;
                    const f32x4 h0 = acc[ai][bj][m][0] + b0[mm][bj], h1 = acc[ai][bj][m][1] + b1[mm][bj];
                    *(f32x4*)(H + o) = h0; *(f32x4*)(H + o + 4) = h1; *(u32x4*)(HB + o) = pk8(h0, h1);
                    ss += sum4(h0 * h0) + sum4(h1 * h1); }
                ss += __shfl_xor(ss, 16); ss += __shfl_xor(ss, 32);
                if (fq == 0) SS[(size_t)row * 32 + u.pn * 4 + wc] = ss; }
        }
}
struct PhaseOut : PhaseN2048<D, D, D> {
    DI bool next(int i, g8::Unit& u) const { return next_(i, u); }
    DI void epi(EPI_ARGS) const { epi_residual(acc, u, wr, wc, fr, fq, p.x_prompt, (float*)(p.ws + WS_H1), (bf16_t*)(p.ws + WS_H1B), (float*)(p.ws + WS_SS1)); }
};
struct PhaseDown : PhaseN2048<DFF, DFF, DFF> {
    DI bool next(int i, g8::Unit& u) const { return next_(i, u); }
    DI void epi(EPI_ARGS) const { epi_residual(acc, u, wr, wc, fr, fq, (const float*)(p.ws + WS_H1), (float*)(p.ws + WS_H2), (bf16_t*)(p.ws + WS_H2B), (float*)(p.ws + WS_SS2)); }
};
struct PhasePe : PhaseN2048<PLE, PLE, PLE> {
    DI bool next(int i, g8::Unit& u) const { const int first = (NTM * 43) % G, nfree = G - first; if (nfree <= 0 || c < first) return false;
        const long L = (long)i * nfree + (c - first); if (L >= 256) return false; const int pm = (int)L >> 3, pn = (int)L & 7;
        u.pm = pm; u.pn = pn; u.A = (const char*)(p.ws + a_off) + (size_t)pm * 256 * LDA * 2; u.B = (const char*)(p.ws + b_off) + (size_t)pn * 256 * LDB * 2; return true; }
    DI void epi(EPI_ARGS) const { float* PE = (float*)(p.ws + WS_PE);
        EPI_ROWS(row) EPI_COLS(col) const size_t o = (size_t)row * D + u.pn * 256 + col; *(f32x4*)(PE + o) = v0; *(f32x4*)(PE + o + 4) = v1; EPI_END }
};
struct PhasePg : PhaseN2048<D, D, D> {
    DI bool next(int i, g8::Unit& u) const { return next_(i, u); }
    DI void epi(EPI_ARGS) const { const float* H2 = (const float*)(p.ws + WS_H2); const float* PE = (const float*)(p.ws + WS_PE); const float* SS2 = (const float*)(p.ws + WS_SS2);
        float* H3 = (float*)(p.ws + WS_H3); float* SS3 = (float*)(p.ws + WS_SS3);
#pragma unroll
        for (int ai = 0; ai < 2; ++ai)
#pragma unroll
            for (int m = 0; m < 4; ++m) { f32x4 hA[2], hB[2], pA[2], pB[2];
                const int row = u.pm * 256 + ai * 128 + wr * 64 + m * 16 + fr; float s2 = 0.f;
#pragma unroll
                for (int k = 0; k < 8; ++k) s2 += sum4(*(const f32x4*)(SS2 + (size_t)row * 32 + 4 * k));
                const float rs = 1.0f / sqrtf(s2 * (1.0f / D) + EPS);
#pragma unroll
                for (int bj = 0; bj < 2; ++bj) { const size_t o = (size_t)row * D + u.pn * 256 + bj * 128 + wc * 32 + 8 * fq;
                    hA[bj] = *(const f32x4*)(H2 + o); hB[bj] = *(const f32x4*)(H2 + o + 4); pA[bj] = *(const f32x4*)(PE + o); pB[bj] = *(const f32x4*)(PE + o + 4); }
                float ss = 0.f;
#pragma unroll
                for (int bj = 0; bj < 2; ++bj) { const size_t o = (size_t)row * D + u.pn * 256 + bj * 128 + wc * 32 + 8 * fq;
                    const f32x4 h0 = hA[bj] + sig4(acc[ai][bj][m][0] * rs) * pA[bj], h1 = hB[bj] + sig4(acc[ai][bj][m][1] * rs) * pB[bj];
                    *(f32x4*)(H3 + o) = h0; *(f32x4*)(H3 + o + 4) = h1; ss += sum4(h0 * h0) + sum4(h1 * h1); }
                ss += __shfl_xor(ss, 16); ss += __shfl_xor(ss, 32);
                if (fq == 0) SS3[(size_t)row * 32 + u.pn * 4 + wc] = ss; } }
};
struct PhaseUp {
    static constexpr int LDA = D, LDB = D, KT = D / 64;
    const Params& p; int G, c;
    DI bool next(int i, g8::Unit& u) const { int pm, pn; if (!g8::grid_order(NTM, 43, G, c, i, pm, pn)) return false;
        u.pm = pm; u.pn = pn; u.A = (const char*)(p.ws + WS_H1B) + (size_t)pm * 256 * D * 2; u.B = (const char*)(p.ws + WS_WUP) + (size_t)pn * 256 * D * 2; return true; }
    DI void epi(EPI_ARGS) const { bf16_t* GU = (bf16_t*)(p.ws + WS_GU);
        EPI_ROWS(row) EPI_COLS(col) *(u32x4*)(GU + (size_t)row * NUP + u.pn * 256 + col) = pk8(v0, v1); EPI_END }
};

struct PhaseWpb {
    static constexpr int LDA = POOLW, LDB = 256, KT = 4;
    const Params& p; int G, c;
    DI bool next(int i, g8::Unit& u) const { const int off = 220 % G; const long L = (long)i * G + ((c + G - off) % G); if (L >= 32) return false;
        const int pm = (int)L >> 2, g = (int)L & 3; u.pm = pm; u.pn = g;
        u.A = (const char*)(p.ws + WS_WBT) + ((size_t)pm * 256 * POOLW + g * 256) * 2; u.B = (const char*)(p.ws + WS_WPS) + (size_t)g * 256 * 256 * 2; return true; }
    DI void epi(EPI_ARGS) const { bf16_t* W = (bf16_t*)(p.ws + WS_WPB);
        EPI_ROWS(row) EPI_COLS(col) *(u32x4*)(W + (size_t)row * POOLW + u.pn * 256 + col) = pk8(v0, v1); EPI_END }
};

template <int KS, int LDA, int LDB>
DI f32x4 skinny16(const bf16_t* A, const bf16_t* W, int lane) {
    const int fr = lane & 15, fq = lane >> 4;
    const bf16_t* ap = A + (size_t)fr * LDA + 8 * fq; const bf16_t* bp = W + (size_t)fr * LDB + 8 * fq;
    f32x4 acc = {0.f, 0.f, 0.f, 0.f};
#pragma unroll 4
    for (int s = 0; s < KS; ++s) { const bf16x8 a = *(const bf16x8*)(ap + 32 * s), b = *(const bf16x8*)(bp + 32 * s); acc = __builtin_amdgcn_mfma_f32_16x16x32_bf16(a, b, acc, 0, 0, 0); }
    return acc;
}
DI float sum16(float v) { v += __shfl_xor(v, 1); v += __shfl_xor(v, 2); v += __shfl_xor(v, 4); v += __shfl_xor(v, 8); return v; }
template <int KIND, int K, int LDA, int LDB, int NCG = 128>
DI void sample_gemm(const Params& p, LAS unsigned char* lds, size_t a_off, size_t w_off, int wave) {
    unsigned char* ws = p.ws; const int lane = lane_id(), fr = lane & 15, fq = lane >> 4;
    constexpr int KS = K / 64;
    for (int it = blockIdx.x; it < 2 * NCG; it += gridDim.x) {
        const int cg_ = it >> 1, r0 = MP + 64 * (it & 1) + 16 * (wave & 3), col = 16 * cg_ + fr, kh = wave >> 2;
        f32x4 acc = skinny16<KS, LDA, LDB>((const bf16_t*)(ws + a_off) + (size_t)r0 * LDA + kh * (K / 2), (const bf16_t*)(ws + w_off) + (size_t)(16 * cg_) * LDB + kh * (K / 2), lane);
        LAS f32x4* xch = (LAS f32x4*)lds;
        if (kh == 1) xch[(wave & 3) * 64 + lane] = acc;
        __syncthreads();
        if (kh == 0) {
        acc += xch[wave * 64 + lane];
        float rs[4] = {0.f, 0.f, 0.f, 0.f};
        if (KIND == 5) {
            const float* SS2S = (const float*)(ws + WS_SS2S);
#pragma unroll
            for (int r = 0; r < 16; ++r) { const float* q = SS2S + (size_t)(r0 - MP + r) * 128; const float s_ = wave_sum(q[lane] + q[64 + lane]); const float rr = 1.0f / sqrtf(s_ * (1.0f / D) + EPS);
#pragma unroll
                for (int j = 0; j < 4; ++j) rs[j] = (r == 4 * fq + j) ? rr : rs[j]; }
        }
#pragma unroll
        for (int j = 0; j < 4; ++j) {
            const int row = r0 + 4 * fq + j; const size_t o = (size_t)row * D + col; const float v = acc[j]; float hsq = 0.f;
            if (KIND == 6) { const float val = v * ((const float*)(ws + WS_RSTD1))[row];
                if (col < KW) ((bf16_t*)(ws + WS_QB))[(size_t)row * KW + col] = (bf16_t)(pk2(val * 0.0625f, 0.f) & 0xffffu);
                else if (col < 2 * KW) ((bf16_t*)(ws + WS_KB))[(size_t)row * KW + col - KW] = (bf16_t)(pk2(val, 0.f) & 0xffffu);
                else ((bf16_t*)(ws + WS_V))[(size_t)row * VW + col - 2 * KW] = (bf16_t)(pk2(val, 0.f) & 0xffffu); }
            if (KIND == 0) { ((float*)(ws + WS_YBG))[o] = v * bf1(((const bf16_t*)(ws + WS_GB))[o]); }
            if (KIND == 1) { ((bf16_t*)(ws + WS_MB))[o] = (bf16_t)(pk2(v * bf1(((const bf16_t*)(ws + WS_GA))[o]) + ((const float*)(ws + WS_YBG))[o], 0.f) & 0xffffu); }
            if (KIND == 2) { const float hv = p.x_sample[(size_t)(row - MP) * D + col] + v; ((float*)(ws + WS_H1))[o] = hv; ((bf16_t*)(ws + WS_H1B))[o] = (bf16_t)(pk2(hv, 0.f) & 0xffffu); hsq = hv * hv; }
            if (KIND == 3) { const float hv = ((const float*)(ws + WS_H1))[o] + v; ((float*)(ws + WS_H2))[o] = hv; ((bf16_t*)(ws + WS_H2B))[o] = (bf16_t)(pk2(hv, 0.f) & 0xffffu); hsq = hv * hv; }
            if (KIND == 4) { ((float*)(ws + WS_PE))[o] = v; }
            if (KIND == 5) { const float hv = ((const float*)(ws + WS_H2))[o] + sigmoidf_(v * rs[j]) * ((const float*)(ws + WS_PE))[o]; ((float*)(ws + WS_H3))[o] = hv; hsq = hv * hv; }
            if (KIND == 2 || KIND == 3 || KIND == 5) { const float t = sum16(hsq);
                float* SSx = (float*)(ws + (KIND == 2 ? WS_SS1S : (KIND == 3 ? WS_SS2S : WS_SS3S))); if (fr == 0) SSx[(size_t)(row - MP) * 128 + cg_] = t; }
        }
        }
        __syncthreads();
    }
}


#define XB_TMO      128
#define XB_XCNT(j)  (256  + 64 * (j))
#define XB_XSUB(j)  (1280 + 64 * (j))
#define XB_XGEN(j)  (2304 + 64 * (j))
#define XB_TOP      3328
#define XB_TOPGEN   3392
#define XCD_BAR_WORDS 3456
#define XB_SPIN_CAP (1u << 22)
DI unsigned xb_ld(unsigned* p)              { return __hip_atomic_load(p, __ATOMIC_RELAXED, __HIP_MEMORY_SCOPE_AGENT); }
DI unsigned xb_add(unsigned* p, unsigned v) { return __hip_atomic_fetch_add(p, v, __ATOMIC_RELAXED, __HIP_MEMORY_SCOPE_AGENT); }
DI unsigned xb_xcc_id() { return (unsigned)__builtin_amdgcn_s_getreg((3 << 11) | 20) & 0xFu; }
#define XB_SPIN(cond, bar) do { unsigned _sp = 0; while (cond) { __builtin_amdgcn_s_sleep(1); \
    if ((++_sp & 255u) == 0u) { if (xb_ld(&(bar)[XB_TMO])) break; if (_sp > XB_SPIN_CAP) { atomicAdd(&(bar)[XB_TMO], 1u); break; } } } } while (0)
struct XcdBarrier { unsigned* bar; unsigned x; volatile LAS unsigned* st; };
DI XcdBarrier xcd_barrier_post(unsigned* bar, volatile LAS unsigned* st, bool t0) {
    XcdBarrier b; b.bar = bar; b.x = xb_xcc_id(); b.st = st;
    if (t0) (void)xb_add(&bar[XB_XCNT(b.x)], 1u);
    return b;
}
DI void xcd_barrier_complete(unsigned* bar, unsigned x, unsigned& nloc, unsigned& nx) {
    const unsigned G = gridDim.x * gridDim.y * gridDim.z;
    unsigned sum, cnt, mine, sp = 0u;
    for (;;) {
        sum = 0u; cnt = 0u; mine = 0u;
#pragma unroll
        for (unsigned j = 0; j < 16; ++j) { const unsigned c = xb_ld(&bar[XB_XCNT(j)]); sum += c; cnt += (c > 0u) ? 1u : 0u; mine = (j == x) ? c : mine; }
        if (sum == G) break;
        __builtin_amdgcn_s_sleep(1);
        if ((++sp & 255u) == 0u) { if (xb_ld(&bar[XB_TMO])) break; if (sp > XB_SPIN_CAP) { atomicAdd(&bar[XB_TMO], 1u); break; } }
    }
    nloc = mine > 0u ? mine : 1u; nx = cnt > 0u ? cnt : 1u;
}
DI void xcd_barrier(const XcdBarrier& b, bool t0) {
    asm volatile("s_waitcnt vmcnt(0)" ::: "memory");
    __syncthreads();
    if (t0) {
        unsigned* bar = b.bar;
        __builtin_amdgcn_s_waitcnt(0);
        unsigned nloc = b.st[0], nx = b.st[1];
        if (nloc == 0u) { xcd_barrier_complete(bar, b.x, nloc, nx); b.st[0] = nloc; b.st[1] = nx; }
        const unsigned old = xb_add(&bar[XB_XSUB(b.x)], 1u);
        const unsigned gen = old / nloc;
        if (old + 1u == (gen + 1u) * nloc) {
            __builtin_amdgcn_fence(__ATOMIC_RELEASE, "agent");
            asm volatile("s_waitcnt vmcnt(0)" ::: "memory");
            const unsigned og = xb_add(&bar[XB_TOP], 1u);
            const unsigned tg = og / nx;
            if (og + 1u == (tg + 1u) * nx) xb_add(&bar[XB_TOPGEN], 1u);
            else XB_SPIN(xb_ld(&bar[XB_TOPGEN]) == tg, bar);
            __builtin_amdgcn_fence(__ATOMIC_ACQUIRE, "agent");
            xb_add(&bar[XB_XGEN(b.x)], 1u);
            asm volatile("s_waitcnt vmcnt(0)" ::: "memory");
        } else {
            XB_SPIN(xb_ld(&bar[XB_XGEN(b.x)]) == gen, bar);
            __builtin_amdgcn_fence(__ATOMIC_ACQUIRE, "agent");
            asm volatile("s_waitcnt vmcnt(0)" ::: "memory");
        }
    }
    __syncthreads();
}

constexpr int N_PHASES = 13;
#ifndef G8_SP2
#define G8_SP2 true
#endif
#ifndef G8_ALIGN
#define G8_ALIGN true
#endif

__global__ void __launch_bounds__(NTHREADS, 2) fwd_kernel(Params p) {
    extern __shared__ __attribute__((aligned(16))) unsigned char lds_raw[];
    LAS unsigned char* lds = (LAS unsigned char*)lds_raw;
    const int G = gridDim.x, c = blockIdx.x;
    const int wave = __builtin_amdgcn_readfirstlane(threadIdx.x >> 6);
    const int lo = p.ph_lo, hi = p.ph_hi;
#ifndef REPEAT_MASK
#define REPEAT_MASK 0
#endif
#ifndef PHASE_MASK
#define PHASE_MASK 0x1bff
#endif
#define IN(k) (((PHASE_MASK >> (k)) & 1) && lo <= (k) && (k) < hi)
    volatile LAS unsigned* bst = (volatile LAS unsigned*)(lds + LDS_MISC);
    const bool t0 = (wave == 0) && (lane_id() == 0);
    XcdBarrier bar; bar.bar = (unsigned*)(p.ws + WS_CTL); bar.x = 0; bar.st = bst;
    if (hi - lo > 1) { if (t0) { bst[0] = 0u; bst[1] = 0u; } __syncthreads(); bar = xcd_barrier_post((unsigned*)(p.ws + WS_CTL), bst, t0); }
#define NEXTPH(k) ((k) == 9 ? 11 : (k) + 1)
#define SEAM(k) do { if (IN(k) && IN(NEXTPH(k))) { xcd_barrier(bar, (wave == 0) && (lane_id() == 0)); } } while (0)
    if (IN(0)) { phase_p0(p, lds, wave); if ((REPEAT_MASK >> 0) & 1) { xcd_barrier(bar, (wave == 0) && (lane_id() == 0)); phase_p0(p, lds, wave); } } SEAM(0);
    if (IN(1)) { sample_gemm<6, D, D, D, 256>(p, lds, WS_XB, WS_WIN, wave); PhaseIn ph{p, G, c, 0, 0}; g8::run<PhaseIn, G8_ALIGN, G8_SP2>(lds, ph, wave); } SEAM(1);
    if (IN(2)) {
        if (G == 256) {
            if (c < 32) scan_role(p, lds, wave, c, 32);
            else if (c < 64) stream_role(p, wave, c - 32, 32);
            else { PhaseIn ph{p, G, c, 1, 64}; g8::run<PhaseIn, G8_ALIGN, G8_SP2>(lds, ph, wave); PhaseWpb pw{p, G, c}; g8::run<PhaseWpb, G8_ALIGN, G8_SP2>(lds, pw, wave); }
        } else {
            PhaseIn ph{p, G, c, 1, 0}; g8::run<PhaseIn, G8_ALIGN, G8_SP2>(lds, ph, wave); PhaseWpb pw{p, G, c}; g8::run<PhaseWpb, G8_ALIGN, G8_SP2>(lds, pw, wave);
            scan_role(p, lds, wave, c, G); stream_role(p, wave, c, G);
        }
    } SEAM(2);
    if (IN(3)) { phase_p3(p, wave); if ((REPEAT_MASK >> 3) & 1) { xcd_barrier(bar, (wave == 0) && (lane_id() == 0)); phase_p3(p, wave); } } SEAM(3);
    if (IN(4)) { sample_gemm<0, POOLW, POOLW, POOLW>(p, lds, WS_PM, WS_WPB, wave); PhaseYb ph{{p, G, c, WS_PM, WS_WPB}}; g8::run<PhaseYb, G8_ALIGN, G8_SP2>(lds, ph, wave); if ((REPEAT_MASK >> 4) & 1) { xcd_barrier(bar, (wave == 0) && (lane_id() == 0)); sample_gemm<0, POOLW, POOLW, POOLW>(p, lds, WS_PM, WS_WPB, wave); PhaseYb ph{{p, G, c, WS_PM, WS_WPB}}; g8::run<PhaseYb, G8_ALIGN, G8_SP2>(lds, ph, wave); } } SEAM(4);
    if (IN(5)) { sample_gemm<1, VW, VW, VW>(p, lds, WS_OG, WS_WA, wave); PhaseYa ph{{p, G, c, WS_OG, WS_WA}}; g8::run<PhaseYa, G8_ALIGN, G8_SP2>(lds, ph, wave); if ((REPEAT_MASK >> 5) & 1) { xcd_barrier(bar, (wave == 0) && (lane_id() == 0)); sample_gemm<1, VW, VW, VW>(p, lds, WS_OG, WS_WA, wave); PhaseYa ph{{p, G, c, WS_OG, WS_WA}}; g8::run<PhaseYa, G8_ALIGN, G8_SP2>(lds, ph, wave); } } SEAM(5);
    if (IN(6)) { sample_gemm<2, D, D, D>(p, lds, WS_MB, WS_WO, wave); PhaseOut ph{{p, G, c, WS_MB, WS_WO}}; g8::run<PhaseOut, G8_ALIGN, G8_SP2>(lds, ph, wave); if ((REPEAT_MASK >> 6) & 1) { xcd_barrier(bar, (wave == 0) && (lane_id() == 0)); sample_gemm<2, D, D, D>(p, lds, WS_MB, WS_WO, wave); PhaseOut ph{{p, G, c, WS_MB, WS_WO}}; g8::run<PhaseOut, G8_ALIGN, G8_SP2>(lds, ph, wave); } } SEAM(6);
    if (IN(7)) { PhaseUp ph{p, G, c}; g8::run<PhaseUp, G8_ALIGN, G8_SP2>(lds, ph, wave); sample_gemm<4, PLE, PLE, PLE>(p, lds, WS_PLB, WS_WPLE, wave); { PhasePe pe{{p, G, c, WS_PLB, WS_WPLE}}; g8::run<PhasePe, G8_ALIGN, G8_SP2>(lds, pe, wave); } if ((REPEAT_MASK >> 7) & 1) { xcd_barrier(bar, (wave == 0) && (lane_id() == 0)); PhaseUp ph{p, G, c}; g8::run<PhaseUp, G8_ALIGN, G8_SP2>(lds, ph, wave); } } SEAM(7);
    if (IN(8)) { phase_conv(p, wave); if ((REPEAT_MASK >> 8) & 1) { xcd_barrier(bar, (wave == 0) && (lane_id() == 0)); phase_conv(p, wave); } } SEAM(8);
    if (IN(9)) { sample_gemm<3, DFF, DFF, DFF>(p, lds, WS_ACT, WS_WD, wave); PhaseDown ph{{p, G, c, WS_ACT, WS_WD}}; g8::run<PhaseDown, G8_ALIGN, G8_SP2>(lds, ph, wave); if ((REPEAT_MASK >> 9) & 1) { xcd_barrier(bar, (wave == 0) && (lane_id() == 0)); sample_gemm<3, DFF, DFF, DFF>(p, lds, WS_ACT, WS_WD, wave); PhaseDown ph{{p, G, c, WS_ACT, WS_WD}}; g8::run<PhaseDown, G8_ALIGN, G8_SP2>(lds, ph, wave); } } SEAM(9);
    if (IN(11)) { sample_gemm<5, D, D, D>(p, lds, WS_H2B, WS_WPG, wave); PhasePg ph{{p, G, c, WS_H2B, WS_WPG}}; g8::run<PhasePg, G8_ALIGN, G8_SP2>(lds, ph, wave); if ((REPEAT_MASK >> 11) & 1) { xcd_barrier(bar, (wave == 0) && (lane_id() == 0)); sample_gemm<5, D, D, D>(p, lds, WS_H2B, WS_WPG, wave); PhasePg ph{{p, G, c, WS_H2B, WS_WPG}}; g8::run<PhasePg, G8_ALIGN, G8_SP2>(lds, ph, wave); } } SEAM(11);
    if (IN(12)) { phase_final(p, wave); if ((REPEAT_MASK >> 12) & 1) { xcd_barrier(bar, (wave == 0) && (lane_id() == 0)); phase_final(p, wave); } }
#undef IN
#undef SEAM
}

extern "C" void kernel_launch(void* const* d_in, const int* in_sizes, int n_in, void* d_out, int out_size, void* d_ws, size_t ws_size, hipStream_t stream) {
    static int grid = 0;
    if (grid == 0) {
        if (n_in != 26 || (size_t)out_size != O_END || ws_size < WS_END) {
            fprintf(stderr, "kernel_launch: unexpected problem: n_in %d out %d ws %zu (need %zu)\n", n_in, out_size, ws_size, (size_t)WS_END); grid = -1; return; }
        int dev = 0, cus = 0, per_cu = 0;
        if (hipGetDevice(&dev) != hipSuccess || hipDeviceGetAttribute(&cus, hipDeviceAttributeMultiprocessorCount, dev) != hipSuccess) { grid = -1; return; }
        if (hipFuncSetAttribute((const void*)fwd_kernel, hipFuncAttributeMaxDynamicSharedMemorySize, LDS_BYTES) != hipSuccess) { fprintf(stderr, "kernel_launch: hipFuncSetAttribute failed\n"); grid = -1; return; }
        if (hipOccupancyMaxActiveBlocksPerMultiprocessor(&per_cu, (const void*)fwd_kernel, NTHREADS, LDS_BYTES) != hipSuccess || per_cu < 1) {
            fprintf(stderr, "kernel_launch: occupancy query reports %d blocks per CU\n", per_cu); (void)hipGetLastError(); grid = -1; return; }
        grid = cus;
    }
    if (grid < 0) return;
    Params p{};
    const float** pp = (const float**)&p;
    for (int i = 0; i < 26; ++i) pp[i] = (const float*)d_in[i];
    p.out = (float*)d_out; p.ws = (unsigned char*)d_ws;
#if MK_N_LAUNCHES == 1
    p.ph_lo = 0; p.ph_hi = N_PHASES;
    void* args[] = {&p};
    if (hipMemsetAsync((char*)d_ws + WS_CTL, 0, XCD_BAR_WORDS * 4, stream) != hipSuccess) { fprintf(stderr, "kernel_launch: memset failed\n"); return; }
    hipError_t e = hipLaunchCooperativeKernel((const void*)fwd_kernel, dim3(grid), dim3(NTHREADS), args, LDS_BYTES, stream);
    if (e != hipSuccess) fprintf(stderr, "kernel_launch: cooperative launch failed: %s (grid %d)\n", hipGetErrorString(e), grid);
#else
    for (int k = 0; k < N_PHASES; ++k) { p.ph_lo = k; p.ph_hi = k + 1; hipLaunchKernelGGL(fwd_kernel, dim3(grid), dim3(NTHREADS), LDS_BYTES, stream, p); }
#endif
}
```

```cpp
#include <hip/hip_runtime.h>
#include <hip/hip_cooperative_groups.h>
#include <cstdio>
#include <cstdint>
namespace cg = cooperative_groups;

#ifndef MK_N_LAUNCHES
#define MK_N_LAUNCHES 1
#endif

#define LAS __attribute__((address_space(3)))
#define DI __device__ __forceinline__
typedef unsigned short bf16_t;
typedef short bf16x8 __attribute__((ext_vector_type(8)));
typedef short s16x4 __attribute__((ext_vector_type(4)));
typedef float f32x4 __attribute__((ext_vector_type(4)));
typedef float f32x2 __attribute__((ext_vector_type(2)));
typedef float f32x16 __attribute__((ext_vector_type(16)));
typedef unsigned u32x4 __attribute__((ext_vector_type(4)));
typedef unsigned u32x2 __attribute__((ext_vector_type(2)));

constexpr int D = 2048, MP = 8192, MS = 128, M = MP + MS, MPAD = 8448, NTM = 33;
constexpr int SEQ = 2048, NB = 4, NH = 4, DK = 256, DV = 512, KW = 1024, VW = 2048;
constexpr int DFF = 5504, NUP = 2 * DFF, PLE = 256, POOLW = 1024, INW = 11280, NIN = 11264;
constexpr float EPS = 1e-6f;
constexpr int NSL = 16;
constexpr int CH = 32, NCHK = MP / CH;

constexpr size_t O_YP = 0, O_YS = O_YP + (size_t)MP * D, O_GLAP = O_YS + (size_t)MS * D, O_POOLP = O_GLAP + (size_t)NB * NH * DK * DV,
                 O_CONVP = O_POOLP + (size_t)NB * 15 * POOLW, O_GLAS = O_CONVP + (size_t)NB * 2 * DFF, O_POOLS = O_GLAS + (size_t)MS * NH * DK * DV,
                 O_CONVS = O_POOLS + (size_t)MS * 15 * POOLW, O_END = O_CONVS + (size_t)MS * 2 * DFF;

constexpr size_t al(size_t x) { return (x + 255) & ~(size_t)255; }
constexpr size_t WS_CTL = 0, CTL_BYTES = 65536;
constexpr size_t WS_WUP = WS_CTL + CTL_BYTES;
constexpr size_t WS_WD = WS_WUP + al((size_t)NUP * D * 2);
constexpr size_t WS_WA = WS_WD + al((size_t)D * DFF * 2);
constexpr size_t WS_WO = WS_WA + al((size_t)D * D * 2);
constexpr size_t WS_WPG = WS_WO + al((size_t)D * D * 2);
constexpr size_t WS_WPB = WS_WPG + al((size_t)D * D * 2);
constexpr size_t WS_WPLE = WS_WPB + al((size_t)D * POOLW * 2);
constexpr size_t WS_WBT = WS_WPLE + al((size_t)D * PLE * 2);
constexpr size_t WS_WPS = WS_WBT + al((size_t)D * POOLW * 2);
constexpr size_t WS_SMALL = WS_WPS + al((size_t)POOLW * 256 * 2);
constexpr size_t WS_RSTD1 = WS_SMALL;
constexpr size_t WS_LAM = WS_RSTD1 + al((size_t)MPAD * 4);
constexpr size_t WS_OSS = WS_LAM + al((size_t)(NCHK + MS) * KW * 4);
constexpr size_t WS_OSP = WS_OSS + al((size_t)MP * NH * NSL * 4);
constexpr size_t WS_SS1 = WS_OSP + al((size_t)MS * NH * 8 * DV * 4);
constexpr size_t WS_SS2 = WS_SS1 + al((size_t)MPAD * 32 * 4);
constexpr size_t WS_SS3 = WS_SS2 + al((size_t)MPAD * 32 * 4);
constexpr size_t WS_SS1S = WS_SS3 + al((size_t)MPAD * 32 * 4);
constexpr size_t WS_SS2S = WS_SS1S + al((size_t)MS * 128 * 4);
constexpr size_t WS_SS3S = WS_SS2S + al((size_t)MS * 128 * 4);
constexpr size_t WS_PLB = WS_SS3S + al((size_t)MS * 128 * 4);
constexpr size_t WS_R1 = WS_PLB + al((size_t)MPAD * PLE * 2);
constexpr size_t WS_XB = WS_R1;
constexpr size_t WS_WIN = WS_XB + al((size_t)MPAD * D * 2);
constexpr size_t WS_BCUM = WS_WIN + al((size_t)NIN * D * 2);
constexpr size_t WS_R1_END = WS_BCUM + al((size_t)MPAD * KW * 4);
constexpr size_t WS_ACT = WS_R1;
static_assert(WS_ACT + al((size_t)MPAD * DFF * 2) <= WS_R1_END, "R1 overlay");
constexpr size_t WS_R2 = WS_R1_END;
constexpr size_t WS_QB = WS_R2;
constexpr size_t WS_KB = WS_QB + al((size_t)MPAD * KW * 2);
constexpr size_t WS_KD = WS_KB + al((size_t)MPAD * KW * 2);
constexpr size_t WS_V = WS_KD + al((size_t)MPAD * KW * 2);
constexpr size_t WS_SR = WS_V + al((size_t)MPAD * VW * 2);
constexpr size_t WS_GA = WS_SR + al((size_t)MPAD * VW * 2);
constexpr size_t WS_GB = WS_GA + al((size_t)MPAD * D * 2);
constexpr size_t WS_U = WS_GB + al((size_t)MPAD * D * 2);
constexpr size_t WS_OG = WS_U + al((size_t)MPAD * POOLW * 4);
constexpr size_t WS_PM = WS_OG + al((size_t)MPAD * VW * 2);
constexpr size_t WS_YBG = WS_PM + al((size_t)MPAD * POOLW * 2);
constexpr size_t WS_R2_END = WS_YBG + al((size_t)MPAD * D * 4);
constexpr size_t WS_GU = WS_R2;
constexpr size_t WS_H2 = WS_GU + al((size_t)MPAD * NUP * 2);
constexpr size_t WS_PE = WS_H2 + al((size_t)MPAD * D * 4);
static_assert(WS_PE + al((size_t)MPAD * D * 4) <= WS_R2_END, "R2 overlay");
constexpr size_t WS_MB = WS_R2_END;
constexpr size_t WS_H1 = WS_MB + al((size_t)MPAD * D * 2);
constexpr size_t WS_H1B = WS_H1 + al((size_t)MPAD * D * 4);
constexpr size_t WS_END = WS_H1B + al((size_t)MPAD * D * 2);
constexpr size_t WS_H3 = WS_H1;
constexpr size_t WS_H2B = WS_MB;

DI unsigned pk2(float lo, float hi) {
    typedef __bf16 bf2 __attribute__((ext_vector_type(2)));
    f32x2 v = {lo, hi};
    bf2 b = __builtin_convertvector(v, bf2);
    return __builtin_bit_cast(unsigned, b);
}
DI float bflo(unsigned w) { return __uint_as_float(w << 16); }
DI float bfhi(unsigned w) { return __uint_as_float(w & 0xffff0000u); }
DI float bf1(bf16_t b) { return __uint_as_float(((unsigned)b) << 16); }
DI float fexp(float x) { return __expf(x); }
DI float sigmoidf_(float x) { return __builtin_amdgcn_rcpf(1.0f + __expf(-x)); }
DI float siluf_(float x) { return x * sigmoidf_(x); }
DI float logsigmoidf_(float z) { return fminf(z, 0.f) - __logf(1.0f + __expf(-fabsf(z))); }
DI float wave_sum(float v) {
#pragma unroll
    for (int o = 1; o < 64; o <<= 1) v += __shfl_xor(v, o);
    return v;
}
DI int lane_id() { int l; asm volatile("v_mbcnt_lo_u32_b32 %0, -1, 0\n\tv_mbcnt_hi_u32_b32 %0, -1, %0" : "=v"(l)); return l; }
#define LDS_WAIT() asm volatile("s_waitcnt lgkmcnt(0)" ::: "memory")
#define VM_WAIT() asm volatile("s_waitcnt vmcnt(0)" ::: "memory")

struct Params {
    const float *x_prompt, *x_sample, *state_gla, *state_pool, *state_conv, *p_prompt, *p_sample;
    const float *norm_mix, *w_in, *w_gate_up, *b_gate, *gla_norm, *w_branch_a, *w_pool, *pool_scale, *w_branch_b, *w_out, *norm_ffn, *w_up, *conv_w, *conv_b,
        *w_down, *norm_ple, *w_ple_gate, *w_ple, *norm_final;
    float* out; unsigned char* ws;
    int ph_lo, ph_hi;
};

constexpr int NWAVES = 8, NTHREADS = 512;
constexpr int LDS_BYTES = 163840;
constexpr int LDS_MISC = LDS_BYTES - 256;

namespace g8 {
constexpr int BM = 256, BK = 64, HALF = 128, HTB = HALF * BK * 2, STAGE_BYTES = 8 * HTB, NXCD = 8, WGM = 8;
DI int lds_byte(int r, int c) { const int st = (r >> 4) * 2 + (c >> 5), rr = r & 15, cc = c & 31, ob = rr * 64 + cc * 2; return st * 1024 + (ob ^ (((ob >> 9) & 1) << 5)); }
DI void stage_rc(int b, int& R, int& C) { const int st = b / 1024, sb = b % 1024, swz = sb ^ (((sb >> 9) & 1) << 5); R = (st >> 1) * 16 + swz / 64; C = (st & 1) * 32 + (swz % 64) / 2; }
DI int perm32(int rho) { const int n = rho >> 4, i = rho & 15; return 8 * (i >> 2) + 4 * n + (i & 3); }

struct Unit { const char* A; const char* B; int pm, pn; };

DI bool grid_order(int nM, int nN, int G, int c, int i, int& pm, int& pn) {
    const int nwg = nM * nN; const long L = (long)i * G + c; if (L >= nwg) return false;
    int wgid = (int)L; { const int q = nwg / NXCD, r = nwg % NXCD, xcd = wgid % NXCD, off = wgid / NXCD; wgid = (xcd < r ? xcd * (q + 1) : r * (q + 1) + (xcd - r) * q) + off; }
    const int nig = WGM * nN, gid = wgid / nig, fm = gid * WGM, gsz = (nM - fm) < WGM ? (nM - fm) : WGM;
    pm = fm + ((wgid % nig) % gsz); pn = (wgid % nig) / gsz; return true;
}

template <class P, bool ALIGN_EPI, bool SP2>
DI void run(LAS unsigned char* lds, const P& ph, int wid) {
    const int lane = lane_id(), tid = wid * 64 + lane, wr = wid >> 2, wc = wid & 3, fr = lane & 15, fq = lane >> 4;
    constexpr int nt = P::KT;
    unsigned voffA[2], voffB[2];
#pragma unroll
    for (int i = 0; i < 2; ++i) { int R, C; stage_rc(tid * 16 + i * 8192, R, C); const int Rb = (R & ~31) + perm32(R & 31);
        voffA[i] = (unsigned)(R * P::LDA + C) * 2u; voffB[i] = (unsigned)(Rb * P::LDB + C) * 2u; }
    constexpr size_t kstep = (size_t)(BK * 2);
    constexpr size_t hstepA = (size_t)HALF * P::LDA * 2, hstepB = (size_t)HALF * P::LDB * 2;
    const unsigned ldsw = (unsigned)wid * 1024u;
    const int aoff = lds_byte(wr * 64 + fr, fq * 8), boff = lds_byte(wc * 32 + fr, fq * 8);
#define G8_SA(b, h) (((b) * 2 + (h)) * HTB)
#define G8_SB(b, h) ((4 + (b) * 2 + (h)) * HTB)
#define G8_STAGE(bufoff, gbase, voff) do { _Pragma("unroll") for (int _i = 0; _i < 2; ++_i) \
        __builtin_amdgcn_global_load_lds((const unsigned*)((const char*)(gbase) + (voff)[_i]), (LAS unsigned*)(lds + (bufoff) + ldsw + _i * 8192), 16, 0, 0); } while (0)
#define G8_LDA(dst, b, h) do { _Pragma("unroll") for (int m = 0; m < 4; ++m) _Pragma("unroll") for (int k = 0; k < 2; ++k) dst[m][k] = *(const LAS bf16x8*)(lds + G8_SA(b, h) + aoff + m * 2048 + k * 1024); } while (0)
#define G8_LDB(dst, b, h) do { _Pragma("unroll") for (int n = 0; n < 2; ++n) _Pragma("unroll") for (int k = 0; k < 2; ++k) dst[n][k] = *(const LAS bf16x8*)(lds + G8_SB(b, h) + boff + n * 2048 + k * 1024); } while (0)
#define G8_MMA(ai, bj, At, Bt) do { __builtin_amdgcn_s_setprio(1); _Pragma("unroll") for (int m = 0; m < 4; ++m) _Pragma("unroll") for (int n = 0; n < 2; ++n) _Pragma("unroll") for (int k = 0; k < 2; ++k) \
        acc[ai][bj][m][n] = __builtin_amdgcn_mfma_f32_16x16x32_bf16(Bt[n][k], At[m][k], acc[ai][bj][m][n], 0, 0, 0); __builtin_amdgcn_s_setprio(0); } while (0)
#define G8_WAIT_V(n) asm volatile("s_waitcnt vmcnt(" #n ")" ::: "memory")
#define G8_WAIT_L(n) asm volatile("s_waitcnt lgkmcnt(" #n ")" ::: "memory")
#define G8_BAR __builtin_amdgcn_s_barrier()
#define G8_SCHED __builtin_amdgcn_sched_barrier(0)
    Unit cur, nxt; int ui = 0;
    if (!ph.next(0, cur)) return;
    f32x4 acc[2][2][4][2];
#pragma unroll
    for (int a = 0; a < 2; ++a)
#pragma unroll
        for (int b = 0; b < 2; ++b)
#pragma unroll
            for (int m = 0; m < 4; ++m)
#pragma unroll
                for (int n = 0; n < 2; ++n) acc[a][b][m][n] = (f32x4){0.f, 0.f, 0.f, 0.f};
    bf16x8 At[4][2], B0[2][2], B1[2][2];
    const char* cA = cur.A; const char* cB = cur.B;
    if constexpr (SP2) {
        G8_STAGE(G8_SB(0, 0), cB, voffB); G8_STAGE(G8_SB(0, 1), cB + hstepB, voffB); G8_STAGE(G8_SA(0, 0), cA, voffA); G8_STAGE(G8_SA(0, 1), cA + hstepA, voffA);
        if (wr == 1) G8_BAR;
        G8_WAIT_V(2); G8_BAR;
        G8_STAGE(G8_SB(1, 0), cB + kstep, voffB); G8_STAGE(G8_SA(1, 0), cA + kstep, voffA); G8_STAGE(G8_SB(1, 1), cB + hstepB + kstep, voffB);
        G8_WAIT_V(6); G8_BAR;
    } else {
        G8_STAGE(G8_SB(0, 0), cB, voffB); G8_STAGE(G8_SA(0, 0), cA, voffA); G8_STAGE(G8_SB(0, 1), cB + hstepB, voffB); G8_STAGE(G8_SA(0, 1), cA + hstepA, voffA);
        if (wr == 1) G8_BAR;
        G8_WAIT_V(4); G8_BAR;
        G8_STAGE(G8_SB(1, 0), cB + kstep, voffB); G8_STAGE(G8_SA(1, 0), cA + kstep, voffA); G8_STAGE(G8_SB(1, 1), cB + hstepB + kstep, voffB);
        G8_WAIT_V(6); G8_BAR;
    }
    for (;;) {
        const bool has_next = ph.next(ui + 1, nxt);
        const char* nA = has_next ? nxt.A : cA; const char* nB = has_next ? nxt.B : cB;
#pragma unroll 1
        for (int t = 0; t < nt; t += 2) {
            const bool last = (t == nt - 2);
            const char* a1 = cA + (size_t)(t + 1) * kstep;
            const char* a2 = last ? nA : cA + (size_t)(t + 2) * kstep; const char* b2 = last ? nB : cB + (size_t)(t + 2) * kstep;
            const char* a3 = a2 + kstep; const char* b3 = b2 + kstep;
            if constexpr (SP2) {
            G8_LDB(B0, 0, 0); G8_LDB(B1, 0, 1); G8_SCHED; G8_LDA(At, 0, 0); G8_STAGE(G8_SA(1, 1), a1 + hstepA, voffA);
            G8_WAIT_V(8); G8_WAIT_L(0); G8_BAR; G8_MMA(0, 0, At, B0); G8_MMA(0, 1, At, B1); G8_BAR; G8_SCHED;
            G8_LDA(At, 0, 1); G8_STAGE(G8_SB(0, 0), b2, voffB); G8_STAGE(G8_SB(0, 1), b2 + hstepB, voffB); G8_STAGE(G8_SA(0, 0), a2, voffA);
            G8_WAIT_V(8); G8_WAIT_L(0); G8_BAR; G8_MMA(1, 0, At, B0); G8_MMA(1, 1, At, B1); G8_BAR; G8_SCHED;
            G8_LDB(B0, 1, 0); G8_LDB(B1, 1, 1); G8_SCHED; G8_LDA(At, 1, 0); G8_STAGE(G8_SA(0, 1), a2 + hstepA, voffA);
            G8_WAIT_V(8); G8_WAIT_L(0); G8_BAR; G8_MMA(0, 0, At, B0); G8_MMA(0, 1, At, B1); G8_BAR; G8_SCHED;
            G8_LDA(At, 1, 1); G8_STAGE(G8_SB(1, 0), b3, voffB); G8_STAGE(G8_SB(1, 1), b3 + hstepB, voffB); G8_STAGE(G8_SA(1, 0), a3, voffA);
            G8_WAIT_V(8); G8_WAIT_L(0); G8_BAR; G8_MMA(1, 0, At, B0); G8_MMA(1, 1, At, B1); G8_BAR; G8_SCHED;
            } else {
            G8_LDB(B0, 0, 0); G8_SCHED; G8_LDA(At, 0, 0); G8_STAGE(G8_SA(1, 1), a1 + hstepA, voffA);
            G8_WAIT_L(8); G8_BAR; G8_WAIT_L(0); G8_MMA(0, 0, At, B0); G8_BAR; G8_SCHED;
            G8_LDB(B1, 0, 1); G8_STAGE(G8_SB(0, 0), b2, voffB);
            G8_BAR; G8_WAIT_L(0); G8_MMA(0, 1, At, B1); G8_BAR;
            G8_LDA(At, 0, 1); G8_STAGE(G8_SA(0, 0), a2, voffA);
            G8_BAR; G8_WAIT_L(0); G8_MMA(1, 0, At, B0); G8_BAR; G8_SCHED;
            G8_STAGE(G8_SB(0, 1), b2 + hstepB, voffB);
            G8_WAIT_V(6); G8_BAR; G8_MMA(1, 1, At, B1); G8_BAR;
            G8_LDB(B0, 1, 0); G8_SCHED; G8_LDA(At, 1, 0); G8_STAGE(G8_SA(0, 1), a2 + hstepA, voffA);
            G8_WAIT_L(8); G8_BAR; G8_WAIT_L(0); G8_MMA(0, 0, At, B0); G8_BAR; G8_SCHED;
            G8_LDB(B1, 1, 1); G8_STAGE(G8_SB(1, 0), b3, voffB);
            G8_BAR; G8_WAIT_L(0); G8_MMA(0, 1, At, B1); G8_BAR;
            G8_LDA(At, 1, 1); G8_STAGE(G8_SA(1, 0), a3, voffA);
            G8_BAR; G8_WAIT_L(0); G8_MMA(1, 0, At, B0); G8_BAR; G8_SCHED;
            G8_STAGE(G8_SB(1, 1), b3 + hstepB, voffB);
            G8_WAIT_V(6); G8_BAR; G8_MMA(1, 1, At, B1); G8_BAR;
            }
        }
        if constexpr (ALIGN_EPI) { if (wr == 0) G8_BAR; }
        ph.epi(acc, cur, wr, wc, fr, fq);
        if (!has_next) break;
#pragma unroll
        for (int a = 0; a < 2; ++a)
#pragma unroll
            for (int b = 0; b < 2; ++b)
#pragma unroll
                for (int m = 0; m < 4; ++m)
#pragma unroll
                    for (int n = 0; n < 2; ++n) acc[a][b][m][n] = (f32x4){0.f, 0.f, 0.f, 0.f};
        cur = nxt; cA = nA; cB = nB; ++ui;
        if constexpr (ALIGN_EPI) { if (wr == 1) G8_BAR; }
    }
    G8_WAIT_V(0);
    if constexpr (!ALIGN_EPI) { if (wr == 0) G8_BAR; }
    G8_BAR;
#undef G8_SA
#undef G8_SB
#undef G8_STAGE
#undef G8_LDA
#undef G8_LDB
#undef G8_MMA
#undef G8_WAIT_V
#undef G8_WAIT_L
#undef G8_BAR
#undef G8_SCHED
}
}

struct TJob { const float* src; bf16_t* dst; const float* gain; int K, Nsrc, Ndst, map, nitems; };

DI int map_col(int map, int n0) {
    if (map == 1) return n0 + (n0 >= 6144 ? 16 : 0);
    if (map == 2) { const int t = n0 >> 8, r = n0 & 255; return (r < 128) ? 128 * t + r : DFF + 128 * t + (r - 128); }
    return n0;
}
constexpr int TR_SCR = 64 * 65 * 4;
static_assert(8 * TR_SCR <= LDS_MISC, "transpose scratch must stay below the barrier words");
DI void p0_transpose_item(const TJob& J, LAS float* scr, int item, int lane) {
    const int nblk = J.Ndst / 64, kb = item / nblk, nb = item % nblk, k0 = 64 * kb, n0 = 64 * nb, ns0 = map_col(J.map, n0);
    const float* src = J.src + (size_t)(k0 + (lane >> 4)) * J.Nsrc + ns0 + 4 * (lane & 15);
    f32x4 v[16];
#pragma unroll
    for (int i = 0; i < 16; ++i) v[i] = *(const f32x4*)(src + (size_t)(4 * i) * J.Nsrc);
    if (J.gain) {
#pragma unroll
        for (int i = 0; i < 16; ++i) v[i] *= J.gain[k0 + 4 * i + (lane >> 4)];
    }
#pragma unroll
    for (int i = 0; i < 16; ++i) { LAS float* d = scr + (4 * i + (lane >> 4)) * 65 + 4 * (lane & 15); d[0] = v[i].x; d[1] = v[i].y; d[2] = v[i].z; d[3] = v[i].w; }
    LDS_WAIT(); asm volatile("" ::: "memory");
    const int c = lane & 7;
#pragma unroll
    for (int j = 0; j < 8; ++j) { const int n = (lane >> 3) + 8 * j; const LAS float* s = scr + (8 * c) * 65 + n;
        u32x4 o; o.x = pk2(s[0 * 65], s[1 * 65]); o.y = pk2(s[2 * 65], s[3 * 65]); o.z = pk2(s[4 * 65], s[5 * 65]); o.w = pk2(s[6 * 65], s[7 * 65]);
        *(u32x4*)(J.dst + (size_t)(n0 + n) * J.K + k0 + 8 * c) = o; }
    LDS_WAIT(); asm volatile("" ::: "memory");
}
DI void p0_wps_item(const Params& p, bf16_t* WPS, int item, int lane) {
    const size_t e = (size_t)item * 512 + lane * 8; const float* src = p.w_pool + e;
    const f32x4 a = *(const f32x4*)src, b = *(const f32x4*)(src + 4);
    u32x4 o; o.x = pk2(a.x, a.y); o.y = pk2(a.z, a.w); o.z = pk2(b.x, b.y); o.w = pk2(b.z, b.w);
    *(u32x4*)(WPS + e) = o;
}
DI void p0_plb_item(const Params& p, bf16_t* PLB, int item, int lane) {
    const size_t e = (size_t)item * 512 + lane * 8; const size_t row = e / PLE;
    const float* src = (row < MP) ? p.p_prompt + e : p.p_sample + (e - (size_t)MP * PLE);
    const f32x4 a = *(const f32x4*)src, b = *(const f32x4*)(src + 4);
    u32x4 o; o.x = pk2(a.x, a.y); o.y = pk2(a.z, a.w); o.z = pk2(b.x, b.y); o.w = pk2(b.z, b.w);
    *(u32x4*)(PLB + e) = o;
}

DI void p0_xprep_unit(const Params& p, LAS unsigned char* lds, int u, int wave) {
    const int lane = lane_id(), tid = wave * 64 + lane;
    unsigned char* ws = p.ws;
    bf16_t* XB = (bf16_t*)(ws + WS_XB); float* RSTD1 = (float*)(ws + WS_RSTD1); float* BCUM = (float*)(ws + WS_BCUM); float* LAM = (float*)(ws + WS_LAM);
    LAS unsigned char* WG = lds; LAS float* GL = (LAS float*)(lds + 65536); LAS float* RS = (LAS float*)(lds + 69632);
    {   f32x4 w[16]; float gk[16];
#pragma unroll
        for (int i = 0; i < 16; ++i) { const int idx = tid + 512 * i, k = idx >> 2, n4 = idx & 3; w[i] = *(const f32x4*)(p.w_in + (size_t)k * INW + 6144 + 4 * n4); gk[i] = p.norm_mix[k]; }
#pragma unroll
        for (int i = 0; i < 16; ++i) { const int idx = tid + 512 * i, k = idx >> 2, n4 = idx & 3; LAS bf16_t* d = (LAS bf16_t*)(WG + (size_t)((k >> 3) * 16 + 4 * n4) * 16) + (k & 7);
            const unsigned a = pk2(w[i].x * gk[i], w[i].y * gk[i]), b = pk2(w[i].z * gk[i], w[i].w * gk[i]);
            d[0] = (bf16_t)(a & 0xffffu); d[8] = (bf16_t)(a >> 16); d[16] = (bf16_t)(b & 0xffffu); d[24] = (bf16_t)(b >> 16); }
    }
    __syncthreads();
    if (wave < 4) {
        const int fr = lane & 15, fq = lane >> 4; const int row = 64 * u + 16 * wave + fr;
        const float* xr = (row < MP) ? p.x_prompt + (size_t)row * D : p.x_sample + (size_t)(row - MP) * D;
        f32x4 acc = {0.f, 0.f, 0.f, 0.f}; float ss = 0.f;
#pragma unroll 1
        for (int s0 = 0; s0 < 64; s0 += 8) {
            f32x4 xa[8], xb[8];
#pragma unroll
            for (int i = 0; i < 8; ++i) { xa[i] = *(const f32x4*)(xr + 32 * (s0 + i) + 8 * fq); xb[i] = *(const f32x4*)(xr + 32 * (s0 + i) + 8 * fq + 4); }
#pragma unroll
            for (int i = 0; i < 8; ++i) { const int s = s0 + i; const f32x4 a = xa[i], b = xb[i];
                ss += (a.x * a.x + a.y * a.y) + (a.z * a.z + a.w * a.w) + (b.x * b.x + b.y * b.y) + (b.z * b.z + b.w * b.w);
                u32x4 o; o.x = pk2(a.x, a.y); o.y = pk2(a.z, a.w); o.z = pk2(b.x, b.y); o.w = pk2(b.z, b.w);
                *(u32x4*)(XB + (size_t)row * D + 32 * s + 8 * fq) = o;
                const bf16x8 af = __builtin_bit_cast(bf16x8, o);
                const bf16x8 bfr = *(const LAS bf16x8*)(WG + (size_t)((4 * s + fq) * 16 + fr) * 16);
                acc = __builtin_amdgcn_mfma_f32_16x16x32_bf16(af, bfr, acc, 0, 0, 0); }
        }
        ss += __shfl_xor(ss, 16); ss += __shfl_xor(ss, 32);
        const float rstd = 1.0f / sqrtf(ss * (1.0f / D) + EPS);
        if (fq == 0) { RS[16 * wave + fr] = rstd; RSTD1[row] = rstd; }
        LDS_WAIT(); asm volatile("" ::: "memory");
#pragma unroll
        for (int j = 0; j < 4; ++j) { const int tl = 16 * wave + 4 * fq + j; GL[tl * 16 + fr] = acc[j] * RS[tl]; }
    }
    __syncthreads();
    const bool sample = (u >= MP / 64);
#pragma unroll 1
    for (int cc = 0; cc < 2; ++cc) {
        const int c = tid + 512 * cc; float wg[16];
#pragma unroll
        for (int j = 0; j < 16; ++j) wg[j] = p.w_gate_up[j * KW + c];
        const float bg = p.b_gate[c]; float cum = 0.f;
#pragma unroll 2
        for (int t = 0; t < 64; ++t) {
            const f32x4 g0 = *(const LAS f32x4*)(GL + t * 16), g1 = *(const LAS f32x4*)(GL + t * 16 + 4), g2 = *(const LAS f32x4*)(GL + t * 16 + 8), g3 = *(const LAS f32x4*)(GL + t * 16 + 12);
            float z = bg;
            z += g0.x * wg[0] + g0.y * wg[1] + g0.z * wg[2] + g0.w * wg[3];
            z += g1.x * wg[4] + g1.y * wg[5] + g1.z * wg[6] + g1.w * wg[7];
            z += g2.x * wg[8] + g2.y * wg[9] + g2.z * wg[10] + g2.w * wg[11];
            z += g3.x * wg[12] + g3.y * wg[13] + g3.z * wg[14] + g3.w * wg[15];
            const float gl = logsigmoidf_(z) * (1.0f / 16.0f);
            const int row = 64 * u + t;
            if (sample) { BCUM[(size_t)row * KW + c] = 0.f; LAM[(size_t)(NCHK + row - MP) * KW + c] = __expf(gl); }
            else { cum = ((t & (CH - 1)) == 0) ? gl : cum + gl; BCUM[(size_t)row * KW + c] = cum; if ((t & (CH - 1)) == CH - 1) LAM[(size_t)(row / CH) * KW + c] = __expf(cum); }
        }
    }
    __syncthreads();
}

constexpr int NXPREP = M / 64;
DI void phase_p0(const Params& p, LAS unsigned char* lds, int wave) {
    const int lane = lane_id();
    unsigned char* ws = p.ws;
#ifndef P0_REP
#define P0_REP 0
#endif
    if ((int)blockIdx.x < NXPREP) { p0_xprep_unit(p, lds, blockIdx.x, wave); if (P0_REP & 1) p0_xprep_unit(p, lds, blockIdx.x, wave); return; }
    TJob J[8];
    J[0] = TJob{p.w_in, (bf16_t*)(ws + WS_WIN), p.norm_mix, D, INW, NIN, 1, (D / 64) * (NIN / 64)};
    J[1] = TJob{p.w_up, (bf16_t*)(ws + WS_WUP), p.norm_ffn, D, NUP, NUP, 2, (D / 64) * (NUP / 64)};
    J[2] = TJob{p.w_down, (bf16_t*)(ws + WS_WD), nullptr, DFF, D, D, 0, (DFF / 64) * (D / 64)};
    J[3] = TJob{p.w_branch_a, (bf16_t*)(ws + WS_WA), p.gla_norm, D, D, D, 0, (D / 64) * (D / 64)};
    J[4] = TJob{p.w_out, (bf16_t*)(ws + WS_WO), nullptr, D, D, D, 0, (D / 64) * (D / 64)};
    J[5] = TJob{p.w_ple_gate, (bf16_t*)(ws + WS_WPG), p.norm_ple, D, D, D, 0, (D / 64) * (D / 64)};
    J[6] = TJob{p.w_ple, (bf16_t*)(ws + WS_WPLE), nullptr, PLE, D, D, 0, (PLE / 64) * (D / 64)};
    J[7] = TJob{p.w_branch_b, (bf16_t*)(ws + WS_WBT), p.pool_scale, POOLW, D, D, 0, (POOLW / 64) * (D / 64)};
    LAS float* scr = (LAS float*)(lds + wave * TR_SCR);
    const int gw = ((int)blockIdx.x - NXPREP) * NWAVES + wave, NGW = ((int)gridDim.x - NXPREP) * NWAVES;
    for (int rep = 0; rep < ((P0_REP & 2) ? 2 : 1); ++rep) {
    int base = 0;
#pragma unroll
    for (int j = 0; j < 8; ++j) {
        const int n = J[j].nitems;
        int it = gw - (base % NGW); if (it < 0) it += NGW;
        for (; it < n; it += NGW) p0_transpose_item(J[j], scr, it, lane);
        base += n;
    }
    }
    for (int it = gw; it < (POOLW * 256) / 512; it += NGW) p0_wps_item(p, (bf16_t*)(ws + WS_WPS), it, lane);
    for (int it = gw; it < (M * PLE) / 512; it += NGW) p0_plb_item(p, (bf16_t*)(ws + WS_PLB), it, lane);
}

#define MFMA32(a, b, c) __builtin_amdgcn_mfma_f32_32x32x16_bf16((a), (b), (c), 0, 0, 0)
typedef LAS s16x4* lds_s16x4_p;
DI s16x4 tr_read(LAS unsigned char* a) { return __builtin_amdgcn_ds_read_tr16_b64_v4i16((lds_s16x4_p)a); }
DI bf16x8 cat8(s16x4 lo, s16x4 hi) { return __builtin_shufflevector(lo, hi, 0, 1, 2, 3, 4, 5, 6, 7); }
DI bf16x8 ld_perm(const bf16_t* p) {
    const u32x2 a = *(const u32x2*)p, b = *(const u32x2*)(p + 8);
    u32x4 r; r.x = a.x; r.y = a.y; r.z = b.x; r.w = b.y; return __builtin_bit_cast(bf16x8, r);
}
template <int S> DI bf16x8 pack_step(const f32x16& x) {
    u32x4 r; r.x = pk2(x[8 * S + 0], x[8 * S + 1]); r.y = pk2(x[8 * S + 2], x[8 * S + 3]); r.z = pk2(x[8 * S + 4], x[8 * S + 5]); r.w = pk2(x[8 * S + 6], x[8 * S + 7]);
    return __builtin_bit_cast(bf16x8, r);
}
DI f32x16 zero16() { f32x16 z;
#pragma unroll
    for (int i = 0; i < 16; ++i) z[i] = 0.f; return z; }

constexpr int SC_BUF = 50176, SC_QI = 0, SC_KI = 16384, SC_VI = 32768, SC_LMI = 49152, SC_ATT = 3 * SC_BUF, SC_BYTES = SC_ATT + 2048;
static_assert(SC_BYTES <= LDS_MISC, "scan LDS map");
DI void dma16(const void* g, LAS unsigned char* l) { __builtin_amdgcn_global_load_lds((const unsigned*)g, (LAS unsigned*)l, 16, 0, 0); }
DI bf16x8 lds_perm(LAS unsigned char* a) {
    const u32x2 x = *(const LAS u32x2*)a, y = *(const LAS u32x2*)(a + 512);
    u32x4 r; r.x = x.x; r.y = x.y; r.z = y.x; r.w = y.y; return __builtin_bit_cast(bf16x8, r);
}
#define SC_BAR() do { asm volatile("s_waitcnt lgkmcnt(0)" ::: "memory"); __builtin_amdgcn_s_barrier(); asm volatile("" ::: "memory"); } while (0)
DI void scan_block(const Params& p, LAS unsigned char* lds, int task, int wave) {
    unsigned char* ws = p.ws;
    const bf16_t* QB = (const bf16_t*)(ws + WS_QB); const bf16_t* KB = (const bf16_t*)(ws + WS_KB);
    const bf16_t* V = (const bf16_t*)(ws + WS_V); bf16_t* OG = (bf16_t*)(ws + WS_OG);
    const float* LAM = (const float*)(ws + WS_LAM); float* OSS = (float*)(ws + WS_OSS);
    const int half = task & 1, hd = (task >> 1) & 3, b = task >> 3, sl = 8 * half + wave;
    f32x16 S[8];
#pragma unroll
    for (int db = 0; db < 8; ++db) S[db] = zero16();

#define SC_ISSUE(ch_, slot_) do { const int _l = lane_id(); const size_t _r0 = (size_t)(b * SEQ + CH * (ch_)); LAS unsigned char* _lb = lds + (slot_) * SC_BUF; asm volatile("" : "+s"(_lb)); \
        _Pragma("unroll") for (int _k = 0; _k < 2; ++_k) { const int _i = 2 * wave + _k; \
            const int _row = _l & 31, _cc = 2 * _i + (_l >> 5); \
            dma16(QB + (_r0 + _row) * KW + hd * 256 + 8 * _cc, _lb + SC_QI + _i * 1024); \
            const int _s = 2 * _i + (_l >> 5), _c2 = (_l & 31) ^ (4 * (_s & 3)); \
            dma16(KB + (_r0 + _s) * KW + hd * 256 + 8 * _c2, _lb + SC_KI + _i * 1024); dma16(V + (_r0 + _s) * VW + hd * 512 + 256 * half + 8 * _c2, _lb + SC_VI + _i * 1024); } \
        if (wave == 0) dma16(LAM + (size_t)(b * (SEQ / CH) + (ch_)) * KW + hd * 256 + 4 * _l, _lb + SC_LMI); } while (0)
    constexpr int NCH = SEQ / CH;
    SC_ISSUE(0, 0); SC_ISSUE(1, 1);
    int slot = 0;
#pragma unroll 1
    for (int ch = 0; ch < NCH; ++ch) {
        const int row0 = b * SEQ + CH * ch;
        if (ch == 0) { if (wave == 0) asm volatile("s_waitcnt vmcnt(7)" ::: "memory"); else asm volatile("s_waitcnt vmcnt(6)" ::: "memory"); }
        else if (ch == 1) { if (wave == 0) asm volatile("s_waitcnt vmcnt(11)" ::: "memory"); else asm volatile("s_waitcnt vmcnt(10)" ::: "memory"); }
        else if (ch + 1 < NCH) { if (wave == 0) asm volatile("s_waitcnt vmcnt(15)" ::: "memory"); else asm volatile("s_waitcnt vmcnt(14)" ::: "memory"); }
        else VM_WAIT();
        SC_BAR();
        { const int s2 = (slot == 0) ? 2 : slot - 1; if (ch + 2 < NCH) SC_ISSUE(ch + 2, s2); }
        const int lane = lane_id();
        const int c = lane & 31, h = lane >> 5;
        const int i16 = lane & 15, q = i16 >> 2, pp = i16 & 3, jb = (lane >> 4) & 1;
        LAS unsigned char* buf = lds + slot * SC_BUF;
        LAS unsigned char* ATT = lds + SC_ATT;

        if (wave < 4) {
            const int si = wave >> 1, ti = wave & 1, fr = lane & 15, fq = lane >> 4;
            f32x4 a = {0.f, 0.f, 0.f, 0.f};
            LAS unsigned char* kp = buf + SC_KI + (16 * si + fr) * 512; LAS unsigned char* qp = buf + SC_QI + fq * 512 + (16 * ti + fr) * 16;
            const int kx = 4 * (fr & 3);
#pragma unroll
            for (int ks = 0; ks < 8; ++ks) a = __builtin_amdgcn_mfma_f32_16x16x32_bf16(*(const LAS bf16x8*)(kp + (((4 * ks + fq) ^ kx) * 16)), *(const LAS bf16x8*)(qp + 2048 * ks), a, 0, 0, 0);
            const int s0 = 16 * si + 4 * fq, t = 16 * ti + fr;
            u32x2 w; w.x = pk2(s0 + 0 <= t ? a[0] : 0.f, s0 + 1 <= t ? a[1] : 0.f); w.y = pk2(s0 + 2 <= t ? a[2] : 0.f, s0 + 3 <= t ? a[3] : 0.f);
            *(LAS u32x2*)(ATT + t * 64 + s0 * 2) = w;
        }
        SC_BAR();

        f32x16 o = zero16();
        LAS unsigned char* vb = buf + SC_VI + (8 * h + q) * 512 + (4 * (wave ^ q) + 2 * jb + (pp >> 1)) * 16 + (pp & 1) * 8;
        const bf16x8 vf0 = cat8(tr_read(vb), tr_read(vb + 4 * 512)), vf1 = cat8(tr_read(vb + 16 * 512), tr_read(vb + 20 * 512));
        {
            LAS unsigned char* ab = ATT + c * 64 + 16 * h;
            o = MFMA32(vf0, *(const LAS bf16x8*)ab, o);
            o = MFMA32(vf1, *(const LAS bf16x8*)(ab + 32), o);
            LAS unsigned char* qa = buf + SC_QI + c * 16 + 8 * h;
#pragma unroll
            for (int db = 0; db < 8; ++db) {
                { const bf16x8 qf = lds_perm(qa + 2048 * db); o = MFMA32(pack_step<0>(S[db]), qf, o); }
                { const bf16x8 qf = lds_perm(qa + 2048 * db + 1024); o = MFMA32(pack_step<1>(S[db]), qf, o); }
                if ((db & 3) == 3) __builtin_amdgcn_sched_barrier(0);
            }
            const int t = row0 + c;
            float ss = 0.f;
#pragma unroll
            for (int r = 0; r < 16; ++r) ss += o[r] * o[r];
            { const auto sw = __builtin_amdgcn_permlane32_swap(__float_as_uint(ss), __float_as_uint(ss), false, false); ss = __uint_as_float(sw[0]) + __uint_as_float(sw[1]); }
            if (h == 0) OSS[(size_t)t * 64 + hd * 16 + sl] = ss;
            bf16_t* og = OG + (size_t)row0 * VW + hd * 512 + 32 * sl + c * VW + 4 * h;
#pragma unroll
            for (int g = 0; g < 4; ++g) { u32x2 w; w.x = pk2(o[4 * g + 0], o[4 * g + 1]); w.y = pk2(o[4 * g + 2], o[4 * g + 3]); *(u32x2*)(og + 8 * g) = w; }
        }
        __builtin_amdgcn_sched_barrier(0);

        {
            LAS unsigned char* kbase = buf + SC_KI + (8 * h + q) * 512 + (2 * jb + (pp >> 1)) * 16 + (pp & 1) * 8;
            LAS unsigned char* lm = buf + SC_LMI + 16 * h;
#pragma unroll
            for (int db = 0; db < 8; ++db) {
                LAS unsigned char* kb = kbase + (((db & 3) ^ q) * 4) * 16 + (db >> 2) * 256;
                S[db] = MFMA32(cat8(tr_read(kb), tr_read(kb + 4 * 512)), vf0, S[db]);
                S[db] = MFMA32(cat8(tr_read(kb + 16 * 512), tr_read(kb + 20 * 512)), vf1, S[db]);
#pragma unroll
                for (int g = 0; g < 4; ++g) { const f32x4 l4 = *(const LAS f32x4*)(lm + (32 * db + 8 * g) * 4);
                    S[db][4 * g + 0] *= l4.x; S[db][4 * g + 1] *= l4.y; S[db][4 * g + 2] *= l4.z; S[db][4 * g + 3] *= l4.w; }
                if (db & 1) __builtin_amdgcn_sched_barrier(0);
            }
        }
        asm volatile("" ::: "memory");
        slot = (slot == 2) ? 0 : slot + 1;
    }
#undef SC_ISSUE
    {   const int lane = lane_id();
        const unsigned voff = (unsigned)(((lane >> 5) * 4 * DV + (lane & 31)) * 4);
        const char* gbase = (const char*)(p.out + O_GLAP + ((size_t)(b * NH + hd) * DK) * DV + 32 * sl);
#pragma unroll
        for (int db = 0; db < 8; ++db) {
#pragma unroll
            for (int r = 0; r < 16; ++r) { const int dl = 32 * db + (r & 3) + 8 * (r >> 2); *(float*)(const_cast<char*>(gbase) + (size_t)dl * DV * 4 + voff) = S[db][r]; }
        }
    }
    __syncthreads();
}

DI void sgla_task(const Params& p, int task, int lane) {
    unsigned char* ws = p.ws;
    const bf16_t* QB = (const bf16_t*)(ws + WS_QB); const bf16_t* KB = (const bf16_t*)(ws + WS_KB); const bf16_t* V = (const bf16_t*)(ws + WS_V);
    const float* LAM = (const float*)(ws + WS_LAM); float* OSP = (float*)(ws + WS_OSP);
    const int dblk = task & 7, hd = (task >> 3) & 3, b = task >> 5; const int row = MP + b;
    const size_t sbase = ((size_t)(b * NH + hd) * DK + 32 * dblk) * DV;
    const float* S0 = p.state_gla + sbase; float* So = p.out + O_GLAS + sbase;
    const int dl = lane & 31;
    const float lam_l = LAM[(size_t)(NCHK + b) * KW + hd * 256 + 32 * dblk + dl];
    const float k_l = bf1(KB[(size_t)row * KW + hd * 256 + 32 * dblk + dl]);
    const float q_l = bf1(QB[(size_t)row * KW + hd * 256 + 32 * dblk + dl]);
    f32x4 va, vb;
    { const u32x2 w = *(const u32x2*)(V + (size_t)row * VW + hd * 512 + 4 * lane); va = (f32x4){bflo(w.x), bfhi(w.x), bflo(w.y), bfhi(w.y)}; }
    { const u32x2 w = *(const u32x2*)(V + (size_t)row * VW + hd * 512 + 256 + 4 * lane); vb = (f32x4){bflo(w.x), bfhi(w.x), bflo(w.y), bfhi(w.y)}; }
    f32x4 oa = {0.f, 0.f, 0.f, 0.f}, ob = {0.f, 0.f, 0.f, 0.f};
#pragma unroll 1
    for (int d0 = 0; d0 < 32; d0 += 16) {
        f32x4 ra[16], rb[16];
#pragma unroll
        for (int i = 0; i < 16; ++i) { ra[i] = __builtin_nontemporal_load((const f32x4*)(S0 + (size_t)(d0 + i) * DV + 4 * lane)); rb[i] = __builtin_nontemporal_load((const f32x4*)(S0 + (size_t)(d0 + i) * DV + 256 + 4 * lane)); }
#pragma unroll
        for (int i = 0; i < 16; ++i) { const int d = d0 + i;
            const float lam = __uint_as_float(__builtin_amdgcn_readlane(__float_as_uint(lam_l), d)), kk = __uint_as_float(__builtin_amdgcn_readlane(__float_as_uint(k_l), d)), qq = __uint_as_float(__builtin_amdgcn_readlane(__float_as_uint(q_l), d));
            const f32x4 sa = ra[i] * lam + va * kk, sb = rb[i] * lam + vb * kk;
            __builtin_nontemporal_store(sa, (f32x4*)(So + (size_t)d * DV + 4 * lane)); __builtin_nontemporal_store(sb, (f32x4*)(So + (size_t)d * DV + 256 + 4 * lane));
            oa += sa * qq; ob += sb * qq; }
    }
    float* op = OSP + ((size_t)(b * NH + hd) * 8 + dblk) * DV;
    *(f32x4*)(op + 4 * lane) = oa; *(f32x4*)(op + 256 + 4 * lane) = ob;
}

DI void pmix_task(const Params& p, int t, int lane) {
    unsigned char* ws = p.ws;
    const float* U = (const float*)(ws + WS_U); bf16_t* PM = (bf16_t*)(ws + WS_PM);
    if (t < MP) {
        const int b = t >> 11, pos = t & 2047;
#pragma unroll
        for (int i = 0; i < 4; ++i) {
            const int w = 2 << i, c = 256 * i + 4 * lane; const int cnt = (pos + 1 < w) ? pos + 1 : w;
            const f32x4 u0 = *(const f32x4*)(U + (size_t)t * POOLW + c); f32x4 s = u0;
#pragma unroll
            for (int j = 1; j < w; ++j) {
                const bool in = j < cnt; const f32x4 v = *(const f32x4*)(U + (size_t)(in ? t - j : t) * POOLW + c); const float m = in ? 1.f : 0.f; s += v * m; }
            const float inv = 1.0f / (float)cnt; const f32x4 mx = s * inv - u0;
            u32x2 o; o.x = pk2(mx.x, mx.y); o.y = pk2(mx.z, mx.w); *(u32x2*)(PM + (size_t)t * POOLW + c) = o;
            if (pos >= SEQ - 15) *(f32x4*)(p.out + O_POOLP + ((size_t)b * 15 + (pos - (SEQ - 15))) * POOLW + c) = u0;
        }
    } else {
        const int b = t - MP; const float* sp = p.state_pool + (size_t)b * 15 * POOLW; float* po = p.out + O_POOLS + (size_t)b * 15 * POOLW;
#pragma unroll
        for (int i = 0; i < 4; ++i) {
            const int w = 2 << i, c = 256 * i + 4 * lane;
            const f32x4 u0 = *(const f32x4*)(U + (size_t)t * POOLW + c); f32x4 s = u0;
#pragma unroll
            for (int j = 1; j < w; ++j) s += *(const f32x4*)(sp + (size_t)(15 - j) * POOLW + c);
            const float inv = 1.0f / (float)w; const f32x4 mx = s * inv - u0;
            u32x2 o; o.x = pk2(mx.x, mx.y); o.y = pk2(mx.z, mx.w); *(u32x2*)(PM + (size_t)t * POOLW + c) = o;
            *(f32x4*)(po + (size_t)14 * POOLW + c) = u0;
        }
    }
}

DI void pool_copy_task(const Params& p, int item, int lane) {
    const int b = item / 14, r = item - 14 * b; const float* src = p.state_pool + ((size_t)b * 15 + r + 1) * POOLW + 4 * lane; float* dst = p.out + O_POOLS + ((size_t)b * 15 + r) * POOLW + 4 * lane;
    const f32x4 v0 = *(const f32x4*)src, v1 = *(const f32x4*)(src + 256), v2 = *(const f32x4*)(src + 512), v3 = *(const f32x4*)(src + 768);
    *(f32x4*)dst = v0; *(f32x4*)(dst + 256) = v1; *(f32x4*)(dst + 512) = v2; *(f32x4*)(dst + 768) = v3;
}
#ifndef P2_REP
#define P2_REP 0
#endif
DI void scan_role(const Params& p, LAS unsigned char* lds, int wave, int idx, int n) {
    for (int rep = 0; rep < ((P2_REP & 1) ? 2 : 1); ++rep) for (int task = (n == 32) ? (idx % 8) * 4 + idx / 8 : idx; task < 2 * NB * NH; task += n) scan_block(p, lds, task, wave);
}
DI void stream_role(const Params& p, int wave, int idx, int n) {
    const int lane = lane_id(); const int gw = idx * NWAVES + wave, NGW = n * NWAVES;
    for (int rep = 0; rep < ((P2_REP & 2) ? 2 : 1); ++rep) {
        for (int it = gw; it < MS * 14; it += NGW) pool_copy_task(p, it, lane);
        for (int task = gw; task < MS * NH * 8; task += NGW) sgla_task(p, task, lane); }
}

DI void ogn_task(const Params& p, int t, int lane) {
    unsigned char* ws = p.ws;
    bf16_t* OG = (bf16_t*)(ws + WS_OG); const float* OSS = (const float*)(ws + WS_OSS); const float* OSP = (const float*)(ws + WS_OSP); const bf16_t* SR = (const bf16_t*)(ws + WS_SR);
    if (t < MP) {
#pragma unroll
        for (int hd = 0; hd < 4; ++hd) {
            const float* sp = OSS + (size_t)t * 64 + hd * 16; const f32x4 a = *(const f32x4*)sp, b = *(const f32x4*)(sp + 4), c = *(const f32x4*)(sp + 8), d = *(const f32x4*)(sp + 12);
            const float ss = ((a.x + a.y) + (a.z + a.w)) + ((b.x + b.y) + (b.z + b.w)) + ((c.x + c.y) + (c.z + c.w)) + ((d.x + d.y) + (d.z + d.w));
            const float rstd = 1.0f / sqrtf(ss * (1.0f / DV) + EPS);
            bf16_t* op = OG + (size_t)t * VW + hd * 512 + 8 * lane; const u32x4 w = *(const u32x4*)op; const u32x4 g = *(const u32x4*)(SR + (size_t)t * VW + hd * 512 + 8 * lane);
            u32x4 o; o.x = pk2(bflo(w.x) * rstd * bflo(g.x), bfhi(w.x) * rstd * bfhi(g.x)); o.y = pk2(bflo(w.y) * rstd * bflo(g.y), bfhi(w.y) * rstd * bfhi(g.y));
            o.z = pk2(bflo(w.z) * rstd * bflo(g.z), bfhi(w.z) * rstd * bfhi(g.z)); o.w = pk2(bflo(w.w) * rstd * bflo(g.w), bfhi(w.w) * rstd * bfhi(g.w));
            *(u32x4*)op = o;
        }
    } else {
        const int b = t - MP;
#pragma unroll
        for (int hd = 0; hd < 4; ++hd) {
            f32x4 oa = {0.f, 0.f, 0.f, 0.f}, ob = {0.f, 0.f, 0.f, 0.f};
#pragma unroll
            for (int k = 0; k < 8; ++k) { const float* op = OSP + ((size_t)(b * NH + hd) * 8 + k) * DV + 8 * lane; oa += *(const f32x4*)op; ob += *(const f32x4*)(op + 4); }
            float ss = (oa.x * oa.x + oa.y * oa.y) + (oa.z * oa.z + oa.w * oa.w) + (ob.x * ob.x + ob.y * ob.y) + (ob.z * ob.z + ob.w * ob.w);
            ss = wave_sum(ss);
            const float rstd = 1.0f / sqrtf(ss * (1.0f / DV) + EPS);
            const u32x4 w = *(const u32x4*)(SR + (size_t)t * VW + hd * 512 + 8 * lane);
            u32x4 o; o.x = pk2(oa.x * rstd * bflo(w.x), oa.y * rstd * bfhi(w.x)); o.y = pk2(oa.z * rstd * bflo(w.y), oa.w * rstd * bfhi(w.y));
            o.z = pk2(ob.x * rstd * bflo(w.z), ob.y * rstd * bfhi(w.z)); o.w = pk2(ob.z * rstd * bflo(w.w), ob.w * rstd * bfhi(w.w));
            *(u32x4*)(OG + (size_t)t * VW + hd * 512 + 8 * lane) = o;
        }
    }
}
DI void phase_p3(const Params& p, int wave) {
    const int lane = lane_id();
    const int gw = (int)blockIdx.x * NWAVES + wave, NGW = gridDim.x * NWAVES;
    for (int t = gw; t < M; t += NGW) pmix_task(p, t, lane);
    for (int t = gw; t < M; t += NGW) ogn_task(p, t, lane);
}

DI float row_rstd(const float* SS, const float* SSs, int row, int lane) {
    float v = (row < MP) ? ((lane < 32) ? SS[(size_t)row * 32 + lane] : 0.f) : (SSs[(size_t)(row - MP) * 128 + lane] + SSs[(size_t)(row - MP) * 128 + 64 + lane]);
    v = wave_sum(v);
    return 1.0f / sqrtf(v * (1.0f / D) + EPS);
}

struct F8 { f32x4 a, b; };
DI F8 unpack8(u32x4 w, float s) { F8 r; r.a = (f32x4){bflo(w.x) * s, bfhi(w.x) * s, bflo(w.y) * s, bfhi(w.y) * s}; r.b = (f32x4){bflo(w.z) * s, bfhi(w.z) * s, bflo(w.w) * s, bfhi(w.w) * s}; return r; }
DI F8 ld8(const float* q) { F8 r; r.a = *(const f32x4*)q; r.b = *(const f32x4*)(q + 4); return r; }
DI void st8(float* q, const F8& v) { *(f32x4*)q = v.a; *(f32x4*)(q + 4) = v.b; }
DI f32x4 silu4(f32x4 x) { return (f32x4){siluf_(x.x), siluf_(x.y), siluf_(x.z), siluf_(x.w)}; }
DI void conv_task(const Params& p, int t, int lane) {
    unsigned char* ws = p.ws;
    const bf16_t* GU = (const bf16_t*)(ws + WS_GU); const float* SS1 = (const float*)(ws + WS_SS1); const float* SS1S = (const float*)(ws + WS_SS1S); bf16_t* ACT = (bf16_t*)(ws + WS_ACT);
    const bool prompt = t < MP; const int b = prompt ? (t >> 11) : (t - MP), pos = prompt ? (t & 2047) : 2;
    const float r0 = row_rstd(SS1, SS1S, t, lane);
    const float r1 = (prompt && pos >= 1) ? row_rstd(SS1, SS1S, t - 1, lane) : 0.f;
    const float r2 = (prompt && pos >= 2) ? row_rstd(SS1, SS1S, t - 2, lane) : 0.f;
    const bf16_t* g0p = GU + (size_t)t * NUP; const bf16_t* g1p = GU + (size_t)((prompt && pos >= 1) ? t - 1 : t) * NUP; const bf16_t* g2p = GU + (size_t)((prompt && pos >= 2) ? t - 2 : t) * NUP;
    const float* sc = p.state_conv + (size_t)b * 2 * DFF;
    for (int v = lane; v < DFF / 8; v += 64) {
        const int ch0 = 8 * v, pn = ch0 >> 7, r = ch0 & 127, gcol = 256 * pn + r, ucol = gcol + 128;
        const F8 g0 = unpack8(*(const u32x4*)(g0p + gcol), r0), up = unpack8(*(const u32x4*)(g0p + ucol), r0);
        F8 g1, g2;
        if (prompt) { g1 = unpack8(*(const u32x4*)(g1p + gcol), r1); g2 = unpack8(*(const u32x4*)(g2p + gcol), r2); }
        else { g1 = ld8(sc + DFF + ch0); g2 = ld8(sc + ch0); }
        const F8 w0 = ld8(p.conv_w + ch0), w1 = ld8(p.conv_w + DFF + ch0), w2 = ld8(p.conv_w + 2 * DFF + ch0), cb = ld8(p.conv_b + ch0);
        const f32x4 ga = cb.a + w0.a * g2.a + w1.a * g1.a + w2.a * g0.a, gb = cb.b + w0.b * g2.b + w1.b * g1.b + w2.b * g0.b;
        const f32x4 aa = silu4(ga) * up.a, ab = silu4(gb) * up.b;
        u32x4 o; o.x = pk2(aa.x, aa.y); o.y = pk2(aa.z, aa.w); o.z = pk2(ab.x, ab.y); o.w = pk2(ab.z, ab.w);
        *(u32x4*)(ACT + (size_t)t * DFF + ch0) = o;
        if (prompt) { if (pos >= SEQ - 2) st8(p.out + O_CONVP + ((size_t)b * 2 + (pos - (SEQ - 2))) * DFF + ch0, g0); }
        else { float* co = p.out + O_CONVS + (size_t)b * 2 * DFF + ch0; st8(co, g1); st8(co + DFF, g0); }
    }
}
DI void conv_block_task(const Params& p, int rb, int vg, int lane) {
    unsigned char* ws = p.ws;
    const bf16_t* GU = (const bf16_t*)(ws + WS_GU); const float* SS1 = (const float*)(ws + WS_SS1); bf16_t* ACT = (bf16_t*)(ws + WS_ACT);
    const int t0 = 16 * rb, b = t0 >> 11, pos0 = t0 & 2047;
    float rr[18];
#pragma unroll
    for (int i = 0; i < 18; ++i) { const int t = t0 - 2 + i; float v = (lane < 32 && (i >= 2 || pos0 > 0)) ? SS1[(size_t)t * 32 + lane] : 0.f; v = wave_sum(v); rr[i] = (i >= 2 || pos0 > 0) ? 1.0f / sqrtf(v * (1.0f / D) + EPS) : 0.f; }
    const int v = vg * 64 + lane; if (v >= DFF / 8) return;
    const int ch0 = 8 * v, pn = ch0 >> 7, r = ch0 & 127, gcol = 256 * pn + r, ucol = gcol + 128;
    const F8 w0 = ld8(p.conv_w + ch0), w1 = ld8(p.conv_w + DFF + ch0), w2 = ld8(p.conv_w + 2 * DFF + ch0), cb = ld8(p.conv_b + ch0);
    const bf16_t* gp = GU + (size_t)t0 * NUP + gcol; const bf16_t* up_ = GU + (size_t)t0 * NUP + ucol;
    F8 g2 = unpack8(*(const u32x4*)(gp - (pos0 > 0 ? 2 : 0) * (size_t)NUP), rr[0]), g1 = unpack8(*(const u32x4*)(gp - (pos0 > 0 ? 1 : 0) * (size_t)NUP), rr[1]);
#pragma unroll 1
    for (int h = 0; h < 2; ++h) {
        u32x4 gw[8], uw[8];
#pragma unroll
        for (int i = 0; i < 8; ++i) { gw[i] = *(const u32x4*)(gp + (size_t)(8 * h + i) * NUP); uw[i] = *(const u32x4*)(up_ + (size_t)(8 * h + i) * NUP); }
#pragma unroll
        for (int i = 0; i < 8; ++i) { const int ii = 8 * h + i; const float r0 = (h == 0) ? rr[2 + i] : rr[10 + i];
            const F8 g0 = unpack8(gw[i], r0), up = unpack8(uw[i], r0);
            const f32x4 ga = cb.a + w0.a * g2.a + w1.a * g1.a + w2.a * g0.a, gb = cb.b + w0.b * g2.b + w1.b * g1.b + w2.b * g0.b;
            const f32x4 aa = silu4(ga) * up.a, ab = silu4(gb) * up.b;
            u32x4 o; o.x = pk2(aa.x, aa.y); o.y = pk2(aa.z, aa.w); o.z = pk2(ab.x, ab.y); o.w = pk2(ab.z, ab.w);
            *(u32x4*)(ACT + (size_t)(t0 + ii) * DFF + ch0) = o;
            if (pos0 + ii >= SEQ - 2) st8(p.out + O_CONVP + ((size_t)b * 2 + (pos0 + ii - (SEQ - 2))) * DFF + ch0, g0);
            g2 = g1; g1 = g0; }
    }
}
DI void phase_conv(const Params& p, int wave) {
    const int lane = lane_id();
    const int gw = (int)blockIdx.x * NWAVES + wave, NGW = gridDim.x * NWAVES;
    constexpr int NVG = (DFF / 8 + 63) / 64;
    for (int t = MP + gw; t < M; t += NGW) conv_task(p, t, lane);
    for (int it = gw; it < (MP / 16) * NVG; it += NGW) conv_block_task(p, it / NVG, it % NVG, lane);
}

DI void phase_final(const Params& p, int wave) {
    const int lane = lane_id();
    const int gw = (int)blockIdx.x * NWAVES + wave, NGW = gridDim.x * NWAVES;
    const float* H3 = (const float*)(p.ws + WS_H3); const float* SS3 = (const float*)(p.ws + WS_SS3); const float* SS3S = (const float*)(p.ws + WS_SS3S);
    for (int t = gw; t < M; t += NGW) {
        const float rs = row_rstd(SS3, SS3S, t, lane);
        float* yo = (t < MP) ? p.out + O_YP + (size_t)t * D : p.out + O_YS + (size_t)(t - MP) * D;
#pragma unroll
        for (int i = 0; i < 8; ++i) { const int c = 256 * i + 4 * lane; const f32x4 hv = *(const f32x4*)(H3 + (size_t)t * D + c), g = *(const f32x4*)(p.norm_final + c);
            *(f32x4*)(yo + c) = hv * rs * g; }
    }
}

#define EPI_ARGS const f32x4 (&acc)[2][2][4][2], const g8::Unit& u, int wr, int wc, int fr, int fq
#define EPI_ROWS(ROWVAR) _Pragma("unroll") for (int ai = 0; ai < 2; ++ai) _Pragma("unroll") for (int m = 0; m < 4; ++m) { const int ROWVAR = u.pm * 256 + ai * 128 + wr * 64 + m * 16 + fr; if (ROWVAR < M) {
#define EPI_COLS(COLVAR) _Pragma("unroll") for (int bj = 0; bj < 2; ++bj) { const int COLVAR = bj * 128 + wc * 32 + 8 * fq; const f32x4 v0 = acc[ai][bj][m][0], v1 = acc[ai][bj][m][1];
#define EPI_END } } }
DI u32x4 pk8(f32x4 a, f32x4 b) { u32x4 o; o.x = pk2(a.x, a.y); o.y = pk2(a.z, a.w); o.z = pk2(b.x, b.y); o.w = pk2(b.z, b.w); return o; }
DI f32x4 exp4(f32x4 x) { return (f32x4){__expf(x.x), __expf(x.y), __expf(x.z), __expf(x.w)}; }
DI f32x4 sig4(f32x4 x) { return (f32x4){sigmoidf_(x.x), sigmoidf_(x.y), sigmoidf_(x.z), sigmoidf_(x.w)}; }
DI f32x4 bf4lo(u32x4 w) { return (f32x4){bflo(w.x), bfhi(w.x), bflo(w.y), bfhi(w.y)}; }
DI f32x4 bf4hi(u32x4 w) { return (f32x4){bflo(w.z), bfhi(w.z), bflo(w.w), bfhi(w.w)}; }
DI float sum4(f32x4 a) { return (a.x + a.y) + (a.z + a.w); }

struct PhaseIn {
    static constexpr int LDA = D, LDB = D, KT = D / 64;
    const Params& p; int G, c, part;
    int c0;
    DI bool next(int i, g8::Unit& u) const { int pm, pn;
        if (part == 0) { if (!g8::grid_order(NTM - 1, 16, G, c, i, pm, pn)) return false; }
        else { if (c < c0 || !g8::grid_order(NTM, 28, G - c0, c - c0, i, pm, pn)) return false; pn += 16; }
        u.pm = pm; u.pn = pn; u.A = (const char*)(p.ws + WS_XB) + (size_t)pm * 256 * D * 2; u.B = (const char*)(p.ws + WS_WIN) + (size_t)pn * 256 * D * 2; return true; }
    DI void epi(EPI_ARGS) const {
        unsigned char* ws = p.ws; const float* RSTD1 = (const float*)(ws + WS_RSTD1); const float* BCUM = (const float*)(ws + WS_BCUM);
        const int pn = u.pn;
        if (pn < 4) {
            bf16_t* QB = (bf16_t*)(ws + WS_QB);
            EPI_ROWS(row) const float rs = RSTD1[row] * 0.0625f; EPI_COLS(col) const size_t o = (size_t)row * KW + pn * 256 + col;
                const f32x4 e0 = exp4(*(const f32x4*)(BCUM + o)), e1 = exp4(*(const f32x4*)(BCUM + o + 4));
                *(u32x4*)(QB + o) = pk8(v0 * rs * e0, v1 * rs * e1); EPI_END
        } else if (pn < 8) {
            bf16_t* KB = (bf16_t*)(ws + WS_KB);
            EPI_ROWS(row) const float rs = RSTD1[row]; EPI_COLS(col) const size_t o = (size_t)row * KW + (pn - 4) * 256 + col;
                const f32x4 b0 = *(const f32x4*)(BCUM + o), b1 = *(const f32x4*)(BCUM + o + 4);
                *(u32x4*)(KB + o) = pk8(v0 * rs * exp4(-b0), v1 * rs * exp4(-b1)); EPI_END
        } else if (pn < 16) {
            bf16_t* V = (bf16_t*)(ws + WS_V);
            EPI_ROWS(row) const float rs = RSTD1[row]; EPI_COLS(col) *(u32x4*)(V + (size_t)row * VW + (pn - 8) * 256 + col) = pk8(v0 * rs, v1 * rs); EPI_END
        } else if (pn < 24) {
            bf16_t* SR = (bf16_t*)(ws + WS_SR);
            EPI_ROWS(row) const float rs = RSTD1[row]; EPI_COLS(col) const f32x4 a = v0 * rs, b = v1 * rs; *(u32x4*)(SR + (size_t)row * VW + (pn - 16) * 256 + col) = pk8(a * sig4(a), b * sig4(b)); EPI_END
        } else if (pn < 28) {
            float* U = (float*)(ws + WS_U);
            EPI_ROWS(row) const float rs = RSTD1[row]; EPI_COLS(col) float* o = U + (size_t)row * POOLW + (pn - 24) * 256 + col; *(f32x4*)o = v0 * rs; *(f32x4*)(o + 4) = v1 * rs; EPI_END
        } else {
            bf16_t* Gt = (bf16_t*)(ws + (pn < 36 ? WS_GA : WS_GB)); const int c0 = (pn < 36 ? pn - 28 : pn - 36) * 256;
            EPI_ROWS(row) const float rs = RSTD1[row]; EPI_COLS(col) *(u32x4*)(Gt + (size_t)row * D + c0 + col) = pk8(sig4(v0 * rs), sig4(v1 * rs)); EPI_END
        }
    }
};

template <int LDA_, int LDB_, int K_> struct PhaseN2048 {
    static constexpr int LDA = LDA_, LDB = LDB_, KT = K_ / 64;
    const Params& p; int G, c; size_t a_off, b_off;
    DI bool next_(int i, g8::Unit& u) const { int pm, pn; if (!g8::grid_order(NTM - 1, 8, G, c, i, pm, pn)) return false;
        u.pm = pm; u.pn = pn; u.A = (const char*)(p.ws + a_off) + (size_t)pm * 256 * LDA * 2; u.B = (const char*)(p.ws + b_off) + (size_t)pn * 256 * LDB * 2; return true; }
};
struct PhaseYb : PhaseN2048<POOLW, POOLW, POOLW> {
    DI bool next(int i, g8::Unit& u) const { return next_(i, u); }
    DI void epi(EPI_ARGS) const { const bf16_t* GB = (const bf16_t*)(p.ws + WS_GB); float* Y = (float*)(p.ws + WS_YBG);
#pragma unroll
        for (int ai = 0; ai < 2; ++ai) { u32x4 g[4][2];
#pragma unroll
            for (int m = 0; m < 4; ++m)
#pragma unroll
                for (int bj = 0; bj < 2; ++bj) g[m][bj] = *(const u32x4*)(GB + (size_t)(u.pm * 256 + ai * 128 + wr * 64 + m * 16 + fr) * D + u.pn * 256 + bj * 128 + wc * 32 + 8 * fq);
#pragma unroll
            for (int m = 0; m < 4; ++m)
#pragma unroll
                for (int bj = 0; bj < 2; ++bj) { const size_t o = (size_t)(u.pm * 256 + ai * 128 + wr * 64 + m * 16 + fr) * D + u.pn * 256 + bj * 128 + wc * 32 + 8 * fq;
                    *(f32x4*)(Y + o) = acc[ai][bj][m][0] * bf4lo(g[m][bj]); *(f32x4*)(Y + o + 4) = acc[ai][bj][m][1] * bf4hi(g[m][bj]); } } }
};
struct PhaseYa : PhaseN2048<VW, VW, VW> {
    DI bool next(int i, g8::Unit& u) const { return next_(i, u); }
    DI void epi(EPI_ARGS) const { const bf16_t* GA = (const bf16_t*)(p.ws + WS_GA); const float* Y = (const float*)(p.ws + WS_YBG); bf16_t* MB = (bf16_t*)(p.ws + WS_MB);
#pragma unroll
        for (int ai = 0; ai < 2; ++ai)
#pragma unroll
            for (int mh = 0; mh < 2; ++mh) { u32x4 g[2][2]; f32x4 y0[2][2], y1[2][2];
#pragma unroll
                for (int mm = 0; mm < 2; ++mm)
#pragma unroll
                    for (int bj = 0; bj < 2; ++bj) { const size_t o = (size_t)(u.pm * 256 + ai * 128 + wr * 64 + (2 * mh + mm) * 16 + fr) * D + u.pn * 256 + bj * 128 + wc * 32 + 8 * fq;
                        g[mm][bj] = *(const u32x4*)(GA + o); y0[mm][bj] = *(const f32x4*)(Y + o); y1[mm][bj] = *(const f32x4*)(Y + o + 4); }
#pragma unroll
                for (int mm = 0; mm < 2; ++mm)
#pragma unroll
                    for (int bj = 0; bj < 2; ++bj) { const int m = 2 * mh + mm; const size_t o = (size_t)(u.pm * 256 + ai * 128 + wr * 64 + m * 16 + fr) * D + u.pn * 256 + bj * 128 + wc * 32 + 8 * fq;
                        *(u32x4*)(MB + o) = pk8(acc[ai][bj][m][0] * bf4lo(g[mm][bj]) + y0[mm][bj], acc[ai][bj][m][1] * bf4hi(g[mm][bj]) + y1[mm][bj]); } } }
};
DI void epi_residual(EPI_ARGS, const float* base_p, float* H, bf16_t* HB, float* SS) {
#pragma unroll
    for (int ai = 0; ai < 2; ++ai)
#pragma unroll
        for (int mh = 0; mh < 2; ++mh) {
            f32x4 b0[2][2], b1[2][2];
#pragma unroll
            for (int mm = 0; mm < 2; ++mm) { const int row = u.pm * 256 + ai * 128 + wr * 64 + (2 * mh + mm) * 16 + fr;
#pragma unroll
                for (int bj = 0; bj < 2; ++bj) { const size_t o = (size_t)row * D + u.pn * 256 + bj * 128 + wc * 32 + 8 * fq; b0[mm][bj] = *(const f32x4*)(base_p + o); b1[mm][bj] = *(const f32x4*)(base_p + o + 4); } }
#pragma unroll
            for (int mm = 0; mm < 2; ++mm) { const int m = 2 * mh + mm; const int row = u.pm * 256 + ai * 128 + wr * 64 + m * 16 + fr; float ss = 0.f;
#pragma unroll
                for (int bj = 0; bj < 2; ++bj) { const size_t o = (size_t)row * D + u.pn * 256 + bj * 128 + wc * 32 + 8 * fq;
                    const f32x4 h0 = acc[ai][bj][m][0] + b0[mm][bj], h1 = acc[ai][bj][m][1] + b1[mm][bj];
                    *(f32x4*)(H + o) = h0; *(f32x4*)(H + o + 4) = h1; *(u32x4*)(HB + o) = pk8(h0, h1);
                    ss += sum4(h0 * h0) + sum4(h1 * h1); }
                ss += __shfl_xor(ss, 16); ss += __shfl_xor(ss, 32);
                if (fq == 0) SS[(size_t)row * 32 + u.pn * 4 + wc] = ss; }
        }
}
struct PhaseOut : PhaseN2048<D, D, D> {
    DI bool next(int i, g8::Unit& u) const { return next_(i, u); }
    DI void epi(EPI_ARGS) const { epi_residual(acc, u, wr, wc, fr, fq, p.x_prompt, (float*)(p.ws + WS_H1), (bf16_t*)(p.ws + WS_H1B), (float*)(p.ws + WS_SS1)); }
};
struct PhaseDown : PhaseN2048<DFF, DFF, DFF> {
    DI bool next(int i, g8::Unit& u) const { return next_(i, u); }
    DI void epi(EPI_ARGS) const { epi_residual(acc, u, wr, wc, fr, fq, (const float*)(p.ws + WS_H1), (float*)(p.ws + WS_H2), (bf16_t*)(p.ws + WS_H2B), (float*)(p.ws + WS_SS2)); }
};
struct PhasePe : PhaseN2048<PLE, PLE, PLE> {
    DI bool next(int i, g8::Unit& u) const { const int first = (NTM * 43) % G, nfree = G - first; if (nfree <= 0 || c < first) return false;
        const long L = (long)i * nfree + (c - first); if (L >= 256) return false; const int pm = (int)L >> 3, pn = (int)L & 7;
        u.pm = pm; u.pn = pn; u.A = (const char*)(p.ws + a_off) + (size_t)pm * 256 * LDA * 2; u.B = (const char*)(p.ws + b_off) + (size_t)pn * 256 * LDB * 2; return true; }
    DI void epi(EPI_ARGS) const { float* PE = (float*)(p.ws + WS_PE);
        EPI_ROWS(row) EPI_COLS(col) const size_t o = (size_t)row * D + u.pn * 256 + col; *(f32x4*)(PE + o) = v0; *(f32x4*)(PE + o + 4) = v1; EPI_END }
};
struct PhasePg : PhaseN2048<D, D, D> {
    DI bool next(int i, g8::Unit& u) const { return next_(i, u); }
    DI void epi(EPI_ARGS) const { const float* H2 = (const float*)(p.ws + WS_H2); const float* PE = (const float*)(p.ws + WS_PE); const float* SS2 = (const float*)(p.ws + WS_SS2);
        float* H3 = (float*)(p.ws + WS_H3); float* SS3 = (float*)(p.ws + WS_SS3);
#pragma unroll
        for (int ai = 0; ai < 2; ++ai)
#pragma unroll
            for (int m = 0; m < 4; ++m) { f32x4 hA[2], hB[2], pA[2], pB[2];
                const int row = u.pm * 256 + ai * 128 + wr * 64 + m * 16 + fr; float s2 = 0.f;
#pragma unroll
                for (int k = 0; k < 8; ++k) s2 += sum4(*(const f32x4*)(SS2 + (size_t)row * 32 + 4 * k));
                const float rs = 1.0f / sqrtf(s2 * (1.0f / D) + EPS);
#pragma unroll
                for (int bj = 0; bj < 2; ++bj) { const size_t o = (size_t)row * D + u.pn * 256 + bj * 128 + wc * 32 + 8 * fq;
                    hA[bj] = *(const f32x4*)(H2 + o); hB[bj] = *(const f32x4*)(H2 + o + 4); pA[bj] = *(const f32x4*)(PE + o); pB[bj] = *(const f32x4*)(PE + o + 4); }
                float ss = 0.f;
#pragma unroll
                for (int bj = 0; bj < 2; ++bj) { const size_t o = (size_t)row * D + u.pn * 256 + bj * 128 + wc * 32 + 8 * fq;
                    const f32x4 h0 = hA[bj] + sig4(acc[ai][bj][m][0] * rs) * pA[bj], h1 = hB[bj] + sig4(acc[ai][bj][m][1] * rs) * pB[bj];
                    *(f32x4*)(H3 + o) = h0; *(f32x4*)(H3 + o + 4) = h1; ss += sum4(h0 * h0) + sum4(h1 * h1); }
                ss += __shfl_xor(ss, 16); ss += __shfl_xor(ss, 32);
                if (fq == 0) SS3[(size_t)row * 32 + u.pn * 4 + wc] = ss; } }
};
struct PhaseUp {
    static constexpr int LDA = D, LDB = D, KT = D / 64;
    const Params& p; int G, c;
    DI bool next(int i, g8::Unit& u) const { int pm, pn; if (!g8::grid_order(NTM, 43, G, c, i, pm, pn)) return false;
        u.pm = pm; u.pn = pn; u.A = (const char*)(p.ws + WS_H1B) + (size_t)pm * 256 * D * 2; u.B = (const char*)(p.ws + WS_WUP) + (size_t)pn * 256 * D * 2; return true; }
    DI void epi(EPI_ARGS) const { bf16_t* GU = (bf16_t*)(p.ws + WS_GU);
        EPI_ROWS(row) EPI_COLS(col) *(u32x4*)(GU + (size_t)row * NUP + u.pn * 256 + col) = pk8(v0, v1); EPI_END }
};

struct PhaseWpb {
    static constexpr int LDA = POOLW, LDB = 256, KT = 4;
    const Params& p; int G, c;
    DI bool next(int i, g8::Unit& u) const { const int off = 220 % G; const long L = (long)i * G + ((c + G - off) % G); if (L >= 32) return false;
        const int pm = (int)L >> 2, g = (int)L & 3; u.pm = pm; u.pn = g;
        u.A = (const char*)(p.ws + WS_WBT) + ((size_t)pm * 256 * POOLW + g * 256) * 2; u.B = (const char*)(p.ws + WS_WPS) + (size_t)g * 256 * 256 * 2; return true; }
    DI void epi(EPI_ARGS) const { bf16_t* W = (bf16_t*)(p.ws + WS_WPB);
        EPI_ROWS(row) EPI_COLS(col) *(u32x4*)(W + (size_t)row * POOLW + u.pn * 256 + col) = pk8(v0, v1); EPI_END }
};

template <int KS, int LDA, int LDB>
DI f32x4 skinny16(const bf16_t* A, const bf16_t* W, int lane) {
    const int fr = lane & 15, fq = lane >> 4;
    const bf16_t* ap = A + (size_t)fr * LDA + 8 * fq; const bf16_t* bp = W + (size_t)fr * LDB + 8 * fq;
    f32x4 acc = {0.f, 0.f, 0.f, 0.f};
#pragma unroll 4
    for (int s = 0; s < KS; ++s) { const bf16x8 a = *(const bf16x8*)(ap + 32 * s), b = *(const bf16x8*)(bp + 32 * s); acc = __builtin_amdgcn_mfma_f32_16x16x32_bf16(a, b, acc, 0, 0, 0); }
    return acc;
}
DI float sum16(float v) { v += __shfl_xor(v, 1); v += __shfl_xor(v, 2); v += __shfl_xor(v, 4); v += __shfl_xor(v, 8); return v; }
template <int KIND, int K, int LDA, int LDB, int NCG = 128>
DI void sample_gemm(const Params& p, LAS unsigned char* lds, size_t a_off, size_t w_off, int wave) {
    unsigned char* ws = p.ws; const int lane = lane_id(), fr = lane & 15, fq = lane >> 4;
    constexpr int KS = K / 64;
    for (int it = blockIdx.x; it < 2 * NCG; it += gridDim.x) {
        const int cg_ = it >> 1, r0 = MP + 64 * (it & 1) + 16 * (wave & 3), col = 16 * cg_ + fr, kh = wave >> 2;
        f32x4 acc = skinny16<KS, LDA, LDB>((const bf16_t*)(ws + a_off) + (size_t)r0 * LDA + kh * (K / 2), (const bf16_t*)(ws + w_off) + (size_t)(16 * cg_) * LDB + kh * (K / 2), lane);
        LAS f32x4* xch = (LAS f32x4*)lds;
        if (kh == 1) xch[(wave & 3) * 64 + lane] = acc;
        __syncthreads();
        if (kh == 0) {
        acc += xch[wave * 64 + lane];
        float rs[4] = {0.f, 0.f, 0.f, 0.f};
        if (KIND == 5) {
            const float* SS2S = (const float*)(ws + WS_SS2S);
#pragma unroll
            for (int r = 0; r < 16; ++r) { const float* q = SS2S + (size_t)(r0 - MP + r) * 128; const float s_ = wave_sum(q[lane] + q[64 + lane]); const float rr = 1.0f / sqrtf(s_ * (1.0f / D) + EPS);
#pragma unroll
                for (int j = 0; j < 4; ++j) rs[j] = (r == 4 * fq + j) ? rr : rs[j]; }
        }
#pragma unroll
        for (int j = 0; j < 4; ++j) {
            const int row = r0 + 4 * fq + j; const size_t o = (size_t)row * D + col; const float v = acc[j]; float hsq = 0.f;
            if (KIND == 6) { const float val = v * ((const float*)(ws + WS_RSTD1))[row];
                if (col < KW) ((bf16_t*)(ws + WS_QB))[(size_t)row * KW + col] = (bf16_t)(pk2(val * 0.0625f, 0.f) & 0xffffu);
                else if (col < 2 * KW) ((bf16_t*)(ws + WS_KB))[(size_t)row * KW + col - KW] = (bf16_t)(pk2(val, 0.f) & 0xffffu);
                else ((bf16_t*)(ws + WS_V))[(size_t)row * VW + col - 2 * KW] = (bf16_t)(pk2(val, 0.f) & 0xffffu); }
            if (KIND == 0) { ((float*)(ws + WS_YBG))[o] = v * bf1(((const bf16_t*)(ws + WS_GB))[o]); }
            if (KIND == 1) { ((bf16_t*)(ws + WS_MB))[o] = (bf16_t)(pk2(v * bf1(((const bf16_t*)(ws + WS_GA))[o]) + ((const float*)(ws + WS_YBG))[o], 0.f) & 0xffffu); }
            if (KIND == 2) { const float hv = p.x_sample[(size_t)(row - MP) * D + col] + v; ((float*)(ws + WS_H1))[o] = hv; ((bf16_t*)(ws + WS_H1B))[o] = (bf16_t)(pk2(hv, 0.f) & 0xffffu); hsq = hv * hv; }
            if (KIND == 3) { const float hv = ((const float*)(ws + WS_H1))[o] + v; ((float*)(ws + WS_H2))[o] = hv; ((bf16_t*)(ws + WS_H2B))[o] = (bf16_t)(pk2(hv, 0.f) & 0xffffu); hsq = hv * hv; }
            if (KIND == 4) { ((float*)(ws + WS_PE))[o] = v; }
            if (KIND == 5) { const float hv = ((const float*)(ws + WS_H2))[o] + sigmoidf_(v * rs[j]) * ((const float*)(ws + WS_PE))[o]; ((float*)(ws + WS_H3))[o] = hv; hsq = hv * hv; }
            if (KIND == 2 || KIND == 3 || KIND == 5) { const float t = sum16(hsq);
                float* SSx = (float*)(ws + (KIND == 2 ? WS_SS1S : (KIND == 3 ? WS_SS2S : WS_SS3S))); if (fr == 0) SSx[(size_t)(row - MP) * 128 + cg_] = t; }
        }
        }
        __syncthreads();
    }
}


#define XB_TMO      128
#define XB_XCNT(j)  (256  + 64 * (j))
#define XB_XSUB(j)  (1280 + 64 * (j))
#define XB_XGEN(j)  (2304 + 64 * (j))
#define XB_TOP      3328
#define XB_TOPGEN   3392
#define XCD_BAR_WORDS 3456
#define XB_SPIN_CAP (1u << 22)
DI unsigned xb_ld(unsigned* p)              { return __hip_atomic_load(p, __ATOMIC_RELAXED, __HIP_MEMORY_SCOPE_AGENT); }
DI unsigned xb_add(unsigned* p, unsigned v) { return __hip_atomic_fetch_add(p, v, __ATOMIC_RELAXED, __HIP_MEMORY_SCOPE_AGENT); }
DI unsigned xb_xcc_id() { return (unsigned)__builtin_amdgcn_s_getreg((3 << 11) | 20) & 0xFu; }
#define XB_SPIN(cond, bar) do { unsigned _sp = 0; while (cond) { __builtin_amdgcn_s_sleep(1); \
    if ((++_sp & 255u) == 0u) { if (xb_ld(&(bar)[XB_TMO])) break; if (_sp > XB_SPIN_CAP) { atomicAdd(&(bar)[XB_TMO], 1u); break; } } } } while (0)
struct XcdBarrier { unsigned* bar; unsigned x; volatile LAS unsigned* st; };
DI XcdBarrier xcd_barrier_post(unsigned* bar, volatile LAS unsigned* st, bool t0) {
    XcdBarrier b; b.bar = bar; b.x = xb_xcc_id(); b.st = st;
    if (t0) (void)xb_add(&bar[XB_XCNT(b.x)], 1u);
    return b;
}
DI void xcd_barrier_complete(unsigned* bar, unsigned x, unsigned& nloc, unsigned& nx) {
    const unsigned G = gridDim.x * gridDim.y * gridDim.z;
    unsigned sum, cnt, mine, sp = 0u;
    for (;;) {
        sum = 0u; cnt = 0u; mine = 0u;
#pragma unroll
        for (unsigned j = 0; j < 16; ++j) { const unsigned c = xb_ld(&bar[XB_XCNT(j)]); sum += c; cnt += (c > 0u) ? 1u : 0u; mine = (j == x) ? c : mine; }
        if (sum == G) break;
        __builtin_amdgcn_s_sleep(1);
        if ((++sp & 255u) == 0u) { if (xb_ld(&bar[XB_TMO])) break; if (sp > XB_SPIN_CAP) { atomicAdd(&bar[XB_TMO], 1u); break; } }
    }
    nloc = mine > 0u ? mine : 1u; nx = cnt > 0u ? cnt : 1u;
}
DI void xcd_barrier(const XcdBarrier& b, bool t0) {
    asm volatile("s_waitcnt vmcnt(0)" ::: "memory");
    __syncthreads();
    if (t0) {
        unsigned* bar = b.bar;
        __builtin_amdgcn_s_waitcnt(0);
        unsigned nloc = b.st[0], nx = b.st[1];
        if (nloc == 0u) { xcd_barrier_complete(bar, b.x, nloc, nx); b.st[0] = nloc; b.st[1] = nx; }
        const unsigned old = xb_add(&bar[XB_XSUB(b.x)], 1u);
        const unsigned gen = old / nloc;
        if (old + 1u == (gen + 1u) * nloc) {
            __builtin_amdgcn_fence(__ATOMIC_RELEASE, "agent");
            asm volatile("s_waitcnt vmcnt(0)" ::: "memory");
            const unsigned og = xb_add(&bar[XB_TOP], 1u);
            const unsigned tg = og / nx;
            if (og + 1u == (tg + 1u) * nx) xb_add(&bar[XB_TOPGEN], 1u);
            else XB_SPIN(xb_ld(&bar[XB_TOPGEN]) == tg, bar);
            __builtin_amdgcn_fence(__ATOMIC_ACQUIRE, "agent");
            xb_add(&bar[XB_XGEN(b.x)], 1u);
            asm volatile("s_waitcnt vmcnt(0)" ::: "memory");
        } else {
            XB_SPIN(xb_ld(&bar[XB_XGEN(b.x)]) == gen, bar);
            __builtin_amdgcn_fence(__ATOMIC_ACQUIRE, "agent");
            asm volatile("s_waitcnt vmcnt(0)" ::: "memory");
        }
    }
    __syncthreads();
}

constexpr int N_PHASES = 13;
#ifndef G8_SP2
#define G8_SP2 true
#endif
#ifndef G8_ALIGN
#define G8_ALIGN true
#endif

__global__ void __launch_bounds__(NTHREADS, 2) fwd_kernel(Params p) {
    extern __shared__ __attribute__((aligned(16))) unsigned char lds_raw[];
    LAS unsigned char* lds = (LAS unsigned char*)lds_raw;
    const int G = gridDim.x, c = blockIdx.x;
    const int wave = __builtin_amdgcn_readfirstlane(threadIdx.x >> 6);
    const int lo = p.ph_lo, hi = p.ph_hi;
#ifndef REPEAT_MASK
#define REPEAT_MASK 0
#endif
#ifndef PHASE_MASK
#define PHASE_MASK 0x1bff
#endif
#define IN(k) (((PHASE_MASK >> (k)) & 1) && lo <= (k) && (k) < hi)
    volatile LAS unsigned* bst = (volatile LAS unsigned*)(lds + LDS_MISC);
    const bool t0 = (wave == 0) && (lane_id() == 0);
    XcdBarrier bar; bar.bar = (unsigned*)(p.ws + WS_CTL); bar.x = 0; bar.st = bst;
    if (hi - lo > 1) { if (t0) { bst[0] = 0u; bst[1] = 0u; } __syncthreads(); bar = xcd_barrier_post((unsigned*)(p.ws + WS_CTL), bst, t0); }
#define NEXTPH(k) ((k) == 9 ? 11 : (k) + 1)
#define SEAM(k) do { if (IN(k) && IN(NEXTPH(k))) { xcd_barrier(bar, (wave == 0) && (lane_id() == 0)); } } while (0)
    if (IN(0)) { phase_p0(p, lds, wave); if ((REPEAT_MASK >> 0) & 1) { xcd_barrier(bar, (wave == 0) && (lane_id() == 0)); phase_p0(p, lds, wave); } } SEAM(0);
    if (IN(1)) { sample_gemm<6, D, D, D, 256>(p, lds, WS_XB, WS_WIN, wave); PhaseIn ph{p, G, c, 0, 0}; g8::run<PhaseIn, G8_ALIGN, G8_SP2>(lds, ph, wave); } SEAM(1);
    if (IN(2)) {
        if (G == 256) {
            if (c < 32) scan_role(p, lds, wave, c, 32);
            else if (c < 71) stream_role(p, wave, c - 32, 39);
            else { PhaseIn ph{p, G, c, 1, 71}; g8::run<PhaseIn, G8_ALIGN, G8_SP2>(lds, ph, wave); PhaseWpb pw{p, G, c}; g8::run<PhaseWpb, G8_ALIGN, G8_SP2>(lds, pw, wave); }
        } else {
            PhaseIn ph{p, G, c, 1, 0}; g8::run<PhaseIn, G8_ALIGN, G8_SP2>(lds, ph, wave); PhaseWpb pw{p, G, c}; g8::run<PhaseWpb, G8_ALIGN, G8_SP2>(lds, pw, wave);
            scan_role(p, lds, wave, c, G); stream_role(p, wave, c, G);
        }
    } SEAM(2);
    if (IN(3)) { phase_p3(p, wave); if ((REPEAT_MASK >> 3) & 1) { xcd_barrier(bar, (wave == 0) && (lane_id() == 0)); phase_p3(p, wave); } } SEAM(3);
    if (IN(4)) { sample_gemm<0, POOLW, POOLW, POOLW>(p, lds, WS_PM, WS_WPB, wave); PhaseYb ph{{p, G, c, WS_PM, WS_WPB}}; g8::run<PhaseYb, G8_ALIGN, G8_SP2>(lds, ph, wave); if ((REPEAT_MASK >> 4) & 1) { xcd_barrier(bar, (wave == 0) && (lane_id() == 0)); sample_gemm<0, POOLW, POOLW, POOLW>(p, lds, WS_PM, WS_WPB, wave); PhaseYb ph{{p, G, c, WS_PM, WS_WPB}}; g8::run<PhaseYb, G8_ALIGN, G8_SP2>(lds, ph, wave); } } SEAM(4);
    if (IN(5)) { sample_gemm<1, VW, VW, VW>(p, lds, WS_OG, WS_WA, wave); PhaseYa ph{{p, G, c, WS_OG, WS_WA}}; g8::run<PhaseYa, G8_ALIGN, G8_SP2>(lds, ph, wave); if ((REPEAT_MASK >> 5) & 1) { xcd_barrier(bar, (wave == 0) && (lane_id() == 0)); sample_gemm<1, VW, VW, VW>(p, lds, WS_OG, WS_WA, wave); PhaseYa ph{{p, G, c, WS_OG, WS_WA}}; g8::run<PhaseYa, G8_ALIGN, G8_SP2>(lds, ph, wave); } } SEAM(5);
    if (IN(6)) { sample_gemm<2, D, D, D>(p, lds, WS_MB, WS_WO, wave); PhaseOut ph{{p, G, c, WS_MB, WS_WO}}; g8::run<PhaseOut, G8_ALIGN, G8_SP2>(lds, ph, wave); if ((REPEAT_MASK >> 6) & 1) { xcd_barrier(bar, (wave == 0) && (lane_id() == 0)); sample_gemm<2, D, D, D>(p, lds, WS_MB, WS_WO, wave); PhaseOut ph{{p, G, c, WS_MB, WS_WO}}; g8::run<PhaseOut, G8_ALIGN, G8_SP2>(lds, ph, wave); } } SEAM(6);
    if (IN(7)) { PhaseUp ph{p, G, c}; g8::run<PhaseUp, G8_ALIGN, G8_SP2>(lds, ph, wave); sample_gemm<4, PLE, PLE, PLE>(p, lds, WS_PLB, WS_WPLE, wave); { PhasePe pe{{p, G, c, WS_PLB, WS_WPLE}}; g8::run<PhasePe, G8_ALIGN, G8_SP2>(lds, pe, wave); } if ((REPEAT_MASK >> 7) & 1) { xcd_barrier(bar, (wave == 0) && (lane_id() == 0)); PhaseUp ph{p, G, c}; g8::run<PhaseUp, G8_ALIGN, G8_SP2>(lds, ph, wave); } } SEAM(7);
    if (IN(8)) { phase_conv(p, wave); if ((REPEAT_MASK >> 8) & 1) { xcd_barrier(bar, (wave == 0) && (lane_id() == 0)); phase_conv(p, wave); } } SEAM(8);
    if (IN(9)) { sample_gemm<3, DFF, DFF, DFF>(p, lds, WS_ACT, WS_WD, wave); PhaseDown ph{{p, G, c, WS_ACT, WS_WD}}; g8::run<PhaseDown, G8_ALIGN, G8_SP2>(lds, ph, wave); if ((REPEAT_MASK >> 9) & 1) { xcd_barrier(bar, (wave == 0) && (lane_id() == 0)); sample_gemm<3, DFF, DFF, DFF>(p, lds, WS_ACT, WS_WD, wave); PhaseDown ph{{p, G, c, WS_ACT, WS_WD}}; g8::run<PhaseDown, G8_ALIGN, G8_SP2>(lds, ph, wave); } } SEAM(9);
    if (IN(11)) { sample_gemm<5, D, D, D>(p, lds, WS_H2B, WS_WPG, wave); PhasePg ph{{p, G, c, WS_H2B, WS_WPG}}; g8::run<PhasePg, G8_ALIGN, G8_SP2>(lds, ph, wave); if ((REPEAT_MASK >> 11) & 1) { xcd_barrier(bar, (wave == 0) && (lane_id() == 0)); sample_gemm<5, D, D, D>(p, lds, WS_H2B, WS_WPG, wave); PhasePg ph{{p, G, c, WS_H2B, WS_WPG}}; g8::run<PhasePg, G8_ALIGN, G8_SP2>(lds, ph, wave); } } SEAM(11);
    if (IN(12)) { phase_final(p, wave); if ((REPEAT_MASK >> 12) & 1) { xcd_barrier(bar, (wave == 0) && (lane_id() == 0)); phase_final(p, wave); } }
#undef IN
#undef SEAM
}

extern "C" void kernel_launch(void* const* d_in, const int* in_sizes, int n_in, void* d_out, int out_size, void* d_ws, size_t ws_size, hipStream_t stream) {
    static int grid = 0;
    if (grid == 0) {
        if (n_in != 26 || (size_t)out_size != O_END || ws_size < WS_END) {
            fprintf(stderr, "kernel_launch: unexpected problem: n_in %d out %d ws %zu (need %zu)\n", n_in, out_size, ws_size, (size_t)WS_END); grid = -1; return; }
        int dev = 0, cus = 0, per_cu = 0;
        if (hipGetDevice(&dev) != hipSuccess || hipDeviceGetAttribute(&cus, hipDeviceAttributeMultiprocessorCount, dev) != hipSuccess) { grid = -1; return; }
        if (hipFuncSetAttribute((const void*)fwd_kernel, hipFuncAttributeMaxDynamicSharedMemorySize, LDS_BYTES) != hipSuccess) { fprintf(stderr, "kernel_launch: hipFuncSetAttribute failed\n"); grid = -1; return; }
        if (hipOccupancyMaxActiveBlocksPerMultiprocessor(&per_cu, (const void*)fwd_kernel, NTHREADS, LDS_BYTES) != hipSuccess || per_cu < 1) {
            fprintf(stderr, "kernel_launch: occupancy query reports %d blocks per CU\n", per_cu); (void)hipGetLastError(); grid = -1; return; }
        grid = cus;
    }
    if (grid < 0) return;
    Params p{};
    const float** pp = (const float**)&p;
    for (int i = 0; i < 26; ++i) pp[i] = (const float*)d_in[i];
    p.out = (float*)d_out; p.ws = (unsigned char*)d_ws;
#if MK_N_LAUNCHES == 1
    p.ph_lo = 0; p.ph_hi = N_PHASES;
    void* args[] = {&p};
    if (hipMemsetAsync((char*)d_ws + WS_CTL, 0, XCD_BAR_WORDS * 4, stream) != hipSuccess) { fprintf(stderr, "kernel_launch: memset failed\n"); return; }
    hipError_t e = hipLaunchCooperativeKernel((const void*)fwd_kernel, dim3(grid), dim3(NTHREADS), args, LDS_BYTES, stream);
    if (e != hipSuccess) fprintf(stderr, "kernel_launch: cooperative launch failed: %s (grid %d)\n", hipGetErrorString(e), grid);
#else
    for (int k = 0; k < N_PHASES; ++k) { p.ph_lo = k; p.ph_hi = k + 1; hipLaunchKernelGGL(fwd_kernel, dim3(grid), dim3(NTHREADS), LDS_BYTES, stream, p); }
#endif
}
```

```cpp
#include <hip/hip_runtime.h>
#include <hip/hip_cooperative_groups.h>
#include <cstdio>
#include <cstdint>
namespace cg = cooperative_groups;

#ifndef MK_N_LAUNCHES
#define MK_N_LAUNCHES 1
#endif

#define LAS __attribute__((address_space(3)))
#define DI __device__ __forceinline__
typedef unsigned short bf16_t;
typedef short bf16x8 __attribute__((ext_vector_type(8)));
typedef short s16x4 __attribute__((ext_vector_type(4)));
typedef float f32x4 __attribute__((ext_vector_type(4)));
typedef float f32x2 __attribute__((ext_vector_type(2)));
typedef float f32x16 __attribute__((ext_vector_type(16)));
typedef unsigned u32x4 __attribute__((ext_vector_type(4)));
typedef unsigned u32x2 __attribute__((ext_vector_type(2)));

constexpr int D = 2048, MP = 8192, MS = 128, M = MP + MS, MPAD = 8448, NTM = 33;
constexpr int SEQ = 2048, NB = 4, NH = 4, DK = 256, DV = 512, KW = 1024, VW = 2048;
constexpr int DFF = 5504, NUP = 2 * DFF, PLE = 256, POOLW = 1024, INW = 11280, NIN = 11264;
constexpr float EPS = 1e-6f;
constexpr int NSL = 16;
constexpr int CH = 32, NCHK = MP / CH;

constexpr size_t O_YP = 0, O_YS = O_YP + (size_t)MP * D, O_GLAP = O_YS + (size_t)MS * D, O_POOLP = O_GLAP + (size_t)NB * NH * DK * DV,
                 O_CONVP = O_POOLP + (size_t)NB * 15 * POOLW, O_GLAS = O_CONVP + (size_t)NB * 2 * DFF, O_POOLS = O_GLAS + (size_t)MS * NH * DK * DV,
                 O_CONVS = O_POOLS + (size_t)MS * 15 * POOLW, O_END = O_CONVS + (size_t)MS * 2 * DFF;

constexpr size_t al(size_t x) { return (x + 255) & ~(size_t)255; }
constexpr size_t WS_CTL = 0, CTL_BYTES = 65536;
constexpr size_t WS_WUP = WS_CTL + CTL_BYTES;
constexpr size_t WS_WD = WS_WUP + al((size_t)NUP * D * 2);
constexpr size_t WS_WA = WS_WD + al((size_t)D * DFF * 2);
constexpr size_t WS_WO = WS_WA + al((size_t)D * D * 2);
constexpr size_t WS_WPG = WS_WO + al((size_t)D * D * 2);
constexpr size_t WS_WPB = WS_WPG + al((size_t)D * D * 2);
constexpr size_t WS_WPLE = WS_WPB + al((size_t)D * POOLW * 2);
constexpr size_t WS_WBT = WS_WPLE + al((size_t)D * PLE * 2);
constexpr size_t WS_WPS = WS_WBT + al((size_t)D * POOLW * 2);
constexpr size_t WS_SMALL = WS_WPS + al((size_t)POOLW * 256 * 2);
constexpr size_t WS_RSTD1 = WS_SMALL;
constexpr size_t WS_LAM = WS_RSTD1 + al((size_t)MPAD * 4);
constexpr size_t WS_OSS = WS_LAM + al((size_t)(NCHK + MS) * KW * 4);
constexpr size_t WS_OSP = WS_OSS + al((size_t)MP * NH * NSL * 4);
constexpr size_t WS_SS1 = WS_OSP + al((size_t)MS * NH * 8 * DV * 4);
constexpr size_t WS_SS2 = WS_SS1 + al((size_t)MPAD * 32 * 4);
constexpr size_t WS_SS3 = WS_SS2 + al((size_t)MPAD * 32 * 4);
constexpr size_t WS_SS1S = WS_SS3 + al((size_t)MPAD * 32 * 4);
constexpr size_t WS_SS2S = WS_SS1S + al((size_t)MS * 128 * 4);
constexpr size_t WS_SS3S = WS_SS2S + al((size_t)MS * 128 * 4);
constexpr size_t WS_PLB = WS_SS3S + al((size_t)MS * 128 * 4);
constexpr size_t WS_R1 = WS_PLB + al((size_t)MPAD * PLE * 2);
constexpr size_t WS_XB = WS_R1;
constexpr size_t WS_WIN = WS_XB + al((size_t)MPAD * D * 2);
constexpr size_t WS_BCUM = WS_WIN + al((size_t)NIN * D * 2);
constexpr size_t WS_R1_END = WS_BCUM + al((size_t)MPAD * KW * 4);
constexpr size_t WS_ACT = WS_R1;
static_assert(WS_ACT + al((size_t)MPAD * DFF * 2) <= WS_R1_END, "R1 overlay");
constexpr size_t WS_R2 = WS_R1_END;
constexpr size_t WS_QB = WS_R2;
constexpr size_t WS_KB = WS_QB + al((size_t)MPAD * KW * 2);
constexpr size_t WS_KD = WS_KB + al((size_t)MPAD * KW * 2);
constexpr size_t WS_V = WS_KD + al((size_t)MPAD * KW * 2);
constexpr size_t WS_SR = WS_V + al((size_t)MPAD * VW * 2);
constexpr size_t WS_GA = WS_SR + al((size_t)MPAD * VW * 2);
constexpr size_t WS_GB = WS_GA + al((size_t)MPAD * D * 2);
constexpr size_t WS_U = WS_GB + al((size_t)MPAD * D * 2);
constexpr size_t WS_OG = WS_U + al((size_t)MPAD * POOLW * 4);
constexpr size_t WS_PM = WS_OG + al((size_t)MPAD * VW * 2);
constexpr size_t WS_YBG = WS_PM + al((size_t)MPAD * POOLW * 2);
constexpr size_t WS_R2_END = WS_YBG + al((size_t)MPAD * D * 4);
constexpr size_t WS_GU = WS_R2;
constexpr size_t WS_H2 = WS_GU + al((size_t)MPAD * NUP * 2);
constexpr size_t WS_PE = WS_H2 + al((size_t)MPAD * D * 4);
static_assert(WS_PE + al((size_t)MPAD * D * 4) <= WS_R2_END, "R2 overlay");
constexpr size_t WS_MB = WS_R2_END;
constexpr size_t WS_H1 = WS_MB + al((size_t)MPAD * D * 2);
constexpr size_t WS_H1B = WS_H1 + al((size_t)MPAD * D * 4);
constexpr size_t WS_END = WS_H1B + al((size_t)MPAD * D * 2);
constexpr size_t WS_H3 = WS_H1;
constexpr size_t WS_H2B = WS_MB;

DI unsigned pk2(float lo, float hi) {
    typedef __bf16 bf2 __attribute__((ext_vector_type(2)));
    f32x2 v = {lo, hi};
    bf2 b = __builtin_convertvector(v, bf2);
    return __builtin_bit_cast(unsigned, b);
}
DI float bflo(unsigned w) { return __uint_as_float(w << 16); }
DI float bfhi(unsigned w) { return __uint_as_float(w & 0xffff0000u); }
DI float bf1(bf16_t b) { return __uint_as_float(((unsigned)b) << 16); }
DI float fexp(float x) { return __expf(x); }
DI float sigmoidf_(float x) { return __builtin_amdgcn_rcpf(1.0f + __expf(-x)); }
DI float siluf_(float x) { return x * sigmoidf_(x); }
DI float logsigmoidf_(float z) { return fminf(z, 0.f) - __logf(1.0f + __expf(-fabsf(z))); }
DI float wave_sum(float v) {
#pragma unroll
    for (int o = 1; o < 64; o <<= 1) v += __shfl_xor(v, o);
    return v;
}
DI int lane_id() { int l; asm volatile("v_mbcnt_lo_u32_b32 %0, -1, 0\n\tv_mbcnt_hi_u32_b32 %0, -1, %0" : "=v"(l)); return l; }
#define LDS_WAIT() asm volatile("s_waitcnt lgkmcnt(0)" ::: "memory")
#define VM_WAIT() asm volatile("s_waitcnt vmcnt(0)" ::: "memory")

struct Params {
    const float *x_prompt, *x_sample, *state_gla, *state_pool, *state_conv, *p_prompt, *p_sample;
    const float *norm_mix, *w_in, *w_gate_up, *b_gate, *gla_norm, *w_branch_a, *w_pool, *pool_scale, *w_branch_b, *w_out, *norm_ffn, *w_up, *conv_w, *conv_b,
        *w_down, *norm_ple, *w_ple_gate, *w_ple, *norm_final;
    float* out; unsigned char* ws;
    int ph_lo, ph_hi;
};

constexpr int NWAVES = 8, NTHREADS = 512;
constexpr int LDS_BYTES = 163840;
constexpr int LDS_MISC = LDS_BYTES - 256;

namespace g8 {
constexpr int BM = 256, BK = 64, HALF = 128, HTB = HALF * BK * 2, STAGE_BYTES = 8 * HTB, NXCD = 8, WGM = 2;
DI int lds_byte(int r, int c) { const int st = (r >> 4) * 2 + (c >> 5), rr = r & 15, cc = c & 31, ob = rr * 64 + cc * 2; return st * 1024 + (ob ^ (((ob >> 9) & 1) << 5)); }
DI void stage_rc(int b, int& R, int& C) { const int st = b / 1024, sb = b % 1024, swz = sb ^ (((sb >> 9) & 1) << 5); R = (st >> 1) * 16 + swz / 64; C = (st & 1) * 32 + (swz % 64) / 2; }
DI int perm32(int rho) { const int n = rho >> 4, i = rho & 15; return 8 * (i >> 2) + 4 * n + (i & 3); }

struct Unit { const char* A; const char* B; int pm, pn; };

DI bool grid_order(int nM, int nN, int G, int c, int i, int& pm, int& pn) {
    const int nwg = nM * nN; const long L = (long)i * G + c; if (L >= nwg) return false;
    int wgid = (int)L; { const int q = nwg / NXCD, r = nwg % NXCD, xcd = wgid % NXCD, off = wgid / NXCD; wgid = (xcd < r ? xcd * (q + 1) : r * (q + 1) + (xcd - r) * q) + off; }
    const int nig = WGM * nN, gid = wgid / nig, fm = gid * WGM, gsz = (nM - fm) < WGM ? (nM - fm) : WGM;
    pm = fm + ((wgid % nig) % gsz); pn = (wgid % nig) / gsz; return true;
}

template <class P, bool ALIGN_EPI, bool SP2>
DI void run(LAS unsigned char* lds, const P& ph, int wid) {
    const int lane = lane_id(), tid = wid * 64 + lane, wr = wid >> 2, wc = wid & 3, fr = lane & 15, fq = lane >> 4;
    constexpr int nt = P::KT;
    unsigned voffA[2], voffB[2];
#pragma unroll
    for (int i = 0; i < 2; ++i) { int R, C; stage_rc(tid * 16 + i * 8192, R, C); const int Rb = (R & ~31) + perm32(R & 31);
        voffA[i] = (unsigned)(R * P::LDA + C) * 2u; voffB[i] = (unsigned)(Rb * P::LDB + C) * 2u; }
    constexpr size_t kstep = (size_t)(BK * 2);
    constexpr size_t hstepA = (size_t)HALF * P::LDA * 2, hstepB = (size_t)HALF * P::LDB * 2;
    const unsigned ldsw = (unsigned)wid * 1024u;
    const int aoff = lds_byte(wr * 64 + fr, fq * 8), boff = lds_byte(wc * 32 + fr, fq * 8);
#define G8_SA(b, h) (((b) * 2 + (h)) * HTB)
#define G8_SB(b, h) ((4 + (b) * 2 + (h)) * HTB)
#define G8_STAGE(bufoff, gbase, voff) do { _Pragma("unroll") for (int _i = 0; _i < 2; ++_i) \
        __builtin_amdgcn_global_load_lds((const unsigned*)((const char*)(gbase) + (voff)[_i]), (LAS unsigned*)(lds + (bufoff) + ldsw + _i * 8192), 16, 0, 0); } while (0)
#define G8_LDA(dst, b, h) do { _Pragma("unroll") for (int m = 0; m < 4; ++m) _Pragma("unroll") for (int k = 0; k < 2; ++k) dst[m][k] = *(const LAS bf16x8*)(lds + G8_SA(b, h) + aoff + m * 2048 + k * 1024); } while (0)
#define G8_LDB(dst, b, h) do { _Pragma("unroll") for (int n = 0; n < 2; ++n) _Pragma("unroll") for (int k = 0; k < 2; ++k) dst[n][k] = *(const LAS bf16x8*)(lds + G8_SB(b, h) + boff + n * 2048 + k * 1024); } while (0)
#define G8_MMA(ai, bj, At, Bt) do { __builtin_amdgcn_s_setprio(1); _Pragma("unroll") for (int m = 0; m < 4; ++m) _Pragma("unroll") for (int n = 0; n < 2; ++n) _Pragma("unroll") for (int k = 0; k < 2; ++k) \
        acc[ai][bj][m][n] = __builtin_amdgcn_mfma_f32_16x16x32_bf16(Bt[n][k], At[m][k], acc[ai][bj][m][n], 0, 0, 0); __builtin_amdgcn_s_setprio(0); } while (0)
#define G8_WAIT_V(n) asm volatile("s_waitcnt vmcnt(" #n ")" ::: "memory")
#define G8_WAIT_L(n) asm volatile("s_waitcnt lgkmcnt(" #n ")" ::: "memory")
#define G8_BAR __builtin_amdgcn_s_barrier()
#define G8_SCHED __builtin_amdgcn_sched_barrier(0)
    Unit cur, nxt; int ui = 0;
    if (!ph.next(0, cur)) return;
    f32x4 acc[2][2][4][2];
#pragma unroll
    for (int a = 0; a < 2; ++a)
#pragma unroll
        for (int b = 0; b < 2; ++b)
#pragma unroll
            for (int m = 0; m < 4; ++m)
#pragma unroll
                for (int n = 0; n < 2; ++n) acc[a][b][m][n] = (f32x4){0.f, 0.f, 0.f, 0.f};
    bf16x8 At[4][2], B0[2][2], B1[2][2];
    const char* cA = cur.A; const char* cB = cur.B;
    if constexpr (SP2) {
        G8_STAGE(G8_SB(0, 0), cB, voffB); G8_STAGE(G8_SB(0, 1), cB + hstepB, voffB); G8_STAGE(G8_SA(0, 0), cA, voffA); G8_STAGE(G8_SA(0, 1), cA + hstepA, voffA);
        if (wr == 1) G8_BAR;
        G8_WAIT_V(2); G8_BAR;
        G8_STAGE(G8_SB(1, 0), cB + kstep, voffB); G8_STAGE(G8_SA(1, 0), cA + kstep, voffA); G8_STAGE(G8_SB(1, 1), cB + hstepB + kstep, voffB);
        G8_WAIT_V(6); G8_BAR;
    } else {
        G8_STAGE(G8_SB(0, 0), cB, voffB); G8_STAGE(G8_SA(0, 0), cA, voffA); G8_STAGE(G8_SB(0, 1), cB + hstepB, voffB); G8_STAGE(G8_SA(0, 1), cA + hstepA, voffA);
        if (wr == 1) G8_BAR;
        G8_WAIT_V(4); G8_BAR;
        G8_STAGE(G8_SB(1, 0), cB + kstep, voffB); G8_STAGE(G8_SA(1, 0), cA + kstep, voffA); G8_STAGE(G8_SB(1, 1), cB + hstepB + kstep, voffB);
        G8_WAIT_V(6); G8_BAR;
    }
    for (;;) {
        const bool has_next = ph.next(ui + 1, nxt);
        const char* nA = has_next ? nxt.A : cA; const char* nB = has_next ? nxt.B : cB;
#pragma unroll 1
        for (int t = 0; t < nt; t += 2) {
            const bool last = (t == nt - 2);
            const char* a1 = cA + (size_t)(t + 1) * kstep;
            const char* a2 = last ? nA : cA + (size_t)(t + 2) * kstep; const char* b2 = last ? nB : cB + (size_t)(t + 2) * kstep;
            const char* a3 = a2 + kstep; const char* b3 = b2 + kstep;
            if constexpr (SP2) {
            G8_LDB(B0, 0, 0); G8_LDB(B1, 0, 1); G8_SCHED; G8_LDA(At, 0, 0); G8_STAGE(G8_SA(1, 1), a1 + hstepA, voffA);
            G8_WAIT_V(8); G8_WAIT_L(0); G8_BAR; G8_MMA(0, 0, At, B0); G8_MMA(0, 1, At, B1); G8_BAR; G8_SCHED;
            G8_LDA(At, 0, 1); G8_STAGE(G8_SB(0, 0), b2, voffB); G8_STAGE(G8_SB(0, 1), b2 + hstepB, voffB); G8_STAGE(G8_SA(0, 0), a2, voffA);
            G8_WAIT_V(8); G8_WAIT_L(0); G8_BAR; G8_MMA(1, 0, At, B0); G8_MMA(1, 1, At, B1); G8_BAR; G8_SCHED;
            G8_LDB(B0, 1, 0); G8_LDB(B1, 1, 1); G8_SCHED; G8_LDA(At, 1, 0); G8_STAGE(G8_SA(0, 1), a2 + hstepA, voffA);
            G8_WAIT_V(8); G8_WAIT_L(0); G8_BAR; G8_MMA(0, 0, At, B0); G8_MMA(0, 1, At, B1); G8_BAR; G8_SCHED;
            G8_LDA(At, 1, 1); G8_STAGE(G8_SB(1, 0), b3, voffB); G8_STAGE(G8_SB(1, 1), b3 + hstepB, voffB); G8_STAGE(G8_SA(1, 0), a3, voffA);
            G8_WAIT_V(8); G8_WAIT_L(0); G8_BAR; G8_MMA(1, 0, At, B0); G8_MMA(1, 1, At, B1); G8_BAR; G8_SCHED;
            } else {
            G8_LDB(B0, 0, 0); G8_SCHED; G8_LDA(At, 0, 0); G8_STAGE(G8_SA(1, 1), a1 + hstepA, voffA);
            G8_WAIT_L(8); G8_BAR; G8_WAIT_L(0); G8_MMA(0, 0, At, B0); G8_BAR; G8_SCHED;
            G8_LDB(B1, 0, 1); G8_STAGE(G8_SB(0, 0), b2, voffB);
            G8_BAR; G8_WAIT_L(0); G8_MMA(0, 1, At, B1); G8_BAR;
            G8_LDA(At, 0, 1); G8_STAGE(G8_SA(0, 0), a2, voffA);
            G8_BAR; G8_WAIT_L(0); G8_MMA(1, 0, At, B0); G8_BAR; G8_SCHED;
            G8_STAGE(G8_SB(0, 1), b2 + hstepB, voffB);
            G8_WAIT_V(6); G8_BAR; G8_MMA(1, 1, At, B1); G8_BAR;
            G8_LDB(B0, 1, 0); G8_SCHED; G8_LDA(At, 1, 0); G8_STAGE(G8_SA(0, 1), a2 + hstepA, voffA);
            G8_WAIT_L(8); G8_BAR; G8_WAIT_L(0); G8_MMA(0, 0, At, B0); G8_BAR; G8_SCHED;
            G8_LDB(B1, 1, 1); G8_STAGE(G8_SB(1, 0), b3, voffB);
            G8_BAR; G8_WAIT_L(0); G8_MMA(0, 1, At, B1); G8_BAR;
            G8_LDA(At, 1, 1); G8_STAGE(G8_SA(1, 0), a3, voffA);
            G8_BAR; G8_WAIT_L(0); G8_MMA(1, 0, At, B0); G8_BAR; G8_SCHED;
            G8_STAGE(G8_SB(1, 1), b3 + hstepB, voffB);
            G8_WAIT_V(6); G8_BAR; G8_MMA(1, 1, At, B1); G8_BAR;
            }
        }
        if constexpr (ALIGN_EPI) { if (wr == 0) G8_BAR; }
        ph.epi(acc, cur, wr, wc, fr, fq);
        if (!has_next) break;
#pragma unroll
        for (int a = 0; a < 2; ++a)
#pragma unroll
            for (int b = 0; b < 2; ++b)
#pragma unroll
                for (int m = 0; m < 4; ++m)
#pragma unroll
                    for (int n = 0; n < 2; ++n) acc[a][b][m][n] = (f32x4){0.f, 0.f, 0.f, 0.f};
        cur = nxt; cA = nA; cB = nB; ++ui;
        if constexpr (ALIGN_EPI) { if (wr == 1) G8_BAR; }
    }
    G8_WAIT_V(0);
    if constexpr (!ALIGN_EPI) { if (wr == 0) G8_BAR; }
    G8_BAR;
#undef G8_SA
#undef G8_SB
#undef G8_STAGE
#undef G8_LDA
#undef G8_LDB
#undef G8_MMA
#undef G8_WAIT_V
#undef G8_WAIT_L
#undef G8_BAR
#undef G8_SCHED
}
}

struct TJob { const float* src; bf16_t* dst; const float* gain; int K, Nsrc, Ndst, map, nitems; };

DI int map_col(int map, int n0) {
    if (map == 1) return n0 + (n0 >= 6144 ? 16 : 0);
    if (map == 2) { const int t = n0 >> 8, r = n0 & 255; return (r < 128) ? 128 * t + r : DFF + 128 * t + (r - 128); }
    return n0;
}
constexpr int TR_SCR = 64 * 65 * 4;
static_assert(8 * TR_SCR <= LDS_MISC, "transpose scratch must stay below the barrier words");
DI void p0_transpose_item(const TJob& J, LAS float* scr, int item, int lane) {
    const int nblk = J.Ndst / 64, kb = item / nblk, nb = item % nblk, k0 = 64 * kb, n0 = 64 * nb, ns0 = map_col(J.map, n0);
    const float* src = J.src + (size_t)(k0 + (lane >> 4)) * J.Nsrc + ns0 + 4 * (lane & 15);
    f32x4 v[16];
#pragma unroll
    for (int i = 0; i < 16; ++i) v[i] = *(const f32x4*)(src + (size_t)(4 * i) * J.Nsrc);
    if (J.gain) {
#pragma unroll
        for (int i = 0; i < 16; ++i) v[i] *= J.gain[k0 + 4 * i + (lane >> 4)];
    }
#pragma unroll
    for (int i = 0; i < 16; ++i) { LAS float* d = scr + (4 * i + (lane >> 4)) * 65 + 4 * (lane & 15); d[0] = v[i].x; d[1] = v[i].y; d[2] = v[i].z; d[3] = v[i].w; }
    LDS_WAIT(); asm volatile("" ::: "memory");
    const int c = lane & 7;
#pragma unroll
    for (int j = 0; j < 8; ++j) { const int n = (lane >> 3) + 8 * j; const LAS float* s = scr + (8 * c) * 65 + n;
        u32x4 o; o.x = pk2(s[0 * 65], s[1 * 65]); o.y = pk2(s[2 * 65], s[3 * 65]); o.z = pk2(s[4 * 65], s[5 * 65]); o.w = pk2(s[6 * 65], s[7 * 65]);
        *(u32x4*)(J.dst + (size_t)(n0 + n) * J.K + k0 + 8 * c) = o; }
    LDS_WAIT(); asm volatile("" ::: "memory");
}
DI void p0_wps_item(const Params& p, bf16_t* WPS, int item, int lane) {
    const size_t e = (size_t)item * 512 + lane * 8; const float* src = p.w_pool + e;
    const f32x4 a = *(const f32x4*)src, b = *(const f32x4*)(src + 4);
    u32x4 o; o.x = pk2(a.x, a.y); o.y = pk2(a.z, a.w); o.z = pk2(b.x, b.y); o.w = pk2(b.z, b.w);
    *(u32x4*)(WPS + e) = o;
}
DI void p0_plb_item(const Params& p, bf16_t* PLB, int item, int lane) {
    const size_t e = (size_t)item * 512 + lane * 8; const size_t row = e / PLE;
    const float* src = (row < MP) ? p.p_prompt + e : p.p_sample + (e - (size_t)MP * PLE);
    const f32x4 a = *(const f32x4*)src, b = *(const f32x4*)(src + 4);
    u32x4 o; o.x = pk2(a.x, a.y); o.y = pk2(a.z, a.w); o.z = pk2(b.x, b.y); o.w = pk2(b.z, b.w);
    *(u32x4*)(PLB + e) = o;
}

DI void p0_xprep_unit(const Params& p, LAS unsigned char* lds, int u, int wave) {
    const int lane = lane_id(), tid = wave * 64 + lane;
    unsigned char* ws = p.ws;
    bf16_t* XB = (bf16_t*)(ws + WS_XB); float* RSTD1 = (float*)(ws + WS_RSTD1); float* BCUM = (float*)(ws + WS_BCUM); float* LAM = (float*)(ws + WS_LAM);
    LAS unsigned char* WG = lds; LAS float* GL = (LAS float*)(lds + 65536); LAS float* RS = (LAS float*)(lds + 69632);
    {   f32x4 w[16]; float gk[16];
#pragma unroll
        for (int i = 0; i < 16; ++i) { const int idx = tid + 512 * i, k = idx >> 2, n4 = idx & 3; w[i] = *(const f32x4*)(p.w_in + (size_t)k * INW + 6144 + 4 * n4); gk[i] = p.norm_mix[k]; }
#pragma unroll
        for (int i = 0; i < 16; ++i) { const int idx = tid + 512 * i, k = idx >> 2, n4 = idx & 3; LAS bf16_t* d = (LAS bf16_t*)(WG + (size_t)((k >> 3) * 16 + 4 * n4) * 16) + (k & 7);
            const unsigned a = pk2(w[i].x * gk[i], w[i].y * gk[i]), b = pk2(w[i].z * gk[i], w[i].w * gk[i]);
            d[0] = (bf16_t)(a & 0xffffu); d[8] = (bf16_t)(a >> 16); d[16] = (bf16_t)(b & 0xffffu); d[24] = (bf16_t)(b >> 16); }
    }
    __syncthreads();
    if (wave < 4) {
        const int fr = lane & 15, fq = lane >> 4; const int row = 64 * u + 16 * wave + fr;
        const float* xr = (row < MP) ? p.x_prompt + (size_t)row * D : p.x_sample + (size_t)(row - MP) * D;
        f32x4 acc = {0.f, 0.f, 0.f, 0.f}; float ss = 0.f;
#pragma unroll 1
        for (int s0 = 0; s0 < 64; s0 += 8) {
            f32x4 xa[8], xb[8];
#pragma unroll
            for (int i = 0; i < 8; ++i) { xa[i] = *(const f32x4*)(xr + 32 * (s0 + i) + 8 * fq); xb[i] = *(const f32x4*)(xr + 32 * (s0 + i) + 8 * fq + 4); }
#pragma unroll
            for (int i = 0; i < 8; ++i) { const int s = s0 + i; const f32x4 a = xa[i], b = xb[i];
                ss += (a.x * a.x + a.y * a.y) + (a.z * a.z + a.w * a.w) + (b.x * b.x + b.y * b.y) + (b.z * b.z + b.w * b.w);
                u32x4 o; o.x = pk2(a.x, a.y); o.y = pk2(a.z, a.w); o.z = pk2(b.x, b.y); o.w = pk2(b.z, b.w);
                *(u32x4*)(XB + (size_t)row * D + 32 * s + 8 * fq) = o;
                const bf16x8 af = __builtin_bit_cast(bf16x8, o);
                const bf16x8 bfr = *(const LAS bf16x8*)(WG + (size_t)((4 * s + fq) * 16 + fr) * 16);
                acc = __builtin_amdgcn_mfma_f32_16x16x32_bf16(af, bfr, acc, 0, 0, 0); }
        }
        ss += __shfl_xor(ss, 16); ss += __shfl_xor(ss, 32);
        const float rstd = 1.0f / sqrtf(ss * (1.0f / D) + EPS);
        if (fq == 0) { RS[16 * wave + fr] = rstd; RSTD1[row] = rstd; }
        LDS_WAIT(); asm volatile("" ::: "memory");
#pragma unroll
        for (int j = 0; j < 4; ++j) { const int tl = 16 * wave + 4 * fq + j; GL[tl * 16 + fr] = acc[j] * RS[tl]; }
    }
    __syncthreads();
    const bool sample = (u >= MP / 64);
#pragma unroll 1
    for (int cc = 0; cc < 2; ++cc) {
        const int c = tid + 512 * cc; float wg[16];
#pragma unroll
        for (int j = 0; j < 16; ++j) wg[j] = p.w_gate_up[j * KW + c];
        const float bg = p.b_gate[c]; float cum = 0.f;
#pragma unroll 2
        for (int t = 0; t < 64; ++t) {
            const f32x4 g0 = *(const LAS f32x4*)(GL + t * 16), g1 = *(const LAS f32x4*)(GL + t * 16 + 4), g2 = *(const LAS f32x4*)(GL + t * 16 + 8), g3 = *(const LAS f32x4*)(GL + t * 16 + 12);
            float z = bg;
            z += g0.x * wg[0] + g0.y * wg[1] + g0.z * wg[2] + g0.w * wg[3];
            z += g1.x * wg[4] + g1.y * wg[5] + g1.z * wg[6] + g1.w * wg[7];
            z += g2.x * wg[8] + g2.y * wg[9] + g2.z * wg[10] + g2.w * wg[11];
            z += g3.x * wg[12] + g3.y * wg[13] + g3.z * wg[14] + g3.w * wg[15];
            const float gl = logsigmoidf_(z) * (1.0f / 16.0f);
            const int row = 64 * u + t;
            if (sample) { BCUM[(size_t)row * KW + c] = 0.f; LAM[(size_t)(NCHK + row - MP) * KW + c] = __expf(gl); }
            else { cum = ((t & (CH - 1)) == 0) ? gl : cum + gl; BCUM[(size_t)row * KW + c] = cum; if ((t & (CH - 1)) == CH - 1) LAM[(size_t)(row / CH) * KW + c] = __expf(cum); }
        }
    }
    __syncthreads();
}

constexpr int NXPREP = M / 64;
DI void phase_p0(const Params& p, LAS unsigned char* lds, int wave) {
    const int lane = lane_id();
    unsigned char* ws = p.ws;
#ifndef P0_REP
#define P0_REP 0
#endif
    const int G = gridDim.x, c = blockIdx.x; const bool has_unit = c < NXPREP;
    const int nx = (G < NXPREP) ? G : NXPREP, W_OTHER = 3;
    const int nslots_total = nx * NWAVES + (G - nx) * NWAVES * W_OTHER;
    const int my_n = has_unit ? 1 : W_OTHER;
    const int my_first = has_unit ? c * NWAVES + wave : nx * NWAVES + ((c - nx) * NWAVES + wave) * W_OTHER;
    if (has_unit) { for (int u = c; u < NXPREP; u += G) p0_xprep_unit(p, lds, u, wave); if (P0_REP & 1) p0_xprep_unit(p, lds, c, wave); }
    TJob J[8];
    J[0] = TJob{p.w_in, (bf16_t*)(ws + WS_WIN), p.norm_mix, D, INW, NIN, 1, (D / 64) * (NIN / 64)};
    J[1] = TJob{p.w_up, (bf16_t*)(ws + WS_WUP), p.norm_ffn, D, NUP, NUP, 2, (D / 64) * (NUP / 64)};
    J[2] = TJob{p.w_down, (bf16_t*)(ws + WS_WD), nullptr, DFF, D, D, 0, (DFF / 64) * (D / 64)};
    J[3] = TJob{p.w_branch_a, (bf16_t*)(ws + WS_WA), p.gla_norm, D, D, D, 0, (D / 64) * (D / 64)};
    J[4] = TJob{p.w_out, (bf16_t*)(ws + WS_WO), nullptr, D, D, D, 0, (D / 64) * (D / 64)};
    J[5] = TJob{p.w_ple_gate, (bf16_t*)(ws + WS_WPG), p.norm_ple, D, D, D, 0, (D / 64) * (D / 64)};
    J[6] = TJob{p.w_ple, (bf16_t*)(ws + WS_WPLE), nullptr, PLE, D, D, 0, (PLE / 64) * (D / 64)};
    J[7] = TJob{p.w_branch_b, (bf16_t*)(ws + WS_WBT), p.pool_scale, POOLW, D, D, 0, (POOLW / 64) * (D / 64)};
    LAS float* scr = (LAS float*)(lds + wave * TR_SCR);
    for (int rep = 0; rep < ((P0_REP & 2) ? 2 : 1); ++rep) {
    int base = 0;
#pragma unroll
    for (int j = 0; j < 8; ++j) {
        const int n = J[j].nitems;
        for (int k = 0; k < my_n; ++k) {
            int it = (my_first + k) - (base % nslots_total); if (it < 0) it += nslots_total;
            for (; it < n; it += nslots_total) p0_transpose_item(J[j], scr, it, lane);
        }
        base += n;
    }
    }
    for (int k = 0; k < my_n; ++k) {
        for (int it = my_first + k; it < (POOLW * 256) / 512; it += nslots_total) p0_wps_item(p, (bf16_t*)(ws + WS_WPS), it, lane);
        for (int it = my_first + k; it < (M * PLE) / 512; it += nslots_total) p0_plb_item(p, (bf16_t*)(ws + WS_PLB), it, lane);
    }
}

#define MFMA32(a, b, c) __builtin_amdgcn_mfma_f32_32x32x16_bf16((a), (b), (c), 0, 0, 0)
typedef LAS s16x4* lds_s16x4_p;
DI s16x4 tr_read(LAS unsigned char* a) { return __builtin_amdgcn_ds_read_tr16_b64_v4i16((lds_s16x4_p)a); }
DI bf16x8 cat8(s16x4 lo, s16x4 hi) { return __builtin_shufflevector(lo, hi, 0, 1, 2, 3, 4, 5, 6, 7); }
DI bf16x8 ld_perm(const bf16_t* p) {
    const u32x2 a = *(const u32x2*)p, b = *(const u32x2*)(p + 8);
    u32x4 r; r.x = a.x; r.y = a.y; r.z = b.x; r.w = b.y; return __builtin_bit_cast(bf16x8, r);
}
template <int S> DI bf16x8 pack_step(const f32x16& x) {
    u32x4 r; r.x = pk2(x[8 * S + 0], x[8 * S + 1]); r.y = pk2(x[8 * S + 2], x[8 * S + 3]); r.z = pk2(x[8 * S + 4], x[8 * S + 5]); r.w = pk2(x[8 * S + 6], x[8 * S + 7]);
    return __builtin_bit_cast(bf16x8, r);
}
DI f32x16 zero16() { f32x16 z;
#pragma unroll
    for (int i = 0; i < 16; ++i) z[i] = 0.f; return z; }

constexpr int SC_BUF = 50176, SC_QI = 0, SC_KI = 16384, SC_VI = 32768, SC_LMI = 49152, SC_ATT = 3 * SC_BUF, SC_BYTES = SC_ATT + 2048;
static_assert(SC_BYTES <= LDS_MISC, "scan LDS map");
DI void dma16(const void* g, LAS unsigned char* l) { __builtin_amdgcn_global_load_lds((const unsigned*)g, (LAS unsigned*)l, 16, 0, 0); }
DI bf16x8 lds_perm(LAS unsigned char* a) {
    const u32x2 x = *(const LAS u32x2*)a, y = *(const LAS u32x2*)(a + 512);
    u32x4 r; r.x = x.x; r.y = x.y; r.z = y.x; r.w = y.y; return __builtin_bit_cast(bf16x8, r);
}
#define SC_BAR() do { asm volatile("s_waitcnt lgkmcnt(0)" ::: "memory"); __builtin_amdgcn_s_barrier(); asm volatile("" ::: "memory"); } while (0)
DI void scan_block(const Params& p, LAS unsigned char* lds, int task, int wave) {
    unsigned char* ws = p.ws;
    const bf16_t* QB = (const bf16_t*)(ws + WS_QB); const bf16_t* KB = (const bf16_t*)(ws + WS_KB);
    const bf16_t* V = (const bf16_t*)(ws + WS_V); bf16_t* OG = (bf16_t*)(ws + WS_OG);
    const float* LAM = (const float*)(ws + WS_LAM); float* OSS = (float*)(ws + WS_OSS);
    const int half = task & 1, hd = (task >> 1) & 3, b = task >> 3, sl = 8 * half + wave;
    f32x16 S[8];
#pragma unroll
    for (int db = 0; db < 8; ++db) S[db] = zero16();

#define SC_ISSUE(ch_, slot_) do { const int _l = lane_id(); const size_t _r0 = (size_t)(b * SEQ + CH * (ch_)); LAS unsigned char* _lb = lds + (slot_) * SC_BUF; asm volatile("" : "+s"(_lb)); \
        _Pragma("unroll") for (int _k = 0; _k < 2; ++_k) { const int _i = 2 * wave + _k; \
            const int _row = _l & 31, _cc = 2 * _i + (_l >> 5); \
            dma16(QB + (_r0 + _row) * KW + hd * 256 + 8 * _cc, _lb + SC_QI + _i * 1024); \
            const int _s = 2 * _i + (_l >> 5), _c2 = (_l & 31) ^ (4 * (_s & 3)); \
            dma16(KB + (_r0 + _s) * KW + hd * 256 + 8 * _c2, _lb + SC_KI + _i * 1024); dma16(V + (_r0 + _s) * VW + hd * 512 + 256 * half + 8 * _c2, _lb + SC_VI + _i * 1024); } \
        if (wave == 0) dma16(LAM + (size_t)(b * (SEQ / CH) + (ch_)) * KW + hd * 256 + 4 * _l, _lb + SC_LMI); } while (0)
    constexpr int NCH = SEQ / CH;
    SC_ISSUE(0, 0); SC_ISSUE(1, 1);
    int slot = 0;
#pragma unroll 1
    for (int ch = 0; ch < NCH; ++ch) {
        const int row0 = b * SEQ + CH * ch;
        if (ch == 0) { if (wave == 0) asm volatile("s_waitcnt vmcnt(7)" ::: "memory"); else asm volatile("s_waitcnt vmcnt(6)" ::: "memory"); }
        else if (ch == 1) { if (wave == 0) asm volatile("s_waitcnt vmcnt(11)" ::: "memory"); else asm volatile("s_waitcnt vmcnt(10)" ::: "memory"); }
        else if (ch + 1 < NCH) { if (wave == 0) asm volatile("s_waitcnt vmcnt(15)" ::: "memory"); else asm volatile("s_waitcnt vmcnt(14)" ::: "memory"); }
        else VM_WAIT();
        SC_BAR();
        { const int s2 = (slot == 0) ? 2 : slot - 1; if (ch + 2 < NCH) SC_ISSUE(ch + 2, s2); }
        const int lane = lane_id();
        const int c = lane & 31, h = lane >> 5;
        const int i16 = lane & 15, q = i16 >> 2, pp = i16 & 3, jb = (lane >> 4) & 1;
        LAS unsigned char* buf = lds + slot * SC_BUF;
        LAS unsigned char* ATT = lds + SC_ATT;

        if (wave < 4) {
            const int si = wave >> 1, ti = wave & 1, fr = lane & 15, fq = lane >> 4;
            f32x4 a = {0.f, 0.f, 0.f, 0.f};
            LAS unsigned char* kp = buf + SC_KI + (16 * si + fr) * 512; LAS unsigned char* qp = buf + SC_QI + fq * 512 + (16 * ti + fr) * 16;
            const int kx = 4 * (fr & 3);
#pragma unroll
            for (int ks = 0; ks < 8; ++ks) a = __builtin_amdgcn_mfma_f32_16x16x32_bf16(*(const LAS bf16x8*)(kp + (((4 * ks + fq) ^ kx) * 16)), *(const LAS bf16x8*)(qp + 2048 * ks), a, 0, 0, 0);
            const int s0 = 16 * si + 4 * fq, t = 16 * ti + fr;
            u32x2 w; w.x = pk2(s0 + 0 <= t ? a[0] : 0.f, s0 + 1 <= t ? a[1] : 0.f); w.y = pk2(s0 + 2 <= t ? a[2] : 0.f, s0 + 3 <= t ? a[3] : 0.f);
            *(LAS u32x2*)(ATT + t * 64 + s0 * 2) = w;
        }
        SC_BAR();

        f32x16 o = zero16();
        LAS unsigned char* vb = buf + SC_VI + (8 * h + q) * 512 + (4 * (wave ^ q) + 2 * jb + (pp >> 1)) * 16 + (pp & 1) * 8;
        const bf16x8 vf0 = cat8(tr_read(vb), tr_read(vb + 4 * 512)), vf1 = cat8(tr_read(vb + 16 * 512), tr_read(vb + 20 * 512));
        {
            LAS unsigned char* ab = ATT + c * 64 + 16 * h;
            o = MFMA32(vf0, *(const LAS bf16x8*)ab, o);
            o = MFMA32(vf1, *(const LAS bf16x8*)(ab + 32), o);
            LAS unsigned char* qa = buf + SC_QI + c * 16 + 8 * h;
#pragma unroll
            for (int db = 0; db < 8; ++db) {
                { const bf16x8 qf = lds_perm(qa + 2048 * db); o = MFMA32(pack_step<0>(S[db]), qf, o); }
                { const bf16x8 qf = lds_perm(qa + 2048 * db + 1024); o = MFMA32(pack_step<1>(S[db]), qf, o); }
                if ((db & 3) == 3) __builtin_amdgcn_sched_barrier(0);
            }
            const int t = row0 + c;
            float ss = 0.f;
#pragma unroll
            for (int r = 0; r < 16; ++r) ss += o[r] * o[r];
            { const auto sw = __builtin_amdgcn_permlane32_swap(__float_as_uint(ss), __float_as_uint(ss), false, false); ss = __uint_as_float(sw[0]) + __uint_as_float(sw[1]); }
            if (h == 0) OSS[(size_t)t * 64 + hd * 16 + sl] = ss;
            bf16_t* og = OG + (size_t)row0 * VW + hd * 512 + 32 * sl + c * VW + 4 * h;
#pragma unroll
            for (int g = 0; g < 4; ++g) { u32x2 w; w.x = pk2(o[4 * g + 0], o[4 * g + 1]); w.y = pk2(o[4 * g + 2], o[4 * g + 3]); *(u32x2*)(og + 8 * g) = w; }
        }
        __builtin_amdgcn_sched_barrier(0);

        {
            LAS unsigned char* kbase = buf + SC_KI + (8 * h + q) * 512 + (2 * jb + (pp >> 1)) * 16 + (pp & 1) * 8;
            LAS unsigned char* lm = buf + SC_LMI + 16 * h;
#pragma unroll
            for (int db = 0; db < 8; ++db) {
                LAS unsigned char* kb = kbase + (((db & 3) ^ q) * 4) * 16 + (db >> 2) * 256;
                S[db] = MFMA32(cat8(tr_read(kb), tr_read(kb + 4 * 512)), vf0, S[db]);
                S[db] = MFMA32(cat8(tr_read(kb + 16 * 512), tr_read(kb + 20 * 512)), vf1, S[db]);
#pragma unroll
                for (int g = 0; g < 4; ++g) { const f32x4 l4 = *(const LAS f32x4*)(lm + (32 * db + 8 * g) * 4);
                    S[db][4 * g + 0] *= l4.x; S[db][4 * g + 1] *= l4.y; S[db][4 * g + 2] *= l4.z; S[db][4 * g + 3] *= l4.w; }
                if (db & 1) __builtin_amdgcn_sched_barrier(0);
            }
        }
        asm volatile("" ::: "memory");
        slot = (slot == 2) ? 0 : slot + 1;
    }
#undef SC_ISSUE
    {   const int lane = lane_id();
        const unsigned voff = (unsigned)(((lane >> 5) * 4 * DV + (lane & 31)) * 4);
        const char* gbase = (const char*)(p.out + O_GLAP + ((size_t)(b * NH + hd) * DK) * DV + 32 * sl);
#pragma unroll
        for (int db = 0; db < 8; ++db) {
#pragma unroll
            for (int r = 0; r < 16; ++r) { const int dl = 32 * db + (r & 3) + 8 * (r >> 2); *(float*)(const_cast<char*>(gbase) + (size_t)dl * DV * 4 + voff) = S[db][r]; }
        }
    }
    __syncthreads();
}

DI void sgla_task(const Params& p, int task, int lane) {
    unsigned char* ws = p.ws;
    const bf16_t* QB = (const bf16_t*)(ws + WS_QB); const bf16_t* KB = (const bf16_t*)(ws + WS_KB); const bf16_t* V = (const bf16_t*)(ws + WS_V);
    const float* LAM = (const float*)(ws + WS_LAM); float* OSP = (float*)(ws + WS_OSP);
    const int dblk = task & 7, hd = (task >> 3) & 3, b = task >> 5; const int row = MP + b;
    const size_t sbase = ((size_t)(b * NH + hd) * DK + 32 * dblk) * DV;
    const float* S0 = p.state_gla + sbase; float* So = p.out + O_GLAS + sbase;
    const int dl = lane & 31;
    const float lam_l = LAM[(size_t)(NCHK + b) * KW + hd * 256 + 32 * dblk + dl];
    const float k_l = bf1(KB[(size_t)row * KW + hd * 256 + 32 * dblk + dl]);
    const float q_l = bf1(QB[(size_t)row * KW + hd * 256 + 32 * dblk + dl]);
    f32x4 va, vb;
    { const u32x2 w = *(const u32x2*)(V + (size_t)row * VW + hd * 512 + 4 * lane); va = (f32x4){bflo(w.x), bfhi(w.x), bflo(w.y), bfhi(w.y)}; }
    { const u32x2 w = *(const u32x2*)(V + (size_t)row * VW + hd * 512 + 256 + 4 * lane); vb = (f32x4){bflo(w.x), bfhi(w.x), bflo(w.y), bfhi(w.y)}; }
    f32x4 oa = {0.f, 0.f, 0.f, 0.f}, ob = {0.f, 0.f, 0.f, 0.f};
#pragma unroll 1
    for (int d0 = 0; d0 < 32; d0 += 16) {
        f32x4 ra[16], rb[16];
#pragma unroll
        for (int i = 0; i < 16; ++i) { ra[i] = __builtin_nontemporal_load((const f32x4*)(S0 + (size_t)(d0 + i) * DV + 4 * lane)); rb[i] = __builtin_nontemporal_load((const f32x4*)(S0 + (size_t)(d0 + i) * DV + 256 + 4 * lane)); }
#pragma unroll
        for (int i = 0; i < 16; ++i) { const int d = d0 + i;
            const float lam = __uint_as_float(__builtin_amdgcn_readlane(__float_as_uint(lam_l), d)), kk = __uint_as_float(__builtin_amdgcn_readlane(__float_as_uint(k_l), d)), qq = __uint_as_float(__builtin_amdgcn_readlane(__float_as_uint(q_l), d));
            const f32x4 sa = ra[i] * lam + va * kk, sb = rb[i] * lam + vb * kk;
            __builtin_nontemporal_store(sa, (f32x4*)(So + (size_t)d * DV + 4 * lane)); __builtin_nontemporal_store(sb, (f32x4*)(So + (size_t)d * DV + 256 + 4 * lane));
            oa += sa * qq; ob += sb * qq; }
    }
    float* op = OSP + ((size_t)(b * NH + hd) * 8 + dblk) * DV;
    *(f32x4*)(op + 4 * lane) = oa; *(f32x4*)(op + 256 + 4 * lane) = ob;
}

DI void pmix_task(const Params& p, int t, int lane) {
    unsigned char* ws = p.ws;
    const float* U = (const float*)(ws + WS_U); bf16_t* PM = (bf16_t*)(ws + WS_PM);
    if (t < MP) {
        const int b = t >> 11, pos = t & 2047;
#pragma unroll
        for (int i = 0; i < 4; ++i) {
            const int w = 2 << i, c = 256 * i + 4 * lane; const int cnt = (pos + 1 < w) ? pos + 1 : w;
            const f32x4 u0 = *(const f32x4*)(U + (size_t)t * POOLW + c); f32x4 s = u0;
#pragma unroll
            for (int j = 1; j < w; ++j) {
                const bool in = j < cnt; const f32x4 v = *(const f32x4*)(U + (size_t)(in ? t - j : t) * POOLW + c); const float m = in ? 1.f : 0.f; s += v * m; }
            const float inv = 1.0f / (float)cnt; const f32x4 mx = s * inv - u0;
            u32x2 o; o.x = pk2(mx.x, mx.y); o.y = pk2(mx.z, mx.w); *(u32x2*)(PM + (size_t)t * POOLW + c) = o;
            if (pos >= SEQ - 15) *(f32x4*)(p.out + O_POOLP + ((size_t)b * 15 + (pos - (SEQ - 15))) * POOLW + c) = u0;
        }
    } else {
        const int b = t - MP; const float* sp = p.state_pool + (size_t)b * 15 * POOLW; float* po = p.out + O_POOLS + (size_t)b * 15 * POOLW;
#pragma unroll
        for (int i = 0; i < 4; ++i) {
            const int w = 2 << i, c = 256 * i + 4 * lane;
            const f32x4 u0 = *(const f32x4*)(U + (size_t)t * POOLW + c); f32x4 s = u0;
#pragma unroll
            for (int j = 1; j < w; ++j) s += *(const f32x4*)(sp + (size_t)(15 - j) * POOLW + c);
            const float inv = 1.0f / (float)w; const f32x4 mx = s * inv - u0;
            u32x2 o; o.x = pk2(mx.x, mx.y); o.y = pk2(mx.z, mx.w); *(u32x2*)(PM + (size_t)t * POOLW + c) = o;
            *(f32x4*)(po + (size_t)14 * POOLW + c) = u0;
        }
    }
}

DI void pool_copy_task(const Params& p, int item, int lane) {
    const int b = item / 14, r = item - 14 * b; const float* src = p.state_pool + ((size_t)b * 15 + r + 1) * POOLW + 4 * lane; float* dst = p.out + O_POOLS + ((size_t)b * 15 + r) * POOLW + 4 * lane;
    const f32x4 v0 = *(const f32x4*)src, v1 = *(const f32x4*)(src + 256), v2 = *(const f32x4*)(src + 512), v3 = *(const f32x4*)(src + 768);
    *(f32x4*)dst = v0; *(f32x4*)(dst + 256) = v1; *(f32x4*)(dst + 512) = v2; *(f32x4*)(dst + 768) = v3;
}
#ifndef P2_REP
#define P2_REP 0
#endif
DI void scan_role(const Params& p, LAS unsigned char* lds, int wave, int idx, int n) {
    for (int rep = 0; rep < ((P2_REP & 1) ? 2 : 1); ++rep) for (int task = (n == 32) ? (idx % 8) * 4 + idx / 8 : idx; task < 2 * NB * NH; task += n) scan_block(p, lds, task, wave);
}
DI void stream_role(const Params& p, int wave, int idx, int n) {
    const int lane = lane_id(); const int gw = idx * NWAVES + wave, NGW = n * NWAVES;
    for (int rep = 0; rep < ((P2_REP & 2) ? 2 : 1); ++rep) {
        for (int it = gw; it < MS * 14; it += NGW) pool_copy_task(p, it, lane);
        for (int task = gw; task < MS * NH * 8; task += NGW) sgla_task(p, task, lane); }
}

DI void ogn_task(const Params& p, int t, int lane) {
    unsigned char* ws = p.ws;
    bf16_t* OG = (bf16_t*)(ws + WS_OG); const float* OSS = (const float*)(ws + WS_OSS); const float* OSP = (const float*)(ws + WS_OSP); const bf16_t* SR = (const bf16_t*)(ws + WS_SR);
    if (t < MP) {
#pragma unroll
        for (int hd = 0; hd < 4; ++hd) {
            const float* sp = OSS + (size_t)t * 64 + hd * 16; const f32x4 a = *(const f32x4*)sp, b = *(const f32x4*)(sp + 4), c = *(const f32x4*)(sp + 8), d = *(const f32x4*)(sp + 12);
            const float ss = ((a.x + a.y) + (a.z + a.w)) + ((b.x + b.y) + (b.z + b.w)) + ((c.x + c.y) + (c.z + c.w)) + ((d.x + d.y) + (d.z + d.w));
            const float rstd = 1.0f / sqrtf(ss * (1.0f / DV) + EPS);
            bf16_t* op = OG + (size_t)t * VW + hd * 512 + 8 * lane; const u32x4 w = *(const u32x4*)op; const u32x4 g = *(const u32x4*)(SR + (size_t)t * VW + hd * 512 + 8 * lane);
            u32x4 o; o.x = pk2(bflo(w.x) * rstd * bflo(g.x), bfhi(w.x) * rstd * bfhi(g.x)); o.y = pk2(bflo(w.y) * rstd * bflo(g.y), bfhi(w.y) * rstd * bfhi(g.y));
            o.z = pk2(bflo(w.z) * rstd * bflo(g.z), bfhi(w.z) * rstd * bfhi(g.z)); o.w = pk2(bflo(w.w) * rstd * bflo(g.w), bfhi(w.w) * rstd * bfhi(g.w));
            *(u32x4*)op = o;
        }
    } else {
        const int b = t - MP;
#pragma unroll
        for (int hd = 0; hd < 4; ++hd) {
            f32x4 oa = {0.f, 0.f, 0.f, 0.f}, ob = {0.f, 0.f, 0.f, 0.f};
#pragma unroll
            for (int k = 0; k < 8; ++k) { const float* op = OSP + ((size_t)(b * NH + hd) * 8 + k) * DV + 8 * lane; oa += *(const f32x4*)op; ob += *(const f32x4*)(op + 4); }
            float ss = (oa.x * oa.x + oa.y * oa.y) + (oa.z * oa.z + oa.w * oa.w) + (ob.x * ob.x + ob.y * ob.y) + (ob.z * ob.z + ob.w * ob.w);
            ss = wave_sum(ss);
            const float rstd = 1.0f / sqrtf(ss * (1.0f / DV) + EPS);
            const u32x4 w = *(const u32x4*)(SR + (size_t)t * VW + hd * 512 + 8 * lane);
            u32x4 o; o.x = pk2(oa.x * rstd * bflo(w.x), oa.y * rstd * bfhi(w.x)); o.y = pk2(oa.z * rstd * bflo(w.y), oa.w * rstd * bfhi(w.y));
            o.z = pk2(ob.x * rstd * bflo(w.z), ob.y * rstd * bfhi(w.z)); o.w = pk2(ob.z * rstd * bflo(w.w), ob.w * rstd * bfhi(w.w));
            *(u32x4*)(OG + (size_t)t * VW + hd * 512 + 8 * lane) = o;
        }
    }
}
DI void phase_p3(const Params& p, int wave) {
    const int lane = lane_id();
    const int gw = (int)blockIdx.x * NWAVES + wave, NGW = gridDim.x * NWAVES;
    for (int t = gw; t < M; t += NGW) pmix_task(p, t, lane);
    for (int t = gw; t < M; t += NGW) ogn_task(p, t, lane);
}

DI float row_rstd(const float* SS, const float* SSs, int row, int lane) {
    float v = (row < MP) ? ((lane < 32) ? SS[(size_t)row * 32 + lane] : 0.f) : (SSs[(size_t)(row - MP) * 128 + lane] + SSs[(size_t)(row - MP) * 128 + 64 + lane]);
    v = wave_sum(v);
    return 1.0f / sqrtf(v * (1.0f / D) + EPS);
}

struct F8 { f32x4 a, b; };
DI F8 unpack8(u32x4 w, float s) { F8 r; r.a = (f32x4){bflo(w.x) * s, bfhi(w.x) * s, bflo(w.y) * s, bfhi(w.y) * s}; r.b = (f32x4){bflo(w.z) * s, bfhi(w.z) * s, bflo(w.w) * s, bfhi(w.w) * s}; return r; }
DI F8 ld8(const float* q) { F8 r; r.a = *(const f32x4*)q; r.b = *(const f32x4*)(q + 4); return r; }
DI void st8(float* q, const F8& v) { *(f32x4*)q = v.a; *(f32x4*)(q + 4) = v.b; }
DI f32x4 silu4(f32x4 x) { return (f32x4){siluf_(x.x), siluf_(x.y), siluf_(x.z), siluf_(x.w)}; }
DI void conv_task(const Params& p, int t, int lane) {
    unsigned char* ws = p.ws;
    const bf16_t* GU = (const bf16_t*)(ws + WS_GU); const float* SS1 = (const float*)(ws + WS_SS1); const float* SS1S = (const float*)(ws + WS_SS1S); bf16_t* ACT = (bf16_t*)(ws + WS_ACT);
    const bool prompt = t < MP; const int b = prompt ? (t >> 11) : (t - MP), pos = prompt ? (t & 2047) : 2;
    const float r0 = row_rstd(SS1, SS1S, t, lane);
    const float r1 = (prompt && pos >= 1) ? row_rstd(SS1, SS1S, t - 1, lane) : 0.f;
    const float r2 = (prompt && pos >= 2) ? row_rstd(SS1, SS1S, t - 2, lane) : 0.f;
    const bf16_t* g0p = GU + (size_t)t * NUP; const bf16_t* g1p = GU + (size_t)((prompt && pos >= 1) ? t - 1 : t) * NUP; const bf16_t* g2p = GU + (size_t)((prompt && pos >= 2) ? t - 2 : t) * NUP;
    const float* sc = p.state_conv + (size_t)b * 2 * DFF;
    for (int v = lane; v < DFF / 8; v += 64) {
        const int ch0 = 8 * v, pn = ch0 >> 7, r = ch0 & 127, gcol = 256 * pn + r, ucol = gcol + 128;
        const F8 g0 = unpack8(*(const u32x4*)(g0p + gcol), r0), up = unpack8(*(const u32x4*)(g0p + ucol), r0);
        F8 g1, g2;
        if (prompt) { g1 = unpack8(*(const u32x4*)(g1p + gcol), r1); g2 = unpack8(*(const u32x4*)(g2p + gcol), r2); }
        else { g1 = ld8(sc + DFF + ch0); g2 = ld8(sc + ch0); }
        const F8 w0 = ld8(p.conv_w + ch0), w1 = ld8(p.conv_w + DFF + ch0), w2 = ld8(p.conv_w + 2 * DFF + ch0), cb = ld8(p.conv_b + ch0);
        const f32x4 ga = cb.a + w0.a * g2.a + w1.a * g1.a + w2.a * g0.a, gb = cb.b + w0.b * g2.b + w1.b * g1.b + w2.b * g0.b;
        const f32x4 aa = silu4(ga) * up.a, ab = silu4(gb) * up.b;
        u32x4 o; o.x = pk2(aa.x, aa.y); o.y = pk2(aa.z, aa.w); o.z = pk2(ab.x, ab.y); o.w = pk2(ab.z, ab.w);
        *(u32x4*)(ACT + (size_t)t * DFF + ch0) = o;
        if (prompt) { if (pos >= SEQ - 2) st8(p.out + O_CONVP + ((size_t)b * 2 + (pos - (SEQ - 2))) * DFF + ch0, g0); }
        else { float* co = p.out + O_CONVS + (size_t)b * 2 * DFF + ch0; st8(co, g1); st8(co + DFF, g0); }
    }
}
DI void conv_block_task(const Params& p, int rb, int vg, int lane) {
    unsigned char* ws = p.ws;
    const bf16_t* GU = (const bf16_t*)(ws + WS_GU); const float* SS1 = (const float*)(ws + WS_SS1); bf16_t* ACT = (bf16_t*)(ws + WS_ACT);
    const int t0 = 16 * rb, b = t0 >> 11, pos0 = t0 & 2047;
    float rr[18];
#pragma unroll
    for (int i = 0; i < 18; ++i) { const int t = t0 - 2 + i; float v = (lane < 32 && (i >= 2 || pos0 > 0)) ? SS1[(size_t)t * 32 + lane] : 0.f; v = wave_sum(v); rr[i] = (i >= 2 || pos0 > 0) ? 1.0f / sqrtf(v * (1.0f / D) + EPS) : 0.f; }
    const int v = vg * 64 + lane; if (v >= DFF / 8) return;
    const int ch0 = 8 * v, pn = ch0 >> 7, r = ch0 & 127, gcol = 256 * pn + r, ucol = gcol + 128;
    const F8 w0 = ld8(p.conv_w + ch0), w1 = ld8(p.conv_w + DFF + ch0), w2 = ld8(p.conv_w + 2 * DFF + ch0), cb = ld8(p.conv_b + ch0);
    const bf16_t* gp = GU + (size_t)t0 * NUP + gcol; const bf16_t* up_ = GU + (size_t)t0 * NUP + ucol;
    F8 g2 = unpack8(*(const u32x4*)(gp - (pos0 > 0 ? 2 : 0) * (size_t)NUP), rr[0]), g1 = unpack8(*(const u32x4*)(gp - (pos0 > 0 ? 1 : 0) * (size_t)NUP), rr[1]);
#pragma unroll 1
    for (int h = 0; h < 2; ++h) {
        u32x4 gw[8], uw[8];
#pragma unroll
        for (int i = 0; i < 8; ++i) { gw[i] = *(const u32x4*)(gp + (size_t)(8 * h + i) * NUP); uw[i] = *(const u32x4*)(up_ + (size_t)(8 * h + i) * NUP); }
#pragma unroll
        for (int i = 0; i < 8; ++i) { const int ii = 8 * h + i; const float r0 = (h == 0) ? rr[2 + i] : rr[10 + i];
            const F8 g0 = unpack8(gw[i], r0), up = unpack8(uw[i], r0);
            const f32x4 ga = cb.a + w0.a * g2.a + w1.a * g1.a + w2.a * g0.a, gb = cb.b + w0.b * g2.b + w1.b * g1.b + w2.b * g0.b;
            const f32x4 aa = silu4(ga) * up.a, ab = silu4(gb) * up.b;
            u32x4 o; o.x = pk2(aa.x, aa.y); o.y = pk2(aa.z, aa.w); o.z = pk2(ab.x, ab.y); o.w = pk2(ab.z, ab.w);
            *(u32x4*)(ACT + (size_t)(t0 + ii) * DFF + ch0) = o;
            if (pos0 + ii >= SEQ - 2) st8(p.out + O_CONVP + ((size_t)b * 2 + (pos0 + ii - (SEQ - 2))) * DFF + ch0, g0);
            g2 = g1; g1 = g0; }
    }
}
DI void phase_conv(const Params& p, int wave) {
    const int lane = lane_id();
    const int gw = (int)blockIdx.x * NWAVES + wave, NGW = gridDim.x * NWAVES;
    constexpr int NVG = (DFF / 8 + 63) / 64;
    for (int t = MP + gw; t < M; t += NGW) conv_task(p, t, lane);
    for (int it = gw; it < (MP / 16) * NVG; it += NGW) conv_block_task(p, it / NVG, it % NVG, lane);
}

DI void phase_final(const Params& p, int wave) {
    const int lane = lane_id();
    const int gw = (int)blockIdx.x * NWAVES + wave, NGW = gridDim.x * NWAVES;
    const float* H3 = (const float*)(p.ws + WS_H3); const float* SS3 = (const float*)(p.ws + WS_SS3); const float* SS3S = (const float*)(p.ws + WS_SS3S);
    for (int t = gw; t < M; t += NGW) {
        const float rs = row_rstd(SS3, SS3S, t, lane);
        float* yo = (t < MP) ? p.out + O_YP + (size_t)t * D : p.out + O_YS + (size_t)(t - MP) * D;
#pragma unroll
        for (int i = 0; i < 8; ++i) { const int c = 256 * i + 4 * lane; const f32x4 hv = *(const f32x4*)(H3 + (size_t)t * D + c), g = *(const f32x4*)(p.norm_final + c);
            *(f32x4*)(yo + c) = hv * rs * g; }
    }
}

#define EPI_ARGS const f32x4 (&acc)[2][2][4][2], const g8::Unit& u, int wr, int wc, int fr, int fq
#define EPI_ROWS(ROWVAR) _Pragma("unroll") for (int ai = 0; ai < 2; ++ai) _Pragma("unroll") for (int m = 0; m < 4; ++m) { const int ROWVAR = u.pm * 256 + ai * 128 + wr * 64 + m * 16 + fr; if (ROWVAR < M) {
#define EPI_COLS(COLVAR) _Pragma("unroll") for (int bj = 0; bj < 2; ++bj) { const int COLVAR = bj * 128 + wc * 32 + 8 * fq; const f32x4 v0 = acc[ai][bj][m][0], v1 = acc[ai][bj][m][1];
#define EPI_END } } }
DI u32x4 pk8(f32x4 a, f32x4 b) { u32x4 o; o.x = pk2(a.x, a.y); o.y = pk2(a.z, a.w); o.z = pk2(b.x, b.y); o.w = pk2(b.z, b.w); return o; }
DI f32x4 exp4(f32x4 x) { return (f32x4){__expf(x.x), __expf(x.y), __expf(x.z), __expf(x.w)}; }
DI f32x4 sig4(f32x4 x) { return (f32x4){sigmoidf_(x.x), sigmoidf_(x.y), sigmoidf_(x.z), sigmoidf_(x.w)}; }
DI f32x4 bf4lo(u32x4 w) { return (f32x4){bflo(w.x), bfhi(w.x), bflo(w.y), bfhi(w.y)}; }
DI f32x4 bf4hi(u32x4 w) { return (f32x4){bflo(w.z), bfhi(w.z), bflo(w.w), bfhi(w.w)}; }
DI float sum4(f32x4 a) { return (a.x + a.y) + (a.z + a.w); }

struct PhaseIn {
    static constexpr int LDA = D, LDB = D, KT = D / 64;
    const Params& p; int G, c, part;
    int c0;
    DI bool next(int i, g8::Unit& u) const { int pm, pn;
        if (part == 0) { if (!g8::grid_order(NTM - 1, 16, G, c, i, pm, pn)) return false; }
        else { if (c < c0 || !g8::grid_order(NTM, 28, G - c0, c - c0, i, pm, pn)) return false; pn += 16; }
        u.pm = pm; u.pn = pn; u.A = (const char*)(p.ws + WS_XB) + (size_t)pm * 256 * D * 2; u.B = (const char*)(p.ws + WS_WIN) + (size_t)pn * 256 * D * 2; return true; }
    DI void epi(EPI_ARGS) const {
        unsigned char* ws = p.ws; const float* RSTD1 = (const float*)(ws + WS_RSTD1); const float* BCUM = (const float*)(ws + WS_BCUM);
        const int pn = u.pn;
        if (pn < 4) {
            bf16_t* QB = (bf16_t*)(ws + WS_QB);
            EPI_ROWS(row) const float rs = RSTD1[row] * 0.0625f; EPI_COLS(col) const size_t o = (size_t)row * KW + pn * 256 + col;
                const f32x4 e0 = exp4(*(const f32x4*)(BCUM + o)), e1 = exp4(*(const f32x4*)(BCUM + o + 4));
                *(u32x4*)(QB + o) = pk8(v0 * rs * e0, v1 * rs * e1); EPI_END
        } else if (pn < 8) {
            bf16_t* KB = (bf16_t*)(ws + WS_KB);
            EPI_ROWS(row) const float rs = RSTD1[row]; EPI_COLS(col) const size_t o = (size_t)row * KW + (pn - 4) * 256 + col;
                const f32x4 b0 = *(const f32x4*)(BCUM + o), b1 = *(const f32x4*)(BCUM + o + 4);
                *(u32x4*)(KB + o) = pk8(v0 * rs * exp4(-b0), v1 * rs * exp4(-b1)); EPI_END
        } else if (pn < 16) {
            bf16_t* V = (bf16_t*)(ws + WS_V);
            EPI_ROWS(row) const float rs = RSTD1[row]; EPI_COLS(col) *(u32x4*)(V + (size_t)row * VW + (pn - 8) * 256 + col) = pk8(v0 * rs, v1 * rs); EPI_END
        } else if (pn < 24) {
            bf16_t* SR = (bf16_t*)(ws + WS_SR);
            EPI_ROWS(row) const float rs = RSTD1[row]; EPI_COLS(col) const f32x4 a = v0 * rs, b = v1 * rs; *(u32x4*)(SR + (size_t)row * VW + (pn - 16) * 256 + col) = pk8(a * sig4(a), b * sig4(b)); EPI_END
        } else if (pn < 28) {
            float* U = (float*)(ws + WS_U);
            EPI_ROWS(row) const float rs = RSTD1[row]; EPI_COLS(col) float* o = U + (size_t)row * POOLW + (pn - 24) * 256 + col; *(f32x4*)o = v0 * rs; *(f32x4*)(o + 4) = v1 * rs; EPI_END
        } else {
            bf16_t* Gt = (bf16_t*)(ws + (pn < 36 ? WS_GA : WS_GB)); const int c0 = (pn < 36 ? pn - 28 : pn - 36) * 256;
            EPI_ROWS(row) const float rs = RSTD1[row]; EPI_COLS(col) *(u32x4*)(Gt + (size_t)row * D + c0 + col) = pk8(sig4(v0 * rs), sig4(v1 * rs)); EPI_END
        }
    }
};

template <int LDA_, int LDB_, int K_> struct PhaseN2048 {
    static constexpr int LDA = LDA_, LDB = LDB_, KT = K_ / 64;
    const Params& p; int G, c; size_t a_off, b_off;
    DI bool next_(int i, g8::Unit& u) const { int pm, pn; if (!g8::grid_order(NTM - 1, 8, G, c, i, pm, pn)) return false;
        u.pm = pm; u.pn = pn; u.A = (const char*)(p.ws + a_off) + (size_t)pm * 256 * LDA * 2; u.B = (const char*)(p.ws + b_off) + (size_t)pn * 256 * LDB * 2; return true; }
};
struct PhaseYb : PhaseN2048<POOLW, POOLW, POOLW> {
    DI bool next(int i, g8::Unit& u) const { return next_(i, u); }
    DI void epi(EPI_ARGS) const { const bf16_t* GB = (const bf16_t*)(p.ws + WS_GB); float* Y = (float*)(p.ws + WS_YBG);
#pragma unroll
        for (int ai = 0; ai < 2; ++ai) { u32x4 g[4][2];
#pragma unroll
            for (int m = 0; m < 4; ++m)
#pragma unroll
                for (int bj = 0; bj < 2; ++bj) g[m][bj] = *(const u32x4*)(GB + (size_t)(u.pm * 256 + ai * 128 + wr * 64 + m * 16 + fr) * D + u.pn * 256 + bj * 128 + wc * 32 + 8 * fq);
#pragma unroll
            for (int m = 0; m < 4; ++m)
#pragma unroll
                for (int bj = 0; bj < 2; ++bj) { const size_t o = (size_t)(u.pm * 256 + ai * 128 + wr * 64 + m * 16 + fr) * D + u.pn * 256 + bj * 128 + wc * 32 + 8 * fq;
                    *(f32x4*)(Y + o) = acc[ai][bj][m][0] * bf4lo(g[m][bj]); *(f32x4*)(Y + o + 4) = acc[ai][bj][m][1] * bf4hi(g[m][bj]); } } }
};
struct PhaseYa : PhaseN2048<VW, VW, VW> {
    DI bool next(int i, g8::Unit& u) const { return next_(i, u); }
    DI void epi(EPI_ARGS) const { const bf16_t* GA = (const bf16_t*)(p.ws + WS_GA); const float* Y = (const float*)(p.ws + WS_YBG); bf16_t* MB = (bf16_t*)(p.ws + WS_MB);
#pragma unroll
        for (int ai = 0; ai < 2; ++ai)
#pragma unroll
            for (int mh = 0; mh < 2; ++mh) { u32x4 g[2][2]; f32x4 y0[2][2], y1[2][2];
#pragma unroll
                for (int mm = 0; mm < 2; ++mm)
#pragma unroll
                    for (int bj = 0; bj < 2; ++bj) { const size_t o = (size_t)(u.pm * 256 + ai * 128 + wr * 64 + (2 * mh + mm) * 16 + fr) * D + u.pn * 256 + bj * 128 + wc * 32 + 8 * fq;
                        g[mm][bj] = *(const u32x4*)(GA + o); y0[mm][bj] = *(const f32x4*)(Y + o); y1[mm][bj] = *(const f32x4*)(Y + o + 4); }
#pragma unroll
                for (int mm = 0; mm < 2; ++mm)
#pragma unroll
                    for (int bj = 0; bj < 2; ++bj) { const int m = 2 * mh + mm; const size_t o = (size_t)(u.pm * 256 + ai * 128 + wr * 64 + m * 16 + fr) * D + u.pn * 256 + bj * 128 + wc * 32 + 8 * fq;
                        *(u32x4*)(MB + o) = pk8(acc[ai][bj][m][0] * bf4lo(g[mm][bj]) + y0[mm][bj], acc[ai][bj][m][1] * bf4hi(g[mm][bj]) + y1[mm][bj]); } } }
};
DI void epi_residual(EPI_ARGS, const float* base_p, float* H, bf16_t* HB, float* SS) {
#pragma unroll
    for (int ai = 0; ai < 2; ++ai)
#pragma unroll
        for (int mh = 0; mh < 2; ++mh) {
            f32x4 b0[2][2], b1[2][2];
#pragma unroll
            for (int mm = 0; mm < 2; ++mm) { const int row = u.pm * 256 + ai * 128 + wr * 64 + (2 * mh + mm) * 16 + fr;
#pragma unroll
                for (int bj = 0; bj < 2; ++bj) { const size_t o = (size_t)row * D + u.pn * 256 + bj * 128 + wc * 32 + 8 * fq; b0[mm][bj] = *(const f32x4*)(base_p + o); b1[mm][bj] = *(const f32x4*)(base_p + o + 4); } }
#pragma unroll
            for (int mm = 0; mm < 2; ++mm) { const int m = 2 * mh + mm; const int row = u.pm * 256 + ai * 128 + wr * 64 + m * 16 + fr; float ss = 0.f;
#pragma unroll
                for (int bj = 0; bj < 2; ++bj) { const size_t o = (size_t)row * D + u.pn * 256 + bj * 128 + wc * 32 + 8 * fq;
                    const f32x4 h0 = acc[ai][bj][m][0] + b0[mm][bj], h1 = acc[ai][bj][m][1] + b1[mm][bj];
                    *(f32x4*)(H + o) = h0; *(f32x4*)(H + o + 4) = h1; *(u32x4*)(HB + o) = pk8(h0, h1);
                    ss += sum4(h0 * h0) + sum4(h1 * h1); }
                ss += __shfl_xor(ss, 16); ss += __shfl_xor(ss, 32);
                if (fq == 0) SS[(size_t)row * 32 + u.pn * 4 + wc] = ss; }
        }
}
struct PhaseOut : PhaseN2048<D, D, D> {
    DI bool next(int i, g8::Unit& u) const { return next_(i, u); }
    DI void epi(EPI_ARGS) const { epi_residual(acc, u, wr, wc, fr, fq, p.x_prompt, (float*)(p.ws + WS_H1), (bf16_t*)(p.ws + WS_H1B), (float*)(p.ws + WS_SS1)); }
};
struct PhaseDown : PhaseN2048<DFF, DFF, DFF> {
    DI bool next(int i, g8::Unit& u) const { return next_(i, u); }
    DI void epi(EPI_ARGS) const { epi_residual(acc, u, wr, wc, fr, fq, (const float*)(p.ws + WS_H1), (float*)(p.ws + WS_H2), (bf16_t*)(p.ws + WS_H2B), (float*)(p.ws + WS_SS2)); }
};
struct PhasePe : PhaseN2048<PLE, PLE, PLE> {
    DI bool next(int i, g8::Unit& u) const { const int first = (NTM * 43) % G, nfree = G - first; if (nfree <= 0 || c < first) return false;
        const long L = (long)i * nfree + (c - first); if (L >= 256) return false; const int pm = (int)L >> 3, pn = (int)L & 7;
        u.pm = pm; u.pn = pn; u.A = (const char*)(p.ws + a_off) + (size_t)pm * 256 * LDA * 2; u.B = (const char*)(p.ws + b_off) + (size_t)pn * 256 * LDB * 2; return true; }
    DI void epi(EPI_ARGS) const { float* PE = (float*)(p.ws + WS_PE);
        EPI_ROWS(row) EPI_COLS(col) const size_t o = (size_t)row * D + u.pn * 256 + col; *(f32x4*)(PE + o) = v0; *(f32x4*)(PE + o + 4) = v1; EPI_END }
};
struct PhasePg : PhaseN2048<D, D, D> {
    DI bool next(int i, g8::Unit& u) const { return next_(i, u); }
    DI void epi(EPI_ARGS) const { const float* H2 = (const float*)(p.ws + WS_H2); const float* PE = (const float*)(p.ws + WS_PE); const float* SS2 = (const float*)(p.ws + WS_SS2);
        float* H3 = (float*)(p.ws + WS_H3); float* SS3 = (float*)(p.ws + WS_SS3);
#pragma unroll
        for (int ai = 0; ai < 2; ++ai)
#pragma unroll
            for (int m = 0; m < 4; ++m) { f32x4 hA[2], hB[2], pA[2], pB[2];
                const int row = u.pm * 256 + ai * 128 + wr * 64 + m * 16 + fr; float s2 = 0.f;
#pragma unroll
                for (int k = 0; k < 8; ++k) s2 += sum4(*(const f32x4*)(SS2 + (size_t)row * 32 + 4 * k));
                const float rs = 1.0f / sqrtf(s2 * (1.0f / D) + EPS);
#pragma unroll
                for (int bj = 0; bj < 2; ++bj) { const size_t o = (size_t)row * D + u.pn * 256 + bj * 128 + wc * 32 + 8 * fq;
                    hA[bj] = *(const f32x4*)(H2 + o); hB[bj] = *(const f32x4*)(H2 + o + 4); pA[bj] = *(const f32x4*)(PE + o); pB[bj] = *(const f32x4*)(PE + o + 4); }
                float ss = 0.f;
#pragma unroll
                for (int bj = 0; bj < 2; ++bj) { const size_t o = (size_t)row * D + u.pn * 256 + bj * 128 + wc * 32 + 8 * fq;
                    const f32x4 h0 = hA[bj] + sig4(acc[ai][bj][m][0] * rs) * pA[bj], h1 = hB[bj] + sig4(acc[ai][bj][m][1] * rs) * pB[bj];
                    *(f32x4*)(H3 + o) = h0; *(f32x4*)(H3 + o + 4) = h1; ss += sum4(h0 * h0) + sum4(h1 * h1); }
                ss += __shfl_xor(ss, 16); ss += __shfl_xor(ss, 32);
                if (fq == 0) SS3[(size_t)row * 32 + u.pn * 4 + wc] = ss; } }
};
struct PhaseUp {
    static constexpr int LDA = D, LDB = D, KT = D / 64;
    const Params& p; int G, c;
    DI bool next(int i, g8::Unit& u) const { int pm, pn; if (!g8::grid_order(NTM, 43, G, c, i, pm, pn)) return false;
        u.pm = pm; u.pn = pn; u.A = (const char*)(p.ws + WS_H1B) + (size_t)pm * 256 * D * 2; u.B = (const char*)(p.ws + WS_WUP) + (size_t)pn * 256 * D * 2; return true; }
    DI void epi(EPI_ARGS) const { bf16_t* GU = (bf16_t*)(p.ws + WS_GU);
        EPI_ROWS(row) EPI_COLS(col) *(u32x4*)(GU + (size_t)row * NUP + u.pn * 256 + col) = pk8(v0, v1); EPI_END }
};

struct PhaseWpb {
    static constexpr int LDA = POOLW, LDB = 256, KT = 4;
    const Params& p; int G, c;
    DI bool next(int i, g8::Unit& u) const { const int off = 220 % G; const long L = (long)i * G + ((c + G - off) % G); if (L >= 32) return false;
        const int pm = (int)L >> 2, g = (int)L & 3; u.pm = pm; u.pn = g;
        u.A = (const char*)(p.ws + WS_WBT) + ((size_t)pm * 256 * POOLW + g * 256) * 2; u.B = (const char*)(p.ws + WS_WPS) + (size_t)g * 256 * 256 * 2; return true; }
    DI void epi(EPI_ARGS) const { bf16_t* W = (bf16_t*)(p.ws + WS_WPB);
        EPI_ROWS(row) EPI_COLS(col) *(u32x4*)(W + (size_t)row * POOLW + u.pn * 256 + col) = pk8(v0, v1); EPI_END }
};

template <int KS, int LDA, int LDB>
DI f32x4 skinny16(const bf16_t* A, const bf16_t* W, int lane) {
    const int fr = lane & 15, fq = lane >> 4;
    const bf16_t* ap = A + (size_t)fr * LDA + 8 * fq; const bf16_t* bp = W + (size_t)fr * LDB + 8 * fq;
    f32x4 acc = {0.f, 0.f, 0.f, 0.f};
#pragma unroll 4
    for (int s = 0; s < KS; ++s) { const bf16x8 a = *(const bf16x8*)(ap + 32 * s), b = *(const bf16x8*)(bp + 32 * s); acc = __builtin_amdgcn_mfma_f32_16x16x32_bf16(a, b, acc, 0, 0, 0); }
    return acc;
}
DI float sum16(float v) { v += __shfl_xor(v, 1); v += __shfl_xor(v, 2); v += __shfl_xor(v, 4); v += __shfl_xor(v, 8); return v; }
template <int KIND, int K, int LDA, int LDB, int NCG = 128>
DI void sample_gemm(const Params& p, LAS unsigned char* lds, size_t a_off, size_t w_off, int wave) {
    unsigned char* ws = p.ws; const int lane = lane_id(), fr = lane & 15, fq = lane >> 4;
    constexpr int KS = K / 64;
    for (int it = blockIdx.x; it < 2 * NCG; it += gridDim.x) {
        const int cg_ = it >> 1, r0 = MP + 64 * (it & 1) + 16 * (wave & 3), col = 16 * cg_ + fr, kh = wave >> 2;
        f32x4 acc = skinny16<KS, LDA, LDB>((const bf16_t*)(ws + a_off) + (size_t)r0 * LDA + kh * (K / 2), (const bf16_t*)(ws + w_off) + (size_t)(16 * cg_) * LDB + kh * (K / 2), lane);
        LAS f32x4* xch = (LAS f32x4*)lds;
        if (kh == 1) xch[(wave & 3) * 64 + lane] = acc;
        __syncthreads();
        if (kh == 0) {
        acc += xch[wave * 64 + lane];
        float rs[4] = {0.f, 0.f, 0.f, 0.f};
        if (KIND == 5) {
            const float* SS2S = (const float*)(ws + WS_SS2S);
#pragma unroll
            for (int r = 0; r < 16; ++r) { const float* q = SS2S + (size_t)(r0 - MP + r) * 128; const float s_ = wave_sum(q[lane] + q[64 + lane]); const float rr = 1.0f / sqrtf(s_ * (1.0f / D) + EPS);
#pragma unroll
                for (int j = 0; j < 4; ++j) rs[j] = (r == 4 * fq + j) ? rr : rs[j]; }
        }
#pragma unroll
        for (int j = 0; j < 4; ++j) {
            const int row = r0 + 4 * fq + j; const size_t o = (size_t)row * D + col; const float v = acc[j]; float hsq = 0.f;
            if (KIND == 6) { const float val = v * ((const float*)(ws + WS_RSTD1))[row];
                if (col < KW) ((bf16_t*)(ws + WS_QB))[(size_t)row * KW + col] = (bf16_t)(pk2(val * 0.0625f, 0.f) & 0xffffu);
                else if (col < 2 * KW) ((bf16_t*)(ws + WS_KB))[(size_t)row * KW + col - KW] = (bf16_t)(pk2(val, 0.f) & 0xffffu);
                else ((bf16_t*)(ws + WS_V))[(size_t)row * VW + col - 2 * KW] = (bf16_t)(pk2(val, 0.f) & 0xffffu); }
            if (KIND == 0) { ((float*)(ws + WS_YBG))[o] = v * bf1(((const bf16_t*)(ws + WS_GB))[o]); }
            if (KIND == 1) { ((bf16_t*)(ws + WS_MB))[o] = (bf16_t)(pk2(v * bf1(((const bf16_t*)(ws + WS_GA))[o]) + ((const float*)(ws + WS_YBG))[o], 0.f) & 0xffffu); }
            if (KIND == 2) { const float hv = p.x_sample[(size_t)(row - MP) * D + col] + v; ((float*)(ws + WS_H1))[o] = hv; ((bf16_t*)(ws + WS_H1B))[o] = (bf16_t)(pk2(hv, 0.f) & 0xffffu); hsq = hv * hv; }
            if (KIND == 3) { const float hv = ((const float*)(ws + WS_H1))[o] + v; ((float*)(ws + WS_H2))[o] = hv; ((bf16_t*)(ws + WS_H2B))[o] = (bf16_t)(pk2(hv, 0.f) & 0xffffu); hsq = hv * hv; }
            if (KIND == 4) { ((float*)(ws + WS_PE))[o] = v; }
            if (KIND == 5) { const float hv = ((const float*)(ws + WS_H2))[o] + sigmoidf_(v * rs[j]) * ((const float*)(ws + WS_PE))[o]; ((float*)(ws + WS_H3))[o] = hv; hsq = hv * hv; }
            if (KIND == 2 || KIND == 3 || KIND == 5) { const float t = sum16(hsq);
                float* SSx = (float*)(ws + (KIND == 2 ? WS_SS1S : (KIND == 3 ? WS_SS2S : WS_SS3S))); if (fr == 0) SSx[(size_t)(row - MP) * 128 + cg_] = t; }
        }
        }
        __syncthreads();
    }
}


#define XB_TMO      128
#define XB_XCNT(j)  (256  + 64 * (j))
#define XB_XSUB(j)  (1280 + 64 * (j))
#define XB_XGEN(j)  (2304 + 64 * (j))
#define XB_TOP      3328
#define XB_TOPGEN   3392
#define XCD_BAR_WORDS 3456
#define XB_SPIN_CAP (1u << 22)
DI unsigned xb_ld(unsigned* p)              { return __hip_atomic_load(p, __ATOMIC_RELAXED, __HIP_MEMORY_SCOPE_AGENT); }
DI unsigned xb_add(unsigned* p, unsigned v) { return __hip_atomic_fetch_add(p, v, __ATOMIC_RELAXED, __HIP_MEMORY_SCOPE_AGENT); }
DI unsigned xb_xcc_id() { return (unsigned)__builtin_amdgcn_s_getreg((3 << 11) | 20) & 0xFu; }
#define XB_SPIN(cond, bar) do { unsigned _sp = 0; while (cond) { __builtin_amdgcn_s_sleep(1); \
    if ((++_sp & 255u) == 0u) { if (xb_ld(&(bar)[XB_TMO])) break; if (_sp > XB_SPIN_CAP) { atomicAdd(&(bar)[XB_TMO], 1u); break; } } } } while (0)
struct XcdBarrier { unsigned* bar; unsigned x; volatile LAS unsigned* st; };
DI XcdBarrier xcd_barrier_post(unsigned* bar, volatile LAS unsigned* st, bool t0) {
    XcdBarrier b; b.bar = bar; b.x = xb_xcc_id(); b.st = st;
    if (t0) (void)xb_add(&bar[XB_XCNT(b.x)], 1u);
    return b;
}
DI void xcd_barrier_complete(unsigned* bar, unsigned x, unsigned& nloc, unsigned& nx) {
    const unsigned G = gridDim.x * gridDim.y * gridDim.z;
    unsigned sum, cnt, mine, sp = 0u;
    for (;;) {
        sum = 0u; cnt = 0u; mine = 0u;
#pragma unroll
        for (unsigned j = 0; j < 16; ++j) { const unsigned c = xb_ld(&bar[XB_XCNT(j)]); sum += c; cnt += (c > 0u) ? 1u : 0u; mine = (j == x) ? c : mine; }
        if (sum == G) break;
        __builtin_amdgcn_s_sleep(1);
        if ((++sp & 255u) == 0u) { if (xb_ld(&bar[XB_TMO])) break; if (sp > XB_SPIN_CAP) { atomicAdd(&bar[XB_TMO], 1u); break; } }
    }
    nloc = mine > 0u ? mine : 1u; nx = cnt > 0u ? cnt : 1u;
}
DI void xcd_barrier(const XcdBarrier& b, bool t0) {
    asm volatile("s_waitcnt vmcnt(0)" ::: "memory");
    __syncthreads();
    if (t0) {
        unsigned* bar = b.bar;
        __builtin_amdgcn_s_waitcnt(0);
        unsigned nloc = b.st[0], nx = b.st[1];
        if (nloc == 0u) { xcd_barrier_complete(bar, b.x, nloc, nx); b.st[0] = nloc; b.st[1] = nx; }
        const unsigned old = xb_add(&bar[XB_XSUB(b.x)], 1u);
        const unsigned gen = old / nloc;
        if (old + 1u == (gen + 1u) * nloc) {
            __builtin_amdgcn_fence(__ATOMIC_RELEASE, "agent");
            asm volatile("s_waitcnt vmcnt(0)" ::: "memory");
            const unsigned og = xb_add(&bar[XB_TOP], 1u);
            const unsigned tg = og / nx;
            if (og + 1u == (tg + 1u) * nx) xb_add(&bar[XB_TOPGEN], 1u);
            else XB_SPIN(xb_ld(&bar[XB_TOPGEN]) == tg, bar);
            __builtin_amdgcn_fence(__ATOMIC_ACQUIRE, "agent");
            xb_add(&bar[XB_XGEN(b.x)], 1u);
            asm volatile("s_waitcnt vmcnt(0)" ::: "memory");
        } else {
            XB_SPIN(xb_ld(&bar[XB_XGEN(b.x)]) == gen, bar);
            __builtin_amdgcn_fence(__ATOMIC_ACQUIRE, "agent");
            asm volatile("s_waitcnt vmcnt(0)" ::: "memory");
        }
    }
    __syncthreads();
}

constexpr int N_PHASES = 13;
#ifndef G8_SP2
#define G8_SP2 true
#endif
#ifndef G8_ALIGN
#define G8_ALIGN true
#endif

__global__ void __launch_bounds__(NTHREADS, 2) fwd_kernel(Params p) {
    extern __shared__ __attribute__((aligned(16))) unsigned char lds_raw[];
    LAS unsigned char* lds = (LAS unsigned char*)lds_raw;
    const int G = gridDim.x, c = blockIdx.x;
    const int wave = __builtin_amdgcn_readfirstlane(threadIdx.x >> 6);
    const int lo = p.ph_lo, hi = p.ph_hi;
#ifndef REPEAT_MASK
#define REPEAT_MASK 0
#endif
#ifndef PHASE_MASK
#define PHASE_MASK 0x1bff
#endif
#define IN(k) (((PHASE_MASK >> (k)) & 1) && lo <= (k) && (k) < hi)
    volatile LAS unsigned* bst = (volatile LAS unsigned*)(lds + LDS_MISC);
    const bool t0 = (wave == 0) && (lane_id() == 0);
    XcdBarrier bar; bar.bar = (unsigned*)(p.ws + WS_CTL); bar.x = 0; bar.st = bst;
    if (hi - lo > 1) { if (t0) { bst[0] = 0u; bst[1] = 0u; } __syncthreads(); bar = xcd_barrier_post((unsigned*)(p.ws + WS_CTL), bst, t0); }
#define NEXTPH(k) ((k) == 9 ? 11 : (k) + 1)
#define SEAM(k) do { if (IN(k) && IN(NEXTPH(k))) { xcd_barrier(bar, (wave == 0) && (lane_id() == 0)); } } while (0)
    if (IN(0)) { phase_p0(p, lds, wave); if ((REPEAT_MASK >> 0) & 1) { xcd_barrier(bar, (wave == 0) && (lane_id() == 0)); phase_p0(p, lds, wave); } } SEAM(0);
    if (IN(1)) { sample_gemm<6, D, D, D, 256>(p, lds, WS_XB, WS_WIN, wave); PhaseIn ph{p, G, c, 0, 0}; g8::run<PhaseIn, G8_ALIGN, G8_SP2>(lds, ph, wave); } SEAM(1);
    if (IN(2)) {
        if (G == 256) {
            if (c < 32) scan_role(p, lds, wave, c, 32);
            else if (c < 71) stream_role(p, wave, c - 32, 39);
            else { PhaseIn ph{p, G, c, 1, 71}; g8::run<PhaseIn, G8_ALIGN, G8_SP2>(lds, ph, wave); PhaseWpb pw{p, G, c}; g8::run<PhaseWpb, G8_ALIGN, G8_SP2>(lds, pw, wave); }
        } else {
            PhaseIn ph{p, G, c, 1, 0}; g8::run<PhaseIn, G8_ALIGN, G8_SP2>(lds, ph, wave); PhaseWpb pw{p, G, c}; g8::run<PhaseWpb, G8_ALIGN, G8_SP2>(lds, pw, wave);
            scan_role(p, lds, wave, c, G); stream_role(p, wave, c, G);
        }
    } SEAM(2);
    if (IN(3)) { phase_p3(p, wave); if ((REPEAT_MASK >> 3) & 1) { xcd_barrier(bar, (wave == 0) && (lane_id() == 0)); phase_p3(p, wave); } } SEAM(3);
    if (IN(4)) { sample_gemm<0, POOLW, POOLW, POOLW>(p, lds, WS_PM, WS_WPB, wave); PhaseYb ph{{p, G, c, WS_PM, WS_WPB}}; g8::run<PhaseYb, G8_ALIGN, G8_SP2>(lds, ph, wave); if ((REPEAT_MASK >> 4) & 1) { xcd_barrier(bar, (wave == 0) && (lane_id() == 0)); sample_gemm<0, POOLW, POOLW, POOLW>(p, lds, WS_PM, WS_WPB, wave); PhaseYb ph{{p, G, c, WS_PM, WS_WPB}}; g8::run<PhaseYb, G8_ALIGN, G8_SP2>(lds, ph, wave); } } SEAM(4);
    if (IN(5)) { sample_gemm<1, VW, VW, VW>(p, lds, WS_OG, WS_WA, wave); PhaseYa ph{{p, G, c, WS_OG, WS_WA}}; g8::run<PhaseYa, G8_ALIGN, G8_SP2>(lds, ph, wave); if ((REPEAT_MASK >> 5) & 1) { xcd_barrier(bar, (wave == 0) && (lane_id() == 0)); sample_gemm<1, VW, VW, VW>(p, lds, WS_OG, WS_WA, wave); PhaseYa ph{{p, G, c, WS_OG, WS_WA}}; g8::run<PhaseYa, G8_ALIGN, G8_SP2>(lds, ph, wave); } } SEAM(5);
    if (IN(6)) { sample_gemm<2, D, D, D>(p, lds, WS_MB, WS_WO, wave); PhaseOut ph{{p, G, c, WS_MB, WS_WO}}; g8::run<PhaseOut, G8_ALIGN, G8_SP2>(lds, ph, wave); if ((REPEAT_MASK >> 6) & 1) { xcd_barrier(bar, (wave == 0) && (lane_id() == 0)); sample_gemm<2, D, D, D>(p, lds, WS_MB, WS_WO, wave); PhaseOut ph{{p, G, c, WS_MB, WS_WO}}; g8::run<PhaseOut, G8_ALIGN, G8_SP2>(lds, ph, wave); } } SEAM(6);
    if (IN(7)) { PhaseUp ph{p, G, c}; g8::run<PhaseUp, G8_ALIGN, G8_SP2>(lds, ph, wave); sample_gemm<4, PLE, PLE, PLE>(p, lds, WS_PLB, WS_WPLE, wave); { PhasePe pe{{p, G, c, WS_PLB, WS_WPLE}}; g8::run<PhasePe, G8_ALIGN, G8_SP2>(lds, pe, wave); } if ((REPEAT_MASK >> 7) & 1) { xcd_barrier(bar, (wave == 0) && (lane_id() == 0)); PhaseUp ph{p, G, c}; g8::run<PhaseUp, G8_ALIGN, G8_SP2>(lds, ph, wave); } } SEAM(7);
    if (IN(8)) { phase_conv(p, wave); if ((REPEAT_MASK >> 8) & 1) { xcd_barrier(bar, (wave == 0) && (lane_id() == 0)); phase_conv(p, wave); } } SEAM(8);
    if (IN(9)) { sample_gemm<3, DFF, DFF, DFF>(p, lds, WS_ACT, WS_WD, wave); PhaseDown ph{{p, G, c, WS_ACT, WS_WD}}; g8::run<PhaseDown, G8_ALIGN, G8_SP2>(lds, ph, wave); if ((REPEAT_MASK >> 9) & 1) { xcd_barrier(bar, (wave == 0) && (lane_id() == 0)); sample_gemm<3, DFF, DFF, DFF>(p, lds, WS_ACT, WS_WD, wave); PhaseDown ph{{p, G, c, WS_ACT, WS_WD}}; g8::run<PhaseDown, G8_ALIGN, G8_SP2>(lds, ph, wave); } } SEAM(9);
    if (IN(11)) { sample_gemm<5, D, D, D>(p, lds, WS_H2B, WS_WPG, wave); PhasePg ph{{p, G, c, WS_H2B, WS_WPG}}; g8::run<PhasePg, G8_ALIGN, G8_SP2>(lds, ph, wave); if ((REPEAT_MASK >> 11) & 1) { xcd_barrier(bar, (wave == 0) && (lane_id() == 0)); sample_gemm<5, D, D, D>(p, lds, WS_H2B, WS_WPG, wave); PhasePg ph{{p, G, c, WS_H2B, WS_WPG}}; g8::run<PhasePg, G8_ALIGN, G8_SP2>(lds, ph, wave); } } SEAM(11);
    if (IN(12)) { phase_final(p, wave); if ((REPEAT_MASK >> 12) & 1) { xcd_barrier(bar, (wave == 0) && (lane_id() == 0)); phase_final(p, wave); } }
#undef IN
#undef SEAM
}

extern "C" void kernel_launch(void* const* d_in, const int* in_sizes, int n_in, void* d_out, int out_size, void* d_ws, size_t ws_size, hipStream_t stream) {
    static int grid = 0;
    if (grid == 0) {
        if (n_in != 26 || (size_t)out_size != O_END || ws_size < WS_END) {
            fprintf(stderr, "kernel_launch: unexpected problem: n_in %d out %d ws %zu (need %zu)\n", n_in, out_size, ws_size, (size_t)WS_END); grid = -1; return; }
        int dev = 0, cus = 0, per_cu = 0;
        if (hipGetDevice(&dev) != hipSuccess || hipDeviceGetAttribute(&cus, hipDeviceAttributeMultiprocessorCount, dev) != hipSuccess) { grid = -1; return; }
        if (hipFuncSetAttribute((const void*)fwd_kernel, hipFuncAttributeMaxDynamicSharedMemorySize, LDS_BYTES) != hipSuccess) { fprintf(stderr, "kernel_launch: hipFuncSetAttribute failed\n"); grid = -1; return; }
        if (hipOccupancyMaxActiveBlocksPerMultiprocessor(&per_cu, (const void*)fwd_kernel, NTHREADS, LDS_BYTES) != hipSuccess || per_cu < 1) {
            fprintf(stderr, "kernel_launch: occupancy query reports %d blocks per CU\n", per_cu); (void)hipGetLastError(); grid = -1; return; }
        grid = cus;
    }
    if (grid < 0) return;
    Params p{};
    const float** pp = (const float**)&p;
    for (int i = 0; i < 26; ++i) pp[i] = (const float*)d_in[i];
    p.out = (float*)d_out; p.ws = (unsigned char*)d_ws;
#if MK_N_LAUNCHES == 1
    p.ph_lo = 0; p.ph_hi = N_PHASES;
    void* args[] = {&p};
    if (hipMemsetAsync((char*)d_ws + WS_CTL, 0, XCD_BAR_WORDS * 4, stream) != hipSuccess) { fprintf(stderr, "kernel_launch: memset failed\n"); return; }
    hipError_t e = hipLaunchCooperativeKernel((const void*)fwd_kernel, dim3(grid), dim3(NTHREADS), args, LDS_BYTES, stream);
    if (e != hipSuccess) fprintf(stderr, "kernel_launch: cooperative launch failed: %s (grid %d)\n", hipGetErrorString(e), grid);
#else
    for (int k = 0; k < N_PHASES; ++k) { p.ph_lo = k; p.ph_hi = k + 1; hipLaunchKernelGGL(fwd_kernel, dim3(grid), dim3(NTHREADS), LDS_BYTES, stream, p); }
#endif
}
```

```cpp
#include <hip/hip_runtime.h>
#include <hip/hip_cooperative_groups.h>
#include <cstdio>
#include <cstdint>
namespace cg = cooperative_groups;

#ifndef MK_N_LAUNCHES
#define MK_N_LAUNCHES 1
#endif

#define LAS __attribute__((address_space(3)))
#define DI __device__ __forceinline__
typedef unsigned short bf16_t;
typedef short bf16x8 __attribute__((ext_vector_type(8)));
typedef short s16x4 __attribute__((ext_vector_type(4)));
typedef float f32x4 __attribute__((ext_vector_type(4)));
typedef float f32x2 __attribute__((ext_vector_type(2)));
typedef float f32x16 __attribute__((ext_vector_type(16)));
typedef unsigned u32x4 __attribute__((ext_vector_type(4)));
typedef unsigned u32x2 __attribute__((ext_vector_type(2)));

constexpr int D = 2048, MP = 8192, MS = 128, M = MP + MS, MPAD = 8448, NTM = 33;
constexpr int SEQ = 2048, NB = 4, NH = 4, DK = 256, DV = 512, KW = 1024, VW = 2048;
constexpr int DFF = 5504, NUP = 2 * DFF, PLE = 256, POOLW = 1024, INW = 11280, NIN = 11264;
constexpr float EPS = 1e-6f;
constexpr int NSL = 16;
constexpr int CH = 32, NCHK = MP / CH;

constexpr size_t O_YP = 0, O_YS = O_YP + (size_t)MP * D, O_GLAP = O_YS + (size_t)MS * D, O_POOLP = O_GLAP + (size_t)NB * NH * DK * DV,
                 O_CONVP = O_POOLP + (size_t)NB * 15 * POOLW, O_GLAS = O_CONVP + (size_t)NB * 2 * DFF, O_POOLS = O_GLAS + (size_t)MS * NH * DK * DV,
                 O_CONVS = O_POOLS + (size_t)MS * 15 * POOLW, O_END = O_CONVS + (size_t)MS * 2 * DFF;

constexpr size_t al(size_t x) { return (x + 255) & ~(size_t)255; }
constexpr size_t WS_CTL = 0, CTL_BYTES = 65536;
constexpr size_t WS_WUP = WS_CTL + CTL_BYTES;
constexpr size_t WS_WD = WS_WUP + al((size_t)NUP * D * 2);
constexpr size_t WS_WA = WS_WD + al((size_t)D * DFF * 2);
constexpr size_t WS_WO = WS_WA + al((size_t)D * D * 2);
constexpr size_t WS_WPG = WS_WO + al((size_t)D * D * 2);
constexpr size_t WS_WPB = WS_WPG + al((size_t)D * D * 2);
constexpr size_t WS_WPLE = WS_WPB + al((size_t)D * POOLW * 2);
constexpr size_t WS_WBT = WS_WPLE + al((size_t)D * PLE * 2);
constexpr size_t WS_WPS = WS_WBT + al((size_t)D * POOLW * 2);
constexpr size_t WS_SMALL = WS_WPS + al((size_t)POOLW * 256 * 2);
constexpr size_t WS_RSTD1 = WS_SMALL;
constexpr size_t WS_LAM = WS_RSTD1 + al((size_t)MPAD * 4);
constexpr size_t WS_OSS = WS_LAM + al((size_t)(NCHK + MS) * KW * 4);
constexpr size_t WS_OSP = WS_OSS + al((size_t)MP * NH * NSL * 4);
constexpr size_t WS_SS1 = WS_OSP + al((size_t)MS * NH * 8 * DV * 4);
constexpr size_t WS_SS2 = WS_SS1 + al((size_t)MPAD * 32 * 4);
constexpr size_t WS_SS3 = WS_SS2 + al((size_t)MPAD * 32 * 4);
constexpr size_t WS_SS1S = WS_SS3 + al((size_t)MPAD * 32 * 4);
constexpr size_t WS_SS2S = WS_SS1S + al((size_t)MS * 128 * 4);
constexpr size_t WS_SS3S = WS_SS2S + al((size_t)MS * 128 * 4);
constexpr size_t WS_PLB = WS_SS3S + al((size_t)MS * 128 * 4);
constexpr size_t WS_R1 = WS_PLB + al((size_t)MPAD * PLE * 2);
constexpr size_t WS_XB = WS_R1;
constexpr size_t WS_WIN = WS_XB + al((size_t)MPAD * D * 2);
constexpr size_t WS_BCUM = WS_WIN + al((size_t)NIN * D * 2);
constexpr size_t WS_R1_END = WS_BCUM + al((size_t)MPAD * KW * 4);
constexpr size_t WS_ACT = WS_R1;
static_assert(WS_ACT + al((size_t)MPAD * DFF * 2) <= WS_R1_END, "R1 overlay");
constexpr size_t WS_R2 = WS_R1_END;
constexpr size_t WS_QB = WS_R2;
constexpr size_t WS_KB = WS_QB + al((size_t)MPAD * KW * 2);
constexpr size_t WS_KD = WS_KB + al((size_t)MPAD * KW * 2);
constexpr size_t WS_V = WS_KD + al((size_t)MPAD * KW * 2);
constexpr size_t WS_SR = WS_V + al((size_t)MPAD * VW * 2);
constexpr size_t WS_GA = WS_SR + al((size_t)MPAD * VW * 2);
constexpr size_t WS_GB = WS_GA + al((size_t)MPAD * D * 2);
constexpr size_t WS_U = WS_GB + al((size_t)MPAD * D * 2);
constexpr size_t WS_OG = WS_U + al((size_t)MPAD * POOLW * 4);
constexpr size_t WS_PM = WS_OG + al((size_t)MPAD * VW * 2);
constexpr size_t WS_YBG = WS_PM + al((size_t)MPAD * POOLW * 2);
constexpr size_t WS_R2_END = WS_YBG + al((size_t)MPAD * D * 4);
constexpr size_t WS_GU = WS_R2;
constexpr size_t WS_H2 = WS_GU + al((size_t)MPAD * NUP * 2);
constexpr size_t WS_PE = WS_H2 + al((size_t)MPAD * D * 4);
static_assert(WS_PE + al((size_t)MPAD * D * 4) <= WS_R2_END, "R2 overlay");
constexpr size_t WS_MB = WS_R2_END;
constexpr size_t WS_H1 = WS_MB + al((size_t)MPAD * D * 2);
constexpr size_t WS_H1B = WS_H1 + al((size_t)MPAD * D * 4);
constexpr size_t WS_END = WS_H1B + al((size_t)MPAD * D * 2);
constexpr size_t WS_H3 = WS_H1;
constexpr size_t WS_H2B = WS_MB;

DI unsigned pk2(float lo, float hi) {
    typedef __bf16 bf2 __attribute__((ext_vector_type(2)));
    f32x2 v = {lo, hi};
    bf2 b = __builtin_convertvector(v, bf2);
    return __builtin_bit_cast(unsigned, b);
}
DI float bflo(unsigned w) { return __uint_as_float(w << 16); }
DI float bfhi(unsigned w) { return __uint_as_float(w & 0xffff0000u); }
DI float bf1(bf16_t b) { return __uint_as_float(((unsigned)b) << 16); }
DI float fexp(float x) { return __expf(x); }
DI float sigmoidf_(float x) { return __builtin_amdgcn_rcpf(1.0f + __expf(-x)); }
DI float siluf_(float x) { return x * sigmoidf_(x); }
DI float logsigmoidf_(float z) { return fminf(z, 0.f) - __logf(1.0f + __expf(-fabsf(z))); }
DI float wave_sum(float v) {
#pragma unroll
    for (int o = 1; o < 64; o <<= 1) v += __shfl_xor(v, o);
    return v;
}
DI int lane_id() { int l; asm volatile("v_mbcnt_lo_u32_b32 %0, -1, 0\n\tv_mbcnt_hi_u32_b32 %0, -1, %0" : "=v"(l)); return l; }
#define LDS_WAIT() asm volatile("s_waitcnt lgkmcnt(0)" ::: "memory")
#define VM_WAIT() asm volatile("s_waitcnt vmcnt(0)" ::: "memory")

struct Params {
    const float *x_prompt, *x_sample, *state_gla, *state_pool, *state_conv, *p_prompt, *p_sample;
    const float *norm_mix, *w_in, *w_gate_up, *b_gate, *gla_norm, *w_branch_a, *w_pool, *pool_scale, *w_branch_b, *w_out, *norm_ffn, *w_up, *conv_w, *conv_b,
        *w_down, *norm_ple, *w_ple_gate, *w_ple, *norm_final;
    float* out; unsigned char* ws;
    int ph_lo, ph_hi;
};

constexpr int NWAVES = 8, NTHREADS = 512;
constexpr int LDS_BYTES = 163840;
constexpr int LDS_MISC = LDS_BYTES - 256;

namespace g8 {
constexpr int BM = 256, BK = 64, HALF = 128, HTB = HALF * BK * 2, STAGE_BYTES = 8 * HTB, NXCD = 8, WGM = 2;
DI int lds_byte(int r, int c) { const int st = (r >> 4) * 2 + (c >> 5), rr = r & 15, cc = c & 31, ob = rr * 64 + cc * 2; return st * 1024 + (ob ^ (((ob >> 9) & 1) << 5)); }
DI void stage_rc(int b, int& R, int& C) { const int st = b / 1024, sb = b % 1024, swz = sb ^ (((sb >> 9) & 1) << 5); R = (st >> 1) * 16 + swz / 64; C = (st & 1) * 32 + (swz % 64) / 2; }
DI int perm32(int rho) { const int n = rho >> 4, i = rho & 15; return 8 * (i >> 2) + 4 * n + (i & 3); }

struct Unit { const char* A; const char* B; int pm, pn; };

DI bool grid_order(int nM, int nN, int G, int c, int i, int& pm, int& pn) {
    const int nwg = nM * nN; const long L = (long)i * G + c; if (L >= nwg) return false;
    int wgid = (int)L; { const int q = nwg / NXCD, r = nwg % NXCD, xcd = wgid % NXCD, off = wgid / NXCD; wgid = (xcd < r ? xcd * (q + 1) : r * (q + 1) + (xcd - r) * q) + off; }
    const int nig = WGM * nN, gid = wgid / nig, fm = gid * WGM, gsz = (nM - fm) < WGM ? (nM - fm) : WGM;
    pm = fm + ((wgid % nig) % gsz); pn = (wgid % nig) / gsz; return true;
}

template <class P, bool ALIGN_EPI, bool SP2>
DI void run(LAS unsigned char* lds, const P& ph, int wid) {
    const int lane = lane_id(), tid = wid * 64 + lane, wr = wid >> 2, wc = wid & 3, fr = lane & 15, fq = lane >> 4;
    constexpr int nt = P::KT;
    unsigned voffA[2], voffB[2];
#pragma unroll
    for (int i = 0; i < 2; ++i) { int R, C; stage_rc(tid * 16 + i * 8192, R, C); const int Rb = (R & ~31) + perm32(R & 31);
        voffA[i] = (unsigned)(R * P::LDA + C) * 2u; voffB[i] = (unsigned)(Rb * P::LDB + C) * 2u; }
    constexpr size_t kstep = (size_t)(BK * 2);
    constexpr size_t hstepA = (size_t)HALF * P::LDA * 2, hstepB = (size_t)HALF * P::LDB * 2;
    const unsigned ldsw = (unsigned)wid * 1024u;
    const int aoff = lds_byte(wr * 64 + fr, fq * 8), boff = lds_byte(wc * 32 + fr, fq * 8);
#define G8_SA(b, h) (((b) * 2 + (h)) * HTB)
#define G8_SB(b, h) ((4 + (b) * 2 + (h)) * HTB)
#define G8_STAGE(bufoff, gbase, voff) do { _Pragma("unroll") for (int _i = 0; _i < 2; ++_i) \
        __builtin_amdgcn_global_load_lds((const unsigned*)((const char*)(gbase) + (voff)[_i]), (LAS unsigned*)(lds + (bufoff) + ldsw + _i * 8192), 16, 0, 0); } while (0)
#define G8_LDA(dst, b, h) do { _Pragma("unroll") for (int m = 0; m < 4; ++m) _Pragma("unroll") for (int k = 0; k < 2; ++k) dst[m][k] = *(const LAS bf16x8*)(lds + G8_SA(b, h) + aoff + m * 2048 + k * 1024); } while (0)
#define G8_LDB(dst, b, h) do { _Pragma("unroll") for (int n = 0; n < 2; ++n) _Pragma("unroll") for (int k = 0; k < 2; ++k) dst[n][k] = *(const LAS bf16x8*)(lds + G8_SB(b, h) + boff + n * 2048 + k * 1024); } while (0)
#define G8_MMA(ai, bj, At, Bt) do { __builtin_amdgcn_s_setprio(1); _Pragma("unroll") for (int m = 0; m < 4; ++m) _Pragma("unroll") for (int n = 0; n < 2; ++n) _Pragma("unroll") for (int k = 0; k < 2; ++k) \
        acc[ai][bj][m][n] = __builtin_amdgcn_mfma_f32_16x16x32_bf16(Bt[n][k], At[m][k], acc[ai][bj][m][n], 0, 0, 0); __builtin_amdgcn_s_setprio(0); } while (0)
#define G8_WAIT_V(n) asm volatile("s_waitcnt vmcnt(" #n ")" ::: "memory")
#define G8_WAIT_L(n) asm volatile("s_waitcnt lgkmcnt(" #n ")" ::: "memory")
#define G8_BAR __builtin_amdgcn_s_barrier()
#define G8_SCHED __builtin_amdgcn_sched_barrier(0)
    Unit cur, nxt; int ui = 0;
    if (!ph.next(0, cur)) return;
    f32x4 acc[2][2][4][2];
#pragma unroll
    for (int a = 0; a < 2; ++a)
#pragma unroll
        for (int b = 0; b < 2; ++b)
#pragma unroll
            for (int m = 0; m < 4; ++m)
#pragma unroll
                for (int n = 0; n < 2; ++n) acc[a][b][m][n] = (f32x4){0.f, 0.f, 0.f, 0.f};
    bf16x8 At[4][2], B0[2][2], B1[2][2];
    const char* cA = cur.A; const char* cB = cur.B;
    if constexpr (SP2) {
        G8_STAGE(G8_SB(0, 0), cB, voffB); G8_STAGE(G8_SB(0, 1), cB + hstepB, voffB); G8_STAGE(G8_SA(0, 0), cA, voffA); G8_STAGE(G8_SA(0, 1), cA + hstepA, voffA);
        if (wr == 1) G8_BAR;
        G8_WAIT_V(2); G8_BAR;
        G8_STAGE(G8_SB(1, 0), cB + kstep, voffB); G8_STAGE(G8_SA(1, 0), cA + kstep, voffA); G8_STAGE(G8_SB(1, 1), cB + hstepB + kstep, voffB);
        G8_WAIT_V(6); G8_BAR;
    } else {
        G8_STAGE(G8_SB(0, 0), cB, voffB); G8_STAGE(G8_SA(0, 0), cA, voffA); G8_STAGE(G8_SB(0, 1), cB + hstepB, voffB); G8_STAGE(G8_SA(0, 1), cA + hstepA, voffA);
        if (wr == 1) G8_BAR;
        G8_WAIT_V(4); G8_BAR;
        G8_STAGE(G8_SB(1, 0), cB + kstep, voffB); G8_STAGE(G8_SA(1, 0), cA + kstep, voffA); G8_STAGE(G8_SB(1, 1), cB + hstepB + kstep, voffB);
        G8_WAIT_V(6); G8_BAR;
    }
    for (;;) {
        const bool has_next = ph.next(ui + 1, nxt);
        const char* nA = has_next ? nxt.A : cA; const char* nB = has_next ? nxt.B : cB;
#pragma unroll 1
        for (int t = 0; t < nt; t += 2) {
            const bool last = (t == nt - 2);
            const char* a1 = cA + (size_t)(t + 1) * kstep;
            const char* a2 = last ? nA : cA + (size_t)(t + 2) * kstep; const char* b2 = last ? nB : cB + (size_t)(t + 2) * kstep;
            const char* a3 = a2 + kstep; const char* b3 = b2 + kstep;
            if constexpr (SP2) {
            G8_LDB(B0, 0, 0); G8_LDB(B1, 0, 1); G8_SCHED; G8_LDA(At, 0, 0); G8_STAGE(G8_SA(1, 1), a1 + hstepA, voffA);
            G8_WAIT_V(8); G8_WAIT_L(0); G8_BAR; G8_MMA(0, 0, At, B0); G8_MMA(0, 1, At, B1); G8_BAR; G8_SCHED;
            G8_LDA(At, 0, 1); G8_STAGE(G8_SB(0, 0), b2, voffB); G8_STAGE(G8_SB(0, 1), b2 + hstepB, voffB); G8_STAGE(G8_SA(0, 0), a2, voffA);
            G8_WAIT_V(8); G8_WAIT_L(0); G8_BAR; G8_MMA(1, 0, At, B0); G8_MMA(1, 1, At, B1); G8_BAR; G8_SCHED;
            G8_LDB(B0, 1, 0); G8_LDB(B1, 1, 1); G8_SCHED; G8_LDA(At, 1, 0); G8_STAGE(G8_SA(0, 1), a2 + hstepA, voffA);
            G8_WAIT_V(8); G8_WAIT_L(0); G8_BAR; G8_MMA(0, 0, At, B0); G8_MMA(0, 1, At, B1); G8_BAR; G8_SCHED;
            G8_LDA(At, 1, 1); G8_STAGE(G8_SB(1, 0), b3, voffB); G8_STAGE(G8_SB(1, 1), b3 + hstepB, voffB); G8_STAGE(G8_SA(1, 0), a3, voffA);
            G8_WAIT_V(8); G8_WAIT_L(0); G8_BAR; G8_MMA(1, 0, At, B0); G8_MMA(1, 1, At, B1); G8_BAR; G8_SCHED;
            } else {
            G8_LDB(B0, 0, 0); G8_SCHED; G8_LDA(At, 0, 0); G8_STAGE(G8_SA(1, 1), a1 + hstepA, voffA);
            G8_WAIT_L(8); G8_BAR; G8_WAIT_L(0); G8_MMA(0, 0, At, B0); G8_BAR; G8_SCHED;
            G8_LDB(B1, 0, 1); G8_STAGE(G8_SB(0, 0), b2, voffB);
            G8_BAR; G8_WAIT_L(0); G8_MMA(0, 1, At, B1); G8_BAR;
            G8_LDA(At, 0, 1); G8_STAGE(G8_SA(0, 0), a2, voffA);
            G8_BAR; G8_WAIT_L(0); G8_MMA(1, 0, At, B0); G8_BAR; G8_SCHED;
            G8_STAGE(G8_SB(0, 1), b2 + hstepB, voffB);
            G8_WAIT_V(6); G8_BAR; G8_MMA(1, 1, At, B1); G8_BAR;
            G8_LDB(B0, 1, 0); G8_SCHED; G8_LDA(At, 1, 0); G8_STAGE(G8_SA(0, 1), a2 + hstepA, voffA);
            G8_WAIT_L(8); G8_BAR; G8_WAIT_L(0); G8_MMA(0, 0, At, B0); G8_BAR; G8_SCHED;
            G8_LDB(B1, 1, 1); G8_STAGE(G8_SB(1, 0), b3, voffB);
            G8_BAR; G8_WAIT_L(0); G8_MMA(0, 1, At, B1); G8_BAR;
            G8_LDA(At, 1, 1); G8_STAGE(G8_SA(1, 0), a3, voffA);
            G8_BAR; G8_WAIT_L(0); G8_MMA(1, 0, At, B0); G8_BAR; G8_SCHED;
            G8_STAGE(G8_SB(1, 1), b3 + hstepB, voffB);
            G8_WAIT_V(6); G8_BAR; G8_MMA(1, 1, At, B1); G8_BAR;
            }
        }
        if constexpr (ALIGN_EPI) { if (wr == 0) G8_BAR; }
        ph.epi(acc, cur, wr, wc, fr, fq);
        if (!has_next) break;
#pragma unroll
        for (int a = 0; a < 2; ++a)
#pragma unroll
            for (int b = 0; b < 2; ++b)
#pragma unroll
                for (int m = 0; m < 4; ++m)
#pragma unroll
                    for (int n = 0; n < 2; ++n) acc[a][b][m][n] = (f32x4){0.f, 0.f, 0.f, 0.f};
        cur = nxt; cA = nA; cB = nB; ++ui;
        if constexpr (ALIGN_EPI) { if (wr == 1) G8_BAR; }
    }
    G8_WAIT_V(0);
    if constexpr (!ALIGN_EPI) { if (wr == 0) G8_BAR; }
    G8_BAR;
#undef G8_SA
#undef G8_SB
#undef G8_STAGE
#undef G8_LDA
#undef G8_LDB
#undef G8_MMA
#undef G8_WAIT_V
#undef G8_WAIT_L
#undef G8_BAR
#undef G8_SCHED
}
}

struct TJob { const float* src; bf16_t* dst; const float* gain; int K, Nsrc, Ndst, map, nitems; };

DI int map_col(int map, int n0) {
    if (map == 1) return n0 + (n0 >= 6144 ? 16 : 0);
    if (map == 2) { const int t = n0 >> 8, r = n0 & 255; return (r < 128) ? 128 * t + r : DFF + 128 * t + (r - 128); }
    return n0;
}
constexpr int TR_SCR = 64 * 65 * 4;
static_assert(8 * TR_SCR <= LDS_MISC, "transpose scratch must stay below the barrier words");
DI void p0_transpose_item(const TJob& J, LAS float* scr, int item, int lane) {
    const int nblk = J.Ndst / 64, kb = item / nblk, nb = item % nblk, k0 = 64 * kb, n0 = 64 * nb, ns0 = map_col(J.map, n0);
    const float* src = J.src + (size_t)(k0 + (lane >> 4)) * J.Nsrc + ns0 + 4 * (lane & 15);
    f32x4 v[16];
#pragma unroll
    for (int i = 0; i < 16; ++i) v[i] = *(const f32x4*)(src + (size_t)(4 * i) * J.Nsrc);
    if (J.gain) {
#pragma unroll
        for (int i = 0; i < 16; ++i) v[i] *= J.gain[k0 + 4 * i + (lane >> 4)];
    }
#pragma unroll
    for (int i = 0; i < 16; ++i) { LAS float* d = scr + (4 * i + (lane >> 4)) * 65 + 4 * (lane & 15); d[0] = v[i].x; d[1] = v[i].y; d[2] = v[i].z; d[3] = v[i].w; }
    LDS_WAIT(); asm volatile("" ::: "memory");
    const int c = lane & 7;
#pragma unroll
    for (int j = 0; j < 8; ++j) { const int n = (lane >> 3) + 8 * j; const LAS float* s = scr + (8 * c) * 65 + n;
        u32x4 o; o.x = pk2(s[0 * 65], s[1 * 65]); o.y = pk2(s[2 * 65], s[3 * 65]); o.z = pk2(s[4 * 65], s[5 * 65]); o.w = pk2(s[6 * 65], s[7 * 65]);
        *(u32x4*)(J.dst + (size_t)(n0 + n) * J.K + k0 + 8 * c) = o; }
    LDS_WAIT(); asm volatile("" ::: "memory");
}
DI void p0_wps_item(const Params& p, bf16_t* WPS, int item, int lane) {
    const size_t e = (size_t)item * 512 + lane * 8; const float* src = p.w_pool + e;
    const f32x4 a = *(const f32x4*)src, b = *(const f32x4*)(src + 4);
    u32x4 o; o.x = pk2(a.x, a.y); o.y = pk2(a.z, a.w); o.z = pk2(b.x, b.y); o.w = pk2(b.z, b.w);
    *(u32x4*)(WPS + e) = o;
}
DI void p0_plb_item(const Params& p, bf16_t* PLB, int item, int lane) {
    const size_t e = (size_t)item * 512 + lane * 8; const size_t row = e / PLE;
    const float* src = (row < MP) ? p.p_prompt + e : p.p_sample + (e - (size_t)MP * PLE);
    const f32x4 a = *(const f32x4*)src, b = *(const f32x4*)(src + 4);
    u32x4 o; o.x = pk2(a.x, a.y); o.y = pk2(a.z, a.w); o.z = pk2(b.x, b.y); o.w = pk2(b.z, b.w);
    *(u32x4*)(PLB + e) = o;
}

DI void p0_xprep_unit(const Params& p, LAS unsigned char* lds, int u, int wave) {
    const int lane = lane_id(), tid = wave * 64 + lane;
    unsigned char* ws = p.ws;
    bf16_t* XB = (bf16_t*)(ws + WS_XB); float* RSTD1 = (float*)(ws + WS_RSTD1); float* BCUM = (float*)(ws + WS_BCUM); float* LAM = (float*)(ws + WS_LAM);
    LAS unsigned char* WG = lds; LAS float* GL = (LAS float*)(lds + 65536); LAS float* RS = (LAS float*)(lds + 69632);
    {   f32x4 w[16]; float gk[16];
#pragma unroll
        for (int i = 0; i < 16; ++i) { const int idx = tid + 512 * i, k = idx >> 2, n4 = idx & 3; w[i] = *(const f32x4*)(p.w_in + (size_t)k * INW + 6144 + 4 * n4); gk[i] = p.norm_mix[k]; }
#pragma unroll
        for (int i = 0; i < 16; ++i) { const int idx = tid + 512 * i, k = idx >> 2, n4 = idx & 3; LAS bf16_t* d = (LAS bf16_t*)(WG + (size_t)((k >> 3) * 16 + 4 * n4) * 16) + (k & 7);
            const unsigned a = pk2(w[i].x * gk[i], w[i].y * gk[i]), b = pk2(w[i].z * gk[i], w[i].w * gk[i]);
            d[0] = (bf16_t)(a & 0xffffu); d[8] = (bf16_t)(a >> 16); d[16] = (bf16_t)(b & 0xffffu); d[24] = (bf16_t)(b >> 16); }
    }
    __syncthreads();
    if (wave < 4) {
        const int fr = lane & 15, fq = lane >> 4; const int row = 64 * u + 16 * wave + fr;
        const float* xr = (row < MP) ? p.x_prompt + (size_t)row * D : p.x_sample + (size_t)(row - MP) * D;
        f32x4 acc = {0.f, 0.f, 0.f, 0.f}; float ss = 0.f;
#pragma unroll 1
        for (int s0 = 0; s0 < 64; s0 += 8) {
            f32x4 xa[8], xb[8];
#pragma unroll
            for (int i = 0; i < 8; ++i) { xa[i] = *(const f32x4*)(xr + 32 * (s0 + i) + 8 * fq); xb[i] = *(const f32x4*)(xr + 32 * (s0 + i) + 8 * fq + 4); }
#pragma unroll
            for (int i = 0; i < 8; ++i) { const int s = s0 + i; const f32x4 a = xa[i], b = xb[i];
                ss += (a.x * a.x + a.y * a.y) + (a.z * a.z + a.w * a.w) + (b.x * b.x + b.y * b.y) + (b.z * b.z + b.w * b.w);
                u32x4 o; o.x = pk2(a.x, a.y); o.y = pk2(a.z, a.w); o.z = pk2(b.x, b.y); o.w = pk2(b.z, b.w);
                *(u32x4*)(XB + (size_t)row * D + 32 * s + 8 * fq) = o;
                const bf16x8 af = __builtin_bit_cast(bf16x8, o);
                const bf16x8 bfr = *(const LAS bf16x8*)(WG + (size_t)((4 * s + fq) * 16 + fr) * 16);
                acc = __builtin_amdgcn_mfma_f32_16x16x32_bf16(af, bfr, acc, 0, 0, 0); }
        }
        ss += __shfl_xor(ss, 16); ss += __shfl_xor(ss, 32);
        const float rstd = 1.0f / sqrtf(ss * (1.0f / D) + EPS);
        if (fq == 0) { RS[16 * wave + fr] = rstd; RSTD1[row] = rstd; }
        LDS_WAIT(); asm volatile("" ::: "memory");
#pragma unroll
        for (int j = 0; j < 4; ++j) { const int tl = 16 * wave + 4 * fq + j; GL[tl * 16 + fr] = acc[j] * RS[tl]; }
    }
    __syncthreads();
    const bool sample = (u >= MP / 64);
#pragma unroll 1
    for (int cc = 0; cc < 2; ++cc) {
        const int c = tid + 512 * cc; float wg[16];
#pragma unroll
        for (int j = 0; j < 16; ++j) wg[j] = p.w_gate_up[j * KW + c];
        const float bg = p.b_gate[c]; float cum = 0.f;
#pragma unroll 2
        for (int t = 0; t < 64; ++t) {
            const f32x4 g0 = *(const LAS f32x4*)(GL + t * 16), g1 = *(const LAS f32x4*)(GL + t * 16 + 4), g2 = *(const LAS f32x4*)(GL + t * 16 + 8), g3 = *(const LAS f32x4*)(GL + t * 16 + 12);
            float z = bg;
            z += g0.x * wg[0] + g0.y * wg[1] + g0.z * wg[2] + g0.w * wg[3];
            z += g1.x * wg[4] + g1.y * wg[5] + g1.z * wg[6] + g1.w * wg[7];
            z += g2.x * wg[8] + g2.y * wg[9] + g2.z * wg[10] + g2.w * wg[11];
            z += g3.x * wg[12] + g3.y * wg[13] + g3.z * wg[14] + g3.w * wg[15];
            const float gl = logsigmoidf_(z) * (1.0f / 16.0f);
            const int row = 64 * u + t;
            if (sample) { BCUM[(size_t)row * KW + c] = 0.f; LAM[(size_t)(NCHK + row - MP) * KW + c] = __expf(gl); }
            else { cum = ((t & (CH - 1)) == 0) ? gl : cum + gl; BCUM[(size_t)row * KW + c] = cum; if ((t & (CH - 1)) == CH - 1) LAM[(size_t)(row / CH) * KW + c] = __expf(cum); }
        }
    }
    __syncthreads();
}

constexpr int NXPREP = M / 64;
DI void phase_p0(const Params& p, LAS unsigned char* lds, int wave) {
    const int lane = lane_id();
    unsigned char* ws = p.ws;
#ifndef P0_REP
#define P0_REP 0
#endif
    const int G = gridDim.x, c = blockIdx.x; const bool has_unit = c < NXPREP;
    const int nx = (G < NXPREP) ? G : NXPREP, W_OTHER = 3;
    const int nslots_total = nx * NWAVES + (G - nx) * NWAVES * W_OTHER;
    const int my_n = has_unit ? 1 : W_OTHER;
    const int my_first = has_unit ? c * NWAVES + wave : nx * NWAVES + ((c - nx) * NWAVES + wave) * W_OTHER;
    if (has_unit) { for (int u = c; u < NXPREP; u += G) p0_xprep_unit(p, lds, u, wave); if (P0_REP & 1) p0_xprep_unit(p, lds, c, wave); }
    TJob J[8];
    J[0] = TJob{p.w_in, (bf16_t*)(ws + WS_WIN), p.norm_mix, D, INW, NIN, 1, (D / 64) * (NIN / 64)};
    J[1] = TJob{p.w_up, (bf16_t*)(ws + WS_WUP), p.norm_ffn, D, NUP, NUP, 2, (D / 64) * (NUP / 64)};
    J[2] = TJob{p.w_down, (bf16_t*)(ws + WS_WD), nullptr, DFF, D, D, 0, (DFF / 64) * (D / 64)};
    J[3] = TJob{p.w_branch_a, (bf16_t*)(ws + WS_WA), p.gla_norm, D, D, D, 0, (D / 64) * (D / 64)};
    J[4] = TJob{p.w_out, (bf16_t*)(ws + WS_WO), nullptr, D, D, D, 0, (D / 64) * (D / 64)};
    J[5] = TJob{p.w_ple_gate, (bf16_t*)(ws + WS_WPG), p.norm_ple, D, D, D, 0, (D / 64) * (D / 64)};
    J[6] = TJob{p.w_ple, (bf16_t*)(ws + WS_WPLE), nullptr, PLE, D, D, 0, (PLE / 64) * (D / 64)};
    J[7] = TJob{p.w_branch_b, (bf16_t*)(ws + WS_WBT), p.pool_scale, POOLW, D, D, 0, (POOLW / 64) * (D / 64)};
    LAS float* scr = (LAS float*)(lds + wave * TR_SCR);
    for (int rep = 0; rep < ((P0_REP & 2) ? 2 : 1); ++rep) {
    int base = 0;
#pragma unroll
    for (int j = 0; j < 8; ++j) {
        const int n = J[j].nitems;
        for (int k = 0; k < my_n; ++k) {
            int it = (my_first + k) - (base % nslots_total); if (it < 0) it += nslots_total;
            for (; it < n; it += nslots_total) p0_transpose_item(J[j], scr, it, lane);
        }
        base += n;
    }
    }
    for (int k = 0; k < my_n; ++k) {
        for (int it = my_first + k; it < (POOLW * 256) / 512; it += nslots_total) p0_wps_item(p, (bf16_t*)(ws + WS_WPS), it, lane);
        for (int it = my_first + k; it < (M * PLE) / 512; it += nslots_total) p0_plb_item(p, (bf16_t*)(ws + WS_PLB), it, lane);
    }
}

#define MFMA32(a, b, c) __builtin_amdgcn_mfma_f32_32x32x16_bf16((a), (b), (c), 0, 0, 0)
typedef LAS s16x4* lds_s16x4_p;
DI s16x4 tr_read(LAS unsigned char* a) { return __builtin_amdgcn_ds_read_tr16_b64_v4i16((lds_s16x4_p)a); }
DI bf16x8 cat8(s16x4 lo, s16x4 hi) { return __builtin_shufflevector(lo, hi, 0, 1, 2, 3, 4, 5, 6, 7); }
DI bf16x8 ld_perm(const bf16_t* p) {
    const u32x2 a = *(const u32x2*)p, b = *(const u32x2*)(p + 8);
    u32x4 r; r.x = a.x; r.y = a.y; r.z = b.x; r.w = b.y; return __builtin_bit_cast(bf16x8, r);
}
template <int S> DI bf16x8 pack_step(const f32x16& x) {
    u32x4 r; r.x = pk2(x[8 * S + 0], x[8 * S + 1]); r.y = pk2(x[8 * S + 2], x[8 * S + 3]); r.z = pk2(x[8 * S + 4], x[8 * S + 5]); r.w = pk2(x[8 * S + 6], x[8 * S + 7]);
    return __builtin_bit_cast(bf16x8, r);
}
DI f32x16 zero16() { f32x16 z;
#pragma unroll
    for (int i = 0; i < 16; ++i) z[i] = 0.f; return z; }

constexpr int SC_BUF = 50176, SC_QI = 0, SC_KI = 16384, SC_VI = 32768, SC_LMI = 49152, SC_ATT = 3 * SC_BUF, SC_BYTES = SC_ATT + 2048;
static_assert(SC_BYTES <= LDS_MISC, "scan LDS map");
DI void dma16(const void* g, LAS unsigned char* l) { __builtin_amdgcn_global_load_lds((const unsigned*)g, (LAS unsigned*)l, 16, 0, 0); }
DI bf16x8 lds_perm(LAS unsigned char* a) {
    const u32x2 x = *(const LAS u32x2*)a, y = *(const LAS u32x2*)(a + 512);
    u32x4 r; r.x = x.x; r.y = x.y; r.z = y.x; r.w = y.y; return __builtin_bit_cast(bf16x8, r);
}
#define SC_BAR() do { asm volatile("s_waitcnt lgkmcnt(0)" ::: "memory"); __builtin_amdgcn_s_barrier(); asm volatile("" ::: "memory"); } while (0)
DI void scan_block(const Params& p, LAS unsigned char* lds, int task, int wave) {
    unsigned char* ws = p.ws;
    const bf16_t* QB = (const bf16_t*)(ws + WS_QB); const bf16_t* KB = (const bf16_t*)(ws + WS_KB);
    const bf16_t* V = (const bf16_t*)(ws + WS_V); bf16_t* OG = (bf16_t*)(ws + WS_OG);
    const float* LAM = (const float*)(ws + WS_LAM); float* OSS = (float*)(ws + WS_OSS);
    const int half = task & 1, hd = (task >> 1) & 3, b = task >> 3, sl = 8 * half + wave;
    f32x16 S[8];
#pragma unroll
    for (int db = 0; db < 8; ++db) S[db] = zero16();

#define SC_ISSUE(ch_, slot_) do { const int _l = lane_id(); const size_t _r0 = (size_t)(b * SEQ + CH * (ch_)); LAS unsigned char* _lb = lds + (slot_) * SC_BUF; asm volatile("" : "+s"(_lb)); \
        _Pragma("unroll") for (int _k = 0; _k < 2; ++_k) { const int _i = 2 * wave + _k; \
            const int _row = _l & 31, _cc = 2 * _i + (_l >> 5); \
            dma16(QB + (_r0 + _row) * KW + hd * 256 + 8 * _cc, _lb + SC_QI + _i * 1024); \
            const int _s = 2 * _i + (_l >> 5), _c2 = (_l & 31) ^ (4 * (_s & 3)); \
            dma16(KB + (_r0 + _s) * KW + hd * 256 + 8 * _c2, _lb + SC_KI + _i * 1024); dma16(V + (_r0 + _s) * VW + hd * 512 + 256 * half + 8 * _c2, _lb + SC_VI + _i * 1024); } \
        if (wave == 0) dma16(LAM + (size_t)(b * (SEQ / CH) + (ch_)) * KW + hd * 256 + 4 * _l, _lb + SC_LMI); } while (0)
    constexpr int NCH = SEQ / CH;
    SC_ISSUE(0, 0); SC_ISSUE(1, 1);
    int slot = 0;
#pragma unroll 1
    for (int ch = 0; ch < NCH; ++ch) {
        const int row0 = b * SEQ + CH * ch;
        if (ch == 0) { if (wave == 0) asm volatile("s_waitcnt vmcnt(7)" ::: "memory"); else asm volatile("s_waitcnt vmcnt(6)" ::: "memory"); }
        else if (ch == 1) { if (wave == 0) asm volatile("s_waitcnt vmcnt(11)" ::: "memory"); else asm volatile("s_waitcnt vmcnt(10)" ::: "memory"); }
        else if (ch + 1 < NCH) { if (wave == 0) asm volatile("s_waitcnt vmcnt(15)" ::: "memory"); else asm volatile("s_waitcnt vmcnt(14)" ::: "memory"); }
        else VM_WAIT();
        SC_BAR();
        { const int s2 = (slot == 0) ? 2 : slot - 1; if (ch + 2 < NCH) SC_ISSUE(ch + 2, s2); }
        const int lane = lane_id();
        const int c = lane & 31, h = lane >> 5;
        const int i16 = lane & 15, q = i16 >> 2, pp = i16 & 3, jb = (lane >> 4) & 1;
        LAS unsigned char* buf = lds + slot * SC_BUF;
        LAS unsigned char* ATT = lds + SC_ATT;

        if (wave < 4) {
            const int si = wave >> 1, ti = wave & 1, fr = lane & 15, fq = lane >> 4;
            f32x4 a = {0.f, 0.f, 0.f, 0.f};
            LAS unsigned char* kp = buf + SC_KI + (16 * si + fr) * 512; LAS unsigned char* qp = buf + SC_QI + fq * 512 + (16 * ti + fr) * 16;
            const int kx = 4 * (fr & 3);
#pragma unroll
            for (int ks = 0; ks < 8; ++ks) a = __builtin_amdgcn_mfma_f32_16x16x32_bf16(*(const LAS bf16x8*)(kp + (((4 * ks + fq) ^ kx) * 16)), *(const LAS bf16x8*)(qp + 2048 * ks), a, 0, 0, 0);
            const int s0 = 16 * si + 4 * fq, t = 16 * ti + fr;
            u32x2 w; w.x = pk2(s0 + 0 <= t ? a[0] : 0.f, s0 + 1 <= t ? a[1] : 0.f); w.y = pk2(s0 + 2 <= t ? a[2] : 0.f, s0 + 3 <= t ? a[3] : 0.f);
            *(LAS u32x2*)(ATT + t * 64 + s0 * 2) = w;
        }
        SC_BAR();

        f32x16 o = zero16();
        LAS unsigned char* vb = buf + SC_VI + (8 * h + q) * 512 + (4 * (wave ^ q) + 2 * jb + (pp >> 1)) * 16 + (pp & 1) * 8;
        const bf16x8 vf0 = cat8(tr_read(vb), tr_read(vb + 4 * 512)), vf1 = cat8(tr_read(vb + 16 * 512), tr_read(vb + 20 * 512));
        {
            LAS unsigned char* ab = ATT + c * 64 + 16 * h;
            o = MFMA32(vf0, *(const LAS bf16x8*)ab, o);
            o = MFMA32(vf1, *(const LAS bf16x8*)(ab + 32), o);
            LAS unsigned char* qa = buf + SC_QI + c * 16 + 8 * h;
#pragma unroll
            for (int db = 0; db < 8; ++db) {
                { const bf16x8 qf = lds_perm(qa + 2048 * db); o = MFMA32(pack_step<0>(S[db]), qf, o); }
                { const bf16x8 qf = lds_perm(qa + 2048 * db + 1024); o = MFMA32(pack_step<1>(S[db]), qf, o); }
                if ((db & 3) == 3) __builtin_amdgcn_sched_barrier(0);
            }
            const int t = row0 + c;
            float ss = 0.f;
#pragma unroll
            for (int r = 0; r < 16; ++r) ss += o[r] * o[r];
            { const auto sw = __builtin_amdgcn_permlane32_swap(__float_as_uint(ss), __float_as_uint(ss), false, false); ss = __uint_as_float(sw[0]) + __uint_as_float(sw[1]); }
            if (h == 0) OSS[(size_t)t * 64 + hd * 16 + sl] = ss;
            bf16_t* og = OG + (size_t)row0 * VW + hd * 512 + 32 * sl + c * VW + 4 * h;
#pragma unroll
            for (int g = 0; g < 4; ++g) { u32x2 w; w.x = pk2(o[4 * g + 0], o[4 * g + 1]); w.y = pk2(o[4 * g + 2], o[4 * g + 3]); *(u32x2*)(og + 8 * g) = w; }
        }
        __builtin_amdgcn_sched_barrier(0);

        {
            LAS unsigned char* kbase = buf + SC_KI + (8 * h + q) * 512 + (2 * jb + (pp >> 1)) * 16 + (pp & 1) * 8;
            LAS unsigned char* lm = buf + SC_LMI + 16 * h;
#pragma unroll
            for (int db = 0; db < 8; ++db) {
                LAS unsigned char* kb = kbase + (((db & 3) ^ q) * 4) * 16 + (db >> 2) * 256;
                S[db] = MFMA32(cat8(tr_read(kb), tr_read(kb + 4 * 512)), vf0, S[db]);
                S[db] = MFMA32(cat8(tr_read(kb + 16 * 512), tr_read(kb + 20 * 512)), vf1, S[db]);
#pragma unroll
                for (int g = 0; g < 4; ++g) { const f32x4 l4 = *(const LAS f32x4*)(lm + (32 * db + 8 * g) * 4);
                    S[db][4 * g + 0] *= l4.x; S[db][4 * g + 1] *= l4.y; S[db][4 * g + 2] *= l4.z; S[db][4 * g + 3] *= l4.w; }
                if (db & 1) __builtin_amdgcn_sched_barrier(0);
            }
        }
        asm volatile("" ::: "memory");
        slot = (slot == 2) ? 0 : slot + 1;
    }
#undef SC_ISSUE
    {   const int lane = lane_id();
        const unsigned voff = (unsigned)(((lane >> 5) * 4 * DV + (lane & 31)) * 4);
        const char* gbase = (const char*)(p.out + O_GLAP + ((size_t)(b * NH + hd) * DK) * DV + 32 * sl);
#pragma unroll
        for (int db = 0; db < 8; ++db) {
#pragma unroll
            for (int r = 0; r < 16; ++r) { const int dl = 32 * db + (r & 3) + 8 * (r >> 2); *(float*)(const_cast<char*>(gbase) + (size_t)dl * DV * 4 + voff) = S[db][r]; }
        }
    }
    __syncthreads();
}

DI void sgla_task(const Params& p, int task, int lane) {
    unsigned char* ws = p.ws;
    const bf16_t* QB = (const bf16_t*)(ws + WS_QB); const bf16_t* KB = (const bf16_t*)(ws + WS_KB); const bf16_t* V = (const bf16_t*)(ws + WS_V);
    const float* LAM = (const float*)(ws + WS_LAM); float* OSP = (float*)(ws + WS_OSP);
    const int dblk = task & 7, hd = (task >> 3) & 3, b = task >> 5; const int row = MP + b;
    const size_t sbase = ((size_t)(b * NH + hd) * DK + 32 * dblk) * DV;
    const float* S0 = p.state_gla + sbase; float* So = p.out + O_GLAS + sbase;
    const int dl = lane & 31;
    const float lam_l = LAM[(size_t)(NCHK + b) * KW + hd * 256 + 32 * dblk + dl];
    const float k_l = bf1(KB[(size_t)row * KW + hd * 256 + 32 * dblk + dl]);
    const float q_l = bf1(QB[(size_t)row * KW + hd * 256 + 32 * dblk + dl]);
    f32x4 va, vb;
    { const u32x2 w = *(const u32x2*)(V + (size_t)row * VW + hd * 512 + 4 * lane); va = (f32x4){bflo(w.x), bfhi(w.x), bflo(w.y), bfhi(w.y)}; }
    { const u32x2 w = *(const u32x2*)(V + (size_t)row * VW + hd * 512 + 256 + 4 * lane); vb = (f32x4){bflo(w.x), bfhi(w.x), bflo(w.y), bfhi(w.y)}; }
    f32x4 oa = {0.f, 0.f, 0.f, 0.f}, ob = {0.f, 0.f, 0.f, 0.f};
#pragma unroll 1
    for (int d0 = 0; d0 < 32; d0 += 16) {
        f32x4 ra[16], rb[16];
#pragma unroll
        for (int i = 0; i < 16; ++i) { ra[i] = __builtin_nontemporal_load((const f32x4*)(S0 + (size_t)(d0 + i) * DV + 4 * lane)); rb[i] = __builtin_nontemporal_load((const f32x4*)(S0 + (size_t)(d0 + i) * DV + 256 + 4 * lane)); }
#pragma unroll
        for (int i = 0; i < 16; ++i) { const int d = d0 + i;
            const float lam = __uint_as_float(__builtin_amdgcn_readlane(__float_as_uint(lam_l), d)), kk = __uint_as_float(__builtin_amdgcn_readlane(__float_as_uint(k_l), d)), qq = __uint_as_float(__builtin_amdgcn_readlane(__float_as_uint(q_l), d));
            const f32x4 sa = ra[i] * lam + va * kk, sb = rb[i] * lam + vb * kk;
            __builtin_nontemporal_store(sa, (f32x4*)(So + (size_t)d * DV + 4 * lane)); __builtin_nontemporal_store(sb, (f32x4*)(So + (size_t)d * DV + 256 + 4 * lane));
            oa += sa * qq; ob += sb * qq; }
    }
    float* op = OSP + ((size_t)(b * NH + hd) * 8 + dblk) * DV;
    *(f32x4*)(op + 4 * lane) = oa; *(f32x4*)(op + 256 + 4 * lane) = ob;
}

DI void pmix_task(const Params& p, int t, int lane) {
    unsigned char* ws = p.ws;
    const float* U = (const float*)(ws + WS_U); bf16_t* PM = (bf16_t*)(ws + WS_PM);
    if (t < MP) {
        const int b = t >> 11, pos = t & 2047;
#pragma unroll
        for (int i = 0; i < 4; ++i) {
            const int w = 2 << i, c = 256 * i + 4 * lane; const int cnt = (pos + 1 < w) ? pos + 1 : w;
            const f32x4 u0 = *(const f32x4*)(U + (size_t)t * POOLW + c); f32x4 s = u0;
#pragma unroll
            for (int j = 1; j < w; ++j) {
                const bool in = j < cnt; const f32x4 v = *(const f32x4*)(U + (size_t)(in ? t - j : t) * POOLW + c); const float m = in ? 1.f : 0.f; s += v * m; }
            const float inv = 1.0f / (float)cnt; const f32x4 mx = s * inv - u0;
            u32x2 o; o.x = pk2(mx.x, mx.y); o.y = pk2(mx.z, mx.w); *(u32x2*)(PM + (size_t)t * POOLW + c) = o;
            if (pos >= SEQ - 15) *(f32x4*)(p.out + O_POOLP + ((size_t)b * 15 + (pos - (SEQ - 15))) * POOLW + c) = u0;
        }
    } else {
        const int b = t - MP; const float* sp = p.state_pool + (size_t)b * 15 * POOLW; float* po = p.out + O_POOLS + (size_t)b * 15 * POOLW;
#pragma unroll
        for (int i = 0; i < 4; ++i) {
            const int w = 2 << i, c = 256 * i + 4 * lane;
            const f32x4 u0 = *(const f32x4*)(U + (size_t)t * POOLW + c); f32x4 s = u0;
#pragma unroll
            for (int j = 1; j < w; ++j) s += *(const f32x4*)(sp + (size_t)(15 - j) * POOLW + c);
            const float inv = 1.0f / (float)w; const f32x4 mx = s * inv - u0;
            u32x2 o; o.x = pk2(mx.x, mx.y); o.y = pk2(mx.z, mx.w); *(u32x2*)(PM + (size_t)t * POOLW + c) = o;
            *(f32x4*)(po + (size_t)14 * POOLW + c) = u0;
        }
    }
}

DI void pool_copy_task(const Params& p, int item, int lane) {
    const int b = item / 14, r = item - 14 * b; const float* src = p.state_pool + ((size_t)b * 15 + r + 1) * POOLW + 4 * lane; float* dst = p.out + O_POOLS + ((size_t)b * 15 + r) * POOLW + 4 * lane;
    const f32x4 v0 = *(const f32x4*)src, v1 = *(const f32x4*)(src + 256), v2 = *(const f32x4*)(src + 512), v3 = *(const f32x4*)(src + 768);
    *(f32x4*)dst = v0; *(f32x4*)(dst + 256) = v1; *(f32x4*)(dst + 512) = v2; *(f32x4*)(dst + 768) = v3;
}
#ifndef P2_REP
#define P2_REP 0
#endif
DI void scan_role(const Params& p, LAS unsigned char* lds, int wave, int idx, int n) {
    for (int rep = 0; rep < ((P2_REP & 1) ? 2 : 1); ++rep) for (int task = (n == 32) ? (idx % 8) * 4 + idx / 8 : idx; task < 2 * NB * NH; task += n) scan_block(p, lds, task, wave);
}
DI void stream_role(const Params& p, int wave, int idx, int n) {
    const int lane = lane_id(); const int gw = idx * NWAVES + wave, NGW = n * NWAVES;
    for (int rep = 0; rep < ((P2_REP & 2) ? 2 : 1); ++rep) {
        for (int it = gw; it < MS * 14; it += NGW) pool_copy_task(p, it, lane);
        for (int task = gw; task < MS * NH * 8; task += NGW) sgla_task(p, task, lane); }
}

DI void ogn_task(const Params& p, int t, int lane) {
    unsigned char* ws = p.ws;
    bf16_t* OG = (bf16_t*)(ws + WS_OG); const float* OSS = (const float*)(ws + WS_OSS); const float* OSP = (const float*)(ws + WS_OSP); const bf16_t* SR = (const bf16_t*)(ws + WS_SR);
    if (t < MP) {
#pragma unroll
        for (int hd = 0; hd < 4; ++hd) {
            const float* sp = OSS + (size_t)t * 64 + hd * 16; const f32x4 a = *(const f32x4*)sp, b = *(const f32x4*)(sp + 4), c = *(const f32x4*)(sp + 8), d = *(const f32x4*)(sp + 12);
            const float ss = ((a.x + a.y) + (a.z + a.w)) + ((b.x + b.y) + (b.z + b.w)) + ((c.x + c.y) + (c.z + c.w)) + ((d.x + d.y) + (d.z + d.w));
            const float rstd = 1.0f / sqrtf(ss * (1.0f / DV) + EPS);
            bf16_t* op = OG + (size_t)t * VW + hd * 512 + 8 * lane; const u32x4 w = *(const u32x4*)op; const u32x4 g = *(const u32x4*)(SR + (size_t)t * VW + hd * 512 + 8 * lane);
            u32x4 o; o.x = pk2(bflo(w.x) * rstd * bflo(g.x), bfhi(w.x) * rstd * bfhi(g.x)); o.y = pk2(bflo(w.y) * rstd * bflo(g.y), bfhi(w.y) * rstd * bfhi(g.y));
            o.z = pk2(bflo(w.z) * rstd * bflo(g.z), bfhi(w.z) * rstd * bfhi(g.z)); o.w = pk2(bflo(w.w) * rstd * bflo(g.w), bfhi(w.w) * rstd * bfhi(g.w));
            *(u32x4*)op = o;
        }
    } else {
        const int b = t - MP;
#pragma unroll
        for (int hd = 0; hd < 4; ++hd) {
            f32x4 oa = {0.f, 0.f, 0.f, 0.f}, ob = {0.f, 0.f, 0.f, 0.f};
#pragma unroll
            for (int k = 0; k < 8; ++k) { const float* op = OSP + ((size_t)(b * NH + hd) * 8 + k) * DV + 8 * lane; oa += *(const f32x4*)op; ob += *(const f32x4*)(op + 4); }
            float ss = (oa.x * oa.x + oa.y * oa.y) + (oa.z * oa.z + oa.w * oa.w) + (ob.x * ob.x + ob.y * ob.y) + (ob.z * ob.z + ob.w * ob.w);
            ss = wave_sum(ss);
            const float rstd = 1.0f / sqrtf(ss * (1.0f / DV) + EPS);
            const u32x4 w = *(const u32x4*)(SR + (size_t)t * VW + hd * 512 + 8 * lane);
            u32x4 o; o.x = pk2(oa.x * rstd * bflo(w.x), oa.y * rstd * bfhi(w.x)); o.y = pk2(oa.z * rstd * bflo(w.y), oa.w * rstd * bfhi(w.y));
            o.z = pk2(ob.x * rstd * bflo(w.z), ob.y * rstd * bfhi(w.z)); o.w = pk2(ob.z * rstd * bflo(w.w), ob.w * rstd * bfhi(w.w));
            *(u32x4*)(OG + (size_t)t * VW + hd * 512 + 8 * lane) = o;
        }
    }
}
DI void phase_p3(const Params& p, int wave) {
    const int lane = lane_id();
    const int gw = (int)blockIdx.x * NWAVES + wave, NGW = gridDim.x * NWAVES;
    for (int t = gw; t < M; t += NGW) pmix_task(p, t, lane);
    for (int t = gw; t < M; t += NGW) ogn_task(p, t, lane);
}

DI float row_rstd(const float* SS, const float* SSs, int row, int lane) {
    float v = (row < MP) ? ((lane < 32) ? SS[(size_t)row * 32 + lane] : 0.f) : (SSs[(size_t)(row - MP) * 128 + lane] + SSs[(size_t)(row - MP) * 128 + 64 + lane]);
    v = wave_sum(v);
    return 1.0f / sqrtf(v * (1.0f / D) + EPS);
}

struct F8 { f32x4 a, b; };
DI F8 unpack8(u32x4 w, float s) { F8 r; r.a = (f32x4){bflo(w.x) * s, bfhi(w.x) * s, bflo(w.y) * s, bfhi(w.y) * s}; r.b = (f32x4){bflo(w.z) * s, bfhi(w.z) * s, bflo(w.w) * s, bfhi(w.w) * s}; return r; }
DI F8 ld8(const float* q) { F8 r; r.a = *(const f32x4*)q; r.b = *(const f32x4*)(q + 4); return r; }
DI void st8(float* q, const F8& v) { *(f32x4*)q = v.a; *(f32x4*)(q + 4) = v.b; }
DI f32x4 silu4(f32x4 x) { return (f32x4){siluf_(x.x), siluf_(x.y), siluf_(x.z), siluf_(x.w)}; }
DI void conv_task(const Params& p, int t, int lane) {
    unsigned char* ws = p.ws;
    const bf16_t* GU = (const bf16_t*)(ws + WS_GU); const float* SS1 = (const float*)(ws + WS_SS1); const float* SS1S = (const float*)(ws + WS_SS1S); bf16_t* ACT = (bf16_t*)(ws + WS_ACT);
    const bool prompt = t < MP; const int b = prompt ? (t >> 11) : (t - MP), pos = prompt ? (t & 2047) : 2;
    const float r0 = row_rstd(SS1, SS1S, t, lane);
    const float r1 = (prompt && pos >= 1) ? row_rstd(SS1, SS1S, t - 1, lane) : 0.f;
    const float r2 = (prompt && pos >= 2) ? row_rstd(SS1, SS1S, t - 2, lane) : 0.f;
    const bf16_t* g0p = GU + (size_t)t * NUP; const bf16_t* g1p = GU + (size_t)((prompt && pos >= 1) ? t - 1 : t) * NUP; const bf16_t* g2p = GU + (size_t)((prompt && pos >= 2) ? t - 2 : t) * NUP;
    const float* sc = p.state_conv + (size_t)b * 2 * DFF;
    for (int v = lane; v < DFF / 8; v += 64) {
        const int ch0 = 8 * v, pn = ch0 >> 7, r = ch0 & 127, gcol = 256 * pn + r, ucol = gcol + 128;
        const F8 g0 = unpack8(*(const u32x4*)(g0p + gcol), r0), up = unpack8(*(const u32x4*)(g0p + ucol), r0);
        F8 g1, g2;
        if (prompt) { g1 = unpack8(*(const u32x4*)(g1p + gcol), r1); g2 = unpack8(*(const u32x4*)(g2p + gcol), r2); }
        else { g1 = ld8(sc + DFF + ch0); g2 = ld8(sc + ch0); }
        const F8 w0 = ld8(p.conv_w + ch0), w1 = ld8(p.conv_w + DFF + ch0), w2 = ld8(p.conv_w + 2 * DFF + ch0), cb = ld8(p.conv_b + ch0);
        const f32x4 ga = cb.a + w0.a * g2.a + w1.a * g1.a + w2.a * g0.a, gb = cb.b + w0.b * g2.b + w1.b * g1.b + w2.b * g0.b;
        const f32x4 aa = silu4(ga) * up.a, ab = silu4(gb) * up.b;
        u32x4 o; o.x = pk2(aa.x, aa.y); o.y = pk2(aa.z, aa.w); o.z = pk2(ab.x, ab.y); o.w = pk2(ab.z, ab.w);
        *(u32x4*)(ACT + (size_t)t * DFF + ch0) = o;
        if (prompt) { if (pos >= SEQ - 2) st8(p.out + O_CONVP + ((size_t)b * 2 + (pos - (SEQ - 2))) * DFF + ch0, g0); }
        else { float* co = p.out + O_CONVS + (size_t)b * 2 * DFF + ch0; st8(co, g1); st8(co + DFF, g0); }
    }
}
DI void conv_block_task(const Params& p, int rb, int vg, int lane) {
    unsigned char* ws = p.ws;
    const bf16_t* GU = (const bf16_t*)(ws + WS_GU); const float* SS1 = (const float*)(ws + WS_SS1); bf16_t* ACT = (bf16_t*)(ws + WS_ACT);
    const int t0 = 16 * rb, b = t0 >> 11, pos0 = t0 & 2047;
    float rr[18];
#pragma unroll
    for (int i = 0; i < 18; ++i) { const int t = t0 - 2 + i; float v = (lane < 32 && (i >= 2 || pos0 > 0)) ? SS1[(size_t)t * 32 + lane] : 0.f; v = wave_sum(v); rr[i] = (i >= 2 || pos0 > 0) ? 1.0f / sqrtf(v * (1.0f / D) + EPS) : 0.f; }
    const int v = vg * 64 + lane; if (v >= DFF / 8) return;
    const int ch0 = 8 * v, pn = ch0 >> 7, r = ch0 & 127, gcol = 256 * pn + r, ucol = gcol + 128;
    const F8 w0 = ld8(p.conv_w + ch0), w1 = ld8(p.conv_w + DFF + ch0), w2 = ld8(p.conv_w + 2 * DFF + ch0), cb = ld8(p.conv_b + ch0);
    const bf16_t* gp = GU + (size_t)t0 * NUP + gcol; const bf16_t* up_ = GU + (size_t)t0 * NUP + ucol;
    F8 g2 = unpack8(*(const u32x4*)(gp - (pos0 > 0 ? 2 : 0) * (size_t)NUP), rr[0]), g1 = unpack8(*(const u32x4*)(gp - (pos0 > 0 ? 1 : 0) * (size_t)NUP), rr[1]);
#pragma unroll 1
    for (int h = 0; h < 2; ++h) {
        u32x4 gw[8], uw[8];
#pragma unroll
        for (int i = 0; i < 8; ++i) { gw[i] = *(const u32x4*)(gp + (size_t)(8 * h + i) * NUP); uw[i] = *(const u32x4*)(up_ + (size_t)(8 * h + i) * NUP); }
#pragma unroll
        for (int i = 0; i < 8; ++i) { const int ii = 8 * h + i; const float r0 = (h == 0) ? rr[2 + i] : rr[10 + i];
            const F8 g0 = unpack8(gw[i], r0), up = unpack8(uw[i], r0);
            const f32x4 ga = cb.a + w0.a * g2.a + w1.a * g1.a + w2.a * g0.a, gb = cb.b + w0.b * g2.b + w1.b * g1.b + w2.b * g0.b;
            const f32x4 aa = silu4(ga) * up.a, ab = silu4(gb) * up.b;
            u32x4 o; o.x = pk2(aa.x, aa.y); o.y = pk2(aa.z, aa.w); o.z = pk2(ab.x, ab.y); o.w = pk2(ab.z, ab.w);
            *(u32x4*)(ACT + (size_t)(t0 + ii) * DFF + ch0) = o;
            if (pos0 + ii >= SEQ - 2) st8(p.out + O_CONVP + ((size_t)b * 2 + (pos0 + ii - (SEQ - 2))) * DFF + ch0, g0);
            g2 = g1; g1 = g0; }
    }
}
DI void phase_conv(const Params& p, int wave) {
    const int lane = lane_id();
    const int gw = (int)blockIdx.x * NWAVES + wave, NGW = gridDim.x * NWAVES;
    constexpr int NVG = (DFF / 8 + 63) / 64;
    for (int t = MP + gw; t < M; t += NGW) conv_task(p, t, lane);
    for (int it = gw; it < (MP / 16) * NVG; it += NGW) conv_block_task(p, it / NVG, it % NVG, lane);
}

DI void phase_final(const Params& p, int wave) {
    const int lane = lane_id();
    const int gw = (int)blockIdx.x * NWAVES + wave, NGW = gridDim.x * NWAVES;
    const float* H3 = (const float*)(p.ws + WS_H3); const float* SS3 = (const float*)(p.ws + WS_SS3); const float* SS3S = (const float*)(p.ws + WS_SS3S);
    for (int t = gw; t < M; t += NGW) {
        const float rs = row_rstd(SS3, SS3S, t, lane);
        float* yo = (t < MP) ? p.out + O_YP + (size_t)t * D : p.out + O_YS + (size_t)(t - MP) * D;
#pragma unroll
        for (int i = 0; i < 8; ++i) { const int c = 256 * i + 4 * lane; const f32x4 hv = *(const f32x4*)(H3 + (size_t)t * D + c), g = *(const f32x4*)(p.norm_final + c);
            *(f32x4*)(yo + c) = hv * rs * g; }
    }
}

#define EPI_ARGS const f32x4 (&acc)[2][2][4][2], const g8::Unit& u, int wr, int wc, int fr, int fq
#define EPI_ROWS(ROWVAR) _Pragma("unroll") for (int ai = 0; ai < 2; ++ai) _Pragma("unroll") for (int m = 0; m < 4; ++m) { const int ROWVAR = u.pm * 256 + ai * 128 + wr * 64 + m * 16 + fr; if (ROWVAR < M) {
#define EPI_COLS(COLVAR) _Pragma("unroll") for (int bj = 0; bj < 2; ++bj) { const int COLVAR = bj * 128 + wc * 32 + 8 * fq; const f32x4 v0 = acc[ai][bj][m][0], v1 = acc[ai][bj][m][1];
#define EPI_END } } }
DI u32x4 pk8(f32x4 a, f32x4 b) { u32x4 o; o.x = pk2(a.x, a.y); o.y = pk2(a.z, a.w); o.z = pk2(b.x, b.y); o.w = pk2(b.z, b.w); return o; }
DI f32x4 exp4(f32x4 x) { return (f32x4){__expf(x.x), __expf(x.y), __expf(x.z), __expf(x.w)}; }
DI f32x4 sig4(f32x4 x) { return (f32x4){sigmoidf_(x.x), sigmoidf_(x.y), sigmoidf_(x.z), sigmoidf_(x.w)}; }
DI f32x4 bf4lo(u32x4 w) { return (f32x4){bflo(w.x), bfhi(w.x), bflo(w.y), bfhi(w.y)}; }
DI f32x4 bf4hi(u32x4 w) { return (f32x4){bflo(w.z), bfhi(w.z), bflo(w.w), bfhi(w.w)}; }
DI float sum4(f32x4 a) { return (a.x + a.y) + (a.z + a.w); }

struct PhaseIn {
    static constexpr int LDA = D, LDB = D, KT = D / 64;
    const Params& p; int G, c, part;
    int c0;
    DI bool next(int i, g8::Unit& u) const { int pm, pn;
        if (part == 0) { if (!g8::grid_order(NTM - 1, 16, G, c, i, pm, pn)) return false; }
        else { if (c < c0 || !g8::grid_order(NTM, 28, G - c0, c - c0, i, pm, pn)) return false; pn += 16; }
        u.pm = pm; u.pn = pn; u.A = (const char*)(p.ws + WS_XB) + (size_t)pm * 256 * D * 2; u.B = (const char*)(p.ws + WS_WIN) + (size_t)pn * 256 * D * 2; return true; }
    DI void epi(EPI_ARGS) const {
        unsigned char* ws = p.ws; const float* RSTD1 = (const float*)(ws + WS_RSTD1); const float* BCUM = (const float*)(ws + WS_BCUM);
        const int pn = u.pn;
        if (pn < 4) {
            bf16_t* QB = (bf16_t*)(ws + WS_QB);
            EPI_ROWS(row) const float rs = RSTD1[row] * 0.0625f; EPI_COLS(col) const size_t o = (size_t)row * KW + pn * 256 + col;
                const f32x4 e0 = exp4(*(const f32x4*)(BCUM + o)), e1 = exp4(*(const f32x4*)(BCUM + o + 4));
                *(u32x4*)(QB + o) = pk8(v0 * rs * e0, v1 * rs * e1); EPI_END
        } else if (pn < 8) {
            bf16_t* KB = (bf16_t*)(ws + WS_KB);
            EPI_ROWS(row) const float rs = RSTD1[row]; EPI_COLS(col) const size_t o = (size_t)row * KW + (pn - 4) * 256 + col;
                const f32x4 b0 = *(const f32x4*)(BCUM + o), b1 = *(const f32x4*)(BCUM + o + 4);
                *(u32x4*)(KB + o) = pk8(v0 * rs * exp4(-b0), v1 * rs * exp4(-b1)); EPI_END
        } else if (pn < 16) {
            bf16_t* V = (bf16_t*)(ws + WS_V);
            EPI_ROWS(row) const float rs = RSTD1[row]; EPI_COLS(col) *(u32x4*)(V + (size_t)row * VW + (pn - 8) * 256 + col) = pk8(v0 * rs, v1 * rs); EPI_END
        } else if (pn < 24) {
            bf16_t* SR = (bf16_t*)(ws + WS_SR);
            EPI_ROWS(row) const float rs = RSTD1[row]; EPI_COLS(col) const f32x4 a = v0 * rs, b = v1 * rs; *(u32x4*)(SR + (size_t)row * VW + (pn - 16) * 256 + col) = pk8(a * sig4(a), b * sig4(b)); EPI_END
        } else if (pn < 28) {
            float* U = (float*)(ws + WS_U);
            EPI_ROWS(row) const float rs = RSTD1[row]; EPI_COLS(col) float* o = U + (size_t)row * POOLW + (pn - 24) * 256 + col; *(f32x4*)o = v0 * rs; *(f32x4*)(o + 4) = v1 * rs; EPI_END
        } else {
            bf16_t* Gt = (bf16_t*)(ws + (pn < 36 ? WS_GA : WS_GB)); const int c0 = (pn < 36 ? pn - 28 : pn - 36) * 256;
            EPI_ROWS(row) const float rs = RSTD1[row]; EPI_COLS(col) *(u32x4*)(Gt + (size_t)row * D + c0 + col) = pk8(sig4(v0 * rs), sig4(v1 * rs)); EPI_END
        }
    }
};

template <int LDA_, int LDB_, int K_> struct PhaseN2048 {
    static constexpr int LDA = LDA_, LDB = LDB_, KT = K_ / 64;
    const Params& p; int G, c; size_t a_off, b_off;
    DI bool next_(int i, g8::Unit& u) const { int pm, pn; if (!g8::grid_order(NTM - 1, 8, G, c, i, pm, pn)) return false;
        u.pm = pm; u.pn = pn; u.A = (const char*)(p.ws + a_off) + (size_t)pm * 256 * LDA * 2; u.B = (const char*)(p.ws + b_off) + (size_t)pn * 256 * LDB * 2; return true; }
};
struct PhaseYb : PhaseN2048<POOLW, POOLW, POOLW> {
    DI bool next(int i, g8::Unit& u) const { return next_(i, u); }
    DI void epi(EPI_ARGS) const { const bf16_t* GB = (const bf16_t*)(p.ws + WS_GB); bf16_t* Y = (bf16_t*)(p.ws + WS_YBG);
#pragma unroll
        for (int ai = 0; ai < 2; ++ai) { u32x4 g[4][2];
#pragma unroll
            for (int m = 0; m < 4; ++m)
#pragma unroll
                for (int bj = 0; bj < 2; ++bj) g[m][bj] = *(const u32x4*)(GB + (size_t)(u.pm * 256 + ai * 128 + wr * 64 + m * 16 + fr) * D + u.pn * 256 + bj * 128 + wc * 32 + 8 * fq);
#pragma unroll
            for (int m = 0; m < 4; ++m)
#pragma unroll
                for (int bj = 0; bj < 2; ++bj) { const size_t o = (size_t)(u.pm * 256 + ai * 128 + wr * 64 + m * 16 + fr) * D + u.pn * 256 + bj * 128 + wc * 32 + 8 * fq;
                    *(u32x4*)(Y + o) = pk8(acc[ai][bj][m][0] * bf4lo(g[m][bj]), acc[ai][bj][m][1] * bf4hi(g[m][bj])); } } }
};
struct PhaseYa : PhaseN2048<VW, VW, VW> {
    DI bool next(int i, g8::Unit& u) const { return next_(i, u); }
    DI void epi(EPI_ARGS) const { const bf16_t* GA = (const bf16_t*)(p.ws + WS_GA); const bf16_t* Y = (const bf16_t*)(p.ws + WS_YBG); bf16_t* MB = (bf16_t*)(p.ws + WS_MB);
#pragma unroll
        for (int ai = 0; ai < 2; ++ai) { u32x4 g[4][2], y[4][2];
#pragma unroll
            for (int m = 0; m < 4; ++m)
#pragma unroll
                for (int bj = 0; bj < 2; ++bj) { const size_t o = (size_t)(u.pm * 256 + ai * 128 + wr * 64 + m * 16 + fr) * D + u.pn * 256 + bj * 128 + wc * 32 + 8 * fq;
                    g[m][bj] = *(const u32x4*)(GA + o); y[m][bj] = *(const u32x4*)(Y + o); }
#pragma unroll
            for (int m = 0; m < 4; ++m)
#pragma unroll
                for (int bj = 0; bj < 2; ++bj) { const size_t o = (size_t)(u.pm * 256 + ai * 128 + wr * 64 + m * 16 + fr) * D + u.pn * 256 + bj * 128 + wc * 32 + 8 * fq;
                    *(u32x4*)(MB + o) = pk8(acc[ai][bj][m][0] * bf4lo(g[m][bj]) + bf4lo(y[m][bj]), acc[ai][bj][m][1] * bf4hi(g[m][bj]) + bf4hi(y[m][bj])); } } }
};
template <bool BASE_BF16>
DI void epi_residual(EPI_ARGS, const void* base_v, bf16_t* HB, float* SS) {
#pragma unroll
    for (int ai = 0; ai < 2; ++ai)
#pragma unroll
        for (int mh = 0; mh < 2; ++mh) {
            f32x4 b0[2][2], b1[2][2];
#pragma unroll
            for (int mm = 0; mm < 2; ++mm) { const int row = u.pm * 256 + ai * 128 + wr * 64 + (2 * mh + mm) * 16 + fr;
#pragma unroll
                for (int bj = 0; bj < 2; ++bj) { const size_t o = (size_t)row * D + u.pn * 256 + bj * 128 + wc * 32 + 8 * fq;
                    if (BASE_BF16) { const u32x4 w = *(const u32x4*)((const bf16_t*)base_v + o); b0[mm][bj] = bf4lo(w); b1[mm][bj] = bf4hi(w); }
                    else { b0[mm][bj] = *(const f32x4*)((const float*)base_v + o); b1[mm][bj] = *(const f32x4*)((const float*)base_v + o + 4); } } }
#pragma unroll
            for (int mm = 0; mm < 2; ++mm) { const int m = 2 * mh + mm; const int row = u.pm * 256 + ai * 128 + wr * 64 + m * 16 + fr; float ss = 0.f;
#pragma unroll
                for (int bj = 0; bj < 2; ++bj) { const size_t o = (size_t)row * D + u.pn * 256 + bj * 128 + wc * 32 + 8 * fq;
                    const f32x4 h0 = acc[ai][bj][m][0] + b0[mm][bj], h1 = acc[ai][bj][m][1] + b1[mm][bj];
                    *(u32x4*)(HB + o) = pk8(h0, h1);
                    ss += sum4(h0 * h0) + sum4(h1 * h1); }
                ss += __shfl_xor(ss, 16); ss += __shfl_xor(ss, 32);
                if (fq == 0) SS[(size_t)row * 32 + u.pn * 4 + wc] = ss; }
        }
}
struct PhaseOut : PhaseN2048<D, D, D> {
    DI bool next(int i, g8::Unit& u) const { return next_(i, u); }
    DI void epi(EPI_ARGS) const { epi_residual<false>(acc, u, wr, wc, fr, fq, p.x_prompt, (bf16_t*)(p.ws + WS_H1B), (float*)(p.ws + WS_SS1)); }
};
struct PhaseDown : PhaseN2048<DFF, DFF, DFF> {
    DI bool next(int i, g8::Unit& u) const { return next_(i, u); }
    DI void epi(EPI_ARGS) const { epi_residual<true>(acc, u, wr, wc, fr, fq, p.ws + WS_H1B, (bf16_t*)(p.ws + WS_H2B), (float*)(p.ws + WS_SS2)); }
};
struct PhasePe : PhaseN2048<PLE, PLE, PLE> {
    DI bool next(int i, g8::Unit& u) const { const int first = (NTM * 43) % G, nfree = G - first; if (nfree <= 0 || c < first) return false;
        const long L = (long)i * nfree + (c - first); if (L >= 256) return false; const int pm = (int)L >> 3, pn = (int)L & 7;
        u.pm = pm; u.pn = pn; u.A = (const char*)(p.ws + a_off) + (size_t)pm * 256 * LDA * 2; u.B = (const char*)(p.ws + b_off) + (size_t)pn * 256 * LDB * 2; return true; }
    DI void epi(EPI_ARGS) const { bf16_t* PE = (bf16_t*)(p.ws + WS_PE);
        EPI_ROWS(row) EPI_COLS(col) const size_t o = (size_t)row * D + u.pn * 256 + col; *(u32x4*)(PE + o) = pk8(v0, v1); EPI_END }
};
struct PhasePg : PhaseN2048<D, D, D> {
    DI bool next(int i, g8::Unit& u) const { return next_(i, u); }
    DI void epi(EPI_ARGS) const { const bf16_t* H2 = (const bf16_t*)(p.ws + WS_H2B); const bf16_t* PE = (const bf16_t*)(p.ws + WS_PE); const float* SS2 = (const float*)(p.ws + WS_SS2);
        float* H3 = (float*)(p.ws + WS_H3); float* SS3 = (float*)(p.ws + WS_SS3);
#pragma unroll
        for (int ai = 0; ai < 2; ++ai)
#pragma unroll
            for (int mh = 0; mh < 2; ++mh) { u32x4 hw[2][2], pw[2][2]; float rs[2];
#pragma unroll
                for (int mm = 0; mm < 2; ++mm) { const int row = u.pm * 256 + ai * 128 + wr * 64 + (2 * mh + mm) * 16 + fr; float s2 = 0.f;
#pragma unroll
                    for (int k = 0; k < 8; ++k) s2 += sum4(*(const f32x4*)(SS2 + (size_t)row * 32 + 4 * k));
                    rs[mm] = 1.0f / sqrtf(s2 * (1.0f / D) + EPS);
#pragma unroll
                    for (int bj = 0; bj < 2; ++bj) { const size_t o = (size_t)row * D + u.pn * 256 + bj * 128 + wc * 32 + 8 * fq; hw[mm][bj] = *(const u32x4*)(H2 + o); pw[mm][bj] = *(const u32x4*)(PE + o); } }
#pragma unroll
                for (int mm = 0; mm < 2; ++mm) { const int m = 2 * mh + mm; const int row = u.pm * 256 + ai * 128 + wr * 64 + m * 16 + fr; float ss = 0.f;
#pragma unroll
                    for (int bj = 0; bj < 2; ++bj) { const size_t o = (size_t)row * D + u.pn * 256 + bj * 128 + wc * 32 + 8 * fq;
                        const f32x4 h0 = bf4lo(hw[mm][bj]) + sig4(acc[ai][bj][m][0] * rs[mm]) * bf4lo(pw[mm][bj]), h1 = bf4hi(hw[mm][bj]) + sig4(acc[ai][bj][m][1] * rs[mm]) * bf4hi(pw[mm][bj]);
                        *(f32x4*)(H3 + o) = h0; *(f32x4*)(H3 + o + 4) = h1; ss += sum4(h0 * h0) + sum4(h1 * h1); }
                    ss += __shfl_xor(ss, 16); ss += __shfl_xor(ss, 32);
                    if (fq == 0) SS3[(size_t)row * 32 + u.pn * 4 + wc] = ss; } } }
};
struct PhaseUp {
    static constexpr int LDA = D, LDB = D, KT = D / 64;
    const Params& p; int G, c;
    DI bool next(int i, g8::Unit& u) const { int pm, pn; if (!g8::grid_order(NTM, 43, G, c, i, pm, pn)) return false;
        u.pm = pm; u.pn = pn; u.A = (const char*)(p.ws + WS_H1B) + (size_t)pm * 256 * D * 2; u.B = (const char*)(p.ws + WS_WUP) + (size_t)pn * 256 * D * 2; return true; }
    DI void epi(EPI_ARGS) const { bf16_t* GU = (bf16_t*)(p.ws + WS_GU);
        EPI_ROWS(row) EPI_COLS(col) *(u32x4*)(GU + (size_t)row * NUP + u.pn * 256 + col) = pk8(v0, v1); EPI_END }
};

struct PhaseWpb {
    static constexpr int LDA = POOLW, LDB = 256, KT = 4;
    const Params& p; int G, c;
    DI bool next(int i, g8::Unit& u) const { const int off = 220 % G; const long L = (long)i * G + ((c + G - off) % G); if (L >= 32) return false;
        const int pm = (int)L >> 2, g = (int)L & 3; u.pm = pm; u.pn = g;
        u.A = (const char*)(p.ws + WS_WBT) + ((size_t)pm * 256 * POOLW + g * 256) * 2; u.B = (const char*)(p.ws + WS_WPS) + (size_t)g * 256 * 256 * 2; return true; }
    DI void epi(EPI_ARGS) const { bf16_t* W = (bf16_t*)(p.ws + WS_WPB);
        EPI_ROWS(row) EPI_COLS(col) *(u32x4*)(W + (size_t)row * POOLW + u.pn * 256 + col) = pk8(v0, v1); EPI_END }
};

template <int KS, int LDA, int LDB>
DI f32x4 skinny16(const bf16_t* A, const bf16_t* W, int lane) {
    const int fr = lane & 15, fq = lane >> 4;
    const bf16_t* ap = A + (size_t)fr * LDA + 8 * fq; const bf16_t* bp = W + (size_t)fr * LDB + 8 * fq;
    f32x4 acc = {0.f, 0.f, 0.f, 0.f};
#pragma unroll 4
    for (int s = 0; s < KS; ++s) { const bf16x8 a = *(const bf16x8*)(ap + 32 * s), b = *(const bf16x8*)(bp + 32 * s); acc = __builtin_amdgcn_mfma_f32_16x16x32_bf16(a, b, acc, 0, 0, 0); }
    return acc;
}
DI float sum16(float v) { v += __shfl_xor(v, 1); v += __shfl_xor(v, 2); v += __shfl_xor(v, 4); v += __shfl_xor(v, 8); return v; }
template <int KIND, int K, int LDA, int LDB, int NCG = 128>
DI void sample_gemm(const Params& p, LAS unsigned char* lds, size_t a_off, size_t w_off, int wave) {
    unsigned char* ws = p.ws; const int lane = lane_id(), fr = lane & 15, fq = lane >> 4;
    constexpr int KS = K / 64;
    for (int it = blockIdx.x; it < 2 * NCG; it += gridDim.x) {
        const int cg_ = it >> 1, r0 = MP + 64 * (it & 1) + 16 * (wave & 3), col = 16 * cg_ + fr, kh = wave >> 2;
        f32x4 acc = skinny16<KS, LDA, LDB>((const bf16_t*)(ws + a_off) + (size_t)r0 * LDA + kh * (K / 2), (const bf16_t*)(ws + w_off) + (size_t)(16 * cg_) * LDB + kh * (K / 2), lane);
        LAS f32x4* xch = (LAS f32x4*)lds;
        if (kh == 1) xch[(wave & 3) * 64 + lane] = acc;
        __syncthreads();
        if (kh == 0) {
        acc += xch[wave * 64 + lane];
        float rs[4] = {0.f, 0.f, 0.f, 0.f};
        if (KIND == 5) {
            const float* SS2S = (const float*)(ws + WS_SS2S);
#pragma unroll
            for (int r = 0; r < 16; ++r) { const float* q = SS2S + (size_t)(r0 - MP + r) * 128; const float s_ = wave_sum(q[lane] + q[64 + lane]); const float rr = 1.0f / sqrtf(s_ * (1.0f / D) + EPS);
#pragma unroll
                for (int j = 0; j < 4; ++j) rs[j] = (r == 4 * fq + j) ? rr : rs[j]; }
        }
#pragma unroll
        for (int j = 0; j < 4; ++j) {
            const int row = r0 + 4 * fq + j; const size_t o = (size_t)row * D + col; const float v = acc[j]; float hsq = 0.f;
            if (KIND == 6) { const float val = v * ((const float*)(ws + WS_RSTD1))[row];
                if (col < KW) ((bf16_t*)(ws + WS_QB))[(size_t)row * KW + col] = (bf16_t)(pk2(val * 0.0625f, 0.f) & 0xffffu);
                else if (col < 2 * KW) ((bf16_t*)(ws + WS_KB))[(size_t)row * KW + col - KW] = (bf16_t)(pk2(val, 0.f) & 0xffffu);
                else ((bf16_t*)(ws + WS_V))[(size_t)row * VW + col - 2 * KW] = (bf16_t)(pk2(val, 0.f) & 0xffffu); }
            if (KIND == 0) { ((bf16_t*)(ws + WS_YBG))[o] = (bf16_t)(pk2(v * bf1(((const bf16_t*)(ws + WS_GB))[o]), 0.f) & 0xffffu); }
            if (KIND == 1) { ((bf16_t*)(ws + WS_MB))[o] = (bf16_t)(pk2(v * bf1(((const bf16_t*)(ws + WS_GA))[o]) + bf1(((const bf16_t*)(ws + WS_YBG))[o]), 0.f) & 0xffffu); }
            if (KIND == 2) { const float hv = p.x_sample[(size_t)(row - MP) * D + col] + v; ((bf16_t*)(ws + WS_H1B))[o] = (bf16_t)(pk2(hv, 0.f) & 0xffffu); hsq = hv * hv; }
            if (KIND == 3) { const float hv = bf1(((const bf16_t*)(ws + WS_H1B))[o]) + v; ((bf16_t*)(ws + WS_H2B))[o] = (bf16_t)(pk2(hv, 0.f) & 0xffffu); hsq = hv * hv; }
            if (KIND == 4) { ((bf16_t*)(ws + WS_PE))[o] = (bf16_t)(pk2(v, 0.f) & 0xffffu); }
            if (KIND == 5) { const float hv = bf1(((const bf16_t*)(ws + WS_H2B))[o]) + sigmoidf_(v * rs[j]) * bf1(((const bf16_t*)(ws + WS_PE))[o]); ((float*)(ws + WS_H3))[o] = hv; hsq = hv * hv; }
            if (KIND == 2 || KIND == 3 || KIND == 5) { const float t = sum16(hsq);
                float* SSx = (float*)(ws + (KIND == 2 ? WS_SS1S : (KIND == 3 ? WS_SS2S : WS_SS3S))); if (fr == 0) SSx[(size_t)(row - MP) * 128 + cg_] = t; }
        }
        }
        __syncthreads();
    }
}


#define XB_TMO      128
#define XB_XCNT(j)  (256  + 64 * (j))
#define XB_XSUB(j)  (1280 + 64 * (j))
#define XB_XGEN(j)  (2304 + 64 * (j))
#define XB_TOP      3328
#define XB_TOPGEN   3392
#define XCD_BAR_WORDS 3456
#define XB_SPIN_CAP (1u << 22)
DI unsigned xb_ld(unsigned* p)              { return __hip_atomic_load(p, __ATOMIC_RELAXED, __HIP_MEMORY_SCOPE_AGENT); }
DI unsigned xb_add(unsigned* p, unsigned v) { return __hip_atomic_fetch_add(p, v, __ATOMIC_RELAXED, __HIP_MEMORY_SCOPE_AGENT); }
DI unsigned xb_xcc_id() { return (unsigned)__builtin_amdgcn_s_getreg((3 << 11) | 20) & 0xFu; }
#define XB_SPIN(cond, bar) do { unsigned _sp = 0; while (cond) { __builtin_amdgcn_s_sleep(1); \
    if ((++_sp & 255u) == 0u) { if (xb_ld(&(bar)[XB_TMO])) break; if (_sp > XB_SPIN_CAP) { atomicAdd(&(bar)[XB_TMO], 1u); break; } } } } while (0)
struct XcdBarrier { unsigned* bar; unsigned x; volatile LAS unsigned* st; };
DI XcdBarrier xcd_barrier_post(unsigned* bar, volatile LAS unsigned* st, bool t0) {
    XcdBarrier b; b.bar = bar; b.x = xb_xcc_id(); b.st = st;
    if (t0) (void)xb_add(&bar[XB_XCNT(b.x)], 1u);
    return b;
}
DI void xcd_barrier_complete(unsigned* bar, unsigned x, unsigned& nloc, unsigned& nx) {
    const unsigned G = gridDim.x * gridDim.y * gridDim.z;
    unsigned sum, cnt, mine, sp = 0u;
    for (;;) {
        sum = 0u; cnt = 0u; mine = 0u;
#pragma unroll
        for (unsigned j = 0; j < 16; ++j) { const unsigned c = xb_ld(&bar[XB_XCNT(j)]); sum += c; cnt += (c > 0u) ? 1u : 0u; mine = (j == x) ? c : mine; }
        if (sum == G) break;
        __builtin_amdgcn_s_sleep(1);
        if ((++sp & 255u) == 0u) { if (xb_ld(&bar[XB_TMO])) break; if (sp > XB_SPIN_CAP) { atomicAdd(&bar[XB_TMO], 1u); break; } }
    }
    nloc = mine > 0u ? mine : 1u; nx = cnt > 0u ? cnt : 1u;
}
DI void xcd_barrier(const XcdBarrier& b, bool t0) {
    asm volatile("s_waitcnt vmcnt(0)" ::: "memory");
    __syncthreads();
    if (t0) {
        unsigned* bar = b.bar;
        __builtin_amdgcn_s_waitcnt(0);
        unsigned nloc = b.st[0], nx = b.st[1];
        if (nloc == 0u) { xcd_barrier_complete(bar, b.x, nloc, nx); b.st[0] = nloc; b.st[1] = nx; }
        const unsigned old = xb_add(&bar[XB_XSUB(b.x)], 1u);
        const unsigned gen = old / nloc;
        if (old + 1u == (gen + 1u) * nloc) {
            __builtin_amdgcn_fence(__ATOMIC_RELEASE, "agent");
            asm volatile("s_waitcnt vmcnt(0)" ::: "memory");
            const unsigned og = xb_add(&bar[XB_TOP], 1u);
            const unsigned tg = og / nx;
            if (og + 1u == (tg + 1u) * nx) xb_add(&bar[XB_TOPGEN], 1u);
            else XB_SPIN(xb_ld(&bar[XB_TOPGEN]) == tg, bar);
            __builtin_amdgcn_fence(__ATOMIC_ACQUIRE, "agent");
            xb_add(&bar[XB_XGEN(b.x)], 1u);
            asm volatile("s_waitcnt vmcnt(0)" ::: "memory");
        } else {
            XB_SPIN(xb_ld(&bar[XB_XGEN(b.x)]) == gen, bar);
            __builtin_amdgcn_fence(__ATOMIC_ACQUIRE, "agent");
            asm volatile("s_waitcnt vmcnt(0)" ::: "memory");
        }
    }
    __syncthreads();
}

constexpr int N_PHASES = 13;
#ifndef G8_SP2
#define G8_SP2 true
#endif
#ifndef G8_ALIGN
#define G8_ALIGN true
#endif

__global__ void __launch_bounds__(NTHREADS, 2) fwd_kernel(Params p) {
    extern __shared__ __attribute__((aligned(16))) unsigned char lds_raw[];
    LAS unsigned char* lds = (LAS unsigned char*)lds_raw;
    const int G = gridDim.x, c = blockIdx.x;
    const int wave = __builtin_amdgcn_readfirstlane(threadIdx.x >> 6);
    const int lo = p.ph_lo, hi = p.ph_hi;
#ifndef REPEAT_MASK
#define REPEAT_MASK 0
#endif
#ifndef PHASE_MASK
#define PHASE_MASK 0x1bff
#endif
#define IN(k) (((PHASE_MASK >> (k)) & 1) && lo <= (k) && (k) < hi)
    volatile LAS unsigned* bst = (volatile LAS unsigned*)(lds + LDS_MISC);
    const bool t0 = (wave == 0) && (lane_id() == 0);
    XcdBarrier bar; bar.bar = (unsigned*)(p.ws + WS_CTL); bar.x = 0; bar.st = bst;
    if (hi - lo > 1) { if (t0) { bst[0] = 0u; bst[1] = 0u; } __syncthreads(); bar = xcd_barrier_post((unsigned*)(p.ws + WS_CTL), bst, t0); }
#define NEXTPH(k) ((k) == 9 ? 11 : (k) + 1)
#define SEAM(k) do { if (IN(k) && IN(NEXTPH(k))) { xcd_barrier(bar, (wave == 0) && (lane_id() == 0)); } } while (0)
    if (IN(0)) { phase_p0(p, lds, wave); if ((REPEAT_MASK >> 0) & 1) { xcd_barrier(bar, (wave == 0) && (lane_id() == 0)); phase_p0(p, lds, wave); } } SEAM(0);
    if (IN(1)) { sample_gemm<6, D, D, D, 256>(p, lds, WS_XB, WS_WIN, wave); PhaseIn ph{p, G, c, 0, 0}; g8::run<PhaseIn, G8_ALIGN, G8_SP2>(lds, ph, wave); } SEAM(1);
    if (IN(2)) {
        if (G == 256) {
            if (c < 32) scan_role(p, lds, wave, c, 32);
            else if (c < 71) stream_role(p, wave, c - 32, 39);
            else { PhaseIn ph{p, G, c, 1, 71}; g8::run<PhaseIn, G8_ALIGN, G8_SP2>(lds, ph, wave); PhaseWpb pw{p, G, c}; g8::run<PhaseWpb, G8_ALIGN, G8_SP2>(lds, pw, wave); }
        } else {
            PhaseIn ph{p, G, c, 1, 0}; g8::run<PhaseIn, G8_ALIGN, G8_SP2>(lds, ph, wave); PhaseWpb pw{p, G, c}; g8::run<PhaseWpb, G8_ALIGN, G8_SP2>(lds, pw, wave);
            scan_role(p, lds, wave, c, G); stream_role(p, wave, c, G);
        }
    } SEAM(2);
    if (IN(3)) { phase_p3(p, wave); if ((REPEAT_MASK >> 3) & 1) { xcd_barrier(bar, (wave == 0) && (lane_id() == 0)); phase_p3(p, wave); } } SEAM(3);
    if (IN(4)) { sample_gemm<0, POOLW, POOLW, POOLW>(p, lds, WS_PM, WS_WPB, wave); PhaseYb ph{{p, G, c, WS_PM, WS_WPB}}; g8::run<PhaseYb, G8_ALIGN, G8_SP2>(lds, ph, wave); if ((REPEAT_MASK >> 4) & 1) { xcd_barrier(bar, (wave == 0) && (lane_id() == 0)); sample_gemm<0, POOLW, POOLW, POOLW>(p, lds, WS_PM, WS_WPB, wave); PhaseYb ph{{p, G, c, WS_PM, WS_WPB}}; g8::run<PhaseYb, G8_ALIGN, G8_SP2>(lds, ph, wave); } } SEAM(4);
    if (IN(5)) { sample_gemm<1, VW, VW, VW>(p, lds, WS_OG, WS_WA, wave); PhaseYa ph{{p, G, c, WS_OG, WS_WA}}; g8::run<PhaseYa, G8_ALIGN, G8_SP2>(lds, ph, wave); if ((REPEAT_MASK >> 5) & 1) { xcd_barrier(bar, (wave == 0) && (lane_id() == 0)); sample_gemm<1, VW, VW, VW>(p, lds, WS_OG, WS_WA, wave); PhaseYa ph{{p, G, c, WS_OG, WS_WA}}; g8::run<PhaseYa, G8_ALIGN, G8_SP2>(lds, ph, wave); } } SEAM(5);
    if (IN(6)) { sample_gemm<2, D, D, D>(p, lds, WS_MB, WS_WO, wave); PhaseOut ph{{p, G, c, WS_MB, WS_WO}}; g8::run<PhaseOut, G8_ALIGN, G8_SP2>(lds, ph, wave); if ((REPEAT_MASK >> 6) & 1) { xcd_barrier(bar, (wave == 0) && (lane_id() == 0)); sample_gemm<2, D, D, D>(p, lds, WS_MB, WS_WO, wave); PhaseOut ph{{p, G, c, WS_MB, WS_WO}}; g8::run<PhaseOut, G8_ALIGN, G8_SP2>(lds, ph, wave); } } SEAM(6);
    if (IN(7)) { PhaseUp ph{p, G, c}; g8::run<PhaseUp, G8_ALIGN, G8_SP2>(lds, ph, wave); sample_gemm<4, PLE, PLE, PLE>(p, lds, WS_PLB, WS_WPLE, wave); { PhasePe pe{{p, G, c, WS_PLB, WS_WPLE}}; g8::run<PhasePe, G8_ALIGN, G8_SP2>(lds, pe, wave); } if ((REPEAT_MASK >> 7) & 1) { xcd_barrier(bar, (wave == 0) && (lane_id() == 0)); PhaseUp ph{p, G, c}; g8::run<PhaseUp, G8_ALIGN, G8_SP2>(lds, ph, wave); } } SEAM(7);
    if (IN(8)) { phase_conv(p, wave); if ((REPEAT_MASK >> 8) & 1) { xcd_barrier(bar, (wave == 0) && (lane_id() == 0)); phase_conv(p, wave); } } SEAM(8);
    if (IN(9)) { sample_gemm<3, DFF, DFF, DFF>(p, lds, WS_ACT, WS_WD, wave); PhaseDown ph{{p, G, c, WS_ACT, WS_WD}}; g8::run<PhaseDown, G8_ALIGN, G8_SP2>(lds, ph, wave); if ((REPEAT_MASK >> 9) & 1) { xcd_barrier(bar, (wave == 0) && (lane_id() == 0)); sample_gemm<3, DFF, DFF, DFF>(p, lds, WS_ACT, WS_WD, wave); PhaseDown ph{{p, G, c, WS_ACT, WS_WD}}; g8::run<PhaseDown, G8_ALIGN, G8_SP2>(lds, ph, wave); } } SEAM(9);
    if (IN(11)) { sample_gemm<5, D, D, D>(p, lds, WS_H2B, WS_WPG, wave); PhasePg ph{{p, G, c, WS_H2B, WS_WPG}}; g8::run<PhasePg, G8_ALIGN, G8_SP2>(lds, ph, wave); if ((REPEAT_MASK >> 11) & 1) { xcd_barrier(bar, (wave == 0) && (lane_id() == 0)); sample_gemm<5, D, D, D>(p, lds, WS_H2B, WS_WPG, wave); PhasePg ph{{p, G, c, WS_H2B, WS_WPG}}; g8::run<PhasePg, G8_ALIGN, G8_SP2>(lds, ph, wave); } } SEAM(11);
    if (IN(12)) { phase_final(p, wave); if ((REPEAT_MASK >> 12) & 1) { xcd_barrier(bar, (wave == 0) && (lane_id() == 0)); phase_final(p, wave); } }
#undef IN
#undef SEAM
}

extern "C" void kernel_launch(void* const* d_in, const int* in_sizes, int n_in, void* d_out, int out_size, void* d_ws, size_t ws_size, hipStream_t stream) {
    static int grid = 0;
    if (grid == 0) {
        if (n_in != 26 || (size_t)out_size != O_END || ws_size < WS_END) {
            fprintf(stderr, "kernel_launch: unexpected problem: n_in %d out %d ws %zu (need %zu)\n", n_in, out_size, ws_size, (size_t)WS_END); grid = -1; return; }
        int dev = 0, cus = 0, per_cu = 0;
        if (hipGetDevice(&dev) != hipSuccess || hipDeviceGetAttribute(&cus, hipDeviceAttributeMultiprocessorCount, dev) != hipSuccess) { grid = -1; return; }
        if (hipFuncSetAttribute((const void*)fwd_kernel, hipFuncAttributeMaxDynamicSharedMemorySize, LDS_BYTES) != hipSuccess) { fprintf(stderr, "kernel_launch: hipFuncSetAttribute failed\n"); grid = -1; return; }
        if (hipOccupancyMaxActiveBlocksPerMultiprocessor(&per_cu, (const void*)fwd_kernel, NTHREADS, LDS_BYTES) != hipSuccess || per_cu < 1) {
            fprintf(stderr, "kernel_launch: occupancy query reports %d blocks per CU\n", per_cu); (void)hipGetLastError(); grid = -1; return; }
        grid = cus;
    }
    if (grid < 0) return;
    Params p{};
    const float** pp = (const float**)&p;
    for (int i = 0; i < 26; ++i) pp[i] = (const float*)d_in[i];
    p.out = (float*)d_out; p.ws = (unsigned char*)d_ws;
#if MK_N_LAUNCHES == 1
    p.ph_lo = 0; p.ph_hi = N_PHASES;
    void* args[] = {&p};
    if (hipMemsetAsync((char*)d_ws + WS_CTL, 0, XCD_BAR_WORDS * 4, stream) != hipSuccess) { fprintf(stderr, "kernel_launch: memset failed\n"); return; }
    hipError_t e = hipLaunchCooperativeKernel((const void*)fwd_kernel, dim3(grid), dim3(NTHREADS), args, LDS_BYTES, stream);
    if (e != hipSuccess) fprintf(stderr, "kernel_launch: cooperative launch failed: %s (grid %d)\n", hipGetErrorString(e), grid);
#else
    for (int k = 0; k < N_PHASES; ++k) { p.ph_lo = k; p.ph_hi = k + 1; hipLaunchKernelGGL(fwd_kernel, dim3(grid), dim3(NTHREADS), LDS_BYTES, stream, p); }
#endif
}
```

```cpp
#include <hip/hip_runtime.h>
#include <hip/hip_cooperative_groups.h>
#include <cstdio>
#include <cstdint>
namespace cg = cooperative_groups;

#ifndef MK_N_LAUNCHES
#define MK_N_LAUNCHES 1
#endif

#define LAS __attribute__((address_space(3)))
#define DI __device__ __forceinline__
typedef unsigned short bf16_t;
typedef short bf16x8 __attribute__((ext_vector_type(8)));
typedef short s16x4 __attribute__((ext_vector_type(4)));
typedef float f32x4 __attribute__((ext_vector_type(4)));
typedef float f32x2 __attribute__((ext_vector_type(2)));
typedef float f32x16 __attribute__((ext_vector_type(16)));
typedef unsigned u32x4 __attribute__((ext_vector_type(4)));
typedef unsigned u32x2 __attribute__((ext_vector_type(2)));

constexpr int D = 2048, MP = 8192, MS = 128, M = MP + MS, MPAD = 8448, NTM = 33;
constexpr int SEQ = 2048, NB = 4, NH = 4, DK = 256, DV = 512, KW = 1024, VW = 2048;
constexpr int DFF = 5504, NUP = 2 * DFF, PLE = 256, POOLW = 1024, INW = 11280, NIN = 11264;
constexpr float EPS = 1e-6f;
constexpr int NSL = 16;
constexpr int CH = 32, NCHK = MP / CH;

constexpr size_t O_YP = 0, O_YS = O_YP + (size_t)MP * D, O_GLAP = O_YS + (size_t)MS * D, O_POOLP = O_GLAP + (size_t)NB * NH * DK * DV,
                 O_CONVP = O_POOLP + (size_t)NB * 15 * POOLW, O_GLAS = O_CONVP + (size_t)NB * 2 * DFF, O_POOLS = O_GLAS + (size_t)MS * NH * DK * DV,
                 O_CONVS = O_POOLS + (size_t)MS * 15 * POOLW, O_END = O_CONVS + (size_t)MS * 2 * DFF;

constexpr size_t al(size_t x) { return (x + 255) & ~(size_t)255; }
constexpr size_t WS_CTL = 0, CTL_BYTES = 65536;
constexpr size_t WS_WUP = WS_CTL + CTL_BYTES;
constexpr size_t WS_WD = WS_WUP + al((size_t)NUP * D * 2);
constexpr size_t WS_WA = WS_WD + al((size_t)D * DFF * 2);
constexpr size_t WS_WO = WS_WA + al((size_t)D * D * 2);
constexpr size_t WS_WPG = WS_WO + al((size_t)D * D * 2);
constexpr size_t WS_WPB = WS_WPG + al((size_t)D * D * 2);
constexpr size_t WS_WPLE = WS_WPB + al((size_t)D * POOLW * 2);
constexpr size_t WS_WBT = WS_WPLE + al((size_t)D * PLE * 2);
constexpr size_t WS_WPS = WS_WBT + al((size_t)D * POOLW * 2);
constexpr size_t WS_SMALL = WS_WPS + al((size_t)POOLW * 256 * 2);
constexpr size_t WS_RSTD1 = WS_SMALL;
constexpr size_t WS_LAM = WS_RSTD1 + al((size_t)MPAD * 4);
constexpr size_t WS_OSS = WS_LAM + al((size_t)(NCHK + MS) * KW * 4);
constexpr size_t WS_OSP = WS_OSS + al((size_t)MP * NH * NSL * 4);
constexpr size_t WS_SS1 = WS_OSP + al((size_t)MS * NH * 8 * DV * 4);
constexpr size_t WS_SS2 = WS_SS1 + al((size_t)MPAD * 32 * 4);
constexpr size_t WS_SS3 = WS_SS2 + al((size_t)MPAD * 32 * 4);
constexpr size_t WS_SS1S = WS_SS3 + al((size_t)MPAD * 32 * 4);
constexpr size_t WS_SS2S = WS_SS1S + al((size_t)MS * 128 * 4);
constexpr size_t WS_SS3S = WS_SS2S + al((size_t)MS * 128 * 4);
constexpr size_t WS_PLB = WS_SS3S + al((size_t)MS * 128 * 4);
constexpr size_t WS_R1 = WS_PLB + al((size_t)MPAD * PLE * 2);
constexpr size_t WS_XB = WS_R1;
constexpr size_t WS_WIN = WS_XB + al((size_t)MPAD * D * 2);
constexpr size_t WS_BCUM = WS_WIN + al((size_t)NIN * D * 2);
constexpr size_t WS_R1_END = WS_BCUM + al((size_t)MPAD * KW * 4);
constexpr size_t WS_ACT = WS_R1;
static_assert(WS_ACT + al((size_t)MPAD * DFF * 2) <= WS_R1_END, "R1 overlay");
constexpr size_t WS_R2 = WS_R1_END;
constexpr size_t WS_QB = WS_R2;
constexpr size_t WS_KB = WS_QB + al((size_t)MPAD * KW * 2);
constexpr size_t WS_KD = WS_KB + al((size_t)MPAD * KW * 2);
constexpr size_t WS_V = WS_KD + al((size_t)MPAD * KW * 2);
constexpr size_t WS_SR = WS_V + al((size_t)MPAD * VW * 2);
constexpr size_t WS_GA = WS_SR + al((size_t)MPAD * VW * 2);
constexpr size_t WS_GB = WS_GA + al((size_t)MPAD * D * 2);
constexpr size_t WS_U = WS_GB + al((size_t)MPAD * D * 2);
constexpr size_t WS_OG = WS_U + al((size_t)MPAD * POOLW * 4);
constexpr size_t WS_PM = WS_OG + al((size_t)MPAD * VW * 2);
constexpr size_t WS_YBG = WS_PM + al((size_t)MPAD * POOLW * 2);
constexpr size_t WS_R2_END = WS_YBG + al((size_t)MPAD * D * 4);
constexpr size_t WS_GU = WS_R2;
constexpr size_t WS_H2 = WS_GU + al((size_t)MPAD * NUP * 2);
constexpr size_t WS_PE = WS_H2 + al((size_t)MPAD * D * 4);
static_assert(WS_PE + al((size_t)MPAD * D * 4) <= WS_R2_END, "R2 overlay");
constexpr size_t WS_MB = WS_R2_END;
constexpr size_t WS_H1 = WS_MB + al((size_t)MPAD * D * 2);
constexpr size_t WS_H1B = WS_H1 + al((size_t)MPAD * D * 4);
constexpr size_t WS_END = WS_H1B + al((size_t)MPAD * D * 2);
constexpr size_t WS_H3 = WS_H1;
constexpr size_t WS_H2B = WS_MB;

DI unsigned pk2(float lo, float hi) {
    typedef __bf16 bf2 __attribute__((ext_vector_type(2)));
    f32x2 v = {lo, hi};
    bf2 b = __builtin_convertvector(v, bf2);
    return __builtin_bit_cast(unsigned, b);
}
DI float bflo(unsigned w) { return __uint_as_float(w << 16); }
DI float bfhi(unsigned w) { return __uint_as_float(w & 0xffff0000u); }
DI float bf1(bf16_t b) { return __uint_as_float(((unsigned)b) << 16); }
DI float fexp(float x) { return __expf(x); }
DI float sigmoidf_(float x) { return __builtin_amdgcn_rcpf(1.0f + __expf(-x)); }
DI float siluf_(float x) { return x * sigmoidf_(x); }
DI float logsigmoidf_(float z) { return fminf(z, 0.f) - __logf(1.0f + __expf(-fabsf(z))); }
DI u32x4 pk8(f32x4 a, f32x4 b) { u32x4 o; o.x = pk2(a.x, a.y); o.y = pk2(a.z, a.w); o.z = pk2(b.x, b.y); o.w = pk2(b.z, b.w); return o; }
DI f32x4 bf4lo(u32x4 w) { return (f32x4){bflo(w.x), bfhi(w.x), bflo(w.y), bfhi(w.y)}; }
DI f32x4 bf4hi(u32x4 w) { return (f32x4){bflo(w.z), bfhi(w.z), bflo(w.w), bfhi(w.w)}; }
DI float wave_sum(float v) {
#pragma unroll
    for (int o = 1; o < 64; o <<= 1) v += __shfl_xor(v, o);
    return v;
}
DI int lane_id() { int l; asm volatile("v_mbcnt_lo_u32_b32 %0, -1, 0\n\tv_mbcnt_hi_u32_b32 %0, -1, %0" : "=v"(l)); return l; }
#define LDS_WAIT() asm volatile("s_waitcnt lgkmcnt(0)" ::: "memory")
#define VM_WAIT() asm volatile("s_waitcnt vmcnt(0)" ::: "memory")

struct Params {
    const float *x_prompt, *x_sample, *state_gla, *state_pool, *state_conv, *p_prompt, *p_sample;
    const float *norm_mix, *w_in, *w_gate_up, *b_gate, *gla_norm, *w_branch_a, *w_pool, *pool_scale, *w_branch_b, *w_out, *norm_ffn, *w_up, *conv_w, *conv_b,
        *w_down, *norm_ple, *w_ple_gate, *w_ple, *norm_final;
    float* out; unsigned char* ws;
    int ph_lo, ph_hi;
};

constexpr int NWAVES = 8, NTHREADS = 512;
constexpr int LDS_BYTES = 163840;
constexpr int LDS_MISC = LDS_BYTES - 256;

namespace g8 {
constexpr int BM = 256, BK = 64, HALF = 128, HTB = HALF * BK * 2, STAGE_BYTES = 8 * HTB, NXCD = 8, WGM = 2;
DI int lds_byte(int r, int c) { const int st = (r >> 4) * 2 + (c >> 5), rr = r & 15, cc = c & 31, ob = rr * 64 + cc * 2; return st * 1024 + (ob ^ (((ob >> 9) & 1) << 5)); }
DI void stage_rc(int b, int& R, int& C) { const int st = b / 1024, sb = b % 1024, swz = sb ^ (((sb >> 9) & 1) << 5); R = (st >> 1) * 16 + swz / 64; C = (st & 1) * 32 + (swz % 64) / 2; }
DI int perm32(int rho) { const int n = rho >> 4, i = rho & 15; return 8 * (i >> 2) + 4 * n + (i & 3); }

struct Unit { const char* A; const char* B; int pm, pn; };

DI bool grid_order(int nM, int nN, int G, int c, int i, int& pm, int& pn) {
    const int nwg = nM * nN; const long L = (long)i * G + c; if (L >= nwg) return false;
    int wgid = (int)L; { const int q = nwg / NXCD, r = nwg % NXCD, xcd = wgid % NXCD, off = wgid / NXCD; wgid = (xcd < r ? xcd * (q + 1) : r * (q + 1) + (xcd - r) * q) + off; }
    const int nig = WGM * nN, gid = wgid / nig, fm = gid * WGM, gsz = (nM - fm) < WGM ? (nM - fm) : WGM;
    pm = fm + ((wgid % nig) % gsz); pn = (wgid % nig) / gsz; return true;
}

template <class P, bool ALIGN_EPI, bool SP2>
DI void run(LAS unsigned char* lds, const P& ph, int wid) {
    const int lane = lane_id(), tid = wid * 64 + lane, wr = wid >> 2, wc = wid & 3, fr = lane & 15, fq = lane >> 4;
    constexpr int nt = P::KT;
    unsigned voffA[2], voffB[2];
#pragma unroll
    for (int i = 0; i < 2; ++i) { int R, C; stage_rc(tid * 16 + i * 8192, R, C); const int Rb = (R & ~31) + perm32(R & 31);
        voffA[i] = (unsigned)(R * P::LDA + C) * 2u; voffB[i] = (unsigned)(Rb * P::LDB + C) * 2u; }
    constexpr size_t kstep = (size_t)(BK * 2);
    constexpr size_t hstepA = (size_t)HALF * P::LDA * 2, hstepB = (size_t)HALF * P::LDB * 2;
    const unsigned ldsw = (unsigned)wid * 1024u;
    const int aoff = lds_byte(wr * 64 + fr, fq * 8), boff = lds_byte(wc * 32 + fr, fq * 8);
#define G8_SA(b, h) (((b) * 2 + (h)) * HTB)
#define G8_SB(b, h) ((4 + (b) * 2 + (h)) * HTB)
#define G8_STAGE(bufoff, gbase, voff) do { _Pragma("unroll") for (int _i = 0; _i < 2; ++_i) \
        __builtin_amdgcn_global_load_lds((const unsigned*)((const char*)(gbase) + (voff)[_i]), (LAS unsigned*)(lds + (bufoff) + ldsw + _i * 8192), 16, 0, 0); } while (0)
#define G8_LDA(dst, b, h) do { _Pragma("unroll") for (int m = 0; m < 4; ++m) _Pragma("unroll") for (int k = 0; k < 2; ++k) dst[m][k] = *(const LAS bf16x8*)(lds + G8_SA(b, h) + aoff + m * 2048 + k * 1024); } while (0)
#define G8_LDB(dst, b, h) do { _Pragma("unroll") for (int n = 0; n < 2; ++n) _Pragma("unroll") for (int k = 0; k < 2; ++k) dst[n][k] = *(const LAS bf16x8*)(lds + G8_SB(b, h) + boff + n * 2048 + k * 1024); } while (0)
#define G8_MMA(ai, bj, At, Bt) do { __builtin_amdgcn_s_setprio(1); _Pragma("unroll") for (int m = 0; m < 4; ++m) _Pragma("unroll") for (int n = 0; n < 2; ++n) _Pragma("unroll") for (int k = 0; k < 2; ++k) \
        acc[ai][bj][m][n] = __builtin_amdgcn_mfma_f32_16x16x32_bf16(Bt[n][k], At[m][k], acc[ai][bj][m][n], 0, 0, 0); __builtin_amdgcn_s_setprio(0); } while (0)
#define G8_WAIT_V(n) asm volatile("s_waitcnt vmcnt(" #n ")" ::: "memory")
#define G8_WAIT_L(n) asm volatile("s_waitcnt lgkmcnt(" #n ")" ::: "memory")
#define G8_BAR __builtin_amdgcn_s_barrier()
#define G8_SCHED __builtin_amdgcn_sched_barrier(0)
    Unit cur, nxt; int ui = 0;
    if (!ph.next(0, cur)) return;
    f32x4 acc[2][2][4][2];
#pragma unroll
    for (int a = 0; a < 2; ++a)
#pragma unroll
        for (int b = 0; b < 2; ++b)
#pragma unroll
            for (int m = 0; m < 4; ++m)
#pragma unroll
                for (int n = 0; n < 2; ++n) acc[a][b][m][n] = (f32x4){0.f, 0.f, 0.f, 0.f};
    bf16x8 At[4][2], B0[2][2], B1[2][2];
    const char* cA = cur.A; const char* cB = cur.B;
    if constexpr (SP2) {
        G8_STAGE(G8_SB(0, 0), cB, voffB); G8_STAGE(G8_SB(0, 1), cB + hstepB, voffB); G8_STAGE(G8_SA(0, 0), cA, voffA); G8_STAGE(G8_SA(0, 1), cA + hstepA, voffA);
        if (wr == 1) G8_BAR;
        G8_WAIT_V(2); G8_BAR;
        G8_STAGE(G8_SB(1, 0), cB + kstep, voffB); G8_STAGE(G8_SA(1, 0), cA + kstep, voffA); G8_STAGE(G8_SB(1, 1), cB + hstepB + kstep, voffB);
        G8_WAIT_V(6); G8_BAR;
    } else {
        G8_STAGE(G8_SB(0, 0), cB, voffB); G8_STAGE(G8_SA(0, 0), cA, voffA); G8_STAGE(G8_SB(0, 1), cB + hstepB, voffB); G8_STAGE(G8_SA(0, 1), cA + hstepA, voffA);
        if (wr == 1) G8_BAR;
        G8_WAIT_V(4); G8_BAR;
        G8_STAGE(G8_SB(1, 0), cB + kstep, voffB); G8_STAGE(G8_SA(1, 0), cA + kstep, voffA); G8_STAGE(G8_SB(1, 1), cB + hstepB + kstep, voffB);
        G8_WAIT_V(6); G8_BAR;
    }
    for (;;) {
        const bool has_next = ph.next(ui + 1, nxt);
        const char* nA = has_next ? nxt.A : cA; const char* nB = has_next ? nxt.B : cB;
#pragma unroll 1
        for (int t = 0; t < nt; t += 2) {
            const bool last = (t == nt - 2);
            const char* a1 = cA + (size_t)(t + 1) * kstep;
            const char* a2 = last ? nA : cA + (size_t)(t + 2) * kstep; const char* b2 = last ? nB : cB + (size_t)(t + 2) * kstep;
            const char* a3 = a2 + kstep; const char* b3 = b2 + kstep;
            if constexpr (SP2) {
            G8_LDB(B0, 0, 0); G8_LDB(B1, 0, 1); G8_SCHED; G8_LDA(At, 0, 0); G8_STAGE(G8_SA(1, 1), a1 + hstepA, voffA);
            G8_WAIT_V(8); G8_WAIT_L(0); G8_BAR; G8_MMA(0, 0, At, B0); G8_MMA(0, 1, At, B1); G8_BAR; G8_SCHED;
            G8_LDA(At, 0, 1); G8_STAGE(G8_SB(0, 0), b2, voffB); G8_STAGE(G8_SB(0, 1), b2 + hstepB, voffB); G8_STAGE(G8_SA(0, 0), a2, voffA);
            G8_WAIT_V(8); G8_WAIT_L(0); G8_BAR; G8_MMA(1, 0, At, B0); G8_MMA(1, 1, At, B1); G8_BAR; G8_SCHED;
            G8_LDB(B0, 1, 0); G8_LDB(B1, 1, 1); G8_SCHED; G8_LDA(At, 1, 0); G8_STAGE(G8_SA(0, 1), a2 + hstepA, voffA);
            G8_WAIT_V(8); G8_WAIT_L(0); G8_BAR; G8_MMA(0, 0, At, B0); G8_MMA(0, 1, At, B1); G8_BAR; G8_SCHED;
            G8_LDA(At, 1, 1); G8_STAGE(G8_SB(1, 0), b3, voffB); G8_STAGE(G8_SB(1, 1), b3 + hstepB, voffB); G8_STAGE(G8_SA(1, 0), a3, voffA);
            G8_WAIT_V(8); G8_WAIT_L(0); G8_BAR; G8_MMA(1, 0, At, B0); G8_MMA(1, 1, At, B1); G8_BAR; G8_SCHED;
            } else {
            G8_LDB(B0, 0, 0); G8_SCHED; G8_LDA(At, 0, 0); G8_STAGE(G8_SA(1, 1), a1 + hstepA, voffA);
            G8_WAIT_L(8); G8_BAR; G8_WAIT_L(0); G8_MMA(0, 0, At, B0); G8_BAR; G8_SCHED;
            G8_LDB(B1, 0, 1); G8_STAGE(G8_SB(0, 0), b2, voffB);
            G8_BAR; G8_WAIT_L(0); G8_MMA(0, 1, At, B1); G8_BAR;
            G8_LDA(At, 0, 1); G8_STAGE(G8_SA(0, 0), a2, voffA);
            G8_BAR; G8_WAIT_L(0); G8_MMA(1, 0, At, B0); G8_BAR; G8_SCHED;
            G8_STAGE(G8_SB(0, 1), b2 + hstepB, voffB);
            G8_WAIT_V(6); G8_BAR; G8_MMA(1, 1, At, B1); G8_BAR;
            G8_LDB(B0, 1, 0); G8_SCHED; G8_LDA(At, 1, 0); G8_STAGE(G8_SA(0, 1), a2 + hstepA, voffA);
            G8_WAIT_L(8); G8_BAR; G8_WAIT_L(0); G8_MMA(0, 0, At, B0); G8_BAR; G8_SCHED;
            G8_LDB(B1, 1, 1); G8_STAGE(G8_SB(1, 0), b3, voffB);
            G8_BAR; G8_WAIT_L(0); G8_MMA(0, 1, At, B1); G8_BAR;
            G8_LDA(At, 1, 1); G8_STAGE(G8_SA(1, 0), a3, voffA);
            G8_BAR; G8_WAIT_L(0); G8_MMA(1, 0, At, B0); G8_BAR; G8_SCHED;
            G8_STAGE(G8_SB(1, 1), b3 + hstepB, voffB);
            G8_WAIT_V(6); G8_BAR; G8_MMA(1, 1, At, B1); G8_BAR;
            }
        }
        if constexpr (ALIGN_EPI) { if (wr == 0) G8_BAR; }
        ph.epi(acc, cur, wr, wc, fr, fq);
        if (!has_next) break;
#pragma unroll
        for (int a = 0; a < 2; ++a)
#pragma unroll
            for (int b = 0; b < 2; ++b)
#pragma unroll
                for (int m = 0; m < 4; ++m)
#pragma unroll
                    for (int n = 0; n < 2; ++n) acc[a][b][m][n] = (f32x4){0.f, 0.f, 0.f, 0.f};
        cur = nxt; cA = nA; cB = nB; ++ui;
        if constexpr (ALIGN_EPI) { if (wr == 1) G8_BAR; }
    }
    G8_WAIT_V(0);
    if constexpr (!ALIGN_EPI) { if (wr == 0) G8_BAR; }
    G8_BAR;
#undef G8_SA
#undef G8_SB
#undef G8_STAGE
#undef G8_LDA
#undef G8_LDB
#undef G8_MMA
#undef G8_WAIT_V
#undef G8_WAIT_L
#undef G8_BAR
#undef G8_SCHED
}
}

struct TJob { const float* src; bf16_t* dst; const float* gain; int K, Nsrc, Ndst, map, nitems; };

DI int map_col(int map, int n0) {
    if (map == 1) return n0 + (n0 >= 6144 ? 16 : 0);
    if (map == 2) { const int t = n0 >> 8, r = n0 & 255; return (r < 128) ? 128 * t + r : DFF + 128 * t + (r - 128); }
    return n0;
}
constexpr int TR_SCR = 64 * 65 * 4;
static_assert(8 * TR_SCR <= LDS_MISC, "transpose scratch must stay below the barrier words");
DI void p0_transpose_item(const TJob& J, LAS float* scr, int item, int lane) {
    const int nblk = J.Ndst / 64, kb = item / nblk, nb = item % nblk, k0 = 64 * kb, n0 = 64 * nb, ns0 = map_col(J.map, n0);
    const float* src = J.src + (size_t)(k0 + (lane >> 4)) * J.Nsrc + ns0 + 4 * (lane & 15);
    f32x4 v[16];
#pragma unroll
    for (int i = 0; i < 16; ++i) v[i] = *(const f32x4*)(src + (size_t)(4 * i) * J.Nsrc);
    if (J.gain) {
#pragma unroll
        for (int i = 0; i < 16; ++i) v[i] *= J.gain[k0 + 4 * i + (lane >> 4)];
    }
#pragma unroll
    for (int i = 0; i < 16; ++i) { LAS float* d = scr + (4 * i + (lane >> 4)) * 65 + 4 * (lane & 15); d[0] = v[i].x; d[1] = v[i].y; d[2] = v[i].z; d[3] = v[i].w; }
    LDS_WAIT(); asm volatile("" ::: "memory");
    const int c = lane & 7;
#pragma unroll
    for (int j = 0; j < 8; ++j) { const int n = (lane >> 3) + 8 * j; const LAS float* s = scr + (8 * c) * 65 + n;
        u32x4 o; o.x = pk2(s[0 * 65], s[1 * 65]); o.y = pk2(s[2 * 65], s[3 * 65]); o.z = pk2(s[4 * 65], s[5 * 65]); o.w = pk2(s[6 * 65], s[7 * 65]);
        *(u32x4*)(J.dst + (size_t)(n0 + n) * J.K + k0 + 8 * c) = o; }
    LDS_WAIT(); asm volatile("" ::: "memory");
}
DI void p0_wps_item(const Params& p, bf16_t* WPS, int item, int lane) {
    const size_t e = (size_t)item * 512 + lane * 8; const float* src = p.w_pool + e;
    const f32x4 a = *(const f32x4*)src, b = *(const f32x4*)(src + 4);
    u32x4 o; o.x = pk2(a.x, a.y); o.y = pk2(a.z, a.w); o.z = pk2(b.x, b.y); o.w = pk2(b.z, b.w);
    *(u32x4*)(WPS + e) = o;
}
DI void p0_plb_item(const Params& p, bf16_t* PLB, int item, int lane) {
    const size_t e = (size_t)item * 512 + lane * 8; const size_t row = e / PLE;
    const float* src = (row < MP) ? p.p_prompt + e : p.p_sample + (e - (size_t)MP * PLE);
    const f32x4 a = *(const f32x4*)src, b = *(const f32x4*)(src + 4);
    u32x4 o; o.x = pk2(a.x, a.y); o.y = pk2(a.z, a.w); o.z = pk2(b.x, b.y); o.w = pk2(b.z, b.w);
    *(u32x4*)(PLB + e) = o;
}

DI void p0_xprep_unit(const Params& p, LAS unsigned char* lds, int u, int wave) {
    const int lane = lane_id(), tid = wave * 64 + lane;
    unsigned char* ws = p.ws;
    bf16_t* XB = (bf16_t*)(ws + WS_XB); float* RSTD1 = (float*)(ws + WS_RSTD1); float* BCUM = (float*)(ws + WS_BCUM); float* LAM = (float*)(ws + WS_LAM);
    LAS unsigned char* WG = lds; LAS float* GL = (LAS float*)(lds + 65536); LAS float* RS = (LAS float*)(lds + 69632);
    {   f32x4 w[16]; float gk[16];
#pragma unroll
        for (int i = 0; i < 16; ++i) { const int idx = tid + 512 * i, k = idx >> 2, n4 = idx & 3; w[i] = *(const f32x4*)(p.w_in + (size_t)k * INW + 6144 + 4 * n4); gk[i] = p.norm_mix[k]; }
#pragma unroll
        for (int i = 0; i < 16; ++i) { const int idx = tid + 512 * i, k = idx >> 2, n4 = idx & 3; LAS bf16_t* d = (LAS bf16_t*)(WG + (size_t)((k >> 3) * 16 + 4 * n4) * 16) + (k & 7);
            const unsigned a = pk2(w[i].x * gk[i], w[i].y * gk[i]), b = pk2(w[i].z * gk[i], w[i].w * gk[i]);
            d[0] = (bf16_t)(a & 0xffffu); d[8] = (bf16_t)(a >> 16); d[16] = (bf16_t)(b & 0xffffu); d[24] = (bf16_t)(b >> 16); }
    }
    __syncthreads();
    if (wave < 4) {
        const int fr = lane & 15, fq = lane >> 4; const int row = 64 * u + 16 * wave + fr;
        const float* xr = (row < MP) ? p.x_prompt + (size_t)row * D : p.x_sample + (size_t)(row - MP) * D;
        f32x4 acc = {0.f, 0.f, 0.f, 0.f}; float ss = 0.f;
#pragma unroll 1
        for (int s0 = 0; s0 < 64; s0 += 8) {
            f32x4 xa[8], xb[8];
#pragma unroll
            for (int i = 0; i < 8; ++i) { xa[i] = *(const f32x4*)(xr + 32 * (s0 + i) + 8 * fq); xb[i] = *(const f32x4*)(xr + 32 * (s0 + i) + 8 * fq + 4); }
#pragma unroll
            for (int i = 0; i < 8; ++i) { const int s = s0 + i; const f32x4 a = xa[i], b = xb[i];
                ss += (a.x * a.x + a.y * a.y) + (a.z * a.z + a.w * a.w) + (b.x * b.x + b.y * b.y) + (b.z * b.z + b.w * b.w);
                u32x4 o; o.x = pk2(a.x, a.y); o.y = pk2(a.z, a.w); o.z = pk2(b.x, b.y); o.w = pk2(b.z, b.w);
                *(u32x4*)(XB + (size_t)row * D + 32 * s + 8 * fq) = o;
                const bf16x8 af = __builtin_bit_cast(bf16x8, o);
                const bf16x8 bfr = *(const LAS bf16x8*)(WG + (size_t)((4 * s + fq) * 16 + fr) * 16);
                acc = __builtin_amdgcn_mfma_f32_16x16x32_bf16(af, bfr, acc, 0, 0, 0); }
        }
        ss += __shfl_xor(ss, 16); ss += __shfl_xor(ss, 32);
        const float rstd = 1.0f / sqrtf(ss * (1.0f / D) + EPS);
        if (fq == 0) { RS[16 * wave + fr] = rstd; RSTD1[row] = rstd; }
        LDS_WAIT(); asm volatile("" ::: "memory");
#pragma unroll
        for (int j = 0; j < 4; ++j) { const int tl = 16 * wave + 4 * fq + j; GL[tl * 16 + fr] = acc[j] * RS[tl]; }
    }
    __syncthreads();
    const bool sample = (u >= MP / 64);
#pragma unroll 1
    for (int cc = 0; cc < 2; ++cc) {
        const int c = tid + 512 * cc; float wg[16];
#pragma unroll
        for (int j = 0; j < 16; ++j) wg[j] = p.w_gate_up[j * KW + c];
        const float bg = p.b_gate[c]; float cum = 0.f;
#pragma unroll 2
        for (int t = 0; t < 64; ++t) {
            const f32x4 g0 = *(const LAS f32x4*)(GL + t * 16), g1 = *(const LAS f32x4*)(GL + t * 16 + 4), g2 = *(const LAS f32x4*)(GL + t * 16 + 8), g3 = *(const LAS f32x4*)(GL + t * 16 + 12);
            float z = bg;
            z += g0.x * wg[0] + g0.y * wg[1] + g0.z * wg[2] + g0.w * wg[3];
            z += g1.x * wg[4] + g1.y * wg[5] + g1.z * wg[6] + g1.w * wg[7];
            z += g2.x * wg[8] + g2.y * wg[9] + g2.z * wg[10] + g2.w * wg[11];
            z += g3.x * wg[12] + g3.y * wg[13] + g3.z * wg[14] + g3.w * wg[15];
            const float gl = logsigmoidf_(z) * (1.0f / 16.0f);
            const int row = 64 * u + t;
            if (sample) { BCUM[(size_t)row * KW + c] = 0.f; LAM[(size_t)(NCHK + row - MP) * KW + c] = __expf(gl); }
            else { cum = ((t & (CH - 1)) == 0) ? gl : cum + gl; BCUM[(size_t)row * KW + c] = cum; if ((t & (CH - 1)) == CH - 1) LAM[(size_t)(row / CH) * KW + c] = __expf(cum); }
        }
    }
    __syncthreads();
}

constexpr int NXPREP = M / 64;
DI void phase_p0(const Params& p, LAS unsigned char* lds, int wave) {
    const int lane = lane_id();
    unsigned char* ws = p.ws;
#ifndef P0_REP
#define P0_REP 0
#endif
    const int G = gridDim.x, c = blockIdx.x; const bool has_unit = c < NXPREP;
    const int nx = (G < NXPREP) ? G : NXPREP, W_OTHER = 3;
    const int nslots_total = nx * NWAVES + (G - nx) * NWAVES * W_OTHER;
    const int my_n = has_unit ? 1 : W_OTHER;
    const int my_first = has_unit ? c * NWAVES + wave : nx * NWAVES + ((c - nx) * NWAVES + wave) * W_OTHER;
    if (has_unit) { for (int u = c; u < NXPREP; u += G) p0_xprep_unit(p, lds, u, wave); if (P0_REP & 1) p0_xprep_unit(p, lds, c, wave); }
    TJob J[8];
    J[0] = TJob{p.w_in, (bf16_t*)(ws + WS_WIN), p.norm_mix, D, INW, NIN, 1, (D / 64) * (NIN / 64)};
    J[1] = TJob{p.w_up, (bf16_t*)(ws + WS_WUP), p.norm_ffn, D, NUP, NUP, 2, (D / 64) * (NUP / 64)};
    J[2] = TJob{p.w_down, (bf16_t*)(ws + WS_WD), nullptr, DFF, D, D, 0, (DFF / 64) * (D / 64)};
    J[3] = TJob{p.w_branch_a, (bf16_t*)(ws + WS_WA), p.gla_norm, D, D, D, 0, (D / 64) * (D / 64)};
    J[4] = TJob{p.w_out, (bf16_t*)(ws + WS_WO), nullptr, D, D, D, 0, (D / 64) * (D / 64)};
    J[5] = TJob{p.w_ple_gate, (bf16_t*)(ws + WS_WPG), p.norm_ple, D, D, D, 0, (D / 64) * (D / 64)};
    J[6] = TJob{p.w_ple, (bf16_t*)(ws + WS_WPLE), nullptr, PLE, D, D, 0, (PLE / 64) * (D / 64)};
    J[7] = TJob{p.w_branch_b, (bf16_t*)(ws + WS_WBT), p.pool_scale, POOLW, D, D, 0, (POOLW / 64) * (D / 64)};
    LAS float* scr = (LAS float*)(lds + wave * TR_SCR);
    for (int rep = 0; rep < ((P0_REP & 2) ? 2 : 1); ++rep) {
    int base = 0;
#pragma unroll
    for (int j = 0; j < 8; ++j) {
        const int n = J[j].nitems;
        for (int k = 0; k < my_n; ++k) {
            int it = (my_first + k) - (base % nslots_total); if (it < 0) it += nslots_total;
            for (; it < n; it += nslots_total) p0_transpose_item(J[j], scr, it, lane);
        }
        base += n;
    }
    }
    for (int k = 0; k < my_n; ++k) {
        for (int it = my_first + k; it < (POOLW * 256) / 512; it += nslots_total) p0_wps_item(p, (bf16_t*)(ws + WS_WPS), it, lane);
        for (int it = my_first + k; it < (M * PLE) / 512; it += nslots_total) p0_plb_item(p, (bf16_t*)(ws + WS_PLB), it, lane);
    }
}

#define MFMA32(a, b, c) __builtin_amdgcn_mfma_f32_32x32x16_bf16((a), (b), (c), 0, 0, 0)
typedef LAS s16x4* lds_s16x4_p;
DI s16x4 tr_read(LAS unsigned char* a) { return __builtin_amdgcn_ds_read_tr16_b64_v4i16((lds_s16x4_p)a); }
DI bf16x8 cat8(s16x4 lo, s16x4 hi) { return __builtin_shufflevector(lo, hi, 0, 1, 2, 3, 4, 5, 6, 7); }
DI bf16x8 ld_perm(const bf16_t* p) {
    const u32x2 a = *(const u32x2*)p, b = *(const u32x2*)(p + 8);
    u32x4 r; r.x = a.x; r.y = a.y; r.z = b.x; r.w = b.y; return __builtin_bit_cast(bf16x8, r);
}
template <int S> DI bf16x8 pack_step(const f32x16& x) {
    u32x4 r; r.x = pk2(x[8 * S + 0], x[8 * S + 1]); r.y = pk2(x[8 * S + 2], x[8 * S + 3]); r.z = pk2(x[8 * S + 4], x[8 * S + 5]); r.w = pk2(x[8 * S + 6], x[8 * S + 7]);
    return __builtin_bit_cast(bf16x8, r);
}
DI f32x16 zero16() { f32x16 z;
#pragma unroll
    for (int i = 0; i < 16; ++i) z[i] = 0.f; return z; }

constexpr int SC_BUF = 50176, SC_QI = 0, SC_KI = 16384, SC_VI = 32768, SC_LMI = 49152, SC_ATT = 3 * SC_BUF, SC_BYTES = SC_ATT + 2048;
static_assert(SC_BYTES <= LDS_MISC, "scan LDS map");
DI void dma16(const void* g, LAS unsigned char* l) { __builtin_amdgcn_global_load_lds((const unsigned*)g, (LAS unsigned*)l, 16, 0, 0); }
DI bf16x8 lds_perm(LAS unsigned char* a) {
    const u32x2 x = *(const LAS u32x2*)a, y = *(const LAS u32x2*)(a + 512);
    u32x4 r; r.x = x.x; r.y = x.y; r.z = y.x; r.w = y.y; return __builtin_bit_cast(bf16x8, r);
}
#define SC_BAR() do { asm volatile("s_waitcnt lgkmcnt(0)" ::: "memory"); __builtin_amdgcn_s_barrier(); asm volatile("" ::: "memory"); } while (0)
DI void scan_block(const Params& p, LAS unsigned char* lds, int task, int wave) {
    unsigned char* ws = p.ws;
    const bf16_t* QB = (const bf16_t*)(ws + WS_QB); const bf16_t* KB = (const bf16_t*)(ws + WS_KB);
    const bf16_t* V = (const bf16_t*)(ws + WS_V); bf16_t* OG = (bf16_t*)(ws + WS_OG);
    const float* LAM = (const float*)(ws + WS_LAM); float* OSS = (float*)(ws + WS_OSS);
    const int half = task & 1, hd = (task >> 1) & 3, b = task >> 3, sl = 8 * half + wave;
    f32x16 S[8];
#pragma unroll
    for (int db = 0; db < 8; ++db) S[db] = zero16();

#define SC_ISSUE(ch_, slot_) do { const int _l = lane_id(); const size_t _r0 = (size_t)(b * SEQ + CH * (ch_)); LAS unsigned char* _lb = lds + (slot_) * SC_BUF; asm volatile("" : "+s"(_lb)); \
        _Pragma("unroll") for (int _k = 0; _k < 2; ++_k) { const int _i = 2 * wave + _k; \
            const int _row = _l & 31, _cc = 2 * _i + (_l >> 5); \
            dma16(QB + (_r0 + _row) * KW + hd * 256 + 8 * _cc, _lb + SC_QI + _i * 1024); \
            const int _s = 2 * _i + (_l >> 5), _c2 = (_l & 31) ^ (4 * (_s & 3)); \
            dma16(KB + (_r0 + _s) * KW + hd * 256 + 8 * _c2, _lb + SC_KI + _i * 1024); dma16(V + (_r0 + _s) * VW + hd * 512 + 256 * half + 8 * _c2, _lb + SC_VI + _i * 1024); } \
        if (wave == 0) dma16(LAM + (size_t)(b * (SEQ / CH) + (ch_)) * KW + hd * 256 + 4 * _l, _lb + SC_LMI); } while (0)
    constexpr int NCH = SEQ / CH;
    SC_ISSUE(0, 0); SC_ISSUE(1, 1);
    int slot = 0;
#pragma unroll 1
    for (int ch = 0; ch < NCH; ++ch) {
        const int row0 = b * SEQ + CH * ch;
        if (ch == 0) { if (wave == 0) asm volatile("s_waitcnt vmcnt(7)" ::: "memory"); else asm volatile("s_waitcnt vmcnt(6)" ::: "memory"); }
        else if (ch == 1) { if (wave == 0) asm volatile("s_waitcnt vmcnt(11)" ::: "memory"); else asm volatile("s_waitcnt vmcnt(10)" ::: "memory"); }
        else if (ch + 1 < NCH) { if (wave == 0) asm volatile("s_waitcnt vmcnt(15)" ::: "memory"); else asm volatile("s_waitcnt vmcnt(14)" ::: "memory"); }
        else VM_WAIT();
        SC_BAR();
        { const int s2 = (slot == 0) ? 2 : slot - 1; if (ch + 2 < NCH) SC_ISSUE(ch + 2, s2); }
        const int lane = lane_id();
        const int c = lane & 31, h = lane >> 5;
        const int i16 = lane & 15, q = i16 >> 2, pp = i16 & 3, jb = (lane >> 4) & 1;
        LAS unsigned char* buf = lds + slot * SC_BUF;
        LAS unsigned char* ATT = lds + SC_ATT;

        if (wave < 4) {
            const int si = wave >> 1, ti = wave & 1, fr = lane & 15, fq = lane >> 4;
            f32x4 a = {0.f, 0.f, 0.f, 0.f};
            LAS unsigned char* kp = buf + SC_KI + (16 * si + fr) * 512; LAS unsigned char* qp = buf + SC_QI + fq * 512 + (16 * ti + fr) * 16;
            const int kx = 4 * (fr & 3);
#pragma unroll
            for (int ks = 0; ks < 8; ++ks) a = __builtin_amdgcn_mfma_f32_16x16x32_bf16(*(const LAS bf16x8*)(kp + (((4 * ks + fq) ^ kx) * 16)), *(const LAS bf16x8*)(qp + 2048 * ks), a, 0, 0, 0);
            const int s0 = 16 * si + 4 * fq, t = 16 * ti + fr;
            u32x2 w; w.x = pk2(s0 + 0 <= t ? a[0] : 0.f, s0 + 1 <= t ? a[1] : 0.f); w.y = pk2(s0 + 2 <= t ? a[2] : 0.f, s0 + 3 <= t ? a[3] : 0.f);
            *(LAS u32x2*)(ATT + t * 64 + s0 * 2) = w;
        }
        SC_BAR();

        f32x16 o = zero16();
        LAS unsigned char* vb = buf + SC_VI + (8 * h + q) * 512 + (4 * (wave ^ q) + 2 * jb + (pp >> 1)) * 16 + (pp & 1) * 8;
        const bf16x8 vf0 = cat8(tr_read(vb), tr_read(vb + 4 * 512)), vf1 = cat8(tr_read(vb + 16 * 512), tr_read(vb + 20 * 512));
        {
            LAS unsigned char* ab = ATT + c * 64 + 16 * h;
            o = MFMA32(vf0, *(const LAS bf16x8*)ab, o);
            o = MFMA32(vf1, *(const LAS bf16x8*)(ab + 32), o);
            LAS unsigned char* qa = buf + SC_QI + c * 16 + 8 * h;
#pragma unroll
            for (int db = 0; db < 8; ++db) {
                { const bf16x8 qf = lds_perm(qa + 2048 * db); o = MFMA32(pack_step<0>(S[db]), qf, o); }
                { const bf16x8 qf = lds_perm(qa + 2048 * db + 1024); o = MFMA32(pack_step<1>(S[db]), qf, o); }
                if ((db & 3) == 3) __builtin_amdgcn_sched_barrier(0);
            }
            const int t = row0 + c;
            float ss = 0.f;
#pragma unroll
            for (int r = 0; r < 16; ++r) ss += o[r] * o[r];
            { const auto sw = __builtin_amdgcn_permlane32_swap(__float_as_uint(ss), __float_as_uint(ss), false, false); ss = __uint_as_float(sw[0]) + __uint_as_float(sw[1]); }
            if (h == 0) OSS[(size_t)t * 64 + hd * 16 + sl] = ss;
            bf16_t* og = OG + (size_t)row0 * VW + hd * 512 + 32 * sl + c * VW + 4 * h;
#pragma unroll
            for (int g = 0; g < 4; ++g) { u32x2 w; w.x = pk2(o[4 * g + 0], o[4 * g + 1]); w.y = pk2(o[4 * g + 2], o[4 * g + 3]); *(u32x2*)(og + 8 * g) = w; }
        }
        __builtin_amdgcn_sched_barrier(0);

        {
            LAS unsigned char* kbase = buf + SC_KI + (8 * h + q) * 512 + (2 * jb + (pp >> 1)) * 16 + (pp & 1) * 8;
            LAS unsigned char* lm = buf + SC_LMI + 16 * h;
#pragma unroll
            for (int db = 0; db < 8; ++db) {
                LAS unsigned char* kb = kbase + (((db & 3) ^ q) * 4) * 16 + (db >> 2) * 256;
                S[db] = MFMA32(cat8(tr_read(kb), tr_read(kb + 4 * 512)), vf0, S[db]);
                S[db] = MFMA32(cat8(tr_read(kb + 16 * 512), tr_read(kb + 20 * 512)), vf1, S[db]);
#pragma unroll
                for (int g = 0; g < 4; ++g) { const f32x4 l4 = *(const LAS f32x4*)(lm + (32 * db + 8 * g) * 4);
                    S[db][4 * g + 0] *= l4.x; S[db][4 * g + 1] *= l4.y; S[db][4 * g + 2] *= l4.z; S[db][4 * g + 3] *= l4.w; }
                if (db & 1) __builtin_amdgcn_sched_barrier(0);
            }
        }
        asm volatile("" ::: "memory");
        slot = (slot == 2) ? 0 : slot + 1;
    }
#undef SC_ISSUE
    {   const int lane = lane_id();
        const unsigned voff = (unsigned)(((lane >> 5) * 4 * DV + (lane & 31)) * 4);
        const char* gbase = (const char*)(p.out + O_GLAP + ((size_t)(b * NH + hd) * DK) * DV + 32 * sl);
#pragma unroll
        for (int db = 0; db < 8; ++db) {
#pragma unroll
            for (int r = 0; r < 16; ++r) { const int dl = 32 * db + (r & 3) + 8 * (r >> 2); *(float*)(const_cast<char*>(gbase) + (size_t)dl * DV * 4 + voff) = S[db][r]; }
        }
    }
    __syncthreads();
}

DI void sgla_task(const Params& p, int task, int lane) {
    unsigned char* ws = p.ws;
    const bf16_t* QB = (const bf16_t*)(ws + WS_QB); const bf16_t* KB = (const bf16_t*)(ws + WS_KB); const bf16_t* V = (const bf16_t*)(ws + WS_V);
    const float* LAM = (const float*)(ws + WS_LAM); float* OSP = (float*)(ws + WS_OSP);
    const int dblk = task & 7, hd = (task >> 3) & 3, b = task >> 5; const int row = MP + b;
    const size_t sbase = ((size_t)(b * NH + hd) * DK + 32 * dblk) * DV;
    const float* S0 = p.state_gla + sbase; float* So = p.out + O_GLAS + sbase;
    const int dl = lane & 31;
    const float lam_l = LAM[(size_t)(NCHK + b) * KW + hd * 256 + 32 * dblk + dl];
    const float k_l = bf1(KB[(size_t)row * KW + hd * 256 + 32 * dblk + dl]);
    const float q_l = bf1(QB[(size_t)row * KW + hd * 256 + 32 * dblk + dl]);
    f32x4 va, vb;
    { const u32x2 w = *(const u32x2*)(V + (size_t)row * VW + hd * 512 + 4 * lane); va = (f32x4){bflo(w.x), bfhi(w.x), bflo(w.y), bfhi(w.y)}; }
    { const u32x2 w = *(const u32x2*)(V + (size_t)row * VW + hd * 512 + 256 + 4 * lane); vb = (f32x4){bflo(w.x), bfhi(w.x), bflo(w.y), bfhi(w.y)}; }
    f32x4 oa = {0.f, 0.f, 0.f, 0.f}, ob = {0.f, 0.f, 0.f, 0.f};
#pragma unroll 1
    for (int d0 = 0; d0 < 32; d0 += 16) {
        f32x4 ra[16], rb[16];
#pragma unroll
        for (int i = 0; i < 16; ++i) { ra[i] = __builtin_nontemporal_load((const f32x4*)(S0 + (size_t)(d0 + i) * DV + 4 * lane)); rb[i] = __builtin_nontemporal_load((const f32x4*)(S0 + (size_t)(d0 + i) * DV + 256 + 4 * lane)); }
#pragma unroll
        for (int i = 0; i < 16; ++i) { const int d = d0 + i;
            const float lam = __uint_as_float(__builtin_amdgcn_readlane(__float_as_uint(lam_l), d)), kk = __uint_as_float(__builtin_amdgcn_readlane(__float_as_uint(k_l), d)), qq = __uint_as_float(__builtin_amdgcn_readlane(__float_as_uint(q_l), d));
            const f32x4 sa = ra[i] * lam + va * kk, sb = rb[i] * lam + vb * kk;
            __builtin_nontemporal_store(sa, (f32x4*)(So + (size_t)d * DV + 4 * lane)); __builtin_nontemporal_store(sb, (f32x4*)(So + (size_t)d * DV + 256 + 4 * lane));
            oa += sa * qq; ob += sb * qq; }
    }
    float* op = OSP + ((size_t)(b * NH + hd) * 8 + dblk) * DV;
    *(f32x4*)(op + 4 * lane) = oa; *(f32x4*)(op + 256 + 4 * lane) = ob;
}

DI void pmix_task(const Params& p, int t, int lane) {
    unsigned char* ws = p.ws;
    const float* U = (const float*)(ws + WS_U); bf16_t* PM = (bf16_t*)(ws + WS_PM);
    if (t < MP) {
        const int b = t >> 11, pos = t & 2047;
#pragma unroll
        for (int i = 0; i < 4; ++i) {
            const int w = 2 << i, c = 256 * i + 4 * lane; const int cnt = (pos + 1 < w) ? pos + 1 : w;
            const f32x4 u0 = *(const f32x4*)(U + (size_t)t * POOLW + c); f32x4 s = u0;
#pragma unroll
            for (int j = 1; j < w; ++j) {
                const bool in = j < cnt; const f32x4 v = *(const f32x4*)(U + (size_t)(in ? t - j : t) * POOLW + c); const float m = in ? 1.f : 0.f; s += v * m; }
            const float inv = 1.0f / (float)cnt; const f32x4 mx = s * inv - u0;
            u32x2 o; o.x = pk2(mx.x, mx.y); o.y = pk2(mx.z, mx.w); *(u32x2*)(PM + (size_t)t * POOLW + c) = o;
            if (pos >= SEQ - 15) *(f32x4*)(p.out + O_POOLP + ((size_t)b * 15 + (pos - (SEQ - 15))) * POOLW + c) = u0;
        }
    } else {
        const int b = t - MP; const float* sp = p.state_pool + (size_t)b * 15 * POOLW; float* po = p.out + O_POOLS + (size_t)b * 15 * POOLW;
#pragma unroll
        for (int i = 0; i < 4; ++i) {
            const int w = 2 << i, c = 256 * i + 4 * lane;
            const f32x4 u0 = *(const f32x4*)(U + (size_t)t * POOLW + c); f32x4 s = u0;
#pragma unroll
            for (int j = 1; j < w; ++j) s += *(const f32x4*)(sp + (size_t)(15 - j) * POOLW + c);
            const float inv = 1.0f / (float)w; const f32x4 mx = s * inv - u0;
            u32x2 o; o.x = pk2(mx.x, mx.y); o.y = pk2(mx.z, mx.w); *(u32x2*)(PM + (size_t)t * POOLW + c) = o;
            *(f32x4*)(po + (size_t)14 * POOLW + c) = u0;
        }
    }
}

DI void pool_copy_task(const Params& p, int item, int lane) {
    const int b = item / 14, r = item - 14 * b; const float* src = p.state_pool + ((size_t)b * 15 + r + 1) * POOLW + 4 * lane; float* dst = p.out + O_POOLS + ((size_t)b * 15 + r) * POOLW + 4 * lane;
    const f32x4 v0 = *(const f32x4*)src, v1 = *(const f32x4*)(src + 256), v2 = *(const f32x4*)(src + 512), v3 = *(const f32x4*)(src + 768);
    *(f32x4*)dst = v0; *(f32x4*)(dst + 256) = v1; *(f32x4*)(dst + 512) = v2; *(f32x4*)(dst + 768) = v3;
}
#ifndef P2_REP
#define P2_REP 0
#endif
DI void scan_role(const Params& p, LAS unsigned char* lds, int wave, int idx, int n) {
    for (int rep = 0; rep < ((P2_REP & 1) ? 2 : 1); ++rep) for (int task = (n == 32) ? (idx % 8) * 4 + idx / 8 : idx; task < 2 * NB * NH; task += n) scan_block(p, lds, task, wave);
}
DI void stream_role(const Params& p, int wave, int idx, int n) {
    const int lane = lane_id(); const int gw = idx * NWAVES + wave, NGW = n * NWAVES;
    for (int rep = 0; rep < ((P2_REP & 2) ? 2 : 1); ++rep) {
        for (int it = gw; it < MS * 14; it += NGW) pool_copy_task(p, it, lane);
        for (int task = gw; task < MS * NH * 8; task += NGW) sgla_task(p, task, lane); }
}

DI void ogn_task(const Params& p, int t, int lane) {
    unsigned char* ws = p.ws;
    bf16_t* OG = (bf16_t*)(ws + WS_OG); const float* OSS = (const float*)(ws + WS_OSS); const float* OSP = (const float*)(ws + WS_OSP); const bf16_t* SR = (const bf16_t*)(ws + WS_SR);
    if (t < MP) {
#pragma unroll
        for (int hd = 0; hd < 4; ++hd) {
            const float* sp = OSS + (size_t)t * 64 + hd * 16; const f32x4 a = *(const f32x4*)sp, b = *(const f32x4*)(sp + 4), c = *(const f32x4*)(sp + 8), d = *(const f32x4*)(sp + 12);
            const float ss = ((a.x + a.y) + (a.z + a.w)) + ((b.x + b.y) + (b.z + b.w)) + ((c.x + c.y) + (c.z + c.w)) + ((d.x + d.y) + (d.z + d.w));
            const float rstd = 1.0f / sqrtf(ss * (1.0f / DV) + EPS);
            bf16_t* op = OG + (size_t)t * VW + hd * 512 + 8 * lane; const u32x4 w = *(const u32x4*)op; const u32x4 g = *(const u32x4*)(SR + (size_t)t * VW + hd * 512 + 8 * lane);
            u32x4 o; o.x = pk2(bflo(w.x) * rstd * bflo(g.x), bfhi(w.x) * rstd * bfhi(g.x)); o.y = pk2(bflo(w.y) * rstd * bflo(g.y), bfhi(w.y) * rstd * bfhi(g.y));
            o.z = pk2(bflo(w.z) * rstd * bflo(g.z), bfhi(w.z) * rstd * bfhi(g.z)); o.w = pk2(bflo(w.w) * rstd * bflo(g.w), bfhi(w.w) * rstd * bfhi(g.w));
            *(u32x4*)op = o;
        }
    } else {
        const int b = t - MP;
#pragma unroll
        for (int hd = 0; hd < 4; ++hd) {
            f32x4 oa = {0.f, 0.f, 0.f, 0.f}, ob = {0.f, 0.f, 0.f, 0.f};
#pragma unroll
            for (int k = 0; k < 8; ++k) { const float* op = OSP + ((size_t)(b * NH + hd) * 8 + k) * DV + 8 * lane; oa += *(const f32x4*)op; ob += *(const f32x4*)(op + 4); }
            float ss = (oa.x * oa.x + oa.y * oa.y) + (oa.z * oa.z + oa.w * oa.w) + (ob.x * ob.x + ob.y * ob.y) + (ob.z * ob.z + ob.w * ob.w);
            ss = wave_sum(ss);
            const float rstd = 1.0f / sqrtf(ss * (1.0f / DV) + EPS);
            const u32x4 w = *(const u32x4*)(SR + (size_t)t * VW + hd * 512 + 8 * lane);
            u32x4 o; o.x = pk2(oa.x * rstd * bflo(w.x), oa.y * rstd * bfhi(w.x)); o.y = pk2(oa.z * rstd * bflo(w.y), oa.w * rstd * bfhi(w.y));
            o.z = pk2(ob.x * rstd * bflo(w.z), ob.y * rstd * bfhi(w.z)); o.w = pk2(ob.z * rstd * bflo(w.w), ob.w * rstd * bfhi(w.w));
            *(u32x4*)(OG + (size_t)t * VW + hd * 512 + 8 * lane) = o;
        }
    }
}
DI void phase_p3(const Params& p, int wave) {
    const int lane = lane_id();
    const int gw = (int)blockIdx.x * NWAVES + wave, NGW = gridDim.x * NWAVES;
    for (int t = gw; t < M; t += NGW) pmix_task(p, t, lane);
    for (int t = gw; t < M; t += NGW) ogn_task(p, t, lane);
}

DI float row_rstd(const float* SS, const float* SSs, int row, int lane) {
    float v = (row < MP) ? ((lane < 32) ? SS[(size_t)row * 32 + lane] : 0.f) : (SSs[(size_t)(row - MP) * 128 + lane] + SSs[(size_t)(row - MP) * 128 + 64 + lane]);
    v = wave_sum(v);
    return 1.0f / sqrtf(v * (1.0f / D) + EPS);
}

struct F8 { f32x4 a, b; };
DI F8 unpack8(u32x4 w, float s) { F8 r; r.a = (f32x4){bflo(w.x) * s, bfhi(w.x) * s, bflo(w.y) * s, bfhi(w.y) * s}; r.b = (f32x4){bflo(w.z) * s, bfhi(w.z) * s, bflo(w.w) * s, bfhi(w.w) * s}; return r; }
DI F8 ld8(const float* q) { F8 r; r.a = *(const f32x4*)q; r.b = *(const f32x4*)(q + 4); return r; }
DI void st8(float* q, const F8& v) { *(f32x4*)q = v.a; *(f32x4*)(q + 4) = v.b; }
DI f32x4 silu4(f32x4 x) { return (f32x4){siluf_(x.x), siluf_(x.y), siluf_(x.z), siluf_(x.w)}; }
DI void conv_task(const Params& p, int t, int lane) {
    unsigned char* ws = p.ws;
    const bf16_t* GU = (const bf16_t*)(ws + WS_GU); const float* SS1 = (const float*)(ws + WS_SS1); const float* SS1S = (const float*)(ws + WS_SS1S); bf16_t* ACT = (bf16_t*)(ws + WS_ACT);
    const bool prompt = t < MP; const int b = prompt ? (t >> 11) : (t - MP), pos = prompt ? (t & 2047) : 2;
    const float r0 = row_rstd(SS1, SS1S, t, lane);
    const float r1 = (prompt && pos >= 1) ? row_rstd(SS1, SS1S, t - 1, lane) : 0.f;
    const float r2 = (prompt && pos >= 2) ? row_rstd(SS1, SS1S, t - 2, lane) : 0.f;
    const bf16_t* g0p = GU + (size_t)t * NUP; const bf16_t* g1p = GU + (size_t)((prompt && pos >= 1) ? t - 1 : t) * NUP; const bf16_t* g2p = GU + (size_t)((prompt && pos >= 2) ? t - 2 : t) * NUP;
    const float* sc = p.state_conv + (size_t)b * 2 * DFF;
    for (int v = lane; v < DFF / 8; v += 64) {
        const int ch0 = 8 * v, pn = ch0 >> 7, r = ch0 & 127, gcol = 256 * pn + r, ucol = gcol + 128;
        const F8 g0 = unpack8(*(const u32x4*)(g0p + gcol), r0), up = unpack8(*(const u32x4*)(g0p + ucol), r0);
        F8 g1, g2;
        if (prompt) { g1 = unpack8(*(const u32x4*)(g1p + gcol), r1); g2 = unpack8(*(const u32x4*)(g2p + gcol), r2); }
        else { g1 = ld8(sc + DFF + ch0); g2 = ld8(sc + ch0); }
        const F8 w0 = ld8(p.conv_w + ch0), w1 = ld8(p.conv_w + DFF + ch0), w2 = ld8(p.conv_w + 2 * DFF + ch0), cb = ld8(p.conv_b + ch0);
        const f32x4 ga = cb.a + w0.a * g2.a + w1.a * g1.a + w2.a * g0.a, gb = cb.b + w0.b * g2.b + w1.b * g1.b + w2.b * g0.b;
        const f32x4 aa = silu4(ga) * up.a, ab = silu4(gb) * up.b;
        u32x4 o; o.x = pk2(aa.x, aa.y); o.y = pk2(aa.z, aa.w); o.z = pk2(ab.x, ab.y); o.w = pk2(ab.z, ab.w);
        *(u32x4*)(ACT + (size_t)t * DFF + ch0) = o;
        if (prompt) { if (pos >= SEQ - 2) st8(p.out + O_CONVP + ((size_t)b * 2 + (pos - (SEQ - 2))) * DFF + ch0, g0); }
        else { float* co = p.out + O_CONVS + (size_t)b * 2 * DFF + ch0; st8(co, g1); st8(co + DFF, g0); }
    }
}
DI void conv_block_task(const Params& p, int rb, int vg, int lane) {
    unsigned char* ws = p.ws;
    const bf16_t* GU = (const bf16_t*)(ws + WS_GU); const float* SS1 = (const float*)(ws + WS_SS1); bf16_t* ACT = (bf16_t*)(ws + WS_ACT);
    const int t0 = 16 * rb, b = t0 >> 11, pos0 = t0 & 2047;
    float rr[18];
#pragma unroll
    for (int i = 0; i < 18; ++i) { const int t = t0 - 2 + i; float v = (lane < 32 && (i >= 2 || pos0 > 0)) ? SS1[(size_t)t * 32 + lane] : 0.f; v = wave_sum(v); rr[i] = (i >= 2 || pos0 > 0) ? 1.0f / sqrtf(v * (1.0f / D) + EPS) : 0.f; }
    const int v = vg * 64 + lane; if (v >= DFF / 8) return;
    const int ch0 = 8 * v, pn = ch0 >> 7, r = ch0 & 127, gcol = 256 * pn + r, ucol = gcol + 128;
    const F8 w0 = ld8(p.conv_w + ch0), w1 = ld8(p.conv_w + DFF + ch0), w2 = ld8(p.conv_w + 2 * DFF + ch0), cb = ld8(p.conv_b + ch0);
    const bf16_t* gp = GU + (size_t)t0 * NUP + gcol; const bf16_t* up_ = GU + (size_t)t0 * NUP + ucol;
    F8 g2 = unpack8(*(const u32x4*)(gp - (pos0 > 0 ? 2 : 0) * (size_t)NUP), rr[0]), g1 = unpack8(*(const u32x4*)(gp - (pos0 > 0 ? 1 : 0) * (size_t)NUP), rr[1]);
#pragma unroll 1
    for (int h = 0; h < 2; ++h) {
        u32x4 gw[8], uw[8];
#pragma unroll
        for (int i = 0; i < 8; ++i) { gw[i] = *(const u32x4*)(gp + (size_t)(8 * h + i) * NUP); uw[i] = *(const u32x4*)(up_ + (size_t)(8 * h + i) * NUP); }
#pragma unroll
        for (int i = 0; i < 8; ++i) { const int ii = 8 * h + i; const float r0 = (h == 0) ? rr[2 + i] : rr[10 + i];
            const F8 g0 = unpack8(gw[i], r0), up = unpack8(uw[i], r0);
            const f32x4 ga = cb.a + w0.a * g2.a + w1.a * g1.a + w2.a * g0.a, gb = cb.b + w0.b * g2.b + w1.b * g1.b + w2.b * g0.b;
            const f32x4 aa = silu4(ga) * up.a, ab = silu4(gb) * up.b;
            u32x4 o; o.x = pk2(aa.x, aa.y); o.y = pk2(aa.z, aa.w); o.z = pk2(ab.x, ab.y); o.w = pk2(ab.z, ab.w);
            *(u32x4*)(ACT + (size_t)(t0 + ii) * DFF + ch0) = o;
            if (pos0 + ii >= SEQ - 2) st8(p.out + O_CONVP + ((size_t)b * 2 + (pos0 + ii - (SEQ - 2))) * DFF + ch0, g0);
            g2 = g1; g1 = g0; }
    }
}
DI void phase_conv(const Params& p, int wave) {
    const int lane = lane_id();
    const int gw = (int)blockIdx.x * NWAVES + wave, NGW = gridDim.x * NWAVES;
    constexpr int NVG = (DFF / 8 + 63) / 64;
    for (int t = MP + gw; t < M; t += NGW) conv_task(p, t, lane);
    for (int it = gw; it < (MP / 16) * NVG; it += NGW) conv_block_task(p, it / NVG, it % NVG, lane);
}

DI void phase_final(const Params& p, int wave) {
    const int lane = lane_id();
    const int gw = (int)blockIdx.x * NWAVES + wave, NGW = gridDim.x * NWAVES;
    const bf16_t* H3 = (const bf16_t*)(p.ws + WS_H3); const float* SS3 = (const float*)(p.ws + WS_SS3); const float* SS3S = (const float*)(p.ws + WS_SS3S);
    for (int t = gw; t < M; t += NGW) {
        const float rs = row_rstd(SS3, SS3S, t, lane);
        float* yo = (t < MP) ? p.out + O_YP + (size_t)t * D : p.out + O_YS + (size_t)(t - MP) * D;
#pragma unroll
        for (int i = 0; i < 4; ++i) { const int c = 512 * i + 8 * lane; const u32x4 w = *(const u32x4*)(H3 + (size_t)t * D + c); const f32x4 g0 = *(const f32x4*)(p.norm_final + c), g1 = *(const f32x4*)(p.norm_final + c + 4);
            *(f32x4*)(yo + c) = bf4lo(w) * rs * g0; *(f32x4*)(yo + c + 4) = bf4hi(w) * rs * g1; }
    }
}

#define EPI_ARGS const f32x4 (&acc)[2][2][4][2], const g8::Unit& u, int wr, int wc, int fr, int fq
#define EPI_ROWS(ROWVAR) _Pragma("unroll") for (int ai = 0; ai < 2; ++ai) _Pragma("unroll") for (int m = 0; m < 4; ++m) { const int ROWVAR = u.pm * 256 + ai * 128 + wr * 64 + m * 16 + fr; if (ROWVAR < M) {
#define EPI_COLS(COLVAR) _Pragma("unroll") for (int bj = 0; bj < 2; ++bj) { const int COLVAR = bj * 128 + wc * 32 + 8 * fq; const f32x4 v0 = acc[ai][bj][m][0], v1 = acc[ai][bj][m][1];
#define EPI_END } } }
DI f32x4 exp4(f32x4 x) { return (f32x4){__expf(x.x), __expf(x.y), __expf(x.z), __expf(x.w)}; }
DI f32x4 sig4(f32x4 x) { return (f32x4){sigmoidf_(x.x), sigmoidf_(x.y), sigmoidf_(x.z), sigmoidf_(x.w)}; }
DI float sum4(f32x4 a) { return (a.x + a.y) + (a.z + a.w); }

struct PhaseIn {
    static constexpr int LDA = D, LDB = D, KT = D / 64;
    const Params& p; int G, c, part;
    int c0;
    DI bool next(int i, g8::Unit& u) const { int pm, pn;
        if (part == 0) { if (!g8::grid_order(NTM - 1, 16, G, c, i, pm, pn)) return false; }
        else { if (c < c0 || !g8::grid_order(NTM, 28, G - c0, c - c0, i, pm, pn)) return false; pn += 16; }
        u.pm = pm; u.pn = pn; u.A = (const char*)(p.ws + WS_XB) + (size_t)pm * 256 * D * 2; u.B = (const char*)(p.ws + WS_WIN) + (size_t)pn * 256 * D * 2; return true; }
    DI void epi(EPI_ARGS) const {
        unsigned char* ws = p.ws; const float* RSTD1 = (const float*)(ws + WS_RSTD1); const float* BCUM = (const float*)(ws + WS_BCUM);
        const int pn = u.pn;
        if (pn < 4) {
            bf16_t* QB = (bf16_t*)(ws + WS_QB);
            EPI_ROWS(row) const float rs = RSTD1[row] * 0.0625f; EPI_COLS(col) const size_t o = (size_t)row * KW + pn * 256 + col;
                const f32x4 e0 = exp4(*(const f32x4*)(BCUM + o)), e1 = exp4(*(const f32x4*)(BCUM + o + 4));
                *(u32x4*)(QB + o) = pk8(v0 * rs * e0, v1 * rs * e1); EPI_END
        } else if (pn < 8) {
            bf16_t* KB = (bf16_t*)(ws + WS_KB);
            EPI_ROWS(row) const float rs = RSTD1[row]; EPI_COLS(col) const size_t o = (size_t)row * KW + (pn - 4) * 256 + col;
                const f32x4 b0 = *(const f32x4*)(BCUM + o), b1 = *(const f32x4*)(BCUM + o + 4);
                *(u32x4*)(KB + o) = pk8(v0 * rs * exp4(-b0), v1 * rs * exp4(-b1)); EPI_END
        } else if (pn < 16) {
            bf16_t* V = (bf16_t*)(ws + WS_V);
            EPI_ROWS(row) const float rs = RSTD1[row]; EPI_COLS(col) *(u32x4*)(V + (size_t)row * VW + (pn - 8) * 256 + col) = pk8(v0 * rs, v1 * rs); EPI_END
        } else if (pn < 24) {
            bf16_t* SR = (bf16_t*)(ws + WS_SR);
            EPI_ROWS(row) const float rs = RSTD1[row]; EPI_COLS(col) const f32x4 a = v0 * rs, b = v1 * rs; *(u32x4*)(SR + (size_t)row * VW + (pn - 16) * 256 + col) = pk8(a * sig4(a), b * sig4(b)); EPI_END
        } else if (pn < 28) {
            float* U = (float*)(ws + WS_U);
            EPI_ROWS(row) const float rs = RSTD1[row]; EPI_COLS(col) float* o = U + (size_t)row * POOLW + (pn - 24) * 256 + col; *(f32x4*)o = v0 * rs; *(f32x4*)(o + 4) = v1 * rs; EPI_END
        } else {
            bf16_t* Gt = (bf16_t*)(ws + (pn < 36 ? WS_GA : WS_GB)); const int c0 = (pn < 36 ? pn - 28 : pn - 36) * 256;
            EPI_ROWS(row) const float rs = RSTD1[row]; EPI_COLS(col) *(u32x4*)(Gt + (size_t)row * D + c0 + col) = pk8(sig4(v0 * rs), sig4(v1 * rs)); EPI_END
        }
    }
};

template <int LDA_, int LDB_, int K_> struct PhaseN2048 {
    static constexpr int LDA = LDA_, LDB = LDB_, KT = K_ / 64;
    const Params& p; int G, c; size_t a_off, b_off;
    DI bool next_(int i, g8::Unit& u) const { int pm, pn; if (!g8::grid_order(NTM - 1, 8, G, c, i, pm, pn)) return false;
        u.pm = pm; u.pn = pn; u.A = (const char*)(p.ws + a_off) + (size_t)pm * 256 * LDA * 2; u.B = (const char*)(p.ws + b_off) + (size_t)pn * 256 * LDB * 2; return true; }
};
struct PhaseYb : PhaseN2048<POOLW, POOLW, POOLW> {
    DI bool next(int i, g8::Unit& u) const { return next_(i, u); }
    DI void epi(EPI_ARGS) const { const bf16_t* GB = (const bf16_t*)(p.ws + WS_GB); bf16_t* Y = (bf16_t*)(p.ws + WS_YBG);
#pragma unroll
        for (int ai = 0; ai < 2; ++ai) { u32x4 g[4][2];
#pragma unroll
            for (int m = 0; m < 4; ++m)
#pragma unroll
                for (int bj = 0; bj < 2; ++bj) g[m][bj] = *(const u32x4*)(GB + (size_t)(u.pm * 256 + ai * 128 + wr * 64 + m * 16 + fr) * D + u.pn * 256 + bj * 128 + wc * 32 + 8 * fq);
#pragma unroll
            for (int m = 0; m < 4; ++m)
#pragma unroll
                for (int bj = 0; bj < 2; ++bj) { const size_t o = (size_t)(u.pm * 256 + ai * 128 + wr * 64 + m * 16 + fr) * D + u.pn * 256 + bj * 128 + wc * 32 + 8 * fq;
                    *(u32x4*)(Y + o) = pk8(acc[ai][bj][m][0] * bf4lo(g[m][bj]), acc[ai][bj][m][1] * bf4hi(g[m][bj])); } } }
};
struct PhaseYa : PhaseN2048<VW, VW, VW> {
    DI bool next(int i, g8::Unit& u) const { return next_(i, u); }
    DI void epi(EPI_ARGS) const { const bf16_t* GA = (const bf16_t*)(p.ws + WS_GA); const bf16_t* Y = (const bf16_t*)(p.ws + WS_YBG); bf16_t* MB = (bf16_t*)(p.ws + WS_MB);
#pragma unroll
        for (int ai = 0; ai < 2; ++ai) { u32x4 g[4][2], y[4][2];
#pragma unroll
            for (int m = 0; m < 4; ++m)
#pragma unroll
                for (int bj = 0; bj < 2; ++bj) { const size_t o = (size_t)(u.pm * 256 + ai * 128 + wr * 64 + m * 16 + fr) * D + u.pn * 256 + bj * 128 + wc * 32 + 8 * fq;
                    g[m][bj] = *(const u32x4*)(GA + o); y[m][bj] = *(const u32x4*)(Y + o); }
#pragma unroll
            for (int m = 0; m < 4; ++m)
#pragma unroll
                for (int bj = 0; bj < 2; ++bj) { const size_t o = (size_t)(u.pm * 256 + ai * 128 + wr * 64 + m * 16 + fr) * D + u.pn * 256 + bj * 128 + wc * 32 + 8 * fq;
                    *(u32x4*)(MB + o) = pk8(acc[ai][bj][m][0] * bf4lo(g[m][bj]) + bf4lo(y[m][bj]), acc[ai][bj][m][1] * bf4hi(g[m][bj]) + bf4hi(y[m][bj])); } } }
};
template <bool BASE_BF16>
DI void epi_residual(EPI_ARGS, const void* base_v, bf16_t* HB, float* SS) {
#pragma unroll
    for (int ai = 0; ai < 2; ++ai)
#pragma unroll
        for (int mh = 0; mh < 2; ++mh) {
            f32x4 b0[2][2], b1[2][2];
#pragma unroll
            for (int mm = 0; mm < 2; ++mm) { const int row = u.pm * 256 + ai * 128 + wr * 64 + (2 * mh + mm) * 16 + fr;
#pragma unroll
                for (int bj = 0; bj < 2; ++bj) { const size_t o = (size_t)row * D + u.pn * 256 + bj * 128 + wc * 32 + 8 * fq;
                    if (BASE_BF16) { const u32x4 w = *(const u32x4*)((const bf16_t*)base_v + o); b0[mm][bj] = bf4lo(w); b1[mm][bj] = bf4hi(w); }
                    else { b0[mm][bj] = *(const f32x4*)((const float*)base_v + o); b1[mm][bj] = *(const f32x4*)((const float*)base_v + o + 4); } } }
#pragma unroll
            for (int mm = 0; mm < 2; ++mm) { const int m = 2 * mh + mm; const int row = u.pm * 256 + ai * 128 + wr * 64 + m * 16 + fr; float ss = 0.f;
#pragma unroll
                for (int bj = 0; bj < 2; ++bj) { const size_t o = (size_t)row * D + u.pn * 256 + bj * 128 + wc * 32 + 8 * fq;
                    const f32x4 h0 = acc[ai][bj][m][0] + b0[mm][bj], h1 = acc[ai][bj][m][1] + b1[mm][bj];
                    *(u32x4*)(HB + o) = pk8(h0, h1);
                    ss += sum4(h0 * h0) + sum4(h1 * h1); }
                ss += __shfl_xor(ss, 16); ss += __shfl_xor(ss, 32);
                if (fq == 0) SS[(size_t)row * 32 + u.pn * 4 + wc] = ss; }
        }
}
struct PhaseOut : PhaseN2048<D, D, D> {
    DI bool next(int i, g8::Unit& u) const { return next_(i, u); }
    DI void epi(EPI_ARGS) const { epi_residual<false>(acc, u, wr, wc, fr, fq, p.x_prompt, (bf16_t*)(p.ws + WS_H1B), (float*)(p.ws + WS_SS1)); }
};
struct PhaseDown : PhaseN2048<DFF, DFF, DFF> {
    DI bool next(int i, g8::Unit& u) const { return next_(i, u); }
    DI void epi(EPI_ARGS) const { epi_residual<true>(acc, u, wr, wc, fr, fq, p.ws + WS_H1B, (bf16_t*)(p.ws + WS_H2B), (float*)(p.ws + WS_SS2)); }
};
struct PhasePe : PhaseN2048<PLE, PLE, PLE> {
    DI bool next(int i, g8::Unit& u) const { const int first = (NTM * 43) % G, nfree = G - first; if (nfree <= 0 || c < first) return false;
        const long L = (long)i * nfree + (c - first); if (L >= 256) return false; const int pm = (int)L >> 3, pn = (int)L & 7;
        u.pm = pm; u.pn = pn; u.A = (const char*)(p.ws + a_off) + (size_t)pm * 256 * LDA * 2; u.B = (const char*)(p.ws + b_off) + (size_t)pn * 256 * LDB * 2; return true; }
    DI void epi(EPI_ARGS) const { bf16_t* PE = (bf16_t*)(p.ws + WS_PE);
        EPI_ROWS(row) EPI_COLS(col) const size_t o = (size_t)row * D + u.pn * 256 + col; *(u32x4*)(PE + o) = pk8(v0, v1); EPI_END }
};
struct PhasePg : PhaseN2048<D, D, D> {
    DI bool next(int i, g8::Unit& u) const { return next_(i, u); }
    DI void epi(EPI_ARGS) const { const bf16_t* H2 = (const bf16_t*)(p.ws + WS_H2B); const bf16_t* PE = (const bf16_t*)(p.ws + WS_PE); const float* SS2 = (const float*)(p.ws + WS_SS2);
        bf16_t* H3 = (bf16_t*)(p.ws + WS_H3); float* SS3 = (float*)(p.ws + WS_SS3);
#pragma unroll
        for (int ai = 0; ai < 2; ++ai)
#pragma unroll
            for (int mh = 0; mh < 2; ++mh) { u32x4 hw[2][2], pw[2][2]; float rs[2];
#pragma unroll
                for (int mm = 0; mm < 2; ++mm) { const int row = u.pm * 256 + ai * 128 + wr * 64 + (2 * mh + mm) * 16 + fr; float s2 = 0.f;
#pragma unroll
                    for (int k = 0; k < 8; ++k) s2 += sum4(*(const f32x4*)(SS2 + (size_t)row * 32 + 4 * k));
                    rs[mm] = 1.0f / sqrtf(s2 * (1.0f / D) + EPS);
#pragma unroll
                    for (int bj = 0; bj < 2; ++bj) { const size_t o = (size_t)row * D + u.pn * 256 + bj * 128 + wc * 32 + 8 * fq; hw[mm][bj] = *(const u32x4*)(H2 + o); pw[mm][bj] = *(const u32x4*)(PE + o); } }
#pragma unroll
                for (int mm = 0; mm < 2; ++mm) { const int m = 2 * mh + mm; const int row = u.pm * 256 + ai * 128 + wr * 64 + m * 16 + fr; float ss = 0.f;
#pragma unroll
                    for (int bj = 0; bj < 2; ++bj) { const size_t o = (size_t)row * D + u.pn * 256 + bj * 128 + wc * 32 + 8 * fq;
                        const f32x4 h0 = bf4lo(hw[mm][bj]) + sig4(acc[ai][bj][m][0] * rs[mm]) * bf4lo(pw[mm][bj]), h1 = bf4hi(hw[mm][bj]) + sig4(acc[ai][bj][m][1] * rs[mm]) * bf4hi(pw[mm][bj]);
                        *(u32x4*)(H3 + o) = pk8(h0, h1); ss += sum4(h0 * h0) + sum4(h1 * h1); }
                    ss += __shfl_xor(ss, 16); ss += __shfl_xor(ss, 32);
                    if (fq == 0) SS3[(size_t)row * 32 + u.pn * 4 + wc] = ss; } } }
};
struct PhaseUp {
    static constexpr int LDA = D, LDB = D, KT = D / 64;
    const Params& p; int G, c;
    DI bool next(int i, g8::Unit& u) const { int pm, pn; if (!g8::grid_order(NTM, 43, G, c, i, pm, pn)) return false;
        u.pm = pm; u.pn = pn; u.A = (const char*)(p.ws + WS_H1B) + (size_t)pm * 256 * D * 2; u.B = (const char*)(p.ws + WS_WUP) + (size_t)pn * 256 * D * 2; return true; }
    DI void epi(EPI_ARGS) const { bf16_t* GU = (bf16_t*)(p.ws + WS_GU);
        EPI_ROWS(row) EPI_COLS(col) *(u32x4*)(GU + (size_t)row * NUP + u.pn * 256 + col) = pk8(v0, v1); EPI_END }
};

struct PhaseWpb {
    static constexpr int LDA = POOLW, LDB = 256, KT = 4;
    const Params& p; int G, c;
    DI bool next(int i, g8::Unit& u) const { const int off = 220 % G; const long L = (long)i * G + ((c + G - off) % G); if (L >= 32) return false;
        const int pm = (int)L >> 2, g = (int)L & 3; u.pm = pm; u.pn = g;
        u.A = (const char*)(p.ws + WS_WBT) + ((size_t)pm * 256 * POOLW + g * 256) * 2; u.B = (const char*)(p.ws + WS_WPS) + (size_t)g * 256 * 256 * 2; return true; }
    DI void epi(EPI_ARGS) const { bf16_t* W = (bf16_t*)(p.ws + WS_WPB);
        EPI_ROWS(row) EPI_COLS(col) *(u32x4*)(W + (size_t)row * POOLW + u.pn * 256 + col) = pk8(v0, v1); EPI_END }
};

template <int KS, int LDA, int LDB>
DI f32x4 skinny16(const bf16_t* A, const bf16_t* W, int lane) {
    const int fr = lane & 15, fq = lane >> 4;
    const bf16_t* ap = A + (size_t)fr * LDA + 8 * fq; const bf16_t* bp = W + (size_t)fr * LDB + 8 * fq;
    f32x4 acc = {0.f, 0.f, 0.f, 0.f};
#pragma unroll 4
    for (int s = 0; s < KS; ++s) { const bf16x8 a = *(const bf16x8*)(ap + 32 * s), b = *(const bf16x8*)(bp + 32 * s); acc = __builtin_amdgcn_mfma_f32_16x16x32_bf16(a, b, acc, 0, 0, 0); }
    return acc;
}
DI float sum16(float v) { v += __shfl_xor(v, 1); v += __shfl_xor(v, 2); v += __shfl_xor(v, 4); v += __shfl_xor(v, 8); return v; }
template <int KIND, int K, int LDA, int LDB, int NCG = 128>
DI void sample_gemm(const Params& p, LAS unsigned char* lds, size_t a_off, size_t w_off, int wave) {
    unsigned char* ws = p.ws; const int lane = lane_id(), fr = lane & 15, fq = lane >> 4;
    constexpr int KS = K / 64;
    for (int it = blockIdx.x; it < 2 * NCG; it += gridDim.x) {
        const int cg_ = it >> 1, r0 = MP + 64 * (it & 1) + 16 * (wave & 3), col = 16 * cg_ + fr, kh = wave >> 2;
        f32x4 acc = skinny16<KS, LDA, LDB>((const bf16_t*)(ws + a_off) + (size_t)r0 * LDA + kh * (K / 2), (const bf16_t*)(ws + w_off) + (size_t)(16 * cg_) * LDB + kh * (K / 2), lane);
        LAS f32x4* xch = (LAS f32x4*)lds;
        if (kh == 1) xch[(wave & 3) * 64 + lane] = acc;
        __syncthreads();
        if (kh == 0) {
        acc += xch[wave * 64 + lane];
        float rs[4] = {0.f, 0.f, 0.f, 0.f};
        if (KIND == 5) {
            const float* SS2S = (const float*)(ws + WS_SS2S);
#pragma unroll
            for (int r = 0; r < 16; ++r) { const float* q = SS2S + (size_t)(r0 - MP + r) * 128; const float s_ = wave_sum(q[lane] + q[64 + lane]); const float rr = 1.0f / sqrtf(s_ * (1.0f / D) + EPS);
#pragma unroll
                for (int j = 0; j < 4; ++j) rs[j] = (r == 4 * fq + j) ? rr : rs[j]; }
        }
#pragma unroll
        for (int j = 0; j < 4; ++j) {
            const int row = r0 + 4 * fq + j; const size_t o = (size_t)row * D + col; const float v = acc[j]; float hsq = 0.f;
            if (KIND == 6) { const float val = v * ((const float*)(ws + WS_RSTD1))[row];
                if (col < KW) ((bf16_t*)(ws + WS_QB))[(size_t)row * KW + col] = (bf16_t)(pk2(val * 0.0625f, 0.f) & 0xffffu);
                else if (col < 2 * KW) ((bf16_t*)(ws + WS_KB))[(size_t)row * KW + col - KW] = (bf16_t)(pk2(val, 0.f) & 0xffffu);
                else ((bf16_t*)(ws + WS_V))[(size_t)row * VW + col - 2 * KW] = (bf16_t)(pk2(val, 0.f) & 0xffffu); }
            if (KIND == 0) { ((bf16_t*)(ws + WS_YBG))[o] = (bf16_t)(pk2(v * bf1(((const bf16_t*)(ws + WS_GB))[o]), 0.f) & 0xffffu); }
            if (KIND == 1) { ((bf16_t*)(ws + WS_MB))[o] = (bf16_t)(pk2(v * bf1(((const bf16_t*)(ws + WS_GA))[o]) + bf1(((const bf16_t*)(ws + WS_YBG))[o]), 0.f) & 0xffffu); }
            if (KIND == 2) { const float hv = p.x_sample[(size_t)(row - MP) * D + col] + v; ((bf16_t*)(ws + WS_H1B))[o] = (bf16_t)(pk2(hv, 0.f) & 0xffffu); hsq = hv * hv; }
            if (KIND == 3) { const float hv = bf1(((const bf16_t*)(ws + WS_H1B))[o]) + v; ((bf16_t*)(ws + WS_H2B))[o] = (bf16_t)(pk2(hv, 0.f) & 0xffffu); hsq = hv * hv; }
            if (KIND == 4) { ((bf16_t*)(ws + WS_PE))[o] = (bf16_t)(pk2(v, 0.f) & 0xffffu); }
            if (KIND == 5) { const float hv = bf1(((const bf16_t*)(ws + WS_H2B))[o]) + sigmoidf_(v * rs[j]) * bf1(((const bf16_t*)(ws + WS_PE))[o]); ((bf16_t*)(ws + WS_H3))[o] = (bf16_t)(pk2(hv, 0.f) & 0xffffu); hsq = hv * hv; }
            if (KIND == 2 || KIND == 3 || KIND == 5) { const float t = sum16(hsq);
                float* SSx = (float*)(ws + (KIND == 2 ? WS_SS1S : (KIND == 3 ? WS_SS2S : WS_SS3S))); if (fr == 0) SSx[(size_t)(row - MP) * 128 + cg_] = t; }
        }
        }
        __syncthreads();
    }
}


#define XB_TMO      128
#define XB_XCNT(j)  (256  + 64 * (j))
#define XB_XSUB(j)  (1280 + 64 * (j))
#define XB_XGEN(j)  (2304 + 64 * (j))
#define XB_TOP      3328
#define XB_TOPGEN   3392
#define XCD_BAR_WORDS 3456
#define XB_SPIN_CAP (1u << 22)
DI unsigned xb_ld(unsigned* p)              { return __hip_atomic_load(p, __ATOMIC_RELAXED, __HIP_MEMORY_SCOPE_AGENT); }
DI unsigned xb_add(unsigned* p, unsigned v) { return __hip_atomic_fetch_add(p, v, __ATOMIC_RELAXED, __HIP_MEMORY_SCOPE_AGENT); }
DI unsigned xb_xcc_id() { return (unsigned)__builtin_amdgcn_s_getreg((3 << 11) | 20) & 0xFu; }
#define XB_SPIN(cond, bar) do { unsigned _sp = 0; while (cond) { __builtin_amdgcn_s_sleep(1); \
    if ((++_sp & 255u) == 0u) { if (xb_ld(&(bar)[XB_TMO])) break; if (_sp > XB_SPIN_CAP) { atomicAdd(&(bar)[XB_TMO], 1u); break; } } } } while (0)
struct XcdBarrier { unsigned* bar; unsigned x; volatile LAS unsigned* st; };
DI XcdBarrier xcd_barrier_post(unsigned* bar, volatile LAS unsigned* st, bool t0) {
    XcdBarrier b; b.bar = bar; b.x = xb_xcc_id(); b.st = st;
    if (t0) (void)xb_add(&bar[XB_XCNT(b.x)], 1u);
    return b;
}
DI void xcd_barrier_complete(unsigned* bar, unsigned x, unsigned& nloc, unsigned& nx) {
    const unsigned G = gridDim.x * gridDim.y * gridDim.z;
    unsigned sum, cnt, mine, sp = 0u;
    for (;;) {
        sum = 0u; cnt = 0u; mine = 0u;
#pragma unroll
        for (unsigned j = 0; j < 16; ++j) { const unsigned c = xb_ld(&bar[XB_XCNT(j)]); sum += c; cnt += (c > 0u) ? 1u : 0u; mine = (j == x) ? c : mine; }
        if (sum == G) break;
        __builtin_amdgcn_s_sleep(1);
        if ((++sp & 255u) == 0u) { if (xb_ld(&bar[XB_TMO])) break; if (sp > XB_SPIN_CAP) { atomicAdd(&bar[XB_TMO], 1u); break; } }
    }
    nloc = mine > 0u ? mine : 1u; nx = cnt > 0u ? cnt : 1u;
}
DI void xcd_barrier(const XcdBarrier& b, bool t0) {
    asm volatile("s_waitcnt vmcnt(0)" ::: "memory");
    __syncthreads();
    if (t0) {
        unsigned* bar = b.bar;
        __builtin_amdgcn_s_waitcnt(0);
        unsigned nloc = b.st[0], nx = b.st[1];
        if (nloc == 0u) { xcd_barrier_complete(bar, b.x, nloc, nx); b.st[0] = nloc; b.st[1] = nx; }
        const unsigned old = xb_add(&bar[XB_XSUB(b.x)], 1u);
        const unsigned gen = old / nloc;
        if (old + 1u == (gen + 1u) * nloc) {
            __builtin_amdgcn_fence(__ATOMIC_RELEASE, "agent");
            asm volatile("s_waitcnt vmcnt(0)" ::: "memory");
            const unsigned og = xb_add(&bar[XB_TOP], 1u);
            const unsigned tg = og / nx;
            if (og + 1u == (tg + 1u) * nx) xb_add(&bar[XB_TOPGEN], 1u);
            else XB_SPIN(xb_ld(&bar[XB_TOPGEN]) == tg, bar);
            __builtin_amdgcn_fence(__ATOMIC_ACQUIRE, "agent");
            xb_add(&bar[XB_XGEN(b.x)], 1u);
            asm volatile("s_waitcnt vmcnt(0)" ::: "memory");
        } else {
            XB_SPIN(xb_ld(&bar[XB_XGEN(b.x)]) == gen, bar);
            __builtin_amdgcn_fence(__ATOMIC_ACQUIRE, "agent");
            asm volatile("s_waitcnt vmcnt(0)" ::: "memory");
        }
    }
    __syncthreads();
}

constexpr int N_PHASES = 13;
#ifndef G8_SP2
#define G8_SP2 true
#endif
#ifndef G8_ALIGN
#define G8_ALIGN true
#endif

__global__ void __launch_bounds__(NTHREADS, 2) fwd_kernel(Params p) {
    extern __shared__ __attribute__((aligned(16))) unsigned char lds_raw[];
    LAS unsigned char* lds = (LAS unsigned char*)lds_raw;
    const int G = gridDim.x, c = blockIdx.x;
    const int wave = __builtin_amdgcn_readfirstlane(threadIdx.x >> 6);
    const int lo = p.ph_lo, hi = p.ph_hi;
#ifndef REPEAT_MASK
#define REPEAT_MASK 0
#endif
#ifndef PHASE_MASK
#define PHASE_MASK 0x1bff
#endif
#define IN(k) (((PHASE_MASK >> (k)) & 1) && lo <= (k) && (k) < hi)
    volatile LAS unsigned* bst = (volatile LAS unsigned*)(lds + LDS_MISC);
    const bool t0 = (wave == 0) && (lane_id() == 0);
    XcdBarrier bar; bar.bar = (unsigned*)(p.ws + WS_CTL); bar.x = 0; bar.st = bst;
    if (hi - lo > 1) { if (t0) { bst[0] = 0u; bst[1] = 0u; } __syncthreads(); bar = xcd_barrier_post((unsigned*)(p.ws + WS_CTL), bst, t0); }
#define NEXTPH(k) ((k) == 9 ? 11 : (k) + 1)
#define SEAM(k) do { if (IN(k) && IN(NEXTPH(k))) { xcd_barrier(bar, (wave == 0) && (lane_id() == 0)); } } while (0)
    if (IN(0)) { phase_p0(p, lds, wave); if ((REPEAT_MASK >> 0) & 1) { xcd_barrier(bar, (wave == 0) && (lane_id() == 0)); phase_p0(p, lds, wave); } } SEAM(0);
    if (IN(1)) { sample_gemm<6, D, D, D, 256>(p, lds, WS_XB, WS_WIN, wave); PhaseIn ph{p, G, c, 0, 0}; g8::run<PhaseIn, G8_ALIGN, G8_SP2>(lds, ph, wave); } SEAM(1);
    if (IN(2)) {
        if (G == 256) {
            if (c < 32) scan_role(p, lds, wave, c, 32);
            else if (c < 71) stream_role(p, wave, c - 32, 39);
            else { PhaseIn ph{p, G, c, 1, 71}; g8::run<PhaseIn, G8_ALIGN, G8_SP2>(lds, ph, wave); PhaseWpb pw{p, G, c}; g8::run<PhaseWpb, G8_ALIGN, G8_SP2>(lds, pw, wave); }
        } else {
            PhaseIn ph{p, G, c, 1, 0}; g8::run<PhaseIn, G8_ALIGN, G8_SP2>(lds, ph, wave); PhaseWpb pw{p, G, c}; g8::run<PhaseWpb, G8_ALIGN, G8_SP2>(lds, pw, wave);
            scan_role(p, lds, wave, c, G); stream_role(p, wave, c, G);
        }
    } SEAM(2);
    if (IN(3)) { phase_p3(p, wave); if ((REPEAT_MASK >> 3) & 1) { xcd_barrier(bar, (wave == 0) && (lane_id() == 0)); phase_p3(p, wave); } } SEAM(3);
    if (IN(4)) { sample_gemm<0, POOLW, POOLW, POOLW>(p, lds, WS_PM, WS_WPB, wave); PhaseYb ph{{p, G, c, WS_PM, WS_WPB}}; g8::run<PhaseYb, G8_ALIGN, G8_SP2>(lds, ph, wave); if ((REPEAT_MASK >> 4) & 1) { xcd_barrier(bar, (wave == 0) && (lane_id() == 0)); sample_gemm<0, POOLW, POOLW, POOLW>(p, lds, WS_PM, WS_WPB, wave); PhaseYb ph{{p, G, c, WS_PM, WS_WPB}}; g8::run<PhaseYb, G8_ALIGN, G8_SP2>(lds, ph, wave); } } SEAM(4);
    if (IN(5)) { sample_gemm<1, VW, VW, VW>(p, lds, WS_OG, WS_WA, wave); PhaseYa ph{{p, G, c, WS_OG, WS_WA}}; g8::run<PhaseYa, G8_ALIGN, G8_SP2>(lds, ph, wave); if ((REPEAT_MASK >> 5) & 1) { xcd_barrier(bar, (wave == 0) && (lane_id() == 0)); sample_gemm<1, VW, VW, VW>(p, lds, WS_OG, WS_WA, wave); PhaseYa ph{{p, G, c, WS_OG, WS_WA}}; g8::run<PhaseYa, G8_ALIGN, G8_SP2>(lds, ph, wave); } } SEAM(5);
    if (IN(6)) { sample_gemm<2, D, D, D>(p, lds, WS_MB, WS_WO, wave); PhaseOut ph{{p, G, c, WS_MB, WS_WO}}; g8::run<PhaseOut, G8_ALIGN, G8_SP2>(lds, ph, wave); if ((REPEAT_MASK >> 6) & 1) { xcd_barrier(bar, (wave == 0) && (lane_id() == 0)); sample_gemm<2, D, D, D>(p, lds, WS_MB, WS_WO, wave); PhaseOut ph{{p, G, c, WS_MB, WS_WO}}; g8::run<PhaseOut, G8_ALIGN, G8_SP2>(lds, ph, wave); } } SEAM(6);
    if (IN(7)) { PhaseUp ph{p, G, c}; g8::run<PhaseUp, G8_ALIGN, G8_SP2>(lds, ph, wave); sample_gemm<4, PLE, PLE, PLE>(p, lds, WS_PLB, WS_WPLE, wave); { PhasePe pe{{p, G, c, WS_PLB, WS_WPLE}}; g8::run<PhasePe, G8_ALIGN, G8_SP2>(lds, pe, wave); } if ((REPEAT_MASK >> 7) & 1) { xcd_barrier(bar, (wave == 0) && (lane_id() == 0)); PhaseUp ph{p, G, c}; g8::run<PhaseUp, G8_ALIGN, G8_SP2>(lds, ph, wave); } } SEAM(7);
    if (IN(8)) { phase_conv(p, wave); if ((REPEAT_MASK >> 8) & 1) { xcd_barrier(bar, (wave == 0) && (lane_id() == 0)); phase_conv(p, wave); } } SEAM(8);
    if (IN(9)) { sample_gemm<3, DFF, DFF, DFF>(p, lds, WS_ACT, WS_WD, wave); PhaseDown ph{{p, G, c, WS_ACT, WS_WD}}; g8::run<PhaseDown, G8_ALIGN, G8_SP2>(lds, ph, wave); if ((REPEAT_MASK >> 9) & 1) { xcd_barrier(bar, (wave == 0) && (lane_id() == 0)); sample_gemm<3, DFF, DFF, DFF>(p, lds, WS_ACT, WS_WD, wave); PhaseDown ph{{p, G, c, WS_ACT, WS_WD}}; g8::run<PhaseDown, G8_ALIGN, G8_SP2>(lds, ph, wave); } } SEAM(9);
    if (IN(11)) { sample_gemm<5, D, D, D>(p, lds, WS_H2B, WS_WPG, wave); PhasePg ph{{p, G, c, WS_H2B, WS_WPG}}; g8::run<PhasePg, G8_ALIGN, G8_SP2>(lds, ph, wave); if ((REPEAT_MASK >> 11) & 1) { xcd_barrier(bar, (wave == 0) && (lane_id() == 0)); sample_gemm<5, D, D, D>(p, lds, WS_H2B, WS_WPG, wave); PhasePg ph{{p, G, c, WS_H2B, WS_WPG}}; g8::run<PhasePg, G8_ALIGN, G8_SP2>(lds, ph, wave); } } SEAM(11);
    if (IN(12)) { phase_final(p, wave); if ((REPEAT_MASK >> 12) & 1) { xcd_barrier(bar, (wave == 0) && (lane_id() == 0)); phase_final(p, wave); } }
#undef IN
#undef SEAM
}

extern "C" void kernel_launch(void* const* d_in, const int* in_sizes, int n_in, void* d_out, int out_size, void* d_ws, size_t ws_size, hipStream_t stream) {
    static int grid = 0;
    if (grid == 0) {
        if (n_in != 26 || (size_t)out_size != O_END || ws_size < WS_END) {
            fprintf(stderr, "kernel_launch: unexpected problem: n_in %d out %d ws %zu (need %zu)\n", n_in, out_size, ws_size, (size_t)WS_END); grid = -1; return; }
        int dev = 0, cus = 0, per_cu = 0;
        if (hipGetDevice(&dev) != hipSuccess || hipDeviceGetAttribute(&cus, hipDeviceAttributeMultiprocessorCount, dev) != hipSuccess) { grid = -1; return; }
        if (hipFuncSetAttribute((const void*)fwd_kernel, hipFuncAttributeMaxDynamicSharedMemorySize, LDS_BYTES) != hipSuccess) { fprintf(stderr, "kernel_launch: hipFuncSetAttribute failed\n"); grid = -1; return; }
        if (hipOccupancyMaxActiveBlocksPerMultiprocessor(&per_cu, (const void*)fwd_kernel, NTHREADS, LDS_BYTES) != hipSuccess || per_cu < 1) {
            fprintf(stderr, "kernel_launch: occupancy query reports %d blocks per CU\n", per_cu); (void)hipGetLastError(); grid = -1; return; }
        grid = cus;
    }
    if (grid < 0) return;
    Params p{};
    const float** pp = (const float**)&p;
    for (int i = 0; i < 26; ++i) pp[i] = (const float*)d_in[i];
    p.out = (float*)d_out; p.ws = (unsigned char*)d_ws;
#if MK_N_LAUNCHES == 1
    p.ph_lo = 0; p.ph_hi = N_PHASES;
    void* args[] = {&p};
    if (hipMemsetAsync((char*)d_ws + WS_CTL, 0, XCD_BAR_WORDS * 4, stream) != hipSuccess) { fprintf(stderr, "kernel_launch: memset failed\n"); return; }
    hipError_t e = hipLaunchCooperativeKernel((const void*)fwd_kernel, dim3(grid), dim3(NTHREADS), args, LDS_BYTES, stream);
    if (e != hipSuccess) fprintf(stderr, "kernel_launch: cooperative launch failed: %s (grid %d)\n", hipGetErrorString(e), grid);
#else
    for (int k = 0; k < N_PHASES; ++k) { p.ph_lo = k; p.ph_hi = k + 1; hipLaunchKernelGGL(fwd_kernel, dim3(grid), dim3(NTHREADS), LDS_BYTES, stream, p); }
#endif
}
```

```cpp
#include <hip/hip_runtime.h>
#include <hip/hip_cooperative_groups.h>
#include <cstdio>
#include <cstdint>
namespace cg = cooperative_groups;

#ifndef MK_N_LAUNCHES
#define MK_N_LAUNCHES 1
#endif

#define LAS __attribute__((address_space(3)))
#define DI __device__ __forceinline__
typedef unsigned short bf16_t;
typedef short bf16x8 __attribute__((ext_vector_type(8)));
typedef short s16x4 __attribute__((ext_vector_type(4)));
typedef float f32x4 __attribute__((ext_vector_type(4)));
typedef float f32x2 __attribute__((ext_vector_type(2)));
typedef float f32x16 __attribute__((ext_vector_type(16)));
typedef unsigned u32x4 __attribute__((ext_vector_type(4)));
typedef unsigned u32x2 __attribute__((ext_vector_type(2)));

constexpr int D = 2048, MP = 8192, MS = 128, M = MP + MS, MPAD = 8448, NTM = 33;
constexpr int SEQ = 2048, NB = 4, NH = 4, DK = 256, DV = 512, KW = 1024, VW = 2048;
constexpr int DFF = 5504, NUP = 2 * DFF, PLE = 256, POOLW = 1024, INW = 11280, NIN = 11264;
constexpr float EPS = 1e-6f;
constexpr int NSL = 16;
constexpr int CH = 32, NCHK = MP / CH;

constexpr size_t O_YP = 0, O_YS = O_YP + (size_t)MP * D, O_GLAP = O_YS + (size_t)MS * D, O_POOLP = O_GLAP + (size_t)NB * NH * DK * DV,
                 O_CONVP = O_POOLP + (size_t)NB * 15 * POOLW, O_GLAS = O_CONVP + (size_t)NB * 2 * DFF, O_POOLS = O_GLAS + (size_t)MS * NH * DK * DV,
                 O_CONVS = O_POOLS + (size_t)MS * 15 * POOLW, O_END = O_CONVS + (size_t)MS * 2 * DFF;

constexpr size_t al(size_t x) { return (x + 255) & ~(size_t)255; }
constexpr size_t WS_CTL = 0, CTL_BYTES = 65536;
constexpr size_t WS_WUP = WS_CTL + CTL_BYTES;
constexpr size_t WS_WD = WS_WUP + al((size_t)NUP * D * 2);
constexpr size_t WS_WA = WS_WD + al((size_t)D * DFF * 2);
constexpr size_t WS_WO = WS_WA + al((size_t)D * D * 2);
constexpr size_t WS_WPG = WS_WO + al((size_t)D * D * 2);
constexpr size_t WS_WPB = WS_WPG + al((size_t)D * D * 2);
constexpr size_t WS_WPLE = WS_WPB + al((size_t)D * POOLW * 2);
constexpr size_t WS_WBT = WS_WPLE + al((size_t)D * PLE * 2);
constexpr size_t WS_WPS = WS_WBT + al((size_t)D * POOLW * 2);
constexpr size_t WS_SMALL = WS_WPS + al((size_t)POOLW * 256 * 2);
constexpr size_t WS_RSTD1 = WS_SMALL;
constexpr size_t WS_LAM = WS_RSTD1 + al((size_t)MPAD * 4);
constexpr size_t WS_OSS = WS_LAM + al((size_t)(NCHK + MS) * KW * 4);
constexpr size_t WS_OSP = WS_OSS + al((size_t)MP * NH * NSL * 4);
constexpr size_t WS_SS1 = WS_OSP + al((size_t)MS * NH * 8 * DV * 4);
constexpr size_t WS_SS2 = WS_SS1 + al((size_t)MPAD * 32 * 4);
constexpr size_t WS_SS3 = WS_SS2 + al((size_t)MPAD * 32 * 4);
constexpr size_t WS_SS1S = WS_SS3 + al((size_t)MPAD * 32 * 4);
constexpr size_t WS_SS2S = WS_SS1S + al((size_t)MS * 128 * 4);
constexpr size_t WS_SS3S = WS_SS2S + al((size_t)MS * 128 * 4);
constexpr size_t WS_RS1 = WS_SS3S + al((size_t)MS * 128 * 4);
constexpr size_t WS_HALO = WS_RS1 + al((size_t)MPAD * 4);
constexpr size_t WS_FIXG = WS_HALO + al((size_t)32 * 2 * DFF * 4);
constexpr size_t WS_FIXU = WS_FIXG + al((size_t)32 * 2 * DFF * 4);
constexpr size_t WS_PLB = WS_FIXU + al((size_t)32 * 2 * DFF * 4);
constexpr size_t WS_R1 = WS_PLB + al((size_t)MPAD * PLE * 2);
constexpr size_t WS_XB = WS_R1;
constexpr size_t WS_WIN = WS_XB + al((size_t)MPAD * D * 2);
constexpr size_t WS_BCUM = WS_WIN + al((size_t)NIN * D * 2);
constexpr size_t WS_R1_END = WS_BCUM + al((size_t)MPAD * KW * 4);
constexpr size_t WS_ACT = WS_R1;
static_assert(WS_ACT + al((size_t)MPAD * DFF * 2) <= WS_R1_END, "R1 overlay");
constexpr size_t WS_R2 = WS_R1_END;
constexpr size_t WS_QB = WS_R2;
constexpr size_t WS_KB = WS_QB + al((size_t)MPAD * KW * 2);
constexpr size_t WS_KD = WS_KB + al((size_t)MPAD * KW * 2);
constexpr size_t WS_V = WS_KD + al((size_t)MPAD * KW * 2);
constexpr size_t WS_SR = WS_V + al((size_t)MPAD * VW * 2);
constexpr size_t WS_GA = WS_SR + al((size_t)MPAD * VW * 2);
constexpr size_t WS_GB = WS_GA + al((size_t)MPAD * D * 2);
constexpr size_t WS_U = WS_GB + al((size_t)MPAD * D * 2);
constexpr size_t WS_OG = WS_U + al((size_t)MPAD * POOLW * 4);
constexpr size_t WS_PM = WS_OG + al((size_t)MPAD * VW * 2);
constexpr size_t WS_YBG = WS_PM + al((size_t)MPAD * POOLW * 2);
constexpr size_t WS_R2_END = WS_YBG + al((size_t)MPAD * D * 4);
constexpr size_t WS_GU = WS_R2;
constexpr size_t WS_H2 = WS_GU + al((size_t)MPAD * NUP * 2);
constexpr size_t WS_PE = WS_H2 + al((size_t)MPAD * D * 4);
static_assert(WS_PE + al((size_t)MPAD * D * 4) <= WS_R2_END, "R2 overlay");
constexpr size_t WS_MB = WS_R2_END;
constexpr size_t WS_H1 = WS_MB + al((size_t)MPAD * D * 2);
constexpr size_t WS_H1B = WS_H1 + al((size_t)MPAD * D * 4);
constexpr size_t WS_END = WS_H1B + al((size_t)MPAD * D * 2);
constexpr size_t WS_H3 = WS_H1;
constexpr size_t WS_H2B = WS_MB;

DI unsigned pk2(float lo, float hi) {
    typedef __bf16 bf2 __attribute__((ext_vector_type(2)));
    f32x2 v = {lo, hi};
    bf2 b = __builtin_convertvector(v, bf2);
    return __builtin_bit_cast(unsigned, b);
}
DI float bflo(unsigned w) { return __uint_as_float(w << 16); }
DI float bfhi(unsigned w) { return __uint_as_float(w & 0xffff0000u); }
DI float bf1(bf16_t b) { return __uint_as_float(((unsigned)b) << 16); }
DI float fexp(float x) { return __expf(x); }
DI float sigmoidf_(float x) { return __builtin_amdgcn_rcpf(1.0f + __expf(-x)); }
DI float siluf_(float x) { return x * sigmoidf_(x); }
DI float logsigmoidf_(float z) { return fminf(z, 0.f) - __logf(1.0f + __expf(-fabsf(z))); }
DI u32x4 pk8(f32x4 a, f32x4 b) { u32x4 o; o.x = pk2(a.x, a.y); o.y = pk2(a.z, a.w); o.z = pk2(b.x, b.y); o.w = pk2(b.z, b.w); return o; }
DI f32x4 bf4lo(u32x4 w) { return (f32x4){bflo(w.x), bfhi(w.x), bflo(w.y), bfhi(w.y)}; }
DI f32x4 bf4hi(u32x4 w) { return (f32x4){bflo(w.z), bfhi(w.z), bflo(w.w), bfhi(w.w)}; }
DI float wave_sum(float v) {
#pragma unroll
    for (int o = 1; o < 64; o <<= 1) v += __shfl_xor(v, o);
    return v;
}
DI int lane_id() { int l; asm volatile("v_mbcnt_lo_u32_b32 %0, -1, 0\n\tv_mbcnt_hi_u32_b32 %0, -1, %0" : "=v"(l)); return l; }
#define LDS_WAIT() asm volatile("s_waitcnt lgkmcnt(0)" ::: "memory")
#define VM_WAIT() asm volatile("s_waitcnt vmcnt(0)" ::: "memory")

struct Params {
    const float *x_prompt, *x_sample, *state_gla, *state_pool, *state_conv, *p_prompt, *p_sample;
    const float *norm_mix, *w_in, *w_gate_up, *b_gate, *gla_norm, *w_branch_a, *w_pool, *pool_scale, *w_branch_b, *w_out, *norm_ffn, *w_up, *conv_w, *conv_b,
        *w_down, *norm_ple, *w_ple_gate, *w_ple, *norm_final;
    float* out; unsigned char* ws;
    int ph_lo, ph_hi;
};

constexpr int NWAVES = 8, NTHREADS = 512;
constexpr int LDS_BYTES = 163840;
constexpr int LDS_XCH = 131072;
constexpr int LDS_MISC = LDS_BYTES - 256;

namespace g8 {
constexpr int BM = 256, BK = 64, HALF = 128, HTB = HALF * BK * 2, STAGE_BYTES = 8 * HTB, NXCD = 8, WGM = 2;
DI int lds_byte(int r, int c) { const int st = (r >> 4) * 2 + (c >> 5), rr = r & 15, cc = c & 31, ob = rr * 64 + cc * 2; return st * 1024 + (ob ^ (((ob >> 9) & 1) << 5)); }
DI void stage_rc(int b, int& R, int& C) { const int st = b / 1024, sb = b % 1024, swz = sb ^ (((sb >> 9) & 1) << 5); R = (st >> 1) * 16 + swz / 64; C = (st & 1) * 32 + (swz % 64) / 2; }
DI int perm32(int rho) { const int n = rho >> 4, i = rho & 15; return 8 * (i >> 2) + 4 * n + (i & 3); }

struct Unit { const char* A; const char* B; int pm, pn; };

DI bool grid_order(int nM, int nN, int G, int c, int i, int& pm, int& pn) {
    const int nwg = nM * nN; const long L = (long)i * G + c; if (L >= nwg) return false;
    int wgid = (int)L; { const int q = nwg / NXCD, r = nwg % NXCD, xcd = wgid % NXCD, off = wgid / NXCD; wgid = (xcd < r ? xcd * (q + 1) : r * (q + 1) + (xcd - r) * q) + off; }
    const int nig = WGM * nN, gid = wgid / nig, fm = gid * WGM, gsz = (nM - fm) < WGM ? (nM - fm) : WGM;
    pm = fm + ((wgid % nig) % gsz); pn = (wgid % nig) / gsz; return true;
}

template <class P, bool ALIGN_EPI, bool SP2>
DI void run(LAS unsigned char* lds, const P& ph, int wid) {
    const int lane = lane_id(), tid = wid * 64 + lane, wr = wid >> 2, wc = wid & 3, fr = lane & 15, fq = lane >> 4;
    constexpr int nt = P::KT;
    unsigned voffA[2], voffB[2];
#pragma unroll
    for (int i = 0; i < 2; ++i) { int R, C; stage_rc(tid * 16 + i * 8192, R, C); const int Rb = (R & ~31) + perm32(R & 31);
        voffA[i] = (unsigned)(R * P::LDA + C) * 2u; voffB[i] = (unsigned)(Rb * P::LDB + C) * 2u; }
    constexpr size_t kstep = (size_t)(BK * 2);
    constexpr size_t hstepA = (size_t)HALF * P::LDA * 2, hstepB = (size_t)HALF * P::LDB * 2;
    const unsigned ldsw = (unsigned)wid * 1024u;
    const int aoff = lds_byte(wr * 64 + fr, fq * 8), boff = lds_byte(wc * 32 + fr, fq * 8);
#define G8_SA(b, h) (((b) * 2 + (h)) * HTB)
#define G8_SB(b, h) ((4 + (b) * 2 + (h)) * HTB)
#define G8_STAGE(bufoff, gbase, voff) do { _Pragma("unroll") for (int _i = 0; _i < 2; ++_i) \
        __builtin_amdgcn_global_load_lds((const unsigned*)((const char*)(gbase) + (voff)[_i]), (LAS unsigned*)(lds + (bufoff) + ldsw + _i * 8192), 16, 0, 0); } while (0)
#define G8_LDA(dst, b, h) do { _Pragma("unroll") for (int m = 0; m < 4; ++m) _Pragma("unroll") for (int k = 0; k < 2; ++k) dst[m][k] = *(const LAS bf16x8*)(lds + G8_SA(b, h) + aoff + m * 2048 + k * 1024); } while (0)
#define G8_LDB(dst, b, h) do { _Pragma("unroll") for (int n = 0; n < 2; ++n) _Pragma("unroll") for (int k = 0; k < 2; ++k) dst[n][k] = *(const LAS bf16x8*)(lds + G8_SB(b, h) + boff + n * 2048 + k * 1024); } while (0)
#define G8_MMA(ai, bj, At, Bt) do { __builtin_amdgcn_s_setprio(1); _Pragma("unroll") for (int m = 0; m < 4; ++m) _Pragma("unroll") for (int n = 0; n < 2; ++n) _Pragma("unroll") for (int k = 0; k < 2; ++k) \
        acc[ai][bj][m][n] = __builtin_amdgcn_mfma_f32_16x16x32_bf16(Bt[n][k], At[m][k], acc[ai][bj][m][n], 0, 0, 0); __builtin_amdgcn_s_setprio(0); } while (0)
#define G8_WAIT_V(n) asm volatile("s_waitcnt vmcnt(" #n ")" ::: "memory")
#define G8_WAIT_L(n) asm volatile("s_waitcnt lgkmcnt(" #n ")" ::: "memory")
#define G8_BAR __builtin_amdgcn_s_barrier()
#define G8_SCHED __builtin_amdgcn_sched_barrier(0)
    Unit cur, nxt; int ui = 0;
    if (!ph.next(0, cur)) return;
    f32x4 acc[2][2][4][2];
#pragma unroll
    for (int a = 0; a < 2; ++a)
#pragma unroll
        for (int b = 0; b < 2; ++b)
#pragma unroll
            for (int m = 0; m < 4; ++m)
#pragma unroll
                for (int n = 0; n < 2; ++n) acc[a][b][m][n] = (f32x4){0.f, 0.f, 0.f, 0.f};
    bf16x8 At[4][2], B0[2][2], B1[2][2];
    const char* cA = cur.A; const char* cB = cur.B;
    if constexpr (SP2) {
        G8_STAGE(G8_SB(0, 0), cB, voffB); G8_STAGE(G8_SB(0, 1), cB + hstepB, voffB); G8_STAGE(G8_SA(0, 0), cA, voffA); G8_STAGE(G8_SA(0, 1), cA + hstepA, voffA);
        if (wr == 1) G8_BAR;
        G8_WAIT_V(2); G8_BAR;
        G8_STAGE(G8_SB(1, 0), cB + kstep, voffB); G8_STAGE(G8_SA(1, 0), cA + kstep, voffA); G8_STAGE(G8_SB(1, 1), cB + hstepB + kstep, voffB);
        G8_WAIT_V(6); G8_BAR;
    } else {
        G8_STAGE(G8_SB(0, 0), cB, voffB); G8_STAGE(G8_SA(0, 0), cA, voffA); G8_STAGE(G8_SB(0, 1), cB + hstepB, voffB); G8_STAGE(G8_SA(0, 1), cA + hstepA, voffA);
        if (wr == 1) G8_BAR;
        G8_WAIT_V(4); G8_BAR;
        G8_STAGE(G8_SB(1, 0), cB + kstep, voffB); G8_STAGE(G8_SA(1, 0), cA + kstep, voffA); G8_STAGE(G8_SB(1, 1), cB + hstepB + kstep, voffB);
        G8_WAIT_V(6); G8_BAR;
    }
    for (;;) {
        const bool has_next = ph.next(ui + 1, nxt);
        const char* nA = has_next ? nxt.A : cA; const char* nB = has_next ? nxt.B : cB;
#pragma unroll 1
        for (int t = 0; t < nt; t += 2) {
            const bool last = (t == nt - 2);
            const char* a1 = cA + (size_t)(t + 1) * kstep;
            const char* a2 = last ? nA : cA + (size_t)(t + 2) * kstep; const char* b2 = last ? nB : cB + (size_t)(t + 2) * kstep;
            const char* a3 = a2 + kstep; const char* b3 = b2 + kstep;
            if constexpr (SP2) {
            G8_LDB(B0, 0, 0); G8_LDB(B1, 0, 1); G8_SCHED; G8_LDA(At, 0, 0); G8_STAGE(G8_SA(1, 1), a1 + hstepA, voffA);
            G8_WAIT_V(8); G8_WAIT_L(0); G8_BAR; G8_MMA(0, 0, At, B0); G8_MMA(0, 1, At, B1); G8_BAR; G8_SCHED;
            G8_LDA(At, 0, 1); G8_STAGE(G8_SB(0, 0), b2, voffB); G8_STAGE(G8_SB(0, 1), b2 + hstepB, voffB); G8_STAGE(G8_SA(0, 0), a2, voffA);
            G8_WAIT_V(8); G8_WAIT_L(0); G8_BAR; G8_MMA(1, 0, At, B0); G8_MMA(1, 1, At, B1); G8_BAR; G8_SCHED;
            G8_LDB(B0, 1, 0); G8_LDB(B1, 1, 1); G8_SCHED; G8_LDA(At, 1, 0); G8_STAGE(G8_SA(0, 1), a2 + hstepA, voffA);
            G8_WAIT_V(8); G8_WAIT_L(0); G8_BAR; G8_MMA(0, 0, At, B0); G8_MMA(0, 1, At, B1); G8_BAR; G8_SCHED;
            G8_LDA(At, 1, 1); G8_STAGE(G8_SB(1, 0), b3, voffB); G8_STAGE(G8_SB(1, 1), b3 + hstepB, voffB); G8_STAGE(G8_SA(1, 0), a3, voffA);
            G8_WAIT_V(8); G8_WAIT_L(0); G8_BAR; G8_MMA(1, 0, At, B0); G8_MMA(1, 1, At, B1); G8_BAR; G8_SCHED;
            } else {
            G8_LDB(B0, 0, 0); G8_SCHED; G8_LDA(At, 0, 0); G8_STAGE(G8_SA(1, 1), a1 + hstepA, voffA);
            G8_WAIT_L(8); G8_BAR; G8_WAIT_L(0); G8_MMA(0, 0, At, B0); G8_BAR; G8_SCHED;
            G8_LDB(B1, 0, 1); G8_STAGE(G8_SB(0, 0), b2, voffB);
            G8_BAR; G8_WAIT_L(0); G8_MMA(0, 1, At, B1); G8_BAR;
            G8_LDA(At, 0, 1); G8_STAGE(G8_SA(0, 0), a2, voffA);
            G8_BAR; G8_WAIT_L(0); G8_MMA(1, 0, At, B0); G8_BAR; G8_SCHED;
            G8_STAGE(G8_SB(0, 1), b2 + hstepB, voffB);
            G8_WAIT_V(6); G8_BAR; G8_MMA(1, 1, At, B1); G8_BAR;
            G8_LDB(B0, 1, 0); G8_SCHED; G8_LDA(At, 1, 0); G8_STAGE(G8_SA(0, 1), a2 + hstepA, voffA);
            G8_WAIT_L(8); G8_BAR; G8_WAIT_L(0); G8_MMA(0, 0, At, B0); G8_BAR; G8_SCHED;
            G8_LDB(B1, 1, 1); G8_STAGE(G8_SB(1, 0), b3, voffB);
            G8_BAR; G8_WAIT_L(0); G8_MMA(0, 1, At, B1); G8_BAR;
            G8_LDA(At, 1, 1); G8_STAGE(G8_SA(1, 0), a3, voffA);
            G8_BAR; G8_WAIT_L(0); G8_MMA(1, 0, At, B0); G8_BAR; G8_SCHED;
            G8_STAGE(G8_SB(1, 1), b3 + hstepB, voffB);
            G8_WAIT_V(6); G8_BAR; G8_MMA(1, 1, At, B1); G8_BAR;
            }
        }
        if constexpr (ALIGN_EPI) { if (wr == 0) G8_BAR; }
        ph.epi(acc, cur, wr, wc, fr, fq);
        if (!has_next) break;
#pragma unroll
        for (int a = 0; a < 2; ++a)
#pragma unroll
            for (int b = 0; b < 2; ++b)
#pragma unroll
                for (int m = 0; m < 4; ++m)
#pragma unroll
                    for (int n = 0; n < 2; ++n) acc[a][b][m][n] = (f32x4){0.f, 0.f, 0.f, 0.f};
        cur = nxt; cA = nA; cB = nB; ++ui;
        if constexpr (ALIGN_EPI) { if (wr == 1) G8_BAR; }
    }
    G8_WAIT_V(0);
    if constexpr (!ALIGN_EPI) { if (wr == 0) G8_BAR; }
    G8_BAR;
#undef G8_SA
#undef G8_SB
#undef G8_STAGE
#undef G8_LDA
#undef G8_LDB
#undef G8_MMA
#undef G8_WAIT_V
#undef G8_WAIT_L
#undef G8_BAR
#undef G8_SCHED
}
}

struct TJob { const float* src; bf16_t* dst; const float* gain; int K, Nsrc, Ndst, map, nitems; };

DI int map_col(int map, int n0) {
    if (map == 1) return n0 + (n0 >= 6144 ? 16 : 0);
    if (map == 2) { const int t = n0 >> 8, r = n0 & 255; return (r < 128) ? 128 * t + r : DFF + 128 * t + (r - 128); }
    return n0;
}
constexpr int TR_SCR = 64 * 65 * 4;
static_assert(8 * TR_SCR <= LDS_MISC, "transpose scratch must stay below the barrier words");
DI void p0_transpose_item(const TJob& J, LAS float* scr, int item, int lane) {
    const int nblk = J.Ndst / 64, kb = item / nblk, nb = item % nblk, k0 = 64 * kb, n0 = 64 * nb, ns0 = map_col(J.map, n0);
    const float* src = J.src + (size_t)(k0 + (lane >> 4)) * J.Nsrc + ns0 + 4 * (lane & 15);
    f32x4 v[16];
#pragma unroll
    for (int i = 0; i < 16; ++i) v[i] = *(const f32x4*)(src + (size_t)(4 * i) * J.Nsrc);
    if (J.gain) {
#pragma unroll
        for (int i = 0; i < 16; ++i) v[i] *= J.gain[k0 + 4 * i + (lane >> 4)];
    }
#pragma unroll
    for (int i = 0; i < 16; ++i) { LAS float* d = scr + (4 * i + (lane >> 4)) * 65 + 4 * (lane & 15); d[0] = v[i].x; d[1] = v[i].y; d[2] = v[i].z; d[3] = v[i].w; }
    LDS_WAIT(); asm volatile("" ::: "memory");
    const int c = lane & 7;
#pragma unroll
    for (int j = 0; j < 8; ++j) { const int n = (lane >> 3) + 8 * j; const LAS float* s = scr + (8 * c) * 65 + n;
        u32x4 o; o.x = pk2(s[0 * 65], s[1 * 65]); o.y = pk2(s[2 * 65], s[3 * 65]); o.z = pk2(s[4 * 65], s[5 * 65]); o.w = pk2(s[6 * 65], s[7 * 65]);
        *(u32x4*)(J.dst + (size_t)(n0 + n) * J.K + k0 + 8 * c) = o; }
    LDS_WAIT(); asm volatile("" ::: "memory");
}
DI void p0_wps_item(const Params& p, bf16_t* WPS, int item, int lane) {
    const size_t e = (size_t)item * 512 + lane * 8; const float* src = p.w_pool + e;
    const f32x4 a = *(const f32x4*)src, b = *(const f32x4*)(src + 4);
    u32x4 o; o.x = pk2(a.x, a.y); o.y = pk2(a.z, a.w); o.z = pk2(b.x, b.y); o.w = pk2(b.z, b.w);
    *(u32x4*)(WPS + e) = o;
}
DI void p0_plb_item(const Params& p, bf16_t* PLB, int item, int lane) {
    const size_t e = (size_t)item * 512 + lane * 8; const size_t row = e / PLE;
    const float* src = (row < MP) ? p.p_prompt + e : p.p_sample + (e - (size_t)MP * PLE);
    const f32x4 a = *(const f32x4*)src, b = *(const f32x4*)(src + 4);
    u32x4 o; o.x = pk2(a.x, a.y); o.y = pk2(a.z, a.w); o.z = pk2(b.x, b.y); o.w = pk2(b.z, b.w);
    *(u32x4*)(PLB + e) = o;
}

DI void p0_xprep_unit(const Params& p, LAS unsigned char* lds, int u, int wave) {
    const int lane = lane_id(), tid = wave * 64 + lane;
    unsigned char* ws = p.ws;
    bf16_t* XB = (bf16_t*)(ws + WS_XB); float* RSTD1 = (float*)(ws + WS_RSTD1); float* BCUM = (float*)(ws + WS_BCUM); float* LAM = (float*)(ws + WS_LAM);
    LAS unsigned char* WG = lds; LAS float* GL = (LAS float*)(lds + 65536); LAS float* RS = (LAS float*)(lds + 69632);
    {   f32x4 w[16]; float gk[16];
#pragma unroll
        for (int i = 0; i < 16; ++i) { const int idx = tid + 512 * i, k = idx >> 2, n4 = idx & 3; w[i] = *(const f32x4*)(p.w_in + (size_t)k * INW + 6144 + 4 * n4); gk[i] = p.norm_mix[k]; }
#pragma unroll
        for (int i = 0; i < 16; ++i) { const int idx = tid + 512 * i, k = idx >> 2, n4 = idx & 3; LAS bf16_t* d = (LAS bf16_t*)(WG + (size_t)((k >> 3) * 16 + 4 * n4) * 16) + (k & 7);
            const unsigned a = pk2(w[i].x * gk[i], w[i].y * gk[i]), b = pk2(w[i].z * gk[i], w[i].w * gk[i]);
            d[0] = (bf16_t)(a & 0xffffu); d[8] = (bf16_t)(a >> 16); d[16] = (bf16_t)(b & 0xffffu); d[24] = (bf16_t)(b >> 16); }
    }
    __syncthreads();
    if (wave < 4) {
        const int fr = lane & 15, fq = lane >> 4; const int row = 64 * u + 16 * wave + fr;
        const float* xr = (row < MP) ? p.x_prompt + (size_t)row * D : p.x_sample + (size_t)(row - MP) * D;
        f32x4 acc = {0.f, 0.f, 0.f, 0.f}; float ss = 0.f;
#pragma unroll 1
        for (int s0 = 0; s0 < 64; s0 += 8) {
            f32x4 xa[8], xb[8];
#pragma unroll
            for (int i = 0; i < 8; ++i) { xa[i] = *(const f32x4*)(xr + 32 * (s0 + i) + 8 * fq); xb[i] = *(const f32x4*)(xr + 32 * (s0 + i) + 8 * fq + 4); }
#pragma unroll
            for (int i = 0; i < 8; ++i) { const int s = s0 + i; const f32x4 a = xa[i], b = xb[i];
                ss += (a.x * a.x + a.y * a.y) + (a.z * a.z + a.w * a.w) + (b.x * b.x + b.y * b.y) + (b.z * b.z + b.w * b.w);
                u32x4 o; o.x = pk2(a.x, a.y); o.y = pk2(a.z, a.w); o.z = pk2(b.x, b.y); o.w = pk2(b.z, b.w);
                *(u32x4*)(XB + (size_t)row * D + 32 * s + 8 * fq) = o;
                const bf16x8 af = __builtin_bit_cast(bf16x8, o);
                const bf16x8 bfr = *(const LAS bf16x8*)(WG + (size_t)((4 * s + fq) * 16 + fr) * 16);
                acc = __builtin_amdgcn_mfma_f32_16x16x32_bf16(af, bfr, acc, 0, 0, 0); }
        }
        ss += __shfl_xor(ss, 16); ss += __shfl_xor(ss, 32);
        const float rstd = 1.0f / sqrtf(ss * (1.0f / D) + EPS);
        if (fq == 0) { RS[16 * wave + fr] = rstd; RSTD1[row] = rstd; ((float*)(ws + WS_RS1))[row] = 0.f; }
        LDS_WAIT(); asm volatile("" ::: "memory");
#pragma unroll
        for (int j = 0; j < 4; ++j) { const int tl = 16 * wave + 4 * fq + j; GL[tl * 16 + fr] = acc[j] * RS[tl]; }
    }
    __syncthreads();
    const bool sample = (u >= MP / 64);
#pragma unroll 1
    for (int cc = 0; cc < 2; ++cc) {
        const int c = tid + 512 * cc; float wg[16];
#pragma unroll
        for (int j = 0; j < 16; ++j) wg[j] = p.w_gate_up[j * KW + c];
        const float bg = p.b_gate[c]; float cum = 0.f;
#pragma unroll 2
        for (int t = 0; t < 64; ++t) {
            const f32x4 g0 = *(const LAS f32x4*)(GL + t * 16), g1 = *(const LAS f32x4*)(GL + t * 16 + 4), g2 = *(const LAS f32x4*)(GL + t * 16 + 8), g3 = *(const LAS f32x4*)(GL + t * 16 + 12);
            float z = bg;
            z += g0.x * wg[0] + g0.y * wg[1] + g0.z * wg[2] + g0.w * wg[3];
            z += g1.x * wg[4] + g1.y * wg[5] + g1.z * wg[6] + g1.w * wg[7];
            z += g2.x * wg[8] + g2.y * wg[9] + g2.z * wg[10] + g2.w * wg[11];
            z += g3.x * wg[12] + g3.y * wg[13] + g3.z * wg[14] + g3.w * wg[15];
            const float gl = logsigmoidf_(z) * (1.0f / 16.0f);
            const int row = 64 * u + t;
            if (sample) { BCUM[(size_t)row * KW + c] = 0.f; LAM[(size_t)(NCHK + row - MP) * KW + c] = __expf(gl); }
            else { cum = ((t & (CH - 1)) == 0) ? gl : cum + gl; BCUM[(size_t)row * KW + c] = cum; if ((t & (CH - 1)) == CH - 1) LAM[(size_t)(row / CH) * KW + c] = __expf(cum); }
        }
    }
    __syncthreads();
}

constexpr int NXPREP = M / 64;
DI void phase_p0(const Params& p, LAS unsigned char* lds, int wave) {
    const int lane = lane_id();
    unsigned char* ws = p.ws;
#ifndef P0_REP
#define P0_REP 0
#endif
    const int G = gridDim.x, c = blockIdx.x; const bool has_unit = c < NXPREP;
    const int nx = (G < NXPREP) ? G : NXPREP, W_OTHER = 3;
    const int nslots_total = nx * NWAVES + (G - nx) * NWAVES * W_OTHER;
    const int my_n = has_unit ? 1 : W_OTHER;
    const int my_first = has_unit ? c * NWAVES + wave : nx * NWAVES + ((c - nx) * NWAVES + wave) * W_OTHER;
    if (has_unit) { for (int u = c; u < NXPREP; u += G) p0_xprep_unit(p, lds, u, wave); if (P0_REP & 1) p0_xprep_unit(p, lds, c, wave); }
    TJob J[8];
    J[0] = TJob{p.w_in, (bf16_t*)(ws + WS_WIN), p.norm_mix, D, INW, NIN, 1, (D / 64) * (NIN / 64)};
    J[1] = TJob{p.w_up, (bf16_t*)(ws + WS_WUP), p.norm_ffn, D, NUP, NUP, 2, (D / 64) * (NUP / 64)};
    J[2] = TJob{p.w_down, (bf16_t*)(ws + WS_WD), nullptr, DFF, D, D, 0, (DFF / 64) * (D / 64)};
    J[3] = TJob{p.w_branch_a, (bf16_t*)(ws + WS_WA), p.gla_norm, D, D, D, 0, (D / 64) * (D / 64)};
    J[4] = TJob{p.w_out, (bf16_t*)(ws + WS_WO), nullptr, D, D, D, 0, (D / 64) * (D / 64)};
    J[5] = TJob{p.w_ple_gate, (bf16_t*)(ws + WS_WPG), p.norm_ple, D, D, D, 0, (D / 64) * (D / 64)};
    J[6] = TJob{p.w_ple, (bf16_t*)(ws + WS_WPLE), nullptr, PLE, D, D, 0, (PLE / 64) * (D / 64)};
    J[7] = TJob{p.w_branch_b, (bf16_t*)(ws + WS_WBT), p.pool_scale, POOLW, D, D, 0, (POOLW / 64) * (D / 64)};
    LAS float* scr = (LAS float*)(lds + wave * TR_SCR);
    for (int rep = 0; rep < ((P0_REP & 2) ? 2 : 1); ++rep) {
    int base = 0;
#pragma unroll
    for (int j = 0; j < 8; ++j) {
        const int n = J[j].nitems;
        for (int k = 0; k < my_n; ++k) {
            int it = (my_first + k) - (base % nslots_total); if (it < 0) it += nslots_total;
            for (; it < n; it += nslots_total) p0_transpose_item(J[j], scr, it, lane);
        }
        base += n;
    }
    }
    for (int k = 0; k < my_n; ++k) {
        for (int it = my_first + k; it < (POOLW * 256) / 512; it += nslots_total) p0_wps_item(p, (bf16_t*)(ws + WS_WPS), it, lane);
        for (int it = my_first + k; it < (M * PLE) / 512; it += nslots_total) p0_plb_item(p, (bf16_t*)(ws + WS_PLB), it, lane);
    }
}

#define MFMA32(a, b, c) __builtin_amdgcn_mfma_f32_32x32x16_bf16((a), (b), (c), 0, 0, 0)
typedef LAS s16x4* lds_s16x4_p;
DI s16x4 tr_read(LAS unsigned char* a) { return __builtin_amdgcn_ds_read_tr16_b64_v4i16((lds_s16x4_p)a); }
DI bf16x8 cat8(s16x4 lo, s16x4 hi) { return __builtin_shufflevector(lo, hi, 0, 1, 2, 3, 4, 5, 6, 7); }
DI bf16x8 ld_perm(const bf16_t* p) {
    const u32x2 a = *(const u32x2*)p, b = *(const u32x2*)(p + 8);
    u32x4 r; r.x = a.x; r.y = a.y; r.z = b.x; r.w = b.y; return __builtin_bit_cast(bf16x8, r);
}
template <int S> DI bf16x8 pack_step(const f32x16& x) {
    u32x4 r; r.x = pk2(x[8 * S + 0], x[8 * S + 1]); r.y = pk2(x[8 * S + 2], x[8 * S + 3]); r.z = pk2(x[8 * S + 4], x[8 * S + 5]); r.w = pk2(x[8 * S + 6], x[8 * S + 7]);
    return __builtin_bit_cast(bf16x8, r);
}
DI f32x16 zero16() { f32x16 z;
#pragma unroll
    for (int i = 0; i < 16; ++i) z[i] = 0.f; return z; }

constexpr int SC_BUF = 50176, SC_QI = 0, SC_KI = 16384, SC_VI = 32768, SC_LMI = 49152, SC_ATT = 3 * SC_BUF, SC_BYTES = SC_ATT + 2048;
static_assert(SC_BYTES <= LDS_MISC, "scan LDS map");
DI void dma16(const void* g, LAS unsigned char* l) { __builtin_amdgcn_global_load_lds((const unsigned*)g, (LAS unsigned*)l, 16, 0, 0); }
DI bf16x8 lds_perm(LAS unsigned char* a) {
    const u32x2 x = *(const LAS u32x2*)a, y = *(const LAS u32x2*)(a + 512);
    u32x4 r; r.x = x.x; r.y = x.y; r.z = y.x; r.w = y.y; return __builtin_bit_cast(bf16x8, r);
}
#define SC_BAR() do { asm volatile("s_waitcnt lgkmcnt(0)" ::: "memory"); __builtin_amdgcn_s_barrier(); asm volatile("" ::: "memory"); } while (0)
DI void scan_block(const Params& p, LAS unsigned char* lds, int task, int wave) {
    unsigned char* ws = p.ws;
    const bf16_t* QB = (const bf16_t*)(ws + WS_QB); const bf16_t* KB = (const bf16_t*)(ws + WS_KB);
    const bf16_t* V = (const bf16_t*)(ws + WS_V); bf16_t* OG = (bf16_t*)(ws + WS_OG);
    const float* LAM = (const float*)(ws + WS_LAM); float* OSS = (float*)(ws + WS_OSS);
    const int half = task & 1, hd = (task >> 1) & 3, b = task >> 3, sl = 8 * half + wave;
    f32x16 S[8];
#pragma unroll
    for (int db = 0; db < 8; ++db) S[db] = zero16();

#define SC_ISSUE(ch_, slot_) do { const int _l = lane_id(); const size_t _r0 = (size_t)(b * SEQ + CH * (ch_)); LAS unsigned char* _lb = lds + (slot_) * SC_BUF; asm volatile("" : "+s"(_lb)); \
        _Pragma("unroll") for (int _k = 0; _k < 2; ++_k) { const int _i = 2 * wave + _k; \
            const int _row = _l & 31, _cc = 2 * _i + (_l >> 5); \
            dma16(QB + (_r0 + _row) * KW + hd * 256 + 8 * _cc, _lb + SC_QI + _i * 1024); \
            const int _s = 2 * _i + (_l >> 5), _c2 = (_l & 31) ^ (4 * (_s & 3)); \
            dma16(KB + (_r0 + _s) * KW + hd * 256 + 8 * _c2, _lb + SC_KI + _i * 1024); dma16(V + (_r0 + _s) * VW + hd * 512 + 256 * half + 8 * _c2, _lb + SC_VI + _i * 1024); } \
        if (wave == 0) dma16(LAM + (size_t)(b * (SEQ / CH) + (ch_)) * KW + hd * 256 + 4 * _l, _lb + SC_LMI); } while (0)
    constexpr int NCH = SEQ / CH;
    SC_ISSUE(0, 0); SC_ISSUE(1, 1);
    int slot = 0;
#pragma unroll 1
    for (int ch = 0; ch < NCH; ++ch) {
        const int row0 = b * SEQ + CH * ch;
        if (ch == 0) { if (wave == 0) asm volatile("s_waitcnt vmcnt(7)" ::: "memory"); else asm volatile("s_waitcnt vmcnt(6)" ::: "memory"); }
        else if (ch == 1) { if (wave == 0) asm volatile("s_waitcnt vmcnt(11)" ::: "memory"); else asm volatile("s_waitcnt vmcnt(10)" ::: "memory"); }
        else if (ch + 1 < NCH) { if (wave == 0) asm volatile("s_waitcnt vmcnt(15)" ::: "memory"); else asm volatile("s_waitcnt vmcnt(14)" ::: "memory"); }
        else VM_WAIT();
        SC_BAR();
        { const int s2 = (slot == 0) ? 2 : slot - 1; if (ch + 2 < NCH) SC_ISSUE(ch + 2, s2); }
        const int lane = lane_id();
        const int c = lane & 31, h = lane >> 5;
        const int i16 = lane & 15, q = i16 >> 2, pp = i16 & 3, jb = (lane >> 4) & 1;
        LAS unsigned char* buf = lds + slot * SC_BUF;
        LAS unsigned char* ATT = lds + SC_ATT;

        if (wave < 4) {
            const int si = wave >> 1, ti = wave & 1, fr = lane & 15, fq = lane >> 4;
            f32x4 a = {0.f, 0.f, 0.f, 0.f};
            LAS unsigned char* kp = buf + SC_KI + (16 * si + fr) * 512; LAS unsigned char* qp = buf + SC_QI + fq * 512 + (16 * ti + fr) * 16;
            const int kx = 4 * (fr & 3);
#pragma unroll
            for (int ks = 0; ks < 8; ++ks) a = __builtin_amdgcn_mfma_f32_16x16x32_bf16(*(const LAS bf16x8*)(kp + (((4 * ks + fq) ^ kx) * 16)), *(const LAS bf16x8*)(qp + 2048 * ks), a, 0, 0, 0);
            const int s0 = 16 * si + 4 * fq, t = 16 * ti + fr;
            u32x2 w; w.x = pk2(s0 + 0 <= t ? a[0] : 0.f, s0 + 1 <= t ? a[1] : 0.f); w.y = pk2(s0 + 2 <= t ? a[2] : 0.f, s0 + 3 <= t ? a[3] : 0.f);
            *(LAS u32x2*)(ATT + t * 64 + s0 * 2) = w;
        }
        SC_BAR();

        f32x16 o = zero16();
        LAS unsigned char* vb = buf + SC_VI + (8 * h + q) * 512 + (4 * (wave ^ q) + 2 * jb + (pp >> 1)) * 16 + (pp & 1) * 8;
        const bf16x8 vf0 = cat8(tr_read(vb), tr_read(vb + 4 * 512)), vf1 = cat8(tr_read(vb + 16 * 512), tr_read(vb + 20 * 512));
        {
            LAS unsigned char* ab = ATT + c * 64 + 16 * h;
            o = MFMA32(vf0, *(const LAS bf16x8*)ab, o);
            o = MFMA32(vf1, *(const LAS bf16x8*)(ab + 32), o);
            LAS unsigned char* qa = buf + SC_QI + c * 16 + 8 * h;
#pragma unroll
            for (int db = 0; db < 8; ++db) {
                { const bf16x8 qf = lds_perm(qa + 2048 * db); o = MFMA32(pack_step<0>(S[db]), qf, o); }
                { const bf16x8 qf = lds_perm(qa + 2048 * db + 1024); o = MFMA32(pack_step<1>(S[db]), qf, o); }
                if ((db & 3) == 3) __builtin_amdgcn_sched_barrier(0);
            }
            const int t = row0 + c;
            float ss = 0.f;
#pragma unroll
            for (int r = 0; r < 16; ++r) ss += o[r] * o[r];
            { const auto sw = __builtin_amdgcn_permlane32_swap(__float_as_uint(ss), __float_as_uint(ss), false, false); ss = __uint_as_float(sw[0]) + __uint_as_float(sw[1]); }
            if (h == 0) OSS[(size_t)t * 64 + hd * 16 + sl] = ss;
            bf16_t* og = OG + (size_t)row0 * VW + hd * 512 + 32 * sl + c * VW + 4 * h;
#pragma unroll
            for (int g = 0; g < 4; ++g) { u32x2 w; w.x = pk2(o[4 * g + 0], o[4 * g + 1]); w.y = pk2(o[4 * g + 2], o[4 * g + 3]); *(u32x2*)(og + 8 * g) = w; }
        }
        __builtin_amdgcn_sched_barrier(0);

        {
            LAS unsigned char* kbase = buf + SC_KI + (8 * h + q) * 512 + (2 * jb + (pp >> 1)) * 16 + (pp & 1) * 8;
            LAS unsigned char* lm = buf + SC_LMI + 16 * h;
#pragma unroll
            for (int db = 0; db < 8; ++db) {
                LAS unsigned char* kb = kbase + (((db & 3) ^ q) * 4) * 16 + (db >> 2) * 256;
                S[db] = MFMA32(cat8(tr_read(kb), tr_read(kb + 4 * 512)), vf0, S[db]);
                S[db] = MFMA32(cat8(tr_read(kb + 16 * 512), tr_read(kb + 20 * 512)), vf1, S[db]);
#pragma unroll
                for (int g = 0; g < 4; ++g) { const f32x4 l4 = *(const LAS f32x4*)(lm + (32 * db + 8 * g) * 4);
                    S[db][4 * g + 0] *= l4.x; S[db][4 * g + 1] *= l4.y; S[db][4 * g + 2] *= l4.z; S[db][4 * g + 3] *= l4.w; }
                if (db & 1) __builtin_amdgcn_sched_barrier(0);
            }
        }
        asm volatile("" ::: "memory");
        slot = (slot == 2) ? 0 : slot + 1;
    }
#undef SC_ISSUE
    {   const int lane = lane_id();
        const unsigned voff = (unsigned)(((lane >> 5) * 4 * DV + (lane & 31)) * 4);
        const char* gbase = (const char*)(p.out + O_GLAP + ((size_t)(b * NH + hd) * DK) * DV + 32 * sl);
#pragma unroll
        for (int db = 0; db < 8; ++db) {
#pragma unroll
            for (int r = 0; r < 16; ++r) { const int dl = 32 * db + (r & 3) + 8 * (r >> 2); *(float*)(const_cast<char*>(gbase) + (size_t)dl * DV * 4 + voff) = S[db][r]; }
        }
    }
    __syncthreads();
}

DI void sgla_task(const Params& p, int task, int lane) {
    unsigned char* ws = p.ws;
    const bf16_t* QB = (const bf16_t*)(ws + WS_QB); const bf16_t* KB = (const bf16_t*)(ws + WS_KB); const bf16_t* V = (const bf16_t*)(ws + WS_V);
    const float* LAM = (const float*)(ws + WS_LAM); float* OSP = (float*)(ws + WS_OSP);
    const int dblk = task & 7, hd = (task >> 3) & 3, b = task >> 5; const int row = MP + b;
    const size_t sbase = ((size_t)(b * NH + hd) * DK + 32 * dblk) * DV;
    const float* S0 = p.state_gla + sbase; float* So = p.out + O_GLAS + sbase;
    const int dl = lane & 31;
    const float lam_l = LAM[(size_t)(NCHK + b) * KW + hd * 256 + 32 * dblk + dl];
    const float k_l = bf1(KB[(size_t)row * KW + hd * 256 + 32 * dblk + dl]);
    const float q_l = bf1(QB[(size_t)row * KW + hd * 256 + 32 * dblk + dl]);
    f32x4 va, vb;
    { const u32x2 w = *(const u32x2*)(V + (size_t)row * VW + hd * 512 + 4 * lane); va = (f32x4){bflo(w.x), bfhi(w.x), bflo(w.y), bfhi(w.y)}; }
    { const u32x2 w = *(const u32x2*)(V + (size_t)row * VW + hd * 512 + 256 + 4 * lane); vb = (f32x4){bflo(w.x), bfhi(w.x), bflo(w.y), bfhi(w.y)}; }
    f32x4 oa = {0.f, 0.f, 0.f, 0.f}, ob = {0.f, 0.f, 0.f, 0.f};
#pragma unroll 1
    for (int d0 = 0; d0 < 32; d0 += 16) {
        f32x4 ra[16], rb[16];
#pragma unroll
        for (int i = 0; i < 16; ++i) { ra[i] = __builtin_nontemporal_load((const f32x4*)(S0 + (size_t)(d0 + i) * DV + 4 * lane)); rb[i] = __builtin_nontemporal_load((const f32x4*)(S0 + (size_t)(d0 + i) * DV + 256 + 4 * lane)); }
#pragma unroll
        for (int i = 0; i < 16; ++i) { const int d = d0 + i;
            const float lam = __uint_as_float(__builtin_amdgcn_readlane(__float_as_uint(lam_l), d)), kk = __uint_as_float(__builtin_amdgcn_readlane(__float_as_uint(k_l), d)), qq = __uint_as_float(__builtin_amdgcn_readlane(__float_as_uint(q_l), d));
            const f32x4 sa = ra[i] * lam + va * kk, sb = rb[i] * lam + vb * kk;
            __builtin_nontemporal_store(sa, (f32x4*)(So + (size_t)d * DV + 4 * lane)); __builtin_nontemporal_store(sb, (f32x4*)(So + (size_t)d * DV + 256 + 4 * lane));
            oa += sa * qq; ob += sb * qq; }
    }
    float* op = OSP + ((size_t)(b * NH + hd) * 8 + dblk) * DV;
    *(f32x4*)(op + 4 * lane) = oa; *(f32x4*)(op + 256 + 4 * lane) = ob;
}

DI void pmix_task(const Params& p, int t, int lane) {
    unsigned char* ws = p.ws;
    const float* U = (const float*)(ws + WS_U); bf16_t* PM = (bf16_t*)(ws + WS_PM);
    if (t < MP) {
        const int b = t >> 11, pos = t & 2047;
#pragma unroll
        for (int i = 0; i < 4; ++i) {
            const int w = 2 << i, c = 256 * i + 4 * lane; const int cnt = (pos + 1 < w) ? pos + 1 : w;
            const f32x4 u0 = *(const f32x4*)(U + (size_t)t * POOLW + c); f32x4 s = u0;
#pragma unroll
            for (int j = 1; j < w; ++j) {
                const bool in = j < cnt; const f32x4 v = *(const f32x4*)(U + (size_t)(in ? t - j : t) * POOLW + c); const float m = in ? 1.f : 0.f; s += v * m; }
            const float inv = 1.0f / (float)cnt; const f32x4 mx = s * inv - u0;
            u32x2 o; o.x = pk2(mx.x, mx.y); o.y = pk2(mx.z, mx.w); *(u32x2*)(PM + (size_t)t * POOLW + c) = o;
            if (pos >= SEQ - 15) *(f32x4*)(p.out + O_POOLP + ((size_t)b * 15 + (pos - (SEQ - 15))) * POOLW + c) = u0;
        }
    } else {
        const int b = t - MP; const float* sp = p.state_pool + (size_t)b * 15 * POOLW; float* po = p.out + O_POOLS + (size_t)b * 15 * POOLW;
#pragma unroll
        for (int i = 0; i < 4; ++i) {
            const int w = 2 << i, c = 256 * i + 4 * lane;
            const f32x4 u0 = *(const f32x4*)(U + (size_t)t * POOLW + c); f32x4 s = u0;
#pragma unroll
            for (int j = 1; j < w; ++j) s += *(const f32x4*)(sp + (size_t)(15 - j) * POOLW + c);
            const float inv = 1.0f / (float)w; const f32x4 mx = s * inv - u0;
            u32x2 o; o.x = pk2(mx.x, mx.y); o.y = pk2(mx.z, mx.w); *(u32x2*)(PM + (size_t)t * POOLW + c) = o;
            *(f32x4*)(po + (size_t)14 * POOLW + c) = u0;
        }
    }
}

DI void pool_copy_task(const Params& p, int item, int lane) {
    const int b = item / 14, r = item - 14 * b; const float* src = p.state_pool + ((size_t)b * 15 + r + 1) * POOLW + 4 * lane; float* dst = p.out + O_POOLS + ((size_t)b * 15 + r) * POOLW + 4 * lane;
    const f32x4 v0 = *(const f32x4*)src, v1 = *(const f32x4*)(src + 256), v2 = *(const f32x4*)(src + 512), v3 = *(const f32x4*)(src + 768);
    *(f32x4*)dst = v0; *(f32x4*)(dst + 256) = v1; *(f32x4*)(dst + 512) = v2; *(f32x4*)(dst + 768) = v3;
}
#ifndef P2_REP
#define P2_REP 0
#endif
DI void scan_role(const Params& p, LAS unsigned char* lds, int wave, int idx, int n) {
    for (int rep = 0; rep < ((P2_REP & 1) ? 2 : 1); ++rep) for (int task = (n == 32) ? (idx % 8) * 4 + idx / 8 : idx; task < 2 * NB * NH; task += n) scan_block(p, lds, task, wave);
}
DI void stream_role(const Params& p, int wave, int idx, int n) {
    const int lane = lane_id(); const int gw = idx * NWAVES + wave, NGW = n * NWAVES;
    for (int rep = 0; rep < ((P2_REP & 2) ? 2 : 1); ++rep) {
        for (int it = gw; it < MS * 14; it += NGW) pool_copy_task(p, it, lane);
        for (int task = gw; task < MS * NH * 8; task += NGW) sgla_task(p, task, lane); }
}

DI void ogn_task(const Params& p, int t, int lane) {
    unsigned char* ws = p.ws;
    bf16_t* OG = (bf16_t*)(ws + WS_OG); const float* OSS = (const float*)(ws + WS_OSS); const float* OSP = (const float*)(ws + WS_OSP); const bf16_t* SR = (const bf16_t*)(ws + WS_SR);
    if (t < MP) {
#pragma unroll
        for (int hd = 0; hd < 4; ++hd) {
            const float* sp = OSS + (size_t)t * 64 + hd * 16; const f32x4 a = *(const f32x4*)sp, b = *(const f32x4*)(sp + 4), c = *(const f32x4*)(sp + 8), d = *(const f32x4*)(sp + 12);
            const float ss = ((a.x + a.y) + (a.z + a.w)) + ((b.x + b.y) + (b.z + b.w)) + ((c.x + c.y) + (c.z + c.w)) + ((d.x + d.y) + (d.z + d.w));
            const float rstd = 1.0f / sqrtf(ss * (1.0f / DV) + EPS);
            bf16_t* op = OG + (size_t)t * VW + hd * 512 + 8 * lane; const u32x4 w = *(const u32x4*)op; const u32x4 g = *(const u32x4*)(SR + (size_t)t * VW + hd * 512 + 8 * lane);
            u32x4 o; o.x = pk2(bflo(w.x) * rstd * bflo(g.x), bfhi(w.x) * rstd * bfhi(g.x)); o.y = pk2(bflo(w.y) * rstd * bflo(g.y), bfhi(w.y) * rstd * bfhi(g.y));
            o.z = pk2(bflo(w.z) * rstd * bflo(g.z), bfhi(w.z) * rstd * bfhi(g.z)); o.w = pk2(bflo(w.w) * rstd * bflo(g.w), bfhi(w.w) * rstd * bfhi(g.w));
            *(u32x4*)op = o;
        }
    } else {
        const int b = t - MP;
#pragma unroll
        for (int hd = 0; hd < 4; ++hd) {
            f32x4 oa = {0.f, 0.f, 0.f, 0.f}, ob = {0.f, 0.f, 0.f, 0.f};
#pragma unroll
            for (int k = 0; k < 8; ++k) { const float* op = OSP + ((size_t)(b * NH + hd) * 8 + k) * DV + 8 * lane; oa += *(const f32x4*)op; ob += *(const f32x4*)(op + 4); }
            float ss = (oa.x * oa.x + oa.y * oa.y) + (oa.z * oa.z + oa.w * oa.w) + (ob.x * ob.x + ob.y * ob.y) + (ob.z * ob.z + ob.w * ob.w);
            ss = wave_sum(ss);
            const float rstd = 1.0f / sqrtf(ss * (1.0f / DV) + EPS);
            const u32x4 w = *(const u32x4*)(SR + (size_t)t * VW + hd * 512 + 8 * lane);
            u32x4 o; o.x = pk2(oa.x * rstd * bflo(w.x), oa.y * rstd * bfhi(w.x)); o.y = pk2(oa.z * rstd * bflo(w.y), oa.w * rstd * bfhi(w.y));
            o.z = pk2(ob.x * rstd * bflo(w.z), ob.y * rstd * bfhi(w.z)); o.w = pk2(ob.z * rstd * bflo(w.w), ob.w * rstd * bfhi(w.w));
            *(u32x4*)(OG + (size_t)t * VW + hd * 512 + 8 * lane) = o;
        }
    }
}
DI void phase_p3(const Params& p, int wave) {
    const int lane = lane_id();
    const int gw = (int)blockIdx.x * NWAVES + wave, NGW = gridDim.x * NWAVES;
    for (int t = gw; t < M; t += NGW) pmix_task(p, t, lane);
    for (int t = gw; t < M; t += NGW) ogn_task(p, t, lane);
}

DI float row_rstd(const float* SS, const float* SSs, int row, int lane) {
    float v = (row < MP) ? ((lane < 32) ? SS[(size_t)row * 32 + lane] : 0.f) : (SSs[(size_t)(row - MP) * 128 + lane] + SSs[(size_t)(row - MP) * 128 + 64 + lane]);
    v = wave_sum(v);
    return 1.0f / sqrtf(v * (1.0f / D) + EPS);
}

struct F8 { f32x4 a, b; };
DI F8 unpack8(u32x4 w, float s) { F8 r; r.a = (f32x4){bflo(w.x) * s, bfhi(w.x) * s, bflo(w.y) * s, bfhi(w.y) * s}; r.b = (f32x4){bflo(w.z) * s, bfhi(w.z) * s, bflo(w.w) * s, bfhi(w.w) * s}; return r; }
DI F8 ld8(const float* q) { F8 r; r.a = *(const f32x4*)q; r.b = *(const f32x4*)(q + 4); return r; }
DI void st8(float* q, const F8& v) { *(f32x4*)q = v.a; *(f32x4*)(q + 4) = v.b; }
DI f32x4 silu4(f32x4 x) { return (f32x4){siluf_(x.x), siluf_(x.y), siluf_(x.z), siluf_(x.w)}; }
DI void conv_fixup_tile(const Params& p, int pm, int wave) {
    if ((pm & 7) == 0) return;
    unsigned char* ws = p.ws; const int tid = wave * 64 + lane_id();
    const float* HALO = (const float*)(ws + WS_HALO) + (size_t)(pm - 1) * 2 * DFF; const float* FG = (const float*)(ws + WS_FIXG) + (size_t)pm * 2 * DFF; const float* FU = (const float*)(ws + WS_FIXU) + (size_t)pm * 2 * DFF;
    bf16_t* ACT = (bf16_t*)(ws + WS_ACT) + (size_t)pm * 256 * DFF;
    for (int v = tid; v < DFF / 8; v += NTHREADS) { const int ch0 = 8 * v;
        const F8 w0 = ld8(p.conv_w + ch0), w1 = ld8(p.conv_w + DFF + ch0), w2 = ld8(p.conv_w + 2 * DFF + ch0), cb = ld8(p.conv_b + ch0);
        const F8 h14 = ld8(HALO + ch0), h15 = ld8(HALO + DFF + ch0), g0 = ld8(FG + ch0), g1 = ld8(FG + DFF + ch0), u0 = ld8(FU + ch0), u1 = ld8(FU + DFF + ch0);
        const f32x4 a0 = silu4(cb.a + w0.a * h14.a + w1.a * h15.a + w2.a * g0.a) * u0.a, b0 = silu4(cb.b + w0.b * h14.b + w1.b * h15.b + w2.b * g0.b) * u0.b;
        const f32x4 a1 = silu4(cb.a + w0.a * h15.a + w1.a * g0.a + w2.a * g1.a) * u1.a, b1 = silu4(cb.b + w0.b * h15.b + w1.b * g0.b + w2.b * g1.b) * u1.b;
        *(u32x4*)(ACT + ch0) = pk8(a0, b0); *(u32x4*)(ACT + DFF + ch0) = pk8(a1, b1); }
}

DI void phase_final(const Params& p, int wave) {
    const int lane = lane_id();
    const int gw = (int)blockIdx.x * NWAVES + wave, NGW = gridDim.x * NWAVES;
    const bf16_t* H3 = (const bf16_t*)(p.ws + WS_H3); const float* SS3 = (const float*)(p.ws + WS_SS3); const float* SS3S = (const float*)(p.ws + WS_SS3S);
    for (int t = gw; t < M; t += NGW) {
        const float rs = row_rstd(SS3, SS3S, t, lane);
        float* yo = (t < MP) ? p.out + O_YP + (size_t)t * D : p.out + O_YS + (size_t)(t - MP) * D;
#pragma unroll
        for (int i = 0; i < 4; ++i) { const int c = 512 * i + 8 * lane; const u32x4 w = *(const u32x4*)(H3 + (size_t)t * D + c); const f32x4 g0 = *(const f32x4*)(p.norm_final + c), g1 = *(const f32x4*)(p.norm_final + c + 4);
            *(f32x4*)(yo + c) = bf4lo(w) * rs * g0; *(f32x4*)(yo + c + 4) = bf4hi(w) * rs * g1; }
    }
}

#define EPI_ARGS const f32x4 (&acc)[2][2][4][2], const g8::Unit& u, int wr, int wc, int fr, int fq
#define EPI_ROWS(ROWVAR) _Pragma("unroll") for (int ai = 0; ai < 2; ++ai) _Pragma("unroll") for (int m = 0; m < 4; ++m) { const int ROWVAR = u.pm * 256 + ai * 128 + wr * 64 + m * 16 + fr; if (ROWVAR < M) {
#define EPI_COLS(COLVAR) _Pragma("unroll") for (int bj = 0; bj < 2; ++bj) { const int COLVAR = bj * 128 + wc * 32 + 8 * fq; const f32x4 v0 = acc[ai][bj][m][0], v1 = acc[ai][bj][m][1];
#define EPI_END } } }
DI f32x4 exp4(f32x4 x) { return (f32x4){__expf(x.x), __expf(x.y), __expf(x.z), __expf(x.w)}; }
DI f32x4 sig4(f32x4 x) { return (f32x4){sigmoidf_(x.x), sigmoidf_(x.y), sigmoidf_(x.z), sigmoidf_(x.w)}; }
DI float sum4(f32x4 a) { return (a.x + a.y) + (a.z + a.w); }

struct PhaseIn {
    static constexpr int LDA = D, LDB = D, KT = D / 64;
    const Params& p; int G, c, part;
    int c0;
    DI bool next(int i, g8::Unit& u) const { int pm, pn;
        if (part == 0) { if (!g8::grid_order(NTM - 1, 16, G, c, i, pm, pn)) return false; }
        else { if (c < c0 || !g8::grid_order(NTM, 28, G - c0, c - c0, i, pm, pn)) return false; pn += 16; }
        u.pm = pm; u.pn = pn; u.A = (const char*)(p.ws + WS_XB) + (size_t)pm * 256 * D * 2; u.B = (const char*)(p.ws + WS_WIN) + (size_t)pn * 256 * D * 2; return true; }
    DI void epi(EPI_ARGS) const {
        unsigned char* ws = p.ws; const float* RSTD1 = (const float*)(ws + WS_RSTD1); const float* BCUM = (const float*)(ws + WS_BCUM);
        const int pn = u.pn;
        if (pn < 4) {
            bf16_t* QB = (bf16_t*)(ws + WS_QB);
            EPI_ROWS(row) const float rs = RSTD1[row] * 0.0625f; EPI_COLS(col) const size_t o = (size_t)row * KW + pn * 256 + col;
                const f32x4 e0 = exp4(*(const f32x4*)(BCUM + o)), e1 = exp4(*(const f32x4*)(BCUM + o + 4));
                *(u32x4*)(QB + o) = pk8(v0 * rs * e0, v1 * rs * e1); EPI_END
        } else if (pn < 8) {
            bf16_t* KB = (bf16_t*)(ws + WS_KB);
            EPI_ROWS(row) const float rs = RSTD1[row]; EPI_COLS(col) const size_t o = (size_t)row * KW + (pn - 4) * 256 + col;
                const f32x4 b0 = *(const f32x4*)(BCUM + o), b1 = *(const f32x4*)(BCUM + o + 4);
                *(u32x4*)(KB + o) = pk8(v0 * rs * exp4(-b0), v1 * rs * exp4(-b1)); EPI_END
        } else if (pn < 16) {
            bf16_t* V = (bf16_t*)(ws + WS_V);
            EPI_ROWS(row) const float rs = RSTD1[row]; EPI_COLS(col) *(u32x4*)(V + (size_t)row * VW + (pn - 8) * 256 + col) = pk8(v0 * rs, v1 * rs); EPI_END
        } else if (pn < 24) {
            bf16_t* SR = (bf16_t*)(ws + WS_SR);
            EPI_ROWS(row) const float rs = RSTD1[row]; EPI_COLS(col) const f32x4 a = v0 * rs, b = v1 * rs; *(u32x4*)(SR + (size_t)row * VW + (pn - 16) * 256 + col) = pk8(a * sig4(a), b * sig4(b)); EPI_END
        } else if (pn < 28) {
            float* U = (float*)(ws + WS_U);
            EPI_ROWS(row) const float rs = RSTD1[row]; EPI_COLS(col) float* o = U + (size_t)row * POOLW + (pn - 24) * 256 + col; *(f32x4*)o = v0 * rs; *(f32x4*)(o + 4) = v1 * rs; EPI_END
        } else {
            bf16_t* Gt = (bf16_t*)(ws + (pn < 36 ? WS_GA : WS_GB)); const int c0 = (pn < 36 ? pn - 28 : pn - 36) * 256;
            EPI_ROWS(row) const float rs = RSTD1[row]; EPI_COLS(col) *(u32x4*)(Gt + (size_t)row * D + c0 + col) = pk8(sig4(v0 * rs), sig4(v1 * rs)); EPI_END
        }
    }
};

template <int LDA_, int LDB_, int K_> struct PhaseN2048 {
    static constexpr int LDA = LDA_, LDB = LDB_, KT = K_ / 64;
    const Params& p; int G, c; size_t a_off, b_off;
    DI bool next_(int i, g8::Unit& u) const { int pm, pn; if (!g8::grid_order(NTM - 1, 8, G, c, i, pm, pn)) return false;
        u.pm = pm; u.pn = pn; u.A = (const char*)(p.ws + a_off) + (size_t)pm * 256 * LDA * 2; u.B = (const char*)(p.ws + b_off) + (size_t)pn * 256 * LDB * 2; return true; }
};
struct PhaseYb : PhaseN2048<POOLW, POOLW, POOLW> {
    DI bool next(int i, g8::Unit& u) const { return next_(i, u); }
    DI void epi(EPI_ARGS) const { const bf16_t* GB = (const bf16_t*)(p.ws + WS_GB); bf16_t* Y = (bf16_t*)(p.ws + WS_YBG);
#pragma unroll
        for (int ai = 0; ai < 2; ++ai) { u32x4 g[4][2];
#pragma unroll
            for (int m = 0; m < 4; ++m)
#pragma unroll
                for (int bj = 0; bj < 2; ++bj) g[m][bj] = *(const u32x4*)(GB + (size_t)(u.pm * 256 + ai * 128 + wr * 64 + m * 16 + fr) * D + u.pn * 256 + bj * 128 + wc * 32 + 8 * fq);
#pragma unroll
            for (int m = 0; m < 4; ++m)
#pragma unroll
                for (int bj = 0; bj < 2; ++bj) { const size_t o = (size_t)(u.pm * 256 + ai * 128 + wr * 64 + m * 16 + fr) * D + u.pn * 256 + bj * 128 + wc * 32 + 8 * fq;
                    *(u32x4*)(Y + o) = pk8(acc[ai][bj][m][0] * bf4lo(g[m][bj]), acc[ai][bj][m][1] * bf4hi(g[m][bj])); } } }
};
struct PhaseYa : PhaseN2048<VW, VW, VW> {
    DI bool next(int i, g8::Unit& u) const { return next_(i, u); }
    DI void epi(EPI_ARGS) const { const bf16_t* GA = (const bf16_t*)(p.ws + WS_GA); const bf16_t* Y = (const bf16_t*)(p.ws + WS_YBG); bf16_t* MB = (bf16_t*)(p.ws + WS_MB);
#pragma unroll
        for (int ai = 0; ai < 2; ++ai) { u32x4 g[4][2], y[4][2];
#pragma unroll
            for (int m = 0; m < 4; ++m)
#pragma unroll
                for (int bj = 0; bj < 2; ++bj) { const size_t o = (size_t)(u.pm * 256 + ai * 128 + wr * 64 + m * 16 + fr) * D + u.pn * 256 + bj * 128 + wc * 32 + 8 * fq;
                    g[m][bj] = *(const u32x4*)(GA + o); y[m][bj] = *(const u32x4*)(Y + o); }
#pragma unroll
            for (int m = 0; m < 4; ++m)
#pragma unroll
                for (int bj = 0; bj < 2; ++bj) { const size_t o = (size_t)(u.pm * 256 + ai * 128 + wr * 64 + m * 16 + fr) * D + u.pn * 256 + bj * 128 + wc * 32 + 8 * fq;
                    *(u32x4*)(MB + o) = pk8(acc[ai][bj][m][0] * bf4lo(g[m][bj]) + bf4lo(y[m][bj]), acc[ai][bj][m][1] * bf4hi(g[m][bj]) + bf4hi(y[m][bj])); } } }
};
template <bool BASE_BF16, bool ATOMIC_SS>
DI void epi_residual(EPI_ARGS, const void* base_v, bf16_t* HB, float* SS) {
#pragma unroll
    for (int ai = 0; ai < 2; ++ai)
#pragma unroll
        for (int mh = 0; mh < 2; ++mh) {
            f32x4 b0[2][2], b1[2][2];
#pragma unroll
            for (int mm = 0; mm < 2; ++mm) { const int row = u.pm * 256 + ai * 128 + wr * 64 + (2 * mh + mm) * 16 + fr;
#pragma unroll
                for (int bj = 0; bj < 2; ++bj) { const size_t o = (size_t)row * D + u.pn * 256 + bj * 128 + wc * 32 + 8 * fq;
                    if (BASE_BF16) { const u32x4 w = *(const u32x4*)((const bf16_t*)base_v + o); b0[mm][bj] = bf4lo(w); b1[mm][bj] = bf4hi(w); }
                    else { b0[mm][bj] = *(const f32x4*)((const float*)base_v + o); b1[mm][bj] = *(const f32x4*)((const float*)base_v + o + 4); } } }
#pragma unroll
            for (int mm = 0; mm < 2; ++mm) { const int m = 2 * mh + mm; const int row = u.pm * 256 + ai * 128 + wr * 64 + m * 16 + fr; float ss = 0.f;
#pragma unroll
                for (int bj = 0; bj < 2; ++bj) { const size_t o = (size_t)row * D + u.pn * 256 + bj * 128 + wc * 32 + 8 * fq;
                    const f32x4 h0 = acc[ai][bj][m][0] + b0[mm][bj], h1 = acc[ai][bj][m][1] + b1[mm][bj];
                    *(u32x4*)(HB + o) = pk8(h0, h1);
                    ss += sum4(h0 * h0) + sum4(h1 * h1); }
                ss += __shfl_xor(ss, 16); ss += __shfl_xor(ss, 32);
                if (fq == 0) { if (ATOMIC_SS) __hip_atomic_fetch_add(SS + row, ss, __ATOMIC_RELAXED, __HIP_MEMORY_SCOPE_AGENT); else SS[(size_t)row * 32 + u.pn * 4 + wc] = ss; } }
        }
}
struct PhaseOut : PhaseN2048<D, D, D> {
    DI bool next(int i, g8::Unit& u) const { return next_(i, u); }
    DI void epi(EPI_ARGS) const { epi_residual<false, true>(acc, u, wr, wc, fr, fq, p.x_prompt, (bf16_t*)(p.ws + WS_H1B), (float*)(p.ws + WS_RS1)); }
};
struct PhaseDown : PhaseN2048<DFF, DFF, DFF> {
    DI bool next(int i, g8::Unit& u) const { return next_(i, u); }
    DI void epi(EPI_ARGS) const { epi_residual<true, false>(acc, u, wr, wc, fr, fq, p.ws + WS_H1B, (bf16_t*)(p.ws + WS_H2B), (float*)(p.ws + WS_SS2)); }
};
struct PhasePe : PhaseN2048<PLE, PLE, PLE> {
    DI bool next(int i, g8::Unit& u) const { const int first = (NTM * 43) % G, nfree = G - first; if (nfree <= 0 || c < first) return false;
        const long L = (long)i * nfree + (c - first); if (L >= 256) return false; const int pm = (int)L >> 3, pn = (int)L & 7;
        u.pm = pm; u.pn = pn; u.A = (const char*)(p.ws + a_off) + (size_t)pm * 256 * LDA * 2; u.B = (const char*)(p.ws + b_off) + (size_t)pn * 256 * LDB * 2; return true; }
    DI void epi(EPI_ARGS) const { bf16_t* PE = (bf16_t*)(p.ws + WS_PE);
        EPI_ROWS(row) EPI_COLS(col) const size_t o = (size_t)row * D + u.pn * 256 + col; *(u32x4*)(PE + o) = pk8(v0, v1); EPI_END }
};
struct PhasePg : PhaseN2048<D, D, D> {
    DI bool next(int i, g8::Unit& u) const { return next_(i, u); }
    DI void epi(EPI_ARGS) const { const bf16_t* H2 = (const bf16_t*)(p.ws + WS_H2B); const bf16_t* PE = (const bf16_t*)(p.ws + WS_PE); const float* SS2 = (const float*)(p.ws + WS_SS2);
        bf16_t* H3 = (bf16_t*)(p.ws + WS_H3); float* SS3 = (float*)(p.ws + WS_SS3);
#pragma unroll
        for (int ai = 0; ai < 2; ++ai)
#pragma unroll
            for (int mh = 0; mh < 2; ++mh) { u32x4 hw[2][2], pw[2][2]; float rs[2];
#pragma unroll
                for (int mm = 0; mm < 2; ++mm) { const int row = u.pm * 256 + ai * 128 + wr * 64 + (2 * mh + mm) * 16 + fr; float s2 = 0.f;
#pragma unroll
                    for (int k = 0; k < 8; ++k) s2 += sum4(*(const f32x4*)(SS2 + (size_t)row * 32 + 4 * k));
                    rs[mm] = 1.0f / sqrtf(s2 * (1.0f / D) + EPS);
#pragma unroll
                    for (int bj = 0; bj < 2; ++bj) { const size_t o = (size_t)row * D + u.pn * 256 + bj * 128 + wc * 32 + 8 * fq; hw[mm][bj] = *(const u32x4*)(H2 + o); pw[mm][bj] = *(const u32x4*)(PE + o); } }
#pragma unroll
                for (int mm = 0; mm < 2; ++mm) { const int m = 2 * mh + mm; const int row = u.pm * 256 + ai * 128 + wr * 64 + m * 16 + fr; float ss = 0.f;
#pragma unroll
                    for (int bj = 0; bj < 2; ++bj) { const size_t o = (size_t)row * D + u.pn * 256 + bj * 128 + wc * 32 + 8 * fq;
                        const f32x4 h0 = bf4lo(hw[mm][bj]) + sig4(acc[ai][bj][m][0] * rs[mm]) * bf4lo(pw[mm][bj]), h1 = bf4hi(hw[mm][bj]) + sig4(acc[ai][bj][m][1] * rs[mm]) * bf4hi(pw[mm][bj]);
                        *(u32x4*)(H3 + o) = pk8(h0, h1); ss += sum4(h0 * h0) + sum4(h1 * h1); }
                    ss += __shfl_xor(ss, 16); ss += __shfl_xor(ss, 32);
                    if (fq == 0) SS3[(size_t)row * 32 + u.pn * 4 + wc] = ss; } } }
};
DI F8 shfl8(const F8& v, int src) { F8 r; r.a = (f32x4){__shfl(v.a.x, src), __shfl(v.a.y, src), __shfl(v.a.z, src), __shfl(v.a.w, src)}; r.b = (f32x4){__shfl(v.b.x, src), __shfl(v.b.y, src), __shfl(v.b.z, src), __shfl(v.b.w, src)}; return r; }
DI F8 sel8(bool c, const F8& x, const F8& y) { F8 r; r.a = c ? x.a : y.a; r.b = c ? x.b : y.b; return r; }
struct PhaseUp {
    static constexpr int LDA = D, LDB = D, KT = D / 64;
    const Params& p; int G, c; LAS unsigned char* xl;
    DI bool next(int i, g8::Unit& u) const { int pm, pn; if (!g8::grid_order(NTM, 43, G, c, i, pm, pn)) return false;
        u.pm = pm; u.pn = pn; u.A = (const char*)(p.ws + WS_H1B) + (size_t)pm * 256 * D * 2; u.B = (const char*)(p.ws + WS_WUP) + (size_t)pn * 256 * D * 2; return true; }
    DI void epi(const f32x4 (&acc)[2][2][4][2], const g8::Unit& u, int wr, int wc, int fr_, int fq_) const {
        unsigned char* ws = p.ws; bf16_t* ACT = (bf16_t*)(ws + WS_ACT); const float* RS1 = (const float*)(ws + WS_RS1);
        const int lane = lane_id(), fr = lane & 15, fq = lane >> 4;
        (void)fr_; (void)fq_;
        const int pm = u.pm, chl = 32 * wc + 8 * fq, chb = 128 * u.pn + chl;
#define UP_RR(ai_, m_) (1.0f / sqrtf(RS1[pm * 256 + (ai_) * 128 + wr * 64 + (m_) * 16 + fr] * (1.0f / D) + EPS))
        LAS float* X = (LAS float*)xl;
        if (pm == NTM - 1) {
#pragma unroll
            for (int n = 0; n < 2; ++n) { const int ch = chb + 4 * n;
                const f32x4 w0 = *(const f32x4*)(p.conv_w + ch), w1 = *(const f32x4*)(p.conv_w + DFF + ch), w2 = *(const f32x4*)(p.conv_w + 2 * DFF + ch), cb = *(const f32x4*)(p.conv_b + ch);
#pragma unroll
                for (int m = 0; m < 4; ++m) { const int row = pm * 256 + wr * 64 + m * 16 + fr, b = row - MP; const float r0 = UP_RR(0, m);
                    const f32x4 g0 = acc[0][0][m][n] * r0, up = acc[0][1][m][n] * r0;
                    const float* sc = p.state_conv + (size_t)b * 2 * DFF + ch; const f32x4 g1 = *(const f32x4*)(sc + DFF), g2 = *(const f32x4*)sc;
                    const f32x4 aa = silu4(cb + w0 * g2 + w1 * g1 + w2 * g0) * up;
                    u32x2 o; o.x = pk2(aa.x, aa.y); o.y = pk2(aa.z, aa.w); *(u32x2*)(ACT + (size_t)row * DFF + ch) = o;
                    float* co = p.out + O_CONVS + (size_t)b * 2 * DFF + ch; *(f32x4*)co = g1; *(f32x4*)(co + DFF) = g0; } }
            asm volatile("s_waitcnt lgkmcnt(0)" ::: "memory"); __builtin_amdgcn_s_barrier(); asm volatile("" ::: "memory");
            return;
        }
#pragma unroll
        for (int n = 0; n < 2; ++n) {
#pragma unroll
            for (int ai = 0; ai < 2; ++ai) if (fr >= 14) { const f32x4 g3 = acc[ai][0][3][n] * UP_RR(ai, 3);
                *(LAS f32x4*)(X + ((2 * ai + wr) * 2 + (fr - 14)) * 128 + chl + 4 * n) = g3;
                if (ai == 1 && wr == 1) { *(f32x4*)((float*)(ws + WS_HALO) + ((size_t)pm * 2 + (fr - 14)) * DFF + chb + 4 * n) = g3;
                    if ((pm & 7) == 7) *(f32x4*)(p.out + O_CONVP + ((size_t)(pm >> 3) * 2 + (fr - 14)) * DFF + chb + 4 * n) = g3; } }
            if (wr == 0 && fr < 2) { *(f32x4*)((float*)(ws + WS_FIXG) + ((size_t)pm * 2 + fr) * DFF + chb + 4 * n) = acc[0][0][0][n] * UP_RR(0, 0);
                *(f32x4*)((float*)(ws + WS_FIXU) + ((size_t)pm * 2 + fr) * DFF + chb + 4 * n) = acc[0][1][0][n] * UP_RR(0, 0); }
        }
        asm volatile("s_waitcnt lgkmcnt(0)" ::: "memory"); __builtin_amdgcn_s_barrier(); asm volatile("" ::: "memory");
        const int src1 = (lane & 48) | ((fr + 15) & 15), src2 = (lane & 48) | ((fr + 14) & 15);
        const f32x4 z4 = {0.f, 0.f, 0.f, 0.f};
#pragma unroll
        for (int n = 0; n < 2; ++n) { const int ch = chb + 4 * n;
            const f32x4 w0 = *(const f32x4*)(p.conv_w + ch), w1 = *(const f32x4*)(p.conv_w + DFF + ch), w2 = *(const f32x4*)(p.conv_w + 2 * DFF + ch), cb = *(const f32x4*)(p.conv_b + ch);
#pragma unroll
            for (int ai = 0; ai < 2; ++ai) {
                f32x4 t1p = z4, t2p = z4;
                if (!(ai == 0 && wr == 0)) { const int ps = (wr == 1) ? 2 * ai : 1; const LAS float* xp = X + (ps * 2) * 128 + chl + 4 * n;
                    const f32x4 pv14 = *(const LAS f32x4*)xp, pv15 = *(const LAS f32x4*)(xp + 128); t1p = pv15; t2p = (fr == 0) ? pv14 : pv15; }
#pragma unroll
                for (int m = 0; m < 4; ++m) { const int row = pm * 256 + ai * 128 + wr * 64 + m * 16 + fr;
                    const float rm = UP_RR(ai, m); const f32x4 gm = acc[ai][0][m][n] * rm;
                    const f32x4 t1 = (f32x4){__shfl(gm.x, src1), __shfl(gm.y, src1), __shfl(gm.z, src1), __shfl(gm.w, src1)};
                    const f32x4 t2 = (f32x4){__shfl(gm.x, src2), __shfl(gm.y, src2), __shfl(gm.z, src2), __shfl(gm.w, src2)};
                    const f32x4 p1 = (fr == 0) ? t1p : t1, p2 = (fr < 2) ? t2p : t2;
                    const f32x4 aa = silu4(cb + w0 * p2 + w1 * p1 + w2 * gm) * (acc[ai][1][m][n] * rm);
                    u32x2 o; o.x = pk2(aa.x, aa.y); o.y = pk2(aa.z, aa.w); *(u32x2*)(ACT + (size_t)row * DFF + ch) = o;
                    t1p = t1; t2p = t2; }
            }
            asm volatile("" ::: "memory");
        }
    }
#undef UP_RR
};

struct PhaseWpb {
    static constexpr int LDA = POOLW, LDB = 256, KT = 4;
    const Params& p; int G, c;
    DI bool next(int i, g8::Unit& u) const { const int off = 220 % G; const long L = (long)i * G + ((c + G - off) % G); if (L >= 32) return false;
        const int pm = (int)L >> 2, g = (int)L & 3; u.pm = pm; u.pn = g;
        u.A = (const char*)(p.ws + WS_WBT) + ((size_t)pm * 256 * POOLW + g * 256) * 2; u.B = (const char*)(p.ws + WS_WPS) + (size_t)g * 256 * 256 * 2; return true; }
    DI void epi(EPI_ARGS) const { bf16_t* W = (bf16_t*)(p.ws + WS_WPB);
        EPI_ROWS(row) EPI_COLS(col) *(u32x4*)(W + (size_t)row * POOLW + u.pn * 256 + col) = pk8(v0, v1); EPI_END }
};

template <int KS, int LDA, int LDB>
DI f32x4 skinny16(const bf16_t* A, const bf16_t* W, int lane) {
    const int fr = lane & 15, fq = lane >> 4;
    const bf16_t* ap = A + (size_t)fr * LDA + 8 * fq; const bf16_t* bp = W + (size_t)fr * LDB + 8 * fq;
    f32x4 acc = {0.f, 0.f, 0.f, 0.f};
#pragma unroll 4
    for (int s = 0; s < KS; ++s) { const bf16x8 a = *(const bf16x8*)(ap + 32 * s), b = *(const bf16x8*)(bp + 32 * s); acc = __builtin_amdgcn_mfma_f32_16x16x32_bf16(a, b, acc, 0, 0, 0); }
    return acc;
}
DI float sum16(float v) { v += __shfl_xor(v, 1); v += __shfl_xor(v, 2); v += __shfl_xor(v, 4); v += __shfl_xor(v, 8); return v; }
template <int KIND, int K, int LDA, int LDB, int NCG = 128>
DI void sample_gemm(const Params& p, LAS unsigned char* lds, size_t a_off, size_t w_off, int wave) {
    unsigned char* ws = p.ws; const int lane = lane_id(), fr = lane & 15, fq = lane >> 4;
    constexpr int KS = K / 64;
    for (int it = blockIdx.x; it < 2 * NCG; it += gridDim.x) {
        const int cg_ = it >> 1, r0 = MP + 64 * (it & 1) + 16 * (wave & 3), col = 16 * cg_ + fr, kh = wave >> 2;
        f32x4 acc = skinny16<KS, LDA, LDB>((const bf16_t*)(ws + a_off) + (size_t)r0 * LDA + kh * (K / 2), (const bf16_t*)(ws + w_off) + (size_t)(16 * cg_) * LDB + kh * (K / 2), lane);
        LAS f32x4* xch = (LAS f32x4*)lds;
        if (kh == 1) xch[(wave & 3) * 64 + lane] = acc;
        __syncthreads();
        if (kh == 0) {
        acc += xch[wave * 64 + lane];
        float rs[4] = {0.f, 0.f, 0.f, 0.f};
        if (KIND == 5) {
            const float* SS2S = (const float*)(ws + WS_SS2S);
#pragma unroll
            for (int r = 0; r < 16; ++r) { const float* q = SS2S + (size_t)(r0 - MP + r) * 128; const float s_ = wave_sum(q[lane] + q[64 + lane]); const float rr = 1.0f / sqrtf(s_ * (1.0f / D) + EPS);
#pragma unroll
                for (int j = 0; j < 4; ++j) rs[j] = (r == 4 * fq + j) ? rr : rs[j]; }
        }
#pragma unroll
        for (int j = 0; j < 4; ++j) {
            const int row = r0 + 4 * fq + j; const size_t o = (size_t)row * D + col; const float v = acc[j]; float hsq = 0.f;
            if (KIND == 6) { const float val = v * ((const float*)(ws + WS_RSTD1))[row];
                if (col < KW) ((bf16_t*)(ws + WS_QB))[(size_t)row * KW + col] = (bf16_t)(pk2(val * 0.0625f, 0.f) & 0xffffu);
                else if (col < 2 * KW) ((bf16_t*)(ws + WS_KB))[(size_t)row * KW + col - KW] = (bf16_t)(pk2(val, 0.f) & 0xffffu);
                else ((bf16_t*)(ws + WS_V))[(size_t)row * VW + col - 2 * KW] = (bf16_t)(pk2(val, 0.f) & 0xffffu); }
            if (KIND == 0) { ((bf16_t*)(ws + WS_YBG))[o] = (bf16_t)(pk2(v * bf1(((const bf16_t*)(ws + WS_GB))[o]), 0.f) & 0xffffu); }
            if (KIND == 1) { ((bf16_t*)(ws + WS_MB))[o] = (bf16_t)(pk2(v * bf1(((const bf16_t*)(ws + WS_GA))[o]) + bf1(((const bf16_t*)(ws + WS_YBG))[o]), 0.f) & 0xffffu); }
            if (KIND == 2) { const float hv = p.x_sample[(size_t)(row - MP) * D + col] + v; ((bf16_t*)(ws + WS_H1B))[o] = (bf16_t)(pk2(hv, 0.f) & 0xffffu); hsq = hv * hv; }
            if (KIND == 3) { const float hv = bf1(((const bf16_t*)(ws + WS_H1B))[o]) + v; ((bf16_t*)(ws + WS_H2B))[o] = (bf16_t)(pk2(hv, 0.f) & 0xffffu); hsq = hv * hv; }
            if (KIND == 4) { ((bf16_t*)(ws + WS_PE))[o] = (bf16_t)(pk2(v, 0.f) & 0xffffu); }
            if (KIND == 5) { const float hv = bf1(((const bf16_t*)(ws + WS_H2B))[o]) + sigmoidf_(v * rs[j]) * bf1(((const bf16_t*)(ws + WS_PE))[o]); ((bf16_t*)(ws + WS_H3))[o] = (bf16_t)(pk2(hv, 0.f) & 0xffffu); hsq = hv * hv; }
            if (KIND == 2) { const float t = sum16(hsq); if (fr == 0) __hip_atomic_fetch_add((float*)(ws + WS_RS1) + row, t, __ATOMIC_RELAXED, __HIP_MEMORY_SCOPE_AGENT); }
            if (KIND == 3 || KIND == 5) { const float t = sum16(hsq);
                float* SSx = (float*)(ws + (KIND == 3 ? WS_SS2S : WS_SS3S)); if (fr == 0) SSx[(size_t)(row - MP) * 128 + cg_] = t; }
        }
        }
        __syncthreads();
    }
}


#define XB_TMO      128
#define XB_XCNT(j)  (256  + 64 * (j))
#define XB_XSUB(j)  (1280 + 64 * (j))
#define XB_XGEN(j)  (2304 + 64 * (j))
#define XB_TOP      3328
#define XB_TOPGEN   3392
#define XCD_BAR_WORDS 3456
#define XB_SPIN_CAP (1u << 22)
DI unsigned xb_ld(unsigned* p)              { return __hip_atomic_load(p, __ATOMIC_RELAXED, __HIP_MEMORY_SCOPE_AGENT); }
DI unsigned xb_add(unsigned* p, unsigned v) { return __hip_atomic_fetch_add(p, v, __ATOMIC_RELAXED, __HIP_MEMORY_SCOPE_AGENT); }
DI unsigned xb_xcc_id() { return (unsigned)__builtin_amdgcn_s_getreg((3 << 11) | 20) & 0xFu; }
#define XB_SPIN(cond, bar) do { unsigned _sp = 0; while (cond) { __builtin_amdgcn_s_sleep(1); \
    if ((++_sp & 255u) == 0u) { if (xb_ld(&(bar)[XB_TMO])) break; if (_sp > XB_SPIN_CAP) { atomicAdd(&(bar)[XB_TMO], 1u); break; } } } } while (0)
struct XcdBarrier { unsigned* bar; unsigned x; volatile LAS unsigned* st; };
DI XcdBarrier xcd_barrier_post(unsigned* bar, volatile LAS unsigned* st, bool t0) {
    XcdBarrier b; b.bar = bar; b.x = xb_xcc_id(); b.st = st;
    if (t0) (void)xb_add(&bar[XB_XCNT(b.x)], 1u);
    return b;
}
DI void xcd_barrier_complete(unsigned* bar, unsigned x, unsigned& nloc, unsigned& nx) {
    const unsigned G = gridDim.x * gridDim.y * gridDim.z;
    unsigned sum, cnt, mine, sp = 0u;
    for (;;) {
        sum = 0u; cnt = 0u; mine = 0u;
#pragma unroll
        for (unsigned j = 0; j < 16; ++j) { const unsigned c = xb_ld(&bar[XB_XCNT(j)]); sum += c; cnt += (c > 0u) ? 1u : 0u; mine = (j == x) ? c : mine; }
        if (sum == G) break;
        __builtin_amdgcn_s_sleep(1);
        if ((++sp & 255u) == 0u) { if (xb_ld(&bar[XB_TMO])) break; if (sp > XB_SPIN_CAP) { atomicAdd(&bar[XB_TMO], 1u); break; } }
    }
    nloc = mine > 0u ? mine : 1u; nx = cnt > 0u ? cnt : 1u;
}
DI void xcd_barrier(const XcdBarrier& b, bool t0) {
    asm volatile("s_waitcnt vmcnt(0)" ::: "memory");
    __syncthreads();
    if (t0) {
        unsigned* bar = b.bar;
        __builtin_amdgcn_s_waitcnt(0);
        unsigned nloc = b.st[0], nx = b.st[1];
        if (nloc == 0u) { xcd_barrier_complete(bar, b.x, nloc, nx); b.st[0] = nloc; b.st[1] = nx; }
        const unsigned old = xb_add(&bar[XB_XSUB(b.x)], 1u);
        const unsigned gen = old / nloc;
        if (old + 1u == (gen + 1u) * nloc) {
            __builtin_amdgcn_fence(__ATOMIC_RELEASE, "agent");
            asm volatile("s_waitcnt vmcnt(0)" ::: "memory");
            const unsigned og = xb_add(&bar[XB_TOP], 1u);
            const unsigned tg = og / nx;
            if (og + 1u == (tg + 1u) * nx) xb_add(&bar[XB_TOPGEN], 1u);
            else XB_SPIN(xb_ld(&bar[XB_TOPGEN]) == tg, bar);
            __builtin_amdgcn_fence(__ATOMIC_ACQUIRE, "agent");
            xb_add(&bar[XB_XGEN(b.x)], 1u);
            asm volatile("s_waitcnt vmcnt(0)" ::: "memory");
        } else {
            XB_SPIN(xb_ld(&bar[XB_XGEN(b.x)]) == gen, bar);
            __builtin_amdgcn_fence(__ATOMIC_ACQUIRE, "agent");
            asm volatile("s_waitcnt vmcnt(0)" ::: "memory");
        }
    }
    __syncthreads();
}

constexpr int N_PHASES = 13;
#ifndef G8_SP2
#define G8_SP2 true
#endif
#ifndef G8_ALIGN
#define G8_ALIGN true
#endif

__global__ void __launch_bounds__(NTHREADS, 2) fwd_kernel(Params p) {
    extern __shared__ __attribute__((aligned(16))) unsigned char lds_raw[];
    LAS unsigned char* lds = (LAS unsigned char*)lds_raw;
    const int G = gridDim.x, c = blockIdx.x;
    const int wave = __builtin_amdgcn_readfirstlane(threadIdx.x >> 6);
    const int lo = p.ph_lo, hi = p.ph_hi;
#ifndef REPEAT_MASK
#define REPEAT_MASK 0
#endif
#ifndef PHASE_MASK
#define PHASE_MASK 0x1aff
#endif
#define IN(k) (((PHASE_MASK >> (k)) & 1) && lo <= (k) && (k) < hi)
    volatile LAS unsigned* bst = (volatile LAS unsigned*)(lds + LDS_MISC);
    const bool t0 = (wave == 0) && (lane_id() == 0);
    XcdBarrier bar; bar.bar = (unsigned*)(p.ws + WS_CTL); bar.x = 0; bar.st = bst;
    if (hi - lo > 1) { if (t0) { bst[0] = 0u; bst[1] = 0u; } __syncthreads(); bar = xcd_barrier_post((unsigned*)(p.ws + WS_CTL), bst, t0); }
#define NEXTPH(k) ((k) == 9 ? 11 : ((k) == 7 ? 9 : (k) + 1))
#define SEAM(k) do { if (IN(k) && IN(NEXTPH(k))) { xcd_barrier(bar, (wave == 0) && (lane_id() == 0)); } } while (0)
    if (IN(0)) { phase_p0(p, lds, wave); if ((REPEAT_MASK >> 0) & 1) { xcd_barrier(bar, (wave == 0) && (lane_id() == 0)); phase_p0(p, lds, wave); } } SEAM(0);
    if (IN(1)) { sample_gemm<6, D, D, D, 256>(p, lds, WS_XB, WS_WIN, wave); PhaseIn ph{p, G, c, 0, 0}; g8::run<PhaseIn, G8_ALIGN, G8_SP2>(lds, ph, wave); } SEAM(1);
    if (IN(2)) {
        if (G == 256) {
            if (c < 32) scan_role(p, lds, wave, c, 32);
            else if (c < 71) stream_role(p, wave, c - 32, 39);
            else { PhaseIn ph{p, G, c, 1, 71}; g8::run<PhaseIn, G8_ALIGN, G8_SP2>(lds, ph, wave); PhaseWpb pw{p, G, c}; g8::run<PhaseWpb, G8_ALIGN, G8_SP2>(lds, pw, wave); }
        } else {
            PhaseIn ph{p, G, c, 1, 0}; g8::run<PhaseIn, G8_ALIGN, G8_SP2>(lds, ph, wave); PhaseWpb pw{p, G, c}; g8::run<PhaseWpb, G8_ALIGN, G8_SP2>(lds, pw, wave);
            scan_role(p, lds, wave, c, G); stream_role(p, wave, c, G);
        }
    } SEAM(2);
    if (IN(3)) { phase_p3(p, wave); if ((REPEAT_MASK >> 3) & 1) { xcd_barrier(bar, (wave == 0) && (lane_id() == 0)); phase_p3(p, wave); } } SEAM(3);
    if (IN(4)) { sample_gemm<0, POOLW, POOLW, POOLW>(p, lds, WS_PM, WS_WPB, wave); PhaseYb ph{{p, G, c, WS_PM, WS_WPB}}; g8::run<PhaseYb, G8_ALIGN, G8_SP2>(lds, ph, wave); if ((REPEAT_MASK >> 4) & 1) { xcd_barrier(bar, (wave == 0) && (lane_id() == 0)); sample_gemm<0, POOLW, POOLW, POOLW>(p, lds, WS_PM, WS_WPB, wave); PhaseYb ph{{p, G, c, WS_PM, WS_WPB}}; g8::run<PhaseYb, G8_ALIGN, G8_SP2>(lds, ph, wave); } } SEAM(4);
    if (IN(5)) { sample_gemm<1, VW, VW, VW>(p, lds, WS_OG, WS_WA, wave); PhaseYa ph{{p, G, c, WS_OG, WS_WA}}; g8::run<PhaseYa, G8_ALIGN, G8_SP2>(lds, ph, wave); if ((REPEAT_MASK >> 5) & 1) { xcd_barrier(bar, (wave == 0) && (lane_id() == 0)); sample_gemm<1, VW, VW, VW>(p, lds, WS_OG, WS_WA, wave); PhaseYa ph{{p, G, c, WS_OG, WS_WA}}; g8::run<PhaseYa, G8_ALIGN, G8_SP2>(lds, ph, wave); } } SEAM(5);
    if (IN(6)) { sample_gemm<2, D, D, D>(p, lds, WS_MB, WS_WO, wave); PhaseOut ph{{p, G, c, WS_MB, WS_WO}}; g8::run<PhaseOut, G8_ALIGN, G8_SP2>(lds, ph, wave); if ((REPEAT_MASK >> 6) & 1) { xcd_barrier(bar, (wave == 0) && (lane_id() == 0)); sample_gemm<2, D, D, D>(p, lds, WS_MB, WS_WO, wave); PhaseOut ph{{p, G, c, WS_MB, WS_WO}}; g8::run<PhaseOut, G8_ALIGN, G8_SP2>(lds, ph, wave); } } SEAM(6);
    if (IN(7)) { PhaseUp ph{p, G, c, lds + LDS_XCH}; g8::run<PhaseUp, true, G8_SP2>(lds, ph, wave); sample_gemm<4, PLE, PLE, PLE>(p, lds, WS_PLB, WS_WPLE, wave); { PhasePe pe{{p, G, c, WS_PLB, WS_WPLE}}; g8::run<PhasePe, G8_ALIGN, G8_SP2>(lds, pe, wave); } } SEAM(7);
    if (IN(9)) { { PhaseDown pd{{p, G, c, WS_ACT, WS_WD}}; g8::Unit uu; for (int i = 0; pd.next(i, uu); ++i) conv_fixup_tile(p, uu.pm, wave); asm volatile("s_waitcnt vmcnt(0)" ::: "memory"); __syncthreads(); } sample_gemm<3, DFF, DFF, DFF>(p, lds, WS_ACT, WS_WD, wave); PhaseDown ph{{p, G, c, WS_ACT, WS_WD}}; g8::run<PhaseDown, G8_ALIGN, G8_SP2>(lds, ph, wave); if ((REPEAT_MASK >> 9) & 1) { xcd_barrier(bar, (wave == 0) && (lane_id() == 0)); sample_gemm<3, DFF, DFF, DFF>(p, lds, WS_ACT, WS_WD, wave); PhaseDown ph{{p, G, c, WS_ACT, WS_WD}}; g8::run<PhaseDown, G8_ALIGN, G8_SP2>(lds, ph, wave); } } SEAM(9);
    if (IN(11)) { sample_gemm<5, D, D, D>(p, lds, WS_H2B, WS_WPG, wave); PhasePg ph{{p, G, c, WS_H2B, WS_WPG}}; g8::run<PhasePg, G8_ALIGN, G8_SP2>(lds, ph, wave); if ((REPEAT_MASK >> 11) & 1) { xcd_barrier(bar, (wave == 0) && (lane_id() == 0)); sample_gemm<5, D, D, D>(p, lds, WS_H2B, WS_WPG, wave); PhasePg ph{{p, G, c, WS_H2B, WS_WPG}}; g8::run<PhasePg, G8_ALIGN, G8_SP2>(lds, ph, wave); } } SEAM(11);
    if (IN(12)) { phase_final(p, wave); if ((REPEAT_MASK >> 12) & 1) { xcd_barrier(bar, (wave == 0) && (lane_id() == 0)); phase_final(p, wave); } }
#undef IN
#undef SEAM
}

extern "C" void kernel_launch(void* const* d_in, const int* in_sizes, int n_in, void* d_out, int out_size, void* d_ws, size_t ws_size, hipStream_t stream) {
    static int grid = 0;
    if (grid == 0) {
        if (n_in != 26 || (size_t)out_size != O_END || ws_size < WS_END) {
            fprintf(stderr, "kernel_launch: unexpected problem: n_in %d out %d ws %zu (need %zu)\n", n_in, out_size, ws_size, (size_t)WS_END); grid = -1; return; }
        int dev = 0, cus = 0, per_cu = 0;
        if (hipGetDevice(&dev) != hipSuccess || hipDeviceGetAttribute(&cus, hipDeviceAttributeMultiprocessorCount, dev) != hipSuccess) { grid = -1; return; }
        if (hipFuncSetAttribute((const void*)fwd_kernel, hipFuncAttributeMaxDynamicSharedMemorySize, LDS_BYTES) != hipSuccess) { fprintf(stderr, "kernel_launch: hipFuncSetAttribute failed\n"); grid = -1; return; }
        if (hipOccupancyMaxActiveBlocksPerMultiprocessor(&per_cu, (const void*)fwd_kernel, NTHREADS, LDS_BYTES) != hipSuccess || per_cu < 1) {
            fprintf(stderr, "kernel_launch: occupancy query reports %d blocks per CU\n", per_cu); (void)hipGetLastError(); grid = -1; return; }
        grid = cus;
    }
    if (grid < 0) return;
    Params p{};
    const float** pp = (const float**)&p;
    for (int i = 0; i < 26; ++i) pp[i] = (const float*)d_in[i];
    p.out = (float*)d_out; p.ws = (unsigned char*)d_ws;
#if MK_N_LAUNCHES == 1
    p.ph_lo = 0; p.ph_hi = N_PHASES;
    void* args[] = {&p};
    if (hipMemsetAsync((char*)d_ws + WS_CTL, 0, XCD_BAR_WORDS * 4, stream) != hipSuccess) { fprintf(stderr, "kernel_launch: memset failed\n"); return; }
    hipError_t e = hipLaunchCooperativeKernel((const void*)fwd_kernel, dim3(grid), dim3(NTHREADS), args, LDS_BYTES, stream);
    if (e != hipSuccess) fprintf(stderr, "kernel_launch: cooperative launch failed: %s (grid %d)\n", hipGetErrorString(e), grid);
#else
    for (int k = 0; k < N_PHASES; ++k) { p.ph_lo = k; p.ph_hi = k + 1; hipLaunchKernelGGL(fwd_kernel, dim3(grid), dim3(NTHREADS), LDS_BYTES, stream, p); }
#endif
}
```

```cpp
#include <hip/hip_runtime.h>
#include <hip/hip_cooperative_groups.h>
#include <cstdio>
#include <cstdint>
namespace cg = cooperative_groups;

#ifndef MK_N_LAUNCHES
#define MK_N_LAUNCHES 1
#endif

#define LAS __attribute__((address_space(3)))
#define DI __device__ __forceinline__
typedef unsigned short bf16_t;
typedef short bf16x8 __attribute__((ext_vector_type(8)));
typedef short s16x4 __attribute__((ext_vector_type(4)));
typedef float f32x4 __attribute__((ext_vector_type(4)));
typedef float f32x2 __attribute__((ext_vector_type(2)));
typedef float f32x16 __attribute__((ext_vector_type(16)));
typedef unsigned u32x4 __attribute__((ext_vector_type(4)));
typedef unsigned u32x2 __attribute__((ext_vector_type(2)));

constexpr int D = 2048, MP = 8192, MS = 128, M = MP + MS, MPAD = 8448, NTM = 33;
constexpr int SEQ = 2048, NB = 4, NH = 4, DK = 256, DV = 512, KW = 1024, VW = 2048;
constexpr int DFF = 5504, NUP = 2 * DFF, PLE = 256, POOLW = 1024, INW = 11280, NIN = 11264;
constexpr float EPS = 1e-6f;
constexpr int NSL = 16;
constexpr int CH = 32, NCHK = MP / CH;

constexpr size_t O_YP = 0, O_YS = O_YP + (size_t)MP * D, O_GLAP = O_YS + (size_t)MS * D, O_POOLP = O_GLAP + (size_t)NB * NH * DK * DV,
                 O_CONVP = O_POOLP + (size_t)NB * 15 * POOLW, O_GLAS = O_CONVP + (size_t)NB * 2 * DFF, O_POOLS = O_GLAS + (size_t)MS * NH * DK * DV,
                 O_CONVS = O_POOLS + (size_t)MS * 15 * POOLW, O_END = O_CONVS + (size_t)MS * 2 * DFF;

constexpr size_t al(size_t x) { return (x + 255) & ~(size_t)255; }
constexpr size_t WS_CTL = 0, CTL_BYTES = 65536;
constexpr size_t WS_WUP = WS_CTL + CTL_BYTES;
constexpr size_t WS_WD = WS_WUP + al((size_t)NUP * D * 2);
constexpr size_t WS_WA = WS_WD + al((size_t)D * DFF * 2);
constexpr size_t WS_WO = WS_WA + al((size_t)D * D * 2);
constexpr size_t WS_WPG = WS_WO + al((size_t)D * D * 2);
constexpr size_t WS_WPB = WS_WPG + al((size_t)D * D * 2);
constexpr size_t WS_WPLE = WS_WPB + al((size_t)D * POOLW * 2);
constexpr size_t WS_WBT = WS_WPLE + al((size_t)D * PLE * 2);
constexpr size_t WS_WPS = WS_WBT + al((size_t)D * POOLW * 2);
constexpr size_t WS_SMALL = WS_WPS + al((size_t)POOLW * 256 * 2);
constexpr size_t WS_RSTD1 = WS_SMALL;
constexpr size_t WS_LAM = WS_RSTD1 + al((size_t)MPAD * 4);
constexpr size_t WS_OSS = WS_LAM + al((size_t)(NCHK + MS) * KW * 4);
constexpr size_t WS_OSP = WS_OSS + al((size_t)MP * NH * NSL * 4);
constexpr size_t WS_SS1 = WS_OSP + al((size_t)MS * NH * 8 * DV * 4);
constexpr size_t WS_SS2 = WS_SS1 + al((size_t)MPAD * 32 * 4);
constexpr size_t WS_SS3 = WS_SS2 + al((size_t)MPAD * 32 * 4);
constexpr size_t WS_SS1S = WS_SS3 + al((size_t)MPAD * 32 * 4);
constexpr size_t WS_SS2S = WS_SS1S + al((size_t)MS * 128 * 4);
constexpr size_t WS_SS3S = WS_SS2S + al((size_t)MS * 128 * 4);
constexpr size_t WS_RS1 = WS_SS3S + al((size_t)MS * 128 * 4);
constexpr size_t WS_HALO = WS_RS1 + al((size_t)MPAD * 4);
constexpr size_t WS_FIXG = WS_HALO + al((size_t)32 * 2 * DFF * 4);
constexpr size_t WS_FIXU = WS_FIXG + al((size_t)32 * 2 * DFF * 4);
constexpr size_t WS_PLB = WS_FIXU + al((size_t)32 * 2 * DFF * 4);
constexpr size_t WS_R1 = WS_PLB + al((size_t)MPAD * PLE * 2);
constexpr size_t WS_XB = WS_R1;
constexpr size_t WS_WIN = WS_XB + al((size_t)MPAD * D * 2);
constexpr size_t WS_BCUM = WS_WIN + al((size_t)NIN * D * 2);
constexpr size_t WS_R1_END = WS_BCUM + al((size_t)MPAD * KW * 4);
constexpr size_t WS_ACT = WS_R1;
static_assert(WS_ACT + al((size_t)MPAD * DFF * 2) <= WS_R1_END, "R1 overlay");
constexpr size_t WS_R2 = WS_R1_END;
constexpr size_t WS_QB = WS_R2;
constexpr size_t WS_KB = WS_QB + al((size_t)MPAD * KW * 2);
constexpr size_t WS_KD = WS_KB + al((size_t)MPAD * KW * 2);
constexpr size_t WS_V = WS_KD + al((size_t)MPAD * KW * 2);
constexpr size_t WS_SR = WS_V + al((size_t)MPAD * VW * 2);
constexpr size_t WS_GA = WS_SR + al((size_t)MPAD * VW * 2);
constexpr size_t WS_GB = WS_GA + al((size_t)MPAD * D * 2);
constexpr size_t WS_U = WS_GB + al((size_t)MPAD * D * 2);
constexpr size_t WS_OG = WS_U + al((size_t)MPAD * POOLW * 4);
constexpr size_t WS_PM = WS_OG + al((size_t)MPAD * VW * 2);
constexpr size_t WS_YBG = WS_PM + al((size_t)MPAD * POOLW * 2);
constexpr size_t WS_R2_END = WS_YBG + al((size_t)MPAD * D * 4);
constexpr size_t WS_GU = WS_R2;
constexpr size_t WS_H2 = WS_GU + al((size_t)MPAD * NUP * 2);
constexpr size_t WS_PE = WS_H2 + al((size_t)MPAD * D * 4);
static_assert(WS_PE + al((size_t)MPAD * D * 4) <= WS_R2_END, "R2 overlay");
constexpr size_t WS_MB = WS_R2_END;
constexpr size_t WS_H1 = WS_MB + al((size_t)MPAD * D * 2);
constexpr size_t WS_H1B = WS_H1 + al((size_t)MPAD * D * 4);
constexpr size_t WS_END = WS_H1B + al((size_t)MPAD * D * 2);
constexpr size_t WS_H3 = WS_H1;
constexpr size_t WS_H2B = WS_MB;

DI unsigned pk2(float lo, float hi) {
    typedef __bf16 bf2 __attribute__((ext_vector_type(2)));
    f32x2 v = {lo, hi};
    bf2 b = __builtin_convertvector(v, bf2);
    return __builtin_bit_cast(unsigned, b);
}
DI float bflo(unsigned w) { return __uint_as_float(w << 16); }
DI float bfhi(unsigned w) { return __uint_as_float(w & 0xffff0000u); }
DI float bf1(bf16_t b) { return __uint_as_float(((unsigned)b) << 16); }
DI float fexp(float x) { return __expf(x); }
DI float sigmoidf_(float x) { return __builtin_amdgcn_rcpf(1.0f + __expf(-x)); }
DI float siluf_(float x) { return x * sigmoidf_(x); }
DI float logsigmoidf_(float z) { return fminf(z, 0.f) - __logf(1.0f + __expf(-fabsf(z))); }
DI u32x4 pk8(f32x4 a, f32x4 b) { u32x4 o; o.x = pk2(a.x, a.y); o.y = pk2(a.z, a.w); o.z = pk2(b.x, b.y); o.w = pk2(b.z, b.w); return o; }
DI f32x4 bf4lo(u32x4 w) { return (f32x4){bflo(w.x), bfhi(w.x), bflo(w.y), bfhi(w.y)}; }
DI f32x4 bf4hi(u32x4 w) { return (f32x4){bflo(w.z), bfhi(w.z), bflo(w.w), bfhi(w.w)}; }
DI float wave_sum(float v) {
#pragma unroll
    for (int o = 1; o < 64; o <<= 1) v += __shfl_xor(v, o);
    return v;
}
DI int lane_id() { int l; asm volatile("v_mbcnt_lo_u32_b32 %0, -1, 0\n\tv_mbcnt_hi_u32_b32 %0, -1, %0" : "=v"(l)); return l; }
#define LDS_WAIT() asm volatile("s_waitcnt lgkmcnt(0)" ::: "memory")
#define VM_WAIT() asm volatile("s_waitcnt vmcnt(0)" ::: "memory")

struct Params {
    const float *x_prompt, *x_sample, *state_gla, *state_pool, *state_conv, *p_prompt, *p_sample;
    const float *norm_mix, *w_in, *w_gate_up, *b_gate, *gla_norm, *w_branch_a, *w_pool, *pool_scale, *w_branch_b, *w_out, *norm_ffn, *w_up, *conv_w, *conv_b,
        *w_down, *norm_ple, *w_ple_gate, *w_ple, *norm_final;
    float* out; unsigned char* ws;
    int ph_lo, ph_hi;
};

constexpr int NWAVES = 8, NTHREADS = 512;
constexpr int LDS_BYTES = 163840;
constexpr int LDS_XCH = 131072;
constexpr int LDS_MISC = LDS_BYTES - 256;

namespace g8 {
constexpr int BM = 256, BK = 64, HALF = 128, HTB = HALF * BK * 2, STAGE_BYTES = 8 * HTB, NXCD = 8, WGM = 2;
DI int lds_byte(int r, int c) { const int st = (r >> 4) * 2 + (c >> 5), rr = r & 15, cc = c & 31, ob = rr * 64 + cc * 2; return st * 1024 + (ob ^ (((ob >> 9) & 1) << 5)); }
DI void stage_rc(int b, int& R, int& C) { const int st = b / 1024, sb = b % 1024, swz = sb ^ (((sb >> 9) & 1) << 5); R = (st >> 1) * 16 + swz / 64; C = (st & 1) * 32 + (swz % 64) / 2; }
DI int perm32(int rho) { const int n = rho >> 4, i = rho & 15; return 8 * (i >> 2) + 4 * n + (i & 3); }

struct Unit { const char* A; const char* B; int pm, pn; };

DI bool grid_order(int nM, int nN, int G, int c, int i, int& pm, int& pn) {
    const int nwg = nM * nN; const long L = (long)i * G + c; if (L >= nwg) return false;
    int wgid = (int)L; { const int q = nwg / NXCD, r = nwg % NXCD, xcd = wgid % NXCD, off = wgid / NXCD; wgid = (xcd < r ? xcd * (q + 1) : r * (q + 1) + (xcd - r) * q) + off; }
    const int nig = WGM * nN, gid = wgid / nig, fm = gid * WGM, gsz = (nM - fm) < WGM ? (nM - fm) : WGM;
    pm = fm + ((wgid % nig) % gsz); pn = (wgid % nig) / gsz; return true;
}

template <class P, bool ALIGN_EPI, bool SP2>
DI void run(LAS unsigned char* lds, const P& ph, int wid) {
    const int lane = lane_id(), tid = wid * 64 + lane, wr = wid >> 2, wc = wid & 3, fr = lane & 15, fq = lane >> 4;
    constexpr int nt = P::KT;
    unsigned voffA[2], voffB[2];
#pragma unroll
    for (int i = 0; i < 2; ++i) { int R, C; stage_rc(tid * 16 + i * 8192, R, C); const int Rb = (R & ~31) + perm32(R & 31);
        voffA[i] = (unsigned)(R * P::LDA + C) * 2u; voffB[i] = (unsigned)(Rb * P::LDB + C) * 2u; }
    constexpr size_t kstep = (size_t)(BK * 2);
    constexpr size_t hstepA = (size_t)HALF * P::LDA * 2, hstepB = (size_t)HALF * P::LDB * 2;
    const unsigned ldsw = (unsigned)wid * 1024u;
    const int aoff = lds_byte(wr * 64 + fr, fq * 8), boff = lds_byte(wc * 32 + fr, fq * 8);
#define G8_SA(b, h) (((b) * 2 + (h)) * HTB)
#define G8_SB(b, h) ((4 + (b) * 2 + (h)) * HTB)
#define G8_STAGE(bufoff, gbase, voff) do { _Pragma("unroll") for (int _i = 0; _i < 2; ++_i) \
        __builtin_amdgcn_global_load_lds((const unsigned*)((const char*)(gbase) + (voff)[_i]), (LAS unsigned*)(lds + (bufoff) + ldsw + _i * 8192), 16, 0, 0); } while (0)
#define G8_LDA(dst, b, h) do { _Pragma("unroll") for (int m = 0; m < 4; ++m) _Pragma("unroll") for (int k = 0; k < 2; ++k) dst[m][k] = *(const LAS bf16x8*)(lds + G8_SA(b, h) + aoff + m * 2048 + k * 1024); } while (0)
#define G8_LDB(dst, b, h) do { _Pragma("unroll") for (int n = 0; n < 2; ++n) _Pragma("unroll") for (int k = 0; k < 2; ++k) dst[n][k] = *(const LAS bf16x8*)(lds + G8_SB(b, h) + boff + n * 2048 + k * 1024); } while (0)
#define G8_MMA(ai, bj, At, Bt) do { __builtin_amdgcn_s_setprio(1); _Pragma("unroll") for (int m = 0; m < 4; ++m) _Pragma("unroll") for (int n = 0; n < 2; ++n) _Pragma("unroll") for (int k = 0; k < 2; ++k) \
        acc[ai][bj][m][n] = __builtin_amdgcn_mfma_f32_16x16x32_bf16(Bt[n][k], At[m][k], acc[ai][bj][m][n], 0, 0, 0); __builtin_amdgcn_s_setprio(0); } while (0)
#define G8_WAIT_V(n) asm volatile("s_waitcnt vmcnt(" #n ")" ::: "memory")
#define G8_WAIT_L(n) asm volatile("s_waitcnt lgkmcnt(" #n ")" ::: "memory")
#define G8_BAR __builtin_amdgcn_s_barrier()
#define G8_SCHED __builtin_amdgcn_sched_barrier(0)
    Unit cur, nxt; int ui = 0;
    if (!ph.next(0, cur)) return;
    f32x4 acc[2][2][4][2];
#pragma unroll
    for (int a = 0; a < 2; ++a)
#pragma unroll
        for (int b = 0; b < 2; ++b)
#pragma unroll
            for (int m = 0; m < 4; ++m)
#pragma unroll
                for (int n = 0; n < 2; ++n) acc[a][b][m][n] = (f32x4){0.f, 0.f, 0.f, 0.f};
    bf16x8 At[4][2], B0[2][2], B1[2][2];
    const char* cA = cur.A; const char* cB = cur.B;
    if constexpr (SP2) {
        G8_STAGE(G8_SB(0, 0), cB, voffB); G8_STAGE(G8_SB(0, 1), cB + hstepB, voffB); G8_STAGE(G8_SA(0, 0), cA, voffA); G8_STAGE(G8_SA(0, 1), cA + hstepA, voffA);
        if (wr == 1) G8_BAR;
        G8_WAIT_V(2); G8_BAR;
        G8_STAGE(G8_SB(1, 0), cB + kstep, voffB); G8_STAGE(G8_SA(1, 0), cA + kstep, voffA); G8_STAGE(G8_SB(1, 1), cB + hstepB + kstep, voffB);
        G8_WAIT_V(6); G8_BAR;
    } else {
        G8_STAGE(G8_SB(0, 0), cB, voffB); G8_STAGE(G8_SA(0, 0), cA, voffA); G8_STAGE(G8_SB(0, 1), cB + hstepB, voffB); G8_STAGE(G8_SA(0, 1), cA + hstepA, voffA);
        if (wr == 1) G8_BAR;
        G8_WAIT_V(4); G8_BAR;
        G8_STAGE(G8_SB(1, 0), cB + kstep, voffB); G8_STAGE(G8_SA(1, 0), cA + kstep, voffA); G8_STAGE(G8_SB(1, 1), cB + hstepB + kstep, voffB);
        G8_WAIT_V(6); G8_BAR;
    }
    for (;;) {
        const bool has_next = ph.next(ui + 1, nxt);
        const char* nA = has_next ? nxt.A : cA; const char* nB = has_next ? nxt.B : cB;
#pragma unroll 1
        for (int t = 0; t < nt; t += 2) {
            const bool last = (t == nt - 2);
            const char* a1 = cA + (size_t)(t + 1) * kstep;
            const char* a2 = last ? nA : cA + (size_t)(t + 2) * kstep; const char* b2 = last ? nB : cB + (size_t)(t + 2) * kstep;
            const char* a3 = a2 + kstep; const char* b3 = b2 + kstep;
            if constexpr (SP2) {
            G8_LDB(B0, 0, 0); G8_LDB(B1, 0, 1); G8_SCHED; G8_LDA(At, 0, 0); G8_STAGE(G8_SA(1, 1), a1 + hstepA, voffA);
            G8_WAIT_V(8); G8_WAIT_L(0); G8_BAR; G8_MMA(0, 0, At, B0); G8_MMA(0, 1, At, B1); G8_BAR; G8_SCHED;
            G8_LDA(At, 0, 1); G8_STAGE(G8_SB(0, 0), b2, voffB); G8_STAGE(G8_SB(0, 1), b2 + hstepB, voffB); G8_STAGE(G8_SA(0, 0), a2, voffA);
            G8_WAIT_V(8); G8_WAIT_L(0); G8_BAR; G8_MMA(1, 0, At, B0); G8_MMA(1, 1, At, B1); G8_BAR; G8_SCHED;
            G8_LDB(B0, 1, 0); G8_LDB(B1, 1, 1); G8_SCHED; G8_LDA(At, 1, 0); G8_STAGE(G8_SA(0, 1), a2 + hstepA, voffA);
            G8_WAIT_V(8); G8_WAIT_L(0); G8_BAR; G8_MMA(0, 0, At, B0); G8_MMA(0, 1, At, B1); G8_BAR; G8_SCHED;
            G8_LDA(At, 1, 1); G8_STAGE(G8_SB(1, 0), b3, voffB); G8_STAGE(G8_SB(1, 1), b3 + hstepB, voffB); G8_STAGE(G8_SA(1, 0), a3, voffA);
            G8_WAIT_V(8); G8_WAIT_L(0); G8_BAR; G8_MMA(1, 0, At, B0); G8_MMA(1, 1, At, B1); G8_BAR; G8_SCHED;
            } else {
            G8_LDB(B0, 0, 0); G8_SCHED; G8_LDA(At, 0, 0); G8_STAGE(G8_SA(1, 1), a1 + hstepA, voffA);
            G8_WAIT_L(8); G8_BAR; G8_WAIT_L(0); G8_MMA(0, 0, At, B0); G8_BAR; G8_SCHED;
            G8_LDB(B1, 0, 1); G8_STAGE(G8_SB(0, 0), b2, voffB);
            G8_BAR; G8_WAIT_L(0); G8_MMA(0, 1, At, B1); G8_BAR;
            G8_LDA(At, 0, 1); G8_STAGE(G8_SA(0, 0), a2, voffA);
            G8_BAR; G8_WAIT_L(0); G8_MMA(1, 0, At, B0); G8_BAR; G8_SCHED;
            G8_STAGE(G8_SB(0, 1), b2 + hstepB, voffB);
            G8_WAIT_V(6); G8_BAR; G8_MMA(1, 1, At, B1); G8_BAR;
            G8_LDB(B0, 1, 0); G8_SCHED; G8_LDA(At, 1, 0); G8_STAGE(G8_SA(0, 1), a2 + hstepA, voffA);
            G8_WAIT_L(8); G8_BAR; G8_WAIT_L(0); G8_MMA(0, 0, At, B0); G8_BAR; G8_SCHED;
            G8_LDB(B1, 1, 1); G8_STAGE(G8_SB(1, 0), b3, voffB);
            G8_BAR; G8_WAIT_L(0); G8_MMA(0, 1, At, B1); G8_BAR;
            G8_LDA(At, 1, 1); G8_STAGE(G8_SA(1, 0), a3, voffA);
            G8_BAR; G8_WAIT_L(0); G8_MMA(1, 0, At, B0); G8_BAR; G8_SCHED;
            G8_STAGE(G8_SB(1, 1), b3 + hstepB, voffB);
            G8_WAIT_V(6); G8_BAR; G8_MMA(1, 1, At, B1); G8_BAR;
            }
        }
        if constexpr (ALIGN_EPI) { if (wr == 0) G8_BAR; }
        ph.epi(acc, cur, wr, wc, fr, fq);
        if (!has_next) break;
#pragma unroll
        for (int a = 0; a < 2; ++a)
#pragma unroll
            for (int b = 0; b < 2; ++b)
#pragma unroll
                for (int m = 0; m < 4; ++m)
#pragma unroll
                    for (int n = 0; n < 2; ++n) acc[a][b][m][n] = (f32x4){0.f, 0.f, 0.f, 0.f};
        cur = nxt; cA = nA; cB = nB; ++ui;
        if constexpr (ALIGN_EPI) { if (wr == 1) G8_BAR; }
    }
    G8_WAIT_V(0);
    if constexpr (!ALIGN_EPI) { if (wr == 0) G8_BAR; }
    G8_BAR;
#undef G8_SA
#undef G8_SB
#undef G8_STAGE
#undef G8_LDA
#undef G8_LDB
#undef G8_MMA
#undef G8_WAIT_V
#undef G8_WAIT_L
#undef G8_BAR
#undef G8_SCHED
}
}

struct TJob { const float* src; bf16_t* dst; const float* gain; int K, Nsrc, Ndst, map, nitems; };

DI int map_col(int map, int n0) {
    if (map == 1) return n0 + (n0 >= 6144 ? 16 : 0);
    if (map == 2) { const int t = n0 >> 8, r = n0 & 255; return (r < 128) ? 128 * t + r : DFF + 128 * t + (r - 128); }
    return n0;
}
constexpr int TR_SCR = 64 * 65 * 4;
static_assert(8 * TR_SCR <= LDS_MISC, "transpose scratch must stay below the barrier words");
DI void p0_transpose_item(const TJob& J, LAS float* scr, int item, int lane) {
    const int nblk = J.Ndst / 64, kb = item / nblk, nb = item % nblk, k0 = 64 * kb, n0 = 64 * nb, ns0 = map_col(J.map, n0);
    const float* src = J.src + (size_t)(k0 + (lane >> 4)) * J.Nsrc + ns0 + 4 * (lane & 15);
    f32x4 v[16];
#pragma unroll
    for (int i = 0; i < 16; ++i) v[i] = *(const f32x4*)(src + (size_t)(4 * i) * J.Nsrc);
    if (J.gain) {
#pragma unroll
        for (int i = 0; i < 16; ++i) v[i] *= J.gain[k0 + 4 * i + (lane >> 4)];
    }
#pragma unroll
    for (int i = 0; i < 16; ++i) { LAS float* d = scr + (4 * i + (lane >> 4)) * 65 + 4 * (lane & 15); d[0] = v[i].x; d[1] = v[i].y; d[2] = v[i].z; d[3] = v[i].w; }
    LDS_WAIT(); asm volatile("" ::: "memory");
    const int c = lane & 7;
#pragma unroll
    for (int j = 0; j < 8; ++j) { const int n = (lane >> 3) + 8 * j; const LAS float* s = scr + (8 * c) * 65 + n;
        u32x4 o; o.x = pk2(s[0 * 65], s[1 * 65]); o.y = pk2(s[2 * 65], s[3 * 65]); o.z = pk2(s[4 * 65], s[5 * 65]); o.w = pk2(s[6 * 65], s[7 * 65]);
        *(u32x4*)(J.dst + (size_t)(n0 + n) * J.K + k0 + 8 * c) = o; }
    LDS_WAIT(); asm volatile("" ::: "memory");
}
DI void p0_wps_item(const Params& p, bf16_t* WPS, int item, int lane) {
    const size_t e = (size_t)item * 512 + lane * 8; const float* src = p.w_pool + e;
    const f32x4 a = *(const f32x4*)src, b = *(const f32x4*)(src + 4);
    u32x4 o; o.x = pk2(a.x, a.y); o.y = pk2(a.z, a.w); o.z = pk2(b.x, b.y); o.w = pk2(b.z, b.w);
    *(u32x4*)(WPS + e) = o;
}
DI void p0_plb_item(const Params& p, bf16_t* PLB, int item, int lane) {
    const size_t e = (size_t)item * 512 + lane * 8; const size_t row = e / PLE;
    const float* src = (row < MP) ? p.p_prompt + e : p.p_sample + (e - (size_t)MP * PLE);
    const f32x4 a = *(const f32x4*)src, b = *(const f32x4*)(src + 4);
    u32x4 o; o.x = pk2(a.x, a.y); o.y = pk2(a.z, a.w); o.z = pk2(b.x, b.y); o.w = pk2(b.z, b.w);
    *(u32x4*)(PLB + e) = o;
}

DI void p0_xprep_unit(const Params& p, LAS unsigned char* lds, int u, int wave) {
    const int lane = lane_id(), tid = wave * 64 + lane;
    unsigned char* ws = p.ws;
    bf16_t* XB = (bf16_t*)(ws + WS_XB); float* RSTD1 = (float*)(ws + WS_RSTD1); float* BCUM = (float*)(ws + WS_BCUM); float* LAM = (float*)(ws + WS_LAM);
    LAS unsigned char* WG = lds; LAS float* GL = (LAS float*)(lds + 65536); LAS float* RS = (LAS float*)(lds + 69632);
    {   f32x4 w[16]; float gk[16];
#pragma unroll
        for (int i = 0; i < 16; ++i) { const int idx = tid + 512 * i, k = idx >> 2, n4 = idx & 3; w[i] = *(const f32x4*)(p.w_in + (size_t)k * INW + 6144 + 4 * n4); gk[i] = p.norm_mix[k]; }
#pragma unroll
        for (int i = 0; i < 16; ++i) { const int idx = tid + 512 * i, k = idx >> 2, n4 = idx & 3; LAS bf16_t* d = (LAS bf16_t*)(WG + (size_t)((k >> 3) * 16 + 4 * n4) * 16) + (k & 7);
            const unsigned a = pk2(w[i].x * gk[i], w[i].y * gk[i]), b = pk2(w[i].z * gk[i], w[i].w * gk[i]);
            d[0] = (bf16_t)(a & 0xffffu); d[8] = (bf16_t)(a >> 16); d[16] = (bf16_t)(b & 0xffffu); d[24] = (bf16_t)(b >> 16); }
    }
    __syncthreads();
    if (wave < 4) {
        const int fr = lane & 15, fq = lane >> 4; const int row = 64 * u + 16 * wave + fr;
        const float* xr = (row < MP) ? p.x_prompt + (size_t)row * D : p.x_sample + (size_t)(row - MP) * D;
        f32x4 acc = {0.f, 0.f, 0.f, 0.f}; float ss = 0.f;
#pragma unroll 1
        for (int s0 = 0; s0 < 64; s0 += 8) {
            f32x4 xa[8], xb[8];
#pragma unroll
            for (int i = 0; i < 8; ++i) { xa[i] = *(const f32x4*)(xr + 32 * (s0 + i) + 8 * fq); xb[i] = *(const f32x4*)(xr + 32 * (s0 + i) + 8 * fq + 4); }
#pragma unroll
            for (int i = 0; i < 8; ++i) { const int s = s0 + i; const f32x4 a = xa[i], b = xb[i];
                ss += (a.x * a.x + a.y * a.y) + (a.z * a.z + a.w * a.w) + (b.x * b.x + b.y * b.y) + (b.z * b.z + b.w * b.w);
                u32x4 o; o.x = pk2(a.x, a.y); o.y = pk2(a.z, a.w); o.z = pk2(b.x, b.y); o.w = pk2(b.z, b.w);
                *(u32x4*)(XB + (size_t)row * D + 32 * s + 8 * fq) = o;
                const bf16x8 af = __builtin_bit_cast(bf16x8, o);
                const bf16x8 bfr = *(const LAS bf16x8*)(WG + (size_t)((4 * s + fq) * 16 + fr) * 16);
                acc = __builtin_amdgcn_mfma_f32_16x16x32_bf16(af, bfr, acc, 0, 0, 0); }
        }
        ss += __shfl_xor(ss, 16); ss += __shfl_xor(ss, 32);
        const float rstd = 1.0f / sqrtf(ss * (1.0f / D) + EPS);
        if (fq == 0) { RS[16 * wave + fr] = rstd; RSTD1[row] = rstd; ((float*)(ws + WS_RS1))[row] = 0.f; }
        LDS_WAIT(); asm volatile("" ::: "memory");
#pragma unroll
        for (int j = 0; j < 4; ++j) { const int tl = 16 * wave + 4 * fq + j; GL[tl * 16 + fr] = acc[j] * RS[tl]; }
    }
    __syncthreads();
    const bool sample = (u >= MP / 64);
#pragma unroll 1
    for (int cc = 0; cc < 2; ++cc) {
        const int c = tid + 512 * cc; float wg[16];
#pragma unroll
        for (int j = 0; j < 16; ++j) wg[j] = p.w_gate_up[j * KW + c];
        const float bg = p.b_gate[c]; float cum = 0.f;
#pragma unroll 2
        for (int t = 0; t < 64; ++t) {
            const f32x4 g0 = *(const LAS f32x4*)(GL + t * 16), g1 = *(const LAS f32x4*)(GL + t * 16 + 4), g2 = *(const LAS f32x4*)(GL + t * 16 + 8), g3 = *(const LAS f32x4*)(GL + t * 16 + 12);
            float z = bg;
            z += g0.x * wg[0] + g0.y * wg[1] + g0.z * wg[2] + g0.w * wg[3];
            z += g1.x * wg[4] + g1.y * wg[5] + g1.z * wg[6] + g1.w * wg[7];
            z += g2.x * wg[8] + g2.y * wg[9] + g2.z * wg[10] + g2.w * wg[11];
            z += g3.x * wg[12] + g3.y * wg[13] + g3.z * wg[14] + g3.w * wg[15];
            const float gl = logsigmoidf_(z) * (1.0f / 16.0f);
            const int row = 64 * u + t;
            if (sample) { BCUM[(size_t)row * KW + c] = 0.f; LAM[(size_t)(NCHK + row - MP) * KW + c] = __expf(gl); }
            else { cum = ((t & (CH - 1)) == 0) ? gl : cum + gl; BCUM[(size_t)row * KW + c] = cum; if ((t & (CH - 1)) == CH - 1) LAM[(size_t)(row / CH) * KW + c] = __expf(cum); }
        }
    }
    __syncthreads();
}

constexpr int NXPREP = M / 64;
DI void phase_p0(const Params& p, LAS unsigned char* lds, int wave) {
    const int lane = lane_id();
    unsigned char* ws = p.ws;
#ifndef P0_REP
#define P0_REP 0
#endif
    const int G = gridDim.x, c = blockIdx.x; const bool has_unit = c < NXPREP;
    const int nx = (G < NXPREP) ? G : NXPREP, W_OTHER = 3;
    const int nslots_total = nx * NWAVES + (G - nx) * NWAVES * W_OTHER;
    const int my_n = has_unit ? 1 : W_OTHER;
    const int my_first = has_unit ? c * NWAVES + wave : nx * NWAVES + ((c - nx) * NWAVES + wave) * W_OTHER;
    if (has_unit) { for (int u = c; u < NXPREP; u += G) p0_xprep_unit(p, lds, u, wave); if (P0_REP & 1) p0_xprep_unit(p, lds, c, wave); }
    TJob J[8];
    J[0] = TJob{p.w_in, (bf16_t*)(ws + WS_WIN), p.norm_mix, D, INW, NIN, 1, (D / 64) * (NIN / 64)};
    J[1] = TJob{p.w_up, (bf16_t*)(ws + WS_WUP), p.norm_ffn, D, NUP, NUP, 2, (D / 64) * (NUP / 64)};
    J[2] = TJob{p.w_down, (bf16_t*)(ws + WS_WD), nullptr, DFF, D, D, 0, (DFF / 64) * (D / 64)};
    J[3] = TJob{p.w_branch_a, (bf16_t*)(ws + WS_WA), p.gla_norm, D, D, D, 0, (D / 64) * (D / 64)};
    J[4] = TJob{p.w_out, (bf16_t*)(ws + WS_WO), nullptr, D, D, D, 0, (D / 64) * (D / 64)};
    J[5] = TJob{p.w_ple_gate, (bf16_t*)(ws + WS_WPG), p.norm_ple, D, D, D, 0, (D / 64) * (D / 64)};
    J[6] = TJob{p.w_ple, (bf16_t*)(ws + WS_WPLE), nullptr, PLE, D, D, 0, (PLE / 64) * (D / 64)};
    J[7] = TJob{p.w_branch_b, (bf16_t*)(ws + WS_WBT), p.pool_scale, POOLW, D, D, 0, (POOLW / 64) * (D / 64)};
    LAS float* scr = (LAS float*)(lds + wave * TR_SCR);
    for (int rep = 0; rep < ((P0_REP & 2) ? 2 : 1); ++rep) {
    int base = 0;
#pragma unroll
    for (int j = 0; j < 8; ++j) {
        const int n = J[j].nitems;
        for (int k = 0; k < my_n; ++k) {
            int it = (my_first + k) - (base % nslots_total); if (it < 0) it += nslots_total;
            for (; it < n; it += nslots_total) p0_transpose_item(J[j], scr, it, lane);
        }
        base += n;
    }
    }
    for (int k = 0; k < my_n; ++k) {
        for (int it = my_first + k; it < (POOLW * 256) / 512; it += nslots_total) p0_wps_item(p, (bf16_t*)(ws + WS_WPS), it, lane);
        for (int it = my_first + k; it < (M * PLE) / 512; it += nslots_total) p0_plb_item(p, (bf16_t*)(ws + WS_PLB), it, lane);
    }
}

#define MFMA32(a, b, c) __builtin_amdgcn_mfma_f32_32x32x16_bf16((a), (b), (c), 0, 0, 0)
typedef LAS s16x4* lds_s16x4_p;
DI s16x4 tr_read(LAS unsigned char* a) { return __builtin_amdgcn_ds_read_tr16_b64_v4i16((lds_s16x4_p)a); }
DI bf16x8 cat8(s16x4 lo, s16x4 hi) { return __builtin_shufflevector(lo, hi, 0, 1, 2, 3, 4, 5, 6, 7); }
DI bf16x8 ld_perm(const bf16_t* p) {
    const u32x2 a = *(const u32x2*)p, b = *(const u32x2*)(p + 8);
    u32x4 r; r.x = a.x; r.y = a.y; r.z = b.x; r.w = b.y; return __builtin_bit_cast(bf16x8, r);
}
template <int S> DI bf16x8 pack_step(const f32x16& x) {
    u32x4 r; r.x = pk2(x[8 * S + 0], x[8 * S + 1]); r.y = pk2(x[8 * S + 2], x[8 * S + 3]); r.z = pk2(x[8 * S + 4], x[8 * S + 5]); r.w = pk2(x[8 * S + 6], x[8 * S + 7]);
    return __builtin_bit_cast(bf16x8, r);
}
DI f32x16 zero16() { f32x16 z;
#pragma unroll
    for (int i = 0; i < 16; ++i) z[i] = 0.f; return z; }

constexpr int SC_BUF = 50176, SC_QI = 0, SC_KI = 16384, SC_VI = 32768, SC_LMI = 49152, SC_ATT = 3 * SC_BUF, SC_BYTES = SC_ATT + 2048;
static_assert(SC_BYTES <= LDS_MISC, "scan LDS map");
DI void dma16(const void* g, LAS unsigned char* l) { __builtin_amdgcn_global_load_lds((const unsigned*)g, (LAS unsigned*)l, 16, 0, 0); }
DI bf16x8 lds_perm(LAS unsigned char* a) {
    const u32x2 x = *(const LAS u32x2*)a, y = *(const LAS u32x2*)(a + 512);
    u32x4 r; r.x = x.x; r.y = x.y; r.z = y.x; r.w = y.y; return __builtin_bit_cast(bf16x8, r);
}
#define SC_BAR() do { asm volatile("s_waitcnt lgkmcnt(0)" ::: "memory"); __builtin_amdgcn_s_barrier(); asm volatile("" ::: "memory"); } while (0)
DI void scan_block(const Params& p, LAS unsigned char* lds, int task, int wave) {
    unsigned char* ws = p.ws;
    const bf16_t* QB = (const bf16_t*)(ws + WS_QB); const bf16_t* KB = (const bf16_t*)(ws + WS_KB);
    const bf16_t* V = (const bf16_t*)(ws + WS_V); bf16_t* OG = (bf16_t*)(ws + WS_OG);
    const float* LAM = (const float*)(ws + WS_LAM); float* OSS = (float*)(ws + WS_OSS);
    const int half = task & 1, hd = (task >> 1) & 3, b = task >> 3, sl = 8 * half + wave;
    f32x16 S[8];
#pragma unroll
    for (int db = 0; db < 8; ++db) S[db] = zero16();

#define SC_ISSUE(ch_, slot_) do { const int _l = lane_id(); const size_t _r0 = (size_t)(b * SEQ + CH * (ch_)); LAS unsigned char* _lb = lds + (slot_) * SC_BUF; asm volatile("" : "+s"(_lb)); \
        _Pragma("unroll") for (int _k = 0; _k < 2; ++_k) { const int _i = 2 * wave + _k; \
            const int _row = _l & 31, _cc = 2 * _i + (_l >> 5); \
            dma16(QB + (_r0 + _row) * KW + hd * 256 + 8 * _cc, _lb + SC_QI + _i * 1024); \
            const int _s = 2 * _i + (_l >> 5), _c2 = (_l & 31) ^ (4 * (_s & 3)); \
            dma16(KB + (_r0 + _s) * KW + hd * 256 + 8 * _c2, _lb + SC_KI + _i * 1024); dma16(V + (_r0 + _s) * VW + hd * 512 + 256 * half + 8 * _c2, _lb + SC_VI + _i * 1024); } \
        if (wave == 0) dma16(LAM + (size_t)(b * (SEQ / CH) + (ch_)) * KW + hd * 256 + 4 * _l, _lb + SC_LMI); } while (0)
    constexpr int NCH = SEQ / CH;
    SC_ISSUE(0, 0); SC_ISSUE(1, 1);
    int slot = 0;
#pragma unroll 1
    for (int ch = 0; ch < NCH; ++ch) {
        const int row0 = b * SEQ + CH * ch;
        if (ch == 0) { if (wave == 0) asm volatile("s_waitcnt vmcnt(7)" ::: "memory"); else asm volatile("s_waitcnt vmcnt(6)" ::: "memory"); }
        else if (ch == 1) { if (wave == 0) asm volatile("s_waitcnt vmcnt(11)" ::: "memory"); else asm volatile("s_waitcnt vmcnt(10)" ::: "memory"); }
        else if (ch + 1 < NCH) { if (wave == 0) asm volatile("s_waitcnt vmcnt(15)" ::: "memory"); else asm volatile("s_waitcnt vmcnt(14)" ::: "memory"); }
        else VM_WAIT();
        SC_BAR();
        { const int s2 = (slot == 0) ? 2 : slot - 1; if (ch + 2 < NCH) SC_ISSUE(ch + 2, s2); }
        const int lane = lane_id();
        const int c = lane & 31, h = lane >> 5;
        const int i16 = lane & 15, q = i16 >> 2, pp = i16 & 3, jb = (lane >> 4) & 1;
        LAS unsigned char* buf = lds + slot * SC_BUF;
        LAS unsigned char* ATT = lds + SC_ATT;

        if (wave < 4) {
            const int si = wave >> 1, ti = wave & 1, fr = lane & 15, fq = lane >> 4;
            f32x4 a = {0.f, 0.f, 0.f, 0.f};
            LAS unsigned char* kp = buf + SC_KI + (16 * si + fr) * 512; LAS unsigned char* qp = buf + SC_QI + fq * 512 + (16 * ti + fr) * 16;
            const int kx = 4 * (fr & 3);
#pragma unroll
            for (int ks = 0; ks < 8; ++ks) a = __builtin_amdgcn_mfma_f32_16x16x32_bf16(*(const LAS bf16x8*)(kp + (((4 * ks + fq) ^ kx) * 16)), *(const LAS bf16x8*)(qp + 2048 * ks), a, 0, 0, 0);
            const int s0 = 16 * si + 4 * fq, t = 16 * ti + fr;
            u32x2 w; w.x = pk2(s0 + 0 <= t ? a[0] : 0.f, s0 + 1 <= t ? a[1] : 0.f); w.y = pk2(s0 + 2 <= t ? a[2] : 0.f, s0 + 3 <= t ? a[3] : 0.f);
            *(LAS u32x2*)(ATT + t * 64 + s0 * 2) = w;
        }
        SC_BAR();

        f32x16 o = zero16();
        LAS unsigned char* vb = buf + SC_VI + (8 * h + q) * 512 + (4 * (wave ^ q) + 2 * jb + (pp >> 1)) * 16 + (pp & 1) * 8;
        const bf16x8 vf0 = cat8(tr_read(vb), tr_read(vb + 4 * 512)), vf1 = cat8(tr_read(vb + 16 * 512), tr_read(vb + 20 * 512));
        {
            LAS unsigned char* ab = ATT + c * 64 + 16 * h;
            o = MFMA32(vf0, *(const LAS bf16x8*)ab, o);
            o = MFMA32(vf1, *(const LAS bf16x8*)(ab + 32), o);
            LAS unsigned char* qa = buf + SC_QI + c * 16 + 8 * h;
#pragma unroll
            for (int db = 0; db < 8; ++db) {
                { const bf16x8 qf = lds_perm(qa + 2048 * db); o = MFMA32(pack_step<0>(S[db]), qf, o); }
                { const bf16x8 qf = lds_perm(qa + 2048 * db + 1024); o = MFMA32(pack_step<1>(S[db]), qf, o); }
                if ((db & 3) == 3) __builtin_amdgcn_sched_barrier(0);
            }
            const int t = row0 + c;
            float ss = 0.f;
#pragma unroll
            for (int r = 0; r < 16; ++r) ss += o[r] * o[r];
            { const auto sw = __builtin_amdgcn_permlane32_swap(__float_as_uint(ss), __float_as_uint(ss), false, false); ss = __uint_as_float(sw[0]) + __uint_as_float(sw[1]); }
            if (h == 0) OSS[(size_t)t * 64 + hd * 16 + sl] = ss;
            bf16_t* og = OG + (size_t)row0 * VW + hd * 512 + 32 * sl + c * VW + 4 * h;
#pragma unroll
            for (int g = 0; g < 4; ++g) { u32x2 w; w.x = pk2(o[4 * g + 0], o[4 * g + 1]); w.y = pk2(o[4 * g + 2], o[4 * g + 3]); *(u32x2*)(og + 8 * g) = w; }
        }
        __builtin_amdgcn_sched_barrier(0);

        {
            LAS unsigned char* kbase = buf + SC_KI + (8 * h + q) * 512 + (2 * jb + (pp >> 1)) * 16 + (pp & 1) * 8;
            LAS unsigned char* lm = buf + SC_LMI + 16 * h;
#pragma unroll
            for (int db = 0; db < 8; ++db) {
                LAS unsigned char* kb = kbase + (((db & 3) ^ q) * 4) * 16 + (db >> 2) * 256;
                S[db] = MFMA32(cat8(tr_read(kb), tr_read(kb + 4 * 512)), vf0, S[db]);
                S[db] = MFMA32(cat8(tr_read(kb + 16 * 512), tr_read(kb + 20 * 512)), vf1, S[db]);
#pragma unroll
                for (int g = 0; g < 4; ++g) { const f32x4 l4 = *(const LAS f32x4*)(lm + (32 * db + 8 * g) * 4);
                    S[db][4 * g + 0] *= l4.x; S[db][4 * g + 1] *= l4.y; S[db][4 * g + 2] *= l4.z; S[db][4 * g + 3] *= l4.w; }
                if (db & 1) __builtin_amdgcn_sched_barrier(0);
            }
        }
        asm volatile("" ::: "memory");
        slot = (slot == 2) ? 0 : slot + 1;
    }
#undef SC_ISSUE
    {   const int lane = lane_id();
        const unsigned voff = (unsigned)(((lane >> 5) * 4 * DV + (lane & 31)) * 4);
        const char* gbase = (const char*)(p.out + O_GLAP + ((size_t)(b * NH + hd) * DK) * DV + 32 * sl);
#pragma unroll
        for (int db = 0; db < 8; ++db) {
#pragma unroll
            for (int r = 0; r < 16; ++r) { const int dl = 32 * db + (r & 3) + 8 * (r >> 2); *(float*)(const_cast<char*>(gbase) + (size_t)dl * DV * 4 + voff) = S[db][r]; }
        }
    }
    __syncthreads();
}

DI void sgla_task(const Params& p, int task, int lane) {
    unsigned char* ws = p.ws;
    const bf16_t* QB = (const bf16_t*)(ws + WS_QB); const bf16_t* KB = (const bf16_t*)(ws + WS_KB); const bf16_t* V = (const bf16_t*)(ws + WS_V);
    const float* LAM = (const float*)(ws + WS_LAM); float* OSP = (float*)(ws + WS_OSP);
    const int dblk = task & 7, hd = (task >> 3) & 3, b = task >> 5; const int row = MP + b;
    const size_t sbase = ((size_t)(b * NH + hd) * DK + 32 * dblk) * DV;
    const float* S0 = p.state_gla + sbase; float* So = p.out + O_GLAS + sbase;
    const int dl = lane & 31;
    const float lam_l = LAM[(size_t)(NCHK + b) * KW + hd * 256 + 32 * dblk + dl];
    const float k_l = bf1(KB[(size_t)row * KW + hd * 256 + 32 * dblk + dl]);
    const float q_l = bf1(QB[(size_t)row * KW + hd * 256 + 32 * dblk + dl]);
    f32x4 va, vb;
    { const u32x2 w = *(const u32x2*)(V + (size_t)row * VW + hd * 512 + 4 * lane); va = (f32x4){bflo(w.x), bfhi(w.x), bflo(w.y), bfhi(w.y)}; }
    { const u32x2 w = *(const u32x2*)(V + (size_t)row * VW + hd * 512 + 256 + 4 * lane); vb = (f32x4){bflo(w.x), bfhi(w.x), bflo(w.y), bfhi(w.y)}; }
    f32x4 oa = {0.f, 0.f, 0.f, 0.f}, ob = {0.f, 0.f, 0.f, 0.f};
#pragma unroll 1
    for (int d0 = 0; d0 < 32; d0 += 16) {
        f32x4 ra[16], rb[16];
#pragma unroll
        for (int i = 0; i < 16; ++i) { ra[i] = __builtin_nontemporal_load((const f32x4*)(S0 + (size_t)(d0 + i) * DV + 4 * lane)); rb[i] = __builtin_nontemporal_load((const f32x4*)(S0 + (size_t)(d0 + i) * DV + 256 + 4 * lane)); }
#pragma unroll
        for (int i = 0; i < 16; ++i) { const int d = d0 + i;
            const float lam = __uint_as_float(__builtin_amdgcn_readlane(__float_as_uint(lam_l), d)), kk = __uint_as_float(__builtin_amdgcn_readlane(__float_as_uint(k_l), d)), qq = __uint_as_float(__builtin_amdgcn_readlane(__float_as_uint(q_l), d));
            const f32x4 sa = ra[i] * lam + va * kk, sb = rb[i] * lam + vb * kk;
            __builtin_nontemporal_store(sa, (f32x4*)(So + (size_t)d * DV + 4 * lane)); __builtin_nontemporal_store(sb, (f32x4*)(So + (size_t)d * DV + 256 + 4 * lane));
            oa += sa * qq; ob += sb * qq; }
    }
    float* op = OSP + ((size_t)(b * NH + hd) * 8 + dblk) * DV;
    *(f32x4*)(op + 4 * lane) = oa; *(f32x4*)(op + 256 + 4 * lane) = ob;
}

DI void pmix_task(const Params& p, int t, int lane) {
    unsigned char* ws = p.ws;
    const float* U = (const float*)(ws + WS_U); bf16_t* PM = (bf16_t*)(ws + WS_PM);
    if (t < MP) {
        const int b = t >> 11, pos = t & 2047;
#pragma unroll
        for (int i = 0; i < 4; ++i) {
            const int w = 2 << i, c = 256 * i + 4 * lane; const int cnt = (pos + 1 < w) ? pos + 1 : w;
            const f32x4 u0 = *(const f32x4*)(U + (size_t)t * POOLW + c); f32x4 s = u0;
#pragma unroll
            for (int j = 1; j < w; ++j) {
                const bool in = j < cnt; const f32x4 v = *(const f32x4*)(U + (size_t)(in ? t - j : t) * POOLW + c); const float m = in ? 1.f : 0.f; s += v * m; }
            const float inv = 1.0f / (float)cnt; const f32x4 mx = s * inv - u0;
            u32x2 o; o.x = pk2(mx.x, mx.y); o.y = pk2(mx.z, mx.w); *(u32x2*)(PM + (size_t)t * POOLW + c) = o;
            if (pos >= SEQ - 15) *(f32x4*)(p.out + O_POOLP + ((size_t)b * 15 + (pos - (SEQ - 15))) * POOLW + c) = u0;
        }
    } else {
        const int b = t - MP; const float* sp = p.state_pool + (size_t)b * 15 * POOLW; float* po = p.out + O_POOLS + (size_t)b * 15 * POOLW;
#pragma unroll
        for (int i = 0; i < 4; ++i) {
            const int w = 2 << i, c = 256 * i + 4 * lane;
            const f32x4 u0 = *(const f32x4*)(U + (size_t)t * POOLW + c); f32x4 s = u0;
#pragma unroll
            for (int j = 1; j < w; ++j) s += *(const f32x4*)(sp + (size_t)(15 - j) * POOLW + c);
            const float inv = 1.0f / (float)w; const f32x4 mx = s * inv - u0;
            u32x2 o; o.x = pk2(mx.x, mx.y); o.y = pk2(mx.z, mx.w); *(u32x2*)(PM + (size_t)t * POOLW + c) = o;
            *(f32x4*)(po + (size_t)14 * POOLW + c) = u0;
        }
    }
}

DI void pool_copy_task(const Params& p, int item, int lane) {
    const int b = item / 14, r = item - 14 * b; const float* src = p.state_pool + ((size_t)b * 15 + r + 1) * POOLW + 4 * lane; float* dst = p.out + O_POOLS + ((size_t)b * 15 + r) * POOLW + 4 * lane;
    const f32x4 v0 = *(const f32x4*)src, v1 = *(const f32x4*)(src + 256), v2 = *(const f32x4*)(src + 512), v3 = *(const f32x4*)(src + 768);
    *(f32x4*)dst = v0; *(f32x4*)(dst + 256) = v1; *(f32x4*)(dst + 512) = v2; *(f32x4*)(dst + 768) = v3;
}
#ifndef P2_REP
#define P2_REP 0
#endif
DI void scan_role(const Params& p, LAS unsigned char* lds, int wave, int idx, int n) {
    for (int rep = 0; rep < ((P2_REP & 1) ? 2 : 1); ++rep) for (int task = (n == 32) ? (idx % 8) * 4 + idx / 8 : idx; task < 2 * NB * NH; task += n) scan_block(p, lds, task, wave);
}
DI void stream_role(const Params& p, int wave, int idx, int n) {
    const int lane = lane_id(); const int gw = idx * NWAVES + wave, NGW = n * NWAVES;
    for (int rep = 0; rep < ((P2_REP & 2) ? 2 : 1); ++rep) {
        for (int it = gw; it < MS * 14; it += NGW) pool_copy_task(p, it, lane);
        for (int task = gw; task < MS * NH * 8; task += NGW) sgla_task(p, task, lane); }
}

DI void ogn_task(const Params& p, int t, int lane) {
    unsigned char* ws = p.ws;
    bf16_t* OG = (bf16_t*)(ws + WS_OG); const float* OSS = (const float*)(ws + WS_OSS); const float* OSP = (const float*)(ws + WS_OSP); const bf16_t* SR = (const bf16_t*)(ws + WS_SR);
    if (t < MP) {
#pragma unroll
        for (int hd = 0; hd < 4; ++hd) {
            const float* sp = OSS + (size_t)t * 64 + hd * 16; const f32x4 a = *(const f32x4*)sp, b = *(const f32x4*)(sp + 4), c = *(const f32x4*)(sp + 8), d = *(const f32x4*)(sp + 12);
            const float ss = ((a.x + a.y) + (a.z + a.w)) + ((b.x + b.y) + (b.z + b.w)) + ((c.x + c.y) + (c.z + c.w)) + ((d.x + d.y) + (d.z + d.w));
            const float rstd = 1.0f / sqrtf(ss * (1.0f / DV) + EPS);
            bf16_t* op = OG + (size_t)t * VW + hd * 512 + 8 * lane; const u32x4 w = *(const u32x4*)op; const u32x4 g = *(const u32x4*)(SR + (size_t)t * VW + hd * 512 + 8 * lane);
            u32x4 o; o.x = pk2(bflo(w.x) * rstd * bflo(g.x), bfhi(w.x) * rstd * bfhi(g.x)); o.y = pk2(bflo(w.y) * rstd * bflo(g.y), bfhi(w.y) * rstd * bfhi(g.y));
            o.z = pk2(bflo(w.z) * rstd * bflo(g.z), bfhi(w.z) * rstd * bfhi(g.z)); o.w = pk2(bflo(w.w) * rstd * bflo(g.w), bfhi(w.w) * rstd * bfhi(g.w));
            *(u32x4*)op = o;
        }
    } else {
        const int b = t - MP;
#pragma unroll
        for (int hd = 0; hd < 4; ++hd) {
            f32x4 oa = {0.f, 0.f, 0.f, 0.f}, ob = {0.f, 0.f, 0.f, 0.f};
#pragma unroll
            for (int k = 0; k < 8; ++k) { const float* op = OSP + ((size_t)(b * NH + hd) * 8 + k) * DV + 8 * lane; oa += *(const f32x4*)op; ob += *(const f32x4*)(op + 4); }
            float ss = (oa.x * oa.x + oa.y * oa.y) + (oa.z * oa.z + oa.w * oa.w) + (ob.x * ob.x + ob.y * ob.y) + (ob.z * ob.z + ob.w * ob.w);
            ss = wave_sum(ss);
            const float rstd = 1.0f / sqrtf(ss * (1.0f / DV) + EPS);
            const u32x4 w = *(const u32x4*)(SR + (size_t)t * VW + hd * 512 + 8 * lane);
            u32x4 o; o.x = pk2(oa.x * rstd * bflo(w.x), oa.y * rstd * bfhi(w.x)); o.y = pk2(oa.z * rstd * bflo(w.y), oa.w * rstd * bfhi(w.y));
            o.z = pk2(ob.x * rstd * bflo(w.z), ob.y * rstd * bfhi(w.z)); o.w = pk2(ob.z * rstd * bflo(w.w), ob.w * rstd * bfhi(w.w));
            *(u32x4*)(OG + (size_t)t * VW + hd * 512 + 8 * lane) = o;
        }
    }
}
DI void phase_p3(const Params& p, int wave) {
    const int lane = lane_id();
    const int gw = (int)blockIdx.x * NWAVES + wave, NGW = gridDim.x * NWAVES;
    for (int t = gw; t < M; t += NGW) pmix_task(p, t, lane);
    for (int t = gw; t < M; t += NGW) ogn_task(p, t, lane);
}

DI float row_rstd(const float* SS, const float* SSs, int row, int lane) {
    float v = (row < MP) ? ((lane < 32) ? SS[(size_t)row * 32 + lane] : 0.f) : (SSs[(size_t)(row - MP) * 128 + lane] + SSs[(size_t)(row - MP) * 128 + 64 + lane]);
    v = wave_sum(v);
    return 1.0f / sqrtf(v * (1.0f / D) + EPS);
}

struct F8 { f32x4 a, b; };
DI F8 unpack8(u32x4 w, float s) { F8 r; r.a = (f32x4){bflo(w.x) * s, bfhi(w.x) * s, bflo(w.y) * s, bfhi(w.y) * s}; r.b = (f32x4){bflo(w.z) * s, bfhi(w.z) * s, bflo(w.w) * s, bfhi(w.w) * s}; return r; }
DI F8 ld8(const float* q) { F8 r; r.a = *(const f32x4*)q; r.b = *(const f32x4*)(q + 4); return r; }
DI void st8(float* q, const F8& v) { *(f32x4*)q = v.a; *(f32x4*)(q + 4) = v.b; }
DI f32x4 silu4(f32x4 x) { return (f32x4){siluf_(x.x), siluf_(x.y), siluf_(x.z), siluf_(x.w)}; }
DI void conv_fixup_tile(const Params& p, int pm, int wave) {
    if ((pm & 7) == 0) return;
    unsigned char* ws = p.ws; const int tid = wave * 64 + lane_id();
    const float* HALO = (const float*)(ws + WS_HALO) + (size_t)(pm - 1) * 2 * DFF; const float* FG = (const float*)(ws + WS_FIXG) + (size_t)pm * 2 * DFF; const float* FU = (const float*)(ws + WS_FIXU) + (size_t)pm * 2 * DFF;
    bf16_t* ACT = (bf16_t*)(ws + WS_ACT) + (size_t)pm * 256 * DFF;
    for (int v = tid; v < DFF / 8; v += NTHREADS) { const int ch0 = 8 * v;
        const F8 w0 = ld8(p.conv_w + ch0), w1 = ld8(p.conv_w + DFF + ch0), w2 = ld8(p.conv_w + 2 * DFF + ch0), cb = ld8(p.conv_b + ch0);
        const F8 h14 = ld8(HALO + ch0), h15 = ld8(HALO + DFF + ch0), g0 = ld8(FG + ch0), g1 = ld8(FG + DFF + ch0), u0 = ld8(FU + ch0), u1 = ld8(FU + DFF + ch0);
        const f32x4 a0 = silu4(cb.a + w0.a * h14.a + w1.a * h15.a + w2.a * g0.a) * u0.a, b0 = silu4(cb.b + w0.b * h14.b + w1.b * h15.b + w2.b * g0.b) * u0.b;
        const f32x4 a1 = silu4(cb.a + w0.a * h15.a + w1.a * g0.a + w2.a * g1.a) * u1.a, b1 = silu4(cb.b + w0.b * h15.b + w1.b * g0.b + w2.b * g1.b) * u1.b;
        *(u32x4*)(ACT + ch0) = pk8(a0, b0); *(u32x4*)(ACT + DFF + ch0) = pk8(a1, b1); }
}

DI void phase_final(const Params& p, int wave) {
    const int lane = lane_id();
    const int gw = (int)blockIdx.x * NWAVES + wave, NGW = gridDim.x * NWAVES;
    const bf16_t* H3 = (const bf16_t*)(p.ws + WS_H3); const float* SS3 = (const float*)(p.ws + WS_SS3); const float* SS3S = (const float*)(p.ws + WS_SS3S);
    for (int t = gw; t < M; t += NGW) {
        const float rs = row_rstd(SS3, SS3S, t, lane);
        float* yo = (t < MP) ? p.out + O_YP + (size_t)t * D : p.out + O_YS + (size_t)(t - MP) * D;
#pragma unroll
        for (int i = 0; i < 4; ++i) { const int c = 512 * i + 8 * lane; const u32x4 w = *(const u32x4*)(H3 + (size_t)t * D + c); const f32x4 g0 = *(const f32x4*)(p.norm_final + c), g1 = *(const f32x4*)(p.norm_final + c + 4);
            *(f32x4*)(yo + c) = bf4lo(w) * rs * g0; *(f32x4*)(yo + c + 4) = bf4hi(w) * rs * g1; }
    }
}

#define EPI_ARGS const f32x4 (&acc)[2][2][4][2], const g8::Unit& u, int wr, int wc, int fr, int fq
#define EPI_ROWS(ROWVAR) _Pragma("unroll") for (int ai = 0; ai < 2; ++ai) _Pragma("unroll") for (int m = 0; m < 4; ++m) { const int ROWVAR = u.pm * 256 + ai * 128 + wr * 64 + m * 16 + fr; if (ROWVAR < M) {
#define EPI_COLS(COLVAR) _Pragma("unroll") for (int bj = 0; bj < 2; ++bj) { const int COLVAR = bj * 128 + wc * 32 + 8 * fq; const f32x4 v0 = acc[ai][bj][m][0], v1 = acc[ai][bj][m][1];
#define EPI_END } } }
DI f32x4 exp4(f32x4 x) { return (f32x4){__expf(x.x), __expf(x.y), __expf(x.z), __expf(x.w)}; }
DI f32x4 sig4(f32x4 x) { return (f32x4){sigmoidf_(x.x), sigmoidf_(x.y), sigmoidf_(x.z), sigmoidf_(x.w)}; }
DI float sum4(f32x4 a) { return (a.x + a.y) + (a.z + a.w); }

struct PhaseIn {
    static constexpr int LDA = D, LDB = D, KT = D / 64;
    const Params& p; int G, c, part;
    int c0;
    DI bool next(int i, g8::Unit& u) const { int pm, pn;
        if (part == 0) { if (!g8::grid_order(NTM - 1, 16, G, c, i, pm, pn)) return false; }
        else { if (c < c0 || !g8::grid_order(NTM, 28, G - c0, c - c0, i, pm, pn)) return false; pn += 16; }
        u.pm = pm; u.pn = pn; u.A = (const char*)(p.ws + WS_XB) + (size_t)pm * 256 * D * 2; u.B = (const char*)(p.ws + WS_WIN) + (size_t)pn * 256 * D * 2; return true; }
    DI void epi(EPI_ARGS) const {
        unsigned char* ws = p.ws; const float* RSTD1 = (const float*)(ws + WS_RSTD1); const float* BCUM = (const float*)(ws + WS_BCUM);
        const int pn = u.pn;
        if (pn < 4) {
            bf16_t* QB = (bf16_t*)(ws + WS_QB);
            EPI_ROWS(row) const float rs = RSTD1[row] * 0.0625f; EPI_COLS(col) const size_t o = (size_t)row * KW + pn * 256 + col;
                const f32x4 e0 = exp4(*(const f32x4*)(BCUM + o)), e1 = exp4(*(const f32x4*)(BCUM + o + 4));
                *(u32x4*)(QB + o) = pk8(v0 * rs * e0, v1 * rs * e1); EPI_END
        } else if (pn < 8) {
            bf16_t* KB = (bf16_t*)(ws + WS_KB);
            EPI_ROWS(row) const float rs = RSTD1[row]; EPI_COLS(col) const size_t o = (size_t)row * KW + (pn - 4) * 256 + col;
                const f32x4 b0 = *(const f32x4*)(BCUM + o), b1 = *(const f32x4*)(BCUM + o + 4);
                *(u32x4*)(KB + o) = pk8(v0 * rs * exp4(-b0), v1 * rs * exp4(-b1)); EPI_END
        } else if (pn < 16) {
            bf16_t* V = (bf16_t*)(ws + WS_V);
            EPI_ROWS(row) const float rs = RSTD1[row]; EPI_COLS(col) *(u32x4*)(V + (size_t)row * VW + (pn - 8) * 256 + col) = pk8(v0 * rs, v1 * rs); EPI_END
        } else if (pn < 24) {
            bf16_t* SR = (bf16_t*)(ws + WS_SR);
            EPI_ROWS(row) const float rs = RSTD1[row]; EPI_COLS(col) const f32x4 a = v0 * rs, b = v1 * rs; *(u32x4*)(SR + (size_t)row * VW + (pn - 16) * 256 + col) = pk8(a * sig4(a), b * sig4(b)); EPI_END
        } else if (pn < 28) {
            float* U = (float*)(ws + WS_U);
            EPI_ROWS(row) const float rs = RSTD1[row]; EPI_COLS(col) float* o = U + (size_t)row * POOLW + (pn - 24) * 256 + col; *(f32x4*)o = v0 * rs; *(f32x4*)(o + 4) = v1 * rs; EPI_END
        } else {
            bf16_t* Gt = (bf16_t*)(ws + (pn < 36 ? WS_GA : WS_GB)); const int c0 = (pn < 36 ? pn - 28 : pn - 36) * 256;
            EPI_ROWS(row) const float rs = RSTD1[row]; EPI_COLS(col) *(u32x4*)(Gt + (size_t)row * D + c0 + col) = pk8(sig4(v0 * rs), sig4(v1 * rs)); EPI_END
        }
    }
};

template <int LDA_, int LDB_, int K_> struct PhaseN2048 {
    static constexpr int LDA = LDA_, LDB = LDB_, KT = K_ / 64;
    const Params& p; int G, c; size_t a_off, b_off;
    DI bool next_(int i, g8::Unit& u) const { int pm, pn; if (!g8::grid_order(NTM - 1, 8, G, c, i, pm, pn)) return false;
        u.pm = pm; u.pn = pn; u.A = (const char*)(p.ws + a_off) + (size_t)pm * 256 * LDA * 2; u.B = (const char*)(p.ws + b_off) + (size_t)pn * 256 * LDB * 2; return true; }
};
struct PhaseYb : PhaseN2048<POOLW, POOLW, POOLW> {
    DI bool next(int i, g8::Unit& u) const { return next_(i, u); }
    DI void epi(EPI_ARGS) const { const bf16_t* GB = (const bf16_t*)(p.ws + WS_GB); bf16_t* Y = (bf16_t*)(p.ws + WS_YBG);
#pragma unroll
        for (int ai = 0; ai < 2; ++ai) { u32x4 g[4][2];
#pragma unroll
            for (int m = 0; m < 4; ++m)
#pragma unroll
                for (int bj = 0; bj < 2; ++bj) g[m][bj] = *(const u32x4*)(GB + (size_t)(u.pm * 256 + ai * 128 + wr * 64 + m * 16 + fr) * D + u.pn * 256 + bj * 128 + wc * 32 + 8 * fq);
#pragma unroll
            for (int m = 0; m < 4; ++m)
#pragma unroll
                for (int bj = 0; bj < 2; ++bj) { const size_t o = (size_t)(u.pm * 256 + ai * 128 + wr * 64 + m * 16 + fr) * D + u.pn * 256 + bj * 128 + wc * 32 + 8 * fq;
                    *(u32x4*)(Y + o) = pk8(acc[ai][bj][m][0] * bf4lo(g[m][bj]), acc[ai][bj][m][1] * bf4hi(g[m][bj])); } } }
};
struct PhaseYa : PhaseN2048<VW, VW, VW> {
    DI bool next(int i, g8::Unit& u) const { return next_(i, u); }
    DI void epi(EPI_ARGS) const { const bf16_t* GA = (const bf16_t*)(p.ws + WS_GA); const bf16_t* Y = (const bf16_t*)(p.ws + WS_YBG); bf16_t* MB = (bf16_t*)(p.ws + WS_MB);
#pragma unroll
        for (int ai = 0; ai < 2; ++ai) { u32x4 g[4][2], y[4][2];
#pragma unroll
            for (int m = 0; m < 4; ++m)
#pragma unroll
                for (int bj = 0; bj < 2; ++bj) { const size_t o = (size_t)(u.pm * 256 + ai * 128 + wr * 64 + m * 16 + fr) * D + u.pn * 256 + bj * 128 + wc * 32 + 8 * fq;
                    g[m][bj] = *(const u32x4*)(GA + o); y[m][bj] = *(const u32x4*)(Y + o); }
#pragma unroll
            for (int m = 0; m < 4; ++m)
#pragma unroll
                for (int bj = 0; bj < 2; ++bj) { const size_t o = (size_t)(u.pm * 256 + ai * 128 + wr * 64 + m * 16 + fr) * D + u.pn * 256 + bj * 128 + wc * 32 + 8 * fq;
                    *(u32x4*)(MB + o) = pk8(acc[ai][bj][m][0] * bf4lo(g[m][bj]) + bf4lo(y[m][bj]), acc[ai][bj][m][1] * bf4hi(g[m][bj]) + bf4hi(y[m][bj])); } } }
};
template <bool BASE_BF16, bool ATOMIC_SS>
DI void epi_residual(EPI_ARGS, const void* base_v, bf16_t* HB, float* SS) {
#pragma unroll
    for (int ai = 0; ai < 2; ++ai)
#pragma unroll
        for (int mh = 0; mh < 2; ++mh) {
            f32x4 b0[2][2], b1[2][2];
#pragma unroll
            for (int mm = 0; mm < 2; ++mm) { const int row = u.pm * 256 + ai * 128 + wr * 64 + (2 * mh + mm) * 16 + fr;
#pragma unroll
                for (int bj = 0; bj < 2; ++bj) { const size_t o = (size_t)row * D + u.pn * 256 + bj * 128 + wc * 32 + 8 * fq;
                    if (BASE_BF16) { const u32x4 w = *(const u32x4*)((const bf16_t*)base_v + o); b0[mm][bj] = bf4lo(w); b1[mm][bj] = bf4hi(w); }
                    else { b0[mm][bj] = *(const f32x4*)((const float*)base_v + o); b1[mm][bj] = *(const f32x4*)((const float*)base_v + o + 4); } } }
#pragma unroll
            for (int mm = 0; mm < 2; ++mm) { const int m = 2 * mh + mm; const int row = u.pm * 256 + ai * 128 + wr * 64 + m * 16 + fr; float ss = 0.f;
#pragma unroll
                for (int bj = 0; bj < 2; ++bj) { const size_t o = (size_t)row * D + u.pn * 256 + bj * 128 + wc * 32 + 8 * fq;
                    const f32x4 h0 = acc[ai][bj][m][0] + b0[mm][bj], h1 = acc[ai][bj][m][1] + b1[mm][bj];
                    *(u32x4*)(HB + o) = pk8(h0, h1);
                    ss += sum4(h0 * h0) + sum4(h1 * h1); }
                ss += __shfl_xor(ss, 16); ss += __shfl_xor(ss, 32);
                if (fq == 0) { if (ATOMIC_SS) __hip_atomic_fetch_add(SS + row, ss, __ATOMIC_RELAXED, __HIP_MEMORY_SCOPE_AGENT); else SS[(size_t)row * 32 + u.pn * 4 + wc] = ss; } }
        }
}
struct PhaseOut : PhaseN2048<D, D, D> {
    DI bool next(int i, g8::Unit& u) const { return next_(i, u); }
    DI void epi(EPI_ARGS) const { epi_residual<false, true>(acc, u, wr, wc, fr, fq, p.x_prompt, (bf16_t*)(p.ws + WS_H1B), (float*)(p.ws + WS_RS1)); }
};
struct PhaseDown : PhaseN2048<DFF, DFF, DFF> {
    DI bool next(int i, g8::Unit& u) const { return next_(i, u); }
    DI void epi(EPI_ARGS) const { epi_residual<true, false>(acc, u, wr, wc, fr, fq, p.ws + WS_H1B, (bf16_t*)(p.ws + WS_H2B), (float*)(p.ws + WS_SS2)); }
};
struct PhasePe : PhaseN2048<PLE, PLE, PLE> {
    DI bool next(int i, g8::Unit& u) const { const int first = (NTM * 43) % G, nfree = G - first; if (nfree <= 0 || c < first) return false;
        const long L = (long)i * nfree + (c - first); if (L >= 256) return false; const int pm = (int)L >> 3, pn = (int)L & 7;
        u.pm = pm; u.pn = pn; u.A = (const char*)(p.ws + a_off) + (size_t)pm * 256 * LDA * 2; u.B = (const char*)(p.ws + b_off) + (size_t)pn * 256 * LDB * 2; return true; }
    DI void epi(EPI_ARGS) const { bf16_t* PE = (bf16_t*)(p.ws + WS_PE);
        EPI_ROWS(row) EPI_COLS(col) const size_t o = (size_t)row * D + u.pn * 256 + col; *(u32x4*)(PE + o) = pk8(v0, v1); EPI_END }
};
struct PhasePg : PhaseN2048<D, D, D> {
    DI bool next(int i, g8::Unit& u) const { return next_(i, u); }
    DI void epi(EPI_ARGS) const { const bf16_t* H2 = (const bf16_t*)(p.ws + WS_H2B); const bf16_t* PE = (const bf16_t*)(p.ws + WS_PE); const float* SS2 = (const float*)(p.ws + WS_SS2);
        bf16_t* H3 = (bf16_t*)(p.ws + WS_H3); float* SS3 = (float*)(p.ws + WS_SS3);
#pragma unroll
        for (int ai = 0; ai < 2; ++ai)
#pragma unroll
            for (int mh = 0; mh < 2; ++mh) { u32x4 hw[2][2], pw[2][2]; float rs[2];
#pragma unroll
                for (int mm = 0; mm < 2; ++mm) { const int row = u.pm * 256 + ai * 128 + wr * 64 + (2 * mh + mm) * 16 + fr; float s2 = 0.f;
#pragma unroll
                    for (int k = 0; k < 8; ++k) s2 += sum4(*(const f32x4*)(SS2 + (size_t)row * 32 + 4 * k));
                    rs[mm] = 1.0f / sqrtf(s2 * (1.0f / D) + EPS);
#pragma unroll
                    for (int bj = 0; bj < 2; ++bj) { const size_t o = (size_t)row * D + u.pn * 256 + bj * 128 + wc * 32 + 8 * fq; hw[mm][bj] = *(const u32x4*)(H2 + o); pw[mm][bj] = *(const u32x4*)(PE + o); } }
#pragma unroll
                for (int mm = 0; mm < 2; ++mm) { const int m = 2 * mh + mm; const int row = u.pm * 256 + ai * 128 + wr * 64 + m * 16 + fr; float ss = 0.f;
#pragma unroll
                    for (int bj = 0; bj < 2; ++bj) { const size_t o = (size_t)row * D + u.pn * 256 + bj * 128 + wc * 32 + 8 * fq;
                        const f32x4 h0 = bf4lo(hw[mm][bj]) + sig4(acc[ai][bj][m][0] * rs[mm]) * bf4lo(pw[mm][bj]), h1 = bf4hi(hw[mm][bj]) + sig4(acc[ai][bj][m][1] * rs[mm]) * bf4hi(pw[mm][bj]);
                        *(u32x4*)(H3 + o) = pk8(h0, h1); ss += sum4(h0 * h0) + sum4(h1 * h1); }
                    ss += __shfl_xor(ss, 16); ss += __shfl_xor(ss, 32);
                    if (fq == 0) SS3[(size_t)row * 32 + u.pn * 4 + wc] = ss; } } }
};
#ifndef ROR_DIR
#define ROR_DIR 0
#endif
template <int N> DI float ror16(float v) { return __uint_as_float((unsigned)__builtin_amdgcn_update_dpp(0, (int)__float_as_uint(v), 0x120 + (ROR_DIR ? 16 - N : N), 0xF, 0xF, false)); }
DI F8 shfl8(const F8& v, int src) { F8 r; r.a = (f32x4){__shfl(v.a.x, src), __shfl(v.a.y, src), __shfl(v.a.z, src), __shfl(v.a.w, src)}; r.b = (f32x4){__shfl(v.b.x, src), __shfl(v.b.y, src), __shfl(v.b.z, src), __shfl(v.b.w, src)}; return r; }
DI F8 sel8(bool c, const F8& x, const F8& y) { F8 r; r.a = c ? x.a : y.a; r.b = c ? x.b : y.b; return r; }
struct PhaseUp {
    static constexpr int LDA = D, LDB = D, KT = D / 64;
    const Params& p; int G, c; LAS unsigned char* xl;
    DI bool next(int i, g8::Unit& u) const { int pm, pn; if (!g8::grid_order(NTM, 43, G, c, i, pm, pn)) return false;
        u.pm = pm; u.pn = pn; u.A = (const char*)(p.ws + WS_H1B) + (size_t)pm * 256 * D * 2; u.B = (const char*)(p.ws + WS_WUP) + (size_t)pn * 256 * D * 2; return true; }
    DI void epi(const f32x4 (&acc)[2][2][4][2], const g8::Unit& u, int wr, int wc, int fr_, int fq_) const {
        unsigned char* ws = p.ws; bf16_t* ACT = (bf16_t*)(ws + WS_ACT); const float* RS1 = (const float*)(ws + WS_RS1);
        const int lane = lane_id(), fr = lane & 15, fq = lane >> 4;
        (void)fr_; (void)fq_;
        const int pm = u.pm, chl = 32 * wc + 8 * fq, chb = 128 * u.pn + chl;
#define UP_RR(ai_, m_) (1.0f / sqrtf(RS1[pm * 256 + (ai_) * 128 + wr * 64 + (m_) * 16 + fr] * (1.0f / D) + EPS))
        LAS float* X = (LAS float*)xl;
        if (pm == NTM - 1) {
#pragma unroll
            for (int n = 0; n < 2; ++n) { const int ch = chb + 4 * n;
                const f32x4 w0 = *(const f32x4*)(p.conv_w + ch), w1 = *(const f32x4*)(p.conv_w + DFF + ch), w2 = *(const f32x4*)(p.conv_w + 2 * DFF + ch), cb = *(const f32x4*)(p.conv_b + ch);
#pragma unroll
                for (int m = 0; m < 4; ++m) { const int row = pm * 256 + wr * 64 + m * 16 + fr, b = row - MP; const float r0 = UP_RR(0, m);
                    const f32x4 g0 = acc[0][0][m][n] * r0, up = acc[0][1][m][n] * r0;
                    const float* sc = p.state_conv + (size_t)b * 2 * DFF + ch; const f32x4 g1 = *(const f32x4*)(sc + DFF), g2 = *(const f32x4*)sc;
                    const f32x4 aa = silu4(cb + w0 * g2 + w1 * g1 + w2 * g0) * up;
                    u32x2 o; o.x = pk2(aa.x, aa.y); o.y = pk2(aa.z, aa.w); *(u32x2*)(ACT + (size_t)row * DFF + ch) = o;
                    float* co = p.out + O_CONVS + (size_t)b * 2 * DFF + ch; *(f32x4*)co = g1; *(f32x4*)(co + DFF) = g0; } }
            asm volatile("s_waitcnt lgkmcnt(0)" ::: "memory"); __builtin_amdgcn_s_barrier(); asm volatile("" ::: "memory");
            return;
        }
#pragma unroll
        for (int n = 0; n < 2; ++n) {
#pragma unroll
            for (int ai = 0; ai < 2; ++ai) if (fr >= 14) { const f32x4 g3 = acc[ai][0][3][n] * UP_RR(ai, 3);
                *(LAS f32x4*)(X + ((2 * ai + wr) * 2 + (fr - 14)) * 128 + chl + 4 * n) = g3;
                if (ai == 1 && wr == 1) { *(f32x4*)((float*)(ws + WS_HALO) + ((size_t)pm * 2 + (fr - 14)) * DFF + chb + 4 * n) = g3;
                    if ((pm & 7) == 7) *(f32x4*)(p.out + O_CONVP + ((size_t)(pm >> 3) * 2 + (fr - 14)) * DFF + chb + 4 * n) = g3; } }
            if (wr == 0 && fr < 2) { *(f32x4*)((float*)(ws + WS_FIXG) + ((size_t)pm * 2 + fr) * DFF + chb + 4 * n) = acc[0][0][0][n] * UP_RR(0, 0);
                *(f32x4*)((float*)(ws + WS_FIXU) + ((size_t)pm * 2 + fr) * DFF + chb + 4 * n) = acc[0][1][0][n] * UP_RR(0, 0); }
        }
        asm volatile("s_waitcnt lgkmcnt(0)" ::: "memory"); __builtin_amdgcn_s_barrier(); asm volatile("" ::: "memory");
        const f32x4 z4 = {0.f, 0.f, 0.f, 0.f};
#pragma unroll
        for (int n = 0; n < 2; ++n) { const int ch = chb + 4 * n;
            const f32x4 w0 = *(const f32x4*)(p.conv_w + ch), w1 = *(const f32x4*)(p.conv_w + DFF + ch), w2 = *(const f32x4*)(p.conv_w + 2 * DFF + ch), cb = *(const f32x4*)(p.conv_b + ch);
#pragma unroll
            for (int ai = 0; ai < 2; ++ai) {
                f32x4 t1p = z4, t2p = z4;
                if (!(ai == 0 && wr == 0)) { const int ps = (wr == 1) ? 2 * ai : 1; const LAS float* xp = X + (ps * 2) * 128 + chl + 4 * n;
                    const f32x4 pv14 = *(const LAS f32x4*)xp, pv15 = *(const LAS f32x4*)(xp + 128); t1p = pv15; t2p = (fr == 0) ? pv14 : pv15; }
#pragma unroll
                for (int m = 0; m < 4; ++m) { const int row = pm * 256 + ai * 128 + wr * 64 + m * 16 + fr;
                    const float rm = UP_RR(ai, m); const f32x4 gm = acc[ai][0][m][n] * rm;
                    const f32x4 t1 = (f32x4){ror16<1>(gm.x), ror16<1>(gm.y), ror16<1>(gm.z), ror16<1>(gm.w)};
                    const f32x4 t2 = (f32x4){ror16<2>(gm.x), ror16<2>(gm.y), ror16<2>(gm.z), ror16<2>(gm.w)};
                    const f32x4 p1 = (fr == 0) ? t1p : t1, p2 = (fr < 2) ? t2p : t2;
                    const f32x4 aa = silu4(cb + w0 * p2 + w1 * p1 + w2 * gm) * (acc[ai][1][m][n] * rm);
                    u32x2 o; o.x = pk2(aa.x, aa.y); o.y = pk2(aa.z, aa.w); *(u32x2*)(ACT + (size_t)row * DFF + ch) = o;
                    t1p = t1; t2p = t2; }
            }
            asm volatile("" ::: "memory");
        }
    }
#undef UP_RR
};

struct PhaseWpb {
    static constexpr int LDA = POOLW, LDB = 256, KT = 4;
    const Params& p; int G, c;
    DI bool next(int i, g8::Unit& u) const { const int off = 220 % G; const long L = (long)i * G + ((c + G - off) % G); if (L >= 32) return false;
        const int pm = (int)L >> 2, g = (int)L & 3; u.pm = pm; u.pn = g;
        u.A = (const char*)(p.ws + WS_WBT) + ((size_t)pm * 256 * POOLW + g * 256) * 2; u.B = (const char*)(p.ws + WS_WPS) + (size_t)g * 256 * 256 * 2; return true; }
    DI void epi(EPI_ARGS) const { bf16_t* W = (bf16_t*)(p.ws + WS_WPB);
        EPI_ROWS(row) EPI_COLS(col) *(u32x4*)(W + (size_t)row * POOLW + u.pn * 256 + col) = pk8(v0, v1); EPI_END }
};

template <int KS, int LDA, int LDB>
DI f32x4 skinny16(const bf16_t* A, const bf16_t* W, int lane) {
    const int fr = lane & 15, fq = lane >> 4;
    const bf16_t* ap = A + (size_t)fr * LDA + 8 * fq; const bf16_t* bp = W + (size_t)fr * LDB + 8 * fq;
    f32x4 acc = {0.f, 0.f, 0.f, 0.f};
#pragma unroll 8
    for (int s = 0; s < KS; ++s) { const bf16x8 a = *(const bf16x8*)(ap + 32 * s), b = *(const bf16x8*)(bp + 32 * s); acc = __builtin_amdgcn_mfma_f32_16x16x32_bf16(a, b, acc, 0, 0, 0); }
    return acc;
}
DI float sum16(float v) { v += __shfl_xor(v, 1); v += __shfl_xor(v, 2); v += __shfl_xor(v, 4); v += __shfl_xor(v, 8); return v; }
template <int KIND, int K, int LDA, int LDB, int NCG = 128>
DI void sample_gemm(const Params& p, LAS unsigned char* lds, size_t a_off, size_t w_off, int wave) {
    unsigned char* ws = p.ws; const int lane = lane_id(), fr = lane & 15, fq = lane >> 4;
    constexpr int KS = K / 64;
    for (int it = blockIdx.x; it < 2 * NCG; it += gridDim.x) {
        const int cg_ = it >> 1, r0 = MP + 64 * (it & 1) + 16 * (wave & 3), col = 16 * cg_ + fr, kh = wave >> 2;
        f32x4 acc = skinny16<KS, LDA, LDB>((const bf16_t*)(ws + a_off) + (size_t)r0 * LDA + kh * (K / 2), (const bf16_t*)(ws + w_off) + (size_t)(16 * cg_) * LDB + kh * (K / 2), lane);
        LAS f32x4* xch = (LAS f32x4*)lds;
        if (kh == 1) xch[(wave & 3) * 64 + lane] = acc;
        __syncthreads();
        if (kh == 0) {
        acc += xch[wave * 64 + lane];
        float rs[4] = {0.f, 0.f, 0.f, 0.f};
        if (KIND == 5) {
            const float* SS2S = (const float*)(ws + WS_SS2S);
#pragma unroll
            for (int r = 0; r < 16; ++r) { const float* q = SS2S + (size_t)(r0 - MP + r) * 128; const float s_ = wave_sum(q[lane] + q[64 + lane]); const float rr = 1.0f / sqrtf(s_ * (1.0f / D) + EPS);
#pragma unroll
                for (int j = 0; j < 4; ++j) rs[j] = (r == 4 * fq + j) ? rr : rs[j]; }
        }
#pragma unroll
        for (int j = 0; j < 4; ++j) {
            const int row = r0 + 4 * fq + j; const size_t o = (size_t)row * D + col; const float v = acc[j]; float hsq = 0.f;
            if (KIND == 6) { const float val = v * ((const float*)(ws + WS_RSTD1))[row];
                if (col < KW) ((bf16_t*)(ws + WS_QB))[(size_t)row * KW + col] = (bf16_t)(pk2(val * 0.0625f, 0.f) & 0xffffu);
                else if (col < 2 * KW) ((bf16_t*)(ws + WS_KB))[(size_t)row * KW + col - KW] = (bf16_t)(pk2(val, 0.f) & 0xffffu);
                else ((bf16_t*)(ws + WS_V))[(size_t)row * VW + col - 2 * KW] = (bf16_t)(pk2(val, 0.f) & 0xffffu); }
            if (KIND == 0) { ((bf16_t*)(ws + WS_YBG))[o] = (bf16_t)(pk2(v * bf1(((const bf16_t*)(ws + WS_GB))[o]), 0.f) & 0xffffu); }
            if (KIND == 1) { ((bf16_t*)(ws + WS_MB))[o] = (bf16_t)(pk2(v * bf1(((const bf16_t*)(ws + WS_GA))[o]) + bf1(((const bf16_t*)(ws + WS_YBG))[o]), 0.f) & 0xffffu); }
            if (KIND == 2) { const float hv = p.x_sample[(size_t)(row - MP) * D + col] + v; ((bf16_t*)(ws + WS_H1B))[o] = (bf16_t)(pk2(hv, 0.f) & 0xffffu); hsq = hv * hv; }
            if (KIND == 3) { const float hv = bf1(((const bf16_t*)(ws + WS_H1B))[o]) + v; ((bf16_t*)(ws + WS_H2B))[o] = (bf16_t)(pk2(hv, 0.f) & 0xffffu); hsq = hv * hv; }
            if (KIND == 4) { ((bf16_t*)(ws + WS_PE))[o] = (bf16_t)(pk2(v, 0.f) & 0xffffu); }
            if (KIND == 5) { const float hv = bf1(((const bf16_t*)(ws + WS_H2B))[o]) + sigmoidf_(v * rs[j]) * bf1(((const bf16_t*)(ws + WS_PE))[o]); ((bf16_t*)(ws + WS_H3))[o] = (bf16_t)(pk2(hv, 0.f) & 0xffffu); hsq = hv * hv; }
            if (KIND == 2) { const float t = sum16(hsq); if (fr == 0) __hip_atomic_fetch_add((float*)(ws + WS_RS1) + row, t, __ATOMIC_RELAXED, __HIP_MEMORY_SCOPE_AGENT); }
            if (KIND == 3 || KIND == 5) { const float t = sum16(hsq);
                float* SSx = (float*)(ws + (KIND == 3 ? WS_SS2S : WS_SS3S)); if (fr == 0) SSx[(size_t)(row - MP) * 128 + cg_] = t; }
        }
        }
        __syncthreads();
    }
}


#define XB_TMO      128
#define XB_XCNT(j)  (256  + 64 * (j))
#define XB_XSUB(j)  (1280 + 64 * (j))
#define XB_XGEN(j)  (2304 + 64 * (j))
#define XB_TOP      3328
#define XB_TOPGEN   3392
#define XCD_BAR_WORDS 3456
#define XB_SPIN_CAP (1u << 22)
DI unsigned xb_ld(unsigned* p)              { return __hip_atomic_load(p, __ATOMIC_RELAXED, __HIP_MEMORY_SCOPE_AGENT); }
DI unsigned xb_add(unsigned* p, unsigned v) { return __hip_atomic_fetch_add(p, v, __ATOMIC_RELAXED, __HIP_MEMORY_SCOPE_AGENT); }
DI unsigned xb_xcc_id() { return (unsigned)__builtin_amdgcn_s_getreg((3 << 11) | 20) & 0xFu; }
#define XB_SPIN(cond, bar) do { unsigned _sp = 0; while (cond) { __builtin_amdgcn_s_sleep(1); \
    if ((++_sp & 255u) == 0u) { if (xb_ld(&(bar)[XB_TMO])) break; if (_sp > XB_SPIN_CAP) { atomicAdd(&(bar)[XB_TMO], 1u); break; } } } } while (0)
struct XcdBarrier { unsigned* bar; unsigned x; volatile LAS unsigned* st; };
DI XcdBarrier xcd_barrier_post(unsigned* bar, volatile LAS unsigned* st, bool t0) {
    XcdBarrier b; b.bar = bar; b.x = xb_xcc_id(); b.st = st;
    if (t0) (void)xb_add(&bar[XB_XCNT(b.x)], 1u);
    return b;
}
DI void xcd_barrier_complete(unsigned* bar, unsigned x, unsigned& nloc, unsigned& nx) {
    const unsigned G = gridDim.x * gridDim.y * gridDim.z;
    unsigned sum, cnt, mine, sp = 0u;
    for (;;) {
        sum = 0u; cnt = 0u; mine = 0u;
#pragma unroll
        for (unsigned j = 0; j < 16; ++j) { const unsigned c = xb_ld(&bar[XB_XCNT(j)]); sum += c; cnt += (c > 0u) ? 1u : 0u; mine = (j == x) ? c : mine; }
        if (sum == G) break;
        __builtin_amdgcn_s_sleep(1);
        if ((++sp & 255u) == 0u) { if (xb_ld(&bar[XB_TMO])) break; if (sp > XB_SPIN_CAP) { atomicAdd(&bar[XB_TMO], 1u); break; } }
    }
    nloc = mine > 0u ? mine : 1u; nx = cnt > 0u ? cnt : 1u;
}
DI void xcd_barrier(const XcdBarrier& b, bool t0) {
    asm volatile("s_waitcnt vmcnt(0)" ::: "memory");
    __syncthreads();
    if (t0) {
        unsigned* bar = b.bar;
        __builtin_amdgcn_s_waitcnt(0);
        unsigned nloc = b.st[0], nx = b.st[1];
        if (nloc == 0u) { xcd_barrier_complete(bar, b.x, nloc, nx); b.st[0] = nloc; b.st[1] = nx; }
        const unsigned old = xb_add(&bar[XB_XSUB(b.x)], 1u);
        const unsigned gen = old / nloc;
        if (old + 1u == (gen + 1u) * nloc) {
            __builtin_amdgcn_fence(__ATOMIC_RELEASE, "agent");
            asm volatile("s_waitcnt vmcnt(0)" ::: "memory");
            const unsigned og = xb_add(&bar[XB_TOP], 1u);
            const unsigned tg = og / nx;
            if (og + 1u == (tg + 1u) * nx) xb_add(&bar[XB_TOPGEN], 1u);
            else XB_SPIN(xb_ld(&bar[XB_TOPGEN]) == tg, bar);
            __builtin_amdgcn_fence(__ATOMIC_ACQUIRE, "agent");
            xb_add(&bar[XB_XGEN(b.x)], 1u);
            asm volatile("s_waitcnt vmcnt(0)" ::: "memory");
        } else {
            XB_SPIN(xb_ld(&bar[XB_XGEN(b.x)]) == gen, bar);
            __builtin_amdgcn_fence(__ATOMIC_ACQUIRE, "agent");
            asm volatile("s_waitcnt vmcnt(0)" ::: "memory");
        }
    }
    __syncthreads();
}

constexpr int N_PHASES = 13;
#ifndef G8_SP2
#define G8_SP2 true
#endif
#ifndef G8_ALIGN
#define G8_ALIGN true
#endif

__global__ void __launch_bounds__(NTHREADS, 2) fwd_kernel(Params p) {
    extern __shared__ __attribute__((aligned(16))) unsigned char lds_raw[];
    LAS unsigned char* lds = (LAS unsigned char*)lds_raw;
    const int G = gridDim.x, c = blockIdx.x;
    const int wave = __builtin_amdgcn_readfirstlane(threadIdx.x >> 6);
    const int lo = p.ph_lo, hi = p.ph_hi;
#ifndef REPEAT_MASK
#define REPEAT_MASK 0
#endif
#ifndef PHASE_MASK
#define PHASE_MASK 0x1aff
#endif
#define IN(k) (((PHASE_MASK >> (k)) & 1) && lo <= (k) && (k) < hi)
    volatile LAS unsigned* bst = (volatile LAS unsigned*)(lds + LDS_MISC);
    const bool t0 = (wave == 0) && (lane_id() == 0);
    XcdBarrier bar; bar.bar = (unsigned*)(p.ws + WS_CTL); bar.x = 0; bar.st = bst;
    if (hi - lo > 1) { if (t0) { bst[0] = 0u; bst[1] = 0u; } __syncthreads(); bar = xcd_barrier_post((unsigned*)(p.ws + WS_CTL), bst, t0); }
#define NEXTPH(k) ((k) == 9 ? 11 : ((k) == 7 ? 9 : (k) + 1))
#define SEAM(k) do { if (IN(k) && IN(NEXTPH(k))) { xcd_barrier(bar, (wave == 0) && (lane_id() == 0)); } } while (0)
    if (IN(0)) { phase_p0(p, lds, wave); if ((REPEAT_MASK >> 0) & 1) { xcd_barrier(bar, (wave == 0) && (lane_id() == 0)); phase_p0(p, lds, wave); } } SEAM(0);
    if (IN(1)) { sample_gemm<6, D, D, D, 256>(p, lds, WS_XB, WS_WIN, wave); PhaseIn ph{p, G, c, 0, 0}; g8::run<PhaseIn, G8_ALIGN, G8_SP2>(lds, ph, wave); } SEAM(1);
    if (IN(2)) {
        if (G == 256) {
            if (c < 32) scan_role(p, lds, wave, c, 32);
            else if (c < 71) stream_role(p, wave, c - 32, 39);
            else { PhaseIn ph{p, G, c, 1, 71}; g8::run<PhaseIn, G8_ALIGN, G8_SP2>(lds, ph, wave); PhaseWpb pw{p, G, c}; g8::run<PhaseWpb, G8_ALIGN, G8_SP2>(lds, pw, wave); }
        } else {
            PhaseIn ph{p, G, c, 1, 0}; g8::run<PhaseIn, G8_ALIGN, G8_SP2>(lds, ph, wave); PhaseWpb pw{p, G, c}; g8::run<PhaseWpb, G8_ALIGN, G8_SP2>(lds, pw, wave);
            scan_role(p, lds, wave, c, G); stream_role(p, wave, c, G);
        }
    } SEAM(2);
    if (IN(3)) { phase_p3(p, wave); if ((REPEAT_MASK >> 3) & 1) { xcd_barrier(bar, (wave == 0) && (lane_id() == 0)); phase_p3(p, wave); } } SEAM(3);
    if (IN(4)) { sample_gemm<0, POOLW, POOLW, POOLW>(p, lds, WS_PM, WS_WPB, wave); PhaseYb ph{{p, G, c, WS_PM, WS_WPB}}; g8::run<PhaseYb, G8_ALIGN, G8_SP2>(lds, ph, wave); if ((REPEAT_MASK >> 4) & 1) { xcd_barrier(bar, (wave == 0) && (lane_id() == 0)); sample_gemm<0, POOLW, POOLW, POOLW>(p, lds, WS_PM, WS_WPB, wave); PhaseYb ph{{p, G, c, WS_PM, WS_WPB}}; g8::run<PhaseYb, G8_ALIGN, G8_SP2>(lds, ph, wave); } }
    if (IN(5)) { asm volatile("s_waitcnt vmcnt(0)" ::: "memory"); __syncthreads(); sample_gemm<1, VW, VW, VW>(p, lds, WS_OG, WS_WA, wave); PhaseYa ph{{p, G, c, WS_OG, WS_WA}}; g8::run<PhaseYa, G8_ALIGN, G8_SP2>(lds, ph, wave); if ((REPEAT_MASK >> 5) & 1) { xcd_barrier(bar, (wave == 0) && (lane_id() == 0)); sample_gemm<1, VW, VW, VW>(p, lds, WS_OG, WS_WA, wave); PhaseYa ph{{p, G, c, WS_OG, WS_WA}}; g8::run<PhaseYa, G8_ALIGN, G8_SP2>(lds, ph, wave); } } SEAM(5);
    if (IN(6)) { sample_gemm<2, D, D, D>(p, lds, WS_MB, WS_WO, wave); PhaseOut ph{{p, G, c, WS_MB, WS_WO}}; g8::run<PhaseOut, G8_ALIGN, G8_SP2>(lds, ph, wave); if ((REPEAT_MASK >> 6) & 1) { xcd_barrier(bar, (wave == 0) && (lane_id() == 0)); sample_gemm<2, D, D, D>(p, lds, WS_MB, WS_WO, wave); PhaseOut ph{{p, G, c, WS_MB, WS_WO}}; g8::run<PhaseOut, G8_ALIGN, G8_SP2>(lds, ph, wave); } } SEAM(6);
    if (IN(7)) { PhaseUp ph{p, G, c, lds + LDS_XCH}; g8::run<PhaseUp, true, G8_SP2>(lds, ph, wave); sample_gemm<4, PLE, PLE, PLE>(p, lds, WS_PLB, WS_WPLE, wave); { PhasePe pe{{p, G, c, WS_PLB, WS_WPLE}}; g8::run<PhasePe, G8_ALIGN, G8_SP2>(lds, pe, wave); } if ((REPEAT_MASK >> 7) & 1) { xcd_barrier(bar, (wave == 0) && (lane_id() == 0)); PhaseUp ph2{p, G, c, lds + LDS_XCH}; g8::run<PhaseUp, true, G8_SP2>(lds, ph2, wave); } } SEAM(7);
    if (IN(9)) { { PhaseDown pd{{p, G, c, WS_ACT, WS_WD}}; g8::Unit uu; for (int i = 0; pd.next(i, uu); ++i) conv_fixup_tile(p, uu.pm, wave); asm volatile("s_waitcnt vmcnt(0)" ::: "memory"); __syncthreads(); } sample_gemm<3, DFF, DFF, DFF>(p, lds, WS_ACT, WS_WD, wave); PhaseDown ph{{p, G, c, WS_ACT, WS_WD}}; g8::run<PhaseDown, G8_ALIGN, G8_SP2>(lds, ph, wave); if ((REPEAT_MASK >> 9) & 1) { xcd_barrier(bar, (wave == 0) && (lane_id() == 0)); sample_gemm<3, DFF, DFF, DFF>(p, lds, WS_ACT, WS_WD, wave); PhaseDown ph{{p, G, c, WS_ACT, WS_WD}}; g8::run<PhaseDown, G8_ALIGN, G8_SP2>(lds, ph, wave); } } SEAM(9);
    if (IN(11)) { sample_gemm<5, D, D, D>(p, lds, WS_H2B, WS_WPG, wave); PhasePg ph{{p, G, c, WS_H2B, WS_WPG}}; g8::run<PhasePg, G8_ALIGN, G8_SP2>(lds, ph, wave); if ((REPEAT_MASK >> 11) & 1) { xcd_barrier(bar, (wave == 0) && (lane_id() == 0)); sample_gemm<5, D, D, D>(p, lds, WS_H2B, WS_WPG, wave); PhasePg ph{{p, G, c, WS_H2B, WS_WPG}}; g8::run<PhasePg, G8_ALIGN, G8_SP2>(lds, ph, wave); } } SEAM(11);
    if (IN(12)) { phase_final(p, wave); if ((REPEAT_MASK >> 12) & 1) { xcd_barrier(bar, (wave == 0) && (lane_id() == 0)); phase_final(p, wave); } }
#undef IN
#undef SEAM
}

extern "C" void kernel_launch(void* const* d_in, const int* in_sizes, int n_in, void* d_out, int out_size, void* d_ws, size_t ws_size, hipStream_t stream) {
    static int grid = 0;
    if (grid == 0) {
        if (n_in != 26 || (size_t)out_size != O_END || ws_size < WS_END) {
            fprintf(stderr, "kernel_launch: unexpected problem: n_in %d out %d ws %zu (need %zu)\n", n_in, out_size, ws_size, (size_t)WS_END); grid = -1; return; }
        int dev = 0, cus = 0, per_cu = 0;
        if (hipGetDevice(&dev) != hipSuccess || hipDeviceGetAttribute(&cus, hipDeviceAttributeMultiprocessorCount, dev) != hipSuccess) { grid = -1; return; }
        if (hipFuncSetAttribute((const void*)fwd_kernel, hipFuncAttributeMaxDynamicSharedMemorySize, LDS_BYTES) != hipSuccess) { fprintf(stderr, "kernel_launch: hipFuncSetAttribute failed\n"); grid = -1; return; }
        if (hipOccupancyMaxActiveBlocksPerMultiprocessor(&per_cu, (const void*)fwd_kernel, NTHREADS, LDS_BYTES) != hipSuccess || per_cu < 1) {
            fprintf(stderr, "kernel_launch: occupancy query reports %d blocks per CU\n", per_cu); (void)hipGetLastError(); grid = -1; return; }
        grid = cus;
    }
    if (grid < 0) return;
    Params p{};
    const float** pp = (const float**)&p;
    for (int i = 0; i < 26; ++i) pp[i] = (const float*)d_in[i];
    p.out = (float*)d_out; p.ws = (unsigned char*)d_ws;
#if MK_N_LAUNCHES == 1
    p.ph_lo = 0; p.ph_hi = N_PHASES;
    void* args[] = {&p};
    if (hipMemsetAsync((char*)d_ws + WS_CTL, 0, XCD_BAR_WORDS * 4, stream) != hipSuccess) { fprintf(stderr, "kernel_launch: memset failed\n"); return; }
    hipError_t e = hipLaunchCooperativeKernel((const void*)fwd_kernel, dim3(grid), dim3(NTHREADS), args, LDS_BYTES, stream);
    if (e != hipSuccess) fprintf(stderr, "kernel_launch: cooperative launch failed: %s (grid %d)\n", hipGetErrorString(e), grid);
#else
    for (int k = 0; k < N_PHASES; ++k) { p.ph_lo = k; p.ph_hi = k + 1; hipLaunchKernelGGL(fwd_kernel, dim3(grid), dim3(NTHREADS), LDS_BYTES, stream, p); }
#endif
}
```

```cpp
#include <hip/hip_runtime.h>
#include <hip/hip_cooperative_groups.h>
#include <cstdio>
#include <cstdint>
namespace cg = cooperative_groups;

#ifndef MK_N_LAUNCHES
#define MK_N_LAUNCHES 1
#endif

#define LAS __attribute__((address_space(3)))
#define DI __device__ __forceinline__
typedef unsigned short bf16_t;
typedef short bf16x8 __attribute__((ext_vector_type(8)));
typedef short s16x4 __attribute__((ext_vector_type(4)));
typedef float f32x4 __attribute__((ext_vector_type(4)));
typedef float f32x2 __attribute__((ext_vector_type(2)));
typedef float f32x16 __attribute__((ext_vector_type(16)));
typedef unsigned u32x4 __attribute__((ext_vector_type(4)));
typedef unsigned u32x2 __attribute__((ext_vector_type(2)));

constexpr int D = 2048, MP = 8192, MS = 128, M = MP + MS, MPAD = 8448, NTM = 33;
constexpr int SEQ = 2048, NB = 4, NH = 4, DK = 256, DV = 512, KW = 1024, VW = 2048;
constexpr int DFF = 5504, NUP = 2 * DFF, PLE = 256, POOLW = 1024, INW = 11280, NIN = 11264;
constexpr float EPS = 1e-6f;
constexpr int NSL = 16;
constexpr int CH = 32, NCHK = MP / CH;

constexpr size_t O_YP = 0, O_YS = O_YP + (size_t)MP * D, O_GLAP = O_YS + (size_t)MS * D, O_POOLP = O_GLAP + (size_t)NB * NH * DK * DV,
                 O_CONVP = O_POOLP + (size_t)NB * 15 * POOLW, O_GLAS = O_CONVP + (size_t)NB * 2 * DFF, O_POOLS = O_GLAS + (size_t)MS * NH * DK * DV,
                 O_CONVS = O_POOLS + (size_t)MS * 15 * POOLW, O_END = O_CONVS + (size_t)MS * 2 * DFF;

constexpr size_t al(size_t x) { return (x + 255) & ~(size_t)255; }
constexpr size_t WS_CTL = 0, CTL_BYTES = 65536;
constexpr size_t WS_WUP = WS_CTL + CTL_BYTES;
constexpr size_t WS_WD = WS_WUP + al((size_t)NUP * D * 2);
constexpr size_t WS_WA = WS_WD + al((size_t)D * DFF * 2);
constexpr size_t WS_WO = WS_WA + al((size_t)D * D * 2);
constexpr size_t WS_WPG = WS_WO + al((size_t)D * D * 2);
constexpr size_t WS_WPB = WS_WPG + al((size_t)D * D * 2);
constexpr size_t WS_WPLE = WS_WPB + al((size_t)D * POOLW * 2);
constexpr size_t WS_WBT = WS_WPLE + al((size_t)D * PLE * 2);
constexpr size_t WS_WPS = WS_WBT + al((size_t)D * POOLW * 2);
constexpr size_t WS_SMALL = WS_WPS + al((size_t)POOLW * 256 * 2);
constexpr size_t WS_RSTD1 = WS_SMALL;
constexpr size_t WS_LAM = WS_RSTD1 + al((size_t)MPAD * 4);
constexpr size_t WS_OSS = WS_LAM + al((size_t)(NCHK + MS) * KW * 4);
constexpr size_t WS_OSP = WS_OSS + al((size_t)MP * NH * NSL * 4);
constexpr size_t WS_SS1 = WS_OSP + al((size_t)MS * NH * 8 * DV * 4);
constexpr size_t WS_SS2 = WS_SS1 + al((size_t)MPAD * 32 * 4);
constexpr size_t WS_SS3 = WS_SS2 + al((size_t)MPAD * 32 * 4);
constexpr size_t WS_SS1S = WS_SS3 + al((size_t)MPAD * 32 * 4);
constexpr size_t WS_SS2S = WS_SS1S + al((size_t)MS * 128 * 4);
constexpr size_t WS_SS3S = WS_SS2S + al((size_t)MS * 128 * 4);
constexpr size_t WS_RS1 = WS_SS3S + al((size_t)MS * 128 * 4);
constexpr size_t WS_HALO = WS_RS1 + al((size_t)MPAD * 4);
constexpr size_t WS_FIXG = WS_HALO + al((size_t)32 * 2 * DFF * 4);
constexpr size_t WS_FIXU = WS_FIXG + al((size_t)32 * 2 * DFF * 4);
constexpr size_t WS_PLB = WS_FIXU + al((size_t)32 * 2 * DFF * 4);
constexpr size_t WS_R1 = WS_PLB + al((size_t)MPAD * PLE * 2);
constexpr size_t WS_XB = WS_R1;
constexpr size_t WS_WIN = WS_XB + al((size_t)MPAD * D * 2);
constexpr size_t WS_BCUM = WS_WIN + al((size_t)NIN * D * 2);
constexpr size_t WS_R1_END = WS_BCUM + al((size_t)MPAD * KW * 4);
constexpr size_t WS_ACT = WS_R1;
static_assert(WS_ACT + al((size_t)MPAD * DFF * 2) <= WS_R1_END, "R1 overlay");
constexpr size_t WS_R2 = WS_R1_END;
constexpr size_t WS_QB = WS_R2;
constexpr size_t WS_KB = WS_QB + al((size_t)MPAD * KW * 2);
constexpr size_t WS_KD = WS_KB + al((size_t)MPAD * KW * 2);
constexpr size_t WS_V = WS_KD + al((size_t)MPAD * KW * 2);
constexpr size_t WS_SR = WS_V + al((size_t)MPAD * VW * 2);
constexpr size_t WS_GA = WS_SR + al((size_t)MPAD * VW * 2);
constexpr size_t WS_GB = WS_GA + al((size_t)MPAD * D * 2);
constexpr size_t WS_U = WS_GB + al((size_t)MPAD * D * 2);
constexpr size_t WS_OG = WS_U + al((size_t)MPAD * POOLW * 4);
constexpr size_t WS_PM = WS_OG + al((size_t)MPAD * VW * 2);
constexpr size_t WS_YBG = WS_PM + al((size_t)MPAD * POOLW * 2);
constexpr size_t WS_R2_END = WS_YBG + al((size_t)MPAD * D * 4);
constexpr size_t WS_GU = WS_R2;
constexpr size_t WS_H2 = WS_GU + al((size_t)MPAD * NUP * 2);
constexpr size_t WS_PE = WS_H2 + al((size_t)MPAD * D * 4);
static_assert(WS_PE + al((size_t)MPAD * D * 4) <= WS_R2_END, "R2 overlay");
constexpr size_t WS_MB = WS_R2_END;
constexpr size_t WS_H1 = WS_MB + al((size_t)MPAD * D * 2);
constexpr size_t WS_H1B = WS_H1 + al((size_t)MPAD * D * 4);
constexpr size_t WS_END = WS_H1B + al((size_t)MPAD * D * 2);
constexpr size_t WS_H3 = WS_H1;
constexpr size_t WS_H2B = WS_MB;

DI unsigned pk2(float lo, float hi) {
    typedef __bf16 bf2 __attribute__((ext_vector_type(2)));
    f32x2 v = {lo, hi};
    bf2 b = __builtin_convertvector(v, bf2);
    return __builtin_bit_cast(unsigned, b);
}
DI float bflo(unsigned w) { return __uint_as_float(w << 16); }
DI float bfhi(unsigned w) { return __uint_as_float(w & 0xffff0000u); }
DI float bf1(bf16_t b) { return __uint_as_float(((unsigned)b) << 16); }
DI float fexp(float x) { return __expf(x); }
DI float sigmoidf_(float x) { return __builtin_amdgcn_rcpf(1.0f + __expf(-x)); }
DI float siluf_(float x) { return x * sigmoidf_(x); }
DI float logsigmoidf_(float z) { return fminf(z, 0.f) - __logf(1.0f + __expf(-fabsf(z))); }
DI u32x4 pk8(f32x4 a, f32x4 b) { u32x4 o; o.x = pk2(a.x, a.y); o.y = pk2(a.z, a.w); o.z = pk2(b.x, b.y); o.w = pk2(b.z, b.w); return o; }
DI f32x4 bf4lo(u32x4 w) { return (f32x4){bflo(w.x), bfhi(w.x), bflo(w.y), bfhi(w.y)}; }
DI f32x4 bf4hi(u32x4 w) { return (f32x4){bflo(w.z), bfhi(w.z), bflo(w.w), bfhi(w.w)}; }
DI float wave_sum(float v) {
#pragma unroll
    for (int o = 1; o < 64; o <<= 1) v += __shfl_xor(v, o);
    return v;
}
DI int lane_id() { int l; asm volatile("v_mbcnt_lo_u32_b32 %0, -1, 0\n\tv_mbcnt_hi_u32_b32 %0, -1, %0" : "=v"(l)); return l; }
#define LDS_WAIT() asm volatile("s_waitcnt lgkmcnt(0)" ::: "memory")
#define VM_WAIT() asm volatile("s_waitcnt vmcnt(0)" ::: "memory")

struct Params {
    const float *x_prompt, *x_sample, *state_gla, *state_pool, *state_conv, *p_prompt, *p_sample;
    const float *norm_mix, *w_in, *w_gate_up, *b_gate, *gla_norm, *w_branch_a, *w_pool, *pool_scale, *w_branch_b, *w_out, *norm_ffn, *w_up, *conv_w, *conv_b,
        *w_down, *norm_ple, *w_ple_gate, *w_ple, *norm_final;
    float* out; unsigned char* ws;
    int ph_lo, ph_hi;
};

constexpr int NWAVES = 8, NTHREADS = 512;
constexpr int LDS_BYTES = 163840;
constexpr int LDS_XCH = 131072;
constexpr int LDS_MISC = LDS_BYTES - 256;

namespace g8 {
constexpr int BM = 256, BK = 64, HALF = 128, HTB = HALF * BK * 2, STAGE_BYTES = 8 * HTB, NXCD = 8, WGM = 2;
DI int lds_byte(int r, int c) { const int st = (r >> 4) * 2 + (c >> 5), rr = r & 15, cc = c & 31, ob = rr * 64 + cc * 2; return st * 1024 + (ob ^ (((ob >> 9) & 1) << 5)); }
DI void stage_rc(int b, int& R, int& C) { const int st = b / 1024, sb = b % 1024, swz = sb ^ (((sb >> 9) & 1) << 5); R = (st >> 1) * 16 + swz / 64; C = (st & 1) * 32 + (swz % 64) / 2; }
DI int perm32(int rho) { const int n = rho >> 4, i = rho & 15; return 8 * (i >> 2) + 4 * n + (i & 3); }

struct Unit { const char* A; const char* B; int pm, pn; };

DI bool grid_order(int nM, int nN, int G, int c, int i, int& pm, int& pn) {
    const int nwg = nM * nN; const long L = (long)i * G + c; if (L >= nwg) return false;
    int wgid = (int)L; { const int q = nwg / NXCD, r = nwg % NXCD, xcd = wgid % NXCD, off = wgid / NXCD; wgid = (xcd < r ? xcd * (q + 1) : r * (q + 1) + (xcd - r) * q) + off; }
    const int nig = WGM * nN, gid = wgid / nig, fm = gid * WGM, gsz = (nM - fm) < WGM ? (nM - fm) : WGM;
    pm = fm + ((wgid % nig) % gsz); pn = (wgid % nig) / gsz; return true;
}

template <class P, bool ALIGN_EPI, bool SP2>
DI void run(LAS unsigned char* lds, const P& ph, int wid) {
    const int lane = lane_id(), tid = wid * 64 + lane, wr = wid >> 2, wc = wid & 3, fr = lane & 15, fq = lane >> 4;
    constexpr int nt = P::KT;
    unsigned voffA[2], voffB[2];
#pragma unroll
    for (int i = 0; i < 2; ++i) { int R, C; stage_rc(tid * 16 + i * 8192, R, C); const int Rb = (R & ~31) + perm32(R & 31);
        voffA[i] = (unsigned)(R * P::LDA + C) * 2u; voffB[i] = (unsigned)(Rb * P::LDB + C) * 2u; }
    constexpr size_t kstep = (size_t)(BK * 2);
    constexpr size_t hstepA = (size_t)HALF * P::LDA * 2, hstepB = (size_t)HALF * P::LDB * 2;
    const unsigned ldsw = (unsigned)wid * 1024u;
    const int aoff = lds_byte(wr * 64 + fr, fq * 8), boff = lds_byte(wc * 32 + fr, fq * 8);
#define G8_SA(b, h) (((b) * 2 + (h)) * HTB)
#define G8_SB(b, h) ((4 + (b) * 2 + (h)) * HTB)
#define G8_STAGE(bufoff, gbase, voff) do { _Pragma("unroll") for (int _i = 0; _i < 2; ++_i) \
        __builtin_amdgcn_global_load_lds((const unsigned*)((const char*)(gbase) + (voff)[_i]), (LAS unsigned*)(lds + (bufoff) + ldsw + _i * 8192), 16, 0, 0); } while (0)
#define G8_LDA(dst, b, h) do { _Pragma("unroll") for (int m = 0; m < 4; ++m) _Pragma("unroll") for (int k = 0; k < 2; ++k) dst[m][k] = *(const LAS bf16x8*)(lds + G8_SA(b, h) + aoff + m * 2048 + k * 1024); } while (0)
#define G8_LDB(dst, b, h) do { _Pragma("unroll") for (int n = 0; n < 2; ++n) _Pragma("unroll") for (int k = 0; k < 2; ++k) dst[n][k] = *(const LAS bf16x8*)(lds + G8_SB(b, h) + boff + n * 2048 + k * 1024); } while (0)
#define G8_MMA(ai, bj, At, Bt) do { __builtin_amdgcn_s_setprio(1); _Pragma("unroll") for (int m = 0; m < 4; ++m) _Pragma("unroll") for (int n = 0; n < 2; ++n) _Pragma("unroll") for (int k = 0; k < 2; ++k) \
        acc[ai][bj][m][n] = __builtin_amdgcn_mfma_f32_16x16x32_bf16(Bt[n][k], At[m][k], acc[ai][bj][m][n], 0, 0, 0); __builtin_amdgcn_s_setprio(0); } while (0)
#define G8_WAIT_V(n) asm volatile("s_waitcnt vmcnt(" #n ")" ::: "memory")
#define G8_WAIT_L(n) asm volatile("s_waitcnt lgkmcnt(" #n ")" ::: "memory")
#define G8_BAR __builtin_amdgcn_s_barrier()
#define G8_SCHED __builtin_amdgcn_sched_barrier(0)
    Unit cur, nxt; int ui = 0;
    if (!ph.next(0, cur)) return;
    f32x4 acc[2][2][4][2];
#pragma unroll
    for (int a = 0; a < 2; ++a)
#pragma unroll
        for (int b = 0; b < 2; ++b)
#pragma unroll
            for (int m = 0; m < 4; ++m)
#pragma unroll
                for (int n = 0; n < 2; ++n) acc[a][b][m][n] = (f32x4){0.f, 0.f, 0.f, 0.f};
    bf16x8 At[4][2], B0[2][2], B1[2][2];
    const char* cA = cur.A; const char* cB = cur.B;
    if constexpr (SP2) {
        G8_STAGE(G8_SB(0, 0), cB, voffB); G8_STAGE(G8_SB(0, 1), cB + hstepB, voffB); G8_STAGE(G8_SA(0, 0), cA, voffA); G8_STAGE(G8_SA(0, 1), cA + hstepA, voffA);
        if (wr == 1) G8_BAR;
        G8_WAIT_V(2); G8_BAR;
        G8_STAGE(G8_SB(1, 0), cB + kstep, voffB); G8_STAGE(G8_SA(1, 0), cA + kstep, voffA); G8_STAGE(G8_SB(1, 1), cB + hstepB + kstep, voffB);
        G8_WAIT_V(6); G8_BAR;
    } else {
        G8_STAGE(G8_SB(0, 0), cB, voffB); G8_STAGE(G8_SA(0, 0), cA, voffA); G8_STAGE(G8_SB(0, 1), cB + hstepB, voffB); G8_STAGE(G8_SA(0, 1), cA + hstepA, voffA);
        if (wr == 1) G8_BAR;
        G8_WAIT_V(4); G8_BAR;
        G8_STAGE(G8_SB(1, 0), cB + kstep, voffB); G8_STAGE(G8_SA(1, 0), cA + kstep, voffA); G8_STAGE(G8_SB(1, 1), cB + hstepB + kstep, voffB);
        G8_WAIT_V(6); G8_BAR;
    }
    for (;;) {
        const bool has_next = ph.next(ui + 1, nxt);
        const char* nA = has_next ? nxt.A : cA; const char* nB = has_next ? nxt.B : cB;
#pragma unroll 1
        for (int t = 0; t < nt; t += 2) {
            const bool last = (t == nt - 2);
            const char* a1 = cA + (size_t)(t + 1) * kstep;
            const char* a2 = last ? nA : cA + (size_t)(t + 2) * kstep; const char* b2 = last ? nB : cB + (size_t)(t + 2) * kstep;
            const char* a3 = a2 + kstep; const char* b3 = b2 + kstep;
            if constexpr (SP2) {
            G8_LDB(B0, 0, 0); G8_LDB(B1, 0, 1); G8_SCHED; G8_LDA(At, 0, 0); G8_STAGE(G8_SA(1, 1), a1 + hstepA, voffA);
            G8_WAIT_V(8); G8_WAIT_L(0); G8_BAR; G8_MMA(0, 0, At, B0); G8_MMA(0, 1, At, B1); G8_BAR; G8_SCHED;
            G8_LDA(At, 0, 1); G8_STAGE(G8_SB(0, 0), b2, voffB); G8_STAGE(G8_SB(0, 1), b2 + hstepB, voffB); G8_STAGE(G8_SA(0, 0), a2, voffA);
            G8_WAIT_V(8); G8_WAIT_L(0); G8_BAR; G8_MMA(1, 0, At, B0); G8_MMA(1, 1, At, B1); G8_BAR; G8_SCHED;
            G8_LDB(B0, 1, 0); G8_LDB(B1, 1, 1); G8_SCHED; G8_LDA(At, 1, 0); G8_STAGE(G8_SA(0, 1), a2 + hstepA, voffA);
            G8_WAIT_V(8); G8_WAIT_L(0); G8_BAR; G8_MMA(0, 0, At, B0); G8_MMA(0, 1, At, B1); G8_BAR; G8_SCHED;
            G8_LDA(At, 1, 1); G8_STAGE(G8_SB(1, 0), b3, voffB); G8_STAGE(G8_SB(1, 1), b3 + hstepB, voffB); G8_STAGE(G8_SA(1, 0), a3, voffA);
            G8_WAIT_V(8); G8_WAIT_L(0); G8_BAR; G8_MMA(1, 0, At, B0); G8_MMA(1, 1, At, B1); G8_BAR; G8_SCHED;
            } else {
            G8_LDB(B0, 0, 0); G8_SCHED; G8_LDA(At, 0, 0); G8_STAGE(G8_SA(1, 1), a1 + hstepA, voffA);
            G8_WAIT_L(8); G8_BAR; G8_WAIT_L(0); G8_MMA(0, 0, At, B0); G8_BAR; G8_SCHED;
            G8_LDB(B1, 0, 1); G8_STAGE(G8_SB(0, 0), b2, voffB);
            G8_BAR; G8_WAIT_L(0); G8_MMA(0, 1, At, B1); G8_BAR;
            G8_LDA(At, 0, 1); G8_STAGE(G8_SA(0, 0), a2, voffA);
            G8_BAR; G8_WAIT_L(0); G8_MMA(1, 0, At, B0); G8_BAR; G8_SCHED;
            G8_STAGE(G8_SB(0, 1), b2 + hstepB, voffB);
            G8_WAIT_V(6); G8_BAR; G8_MMA(1, 1, At, B1); G8_BAR;
            G8_LDB(B0, 1, 0); G8_SCHED; G8_LDA(At, 1, 0); G8_STAGE(G8_SA(0, 1), a2 + hstepA, voffA);
            G8_WAIT_L(8); G8_BAR; G8_WAIT_L(0); G8_MMA(0, 0, At, B0); G8_BAR; G8_SCHED;
            G8_LDB(B1, 1, 1); G8_STAGE(G8_SB(1, 0), b3, voffB);
            G8_BAR; G8_WAIT_L(0); G8_MMA(0, 1, At, B1); G8_BAR;
            G8_LDA(At, 1, 1); G8_STAGE(G8_SA(1, 0), a3, voffA);
            G8_BAR; G8_WAIT_L(0); G8_MMA(1, 0, At, B0); G8_BAR; G8_SCHED;
            G8_STAGE(G8_SB(1, 1), b3 + hstepB, voffB);
            G8_WAIT_V(6); G8_BAR; G8_MMA(1, 1, At, B1); G8_BAR;
            }
        }
        if constexpr (ALIGN_EPI) { if (wr == 0) G8_BAR; }
        ph.epi(acc, cur, wr, wc, fr, fq);
        if (!has_next) break;
#pragma unroll
        for (int a = 0; a < 2; ++a)
#pragma unroll
            for (int b = 0; b < 2; ++b)
#pragma unroll
                for (int m = 0; m < 4; ++m)
#pragma unroll
                    for (int n = 0; n < 2; ++n) acc[a][b][m][n] = (f32x4){0.f, 0.f, 0.f, 0.f};
        cur = nxt; cA = nA; cB = nB; ++ui;
        if constexpr (ALIGN_EPI) { if (wr == 1) G8_BAR; }
    }
    G8_WAIT_V(0);
    if constexpr (!ALIGN_EPI) { if (wr == 0) G8_BAR; }
    G8_BAR;
#undef G8_SA
#undef G8_SB
#undef G8_STAGE
#undef G8_LDA
#undef G8_LDB
#undef G8_MMA
#undef G8_WAIT_V
#undef G8_WAIT_L
#undef G8_BAR
#undef G8_SCHED
}
}

struct TJob { const float* src; bf16_t* dst; const float* gain; int K, Nsrc, Ndst, map, nitems; };

DI int map_col(int map, int n0) {
    if (map == 1) return n0 + (n0 >= 6144 ? 16 : 0);
    if (map == 2) { const int t = n0 >> 8, r = n0 & 255; return (r < 128) ? 128 * t + r : DFF + 128 * t + (r - 128); }
    return n0;
}
constexpr int TR_SCR = 64 * 65 * 4;
static_assert(8 * TR_SCR <= LDS_MISC, "transpose scratch must stay below the barrier words");
DI void p0_transpose_item(const TJob& J, LAS float* scr, int item, int lane) {
    const int nblk = J.Ndst / 64, kb = item / nblk, nb = item % nblk, k0 = 64 * kb, n0 = 64 * nb, ns0 = map_col(J.map, n0);
    const float* src = J.src + (size_t)(k0 + (lane >> 4)) * J.Nsrc + ns0 + 4 * (lane & 15);
    f32x4 v[16];
#pragma unroll
    for (int i = 0; i < 16; ++i) v[i] = *(const f32x4*)(src + (size_t)(4 * i) * J.Nsrc);
    if (J.gain) {
#pragma unroll
        for (int i = 0; i < 16; ++i) v[i] *= J.gain[k0 + 4 * i + (lane >> 4)];
    }
#pragma unroll
    for (int i = 0; i < 16; ++i) { LAS float* d = scr + (4 * i + (lane >> 4)) * 65 + 4 * (lane & 15); d[0] = v[i].x; d[1] = v[i].y; d[2] = v[i].z; d[3] = v[i].w; }
    LDS_WAIT(); asm volatile("" ::: "memory");
    const int c = lane & 7;
#pragma unroll
    for (int j = 0; j < 8; ++j) { const int n = (lane >> 3) + 8 * j; const LAS float* s = scr + (8 * c) * 65 + n;
        u32x4 o; o.x = pk2(s[0 * 65], s[1 * 65]); o.y = pk2(s[2 * 65], s[3 * 65]); o.z = pk2(s[4 * 65], s[5 * 65]); o.w = pk2(s[6 * 65], s[7 * 65]);
        *(u32x4*)(J.dst + (size_t)(n0 + n) * J.K + k0 + 8 * c) = o; }
    LDS_WAIT(); asm volatile("" ::: "memory");
}
DI void p0_wps_item(const Params& p, bf16_t* WPS, int item, int lane) {
    const size_t e = (size_t)item * 512 + lane * 8; const float* src = p.w_pool + e;
    const f32x4 a = *(const f32x4*)src, b = *(const f32x4*)(src + 4);
    u32x4 o; o.x = pk2(a.x, a.y); o.y = pk2(a.z, a.w); o.z = pk2(b.x, b.y); o.w = pk2(b.z, b.w);
    *(u32x4*)(WPS + e) = o;
}
DI void p0_plb_item(const Params& p, bf16_t* PLB, int item, int lane) {
    const size_t e = (size_t)item * 512 + lane * 8; const size_t row = e / PLE;
    const float* src = (row < MP) ? p.p_prompt + e : p.p_sample + (e - (size_t)MP * PLE);
    const f32x4 a = *(const f32x4*)src, b = *(const f32x4*)(src + 4);
    u32x4 o; o.x = pk2(a.x, a.y); o.y = pk2(a.z, a.w); o.z = pk2(b.x, b.y); o.w = pk2(b.z, b.w);
    *(u32x4*)(PLB + e) = o;
}

DI void p0_xprep_unit(const Params& p, LAS unsigned char* lds, int u, int wave) {
    const int lane = lane_id(), tid = wave * 64 + lane;
    unsigned char* ws = p.ws;
    bf16_t* XB = (bf16_t*)(ws + WS_XB); float* RSTD1 = (float*)(ws + WS_RSTD1); float* BCUM = (float*)(ws + WS_BCUM); float* LAM = (float*)(ws + WS_LAM);
    LAS unsigned char* WG = lds; LAS float* GL = (LAS float*)(lds + 65536); LAS float* RS = (LAS float*)(lds + 69632);
    {   f32x4 w[16]; float gk[16];
#pragma unroll
        for (int i = 0; i < 16; ++i) { const int idx = tid + 512 * i, k = idx >> 2, n4 = idx & 3; w[i] = *(const f32x4*)(p.w_in + (size_t)k * INW + 6144 + 4 * n4); gk[i] = p.norm_mix[k]; }
#pragma unroll
        for (int i = 0; i < 16; ++i) { const int idx = tid + 512 * i, k = idx >> 2, n4 = idx & 3; LAS bf16_t* d = (LAS bf16_t*)(WG + (size_t)((k >> 3) * 16 + 4 * n4) * 16) + (k & 7);
            const unsigned a = pk2(w[i].x * gk[i], w[i].y * gk[i]), b = pk2(w[i].z * gk[i], w[i].w * gk[i]);
            d[0] = (bf16_t)(a & 0xffffu); d[8] = (bf16_t)(a >> 16); d[16] = (bf16_t)(b & 0xffffu); d[24] = (bf16_t)(b >> 16); }
    }
    __syncthreads();
    if (wave < 4) {
        const int fr = lane & 15, fq = lane >> 4; const int row = 64 * u + 16 * wave + fr;
        const float* xr = (row < MP) ? p.x_prompt + (size_t)row * D : p.x_sample + (size_t)(row - MP) * D;
        f32x4 acc = {0.f, 0.f, 0.f, 0.f}; float ss = 0.f;
#pragma unroll 1
        for (int s0 = 0; s0 < 64; s0 += 8) {
            f32x4 xa[8], xb[8];
#pragma unroll
            for (int i = 0; i < 8; ++i) { xa[i] = *(const f32x4*)(xr + 32 * (s0 + i) + 8 * fq); xb[i] = *(const f32x4*)(xr + 32 * (s0 + i) + 8 * fq + 4); }
#pragma unroll
            for (int i = 0; i < 8; ++i) { const int s = s0 + i; const f32x4 a = xa[i], b = xb[i];
                ss += (a.x * a.x + a.y * a.y) + (a.z * a.z + a.w * a.w) + (b.x * b.x + b.y * b.y) + (b.z * b.z + b.w * b.w);
                u32x4 o; o.x = pk2(a.x, a.y); o.y = pk2(a.z, a.w); o.z = pk2(b.x, b.y); o.w = pk2(b.z, b.w);
                *(u32x4*)(XB + (size_t)row * D + 32 * s + 8 * fq) = o;
                const bf16x8 af = __builtin_bit_cast(bf16x8, o);
                const bf16x8 bfr = *(const LAS bf16x8*)(WG + (size_t)((4 * s + fq) * 16 + fr) * 16);
                acc = __builtin_amdgcn_mfma_f32_16x16x32_bf16(af, bfr, acc, 0, 0, 0); }
        }
        ss += __shfl_xor(ss, 16); ss += __shfl_xor(ss, 32);
        const float rstd = 1.0f / sqrtf(ss * (1.0f / D) + EPS);
        if (fq == 0) { RS[16 * wave + fr] = rstd; RSTD1[row] = rstd; ((float*)(ws + WS_RS1))[row] = 0.f; }
        LDS_WAIT(); asm volatile("" ::: "memory");
#pragma unroll
        for (int j = 0; j < 4; ++j) { const int tl = 16 * wave + 4 * fq + j; GL[tl * 16 + fr] = acc[j] * RS[tl]; }
    }
    __syncthreads();
    const bool sample = (u >= MP / 64);
#pragma unroll 1
    for (int cc = 0; cc < 2; ++cc) {
        const int c = tid + 512 * cc; float wg[16];
#pragma unroll
        for (int j = 0; j < 16; ++j) wg[j] = p.w_gate_up[j * KW + c];
        const float bg = p.b_gate[c]; float cum = 0.f;
#pragma unroll 2
        for (int t = 0; t < 64; ++t) {
            const f32x4 g0 = *(const LAS f32x4*)(GL + t * 16), g1 = *(const LAS f32x4*)(GL + t * 16 + 4), g2 = *(const LAS f32x4*)(GL + t * 16 + 8), g3 = *(const LAS f32x4*)(GL + t * 16 + 12);
            float z = bg;
            z += g0.x * wg[0] + g0.y * wg[1] + g0.z * wg[2] + g0.w * wg[3];
            z += g1.x * wg[4] + g1.y * wg[5] + g1.z * wg[6] + g1.w * wg[7];
            z += g2.x * wg[8] + g2.y * wg[9] + g2.z * wg[10] + g2.w * wg[11];
            z += g3.x * wg[12] + g3.y * wg[13] + g3.z * wg[14] + g3.w * wg[15];
            const float gl = logsigmoidf_(z) * (1.0f / 16.0f);
            const int row = 64 * u + t;
            if (sample) { BCUM[(size_t)row * KW + c] = 0.f; LAM[(size_t)(NCHK + row - MP) * KW + c] = __expf(gl); }
            else { cum = ((t & (CH - 1)) == 0) ? gl : cum + gl; BCUM[(size_t)row * KW + c] = cum; if ((t & (CH - 1)) == CH - 1) LAM[(size_t)(row / CH) * KW + c] = __expf(cum); }
        }
    }
    __syncthreads();
}

constexpr int NXPREP = M / 64;
#ifndef DEFER_W
#define DEFER_W 1
#endif
DI void phase_p0(const Params& p, LAS unsigned char* lds, int wave) {
    const int lane = lane_id();
    unsigned char* ws = p.ws;
#ifndef P0_REP
#define P0_REP 0
#endif
    const int G = gridDim.x, c = blockIdx.x; const bool has_unit = c < NXPREP;
    const int nx = (G < NXPREP) ? G : NXPREP, W_OTHER = 3;
    const int nslots_total = nx * NWAVES + (G - nx) * NWAVES * W_OTHER;
    const int my_n = has_unit ? 1 : W_OTHER;
    const int my_first = has_unit ? c * NWAVES + wave : nx * NWAVES + ((c - nx) * NWAVES + wave) * W_OTHER;
    if (has_unit) { for (int u = c; u < NXPREP; u += G) p0_xprep_unit(p, lds, u, wave); if (P0_REP & 1) p0_xprep_unit(p, lds, c, wave); }
    TJob J[8];
    J[0] = TJob{p.w_in, (bf16_t*)(ws + WS_WIN), p.norm_mix, D, INW, NIN, 1, (D / 64) * (NIN / 64)};
    J[1] = TJob{p.w_up, (bf16_t*)(ws + WS_WUP), p.norm_ffn, D, NUP, NUP, 2, (D / 64) * (NUP / 64)};
    J[2] = TJob{p.w_down, (bf16_t*)(ws + WS_WD), nullptr, DFF, D, D, 0, DEFER_W ? 0 : (DFF / 64) * (D / 64)};
    J[3] = TJob{p.w_branch_a, (bf16_t*)(ws + WS_WA), p.gla_norm, D, D, D, 0, DEFER_W ? 0 : (D / 64) * (D / 64)};
    J[4] = TJob{p.w_out, (bf16_t*)(ws + WS_WO), nullptr, D, D, D, 0, DEFER_W ? 0 : (D / 64) * (D / 64)};
    J[5] = TJob{p.w_ple_gate, (bf16_t*)(ws + WS_WPG), p.norm_ple, D, D, D, 0, DEFER_W ? 0 : (D / 64) * (D / 64)};
    J[6] = TJob{p.w_ple, (bf16_t*)(ws + WS_WPLE), nullptr, PLE, D, D, 0, (PLE / 64) * (D / 64)};
    J[7] = TJob{p.w_branch_b, (bf16_t*)(ws + WS_WBT), p.pool_scale, POOLW, D, D, 0, (POOLW / 64) * (D / 64)};
    LAS float* scr = (LAS float*)(lds + wave * TR_SCR);
    for (int rep = 0; rep < ((P0_REP & 2) ? 2 : 1); ++rep) {
    int base = 0;
#pragma unroll
    for (int j = 0; j < 8; ++j) {
        const int n = J[j].nitems;
        for (int k = 0; k < my_n; ++k) {
            int it = (my_first + k) - (base % nslots_total); if (it < 0) it += nslots_total;
            for (; it < n; it += nslots_total) p0_transpose_item(J[j], scr, it, lane);
        }
        base += n;
    }
    }
    for (int k = 0; k < my_n; ++k) {
        for (int it = my_first + k; it < (POOLW * 256) / 512; it += nslots_total) p0_wps_item(p, (bf16_t*)(ws + WS_WPS), it, lane);
        for (int it = my_first + k; it < (M * PLE) / 512; it += nslots_total) p0_plb_item(p, (bf16_t*)(ws + WS_PLB), it, lane);
    }
}

template <int SET> DI void deferred_transposes(const Params& p, LAS unsigned char* lds, int wave, int idx, int n) {
    if (!DEFER_W) return;
    unsigned char* ws = p.ws; const int lane = lane_id();
    TJob J[2];
    if (SET == 0) { J[0] = TJob{p.w_down, (bf16_t*)(ws + WS_WD), nullptr, DFF, D, D, 0, (DFF / 64) * (D / 64)};
        J[1] = TJob{p.w_ple_gate, (bf16_t*)(ws + WS_WPG), p.norm_ple, D, D, D, 0, (D / 64) * (D / 64)}; }
    else { J[0] = TJob{p.w_branch_a, (bf16_t*)(ws + WS_WA), p.gla_norm, D, D, D, 0, (D / 64) * (D / 64)};
        J[1] = TJob{p.w_out, (bf16_t*)(ws + WS_WO), nullptr, D, D, D, 0, (D / 64) * (D / 64)}; }
    LAS float* scr = (LAS float*)(lds + wave * TR_SCR);
    const int gw = idx * NWAVES + wave, NGW = n * NWAVES;
#pragma unroll
    for (int j = 0; j < 2; ++j) for (int it = gw; it < J[j].nitems; it += NGW) p0_transpose_item(J[j], scr, it, lane);
}

#define MFMA32(a, b, c) __builtin_amdgcn_mfma_f32_32x32x16_bf16((a), (b), (c), 0, 0, 0)
typedef LAS s16x4* lds_s16x4_p;
DI s16x4 tr_read(LAS unsigned char* a) { return __builtin_amdgcn_ds_read_tr16_b64_v4i16((lds_s16x4_p)a); }
DI bf16x8 cat8(s16x4 lo, s16x4 hi) { return __builtin_shufflevector(lo, hi, 0, 1, 2, 3, 4, 5, 6, 7); }
DI bf16x8 ld_perm(const bf16_t* p) {
    const u32x2 a = *(const u32x2*)p, b = *(const u32x2*)(p + 8);
    u32x4 r; r.x = a.x; r.y = a.y; r.z = b.x; r.w = b.y; return __builtin_bit_cast(bf16x8, r);
}
template <int S> DI bf16x8 pack_step(const f32x16& x) {
    u32x4 r; r.x = pk2(x[8 * S + 0], x[8 * S + 1]); r.y = pk2(x[8 * S + 2], x[8 * S + 3]); r.z = pk2(x[8 * S + 4], x[8 * S + 5]); r.w = pk2(x[8 * S + 6], x[8 * S + 7]);
    return __builtin_bit_cast(bf16x8, r);
}
DI f32x16 zero16() { f32x16 z;
#pragma unroll
    for (int i = 0; i < 16; ++i) z[i] = 0.f; return z; }

constexpr int SC_BUF = 50176, SC_QI = 0, SC_KI = 16384, SC_VI = 32768, SC_LMI = 49152, SC_ATT = 3 * SC_BUF, SC_BYTES = SC_ATT + 2048;
static_assert(SC_BYTES <= LDS_MISC, "scan LDS map");
DI void dma16(const void* g, LAS unsigned char* l) { __builtin_amdgcn_global_load_lds((const unsigned*)g, (LAS unsigned*)l, 16, 0, 0); }
DI bf16x8 lds_perm(LAS unsigned char* a) {
    const u32x2 x = *(const LAS u32x2*)a, y = *(const LAS u32x2*)(a + 512);
    u32x4 r; r.x = x.x; r.y = x.y; r.z = y.x; r.w = y.y; return __builtin_bit_cast(bf16x8, r);
}
#define SC_BAR() do { asm volatile("s_waitcnt lgkmcnt(0)" ::: "memory"); __builtin_amdgcn_s_barrier(); asm volatile("" ::: "memory"); } while (0)
DI void scan_block(const Params& p, LAS unsigned char* lds, int task, int wave) {
    unsigned char* ws = p.ws;
    const bf16_t* QB = (const bf16_t*)(ws + WS_QB); const bf16_t* KB = (const bf16_t*)(ws + WS_KB);
    const bf16_t* V = (const bf16_t*)(ws + WS_V); bf16_t* OG = (bf16_t*)(ws + WS_OG);
    const float* LAM = (const float*)(ws + WS_LAM); float* OSS = (float*)(ws + WS_OSS);
    const int half = task & 1, hd = (task >> 1) & 3, b = task >> 3, sl = 8 * half + wave;
    f32x16 S[8];
#pragma unroll
    for (int db = 0; db < 8; ++db) S[db] = zero16();

#define SC_ISSUE(ch_, slot_) do { const int _l = lane_id(); const size_t _r0 = (size_t)(b * SEQ + CH * (ch_)); LAS unsigned char* _lb = lds + (slot_) * SC_BUF; asm volatile("" : "+s"(_lb)); \
        _Pragma("unroll") for (int _k = 0; _k < 2; ++_k) { const int _i = 2 * wave + _k; \
            const int _row = _l & 31, _cc = 2 * _i + (_l >> 5); \
            dma16(QB + (_r0 + _row) * KW + hd * 256 + 8 * _cc, _lb + SC_QI + _i * 1024); \
            const int _s = 2 * _i + (_l >> 5), _c2 = (_l & 31) ^ (4 * (_s & 3)); \
            dma16(KB + (_r0 + _s) * KW + hd * 256 + 8 * _c2, _lb + SC_KI + _i * 1024); dma16(V + (_r0 + _s) * VW + hd * 512 + 256 * half + 8 * _c2, _lb + SC_VI + _i * 1024); } \
        if (wave == 0) dma16(LAM + (size_t)(b * (SEQ / CH) + (ch_)) * KW + hd * 256 + 4 * _l, _lb + SC_LMI); } while (0)
    constexpr int NCH = SEQ / CH;
    SC_ISSUE(0, 0); SC_ISSUE(1, 1);
    int slot = 0;
#pragma unroll 1
    for (int ch = 0; ch < NCH; ++ch) {
        const int row0 = b * SEQ + CH * ch;
        if (ch == 0) { if (wave == 0) asm volatile("s_waitcnt vmcnt(7)" ::: "memory"); else asm volatile("s_waitcnt vmcnt(6)" ::: "memory"); }
        else if (ch == 1) { if (wave == 0) asm volatile("s_waitcnt vmcnt(11)" ::: "memory"); else asm volatile("s_waitcnt vmcnt(10)" ::: "memory"); }
        else if (ch + 1 < NCH) { if (wave == 0) asm volatile("s_waitcnt vmcnt(15)" ::: "memory"); else asm volatile("s_waitcnt vmcnt(14)" ::: "memory"); }
        else VM_WAIT();
        SC_BAR();
        { const int s2 = (slot == 0) ? 2 : slot - 1; if (ch + 2 < NCH) SC_ISSUE(ch + 2, s2); }
        const int lane = lane_id();
        const int c = lane & 31, h = lane >> 5;
        const int i16 = lane & 15, q = i16 >> 2, pp = i16 & 3, jb = (lane >> 4) & 1;
        LAS unsigned char* buf = lds + slot * SC_BUF;
        LAS unsigned char* ATT = lds + SC_ATT;

        if (wave < 4) {
            const int si = wave >> 1, ti = wave & 1, fr = lane & 15, fq = lane >> 4;
            f32x4 a = {0.f, 0.f, 0.f, 0.f};
            LAS unsigned char* kp = buf + SC_KI + (16 * si + fr) * 512; LAS unsigned char* qp = buf + SC_QI + fq * 512 + (16 * ti + fr) * 16;
            const int kx = 4 * (fr & 3);
#pragma unroll
            for (int ks = 0; ks < 8; ++ks) a = __builtin_amdgcn_mfma_f32_16x16x32_bf16(*(const LAS bf16x8*)(kp + (((4 * ks + fq) ^ kx) * 16)), *(const LAS bf16x8*)(qp + 2048 * ks), a, 0, 0, 0);
            const int s0 = 16 * si + 4 * fq, t = 16 * ti + fr;
            u32x2 w; w.x = pk2(s0 + 0 <= t ? a[0] : 0.f, s0 + 1 <= t ? a[1] : 0.f); w.y = pk2(s0 + 2 <= t ? a[2] : 0.f, s0 + 3 <= t ? a[3] : 0.f);
            *(LAS u32x2*)(ATT + t * 64 + s0 * 2) = w;
        }
        SC_BAR();

        f32x16 o = zero16();
        LAS unsigned char* vb = buf + SC_VI + (8 * h + q) * 512 + (4 * (wave ^ q) + 2 * jb + (pp >> 1)) * 16 + (pp & 1) * 8;
        const bf16x8 vf0 = cat8(tr_read(vb), tr_read(vb + 4 * 512)), vf1 = cat8(tr_read(vb + 16 * 512), tr_read(vb + 20 * 512));
        {
            LAS unsigned char* ab = ATT + c * 64 + 16 * h;
            o = MFMA32(vf0, *(const LAS bf16x8*)ab, o);
            o = MFMA32(vf1, *(const LAS bf16x8*)(ab + 32), o);
            LAS unsigned char* qa = buf + SC_QI + c * 16 + 8 * h;
#pragma unroll
            for (int db = 0; db < 8; ++db) {
                { const bf16x8 qf = lds_perm(qa + 2048 * db); o = MFMA32(pack_step<0>(S[db]), qf, o); }
                { const bf16x8 qf = lds_perm(qa + 2048 * db + 1024); o = MFMA32(pack_step<1>(S[db]), qf, o); }
                if ((db & 3) == 3) __builtin_amdgcn_sched_barrier(0);
            }
            const int t = row0 + c;
            float ss = 0.f;
#pragma unroll
            for (int r = 0; r < 16; ++r) ss += o[r] * o[r];
            { const auto sw = __builtin_amdgcn_permlane32_swap(__float_as_uint(ss), __float_as_uint(ss), false, false); ss = __uint_as_float(sw[0]) + __uint_as_float(sw[1]); }
            if (h == 0) OSS[(size_t)t * 64 + hd * 16 + sl] = ss;
            bf16_t* og = OG + (size_t)row0 * VW + hd * 512 + 32 * sl + c * VW + 4 * h;
#pragma unroll
            for (int g = 0; g < 4; ++g) { u32x2 w; w.x = pk2(o[4 * g + 0], o[4 * g + 1]); w.y = pk2(o[4 * g + 2], o[4 * g + 3]); *(u32x2*)(og + 8 * g) = w; }
        }
        __builtin_amdgcn_sched_barrier(0);

        {
            LAS unsigned char* kbase = buf + SC_KI + (8 * h + q) * 512 + (2 * jb + (pp >> 1)) * 16 + (pp & 1) * 8;
            LAS unsigned char* lm = buf + SC_LMI + 16 * h;
#pragma unroll
            for (int db = 0; db < 8; ++db) {
                LAS unsigned char* kb = kbase + (((db & 3) ^ q) * 4) * 16 + (db >> 2) * 256;
                S[db] = MFMA32(cat8(tr_read(kb), tr_read(kb + 4 * 512)), vf0, S[db]);
                S[db] = MFMA32(cat8(tr_read(kb + 16 * 512), tr_read(kb + 20 * 512)), vf1, S[db]);
#pragma unroll
                for (int g = 0; g < 4; ++g) { const f32x4 l4 = *(const LAS f32x4*)(lm + (32 * db + 8 * g) * 4);
                    S[db][4 * g + 0] *= l4.x; S[db][4 * g + 1] *= l4.y; S[db][4 * g + 2] *= l4.z; S[db][4 * g + 3] *= l4.w; }
                if (db & 1) __builtin_amdgcn_sched_barrier(0);
            }
        }
        asm volatile("" ::: "memory");
        slot = (slot == 2) ? 0 : slot + 1;
    }
#undef SC_ISSUE
    {   const int lane = lane_id();
        const unsigned voff = (unsigned)(((lane >> 5) * 4 * DV + (lane & 31)) * 4);
        const char* gbase = (const char*)(p.out + O_GLAP + ((size_t)(b * NH + hd) * DK) * DV + 32 * sl);
#pragma unroll
        for (int db = 0; db < 8; ++db) {
#pragma unroll
            for (int r = 0; r < 16; ++r) { const int dl = 32 * db + (r & 3) + 8 * (r >> 2); *(float*)(const_cast<char*>(gbase) + (size_t)dl * DV * 4 + voff) = S[db][r]; }
        }
    }
    __syncthreads();
}

DI void sgla_task(const Params& p, int task, int lane) {
    unsigned char* ws = p.ws;
    const bf16_t* QB = (const bf16_t*)(ws + WS_QB); const bf16_t* KB = (const bf16_t*)(ws + WS_KB); const bf16_t* V = (const bf16_t*)(ws + WS_V);
    const float* LAM = (const float*)(ws + WS_LAM); float* OSP = (float*)(ws + WS_OSP);
    const int dblk = task & 7, hd = (task >> 3) & 3, b = task >> 5; const int row = MP + b;
    const size_t sbase = ((size_t)(b * NH + hd) * DK + 32 * dblk) * DV;
    const float* S0 = p.state_gla + sbase; float* So = p.out + O_GLAS + sbase;
    const int dl = lane & 31;
    const float lam_l = LAM[(size_t)(NCHK + b) * KW + hd * 256 + 32 * dblk + dl];
    const float k_l = bf1(KB[(size_t)row * KW + hd * 256 + 32 * dblk + dl]);
    const float q_l = bf1(QB[(size_t)row * KW + hd * 256 + 32 * dblk + dl]);
    f32x4 va, vb;
    { const u32x2 w = *(const u32x2*)(V + (size_t)row * VW + hd * 512 + 4 * lane); va = (f32x4){bflo(w.x), bfhi(w.x), bflo(w.y), bfhi(w.y)}; }
    { const u32x2 w = *(const u32x2*)(V + (size_t)row * VW + hd * 512 + 256 + 4 * lane); vb = (f32x4){bflo(w.x), bfhi(w.x), bflo(w.y), bfhi(w.y)}; }
    f32x4 oa = {0.f, 0.f, 0.f, 0.f}, ob = {0.f, 0.f, 0.f, 0.f};
#pragma unroll 1
    for (int d0 = 0; d0 < 32; d0 += 16) {
        f32x4 ra[16], rb[16];
#pragma unroll
        for (int i = 0; i < 16; ++i) { ra[i] = __builtin_nontemporal_load((const f32x4*)(S0 + (size_t)(d0 + i) * DV + 4 * lane)); rb[i] = __builtin_nontemporal_load((const f32x4*)(S0 + (size_t)(d0 + i) * DV + 256 + 4 * lane)); }
#pragma unroll
        for (int i = 0; i < 16; ++i) { const int d = d0 + i;
            const float lam = __uint_as_float(__builtin_amdgcn_readlane(__float_as_uint(lam_l), d)), kk = __uint_as_float(__builtin_amdgcn_readlane(__float_as_uint(k_l), d)), qq = __uint_as_float(__builtin_amdgcn_readlane(__float_as_uint(q_l), d));
            const f32x4 sa = ra[i] * lam + va * kk, sb = rb[i] * lam + vb * kk;
            __builtin_nontemporal_store(sa, (f32x4*)(So + (size_t)d * DV + 4 * lane)); __builtin_nontemporal_store(sb, (f32x4*)(So + (size_t)d * DV + 256 + 4 * lane));
            oa += sa * qq; ob += sb * qq; }
    }
    float* op = OSP + ((size_t)(b * NH + hd) * 8 + dblk) * DV;
    *(f32x4*)(op + 4 * lane) = oa; *(f32x4*)(op + 256 + 4 * lane) = ob;
}

DI void pmix_task(const Params& p, int t, int lane) {
    unsigned char* ws = p.ws;
    const float* U = (const float*)(ws + WS_U); bf16_t* PM = (bf16_t*)(ws + WS_PM);
    if (t < MP) {
        const int b = t >> 11, pos = t & 2047;
#pragma unroll
        for (int i = 0; i < 4; ++i) {
            const int w = 2 << i, c = 256 * i + 4 * lane; const int cnt = (pos + 1 < w) ? pos + 1 : w;
            const f32x4 u0 = *(const f32x4*)(U + (size_t)t * POOLW + c); f32x4 s = u0;
#pragma unroll
            for (int j = 1; j < w; ++j) {
                const bool in = j < cnt; const f32x4 v = *(const f32x4*)(U + (size_t)(in ? t - j : t) * POOLW + c); const float m = in ? 1.f : 0.f; s += v * m; }
            const float inv = 1.0f / (float)cnt; const f32x4 mx = s * inv - u0;
            u32x2 o; o.x = pk2(mx.x, mx.y); o.y = pk2(mx.z, mx.w); *(u32x2*)(PM + (size_t)t * POOLW + c) = o;
            if (pos >= SEQ - 15) *(f32x4*)(p.out + O_POOLP + ((size_t)b * 15 + (pos - (SEQ - 15))) * POOLW + c) = u0;
        }
    } else {
        const int b = t - MP; const float* sp = p.state_pool + (size_t)b * 15 * POOLW; float* po = p.out + O_POOLS + (size_t)b * 15 * POOLW;
#pragma unroll
        for (int i = 0; i < 4; ++i) {
            const int w = 2 << i, c = 256 * i + 4 * lane;
            const f32x4 u0 = *(const f32x4*)(U + (size_t)t * POOLW + c); f32x4 s = u0;
#pragma unroll
            for (int j = 1; j < w; ++j) s += *(const f32x4*)(sp + (size_t)(15 - j) * POOLW + c);
            const float inv = 1.0f / (float)w; const f32x4 mx = s * inv - u0;
            u32x2 o; o.x = pk2(mx.x, mx.y); o.y = pk2(mx.z, mx.w); *(u32x2*)(PM + (size_t)t * POOLW + c) = o;
            *(f32x4*)(po + (size_t)14 * POOLW + c) = u0;
        }
    }
}

DI void pool_copy_task(const Params& p, int item, int lane) {
    const int b = item / 14, r = item - 14 * b; const float* src = p.state_pool + ((size_t)b * 15 + r + 1) * POOLW + 4 * lane; float* dst = p.out + O_POOLS + ((size_t)b * 15 + r) * POOLW + 4 * lane;
    const f32x4 v0 = *(const f32x4*)src, v1 = *(const f32x4*)(src + 256), v2 = *(const f32x4*)(src + 512), v3 = *(const f32x4*)(src + 768);
    *(f32x4*)dst = v0; *(f32x4*)(dst + 256) = v1; *(f32x4*)(dst + 512) = v2; *(f32x4*)(dst + 768) = v3;
}
#ifndef P2_REP
#define P2_REP 0
#endif
DI void scan_role(const Params& p, LAS unsigned char* lds, int wave, int idx, int n) {
    for (int rep = 0; rep < ((P2_REP & 1) ? 2 : 1); ++rep) for (int task = (n == 32) ? (idx % 8) * 4 + idx / 8 : idx; task < 2 * NB * NH; task += n) scan_block(p, lds, task, wave);
}
DI void stream_role(const Params& p, int wave, int idx, int n) {
    const int lane = lane_id(); const int gw = idx * NWAVES + wave, NGW = n * NWAVES;
    for (int rep = 0; rep < ((P2_REP & 2) ? 2 : 1); ++rep) {
        for (int it = gw; it < MS * 14; it += NGW) pool_copy_task(p, it, lane);
        for (int task = gw; task < MS * NH * 8; task += NGW) sgla_task(p, task, lane); }
}

DI void ogn_task(const Params& p, int t, int lane) {
    unsigned char* ws = p.ws;
    bf16_t* OG = (bf16_t*)(ws + WS_OG); const float* OSS = (const float*)(ws + WS_OSS); const float* OSP = (const float*)(ws + WS_OSP); const bf16_t* SR = (const bf16_t*)(ws + WS_SR);
    if (t < MP) {
#pragma unroll
        for (int hd = 0; hd < 4; ++hd) {
            const float* sp = OSS + (size_t)t * 64 + hd * 16; const f32x4 a = *(const f32x4*)sp, b = *(const f32x4*)(sp + 4), c = *(const f32x4*)(sp + 8), d = *(const f32x4*)(sp + 12);
            const float ss = ((a.x + a.y) + (a.z + a.w)) + ((b.x + b.y) + (b.z + b.w)) + ((c.x + c.y) + (c.z + c.w)) + ((d.x + d.y) + (d.z + d.w));
            const float rstd = 1.0f / sqrtf(ss * (1.0f / DV) + EPS);
            bf16_t* op = OG + (size_t)t * VW + hd * 512 + 8 * lane; const u32x4 w = *(const u32x4*)op; const u32x4 g = *(const u32x4*)(SR + (size_t)t * VW + hd * 512 + 8 * lane);
            u32x4 o; o.x = pk2(bflo(w.x) * rstd * bflo(g.x), bfhi(w.x) * rstd * bfhi(g.x)); o.y = pk2(bflo(w.y) * rstd * bflo(g.y), bfhi(w.y) * rstd * bfhi(g.y));
            o.z = pk2(bflo(w.z) * rstd * bflo(g.z), bfhi(w.z) * rstd * bfhi(g.z)); o.w = pk2(bflo(w.w) * rstd * bflo(g.w), bfhi(w.w) * rstd * bfhi(g.w));
            *(u32x4*)op = o;
        }
    } else {
        const int b = t - MP;
#pragma unroll
        for (int hd = 0; hd < 4; ++hd) {
            f32x4 oa = {0.f, 0.f, 0.f, 0.f}, ob = {0.f, 0.f, 0.f, 0.f};
#pragma unroll
            for (int k = 0; k < 8; ++k) { const float* op = OSP + ((size_t)(b * NH + hd) * 8 + k) * DV + 8 * lane; oa += *(const f32x4*)op; ob += *(const f32x4*)(op + 4); }
            float ss = (oa.x * oa.x + oa.y * oa.y) + (oa.z * oa.z + oa.w * oa.w) + (ob.x * ob.x + ob.y * ob.y) + (ob.z * ob.z + ob.w * ob.w);
            ss = wave_sum(ss);
            const float rstd = 1.0f / sqrtf(ss * (1.0f / DV) + EPS);
            const u32x4 w = *(const u32x4*)(SR + (size_t)t * VW + hd * 512 + 8 * lane);
            u32x4 o; o.x = pk2(oa.x * rstd * bflo(w.x), oa.y * rstd * bfhi(w.x)); o.y = pk2(oa.z * rstd * bflo(w.y), oa.w * rstd * bfhi(w.y));
            o.z = pk2(ob.x * rstd * bflo(w.z), ob.y * rstd * bfhi(w.z)); o.w = pk2(ob.z * rstd * bflo(w.w), ob.w * rstd * bfhi(w.w));
            *(u32x4*)(OG + (size_t)t * VW + hd * 512 + 8 * lane) = o;
        }
    }
}
DI void phase_p3(const Params& p, int wave) {
    const int lane = lane_id();
    const int gw = (int)blockIdx.x * NWAVES + wave, NGW = gridDim.x * NWAVES;
    for (int t = gw; t < M; t += NGW) pmix_task(p, t, lane);
    for (int t = gw; t < M; t += NGW) ogn_task(p, t, lane);
}

DI float row_rstd(const float* SS, const float* SSs, int row, int lane) {
    float v = (row < MP) ? ((lane < 32) ? SS[(size_t)row * 32 + lane] : 0.f) : (SSs[(size_t)(row - MP) * 128 + lane] + SSs[(size_t)(row - MP) * 128 + 64 + lane]);
    v = wave_sum(v);
    return 1.0f / sqrtf(v * (1.0f / D) + EPS);
}

struct F8 { f32x4 a, b; };
DI F8 unpack8(u32x4 w, float s) { F8 r; r.a = (f32x4){bflo(w.x) * s, bfhi(w.x) * s, bflo(w.y) * s, bfhi(w.y) * s}; r.b = (f32x4){bflo(w.z) * s, bfhi(w.z) * s, bflo(w.w) * s, bfhi(w.w) * s}; return r; }
DI F8 ld8(const float* q) { F8 r; r.a = *(const f32x4*)q; r.b = *(const f32x4*)(q + 4); return r; }
DI void st8(float* q, const F8& v) { *(f32x4*)q = v.a; *(f32x4*)(q + 4) = v.b; }
DI f32x4 silu4(f32x4 x) { return (f32x4){siluf_(x.x), siluf_(x.y), siluf_(x.z), siluf_(x.w)}; }
DI void conv_fixup_tile(const Params& p, int pm, int wave) {
    if ((pm & 7) == 0) return;
    unsigned char* ws = p.ws; const int tid = wave * 64 + lane_id();
    const float* HALO = (const float*)(ws + WS_HALO) + (size_t)(pm - 1) * 2 * DFF; const float* FG = (const float*)(ws + WS_FIXG) + (size_t)pm * 2 * DFF; const float* FU = (const float*)(ws + WS_FIXU) + (size_t)pm * 2 * DFF;
    bf16_t* ACT = (bf16_t*)(ws + WS_ACT) + (size_t)pm * 256 * DFF;
    for (int v = tid; v < DFF / 8; v += NTHREADS) { const int ch0 = 8 * v;
        const F8 w0 = ld8(p.conv_w + ch0), w1 = ld8(p.conv_w + DFF + ch0), w2 = ld8(p.conv_w + 2 * DFF + ch0), cb = ld8(p.conv_b + ch0);
        const F8 h14 = ld8(HALO + ch0), h15 = ld8(HALO + DFF + ch0), g0 = ld8(FG + ch0), g1 = ld8(FG + DFF + ch0), u0 = ld8(FU + ch0), u1 = ld8(FU + DFF + ch0);
        const f32x4 a0 = silu4(cb.a + w0.a * h14.a + w1.a * h15.a + w2.a * g0.a) * u0.a, b0 = silu4(cb.b + w0.b * h14.b + w1.b * h15.b + w2.b * g0.b) * u0.b;
        const f32x4 a1 = silu4(cb.a + w0.a * h15.a + w1.a * g0.a + w2.a * g1.a) * u1.a, b1 = silu4(cb.b + w0.b * h15.b + w1.b * g0.b + w2.b * g1.b) * u1.b;
        *(u32x4*)(ACT + ch0) = pk8(a0, b0); *(u32x4*)(ACT + DFF + ch0) = pk8(a1, b1); }
}

DI void phase_final(const Params& p, int wave) {
    const int lane = lane_id();
    const int gw = (int)blockIdx.x * NWAVES + wave, NGW = gridDim.x * NWAVES;
    const bf16_t* H3 = (const bf16_t*)(p.ws + WS_H3); const float* SS3 = (const float*)(p.ws + WS_SS3); const float* SS3S = (const float*)(p.ws + WS_SS3S);
    for (int t = gw; t < M; t += NGW) {
        const float rs = row_rstd(SS3, SS3S, t, lane);
        float* yo = (t < MP) ? p.out + O_YP + (size_t)t * D : p.out + O_YS + (size_t)(t - MP) * D;
#pragma unroll
        for (int i = 0; i < 4; ++i) { const int c = 512 * i + 8 * lane; const u32x4 w = *(const u32x4*)(H3 + (size_t)t * D + c); const f32x4 g0 = *(const f32x4*)(p.norm_final + c), g1 = *(const f32x4*)(p.norm_final + c + 4);
            *(f32x4*)(yo + c) = bf4lo(w) * rs * g0; *(f32x4*)(yo + c + 4) = bf4hi(w) * rs * g1; }
    }
}

#define EPI_ARGS const f32x4 (&acc)[2][2][4][2], const g8::Unit& u, int wr, int wc, int fr, int fq
#define EPI_ROWS(ROWVAR) _Pragma("unroll") for (int ai = 0; ai < 2; ++ai) _Pragma("unroll") for (int m = 0; m < 4; ++m) { const int ROWVAR = u.pm * 256 + ai * 128 + wr * 64 + m * 16 + fr; if (ROWVAR < M) {
#define EPI_COLS(COLVAR) _Pragma("unroll") for (int bj = 0; bj < 2; ++bj) { const int COLVAR = bj * 128 + wc * 32 + 8 * fq; const f32x4 v0 = acc[ai][bj][m][0], v1 = acc[ai][bj][m][1];
#define EPI_END } } }
DI f32x4 exp4(f32x4 x) { return (f32x4){__expf(x.x), __expf(x.y), __expf(x.z), __expf(x.w)}; }
DI f32x4 sig4(f32x4 x) { return (f32x4){sigmoidf_(x.x), sigmoidf_(x.y), sigmoidf_(x.z), sigmoidf_(x.w)}; }
DI float sum4(f32x4 a) { return (a.x + a.y) + (a.z + a.w); }

struct PhaseIn {
    static constexpr int LDA = D, LDB = D, KT = D / 64;
    const Params& p; int G, c, part;
    int c0;
    DI bool next(int i, g8::Unit& u) const { int pm, pn;
        if (part == 0) { if (!g8::grid_order(NTM - 1, 16, G, c, i, pm, pn)) return false; }
        else { if (c < c0 || !g8::grid_order(NTM, 28, G - c0, c - c0, i, pm, pn)) return false; pn += 16; }
        u.pm = pm; u.pn = pn; u.A = (const char*)(p.ws + WS_XB) + (size_t)pm * 256 * D * 2; u.B = (const char*)(p.ws + WS_WIN) + (size_t)pn * 256 * D * 2; return true; }
    DI void epi(EPI_ARGS) const {
        unsigned char* ws = p.ws; const float* RSTD1 = (const float*)(ws + WS_RSTD1); const float* BCUM = (const float*)(ws + WS_BCUM);
        const int pn = u.pn;
        if (pn < 4) {
            bf16_t* QB = (bf16_t*)(ws + WS_QB);
            EPI_ROWS(row) const float rs = RSTD1[row] * 0.0625f; EPI_COLS(col) const size_t o = (size_t)row * KW + pn * 256 + col;
                const f32x4 e0 = exp4(*(const f32x4*)(BCUM + o)), e1 = exp4(*(const f32x4*)(BCUM + o + 4));
                *(u32x4*)(QB + o) = pk8(v0 * rs * e0, v1 * rs * e1); EPI_END
        } else if (pn < 8) {
            bf16_t* KB = (bf16_t*)(ws + WS_KB);
            EPI_ROWS(row) const float rs = RSTD1[row]; EPI_COLS(col) const size_t o = (size_t)row * KW + (pn - 4) * 256 + col;
                const f32x4 b0 = *(const f32x4*)(BCUM + o), b1 = *(const f32x4*)(BCUM + o + 4);
                *(u32x4*)(KB + o) = pk8(v0 * rs * exp4(-b0), v1 * rs * exp4(-b1)); EPI_END
        } else if (pn < 16) {
            bf16_t* V = (bf16_t*)(ws + WS_V);
            EPI_ROWS(row) const float rs = RSTD1[row]; EPI_COLS(col) *(u32x4*)(V + (size_t)row * VW + (pn - 8) * 256 + col) = pk8(v0 * rs, v1 * rs); EPI_END
        } else if (pn < 24) {
            bf16_t* SR = (bf16_t*)(ws + WS_SR);
            EPI_ROWS(row) const float rs = RSTD1[row]; EPI_COLS(col) const f32x4 a = v0 * rs, b = v1 * rs; *(u32x4*)(SR + (size_t)row * VW + (pn - 16) * 256 + col) = pk8(a * sig4(a), b * sig4(b)); EPI_END
        } else if (pn < 28) {
            float* U = (float*)(ws + WS_U);
            EPI_ROWS(row) const float rs = RSTD1[row]; EPI_COLS(col) float* o = U + (size_t)row * POOLW + (pn - 24) * 256 + col; *(f32x4*)o = v0 * rs; *(f32x4*)(o + 4) = v1 * rs; EPI_END
        } else {
            bf16_t* Gt = (bf16_t*)(ws + (pn < 36 ? WS_GA : WS_GB)); const int c0 = (pn < 36 ? pn - 28 : pn - 36) * 256;
            EPI_ROWS(row) const float rs = RSTD1[row]; EPI_COLS(col) *(u32x4*)(Gt + (size_t)row * D + c0 + col) = pk8(sig4(v0 * rs), sig4(v1 * rs)); EPI_END
        }
    }
};

template <int LDA_, int LDB_, int K_> struct PhaseN2048 {
    static constexpr int LDA = LDA_, LDB = LDB_, KT = K_ / 64;
    const Params& p; int G, c; size_t a_off, b_off;
    DI bool next_(int i, g8::Unit& u) const { int pm, pn; if (!g8::grid_order(NTM - 1, 8, G, c, i, pm, pn)) return false;
        u.pm = pm; u.pn = pn; u.A = (const char*)(p.ws + a_off) + (size_t)pm * 256 * LDA * 2; u.B = (const char*)(p.ws + b_off) + (size_t)pn * 256 * LDB * 2; return true; }
};
struct PhaseYb : PhaseN2048<POOLW, POOLW, POOLW> {
    DI bool next(int i, g8::Unit& u) const { return next_(i, u); }
    DI void epi(EPI_ARGS) const { const bf16_t* GB = (const bf16_t*)(p.ws + WS_GB); bf16_t* Y = (bf16_t*)(p.ws + WS_YBG);
#pragma unroll
        for (int ai = 0; ai < 2; ++ai) { u32x4 g[4][2];
#pragma unroll
            for (int m = 0; m < 4; ++m)
#pragma unroll
                for (int bj = 0; bj < 2; ++bj) g[m][bj] = *(const u32x4*)(GB + (size_t)(u.pm * 256 + ai * 128 + wr * 64 + m * 16 + fr) * D + u.pn * 256 + bj * 128 + wc * 32 + 8 * fq);
#pragma unroll
            for (int m = 0; m < 4; ++m)
#pragma unroll
                for (int bj = 0; bj < 2; ++bj) { const size_t o = (size_t)(u.pm * 256 + ai * 128 + wr * 64 + m * 16 + fr) * D + u.pn * 256 + bj * 128 + wc * 32 + 8 * fq;
                    *(u32x4*)(Y + o) = pk8(acc[ai][bj][m][0] * bf4lo(g[m][bj]), acc[ai][bj][m][1] * bf4hi(g[m][bj])); } } }
};
struct PhaseYa : PhaseN2048<VW, VW, VW> {
    DI bool next(int i, g8::Unit& u) const { return next_(i, u); }
    DI void epi(EPI_ARGS) const { const bf16_t* GA = (const bf16_t*)(p.ws + WS_GA); const bf16_t* Y = (const bf16_t*)(p.ws + WS_YBG); bf16_t* MB = (bf16_t*)(p.ws + WS_MB);
#pragma unroll
        for (int ai = 0; ai < 2; ++ai) { u32x4 g[4][2], y[4][2];
#pragma unroll
            for (int m = 0; m < 4; ++m)
#pragma unroll
                for (int bj = 0; bj < 2; ++bj) { const size_t o = (size_t)(u.pm * 256 + ai * 128 + wr * 64 + m * 16 + fr) * D + u.pn * 256 + bj * 128 + wc * 32 + 8 * fq;
                    g[m][bj] = *(const u32x4*)(GA + o); y[m][bj] = *(const u32x4*)(Y + o); }
#pragma unroll
            for (int m = 0; m < 4; ++m)
#pragma unroll
                for (int bj = 0; bj < 2; ++bj) { const size_t o = (size_t)(u.pm * 256 + ai * 128 + wr * 64 + m * 16 + fr) * D + u.pn * 256 + bj * 128 + wc * 32 + 8 * fq;
                    *(u32x4*)(MB + o) = pk8(acc[ai][bj][m][0] * bf4lo(g[m][bj]) + bf4lo(y[m][bj]), acc[ai][bj][m][1] * bf4hi(g[m][bj]) + bf4hi(y[m][bj])); } } }
};
template <bool BASE_BF16, bool ATOMIC_SS>
DI void epi_residual(EPI_ARGS, const void* base_v, bf16_t* HB, float* SS) {
#pragma unroll
    for (int ai = 0; ai < 2; ++ai)
#pragma unroll
        for (int mh = 0; mh < 2; ++mh) {
            f32x4 b0[2][2], b1[2][2];
#pragma unroll
            for (int mm = 0; mm < 2; ++mm) { const int row = u.pm * 256 + ai * 128 + wr * 64 + (2 * mh + mm) * 16 + fr;
#pragma unroll
                for (int bj = 0; bj < 2; ++bj) { const size_t o = (size_t)row * D + u.pn * 256 + bj * 128 + wc * 32 + 8 * fq;
                    if (BASE_BF16) { const u32x4 w = *(const u32x4*)((const bf16_t*)base_v + o); b0[mm][bj] = bf4lo(w); b1[mm][bj] = bf4hi(w); }
                    else { b0[mm][bj] = *(const f32x4*)((const float*)base_v + o); b1[mm][bj] = *(const f32x4*)((const float*)base_v + o + 4); } } }
#pragma unroll
            for (int mm = 0; mm < 2; ++mm) { const int m = 2 * mh + mm; const int row = u.pm * 256 + ai * 128 + wr * 64 + m * 16 + fr; float ss = 0.f;
#pragma unroll
                for (int bj = 0; bj < 2; ++bj) { const size_t o = (size_t)row * D + u.pn * 256 + bj * 128 + wc * 32 + 8 * fq;
                    const f32x4 h0 = acc[ai][bj][m][0] + b0[mm][bj], h1 = acc[ai][bj][m][1] + b1[mm][bj];
                    *(u32x4*)(HB + o) = pk8(h0, h1);
                    ss += sum4(h0 * h0) + sum4(h1 * h1); }
                ss += __shfl_xor(ss, 16); ss += __shfl_xor(ss, 32);
                if (fq == 0) { if (ATOMIC_SS) __hip_atomic_fetch_add(SS + row, ss, __ATOMIC_RELAXED, __HIP_MEMORY_SCOPE_AGENT); else SS[(size_t)row * 32 + u.pn * 4 + wc] = ss; } }
        }
}
struct PhaseOut : PhaseN2048<D, D, D> {
    DI bool next(int i, g8::Unit& u) const { return next_(i, u); }
    DI void epi(EPI_ARGS) const { epi_residual<false, true>(acc, u, wr, wc, fr, fq, p.x_prompt, (bf16_t*)(p.ws + WS_H1B), (float*)(p.ws + WS_RS1)); }
};
struct PhaseDown : PhaseN2048<DFF, DFF, DFF> {
    DI bool next(int i, g8::Unit& u) const { return next_(i, u); }
    DI void epi(EPI_ARGS) const { epi_residual<true, false>(acc, u, wr, wc, fr, fq, p.ws + WS_H1B, (bf16_t*)(p.ws + WS_H2B), (float*)(p.ws + WS_SS2)); }
};
struct PhasePe : PhaseN2048<PLE, PLE, PLE> {
    int first, nfree;
    DI bool next(int i, g8::Unit& u) const { if (nfree <= 0 || c < first || c >= first + nfree) return false;
        const long L = (long)i * nfree + (c - first); if (L >= 256) return false; const int pm = (int)L >> 3, pn = (int)L & 7;
        u.pm = pm; u.pn = pn; u.A = (const char*)(p.ws + a_off) + (size_t)pm * 256 * LDA * 2; u.B = (const char*)(p.ws + b_off) + (size_t)pn * 256 * LDB * 2; return true; }
    DI void epi(EPI_ARGS) const { bf16_t* PE = (bf16_t*)(p.ws + WS_PE);
        EPI_ROWS(row) EPI_COLS(col) const size_t o = (size_t)row * D + u.pn * 256 + col; *(u32x4*)(PE + o) = pk8(v0, v1); EPI_END }
};
struct PhasePg : PhaseN2048<D, D, D> {
    DI bool next(int i, g8::Unit& u) const { return next_(i, u); }
    DI void epi(EPI_ARGS) const { const bf16_t* H2 = (const bf16_t*)(p.ws + WS_H2B); const bf16_t* PE = (const bf16_t*)(p.ws + WS_PE); const float* SS2 = (const float*)(p.ws + WS_SS2);
        bf16_t* H3 = (bf16_t*)(p.ws + WS_H3); float* SS3 = (float*)(p.ws + WS_SS3);
#pragma unroll
        for (int ai = 0; ai < 2; ++ai)
#pragma unroll
            for (int mh = 0; mh < 2; ++mh) { u32x4 hw[2][2], pw[2][2]; float rs[2];
#pragma unroll
                for (int mm = 0; mm < 2; ++mm) { const int row = u.pm * 256 + ai * 128 + wr * 64 + (2 * mh + mm) * 16 + fr; float s2 = 0.f;
#pragma unroll
                    for (int k = 0; k < 8; ++k) s2 += sum4(*(const f32x4*)(SS2 + (size_t)row * 32 + 4 * k));
                    rs[mm] = 1.0f / sqrtf(s2 * (1.0f / D) + EPS);
#pragma unroll
                    for (int bj = 0; bj < 2; ++bj) { const size_t o = (size_t)row * D + u.pn * 256 + bj * 128 + wc * 32 + 8 * fq; hw[mm][bj] = *(const u32x4*)(H2 + o); pw[mm][bj] = *(const u32x4*)(PE + o); } }
#pragma unroll
                for (int mm = 0; mm < 2; ++mm) { const int m = 2 * mh + mm; const int row = u.pm * 256 + ai * 128 + wr * 64 + m * 16 + fr; float ss = 0.f;
#pragma unroll
                    for (int bj = 0; bj < 2; ++bj) { const size_t o = (size_t)row * D + u.pn * 256 + bj * 128 + wc * 32 + 8 * fq;
                        const f32x4 h0 = bf4lo(hw[mm][bj]) + sig4(acc[ai][bj][m][0] * rs[mm]) * bf4lo(pw[mm][bj]), h1 = bf4hi(hw[mm][bj]) + sig4(acc[ai][bj][m][1] * rs[mm]) * bf4hi(pw[mm][bj]);
                        *(u32x4*)(H3 + o) = pk8(h0, h1); ss += sum4(h0 * h0) + sum4(h1 * h1); }
                    ss += __shfl_xor(ss, 16); ss += __shfl_xor(ss, 32);
                    if (fq == 0) SS3[(size_t)row * 32 + u.pn * 4 + wc] = ss; } } }
};
#ifndef ROR_DIR
#define ROR_DIR 0
#endif
template <int N> DI float ror16(float v) { return __uint_as_float((unsigned)__builtin_amdgcn_update_dpp(0, (int)__float_as_uint(v), 0x120 + (ROR_DIR ? 16 - N : N), 0xF, 0xF, false)); }
DI F8 shfl8(const F8& v, int src) { F8 r; r.a = (f32x4){__shfl(v.a.x, src), __shfl(v.a.y, src), __shfl(v.a.z, src), __shfl(v.a.w, src)}; r.b = (f32x4){__shfl(v.b.x, src), __shfl(v.b.y, src), __shfl(v.b.z, src), __shfl(v.b.w, src)}; return r; }
DI F8 sel8(bool c, const F8& x, const F8& y) { F8 r; r.a = c ? x.a : y.a; r.b = c ? x.b : y.b; return r; }
struct PhaseUp {
    static constexpr int LDA = D, LDB = D, KT = D / 64;
    const Params& p; int G, c; LAS unsigned char* xl;
    DI bool next(int i, g8::Unit& u) const { int pm, pn; if (c >= G || !g8::grid_order(NTM, 43, G, c, i, pm, pn)) return false;
        u.pm = pm; u.pn = pn; u.A = (const char*)(p.ws + WS_H1B) + (size_t)pm * 256 * D * 2; u.B = (const char*)(p.ws + WS_WUP) + (size_t)pn * 256 * D * 2; return true; }
    DI void epi(const f32x4 (&acc)[2][2][4][2], const g8::Unit& u, int wr, int wc, int fr_, int fq_) const {
        unsigned char* ws = p.ws; bf16_t* ACT = (bf16_t*)(ws + WS_ACT); const float* RS1 = (const float*)(ws + WS_RS1);
        const int lane = lane_id(), fr = lane & 15, fq = lane >> 4;
        (void)fr_; (void)fq_;
        const int pm = u.pm, chl = 32 * wc + 8 * fq, chb = 128 * u.pn + chl;
#define UP_RR(ai_, m_) (1.0f / sqrtf(RS1[pm * 256 + (ai_) * 128 + wr * 64 + (m_) * 16 + fr] * (1.0f / D) + EPS))
        LAS float* X = (LAS float*)xl;
        if (pm == NTM - 1) {
#pragma unroll
            for (int n = 0; n < 2; ++n) { const int ch = chb + 4 * n;
                const f32x4 w0 = *(const f32x4*)(p.conv_w + ch), w1 = *(const f32x4*)(p.conv_w + DFF + ch), w2 = *(const f32x4*)(p.conv_w + 2 * DFF + ch), cb = *(const f32x4*)(p.conv_b + ch);
#pragma unroll
                for (int m = 0; m < 4; ++m) { const int row = pm * 256 + wr * 64 + m * 16 + fr, b = row - MP; const float r0 = UP_RR(0, m);
                    const f32x4 g0 = acc[0][0][m][n] * r0, up = acc[0][1][m][n] * r0;
                    const float* sc = p.state_conv + (size_t)b * 2 * DFF + ch; const f32x4 g1 = *(const f32x4*)(sc + DFF), g2 = *(const f32x4*)sc;
                    const f32x4 aa = silu4(cb + w0 * g2 + w1 * g1 + w2 * g0) * up;
                    u32x2 o; o.x = pk2(aa.x, aa.y); o.y = pk2(aa.z, aa.w); *(u32x2*)(ACT + (size_t)row * DFF + ch) = o;
                    float* co = p.out + O_CONVS + (size_t)b * 2 * DFF + ch; *(f32x4*)co = g1; *(f32x4*)(co + DFF) = g0; } }
            asm volatile("s_waitcnt lgkmcnt(0)" ::: "memory"); __builtin_amdgcn_s_barrier(); asm volatile("" ::: "memory");
            return;
        }
#pragma unroll
        for (int n = 0; n < 2; ++n) {
#pragma unroll
            for (int ai = 0; ai < 2; ++ai) if (fr >= 14) { const f32x4 g3 = acc[ai][0][3][n] * UP_RR(ai, 3);
                *(LAS f32x4*)(X + ((2 * ai + wr) * 2 + (fr - 14)) * 128 + chl + 4 * n) = g3;
                if (ai == 1 && wr == 1) { *(f32x4*)((float*)(ws + WS_HALO) + ((size_t)pm * 2 + (fr - 14)) * DFF + chb + 4 * n) = g3;
                    if ((pm & 7) == 7) *(f32x4*)(p.out + O_CONVP + ((size_t)(pm >> 3) * 2 + (fr - 14)) * DFF + chb + 4 * n) = g3; } }
            if (wr == 0 && fr < 2) { *(f32x4*)((float*)(ws + WS_FIXG) + ((size_t)pm * 2 + fr) * DFF + chb + 4 * n) = acc[0][0][0][n] * UP_RR(0, 0);
                *(f32x4*)((float*)(ws + WS_FIXU) + ((size_t)pm * 2 + fr) * DFF + chb + 4 * n) = acc[0][1][0][n] * UP_RR(0, 0); }
        }
        asm volatile("s_waitcnt lgkmcnt(0)" ::: "memory"); __builtin_amdgcn_s_barrier(); asm volatile("" ::: "memory");
        const f32x4 z4 = {0.f, 0.f, 0.f, 0.f};
#pragma unroll
        for (int n = 0; n < 2; ++n) { const int ch = chb + 4 * n;
            const f32x4 w0 = *(const f32x4*)(p.conv_w + ch), w1 = *(const f32x4*)(p.conv_w + DFF + ch), w2 = *(const f32x4*)(p.conv_w + 2 * DFF + ch), cb = *(const f32x4*)(p.conv_b + ch);
#pragma unroll
            for (int ai = 0; ai < 2; ++ai) {
                f32x4 t1p = z4, t2p = z4;
                if (!(ai == 0 && wr == 0)) { const int ps = (wr == 1) ? 2 * ai : 1; const LAS float* xp = X + (ps * 2) * 128 + chl + 4 * n;
                    const f32x4 pv14 = *(const LAS f32x4*)xp, pv15 = *(const LAS f32x4*)(xp + 128); t1p = pv15; t2p = (fr == 0) ? pv14 : pv15; }
#pragma unroll
                for (int m = 0; m < 4; ++m) { const int row = pm * 256 + ai * 128 + wr * 64 + m * 16 + fr;
                    const float rm = UP_RR(ai, m); const f32x4 gm = acc[ai][0][m][n] * rm;
                    const f32x4 t1 = (f32x4){ror16<1>(gm.x), ror16<1>(gm.y), ror16<1>(gm.z), ror16<1>(gm.w)};
                    const f32x4 t2 = (f32x4){ror16<2>(gm.x), ror16<2>(gm.y), ror16<2>(gm.z), ror16<2>(gm.w)};
                    const f32x4 p1 = (fr == 0) ? t1p : t1, p2 = (fr < 2) ? t2p : t2;
                    const f32x4 aa = silu4(cb + w0 * p2 + w1 * p1 + w2 * gm) * (acc[ai][1][m][n] * rm);
                    u32x2 o; o.x = pk2(aa.x, aa.y); o.y = pk2(aa.z, aa.w); *(u32x2*)(ACT + (size_t)row * DFF + ch) = o;
                    t1p = t1; t2p = t2; }
            }
            asm volatile("" ::: "memory");
        }
    }
#undef UP_RR
};

struct PhaseWpb {
    static constexpr int LDA = POOLW, LDB = 256, KT = 4;
    const Params& p; int G, c;
    DI bool next(int i, g8::Unit& u) const { const int off = 220 % G; const long L = (long)i * G + ((c + G - off) % G); if (L >= 32) return false;
        const int pm = (int)L >> 2, g = (int)L & 3; u.pm = pm; u.pn = g;
        u.A = (const char*)(p.ws + WS_WBT) + ((size_t)pm * 256 * POOLW + g * 256) * 2; u.B = (const char*)(p.ws + WS_WPS) + (size_t)g * 256 * 256 * 2; return true; }
    DI void epi(EPI_ARGS) const { bf16_t* W = (bf16_t*)(p.ws + WS_WPB);
        EPI_ROWS(row) EPI_COLS(col) *(u32x4*)(W + (size_t)row * POOLW + u.pn * 256 + col) = pk8(v0, v1); EPI_END }
};

template <int LDA, int LDB>
DI void skinny64(const bf16_t* A, const bf16_t* W, int lane, int s0, int s1, f32x4 (&acc)[4]) {
    const int fr = lane & 15, fq = lane >> 4;
    const bf16_t* ap = A + (size_t)fr * LDA + 8 * fq; const bf16_t* bp = W + (size_t)fr * LDB + 8 * fq;
#pragma unroll
    for (int g = 0; g < 4; ++g) acc[g] = (f32x4){0.f, 0.f, 0.f, 0.f};
#pragma unroll 4
    for (int s = s0; s < s1; ++s) { const bf16x8 b = *(const bf16x8*)(bp + 32 * s);
#pragma unroll
        for (int g = 0; g < 4; ++g) { const bf16x8 a = *(const bf16x8*)(ap + (size_t)(16 * g) * LDA + 32 * s); acc[g] = __builtin_amdgcn_mfma_f32_16x16x32_bf16(a, b, acc[g], 0, 0, 0); } }
}
DI float sum16(float v) { v += __shfl_xor(v, 1); v += __shfl_xor(v, 2); v += __shfl_xor(v, 4); v += __shfl_xor(v, 8); return v; }
template <int KIND, int K, int LDA, int LDB, int NCG = 128>
DI void sample_gemm(const Params& p, LAS unsigned char* lds, size_t a_off, size_t w_off, int wave) {
    unsigned char* ws = p.ws; const int lane = lane_id(), fr = lane & 15, fq = lane >> 4;
    constexpr int KS = K / 32;
    for (int it = blockIdx.x; it < 2 * NCG; it += gridDim.x) {
        const int cg_ = it >> 1, rb = MP + 64 * (it & 1), r0 = rb + 16 * (wave & 3), col = 16 * cg_ + fr;
        f32x4 part[4];
        skinny64<LDA, LDB>((const bf16_t*)(ws + a_off) + (size_t)rb * LDA, (const bf16_t*)(ws + w_off) + (size_t)(16 * cg_) * LDB, lane, (wave * KS) / 8, ((wave + 1) * KS) / 8, part);
        LAS f32x4* xch = (LAS f32x4*)lds;
#pragma unroll
        for (int g = 0; g < 4; ++g) xch[(wave * 4 + g) * 64 + lane] = part[g];
        __syncthreads();
        if (wave < 4) {
        f32x4 acc = xch[wave * 64 + lane];
#pragma unroll
        for (int w = 1; w < 8; ++w) acc += xch[(w * 4 + wave) * 64 + lane];
        float rs[4] = {0.f, 0.f, 0.f, 0.f};
        if (KIND == 5) {
            const float* SS2S = (const float*)(ws + WS_SS2S);
#pragma unroll
            for (int r = 0; r < 16; ++r) { const float* q = SS2S + (size_t)(r0 - MP + r) * 128; const float s_ = wave_sum(q[lane] + q[64 + lane]); const float rr = 1.0f / sqrtf(s_ * (1.0f / D) + EPS);
#pragma unroll
                for (int j = 0; j < 4; ++j) rs[j] = (r == 4 * fq + j) ? rr : rs[j]; }
        }
#pragma unroll
        for (int j = 0; j < 4; ++j) {
            const int row = r0 + 4 * fq + j; const size_t o = (size_t)row * D + col; const float v = acc[j]; float hsq = 0.f;
            if (KIND == 6) { const float val = v * ((const float*)(ws + WS_RSTD1))[row];
                if (col < KW) ((bf16_t*)(ws + WS_QB))[(size_t)row * KW + col] = (bf16_t)(pk2(val * 0.0625f, 0.f) & 0xffffu);
                else if (col < 2 * KW) ((bf16_t*)(ws + WS_KB))[(size_t)row * KW + col - KW] = (bf16_t)(pk2(val, 0.f) & 0xffffu);
                else ((bf16_t*)(ws + WS_V))[(size_t)row * VW + col - 2 * KW] = (bf16_t)(pk2(val, 0.f) & 0xffffu); }
            if (KIND == 0) { ((bf16_t*)(ws + WS_YBG))[o] = (bf16_t)(pk2(v * bf1(((const bf16_t*)(ws + WS_GB))[o]), 0.f) & 0xffffu); }
            if (KIND == 1) { ((bf16_t*)(ws + WS_MB))[o] = (bf16_t)(pk2(v * bf1(((const bf16_t*)(ws + WS_GA))[o]) + bf1(((const bf16_t*)(ws + WS_YBG))[o]), 0.f) & 0xffffu); }
            if (KIND == 2) { const float hv = p.x_sample[(size_t)(row - MP) * D + col] + v; ((bf16_t*)(ws + WS_H1B))[o] = (bf16_t)(pk2(hv, 0.f) & 0xffffu); hsq = hv * hv; }
            if (KIND == 3) { const float hv = bf1(((const bf16_t*)(ws + WS_H1B))[o]) + v; ((bf16_t*)(ws + WS_H2B))[o] = (bf16_t)(pk2(hv, 0.f) & 0xffffu); hsq = hv * hv; }
            if (KIND == 4) { ((bf16_t*)(ws + WS_PE))[o] = (bf16_t)(pk2(v, 0.f) & 0xffffu); }
            if (KIND == 5) { const float hv = bf1(((const bf16_t*)(ws + WS_H2B))[o]) + sigmoidf_(v * rs[j]) * bf1(((const bf16_t*)(ws + WS_PE))[o]); ((bf16_t*)(ws + WS_H3))[o] = (bf16_t)(pk2(hv, 0.f) & 0xffffu); hsq = hv * hv; }
            if (KIND == 2) { const float t = sum16(hsq); if (fr == 0) __hip_atomic_fetch_add((float*)(ws + WS_RS1) + row, t, __ATOMIC_RELAXED, __HIP_MEMORY_SCOPE_AGENT); }
            if (KIND == 3 || KIND == 5) { const float t = sum16(hsq);
                float* SSx = (float*)(ws + (KIND == 3 ? WS_SS2S : WS_SS3S)); if (fr == 0) SSx[(size_t)(row - MP) * 128 + cg_] = t; }
        }
        }
        __syncthreads();
    }
}


#define XB_TMO      128
#define XB_XCNT(j)  (256  + 64 * (j))
#define XB_XSUB(j)  (1280 + 64 * (j))
#define XB_XGEN(j)  (2304 + 64 * (j))
#define XB_TOP      3328
#define XB_TOPGEN   3392
#define XCD_BAR_WORDS 3456
#define XB_SPIN_CAP (1u << 22)
DI unsigned xb_ld(unsigned* p)              { return __hip_atomic_load(p, __ATOMIC_RELAXED, __HIP_MEMORY_SCOPE_AGENT); }
DI unsigned xb_add(unsigned* p, unsigned v) { return __hip_atomic_fetch_add(p, v, __ATOMIC_RELAXED, __HIP_MEMORY_SCOPE_AGENT); }
DI unsigned xb_xcc_id() { return (unsigned)__builtin_amdgcn_s_getreg((3 << 11) | 20) & 0xFu; }
#define XB_SPIN(cond, bar) do { unsigned _sp = 0; while (cond) { __builtin_amdgcn_s_sleep(1); \
    if ((++_sp & 255u) == 0u) { if (xb_ld(&(bar)[XB_TMO])) break; if (_sp > XB_SPIN_CAP) { atomicAdd(&(bar)[XB_TMO], 1u); break; } } } } while (0)
struct XcdBarrier { unsigned* bar; unsigned x; volatile LAS unsigned* st; };
DI XcdBarrier xcd_barrier_post(unsigned* bar, volatile LAS unsigned* st, bool t0) {
    XcdBarrier b; b.bar = bar; b.x = xb_xcc_id(); b.st = st;
    if (t0) (void)xb_add(&bar[XB_XCNT(b.x)], 1u);
    return b;
}
DI void xcd_barrier_complete(unsigned* bar, unsigned x, unsigned& nloc, unsigned& nx) {
    const unsigned G = gridDim.x * gridDim.y * gridDim.z;
    unsigned sum, cnt, mine, sp = 0u;
    for (;;) {
        sum = 0u; cnt = 0u; mine = 0u;
#pragma unroll
        for (unsigned j = 0; j < 16; ++j) { const unsigned c = xb_ld(&bar[XB_XCNT(j)]); sum += c; cnt += (c > 0u) ? 1u : 0u; mine = (j == x) ? c : mine; }
        if (sum == G) break;
        __builtin_amdgcn_s_sleep(1);
        if ((++sp & 255u) == 0u) { if (xb_ld(&bar[XB_TMO])) break; if (sp > XB_SPIN_CAP) { atomicAdd(&bar[XB_TMO], 1u); break; } }
    }
    nloc = mine > 0u ? mine : 1u; nx = cnt > 0u ? cnt : 1u;
}
DI void xcd_barrier(const XcdBarrier& b, bool t0) {
    asm volatile("s_waitcnt vmcnt(0)" ::: "memory");
    __syncthreads();
    if (t0) {
        unsigned* bar = b.bar;
        __builtin_amdgcn_s_waitcnt(0);
        unsigned nloc = b.st[0], nx = b.st[1];
        if (nloc == 0u) { xcd_barrier_complete(bar, b.x, nloc, nx); b.st[0] = nloc; b.st[1] = nx; }
        const unsigned old = xb_add(&bar[XB_XSUB(b.x)], 1u);
        const unsigned gen = old / nloc;
        if (old + 1u == (gen + 1u) * nloc) {
            __builtin_amdgcn_fence(__ATOMIC_RELEASE, "agent");
            asm volatile("s_waitcnt vmcnt(0)" ::: "memory");
            const unsigned og = xb_add(&bar[XB_TOP], 1u);
            const unsigned tg = og / nx;
            if (og + 1u == (tg + 1u) * nx) xb_add(&bar[XB_TOPGEN], 1u);
            else XB_SPIN(xb_ld(&bar[XB_TOPGEN]) == tg, bar);
            __builtin_amdgcn_fence(__ATOMIC_ACQUIRE, "agent");
            xb_add(&bar[XB_XGEN(b.x)], 1u);
            asm volatile("s_waitcnt vmcnt(0)" ::: "memory");
        } else {
            XB_SPIN(xb_ld(&bar[XB_XGEN(b.x)]) == gen, bar);
            __builtin_amdgcn_fence(__ATOMIC_ACQUIRE, "agent");
            asm volatile("s_waitcnt vmcnt(0)" ::: "memory");
        }
    }
    __syncthreads();
}

constexpr int N_PHASES = 13;
#ifndef G8_SP2
#define G8_SP2 true
#endif
#ifndef G8_ALIGN
#define G8_ALIGN true
#endif

__global__ void __launch_bounds__(NTHREADS, 2) fwd_kernel(Params p) {
    extern __shared__ __attribute__((aligned(16))) unsigned char lds_raw[];
    LAS unsigned char* lds = (LAS unsigned char*)lds_raw;
    const int G = gridDim.x, c = blockIdx.x;
    const int wave = __builtin_amdgcn_readfirstlane(threadIdx.x >> 6);
    const int lo = p.ph_lo, hi = p.ph_hi;
#ifndef REPEAT_MASK
#define REPEAT_MASK 0
#endif
#ifndef PHASE_MASK
#define PHASE_MASK 0x1aff
#endif
#define IN(k) (((PHASE_MASK >> (k)) & 1) && lo <= (k) && (k) < hi)
    volatile LAS unsigned* bst = (volatile LAS unsigned*)(lds + LDS_MISC);
    const bool t0 = (wave == 0) && (lane_id() == 0);
    XcdBarrier bar; bar.bar = (unsigned*)(p.ws + WS_CTL); bar.x = 0; bar.st = bst;
    if (hi - lo > 1) { if (t0) { bst[0] = 0u; bst[1] = 0u; } __syncthreads(); bar = xcd_barrier_post((unsigned*)(p.ws + WS_CTL), bst, t0); }
#define NEXTPH(k) ((k) == 9 ? 11 : ((k) == 7 ? 9 : (k) + 1))
#define SEAM(k) do { if (IN(k) && IN(NEXTPH(k))) { xcd_barrier(bar, (wave == 0) && (lane_id() == 0)); } } while (0)
    if (IN(0)) { phase_p0(p, lds, wave); if ((REPEAT_MASK >> 0) & 1) { xcd_barrier(bar, (wave == 0) && (lane_id() == 0)); phase_p0(p, lds, wave); } } SEAM(0);
    if (IN(1)) { sample_gemm<6, D, D, D, 256>(p, lds, WS_XB, WS_WIN, wave); PhaseIn ph{p, G, c, 0, 0}; g8::run<PhaseIn, G8_ALIGN, G8_SP2>(lds, ph, wave); } SEAM(1);
    if (IN(2)) {
        if (G == 256) {
            if (c < 32) { scan_role(p, lds, wave, c, 32); deferred_transposes<1>(p, lds, wave, c, 32); }
            else if (c < 71) stream_role(p, wave, c - 32, 39);
            else { PhaseIn ph{p, G, c, 1, 71}; g8::run<PhaseIn, G8_ALIGN, G8_SP2>(lds, ph, wave); PhaseWpb pw{p, G, c}; g8::run<PhaseWpb, G8_ALIGN, G8_SP2>(lds, pw, wave); }
        } else {
            PhaseIn ph{p, G, c, 1, 0}; g8::run<PhaseIn, G8_ALIGN, G8_SP2>(lds, ph, wave); PhaseWpb pw{p, G, c}; g8::run<PhaseWpb, G8_ALIGN, G8_SP2>(lds, pw, wave);
            scan_role(p, lds, wave, c, G); deferred_transposes<1>(p, lds, wave, c, G); stream_role(p, wave, c, G);
        }
    } SEAM(2);
    if (IN(3)) { phase_p3(p, wave); if ((REPEAT_MASK >> 3) & 1) { xcd_barrier(bar, (wave == 0) && (lane_id() == 0)); phase_p3(p, wave); } } SEAM(3);
    if (IN(4)) { sample_gemm<0, POOLW, POOLW, POOLW>(p, lds, WS_PM, WS_WPB, wave); PhaseYb ph{{p, G, c, WS_PM, WS_WPB}}; g8::run<PhaseYb, G8_ALIGN, G8_SP2>(lds, ph, wave); if ((REPEAT_MASK >> 4) & 1) { xcd_barrier(bar, (wave == 0) && (lane_id() == 0)); sample_gemm<0, POOLW, POOLW, POOLW>(p, lds, WS_PM, WS_WPB, wave); PhaseYb ph{{p, G, c, WS_PM, WS_WPB}}; g8::run<PhaseYb, G8_ALIGN, G8_SP2>(lds, ph, wave); } }
    if (IN(5)) { asm volatile("s_waitcnt vmcnt(0)" ::: "memory"); __syncthreads(); sample_gemm<1, VW, VW, VW>(p, lds, WS_OG, WS_WA, wave); PhaseYa ph{{p, G, c, WS_OG, WS_WA}}; g8::run<PhaseYa, G8_ALIGN, G8_SP2>(lds, ph, wave); if ((REPEAT_MASK >> 5) & 1) { xcd_barrier(bar, (wave == 0) && (lane_id() == 0)); sample_gemm<1, VW, VW, VW>(p, lds, WS_OG, WS_WA, wave); PhaseYa ph{{p, G, c, WS_OG, WS_WA}}; g8::run<PhaseYa, G8_ALIGN, G8_SP2>(lds, ph, wave); } } SEAM(5);
    if (IN(6)) { sample_gemm<2, D, D, D>(p, lds, WS_MB, WS_WO, wave); PhaseOut ph{{p, G, c, WS_MB, WS_WO}}; g8::run<PhaseOut, G8_ALIGN, G8_SP2>(lds, ph, wave); if ((REPEAT_MASK >> 6) & 1) { xcd_barrier(bar, (wave == 0) && (lane_id() == 0)); sample_gemm<2, D, D, D>(p, lds, WS_MB, WS_WO, wave); PhaseOut ph{{p, G, c, WS_MB, WS_WO}}; g8::run<PhaseOut, G8_ALIGN, G8_SP2>(lds, ph, wave); } } SEAM(6);
    if (IN(7)) {
        const int ng = (G == 256) ? 240 : G;
        PhaseUp ph{p, ng, c, lds + LDS_XCH}; g8::run<PhaseUp, true, G8_SP2>(lds, ph, wave);
        sample_gemm<4, PLE, PLE, PLE>(p, lds, WS_PLB, WS_WPLE, wave);
        { PhasePe pe{{p, G, c, WS_PLB, WS_WPLE}, (G == 256) ? 240 : 0, (G == 256) ? 16 : G}; g8::run<PhasePe, G8_ALIGN, G8_SP2>(lds, pe, wave); }
        if (G == 256) { if (c >= 240) deferred_transposes<0>(p, lds, wave, c - 240, 16); } else deferred_transposes<0>(p, lds, wave, c, G);
        if ((REPEAT_MASK >> 7) & 1) { xcd_barrier(bar, (wave == 0) && (lane_id() == 0)); PhaseUp ph2{p, ng, c, lds + LDS_XCH}; g8::run<PhaseUp, true, G8_SP2>(lds, ph2, wave); }
    } SEAM(7);
    if (IN(9)) { { PhaseDown pd{{p, G, c, WS_ACT, WS_WD}}; g8::Unit uu; for (int i = 0; pd.next(i, uu); ++i) conv_fixup_tile(p, uu.pm, wave); asm volatile("s_waitcnt vmcnt(0)" ::: "memory"); __syncthreads(); } sample_gemm<3, DFF, DFF, DFF>(p, lds, WS_ACT, WS_WD, wave); PhaseDown ph{{p, G, c, WS_ACT, WS_WD}}; g8::run<PhaseDown, G8_ALIGN, G8_SP2>(lds, ph, wave); if ((REPEAT_MASK >> 9) & 1) { xcd_barrier(bar, (wave == 0) && (lane_id() == 0)); sample_gemm<3, DFF, DFF, DFF>(p, lds, WS_ACT, WS_WD, wave); PhaseDown ph{{p, G, c, WS_ACT, WS_WD}}; g8::run<PhaseDown, G8_ALIGN, G8_SP2>(lds, ph, wave); } } SEAM(9);
    if (IN(11)) { sample_gemm<5, D, D, D>(p, lds, WS_H2B, WS_WPG, wave); PhasePg ph{{p, G, c, WS_H2B, WS_WPG}}; g8::run<PhasePg, G8_ALIGN, G8_SP2>(lds, ph, wave); if ((REPEAT_MASK >> 11) & 1) { xcd_barrier(bar, (wave == 0) && (lane_id() == 0)); sample_gemm<5, D, D, D>(p, lds, WS_H2B, WS_WPG, wave); PhasePg ph{{p, G, c, WS_H2B, WS_WPG}}; g8::run<PhasePg, G8_ALIGN, G8_SP2>(lds, ph, wave); } } SEAM(11);
    if (IN(12)) { phase_final(p, wave); if ((REPEAT_MASK >> 12) & 1) { xcd_barrier(bar, (wave == 0) && (lane_id() == 0)); phase_final(p, wave); } }
#undef IN
#undef SEAM
}

extern "C" void kernel_launch(void* const* d_in, const int* in_sizes, int n_in, void* d_out, int out_size, void* d_ws, size_t ws_size, hipStream_t stream) {
    static int grid = 0;
    if (grid == 0) {
        if (n_in != 26 || (size_t)out_size != O_END || ws_size < WS_END) {
            fprintf(stderr, "kernel_launch: unexpected problem: n_in %d out %d ws %zu (need %zu)\n", n_in, out_size, ws_size, (size_t)WS_END); grid = -1; return; }
        int dev = 0, cus = 0, per_cu = 0;
        if (hipGetDevice(&dev) != hipSuccess || hipDeviceGetAttribute(&cus, hipDeviceAttributeMultiprocessorCount, dev) != hipSuccess) { grid = -1; return; }
        if (hipFuncSetAttribute((const void*)fwd_kernel, hipFuncAttributeMaxDynamicSharedMemorySize, LDS_BYTES) != hipSuccess) { fprintf(stderr, "kernel_launch: hipFuncSetAttribute failed\n"); grid = -1; return; }
        if (hipOccupancyMaxActiveBlocksPerMultiprocessor(&per_cu, (const void*)fwd_kernel, NTHREADS, LDS_BYTES) != hipSuccess || per_cu < 1) {
            fprintf(stderr, "kernel_launch: occupancy query reports %d blocks per CU\n", per_cu); (void)hipGetLastError(); grid = -1; return; }
        grid = cus;
    }
    if (grid < 0) return;
    Params p{};
    const float** pp = (const float**)&p;
    for (int i = 0; i < 26; ++i) pp[i] = (const float*)d_in[i];
    p.out = (float*)d_out; p.ws = (unsigned char*)d_ws;
#if MK_N_LAUNCHES == 1
    p.ph_lo = 0; p.ph_hi = N_PHASES;
    void* args[] = {&p};
    if (hipMemsetAsync((char*)d_ws + WS_CTL, 0, XCD_BAR_WORDS * 4, stream) != hipSuccess) { fprintf(stderr, "kernel_launch: memset failed\n"); return; }
    hipError_t e = hipLaunchCooperativeKernel((const void*)fwd_kernel, dim3(grid), dim3(NTHREADS), args, LDS_BYTES, stream);
    if (e != hipSuccess) fprintf(stderr, "kernel_launch: cooperative launch failed: %s (grid %d)\n", hipGetErrorString(e), grid);
#else
    for (int k = 0; k < N_PHASES; ++k) { p.ph_lo = k; p.ph_hi = k + 1; hipLaunchKernelGGL(fwd_kernel, dim3(grid), dim3(NTHREADS), LDS_BYTES, stream, p); }
#endif
}
```

```cpp
#include <hip/hip_runtime.h>
#include <hip/hip_cooperative_groups.h>
#include <cstdio>
#include <cstdint>
namespace cg = cooperative_groups;

#ifndef MK_N_LAUNCHES
#define MK_N_LAUNCHES 1
#endif

#define LAS __attribute__((address_space(3)))
#define DI __device__ __forceinline__
typedef unsigned short bf16_t;
typedef short bf16x8 __attribute__((ext_vector_type(8)));
typedef short s16x4 __attribute__((ext_vector_type(4)));
typedef float f32x4 __attribute__((ext_vector_type(4)));
typedef float f32x2 __attribute__((ext_vector_type(2)));
typedef float f32x16 __attribute__((ext_vector_type(16)));
typedef unsigned u32x4 __attribute__((ext_vector_type(4)));
typedef unsigned u32x2 __attribute__((ext_vector_type(2)));

constexpr int D = 2048, MP = 8192, MS = 128, M = MP + MS, MPAD = 8448, NTM = 33;
constexpr int SEQ = 2048, NB = 4, NH = 4, DK = 256, DV = 512, KW = 1024, VW = 2048;
constexpr int DFF = 5504, NUP = 2 * DFF, PLE = 256, POOLW = 1024, INW = 11280, NIN = 11264;
constexpr float EPS = 1e-6f;
constexpr int NSL = 16;
constexpr int CH = 32, NCHK = MP / CH;

constexpr size_t O_YP = 0, O_YS = O_YP + (size_t)MP * D, O_GLAP = O_YS + (size_t)MS * D, O_POOLP = O_GLAP + (size_t)NB * NH * DK * DV,
                 O_CONVP = O_POOLP + (size_t)NB * 15 * POOLW, O_GLAS = O_CONVP + (size_t)NB * 2 * DFF, O_POOLS = O_GLAS + (size_t)MS * NH * DK * DV,
                 O_CONVS = O_POOLS + (size_t)MS * 15 * POOLW, O_END = O_CONVS + (size_t)MS * 2 * DFF;

constexpr size_t al(size_t x) { return (x + 255) & ~(size_t)255; }
constexpr size_t WS_CTL = 0, CTL_BYTES = 65536;
constexpr size_t WS_WUP = WS_CTL + CTL_BYTES;
constexpr size_t WS_WD = WS_WUP + al((size_t)NUP * D * 2);
constexpr size_t WS_WA = WS_WD + al((size_t)D * DFF * 2);
constexpr size_t WS_WO = WS_WA + al((size_t)D * D * 2);
constexpr size_t WS_WPG = WS_WO + al((size_t)D * D * 2);
constexpr size_t WS_WPB = WS_WPG + al((size_t)D * D * 2);
constexpr size_t WS_WPLE = WS_WPB + al((size_t)D * POOLW * 2);
constexpr size_t WS_WBT = WS_WPLE + al((size_t)D * PLE * 2);
constexpr size_t WS_WPS = WS_WBT + al((size_t)D * POOLW * 2);
constexpr size_t WS_SMALL = WS_WPS + al((size_t)POOLW * 256 * 2);
constexpr size_t WS_RSTD1 = WS_SMALL;
constexpr size_t WS_LAM = WS_RSTD1 + al((size_t)MPAD * 4);
constexpr size_t WS_OSS = WS_LAM + al((size_t)(NCHK + MS) * KW * 4);
constexpr size_t WS_OSP = WS_OSS + al((size_t)MP * NH * NSL * 4);
constexpr size_t WS_SS1 = WS_OSP + al((size_t)MS * NH * 8 * DV * 4);
constexpr size_t WS_SS2 = WS_SS1 + al((size_t)MPAD * 32 * 4);
constexpr size_t WS_SS3 = WS_SS2 + al((size_t)MPAD * 32 * 4);
constexpr size_t WS_SS1S = WS_SS3 + al((size_t)MPAD * 32 * 4);
constexpr size_t WS_SS2S = WS_SS1S + al((size_t)MS * 128 * 4);
constexpr size_t WS_SS3S = WS_SS2S + al((size_t)MS * 128 * 4);
constexpr size_t WS_RS1 = WS_SS3S + al((size_t)MS * 128 * 4);
constexpr size_t WS_HALO = WS_RS1 + al((size_t)MPAD * 4);
constexpr size_t WS_FIXG = WS_HALO + al((size_t)32 * 2 * DFF * 4);
constexpr size_t WS_FIXU = WS_FIXG + al((size_t)32 * 2 * DFF * 4);
constexpr size_t WS_PLB = WS_FIXU + al((size_t)32 * 2 * DFF * 4);
constexpr size_t WS_R1 = WS_PLB + al((size_t)MPAD * PLE * 2);
constexpr size_t WS_XB = WS_R1;
constexpr size_t WS_WIN = WS_XB + al((size_t)MPAD * D * 2);
constexpr size_t WS_BCUM = WS_WIN + al((size_t)NIN * D * 2);
constexpr size_t WS_R1_END = WS_BCUM + al((size_t)MPAD * KW * 4);
constexpr size_t WS_ACT = WS_R1;
static_assert(WS_ACT + al((size_t)MPAD * DFF * 2) <= WS_R1_END, "R1 overlay");
constexpr size_t WS_R2 = WS_R1_END;
constexpr size_t WS_QB = WS_R2;
constexpr size_t WS_KB = WS_QB + al((size_t)MPAD * KW * 2);
constexpr size_t WS_KD = WS_KB + al((size_t)MPAD * KW * 2);
constexpr size_t WS_V = WS_KD + al((size_t)MPAD * KW * 2);
constexpr size_t WS_SR = WS_V + al((size_t)MPAD * VW * 2);
constexpr size_t WS_GA = WS_SR + al((size_t)MPAD * VW * 2);
constexpr size_t WS_GB = WS_GA + al((size_t)MPAD * D * 2);
constexpr size_t WS_U = WS_GB + al((size_t)MPAD * D * 2);
constexpr size_t WS_OG = WS_U + al((size_t)MPAD * POOLW * 4);
constexpr size_t WS_PM = WS_OG + al((size_t)MPAD * VW * 2);
constexpr size_t WS_YBG = WS_PM + al((size_t)MPAD * POOLW * 2);
constexpr size_t WS_R2_END = WS_YBG + al((size_t)MPAD * D * 4);
constexpr size_t WS_GU = WS_R2;
constexpr size_t WS_H2 = WS_GU + al((size_t)MPAD * NUP * 2);
constexpr size_t WS_PE = WS_H2 + al((size_t)MPAD * D * 4);
static_assert(WS_PE + al((size_t)MPAD * D * 4) <= WS_R2_END, "R2 overlay");
constexpr size_t WS_MB = WS_R2_END;
constexpr size_t WS_H1 = WS_MB + al((size_t)MPAD * D * 2);
constexpr size_t WS_H1B = WS_H1 + al((size_t)MPAD * D * 4);
constexpr size_t WS_END = WS_H1B + al((size_t)MPAD * D * 2);
constexpr size_t WS_H3 = WS_H1;
constexpr size_t WS_H2B = WS_MB;

DI unsigned pk2(float lo, float hi) {
    typedef __bf16 bf2 __attribute__((ext_vector_type(2)));
    f32x2 v = {lo, hi};
    bf2 b = __builtin_convertvector(v, bf2);
    return __builtin_bit_cast(unsigned, b);
}
DI float bflo(unsigned w) { return __uint_as_float(w << 16); }
DI float bfhi(unsigned w) { return __uint_as_float(w & 0xffff0000u); }
DI float bf1(bf16_t b) { return __uint_as_float(((unsigned)b) << 16); }
DI float fexp(float x) { return __expf(x); }
DI unsigned pku4(f32x4 v) {
    unsigned r = 0u; r = __builtin_amdgcn_cvt_pk_u8_f32(v.x * 255.0f, 0u, r); r = __builtin_amdgcn_cvt_pk_u8_f32(v.y * 255.0f, 1u, r); r = __builtin_amdgcn_cvt_pk_u8_f32(v.z * 255.0f, 2u, r); r = __builtin_amdgcn_cvt_pk_u8_f32(v.w * 255.0f, 3u, r); return r; }
DI f32x4 unpku4(unsigned w) { return (f32x4){(float)(w & 0xffu), (float)((w >> 8) & 0xffu), (float)((w >> 16) & 0xffu), (float)(w >> 24)} * (1.0f / 255.0f); }
DI float sigmoidf_(float x) { return __builtin_amdgcn_rcpf(1.0f + __expf(-x)); }
DI float siluf_(float x) { return x * sigmoidf_(x); }
DI float logsigmoidf_(float z) { return fminf(z, 0.f) - __logf(1.0f + __expf(-fabsf(z))); }
DI u32x4 pk8(f32x4 a, f32x4 b) { u32x4 o; o.x = pk2(a.x, a.y); o.y = pk2(a.z, a.w); o.z = pk2(b.x, b.y); o.w = pk2(b.z, b.w); return o; }
DI f32x4 bf4lo(u32x4 w) { return (f32x4){bflo(w.x), bfhi(w.x), bflo(w.y), bfhi(w.y)}; }
DI f32x4 bf4hi(u32x4 w) { return (f32x4){bflo(w.z), bfhi(w.z), bflo(w.w), bfhi(w.w)}; }
DI float wave_sum(float v) {
#pragma unroll
    for (int o = 1; o < 64; o <<= 1) v += __shfl_xor(v, o);
    return v;
}
DI int lane_id() { int l; asm volatile("v_mbcnt_lo_u32_b32 %0, -1, 0\n\tv_mbcnt_hi_u32_b32 %0, -1, %0" : "=v"(l)); return l; }
#define LDS_WAIT() asm volatile("s_waitcnt lgkmcnt(0)" ::: "memory")
#define VM_WAIT() asm volatile("s_waitcnt vmcnt(0)" ::: "memory")

struct Params {
    const float *x_prompt, *x_sample, *state_gla, *state_pool, *state_conv, *p_prompt, *p_sample;
    const float *norm_mix, *w_in, *w_gate_up, *b_gate, *gla_norm, *w_branch_a, *w_pool, *pool_scale, *w_branch_b, *w_out, *norm_ffn, *w_up, *conv_w, *conv_b,
        *w_down, *norm_ple, *w_ple_gate, *w_ple, *norm_final;
    float* out; unsigned char* ws;
    int ph_lo, ph_hi;
};

constexpr int NWAVES = 8, NTHREADS = 512;
constexpr int LDS_BYTES = 163840;
constexpr int LDS_XCH = 131072;
constexpr int LDS_MISC = LDS_BYTES - 256;

namespace g8 {
constexpr int BM = 256, BK = 64, HALF = 128, HTB = HALF * BK * 2, STAGE_BYTES = 8 * HTB, NXCD = 8, WGM = 2;
DI int lds_byte(int r, int c) { const int st = (r >> 4) * 2 + (c >> 5), rr = r & 15, cc = c & 31, ob = rr * 64 + cc * 2; return st * 1024 + (ob ^ (((ob >> 9) & 1) << 5)); }
DI void stage_rc(int b, int& R, int& C) { const int st = b / 1024, sb = b % 1024, swz = sb ^ (((sb >> 9) & 1) << 5); R = (st >> 1) * 16 + swz / 64; C = (st & 1) * 32 + (swz % 64) / 2; }
DI int perm32(int rho) { const int n = rho >> 4, i = rho & 15; return 8 * (i >> 2) + 4 * n + (i & 3); }

struct Unit { const char* A; const char* B; int pm, pn; };

DI bool grid_order(int nM, int nN, int G, int c, int i, int& pm, int& pn, int WGM = g8::WGM) {
    const int nwg = nM * nN; const long L = (long)i * G + c; if (L >= nwg) return false;
    int wgid = (int)L; { const int q = nwg / NXCD, r = nwg % NXCD, xcd = wgid % NXCD, off = wgid / NXCD; wgid = (xcd < r ? xcd * (q + 1) : r * (q + 1) + (xcd - r) * q) + off; }
    const int nig = WGM * nN, gid = wgid / nig, fm = gid * WGM, gsz = (nM - fm) < WGM ? (nM - fm) : WGM;
    pm = fm + ((wgid % nig) % gsz); pn = (wgid % nig) / gsz; return true;
}

template <class P, bool ALIGN_EPI, bool SP2>
DI void run(LAS unsigned char* lds, const P& ph, int wid) {
    const int lane = lane_id(), tid = wid * 64 + lane, wr = wid >> 2, wc = wid & 3, fr = lane & 15, fq = lane >> 4;
    constexpr int nt = P::KT;
    unsigned voffA[2], voffB[2];
#pragma unroll
    for (int i = 0; i < 2; ++i) { int R, C; stage_rc(tid * 16 + i * 8192, R, C); const int Rb = (R & ~31) + perm32(R & 31);
        voffA[i] = (unsigned)(R * P::LDA + C) * 2u; voffB[i] = (unsigned)(Rb * P::LDB + C) * 2u; }
    constexpr size_t kstep = (size_t)(BK * 2);
    constexpr size_t hstepA = (size_t)HALF * P::LDA * 2, hstepB = (size_t)HALF * P::LDB * 2;
    const unsigned ldsw = (unsigned)wid * 1024u;
    const int aoff = lds_byte(wr * 64 + fr, fq * 8), boff = lds_byte(wc * 32 + fr, fq * 8);
#define G8_SA(b, h) (((b) * 2 + (h)) * HTB)
#define G8_SB(b, h) ((4 + (b) * 2 + (h)) * HTB)
#define G8_STAGE(bufoff, gbase, voff) do { _Pragma("unroll") for (int _i = 0; _i < 2; ++_i) \
        __builtin_amdgcn_global_load_lds((const unsigned*)((const char*)(gbase) + (voff)[_i]), (LAS unsigned*)(lds + (bufoff) + ldsw + _i * 8192), 16, 0, 0); } while (0)
#define G8_LDA(dst, b, h) do { _Pragma("unroll") for (int m = 0; m < 4; ++m) _Pragma("unroll") for (int k = 0; k < 2; ++k) dst[m][k] = *(const LAS bf16x8*)(lds + G8_SA(b, h) + aoff + m * 2048 + k * 1024); } while (0)
#define G8_LDB(dst, b, h) do { _Pragma("unroll") for (int n = 0; n < 2; ++n) _Pragma("unroll") for (int k = 0; k < 2; ++k) dst[n][k] = *(const LAS bf16x8*)(lds + G8_SB(b, h) + boff + n * 2048 + k * 1024); } while (0)
#define G8_MMA(ai, bj, At, Bt) do { __builtin_amdgcn_s_setprio(1); _Pragma("unroll") for (int m = 0; m < 4; ++m) _Pragma("unroll") for (int n = 0; n < 2; ++n) _Pragma("unroll") for (int k = 0; k < 2; ++k) \
        acc[ai][bj][m][n] = __builtin_amdgcn_mfma_f32_16x16x32_bf16(Bt[n][k], At[m][k], acc[ai][bj][m][n], 0, 0, 0); __builtin_amdgcn_s_setprio(0); } while (0)
#define G8_WAIT_V(n) asm volatile("s_waitcnt vmcnt(" #n ")" ::: "memory")
#define G8_WAIT_L(n) asm volatile("s_waitcnt lgkmcnt(" #n ")" ::: "memory")
#define G8_BAR __builtin_amdgcn_s_barrier()
#define G8_SCHED __builtin_amdgcn_sched_barrier(0)
    Unit cur, nxt; int ui = 0;
    if (!ph.next(0, cur)) return;
    f32x4 acc[2][2][4][2];
#pragma unroll
    for (int a = 0; a < 2; ++a)
#pragma unroll
        for (int b = 0; b < 2; ++b)
#pragma unroll
            for (int m = 0; m < 4; ++m)
#pragma unroll
                for (int n = 0; n < 2; ++n) acc[a][b][m][n] = (f32x4){0.f, 0.f, 0.f, 0.f};
    bf16x8 At[4][2], B0[2][2], B1[2][2];
    const char* cA = cur.A; const char* cB = cur.B;
    if constexpr (SP2) {
        G8_STAGE(G8_SB(0, 0), cB, voffB); G8_STAGE(G8_SB(0, 1), cB + hstepB, voffB); G8_STAGE(G8_SA(0, 0), cA, voffA); G8_STAGE(G8_SA(0, 1), cA + hstepA, voffA);
        if (wr == 1) G8_BAR;
        G8_WAIT_V(2); G8_BAR;
        G8_STAGE(G8_SB(1, 0), cB + kstep, voffB); G8_STAGE(G8_SA(1, 0), cA + kstep, voffA); G8_STAGE(G8_SB(1, 1), cB + hstepB + kstep, voffB);
        G8_WAIT_V(6); G8_BAR;
    } else {
        G8_STAGE(G8_SB(0, 0), cB, voffB); G8_STAGE(G8_SA(0, 0), cA, voffA); G8_STAGE(G8_SB(0, 1), cB + hstepB, voffB); G8_STAGE(G8_SA(0, 1), cA + hstepA, voffA);
        if (wr == 1) G8_BAR;
        G8_WAIT_V(4); G8_BAR;
        G8_STAGE(G8_SB(1, 0), cB + kstep, voffB); G8_STAGE(G8_SA(1, 0), cA + kstep, voffA); G8_STAGE(G8_SB(1, 1), cB + hstepB + kstep, voffB);
        G8_WAIT_V(6); G8_BAR;
    }
    for (;;) {
        const bool has_next = ph.next(ui + 1, nxt);
        const char* nA = has_next ? nxt.A : cA; const char* nB = has_next ? nxt.B : cB;
#pragma unroll 1
        for (int t = 0; t < nt; t += 2) {
            const bool last = (t == nt - 2);
            const char* a1 = cA + (size_t)(t + 1) * kstep;
            const char* a2 = last ? nA : cA + (size_t)(t + 2) * kstep; const char* b2 = last ? nB : cB + (size_t)(t + 2) * kstep;
            const char* a3 = a2 + kstep; const char* b3 = b2 + kstep;
            if constexpr (SP2) {
            G8_LDB(B0, 0, 0); G8_LDB(B1, 0, 1); G8_SCHED; G8_LDA(At, 0, 0); G8_STAGE(G8_SA(1, 1), a1 + hstepA, voffA);
            G8_WAIT_V(8); G8_WAIT_L(0); G8_BAR; G8_MMA(0, 0, At, B0); G8_MMA(0, 1, At, B1); G8_BAR; G8_SCHED;
            G8_LDA(At, 0, 1); G8_STAGE(G8_SB(0, 0), b2, voffB); G8_STAGE(G8_SB(0, 1), b2 + hstepB, voffB); G8_STAGE(G8_SA(0, 0), a2, voffA);
            G8_WAIT_V(8); G8_WAIT_L(0); G8_BAR; G8_MMA(1, 0, At, B0); G8_MMA(1, 1, At, B1); G8_BAR; G8_SCHED;
            G8_LDB(B0, 1, 0); G8_LDB(B1, 1, 1); G8_SCHED; G8_LDA(At, 1, 0); G8_STAGE(G8_SA(0, 1), a2 + hstepA, voffA);
            G8_WAIT_V(8); G8_WAIT_L(0); G8_BAR; G8_MMA(0, 0, At, B0); G8_MMA(0, 1, At, B1); G8_BAR; G8_SCHED;
            G8_LDA(At, 1, 1); G8_STAGE(G8_SB(1, 0), b3, voffB); G8_STAGE(G8_SB(1, 1), b3 + hstepB, voffB); G8_STAGE(G8_SA(1, 0), a3, voffA);
            G8_WAIT_V(8); G8_WAIT_L(0); G8_BAR; G8_MMA(1, 0, At, B0); G8_MMA(1, 1, At, B1); G8_BAR; G8_SCHED;
            } else {
            G8_LDB(B0, 0, 0); G8_SCHED; G8_LDA(At, 0, 0); G8_STAGE(G8_SA(1, 1), a1 + hstepA, voffA);
            G8_WAIT_L(8); G8_BAR; G8_WAIT_L(0); G8_MMA(0, 0, At, B0); G8_BAR; G8_SCHED;
            G8_LDB(B1, 0, 1); G8_STAGE(G8_SB(0, 0), b2, voffB);
            G8_BAR; G8_WAIT_L(0); G8_MMA(0, 1, At, B1); G8_BAR;
            G8_LDA(At, 0, 1); G8_STAGE(G8_SA(0, 0), a2, voffA);
            G8_BAR; G8_WAIT_L(0); G8_MMA(1, 0, At, B0); G8_BAR; G8_SCHED;
            G8_STAGE(G8_SB(0, 1), b2 + hstepB, voffB);
            G8_WAIT_V(6); G8_BAR; G8_MMA(1, 1, At, B1); G8_BAR;
            G8_LDB(B0, 1, 0); G8_SCHED; G8_LDA(At, 1, 0); G8_STAGE(G8_SA(0, 1), a2 + hstepA, voffA);
            G8_WAIT_L(8); G8_BAR; G8_WAIT_L(0); G8_MMA(0, 0, At, B0); G8_BAR; G8_SCHED;
            G8_LDB(B1, 1, 1); G8_STAGE(G8_SB(1, 0), b3, voffB);
            G8_BAR; G8_WAIT_L(0); G8_MMA(0, 1, At, B1); G8_BAR;
            G8_LDA(At, 1, 1); G8_STAGE(G8_SA(1, 0), a3, voffA);
            G8_BAR; G8_WAIT_L(0); G8_MMA(1, 0, At, B0); G8_BAR; G8_SCHED;
            G8_STAGE(G8_SB(1, 1), b3 + hstepB, voffB);
            G8_WAIT_V(6); G8_BAR; G8_MMA(1, 1, At, B1); G8_BAR;
            }
        }
        if constexpr (ALIGN_EPI) { if (wr == 0) G8_BAR; }
        ph.epi(acc, cur, wr, wc, fr, fq);
        if (!has_next) break;
#pragma unroll
        for (int a = 0; a < 2; ++a)
#pragma unroll
            for (int b = 0; b < 2; ++b)
#pragma unroll
                for (int m = 0; m < 4; ++m)
#pragma unroll
                    for (int n = 0; n < 2; ++n) acc[a][b][m][n] = (f32x4){0.f, 0.f, 0.f, 0.f};
        cur = nxt; cA = nA; cB = nB; ++ui;
        if constexpr (ALIGN_EPI) { if (wr == 1) G8_BAR; }
    }
    G8_WAIT_V(0);
    if constexpr (!ALIGN_EPI) { if (wr == 0) G8_BAR; }
    G8_BAR;
#undef G8_SA
#undef G8_SB
#undef G8_STAGE
#undef G8_LDA
#undef G8_LDB
#undef G8_MMA
#undef G8_WAIT_V
#undef G8_WAIT_L
#undef G8_BAR
#undef G8_SCHED
}
}

struct TJob { const float* src; bf16_t* dst; const float* gain; int K, Nsrc, Ndst, map, nitems; };

DI int map_col(int map, int n0) {
    if (map == 1) return n0 + (n0 >= 6144 ? 16 : 0);
    if (map == 2) { const int t = n0 >> 8, r = n0 & 255; return (r < 128) ? 128 * t + r : DFF + 128 * t + (r - 128); }
    return n0;
}
constexpr int TR_SCR = 64 * 65 * 4;
static_assert(8 * TR_SCR <= LDS_MISC, "transpose scratch must stay below the barrier words");
DI void p0_transpose_item(const TJob& J, LAS float* scr, int item, int lane) {
#if defined(P0_MAP2)
    const int nkb = J.K / 64, kb = item % nkb, nb = item / nkb, k0 = 64 * kb, n0 = 64 * nb, ns0 = map_col(J.map, n0);
#elif defined(P0_MAP3)
    const int nblk = J.Ndst / 64, g = item / (8 * nblk), r = item % (8 * nblk), kb = 8 * g + (r & 7), nb = r >> 3, k0 = 64 * kb, n0 = 64 * nb, ns0 = map_col(J.map, n0);
#else
    const int nblk = J.Ndst / 64, kb = item / nblk, nb = item % nblk, k0 = 64 * kb, n0 = 64 * nb, ns0 = map_col(J.map, n0);
#endif
    const float* src = J.src + (size_t)(k0 + (lane >> 4)) * J.Nsrc + ns0 + 4 * (lane & 15);
    f32x4 v[16];
#pragma unroll
    for (int i = 0; i < 16; ++i) v[i] = __builtin_nontemporal_load((const f32x4*)(src + (size_t)(4 * i) * J.Nsrc));
    if (J.gain) {
#pragma unroll
        for (int i = 0; i < 16; ++i) v[i] *= J.gain[k0 + 4 * i + (lane >> 4)];
    }
#pragma unroll
    for (int i = 0; i < 16; ++i) { LAS float* d = scr + (4 * i + (lane >> 4)) * 65 + 4 * (lane & 15); d[0] = v[i].x; d[1] = v[i].y; d[2] = v[i].z; d[3] = v[i].w; }
    LDS_WAIT(); asm volatile("" ::: "memory");
    const int c = lane & 7;
#pragma unroll
    for (int j = 0; j < 8; ++j) { const int n = (lane >> 3) + 8 * j; const LAS float* s = scr + (8 * c) * 65 + n;
        u32x4 o; o.x = pk2(s[0 * 65], s[1 * 65]); o.y = pk2(s[2 * 65], s[3 * 65]); o.z = pk2(s[4 * 65], s[5 * 65]); o.w = pk2(s[6 * 65], s[7 * 65]);
        *(u32x4*)(J.dst + (size_t)(n0 + n) * J.K + k0 + 8 * c) = o; }
    LDS_WAIT(); asm volatile("" ::: "memory");
}
DI void p0_wps_item(const Params& p, bf16_t* WPS, int item, int lane) {
    const size_t e = (size_t)item * 512 + lane * 8; const float* src = p.w_pool + e;
    const f32x4 a = *(const f32x4*)src, b = *(const f32x4*)(src + 4);
    u32x4 o; o.x = pk2(a.x, a.y); o.y = pk2(a.z, a.w); o.z = pk2(b.x, b.y); o.w = pk2(b.z, b.w);
    *(u32x4*)(WPS + e) = o;
}
DI void p0_plb_item(const Params& p, bf16_t* PLB, int item, int lane) {
    const size_t e = (size_t)item * 512 + lane * 8; const size_t row = e / PLE;
    const float* src = (row < MP) ? p.p_prompt + e : p.p_sample + (e - (size_t)MP * PLE);
    const f32x4 a = *(const f32x4*)src, b = *(const f32x4*)(src + 4);
    u32x4 o; o.x = pk2(a.x, a.y); o.y = pk2(a.z, a.w); o.z = pk2(b.x, b.y); o.w = pk2(b.z, b.w);
    *(u32x4*)(PLB + e) = o;
}

DI void p0_xprep_unit(const Params& p, LAS unsigned char* lds, int u, int wave) {
    const int lane = lane_id(), tid = wave * 64 + lane;
    unsigned char* ws = p.ws;
    bf16_t* XB = (bf16_t*)(ws + WS_XB); float* RSTD1 = (float*)(ws + WS_RSTD1); float* BCUM = (float*)(ws + WS_BCUM); float* LAM = (float*)(ws + WS_LAM);
    LAS unsigned char* WG = lds; LAS float* GL = (LAS float*)(lds + 65536); LAS float* RS = (LAS float*)(lds + 69632);
    {   f32x4 w[16]; float gk[16];
#pragma unroll
        for (int i = 0; i < 16; ++i) { const int idx = tid + 512 * i, k = idx >> 2, n4 = idx & 3; w[i] = *(const f32x4*)(p.w_in + (size_t)k * INW + 6144 + 4 * n4); gk[i] = p.norm_mix[k]; }
#pragma unroll
        for (int i = 0; i < 16; ++i) { const int idx = tid + 512 * i, k = idx >> 2, n4 = idx & 3; LAS bf16_t* d = (LAS bf16_t*)(WG + (size_t)((k >> 3) * 16 + 4 * n4) * 16) + (k & 7);
            const unsigned a = pk2(w[i].x * gk[i], w[i].y * gk[i]), b = pk2(w[i].z * gk[i], w[i].w * gk[i]);
            d[0] = (bf16_t)(a & 0xffffu); d[8] = (bf16_t)(a >> 16); d[16] = (bf16_t)(b & 0xffffu); d[24] = (bf16_t)(b >> 16); }
    }
    __syncthreads();
    if (wave < 4) {
        const int fr = lane & 15, fq = lane >> 4; const int row = 64 * u + 16 * wave + fr;
        const float* xr = (row < MP) ? p.x_prompt + (size_t)row * D : p.x_sample + (size_t)(row - MP) * D;
        f32x4 acc = {0.f, 0.f, 0.f, 0.f}; float ss = 0.f;
#pragma unroll 1
        for (int s0 = 0; s0 < 64; s0 += 8) {
            f32x4 xa[8], xb[8];
#pragma unroll
                        for (int i = 0; i < 8; ++i) { xa[i] = __builtin_nontemporal_load((const f32x4*)(xr + 32 * (s0 + i) + 8 * fq)); xb[i] = __builtin_nontemporal_load((const f32x4*)(xr + 32 * (s0 + i) + 8 * fq + 4)); }
#pragma unroll
            for (int i = 0; i < 8; ++i) { const int s = s0 + i; const f32x4 a = xa[i], b = xb[i];
                ss += (a.x * a.x + a.y * a.y) + (a.z * a.z + a.w * a.w) + (b.x * b.x + b.y * b.y) + (b.z * b.z + b.w * b.w);
                u32x4 o; o.x = pk2(a.x, a.y); o.y = pk2(a.z, a.w); o.z = pk2(b.x, b.y); o.w = pk2(b.z, b.w);
                *(u32x4*)(XB + (size_t)row * D + 32 * s + 8 * fq) = o;
                const bf16x8 af = __builtin_bit_cast(bf16x8, o);
                const bf16x8 bfr = *(const LAS bf16x8*)(WG + (size_t)((4 * s + fq) * 16 + fr) * 16);
                acc = __builtin_amdgcn_mfma_f32_16x16x32_bf16(af, bfr, acc, 0, 0, 0); }
        }
        ss += __shfl_xor(ss, 16); ss += __shfl_xor(ss, 32);
        const float rstd = 1.0f / sqrtf(ss * (1.0f / D) + EPS);
        if (fq == 0) { RS[16 * wave + fr] = rstd; RSTD1[row] = rstd; ((float*)(ws + WS_RS1))[row] = 0.f; }
        LDS_WAIT(); asm volatile("" ::: "memory");
#pragma unroll
        for (int j = 0; j < 4; ++j) { const int tl = 16 * wave + 4 * fq + j; GL[tl * 16 + fr] = acc[j] * RS[tl]; }
    }
    __syncthreads();
    const bool sample = (u >= MP / 64);
#pragma unroll 1
    for (int cc = 0; cc < 2; ++cc) {
        const int c = tid + 512 * cc; float wg[16];
#pragma unroll
        for (int j = 0; j < 16; ++j) wg[j] = p.w_gate_up[j * KW + c];
        const float bg = p.b_gate[c]; float cum = 0.f;
#pragma unroll 2
        for (int t = 0; t < 64; ++t) {
            const f32x4 g0 = *(const LAS f32x4*)(GL + t * 16), g1 = *(const LAS f32x4*)(GL + t * 16 + 4), g2 = *(const LAS f32x4*)(GL + t * 16 + 8), g3 = *(const LAS f32x4*)(GL + t * 16 + 12);
            float z = bg;
            z += g0.x * wg[0] + g0.y * wg[1] + g0.z * wg[2] + g0.w * wg[3];
            z += g1.x * wg[4] + g1.y * wg[5] + g1.z * wg[6] + g1.w * wg[7];
            z += g2.x * wg[8] + g2.y * wg[9] + g2.z * wg[10] + g2.w * wg[11];
            z += g3.x * wg[12] + g3.y * wg[13] + g3.z * wg[14] + g3.w * wg[15];
            const float gl = logsigmoidf_(z) * (1.0f / 16.0f);
            const int row = 64 * u + t;
            if (sample) { BCUM[(size_t)row * KW + c] = 0.f; LAM[(size_t)(NCHK + row - MP) * KW + c] = __expf(gl); }
            else { cum = ((t & (CH - 1)) == 0) ? gl : cum + gl; BCUM[(size_t)row * KW + c] = cum; if ((t & (CH - 1)) == CH - 1) LAM[(size_t)(row / CH) * KW + c] = __expf(cum); }
        }
    }
    __syncthreads();
}

constexpr int NXPREP = M / 64;
#ifndef P0_W_OTHER
#define P0_W_OTHER 5
#endif
#ifndef DEFER_W
#define DEFER_W 1
#endif
template <int SET> DI void deferred_transposes(const Params& p, LAS unsigned char* lds, int wave, int idx, int n);
DI void phase_p0(const Params& p, LAS unsigned char* lds, int wave) {
    const int lane = lane_id();
    unsigned char* ws = p.ws;
#ifndef P0_REP
#define P0_REP 0
#endif
    const int G = gridDim.x, c = blockIdx.x; const bool has_unit = c < NXPREP;
    const int nx = (G < NXPREP) ? G : NXPREP, W_OTHER = P0_W_OTHER;
    const int nslots_total = nx * NWAVES + (G - nx) * NWAVES * W_OTHER;
    const int my_n = has_unit ? 1 : W_OTHER;
    const int my_first = has_unit ? c * NWAVES + wave : nx * NWAVES + ((c - nx) * NWAVES + wave) * W_OTHER;
    if (has_unit) { for (int u = c; u < NXPREP; u += G) p0_xprep_unit(p, lds, u, wave); if (P0_REP & 1) p0_xprep_unit(p, lds, c, wave); }
    TJob J[8];
    J[0] = TJob{p.w_in, (bf16_t*)(ws + WS_WIN), p.norm_mix, D, INW, NIN, 1, (D / 64) * (NIN / 64)};
    J[1] = TJob{p.w_up, (bf16_t*)(ws + WS_WUP), p.norm_ffn, D, NUP, NUP, 2, (D / 64) * (NUP / 64)};
    J[2] = TJob{p.w_down, (bf16_t*)(ws + WS_WD), nullptr, DFF, D, D, 0, DEFER_W ? 0 : (DFF / 64) * (D / 64)};
    J[3] = TJob{p.w_branch_a, (bf16_t*)(ws + WS_WA), p.gla_norm, D, D, D, 0, DEFER_W ? 0 : (D / 64) * (D / 64)};
    J[4] = TJob{p.w_out, (bf16_t*)(ws + WS_WO), nullptr, D, D, D, 0, DEFER_W ? 0 : (D / 64) * (D / 64)};
    J[5] = TJob{p.w_ple_gate, (bf16_t*)(ws + WS_WPG), p.norm_ple, D, D, D, 0, DEFER_W ? 0 : (D / 64) * (D / 64)};
    J[6] = TJob{p.w_ple, (bf16_t*)(ws + WS_WPLE), nullptr, PLE, D, D, 0, (PLE / 64) * (D / 64)};
    J[7] = TJob{p.w_branch_b, (bf16_t*)(ws + WS_WBT), p.pool_scale, POOLW, D, D, 0, (POOLW / 64) * (D / 64)};
    LAS float* scr = (LAS float*)(lds + wave * TR_SCR);
    for (int rep = 0; rep < ((P0_REP & 2) ? 2 : 1); ++rep) {
    int base = 0;
#pragma unroll
    for (int j = 0; j < 8; ++j) {
        const int n = J[j].nitems;
        for (int k = 0; k < my_n; ++k) {
            int it = (my_first + k) - (base % nslots_total); if (it < 0) it += nslots_total;
            for (; it < n; it += nslots_total) p0_transpose_item(J[j], scr, it, lane);
        }
        base += n;
    }
    }
    if (G == 256 && !has_unit) deferred_transposes<1>(p, lds, wave, c - nx, G - nx);
    for (int k = 0; k < my_n; ++k) {
        for (int it = my_first + k; it < (POOLW * 256) / 512; it += nslots_total) p0_wps_item(p, (bf16_t*)(ws + WS_WPS), it, lane);
        for (int it = my_first + k; it < (M * PLE) / 512; it += nslots_total) p0_plb_item(p, (bf16_t*)(ws + WS_PLB), it, lane);
    }
}

template <int SET> DI void deferred_transposes(const Params& p, LAS unsigned char* lds, int wave, int idx, int n) {
    if (!DEFER_W) return;
    unsigned char* ws = p.ws; const int lane = lane_id();
    TJob J[2];
    if (SET == 0) { J[0] = TJob{p.w_down, (bf16_t*)(ws + WS_WD), nullptr, DFF, D, D, 0, (DFF / 64) * (D / 64)};
        J[1] = TJob{p.w_ple_gate, (bf16_t*)(ws + WS_WPG), p.norm_ple, D, D, D, 0, (D / 64) * (D / 64)}; }
    else { J[0] = TJob{p.w_branch_a, (bf16_t*)(ws + WS_WA), p.gla_norm, D, D, D, 0, (D / 64) * (D / 64)};
        J[1] = TJob{p.w_out, (bf16_t*)(ws + WS_WO), nullptr, D, D, D, 0, (D / 64) * (D / 64)}; }
    LAS float* scr = (LAS float*)(lds + wave * TR_SCR);
    const int gw = idx * NWAVES + wave, NGW = n * NWAVES;
#pragma unroll
    for (int j = 0; j < 2; ++j) for (int it = gw; it < J[j].nitems; it += NGW) p0_transpose_item(J[j], scr, it, lane);
}

#define MFMA32(a, b, c) __builtin_amdgcn_mfma_f32_32x32x16_bf16((a), (b), (c), 0, 0, 0)
typedef LAS s16x4* lds_s16x4_p;
DI s16x4 tr_read(LAS unsigned char* a) { return __builtin_amdgcn_ds_read_tr16_b64_v4i16((lds_s16x4_p)a); }
DI bf16x8 cat8(s16x4 lo, s16x4 hi) { return __builtin_shufflevector(lo, hi, 0, 1, 2, 3, 4, 5, 6, 7); }
DI bf16x8 ld_perm(const bf16_t* p) {
    const u32x2 a = *(const u32x2*)p, b = *(const u32x2*)(p + 8);
    u32x4 r; r.x = a.x; r.y = a.y; r.z = b.x; r.w = b.y; return __builtin_bit_cast(bf16x8, r);
}
template <int S> DI bf16x8 pack_step(const f32x16& x) {
    u32x4 r; r.x = pk2(x[8 * S + 0], x[8 * S + 1]); r.y = pk2(x[8 * S + 2], x[8 * S + 3]); r.z = pk2(x[8 * S + 4], x[8 * S + 5]); r.w = pk2(x[8 * S + 6], x[8 * S + 7]);
    return __builtin_bit_cast(bf16x8, r);
}
DI f32x16 zero16() { f32x16 z;
#pragma unroll
    for (int i = 0; i < 16; ++i) z[i] = 0.f; return z; }

constexpr int SC_BUF = 50176, SC_QI = 0, SC_KI = 16384, SC_VI = 32768, SC_LMI = 49152, SC_ATT = 3 * SC_BUF, SC_BYTES = SC_ATT + 2048;
static_assert(SC_BYTES <= LDS_MISC, "scan LDS map");
DI void dma16(const void* g, LAS unsigned char* l) { __builtin_amdgcn_global_load_lds((const unsigned*)g, (LAS unsigned*)l, 16, 0, 0); }
DI bf16x8 lds_perm(LAS unsigned char* a) {
    const u32x2 x = *(const LAS u32x2*)a, y = *(const LAS u32x2*)(a + 512);
    u32x4 r; r.x = x.x; r.y = x.y; r.z = y.x; r.w = y.y; return __builtin_bit_cast(bf16x8, r);
}
#define SC_BAR() do { asm volatile("s_waitcnt lgkmcnt(0)" ::: "memory"); __builtin_amdgcn_s_barrier(); asm volatile("" ::: "memory"); } while (0)
DI void scan_block(const Params& p, LAS unsigned char* lds, int task, int wave) {
    unsigned char* ws = p.ws;
    const bf16_t* QB = (const bf16_t*)(ws + WS_QB); const bf16_t* KB = (const bf16_t*)(ws + WS_KB);
    const bf16_t* V = (const bf16_t*)(ws + WS_V); bf16_t* OG = (bf16_t*)(ws + WS_OG);
    const float* LAM = (const float*)(ws + WS_LAM); float* OSS = (float*)(ws + WS_OSS);
    const int half = task & 1, hd = (task >> 1) & 3, b = task >> 3, sl = 8 * half + wave;
    f32x16 S[8];
#pragma unroll
    for (int db = 0; db < 8; ++db) S[db] = zero16();

#define SC_ISSUE(ch_, slot_) do { const int _l = lane_id(); const size_t _r0 = (size_t)(b * SEQ + CH * (ch_)); LAS unsigned char* _lb = lds + (slot_) * SC_BUF; asm volatile("" : "+s"(_lb)); \
        _Pragma("unroll") for (int _k = 0; _k < 2; ++_k) { const int _i = 2 * wave + _k; \
            const int _row = _l & 31, _cc = 2 * _i + (_l >> 5); \
            dma16(QB + (_r0 + _row) * KW + hd * 256 + 8 * _cc, _lb + SC_QI + _i * 1024); \
            const int _s = 2 * _i + (_l >> 5), _c2 = (_l & 31) ^ (4 * (_s & 3)); \
            dma16(KB + (_r0 + _s) * KW + hd * 256 + 8 * _c2, _lb + SC_KI + _i * 1024); dma16(V + (_r0 + _s) * VW + hd * 512 + 256 * half + 8 * _c2, _lb + SC_VI + _i * 1024); } \
        if (wave == 0) dma16(LAM + (size_t)(b * (SEQ / CH) + (ch_)) * KW + hd * 256 + 4 * _l, _lb + SC_LMI); } while (0)
    constexpr int NCH = SEQ / CH;
    SC_ISSUE(0, 0); SC_ISSUE(1, 1);
    int slot = 0;
#pragma unroll 1
    for (int ch = 0; ch < NCH; ++ch) {
        const int row0 = b * SEQ + CH * ch;
        if (ch == 0) { if (wave == 0) asm volatile("s_waitcnt vmcnt(7)" ::: "memory"); else asm volatile("s_waitcnt vmcnt(6)" ::: "memory"); }
        else if (ch == 1) { if (wave == 0) asm volatile("s_waitcnt vmcnt(11)" ::: "memory"); else asm volatile("s_waitcnt vmcnt(10)" ::: "memory"); }
        else if (ch + 1 < NCH) { if (wave == 0) asm volatile("s_waitcnt vmcnt(15)" ::: "memory"); else asm volatile("s_waitcnt vmcnt(14)" ::: "memory"); }
        else VM_WAIT();
        SC_BAR();
        { const int s2 = (slot == 0) ? 2 : slot - 1; if (ch + 2 < NCH) SC_ISSUE(ch + 2, s2); }
        const int lane = lane_id();
        const int c = lane & 31, h = lane >> 5;
        const int i16 = lane & 15, q = i16 >> 2, pp = i16 & 3, jb = (lane >> 4) & 1;
        LAS unsigned char* buf = lds + slot * SC_BUF;
        LAS unsigned char* ATT = lds + SC_ATT;

        if (wave < 4) {
            const int si = wave >> 1, ti = wave & 1, fr = lane & 15, fq = lane >> 4;
            f32x4 a = {0.f, 0.f, 0.f, 0.f};
            LAS unsigned char* kp = buf + SC_KI + (16 * si + fr) * 512; LAS unsigned char* qp = buf + SC_QI + fq * 512 + (16 * ti + fr) * 16;
            const int kx = 4 * (fr & 3);
#pragma unroll
            for (int ks = 0; ks < 8; ++ks) a = __builtin_amdgcn_mfma_f32_16x16x32_bf16(*(const LAS bf16x8*)(kp + (((4 * ks + fq) ^ kx) * 16)), *(const LAS bf16x8*)(qp + 2048 * ks), a, 0, 0, 0);
            const int s0 = 16 * si + 4 * fq, t = 16 * ti + fr;
            u32x2 w; w.x = pk2(s0 + 0 <= t ? a[0] : 0.f, s0 + 1 <= t ? a[1] : 0.f); w.y = pk2(s0 + 2 <= t ? a[2] : 0.f, s0 + 3 <= t ? a[3] : 0.f);
            *(LAS u32x2*)(ATT + t * 64 + s0 * 2) = w;
        }
        SC_BAR();

        f32x16 o = zero16();
        LAS unsigned char* vb = buf + SC_VI + (8 * h + q) * 512 + (4 * (wave ^ q) + 2 * jb + (pp >> 1)) * 16 + (pp & 1) * 8;
        const bf16x8 vf0 = cat8(tr_read(vb), tr_read(vb + 4 * 512)), vf1 = cat8(tr_read(vb + 16 * 512), tr_read(vb + 20 * 512));
        {
            LAS unsigned char* ab = ATT + c * 64 + 16 * h;
            o = MFMA32(vf0, *(const LAS bf16x8*)ab, o);
            o = MFMA32(vf1, *(const LAS bf16x8*)(ab + 32), o);
            LAS unsigned char* qa = buf + SC_QI + c * 16 + 8 * h;
#pragma unroll
            for (int db = 0; db < 8; ++db) {
                { const bf16x8 qf = lds_perm(qa + 2048 * db); o = MFMA32(pack_step<0>(S[db]), qf, o); }
                { const bf16x8 qf = lds_perm(qa + 2048 * db + 1024); o = MFMA32(pack_step<1>(S[db]), qf, o); }
                if ((db & 3) == 3) __builtin_amdgcn_sched_barrier(0);
            }
            const int t = row0 + c;
            float ss = 0.f;
#pragma unroll
            for (int r = 0; r < 16; ++r) ss += o[r] * o[r];
            { const auto sw = __builtin_amdgcn_permlane32_swap(__float_as_uint(ss), __float_as_uint(ss), false, false); ss = __uint_as_float(sw[0]) + __uint_as_float(sw[1]); }
            if (h == 0) OSS[(size_t)t * 64 + hd * 16 + sl] = ss;
            bf16_t* og = OG + (size_t)row0 * VW + hd * 512 + 32 * sl + c * VW + 4 * h;
#pragma unroll
            for (int g = 0; g < 4; ++g) { u32x2 w; w.x = pk2(o[4 * g + 0], o[4 * g + 1]); w.y = pk2(o[4 * g + 2], o[4 * g + 3]); *(u32x2*)(og + 8 * g) = w; }
        }
        __builtin_amdgcn_sched_barrier(0);

        {
            LAS unsigned char* kbase = buf + SC_KI + (8 * h + q) * 512 + (2 * jb + (pp >> 1)) * 16 + (pp & 1) * 8;
            LAS unsigned char* lm = buf + SC_LMI + 16 * h;
#pragma unroll
            for (int db = 0; db < 8; ++db) {
                LAS unsigned char* kb = kbase + (((db & 3) ^ q) * 4) * 16 + (db >> 2) * 256;
                S[db] = MFMA32(cat8(tr_read(kb), tr_read(kb + 4 * 512)), vf0, S[db]);
                S[db] = MFMA32(cat8(tr_read(kb + 16 * 512), tr_read(kb + 20 * 512)), vf1, S[db]);
#pragma unroll
                for (int g = 0; g < 4; ++g) { const f32x4 l4 = *(const LAS f32x4*)(lm + (32 * db + 8 * g) * 4);
                    S[db][4 * g + 0] *= l4.x; S[db][4 * g + 1] *= l4.y; S[db][4 * g + 2] *= l4.z; S[db][4 * g + 3] *= l4.w; }
                if (db & 1) __builtin_amdgcn_sched_barrier(0);
            }
        }
        asm volatile("" ::: "memory");
        slot = (slot == 2) ? 0 : slot + 1;
    }
#undef SC_ISSUE
    {   const int lane = lane_id();
        const unsigned voff = (unsigned)(((lane >> 5) * 4 * DV + (lane & 31)) * 4);
        const char* gbase = (const char*)(p.out + O_GLAP + ((size_t)(b * NH + hd) * DK) * DV + 32 * sl);
#pragma unroll
        for (int db = 0; db < 8; ++db) {
#pragma unroll
            for (int r = 0; r < 16; ++r) { const int dl = 32 * db + (r & 3) + 8 * (r >> 2); *(float*)(const_cast<char*>(gbase) + (size_t)dl * DV * 4 + voff) = S[db][r]; }
        }
    }
    __syncthreads();
}

DI void sgla_task(const Params& p, int task, int lane) {
    unsigned char* ws = p.ws;
    const bf16_t* QB = (const bf16_t*)(ws + WS_QB); const bf16_t* KB = (const bf16_t*)(ws + WS_KB); const bf16_t* V = (const bf16_t*)(ws + WS_V);
    const float* LAM = (const float*)(ws + WS_LAM); float* OSP = (float*)(ws + WS_OSP);
    const int dblk = task & 7, hd = (task >> 3) & 3, b = task >> 5; const int row = MP + b;
    const size_t sbase = ((size_t)(b * NH + hd) * DK + 32 * dblk) * DV;
    const float* S0 = p.state_gla + sbase; float* So = p.out + O_GLAS + sbase;
    const int dl = lane & 31;
    const float lam_l = LAM[(size_t)(NCHK + b) * KW + hd * 256 + 32 * dblk + dl];
    const float k_l = bf1(KB[(size_t)row * KW + hd * 256 + 32 * dblk + dl]);
    const float q_l = bf1(QB[(size_t)row * KW + hd * 256 + 32 * dblk + dl]);
    f32x4 va, vb;
    { const u32x2 w = *(const u32x2*)(V + (size_t)row * VW + hd * 512 + 4 * lane); va = (f32x4){bflo(w.x), bfhi(w.x), bflo(w.y), bfhi(w.y)}; }
    { const u32x2 w = *(const u32x2*)(V + (size_t)row * VW + hd * 512 + 256 + 4 * lane); vb = (f32x4){bflo(w.x), bfhi(w.x), bflo(w.y), bfhi(w.y)}; }
    f32x4 oa = {0.f, 0.f, 0.f, 0.f}, ob = {0.f, 0.f, 0.f, 0.f};
#pragma unroll 1
    for (int d0 = 0; d0 < 32; d0 += 16) {
        f32x4 ra[16], rb[16];
#pragma unroll
        for (int i = 0; i < 16; ++i) { ra[i] = __builtin_nontemporal_load((const f32x4*)(S0 + (size_t)(d0 + i) * DV + 4 * lane)); rb[i] = __builtin_nontemporal_load((const f32x4*)(S0 + (size_t)(d0 + i) * DV + 256 + 4 * lane)); }
#pragma unroll
        for (int i = 0; i < 16; ++i) { const int d = d0 + i;
            const float lam = __uint_as_float(__builtin_amdgcn_readlane(__float_as_uint(lam_l), d)), kk = __uint_as_float(__builtin_amdgcn_readlane(__float_as_uint(k_l), d)), qq = __uint_as_float(__builtin_amdgcn_readlane(__float_as_uint(q_l), d));
            const f32x4 sa = ra[i] * lam + va * kk, sb = rb[i] * lam + vb * kk;
            __builtin_nontemporal_store(sa, (f32x4*)(So + (size_t)d * DV + 4 * lane)); __builtin_nontemporal_store(sb, (f32x4*)(So + (size_t)d * DV + 256 + 4 * lane));
            oa += sa * qq; ob += sb * qq; }
    }
    float* op = OSP + ((size_t)(b * NH + hd) * 8 + dblk) * DV;
    *(f32x4*)(op + 4 * lane) = oa; *(f32x4*)(op + 256 + 4 * lane) = ob;
}

DI f32x4 ldu4(const bf16_t* q) { const u32x2 w = *(const u32x2*)q; return (f32x4){bflo(w.x), bfhi(w.x), bflo(w.y), bfhi(w.y)}; }
DI void pmix_task(const Params& p, int t, int lane) {
    unsigned char* ws = p.ws;
    const bf16_t* U = (const bf16_t*)(ws + WS_U); bf16_t* PM = (bf16_t*)(ws + WS_PM);
    if (t < MP) {
        const int b = t >> 11, pos = t & 2047;
#pragma unroll
        for (int i = 0; i < 4; ++i) {
            const int w = 2 << i, c = 256 * i + 4 * lane; const int cnt = (pos + 1 < w) ? pos + 1 : w;
            const f32x4 u0 = ldu4(U + (size_t)t * POOLW + c); f32x4 s = u0;
#pragma unroll
            for (int j = 1; j < w; ++j) {
                const bool in = j < cnt; const f32x4 v = ldu4(U + (size_t)(in ? t - j : t) * POOLW + c); const float m = in ? 1.f : 0.f; s += v * m; }
            const float inv = 1.0f / (float)cnt; const f32x4 mx = s * inv - u0;
            u32x2 o; o.x = pk2(mx.x, mx.y); o.y = pk2(mx.z, mx.w); *(u32x2*)(PM + (size_t)t * POOLW + c) = o;
            if (pos >= SEQ - 15) *(f32x4*)(p.out + O_POOLP + ((size_t)b * 15 + (pos - (SEQ - 15))) * POOLW + c) = u0;
        }
    } else {
        const int b = t - MP; const float* sp = p.state_pool + (size_t)b * 15 * POOLW; float* po = p.out + O_POOLS + (size_t)b * 15 * POOLW;
#pragma unroll
        for (int i = 0; i < 4; ++i) {
            const int w = 2 << i, c = 256 * i + 4 * lane;
            const f32x4 u0 = ldu4(U + (size_t)t * POOLW + c); f32x4 s = u0;
#pragma unroll
            for (int j = 1; j < w; ++j) s += *(const f32x4*)(sp + (size_t)(15 - j) * POOLW + c);
            const float inv = 1.0f / (float)w; const f32x4 mx = s * inv - u0;
            u32x2 o; o.x = pk2(mx.x, mx.y); o.y = pk2(mx.z, mx.w); *(u32x2*)(PM + (size_t)t * POOLW + c) = o;
            *(f32x4*)(po + (size_t)14 * POOLW + c) = u0;
        }
    }
}

DI void pool_copy_task(const Params& p, int item, int lane) {
    const int b = item / 14, r = item - 14 * b; const float* src = p.state_pool + ((size_t)b * 15 + r + 1) * POOLW + 4 * lane; float* dst = p.out + O_POOLS + ((size_t)b * 15 + r) * POOLW + 4 * lane;
#ifdef POOL_NT
    const f32x4 v0 = __builtin_nontemporal_load((const f32x4*)src), v1 = __builtin_nontemporal_load((const f32x4*)(src + 256)), v2 = __builtin_nontemporal_load((const f32x4*)(src + 512)), v3 = __builtin_nontemporal_load((const f32x4*)(src + 768));
    __builtin_nontemporal_store(v0, (f32x4*)dst); __builtin_nontemporal_store(v1, (f32x4*)(dst + 256)); __builtin_nontemporal_store(v2, (f32x4*)(dst + 512)); __builtin_nontemporal_store(v3, (f32x4*)(dst + 768));
#else
    const f32x4 v0 = *(const f32x4*)src, v1 = *(const f32x4*)(src + 256), v2 = *(const f32x4*)(src + 512), v3 = *(const f32x4*)(src + 768);
    *(f32x4*)dst = v0; *(f32x4*)(dst + 256) = v1; *(f32x4*)(dst + 512) = v2; *(f32x4*)(dst + 768) = v3;
#endif
}
#ifndef P2_REP
#define P2_REP 0
#endif
DI void scan_role(const Params& p, LAS unsigned char* lds, int wave, int idx, int n) {
    for (int rep = 0; rep < ((P2_REP & 1) ? 2 : 1); ++rep) for (int task = (n == 32) ? (idx % 8) * 4 + idx / 8 : idx; task < 2 * NB * NH; task += n) scan_block(p, lds, task, wave);
}
constexpr int SG_NSTREAM = 13 * 39 * NWAVES;
DI void scan_tail(const Params& p, int wave, int idx) { const int j = wave * 32 + idx; if (SG_NSTREAM + j < MS * NH * 8) sgla_task(p, SG_NSTREAM + j, lane_id()); }
DI void stream_role(const Params& p, int wave, int idx, int n) {
    const int lane = lane_id(); const int gw = idx * NWAVES + wave, NGW = n * NWAVES;
    for (int rep = 0; rep < ((P2_REP & 2) ? 2 : 1); ++rep) {
        const int ntask = (n == 39) ? SG_NSTREAM : MS * NH * 8;
        for (int task = gw; task < ntask; task += NGW) sgla_task(p, task, lane); }
}

DI void ogn_task(const Params& p, int t, int lane) {
    unsigned char* ws = p.ws;
    bf16_t* OG = (bf16_t*)(ws + WS_OG); const float* OSS = (const float*)(ws + WS_OSS); const float* OSP = (const float*)(ws + WS_OSP); const bf16_t* SR = (const bf16_t*)(ws + WS_SR);
    if (t < MP) {
        f32x4 sa[4], sb[4], sc[4], sd[4]; u32x4 w[4], g[4];
#pragma unroll
        for (int hd = 0; hd < 4; ++hd) {
            const float* sp = OSS + (size_t)t * 64 + hd * 16; sa[hd] = *(const f32x4*)sp; sb[hd] = *(const f32x4*)(sp + 4); sc[hd] = *(const f32x4*)(sp + 8); sd[hd] = *(const f32x4*)(sp + 12);
            w[hd] = *(const u32x4*)(OG + (size_t)t * VW + hd * 512 + 8 * lane); g[hd] = *(const u32x4*)(SR + (size_t)t * VW + hd * 512 + 8 * lane); }
#pragma unroll
        for (int hd = 0; hd < 4; ++hd) {
            const f32x4 a = sa[hd], b = sb[hd], c = sc[hd], d = sd[hd];
            const float ss = ((a.x + a.y) + (a.z + a.w)) + ((b.x + b.y) + (b.z + b.w)) + ((c.x + c.y) + (c.z + c.w)) + ((d.x + d.y) + (d.z + d.w));
            const float rstd = 1.0f / sqrtf(ss * (1.0f / DV) + EPS);
            const u32x4 ww = w[hd], gg = g[hd];
            u32x4 o; o.x = pk2(bflo(ww.x) * rstd * bflo(gg.x), bfhi(ww.x) * rstd * bfhi(gg.x)); o.y = pk2(bflo(ww.y) * rstd * bflo(gg.y), bfhi(ww.y) * rstd * bfhi(gg.y));
            o.z = pk2(bflo(ww.z) * rstd * bflo(gg.z), bfhi(ww.z) * rstd * bfhi(gg.z)); o.w = pk2(bflo(ww.w) * rstd * bflo(gg.w), bfhi(ww.w) * rstd * bfhi(gg.w));
            *(u32x4*)(OG + (size_t)t * VW + hd * 512 + 8 * lane) = o;
        }
    } else {
        const int b = t - MP;
#pragma unroll
        for (int hd = 0; hd < 4; ++hd) {
            f32x4 oa = {0.f, 0.f, 0.f, 0.f}, ob = {0.f, 0.f, 0.f, 0.f};
#pragma unroll
            for (int k = 0; k < 8; ++k) { const float* op = OSP + ((size_t)(b * NH + hd) * 8 + k) * DV + 8 * lane; oa += *(const f32x4*)op; ob += *(const f32x4*)(op + 4); }
            float ss = (oa.x * oa.x + oa.y * oa.y) + (oa.z * oa.z + oa.w * oa.w) + (ob.x * ob.x + ob.y * ob.y) + (ob.z * ob.z + ob.w * ob.w);
            ss = wave_sum(ss);
            const float rstd = 1.0f / sqrtf(ss * (1.0f / DV) + EPS);
            const u32x4 w = *(const u32x4*)(SR + (size_t)t * VW + hd * 512 + 8 * lane);
            u32x4 o; o.x = pk2(oa.x * rstd * bflo(w.x), oa.y * rstd * bfhi(w.x)); o.y = pk2(oa.z * rstd * bflo(w.y), oa.w * rstd * bfhi(w.y));
            o.z = pk2(ob.x * rstd * bflo(w.z), ob.y * rstd * bfhi(w.z)); o.w = pk2(ob.z * rstd * bflo(w.w), ob.w * rstd * bfhi(w.w));
            *(u32x4*)(OG + (size_t)t * VW + hd * 512 + 8 * lane) = o;
        }
    }
}
DI void phase_p3(const Params& p, int wave) {
    const int lane = lane_id();
    const int gw = (int)blockIdx.x * NWAVES + wave, NGW = gridDim.x * NWAVES;
    for (int t = gw; t < M; t += NGW) pmix_task(p, t, lane);
    for (int t = gw; t < M; t += NGW) ogn_task(p, t, lane);
}

DI float row_rstd(const float* SS, const float* SSs, int row, int lane) {
    float v = (row < MP) ? ((lane < 32) ? SS[(size_t)row * 32 + lane] : 0.f) : (SSs[(size_t)(row - MP) * 128 + lane] + SSs[(size_t)(row - MP) * 128 + 64 + lane]);
    v = wave_sum(v);
    return 1.0f / sqrtf(v * (1.0f / D) + EPS);
}

struct F8 { f32x4 a, b; };
DI F8 unpack8(u32x4 w, float s) { F8 r; r.a = (f32x4){bflo(w.x) * s, bfhi(w.x) * s, bflo(w.y) * s, bfhi(w.y) * s}; r.b = (f32x4){bflo(w.z) * s, bfhi(w.z) * s, bflo(w.w) * s, bfhi(w.w) * s}; return r; }
DI F8 ld8(const float* q) { F8 r; r.a = *(const f32x4*)q; r.b = *(const f32x4*)(q + 4); return r; }
DI void st8(float* q, const F8& v) { *(f32x4*)q = v.a; *(f32x4*)(q + 4) = v.b; }
DI f32x4 silu4(f32x4 x) { return (f32x4){siluf_(x.x), siluf_(x.y), siluf_(x.z), siluf_(x.w)}; }
DI void conv_fixup_tile(const Params& p, int pm, int wave) {
    if ((pm & 7) == 0) return;
    unsigned char* ws = p.ws; const int tid = wave * 64 + lane_id();
    const float* HALO = (const float*)(ws + WS_HALO) + (size_t)(pm - 1) * 2 * DFF; const float* FG = (const float*)(ws + WS_FIXG) + (size_t)pm * 2 * DFF; const float* FU = (const float*)(ws + WS_FIXU) + (size_t)pm * 2 * DFF;
    bf16_t* ACT = (bf16_t*)(ws + WS_ACT) + (size_t)pm * 256 * DFF;
    for (int v = tid; v < DFF / 8; v += NTHREADS) { const int ch0 = 8 * v;
        const F8 w0 = ld8(p.conv_w + ch0), w1 = ld8(p.conv_w + DFF + ch0), w2 = ld8(p.conv_w + 2 * DFF + ch0), cb = ld8(p.conv_b + ch0);
        const F8 h14 = ld8(HALO + ch0), h15 = ld8(HALO + DFF + ch0), g0 = ld8(FG + ch0), g1 = ld8(FG + DFF + ch0), u0 = ld8(FU + ch0), u1 = ld8(FU + DFF + ch0);
        const f32x4 a0 = silu4(cb.a + w0.a * h14.a + w1.a * h15.a + w2.a * g0.a) * u0.a, b0 = silu4(cb.b + w0.b * h14.b + w1.b * h15.b + w2.b * g0.b) * u0.b;
        const f32x4 a1 = silu4(cb.a + w0.a * h15.a + w1.a * g0.a + w2.a * g1.a) * u1.a, b1 = silu4(cb.b + w0.b * h15.b + w1.b * g0.b + w2.b * g1.b) * u1.b;
        *(u32x4*)(ACT + ch0) = pk8(a0, b0); *(u32x4*)(ACT + DFF + ch0) = pk8(a1, b1); }
}

DI void phase_final(const Params& p, int wave) {
    const int lane = lane_id();
    const int gw = (int)blockIdx.x * NWAVES + wave, NGW = gridDim.x * NWAVES;
    const bf16_t* H3 = (const bf16_t*)(p.ws + WS_H3); const float* SS3 = (const float*)(p.ws + WS_SS3); const float* SS3S = (const float*)(p.ws + WS_SS3S);
    for (int t = gw; t < M; t += NGW) {
        const float rs = row_rstd(SS3, SS3S, t, lane);
        float* yo = (t < MP) ? p.out + O_YP + (size_t)t * D : p.out + O_YS + (size_t)(t - MP) * D;
        u32x4 w[4]; f32x4 g0[4], g1[4];
#pragma unroll
        for (int i = 0; i < 4; ++i) { const int c = 512 * i + 8 * lane; w[i] = *(const u32x4*)(H3 + (size_t)t * D + c); g0[i] = *(const f32x4*)(p.norm_final + c); g1[i] = *(const f32x4*)(p.norm_final + c + 4); }
#pragma unroll
        for (int i = 0; i < 4; ++i) { const int c = 512 * i + 8 * lane; *(f32x4*)(yo + c) = bf4lo(w[i]) * rs * g0[i]; *(f32x4*)(yo + c + 4) = bf4hi(w[i]) * rs * g1[i]; }
    }
}

#define EPI_ARGS const f32x4 (&acc)[2][2][4][2], const g8::Unit& u, int wr, int wc, int fr, int fq
#define EPI_ROWS(ROWVAR) _Pragma("unroll") for (int ai = 0; ai < 2; ++ai) _Pragma("unroll") for (int m = 0; m < 4; ++m) { const int ROWVAR = u.pm * 256 + ai * 128 + wr * 64 + m * 16 + fr; if (ROWVAR < M) {
#define EPI_COLS(COLVAR) _Pragma("unroll") for (int bj = 0; bj < 2; ++bj) { const int COLVAR = bj * 128 + wc * 32 + 8 * fq; const f32x4 v0 = acc[ai][bj][m][0], v1 = acc[ai][bj][m][1];
#define EPI_END } } }
DI f32x4 exp4(f32x4 x) { return (f32x4){__expf(x.x), __expf(x.y), __expf(x.z), __expf(x.w)}; }
DI f32x4 sig4(f32x4 x) { return (f32x4){sigmoidf_(x.x), sigmoidf_(x.y), sigmoidf_(x.z), sigmoidf_(x.w)}; }
DI float sum4(f32x4 a) { return (a.x + a.y) + (a.z + a.w); }

#ifndef WGM_P2
#define WGM_P2 2
#endif
struct PhaseIn {
    static constexpr int LDA = D, LDB = D, KT = D / 64;
    const Params& p; int G, c, part;
    int c0;
    DI bool next(int i, g8::Unit& u) const { int pm, pn;
        if (part == 0) { if (!g8::grid_order(NTM - 1, 16, G, c, i, pm, pn)) return false; }
        else { if (c < c0 || !g8::grid_order(NTM, 28, G - c0, c - c0, i, pm, pn, WGM_P2)) return false; pn += 16; }
        u.pm = pm; u.pn = pn; u.A = (const char*)(p.ws + WS_XB) + (size_t)pm * 256 * D * 2; u.B = (const char*)(p.ws + WS_WIN) + (size_t)pn * 256 * D * 2; return true; }
    DI void epi(EPI_ARGS) const {
        unsigned char* ws = p.ws; const float* RSTD1 = (const float*)(ws + WS_RSTD1); const float* BCUM = (const float*)(ws + WS_BCUM);
        const int pn = u.pn;
        if (pn < 4) {
            bf16_t* QB = (bf16_t*)(ws + WS_QB);
            EPI_ROWS(row) const float rs = RSTD1[row] * 0.0625f; EPI_COLS(col) const size_t o = (size_t)row * KW + pn * 256 + col;
                const f32x4 e0 = exp4(*(const f32x4*)(BCUM + o)), e1 = exp4(*(const f32x4*)(BCUM + o + 4));
                *(u32x4*)(QB + o) = pk8(v0 * rs * e0, v1 * rs * e1); EPI_END
        } else if (pn < 8) {
            bf16_t* KB = (bf16_t*)(ws + WS_KB);
            EPI_ROWS(row) const float rs = RSTD1[row]; EPI_COLS(col) const size_t o = (size_t)row * KW + (pn - 4) * 256 + col;
                const f32x4 b0 = *(const f32x4*)(BCUM + o), b1 = *(const f32x4*)(BCUM + o + 4);
                *(u32x4*)(KB + o) = pk8(v0 * rs * exp4(-b0), v1 * rs * exp4(-b1)); EPI_END
        } else if (pn < 16) {
            bf16_t* V = (bf16_t*)(ws + WS_V);
            EPI_ROWS(row) const float rs = RSTD1[row]; EPI_COLS(col) *(u32x4*)(V + (size_t)row * VW + (pn - 8) * 256 + col) = pk8(v0 * rs, v1 * rs); EPI_END
        } else if (pn < 24) {
            bf16_t* SR = (bf16_t*)(ws + WS_SR);
            EPI_ROWS(row) const float rs = RSTD1[row]; EPI_COLS(col) const f32x4 a = v0 * rs, b = v1 * rs; *(u32x4*)(SR + (size_t)row * VW + (pn - 16) * 256 + col) = pk8(a * sig4(a), b * sig4(b)); EPI_END
        } else if (pn < 28) {
            bf16_t* U = (bf16_t*)(ws + WS_U);
            EPI_ROWS(row) const float rs = RSTD1[row]; EPI_COLS(col) *(u32x4*)(U + (size_t)row * POOLW + (pn - 24) * 256 + col) = pk8(v0 * rs, v1 * rs); EPI_END
        } else {
            unsigned char* Gt = ws + (pn < 36 ? WS_GA : WS_GB); const int c0 = (pn < 36 ? pn - 28 : pn - 36) * 256;
            EPI_ROWS(row) const float rs = RSTD1[row]; EPI_COLS(col) u32x2 gq; gq.x = pku4(sig4(v0 * rs)); gq.y = pku4(sig4(v1 * rs)); *(u32x2*)(Gt + (size_t)row * D + c0 + col) = gq; EPI_END
        }
    }
};

template <int LDA_, int LDB_, int K_> struct PhaseN2048 {
    static constexpr int LDA = LDA_, LDB = LDB_, KT = K_ / 64;
    const Params& p; int G, c; size_t a_off, b_off;
    DI bool next_(int i, g8::Unit& u) const { int pm, pn; if (!g8::grid_order(NTM - 1, 8, G, c, i, pm, pn)) return false;
        u.pm = pm; u.pn = pn; u.A = (const char*)(p.ws + a_off) + (size_t)pm * 256 * LDA * 2; u.B = (const char*)(p.ws + b_off) + (size_t)pn * 256 * LDB * 2; return true; }
};
struct PhaseYb : PhaseN2048<POOLW, POOLW, POOLW> {
    DI bool next(int i, g8::Unit& u) const { return next_(i, u); }
    DI void epi(EPI_ARGS) const { const unsigned char* GB = p.ws + WS_GB; bf16_t* Y = (bf16_t*)(p.ws + WS_YBG);
#pragma unroll
        for (int ai = 0; ai < 2; ++ai) { u32x2 g[4][2];
#pragma unroll
            for (int m = 0; m < 4; ++m)
#pragma unroll
                for (int bj = 0; bj < 2; ++bj) g[m][bj] = *(const u32x2*)(GB + (size_t)(u.pm * 256 + ai * 128 + wr * 64 + m * 16 + fr) * D + u.pn * 256 + bj * 128 + wc * 32 + 8 * fq);
#pragma unroll
            for (int m = 0; m < 4; ++m)
#pragma unroll
                for (int bj = 0; bj < 2; ++bj) { const size_t o = (size_t)(u.pm * 256 + ai * 128 + wr * 64 + m * 16 + fr) * D + u.pn * 256 + bj * 128 + wc * 32 + 8 * fq;
                    *(u32x4*)(Y + o) = pk8(acc[ai][bj][m][0] * unpku4(g[m][bj].x), acc[ai][bj][m][1] * unpku4(g[m][bj].y)); } } }
};
struct PhaseYa : PhaseN2048<VW, VW, VW> {
    DI bool next(int i, g8::Unit& u) const { return next_(i, u); }
    DI void epi(EPI_ARGS) const { const unsigned char* GA = p.ws + WS_GA; const bf16_t* Y = (const bf16_t*)(p.ws + WS_YBG); bf16_t* MB = (bf16_t*)(p.ws + WS_MB);
#pragma unroll
        for (int ai = 0; ai < 2; ++ai) { u32x2 g[4][2]; u32x4 y[4][2];
#pragma unroll
            for (int m = 0; m < 4; ++m)
#pragma unroll
                for (int bj = 0; bj < 2; ++bj) { const size_t o = (size_t)(u.pm * 256 + ai * 128 + wr * 64 + m * 16 + fr) * D + u.pn * 256 + bj * 128 + wc * 32 + 8 * fq;
                    g[m][bj] = *(const u32x2*)(GA + o); y[m][bj] = *(const u32x4*)(Y + o); }
#pragma unroll
            for (int m = 0; m < 4; ++m)
#pragma unroll
                for (int bj = 0; bj < 2; ++bj) { const size_t o = (size_t)(u.pm * 256 + ai * 128 + wr * 64 + m * 16 + fr) * D + u.pn * 256 + bj * 128 + wc * 32 + 8 * fq;
                    *(u32x4*)(MB + o) = pk8(acc[ai][bj][m][0] * unpku4(g[m][bj].x) + bf4lo(y[m][bj]), acc[ai][bj][m][1] * unpku4(g[m][bj].y) + bf4hi(y[m][bj])); } } }
};
template <bool BASE_BF16, bool ATOMIC_SS>
DI void epi_residual(EPI_ARGS, const void* base_v, bf16_t* HB, float* SS) {
#pragma unroll
    for (int ai = 0; ai < 2; ++ai)
#pragma unroll
        for (int mh = 0; mh < 2; ++mh) {
            f32x4 b0[2][2], b1[2][2];
#pragma unroll
            for (int mm = 0; mm < 2; ++mm) { const int row = u.pm * 256 + ai * 128 + wr * 64 + (2 * mh + mm) * 16 + fr;
#pragma unroll
                for (int bj = 0; bj < 2; ++bj) { const size_t o = (size_t)row * D + u.pn * 256 + bj * 128 + wc * 32 + 8 * fq;
                    if (BASE_BF16) { const u32x4 w = *(const u32x4*)((const bf16_t*)base_v + o); b0[mm][bj] = bf4lo(w); b1[mm][bj] = bf4hi(w); }
                    else {
#ifdef X_NT
                        b0[mm][bj] = __builtin_nontemporal_load((const f32x4*)((const float*)base_v + o)); b1[mm][bj] = __builtin_nontemporal_load((const f32x4*)((const float*)base_v + o + 4));
#else
                        b0[mm][bj] = *(const f32x4*)((const float*)base_v + o); b1[mm][bj] = *(const f32x4*)((const float*)base_v + o + 4);
#endif
                    } } }
#pragma unroll
            for (int mm = 0; mm < 2; ++mm) { const int m = 2 * mh + mm; const int row = u.pm * 256 + ai * 128 + wr * 64 + m * 16 + fr; float ss = 0.f;
#pragma unroll
                for (int bj = 0; bj < 2; ++bj) { const size_t o = (size_t)row * D + u.pn * 256 + bj * 128 + wc * 32 + 8 * fq;
                    const f32x4 h0 = acc[ai][bj][m][0] + b0[mm][bj], h1 = acc[ai][bj][m][1] + b1[mm][bj];
                    *(u32x4*)(HB + o) = pk8(h0, h1);
                    ss += sum4(h0 * h0) + sum4(h1 * h1); }
                ss += __shfl_xor(ss, 16); ss += __shfl_xor(ss, 32);
                if (fq == 0) { if (ATOMIC_SS) __hip_atomic_fetch_add(SS + row, ss, __ATOMIC_RELAXED, __HIP_MEMORY_SCOPE_AGENT); else SS[(size_t)row * 32 + u.pn * 4 + wc] = ss; } }
        }
}
struct PhaseOut : PhaseN2048<D, D, D> {
    DI bool next(int i, g8::Unit& u) const { return next_(i, u); }
    DI void epi(EPI_ARGS) const { epi_residual<false, true>(acc, u, wr, wc, fr, fq, p.x_prompt, (bf16_t*)(p.ws + WS_H1B), (float*)(p.ws + WS_RS1)); }
};
struct PhaseDown : PhaseN2048<DFF, DFF, DFF> {
    DI bool next(int i, g8::Unit& u) const { return next_(i, u); }
    DI void epi(EPI_ARGS) const { epi_residual<true, false>(acc, u, wr, wc, fr, fq, p.ws + WS_H1B, (bf16_t*)(p.ws + WS_H2B), (float*)(p.ws + WS_SS2)); }
};
struct PhasePe : PhaseN2048<PLE, PLE, PLE> {
    int first, nfree;
    DI bool next(int i, g8::Unit& u) const { if (nfree <= 0 || c < first || c >= first + nfree) return false;
        const long L = (long)i * nfree + (c - first); if (L >= 256) return false; const int pm = (int)L >> 3, pn = (int)L & 7;
        u.pm = pm; u.pn = pn; u.A = (const char*)(p.ws + a_off) + (size_t)pm * 256 * LDA * 2; u.B = (const char*)(p.ws + b_off) + (size_t)pn * 256 * LDB * 2; return true; }
    DI void epi(EPI_ARGS) const { bf16_t* PE = (bf16_t*)(p.ws + WS_PE);
        EPI_ROWS(row) EPI_COLS(col) const size_t o = (size_t)row * D + u.pn * 256 + col; *(u32x4*)(PE + o) = pk8(v0, v1); EPI_END }
};
struct PhasePg : PhaseN2048<D, D, D> {
    DI bool next(int i, g8::Unit& u) const { return next_(i, u); }
    DI void epi(EPI_ARGS) const { const bf16_t* H2 = (const bf16_t*)(p.ws + WS_H2B); const bf16_t* PE = (const bf16_t*)(p.ws + WS_PE); const float* SS2 = (const float*)(p.ws + WS_SS2);
        bf16_t* H3 = (bf16_t*)(p.ws + WS_H3); float* SS3 = (float*)(p.ws + WS_SS3);
#pragma unroll
        for (int ai = 0; ai < 2; ++ai)
#pragma unroll
            for (int mh = 0; mh < 2; ++mh) { u32x4 hw[2][2], pw[2][2]; float rs[2];
#pragma unroll
                for (int mm = 0; mm < 2; ++mm) { const int row = u.pm * 256 + ai * 128 + wr * 64 + (2 * mh + mm) * 16 + fr; float s2 = 0.f;
#pragma unroll
                    for (int k = 0; k < 8; ++k) s2 += sum4(*(const f32x4*)(SS2 + (size_t)row * 32 + 4 * k));
                    rs[mm] = 1.0f / sqrtf(s2 * (1.0f / D) + EPS);
#pragma unroll
                    for (int bj = 0; bj < 2; ++bj) { const size_t o = (size_t)row * D + u.pn * 256 + bj * 128 + wc * 32 + 8 * fq; hw[mm][bj] = *(const u32x4*)(H2 + o); pw[mm][bj] = *(const u32x4*)(PE + o); } }
#pragma unroll
                for (int mm = 0; mm < 2; ++mm) { const int m = 2 * mh + mm; const int row = u.pm * 256 + ai * 128 + wr * 64 + m * 16 + fr; float ss = 0.f;
#pragma unroll
                    for (int bj = 0; bj < 2; ++bj) { const size_t o = (size_t)row * D + u.pn * 256 + bj * 128 + wc * 32 + 8 * fq;
                        const f32x4 h0 = bf4lo(hw[mm][bj]) + sig4(acc[ai][bj][m][0] * rs[mm]) * bf4lo(pw[mm][bj]), h1 = bf4hi(hw[mm][bj]) + sig4(acc[ai][bj][m][1] * rs[mm]) * bf4hi(pw[mm][bj]);
                        *(u32x4*)(H3 + o) = pk8(h0, h1); ss += sum4(h0 * h0) + sum4(h1 * h1); }
                    ss += __shfl_xor(ss, 16); ss += __shfl_xor(ss, 32);
                    if (fq == 0) SS3[(size_t)row * 32 + u.pn * 4 + wc] = ss; } } }
};
#ifndef ROR_DIR
#define ROR_DIR 0
#endif
template <int N> DI float ror16(float v) { return __uint_as_float((unsigned)__builtin_amdgcn_update_dpp(0, (int)__float_as_uint(v), 0x120 + (ROR_DIR ? 16 - N : N), 0xF, 0xF, false)); }
DI F8 shfl8(const F8& v, int src) { F8 r; r.a = (f32x4){__shfl(v.a.x, src), __shfl(v.a.y, src), __shfl(v.a.z, src), __shfl(v.a.w, src)}; r.b = (f32x4){__shfl(v.b.x, src), __shfl(v.b.y, src), __shfl(v.b.z, src), __shfl(v.b.w, src)}; return r; }
DI F8 sel8(bool c, const F8& x, const F8& y) { F8 r; r.a = c ? x.a : y.a; r.b = c ? x.b : y.b; return r; }
#ifdef ACT_NT
#define ACT_ST(v_, p_) __builtin_nontemporal_store(v_, p_)
#else
#define ACT_ST(v_, p_) (*(p_) = (v_))
#endif
struct PhaseUp {
    static constexpr int LDA = D, LDB = D, KT = D / 64;
    const Params& p; int G, c; LAS unsigned char* xl;
    DI bool next(int i, g8::Unit& u) const { int pm, pn; if (c >= G || !g8::grid_order(NTM, 43, G, c, i, pm, pn)) return false;
        u.pm = pm; u.pn = pn; u.A = (const char*)(p.ws + WS_H1B) + (size_t)pm * 256 * D * 2; u.B = (const char*)(p.ws + WS_WUP) + (size_t)pn * 256 * D * 2; return true; }
    DI void epi(const f32x4 (&acc)[2][2][4][2], const g8::Unit& u, int wr, int wc, int fr_, int fq_) const {
        unsigned char* ws = p.ws; bf16_t* ACT = (bf16_t*)(ws + WS_ACT); const float* RS1 = (const float*)(ws + WS_RS1);
        const int lane = lane_id(), fr = lane & 15, fq = lane >> 4;
        (void)fr_; (void)fq_;
        const int pm = u.pm, chl = 32 * wc + 8 * fq, chb = 128 * u.pn + chl;
#define UP_RR(ai_, m_) (1.0f / sqrtf(RS1[pm * 256 + (ai_) * 128 + wr * 64 + (m_) * 16 + fr] * (1.0f / D) + EPS))
        LAS float* X = (LAS float*)xl;
        if (pm == NTM - 1) {
#pragma unroll
            for (int n = 0; n < 2; ++n) { const int ch = chb + 4 * n;
                const f32x4 w0 = *(const f32x4*)(p.conv_w + ch), w1 = *(const f32x4*)(p.conv_w + DFF + ch), w2 = *(const f32x4*)(p.conv_w + 2 * DFF + ch), cb = *(const f32x4*)(p.conv_b + ch);
#pragma unroll
                for (int m = 0; m < 4; ++m) { const int row = pm * 256 + wr * 64 + m * 16 + fr, b = row - MP; const float r0 = UP_RR(0, m);
                    const f32x4 g0 = acc[0][0][m][n] * r0, up = acc[0][1][m][n] * r0;
                    const float* sc = p.state_conv + (size_t)b * 2 * DFF + ch; const f32x4 g1 = *(const f32x4*)(sc + DFF), g2 = *(const f32x4*)sc;
                    const f32x4 aa = silu4(cb + w0 * g2 + w1 * g1 + w2 * g0) * up;
                    u32x2 o; o.x = pk2(aa.x, aa.y); o.y = pk2(aa.z, aa.w); ACT_ST(o, (u32x2*)(ACT + (size_t)row * DFF + ch));
                    float* co = p.out + O_CONVS + (size_t)b * 2 * DFF + ch; *(f32x4*)co = g1; *(f32x4*)(co + DFF) = g0; } }
            asm volatile("s_waitcnt lgkmcnt(0)" ::: "memory"); __builtin_amdgcn_s_barrier(); asm volatile("" ::: "memory");
            return;
        }
#pragma unroll
        for (int n = 0; n < 2; ++n) {
#pragma unroll
            for (int ai = 0; ai < 2; ++ai) if (fr >= 14) { const f32x4 g3 = acc[ai][0][3][n] * UP_RR(ai, 3);
                *(LAS f32x4*)(X + ((2 * ai + wr) * 2 + (fr - 14)) * 128 + chl + 4 * n) = g3;
                if (ai == 1 && wr == 1) { *(f32x4*)((float*)(ws + WS_HALO) + ((size_t)pm * 2 + (fr - 14)) * DFF + chb + 4 * n) = g3;
                    if ((pm & 7) == 7) *(f32x4*)(p.out + O_CONVP + ((size_t)(pm >> 3) * 2 + (fr - 14)) * DFF + chb + 4 * n) = g3; } }
            if (wr == 0 && fr < 2) { *(f32x4*)((float*)(ws + WS_FIXG) + ((size_t)pm * 2 + fr) * DFF + chb + 4 * n) = acc[0][0][0][n] * UP_RR(0, 0);
                *(f32x4*)((float*)(ws + WS_FIXU) + ((size_t)pm * 2 + fr) * DFF + chb + 4 * n) = acc[0][1][0][n] * UP_RR(0, 0); }
        }
        asm volatile("s_waitcnt lgkmcnt(0)" ::: "memory"); __builtin_amdgcn_s_barrier(); asm volatile("" ::: "memory");
        const f32x4 z4 = {0.f, 0.f, 0.f, 0.f};
#pragma unroll
        for (int n = 0; n < 2; ++n) { const int ch = chb + 4 * n;
            const f32x4 w0 = *(const f32x4*)(p.conv_w + ch), w1 = *(const f32x4*)(p.conv_w + DFF + ch), w2 = *(const f32x4*)(p.conv_w + 2 * DFF + ch), cb = *(const f32x4*)(p.conv_b + ch);
#pragma unroll
            for (int ai = 0; ai < 2; ++ai) {
                f32x4 t1p = z4, t2p = z4;
                if (!(ai == 0 && wr == 0)) { const int ps = (wr == 1) ? 2 * ai : 1; const LAS float* xp = X + (ps * 2) * 128 + chl + 4 * n;
                    const f32x4 pv14 = *(const LAS f32x4*)xp, pv15 = *(const LAS f32x4*)(xp + 128); t1p = pv15; t2p = (fr == 0) ? pv14 : pv15; }
#pragma unroll
                for (int m = 0; m < 4; ++m) { const int row = pm * 256 + ai * 128 + wr * 64 + m * 16 + fr;
                    const float rm = UP_RR(ai, m); const f32x4 gm = acc[ai][0][m][n] * rm;
                    const f32x4 t1 = (f32x4){ror16<1>(gm.x), ror16<1>(gm.y), ror16<1>(gm.z), ror16<1>(gm.w)};
                    const f32x4 t2 = (f32x4){ror16<2>(gm.x), ror16<2>(gm.y), ror16<2>(gm.z), ror16<2>(gm.w)};
                    const f32x4 p1 = (fr == 0) ? t1p : t1, p2 = (fr < 2) ? t2p : t2;
                    const f32x4 aa = silu4(cb + w0 * p2 + w1 * p1 + w2 * gm) * (acc[ai][1][m][n] * rm);
                    u32x2 o; o.x = pk2(aa.x, aa.y); o.y = pk2(aa.z, aa.w); ACT_ST(o, (u32x2*)(ACT + (size_t)row * DFF + ch));
                    t1p = t1; t2p = t2; }
            }
            asm volatile("" ::: "memory");
        }
    }
#undef UP_RR
};

struct PhaseWpb {
    static constexpr int LDA = POOLW, LDB = 256, KT = 4;
    const Params& p; int G, c;
    DI bool next(int i, g8::Unit& u) const { const int off = 220 % G; const long L = (long)i * G + ((c + G - off) % G); if (L >= 32) return false;
        const int pm = (int)L >> 2, g = (int)L & 3; u.pm = pm; u.pn = g;
        u.A = (const char*)(p.ws + WS_WBT) + ((size_t)pm * 256 * POOLW + g * 256) * 2; u.B = (const char*)(p.ws + WS_WPS) + (size_t)g * 256 * 256 * 2; return true; }
    DI void epi(EPI_ARGS) const { bf16_t* W = (bf16_t*)(p.ws + WS_WPB);
        EPI_ROWS(row) EPI_COLS(col) *(u32x4*)(W + (size_t)row * POOLW + u.pn * 256 + col) = pk8(v0, v1); EPI_END }
};

template <int LDA, int LDB>
DI void skinny64(const bf16_t* A, const bf16_t* W, int lane, int s0, int s1, f32x4 (&acc)[4]) {
    const int fr = lane & 15, fq = lane >> 4;
    const bf16_t* ap = A + (size_t)fr * LDA + 8 * fq; const bf16_t* bp = W + (size_t)fr * LDB + 8 * fq;
#pragma unroll
    for (int g = 0; g < 4; ++g) acc[g] = (f32x4){0.f, 0.f, 0.f, 0.f};
#pragma unroll 4
    for (int s = s0; s < s1; ++s) { const bf16x8 b = *(const bf16x8*)(bp + 32 * s);
#pragma unroll
        for (int g = 0; g < 4; ++g) { const bf16x8 a = *(const bf16x8*)(ap + (size_t)(16 * g) * LDA + 32 * s); acc[g] = __builtin_amdgcn_mfma_f32_16x16x32_bf16(a, b, acc[g], 0, 0, 0); } }
}
DI float sum16(float v) { v += __shfl_xor(v, 1); v += __shfl_xor(v, 2); v += __shfl_xor(v, 4); v += __shfl_xor(v, 8); return v; }
template <int KIND, int K, int LDA, int LDB, int NCG = 128>
DI void sample_gemm(const Params& p, LAS unsigned char* lds, size_t a_off, size_t w_off, int wave) {
    unsigned char* ws = p.ws; const int lane = lane_id(), fr = lane & 15, fq = lane >> 4;
    constexpr int KS = K / 32;
    for (int it = blockIdx.x; it < 2 * NCG; it += gridDim.x) {
        const int cg_ = it >> 1, rb = MP + 64 * (it & 1), r0 = rb + 16 * (wave & 3), col = 16 * cg_ + fr;
        f32x4 part[4];
        skinny64<LDA, LDB>((const bf16_t*)(ws + a_off) + (size_t)rb * LDA, (const bf16_t*)(ws + w_off) + (size_t)(16 * cg_) * LDB, lane, (wave * KS) / 8, ((wave + 1) * KS) / 8, part);
        LAS f32x4* xch = (LAS f32x4*)lds;
#pragma unroll
        for (int g = 0; g < 4; ++g) xch[(wave * 4 + g) * 64 + lane] = part[g];
        __syncthreads();
        if (wave < 4) {
        f32x4 acc = xch[wave * 64 + lane];
#pragma unroll
        for (int w = 1; w < 8; ++w) acc += xch[(w * 4 + wave) * 64 + lane];
        float rs[4] = {0.f, 0.f, 0.f, 0.f};
        if (KIND == 5) {
            const float* SS2S = (const float*)(ws + WS_SS2S);
#pragma unroll
            for (int r = 0; r < 16; ++r) { const float* q = SS2S + (size_t)(r0 - MP + r) * 128; const float s_ = wave_sum(q[lane] + q[64 + lane]); const float rr = 1.0f / sqrtf(s_ * (1.0f / D) + EPS);
#pragma unroll
                for (int j = 0; j < 4; ++j) rs[j] = (r == 4 * fq + j) ? rr : rs[j]; }
        }
#pragma unroll
        for (int j = 0; j < 4; ++j) {
            const int row = r0 + 4 * fq + j; const size_t o = (size_t)row * D + col; const float v = acc[j]; float hsq = 0.f;
            if (KIND == 6) { const float val = v * ((const float*)(ws + WS_RSTD1))[row];
                if (col < KW) ((bf16_t*)(ws + WS_QB))[(size_t)row * KW + col] = (bf16_t)(pk2(val * 0.0625f, 0.f) & 0xffffu);
                else if (col < 2 * KW) ((bf16_t*)(ws + WS_KB))[(size_t)row * KW + col - KW] = (bf16_t)(pk2(val, 0.f) & 0xffffu);
                else ((bf16_t*)(ws + WS_V))[(size_t)row * VW + col - 2 * KW] = (bf16_t)(pk2(val, 0.f) & 0xffffu); }
            if (KIND == 0) { ((bf16_t*)(ws + WS_YBG))[o] = (bf16_t)(pk2(v * ((float)(ws + WS_GB)[o] * (1.0f / 255.0f)), 0.f) & 0xffffu); }
            if (KIND == 1) { ((bf16_t*)(ws + WS_MB))[o] = (bf16_t)(pk2(v * ((float)(ws + WS_GA)[o] * (1.0f / 255.0f)) + bf1(((const bf16_t*)(ws + WS_YBG))[o]), 0.f) & 0xffffu); }
            if (KIND == 2) { const float hv = p.x_sample[(size_t)(row - MP) * D + col] + v; ((bf16_t*)(ws + WS_H1B))[o] = (bf16_t)(pk2(hv, 0.f) & 0xffffu); hsq = hv * hv; }
            if (KIND == 3) { const float hv = bf1(((const bf16_t*)(ws + WS_H1B))[o]) + v; ((bf16_t*)(ws + WS_H2B))[o] = (bf16_t)(pk2(hv, 0.f) & 0xffffu); hsq = hv * hv; }
            if (KIND == 4) { ((bf16_t*)(ws + WS_PE))[o] = (bf16_t)(pk2(v, 0.f) & 0xffffu); }
            if (KIND == 5) { const float hv = bf1(((const bf16_t*)(ws + WS_H2B))[o]) + sigmoidf_(v * rs[j]) * bf1(((const bf16_t*)(ws + WS_PE))[o]); ((bf16_t*)(ws + WS_H3))[o] = (bf16_t)(pk2(hv, 0.f) & 0xffffu); hsq = hv * hv; }
            if (KIND == 2) { const float t = sum16(hsq); if (fr == 0) __hip_atomic_fetch_add((float*)(ws + WS_RS1) + row, t, __ATOMIC_RELAXED, __HIP_MEMORY_SCOPE_AGENT); }
            if (KIND == 3 || KIND == 5) { const float t = sum16(hsq);
                float* SSx = (float*)(ws + (KIND == 3 ? WS_SS2S : WS_SS3S)); if (fr == 0) SSx[(size_t)(row - MP) * 128 + cg_] = t; }
        }
        }
        __syncthreads();
    }
}


#define XB_TMO      128
#define XB_XCNT(j)  (256  + 64 * (j))
#define XB_XSUB(j)  (1280 + 64 * (j))
#define XB_XGEN(j)  (2304 + 64 * (j))
#define XB_TOP      3328
#define XB_TOPGEN   3392
#define XCD_BAR_WORDS 3456
#define XB_SPIN_CAP (1u << 22)
DI unsigned xb_ld(unsigned* p)              { return __hip_atomic_load(p, __ATOMIC_RELAXED, __HIP_MEMORY_SCOPE_AGENT); }
DI unsigned xb_add(unsigned* p, unsigned v) { return __hip_atomic_fetch_add(p, v, __ATOMIC_RELAXED, __HIP_MEMORY_SCOPE_AGENT); }
DI unsigned xb_xcc_id() { return (unsigned)__builtin_amdgcn_s_getreg((3 << 11) | 20) & 0xFu; }
#define XB_SPIN(cond, bar) do { unsigned _sp = 0; while (cond) { __builtin_amdgcn_s_sleep(1); \
    if ((++_sp & 255u) == 0u) { if (xb_ld(&(bar)[XB_TMO])) break; if (_sp > XB_SPIN_CAP) { atomicAdd(&(bar)[XB_TMO], 1u); break; } } } } while (0)
struct XcdBarrier { unsigned* bar; unsigned x; volatile LAS unsigned* st; };
DI XcdBarrier xcd_barrier_post(unsigned* bar, volatile LAS unsigned* st, bool t0) {
    XcdBarrier b; b.bar = bar; b.x = xb_xcc_id(); b.st = st;
    if (t0) (void)xb_add(&bar[XB_XCNT(b.x)], 1u);
    return b;
}
DI void xcd_barrier_complete(unsigned* bar, unsigned x, unsigned& nloc, unsigned& nx) {
    const unsigned G = gridDim.x * gridDim.y * gridDim.z;
    unsigned sum, cnt, mine, sp = 0u;
    for (;;) {
        sum = 0u; cnt = 0u; mine = 0u;
#pragma unroll
        for (unsigned j = 0; j < 16; ++j) { const unsigned c = xb_ld(&bar[XB_XCNT(j)]); sum += c; cnt += (c > 0u) ? 1u : 0u; mine = (j == x) ? c : mine; }
        if (sum == G) break;
        __builtin_amdgcn_s_sleep(1);
        if ((++sp & 255u) == 0u) { if (xb_ld(&bar[XB_TMO])) break; if (sp > XB_SPIN_CAP) { atomicAdd(&bar[XB_TMO], 1u); break; } }
    }
    nloc = mine > 0u ? mine : 1u; nx = cnt > 0u ? cnt : 1u;
}
DI void xcd_barrier(const XcdBarrier& b, bool t0) {
    asm volatile("s_waitcnt vmcnt(0)" ::: "memory");
    __syncthreads();
    if (t0) {
        unsigned* bar = b.bar;
        __builtin_amdgcn_s_waitcnt(0);
        unsigned nloc = b.st[0], nx = b.st[1];
        if (nloc == 0u) { xcd_barrier_complete(bar, b.x, nloc, nx); b.st[0] = nloc; b.st[1] = nx; }
        const unsigned old = xb_add(&bar[XB_XSUB(b.x)], 1u);
        const unsigned gen = old / nloc;
        if (old + 1u == (gen + 1u) * nloc) {
            __builtin_amdgcn_fence(__ATOMIC_RELEASE, "agent");
            asm volatile("s_waitcnt vmcnt(0)" ::: "memory");
            const unsigned og = xb_add(&bar[XB_TOP], 1u);
            const unsigned tg = og / nx;
            if (og + 1u == (tg + 1u) * nx) xb_add(&bar[XB_TOPGEN], 1u);
            else XB_SPIN(xb_ld(&bar[XB_TOPGEN]) == tg, bar);
            __builtin_amdgcn_fence(__ATOMIC_ACQUIRE, "agent");
            xb_add(&bar[XB_XGEN(b.x)], 1u);
            asm volatile("s_waitcnt vmcnt(0)" ::: "memory");
        } else {
            XB_SPIN(xb_ld(&bar[XB_XGEN(b.x)]) == gen, bar);
            __builtin_amdgcn_fence(__ATOMIC_ACQUIRE, "agent");
            asm volatile("s_waitcnt vmcnt(0)" ::: "memory");
        }
    }
    __syncthreads();
}

#define QW_GEMM 3700
#define QW_SCAN 3716
#define QW_SOGN 3732
DI void role_signal(unsigned* ctr, bool t0) {
    asm volatile("s_waitcnt vmcnt(0)" ::: "memory");
    __syncthreads();
    if (t0) { __builtin_amdgcn_s_waitcnt(0); __builtin_amdgcn_fence(__ATOMIC_RELEASE, "agent"); asm volatile("s_waitcnt vmcnt(0)" ::: "memory"); (void)xb_add(ctr, 1u); }
}
DI void role_wait(unsigned* ctr, unsigned n, unsigned* bar, bool t0) {
    if (t0) { XB_SPIN(xb_ld(ctr) < n, bar); __builtin_amdgcn_fence(__ATOMIC_ACQUIRE, "agent"); asm volatile("s_waitcnt vmcnt(0)" ::: "memory"); }
    __syncthreads();
}

constexpr int N_PHASES = 13;
#ifndef G8_SP2
#define G8_SP2 true
#endif
#ifndef G8_ALIGN
#define G8_ALIGN true
#endif

__global__ void __launch_bounds__(NTHREADS, 2) fwd_kernel(Params p) {
    extern __shared__ __attribute__((aligned(16))) unsigned char lds_raw[];
    LAS unsigned char* lds = (LAS unsigned char*)lds_raw;
    const int G = gridDim.x, c = blockIdx.x;
    const int wave = __builtin_amdgcn_readfirstlane(threadIdx.x >> 6);
    const int lo = p.ph_lo, hi = p.ph_hi;
#ifndef REPEAT_MASK
#define REPEAT_MASK 0
#endif
#ifndef PHASE_MASK
#define PHASE_MASK 0x1aff
#endif
#define IN(k) (((PHASE_MASK >> (k)) & 1) && lo <= (k) && (k) < hi)
#ifdef PROBE_A
    unsigned long long tpa = 0, tpb = 0;
#define TP(k) do { if ((k) == PROBE_A) tpa = __builtin_amdgcn_s_memrealtime(); if ((k) == PROBE_B) tpb = __builtin_amdgcn_s_memrealtime(); } while (0)
#else
#define TP(k) do { } while (0)
#endif
    volatile LAS unsigned* bst = (volatile LAS unsigned*)(lds + LDS_MISC);
    const bool t0 = (wave == 0) && (lane_id() == 0);
    XcdBarrier bar; bar.bar = (unsigned*)(p.ws + WS_CTL); bar.x = 0; bar.st = bst;
    if (hi - lo > 1) { if (t0) { bst[0] = 0u; bst[1] = 0u; } __syncthreads(); bar = xcd_barrier_post((unsigned*)(p.ws + WS_CTL), bst, t0); }
#define NEXTPH(k) ((k) == 9 ? 11 : ((k) == 7 ? 9 : (k) + 1))
#if defined(PROBE_A) && !defined(PROBE_NOSYNC)
#define PRESYNC() do { asm volatile("s_waitcnt vmcnt(0)" ::: "memory"); __syncthreads(); } while (0)
#else
#define PRESYNC() do { } while (0)
#endif
#define SEAM(k) do { PRESYNC(); TP(2 * (k) + 1); if (IN(k) && IN(NEXTPH(k))) { xcd_barrier(bar, (wave == 0) && (lane_id() == 0)); } TP(2 * (k) + 2); } while (0)
    TP(0);
    if (IN(0)) { phase_p0(p, lds, wave); if ((REPEAT_MASK >> 0) & 1) { xcd_barrier(bar, (wave == 0) && (lane_id() == 0)); phase_p0(p, lds, wave); } } SEAM(0);
#if 1
    if (IN(1)) { PhaseIn ph{p, G, c, 0, 0}; g8::run<PhaseIn, G8_ALIGN, G8_SP2>(lds, ph, wave); sample_gemm<6, D, D, D, 256>(p, lds, WS_XB, WS_WIN, wave);
#else
    if (IN(1)) { sample_gemm<6, D, D, D, 256>(p, lds, WS_XB, WS_WIN, wave); TP(31); PhaseIn ph{p, G, c, 0, 0}; g8::run<PhaseIn, G8_ALIGN, G8_SP2>(lds, ph, wave);
#endif
        if (G != 256) deferred_transposes<1>(p, lds, wave, c, G);
        { const int lane = lane_id(); for (int it = c * NWAVES + wave; it < MS * 14; it += G * NWAVES) pool_copy_task(p, it, lane); } } SEAM(1);
    if (IN(2)) {
        if (G == 256) {
            unsigned* ctl = (unsigned*)(p.ws + WS_CTL); const bool tz = (wave == 0) && (lane_id() == 0);
            if (c < 32) { scan_role(p, lds, wave, c, 32); TP(30); role_signal(ctl + QW_SCAN, tz); scan_tail(p, wave, c); }
            else if (c < 71) stream_role(p, wave, c - 32, 39);
            else { PhaseIn ph{p, G, c, 1, 71}; g8::run<PhaseIn, G8_ALIGN, G8_SP2>(lds, ph, wave); PhaseWpb pw{p, G, c}; g8::run<PhaseWpb, G8_ALIGN, G8_SP2>(lds, pw, wave); TP(32);
                role_signal(ctl + QW_GEMM, tz); role_wait(ctl + QW_GEMM, 185u, ctl, tz);
                const int lane = lane_id(); const int gw = (c - 71) * NWAVES + wave, NGW = 185 * NWAVES;
                for (int t = gw; t < M; t += NGW) pmix_task(p, t, lane);
                role_wait(ctl + QW_SCAN, 32u, ctl, tz);
                for (int t = gw; t < MP; t += NGW) ogn_task(p, t, lane); }
        } else {
            PhaseIn ph{p, G, c, 1, 0}; g8::run<PhaseIn, G8_ALIGN, G8_SP2>(lds, ph, wave); PhaseWpb pw{p, G, c}; g8::run<PhaseWpb, G8_ALIGN, G8_SP2>(lds, pw, wave);
            scan_role(p, lds, wave, c, G); stream_role(p, wave, c, G);
        }
    } SEAM(2);
    if (G != 256) {
    if (IN(3)) { phase_p3(p, wave); if ((REPEAT_MASK >> 3) & 1) { xcd_barrier(bar, (wave == 0) && (lane_id() == 0)); phase_p3(p, wave); } } SEAM(3);
    }
    if (IN(4)) { if (G == 256) { unsigned* ctl = (unsigned*)(p.ws + WS_CTL); if (c < 16) { ogn_task(p, MP + c * NWAVES + wave, lane_id()); role_signal(ctl + QW_SOGN, (wave == 0) && (lane_id() == 0)); } }
        PhaseYb ph{{p, G, c, WS_PM, WS_WPB}}; g8::run<PhaseYb, G8_ALIGN, G8_SP2>(lds, ph, wave); sample_gemm<0, POOLW, POOLW, POOLW>(p, lds, WS_PM, WS_WPB, wave); if ((REPEAT_MASK >> 4) & 1) { xcd_barrier(bar, (wave == 0) && (lane_id() == 0)); sample_gemm<0, POOLW, POOLW, POOLW>(p, lds, WS_PM, WS_WPB, wave); PhaseYb ph{{p, G, c, WS_PM, WS_WPB}}; g8::run<PhaseYb, G8_ALIGN, G8_SP2>(lds, ph, wave); } }
    TP(9); TP(10);
    if (IN(5)) { asm volatile("s_waitcnt vmcnt(0)" ::: "memory"); __syncthreads(); if (G == 256) { unsigned* ctl = (unsigned*)(p.ws + WS_CTL); role_wait(ctl + QW_SOGN, 16u, ctl, (wave == 0) && (lane_id() == 0)); } PhaseYa ph{{p, G, c, WS_OG, WS_WA}}; g8::run<PhaseYa, G8_ALIGN, G8_SP2>(lds, ph, wave); sample_gemm<1, VW, VW, VW>(p, lds, WS_OG, WS_WA, wave); if ((REPEAT_MASK >> 5) & 1) { xcd_barrier(bar, (wave == 0) && (lane_id() == 0)); sample_gemm<1, VW, VW, VW>(p, lds, WS_OG, WS_WA, wave); PhaseYa ph{{p, G, c, WS_OG, WS_WA}}; g8::run<PhaseYa, G8_ALIGN, G8_SP2>(lds, ph, wave); } } SEAM(5);
    if (IN(6)) { PhaseOut ph{{p, G, c, WS_MB, WS_WO}}; g8::run<PhaseOut, G8_ALIGN, G8_SP2>(lds, ph, wave); sample_gemm<2, D, D, D>(p, lds, WS_MB, WS_WO, wave); if ((REPEAT_MASK >> 6) & 1) { xcd_barrier(bar, (wave == 0) && (lane_id() == 0)); sample_gemm<2, D, D, D>(p, lds, WS_MB, WS_WO, wave); PhaseOut ph{{p, G, c, WS_MB, WS_WO}}; g8::run<PhaseOut, G8_ALIGN, G8_SP2>(lds, ph, wave); } } SEAM(6);
    if (IN(7)) {
        const int ng = (G == 256) ? 240 : G;
        PhaseUp ph{p, ng, c, lds + LDS_XCH}; g8::run<PhaseUp, true, G8_SP2>(lds, ph, wave);
        sample_gemm<4, PLE, PLE, PLE>(p, lds, WS_PLB, WS_WPLE, wave);
        { PhasePe pe{{p, G, c, WS_PLB, WS_WPLE}, (G == 256) ? 240 : 0, (G == 256) ? 16 : G}; g8::run<PhasePe, G8_ALIGN, G8_SP2>(lds, pe, wave); }
        if (G == 256) { if (c >= 240) deferred_transposes<0>(p, lds, wave, c - 240, 16); } else deferred_transposes<0>(p, lds, wave, c, G);
        if ((REPEAT_MASK >> 7) & 1) { xcd_barrier(bar, (wave == 0) && (lane_id() == 0)); PhaseUp ph2{p, ng, c, lds + LDS_XCH}; g8::run<PhaseUp, true, G8_SP2>(lds, ph2, wave); }
    } SEAM(7);
    if (IN(9)) { { PhaseDown pd{{p, G, c, WS_ACT, WS_WD}}; g8::Unit uu; for (int i = 0; pd.next(i, uu); ++i) conv_fixup_tile(p, uu.pm, wave); asm volatile("s_waitcnt vmcnt(0)" ::: "memory"); __syncthreads(); } PhaseDown ph{{p, G, c, WS_ACT, WS_WD}}; g8::run<PhaseDown, G8_ALIGN, G8_SP2>(lds, ph, wave); sample_gemm<3, DFF, DFF, DFF>(p, lds, WS_ACT, WS_WD, wave); if ((REPEAT_MASK >> 9) & 1) { xcd_barrier(bar, (wave == 0) && (lane_id() == 0)); sample_gemm<3, DFF, DFF, DFF>(p, lds, WS_ACT, WS_WD, wave); PhaseDown ph{{p, G, c, WS_ACT, WS_WD}}; g8::run<PhaseDown, G8_ALIGN, G8_SP2>(lds, ph, wave); } } SEAM(9);
    if (IN(11)) { PhasePg ph{{p, G, c, WS_H2B, WS_WPG}}; g8::run<PhasePg, G8_ALIGN, G8_SP2>(lds, ph, wave); sample_gemm<5, D, D, D>(p, lds, WS_H2B, WS_WPG, wave); if ((REPEAT_MASK >> 11) & 1) { xcd_barrier(bar, (wave == 0) && (lane_id() == 0)); sample_gemm<5, D, D, D>(p, lds, WS_H2B, WS_WPG, wave); PhasePg ph{{p, G, c, WS_H2B, WS_WPG}}; g8::run<PhasePg, G8_ALIGN, G8_SP2>(lds, ph, wave); } } SEAM(11);
    if (IN(12)) { phase_final(p, wave); if ((REPEAT_MASK >> 12) & 1) { xcd_barrier(bar, (wave == 0) && (lane_id() == 0)); phase_final(p, wave); } }
    TP(25);
#ifdef PROBE_A
#ifdef PROBE_LO
    { unsigned* mx = (unsigned*)(p.ws + WS_CTL) + 3500;
      if (c >= PROBE_LO && c <= PROBE_HI && lane_id() == 0) __hip_atomic_fetch_max(mx, (unsigned)(tpb - tpa), __ATOMIC_RELAXED, __HIP_MEMORY_SCOPE_AGENT);
      xcd_barrier(bar, (wave == 0) && (lane_id() == 0));
      if (c == 0 && wave == 0) { const unsigned long long te = __builtin_amdgcn_s_memrealtime(); const unsigned long long dt = (unsigned long long)xb_ld(mx) * PROBE_MUL; while (__builtin_amdgcn_s_memrealtime() - te < dt) __builtin_amdgcn_s_sleep(8); } }
#else
    if (c == PROBE_BLK && wave == 0) { const unsigned long long te = __builtin_amdgcn_s_memrealtime(); const unsigned long long dt = (tpb - tpa) * PROBE_MUL; while (__builtin_amdgcn_s_memrealtime() - te < dt) __builtin_amdgcn_s_sleep(8); }
#endif
#endif
#undef IN
#undef SEAM
}

extern "C" void kernel_launch(void* const* d_in, const int* in_sizes, int n_in, void* d_out, int out_size, void* d_ws, size_t ws_size, hipStream_t stream) {
    static int grid = 0;
    if (grid == 0) {
        if (n_in != 26 || (size_t)out_size != O_END || ws_size < WS_END) {
            fprintf(stderr, "kernel_launch: unexpected problem: n_in %d out %d ws %zu (need %zu)\n", n_in, out_size, ws_size, (size_t)WS_END); grid = -1; return; }
        int dev = 0, cus = 0, per_cu = 0;
        if (hipGetDevice(&dev) != hipSuccess || hipDeviceGetAttribute(&cus, hipDeviceAttributeMultiprocessorCount, dev) != hipSuccess) { grid = -1; return; }
        if (hipFuncSetAttribute((const void*)fwd_kernel, hipFuncAttributeMaxDynamicSharedMemorySize, LDS_BYTES) != hipSuccess) { fprintf(stderr, "kernel_launch: hipFuncSetAttribute failed\n"); grid = -1; return; }
        if (hipOccupancyMaxActiveBlocksPerMultiprocessor(&per_cu, (const void*)fwd_kernel, NTHREADS, LDS_BYTES) != hipSuccess || per_cu < 1) {
            fprintf(stderr, "kernel_launch: occupancy query reports %d blocks per CU\n", per_cu); (void)hipGetLastError(); grid = -1; return; }
        grid = cus;
    }
    if (grid < 0) return;
    Params p{};
    const float** pp = (const float**)&p;
    for (int i = 0; i < 26; ++i) pp[i] = (const float*)d_in[i];
    p.out = (float*)d_out; p.ws = (unsigned char*)d_ws;
#if MK_N_LAUNCHES == 1
    p.ph_lo = 0; p.ph_hi = N_PHASES;
    void* args[] = {&p};
    if (hipMemsetAsync((char*)d_ws + WS_CTL, 0, 16384, stream) != hipSuccess) { fprintf(stderr, "kernel_launch: memset failed\n"); return; }
    hipError_t e = hipLaunchCooperativeKernel((const void*)fwd_kernel, dim3(grid), dim3(NTHREADS), args, LDS_BYTES, stream);
    if (e != hipSuccess) fprintf(stderr, "kernel_launch: cooperative launch failed: %s (grid %d)\n", hipGetErrorString(e), grid);
#else
    for (int k = 0; k < N_PHASES; ++k) { p.ph_lo = k; p.ph_hi = k + 1; hipLaunchKernelGGL(fwd_kernel, dim3(grid), dim3(NTHREADS), LDS_BYTES, stream, p); }
#endif
}
```
